# Optimizing an MI355X kernel written in HIP

```python
import math
import jax
import jax.numpy as jnp
from jax import lax
import numpy as np

D_MODEL = 2048
BATCH = 2
SEQ = 4096
DEPTH = 2

GRID_W = 64
CTX_LEN = 256
N_BRANCH = 4
BRANCH_W = D_MODEL // 4
S5_GROUP_CH = 16
S5_GROUPS = BRANCH_W // S5_GROUP_CH
S5_STATE = 64
GQA_HEAD_DIM = 128
GQA_HEADS = BRANCH_W // GQA_HEAD_DIM
GQA_KV_HEADS = GQA_HEADS // 2
RET_HEADS = 4
RET_V_DIM = BRANCH_W // RET_HEADS
RET_QK_DIM = RET_V_DIM // 2
RET_CHUNK = 128
MLA_HEADS = 4
MLA_Q_LORA = BRANCH_W
MLA_KV_LORA = BRANCH_W // 2
MLA_NOPE_DIM = 128
MLA_ROPE_DIM = 64
MLA_V_DIM = BRANCH_W // MLA_HEADS
N_EXPERTS = 16
EXPERT_FF = D_MODEL // 2
EC_CAPACITY_FACTOR = 2
Q_BLOCK = 128
ROPE_BASE = 10000.0
NORM_EPS = 1e-6
DEEPNORM_ALPHA = (2 * DEPTH) ** 0.25
DEEPNORM_BETA = (8 * DEPTH) ** -0.25
IN_WIDTHS = (
    BRANCH_W,
    GQA_HEADS * GQA_HEAD_DIM, GQA_KV_HEADS * GQA_HEAD_DIM, GQA_KV_HEADS * GQA_HEAD_DIM,
    RET_HEADS * RET_QK_DIM, RET_HEADS * RET_QK_DIM, RET_HEADS * RET_V_DIM, RET_HEADS * RET_V_DIM,
    MLA_Q_LORA, MLA_KV_LORA, MLA_ROPE_DIM,
)
IN_TOTAL = sum(IN_WIDTHS)
IN_OFFSETS = tuple(int(v) for v in np.cumsum(IN_WIDTHS)[:-1])
F32 = jnp.float32

kernel_name = 'hybrid_s5_gqa_retention_mla_ecmoe_dit'


def standardize(x):
    xf = x.astype(F32)
    xc = xf - jnp.mean(xf, -1, keepdims=True)
    return xc * lax.rsqrt(jnp.mean(xc * xc, -1, keepdims=True) + NORM_EPS)


def layer_norm(x, g, b):
    return (standardize(x) * g + b).astype(x.dtype)


def modulate(x, shift, scale):
    return (standardize(x) * (1.0 + scale) + shift).astype(x.dtype)


def rms_norm(x, g):
    xf = x.astype(F32)
    return (xf * lax.rsqrt(jnp.mean(xf * xf, -1, keepdims=True) + NORM_EPS) * g).astype(x.dtype)


def rope_1d(x, pos):
    n = x.shape[-1] // 2
    inv = ROPE_BASE ** (-jnp.arange(n, dtype=F32) / n)
    ang = pos.astype(F32)[:, None] * inv[None, :]
    cos, sin = jnp.cos(ang), jnp.sin(ang)
    xf = x.astype(F32)
    x1, x2 = xf[..., :n], xf[..., n:]
    return jnp.concatenate([x1 * cos - x2 * sin, x1 * sin + x2 * cos], -1)


def axial_rope(x, row, col):
    half = x.shape[-1] // 2
    return jnp.concatenate([rope_1d(x[..., :half], row), rope_1d(x[..., half:], col)], -1).astype(x.dtype)


def split_heads(t, n_heads):
    b, n, _ = t.shape
    return t.reshape(b, n, n_heads, -1).transpose(0, 2, 1, 3)


def merge_heads(t):
    b, h, n, d = t.shape
    return t.transpose(0, 2, 1, 3).reshape(b, n, h * d)


def block_attention(q, k, v, scale):
    b, hk, g, n, dh = q.shape
    nb = n // Q_BLOCK
    qb = jnp.moveaxis(q.reshape(b, hk, g, nb, Q_BLOCK, dh), 3, 0)

    def one_block(qi):
        s = jnp.einsum('bhgqd,bhkd->bhgqk', qi, k).astype(F32) * scale
        p = jax.nn.softmax(s, axis=-1)
        return jnp.einsum('bhgqk,bhkd->bhgqd', p.astype(v.dtype), v)

    o = lax.map(one_block, qb)
    return jnp.moveaxis(o, 0, 3).reshape(b, hk, g, n, v.shape[-1])


def s5_discretise(a_re, a_im, log_dt, b_re, b_im):
    dt = jnp.exp(log_dt.astype(F32))[:, None]
    a_re = a_re.astype(F32)
    a_im = a_im.astype(F32)
    mag = jnp.exp(a_re * dt)
    ab_re, ab_im = mag * jnp.cos(a_im * dt), mag * jnp.sin(a_im * dt)
    den = a_re * a_re + a_im * a_im
    num_re, num_im = ab_re - 1.0, ab_im
    coef_re = (num_re * a_re + num_im * a_im) / den
    coef_im = (num_im * a_re - num_re * a_im) / den
    b_re = b_re.astype(F32)
    b_im = b_im.astype(F32)
    bb_re = coef_re[..., None] * b_re - coef_im[..., None] * b_im
    bb_im = coef_re[..., None] * b_im + coef_im[..., None] * b_re
    return ab_re, ab_im, bb_re, bb_im


def complex_affine_combine(left, right):
    la_re, la_im, lb_re, lb_im = left
    ra_re, ra_im, rb_re, rb_im = right
    return (la_re * ra_re - la_im * ra_im,
            la_re * ra_im + la_im * ra_re,
            ra_re * lb_re - ra_im * lb_im + rb_re,
            ra_re * lb_im + ra_im * lb_re + rb_im)


def s5_scan(u, ab_re, ab_im, bb_re, bb_im, h0_re, h0_im, reverse):
    if reverse:
        u = jnp.flip(u, 1)
    uf = u.astype(F32)
    b_re = jnp.einsum('bngi,gpi->bngp', uf, bb_re)
    b_im = jnp.einsum('bngi,gpi->bngp', uf, bb_im)
    b_re = b_re.at[:, 0].add(ab_re * h0_re - ab_im * h0_im)
    b_im = b_im.at[:, 0].add(ab_re * h0_im + ab_im * h0_re)
    a_re = jnp.broadcast_to(ab_re, b_re.shape)
    a_im = jnp.broadcast_to(ab_im, b_im.shape)
    _, _, h_re, h_im = lax.associative_scan(complex_affine_combine, (a_re, a_im, b_re, b_im), axis=1)
    if reverse:
        h_re, h_im = jnp.flip(h_re, 1), jnp.flip(h_im, 1)
    return h_re, h_im


def s5_readout(h_re, h_im, u, lp):
    b, n, w = u.shape
    y = (jnp.einsum('bngp,gip->bngi', h_re, lp['s5_c_re'].astype(F32))
         - jnp.einsum('bngp,gip->bngi', h_im, lp['s5_c_im'].astype(F32))).reshape(b, n, w)
    y = (y + lp['s5_d'].astype(F32) * u.astype(F32)).astype(u.dtype)
    z = jax.nn.gelu(y)
    return z * jax.nn.sigmoid(z @ lp['s5_w_glu'])


def s5_branch(u, uc, lp, need_ctx):
    b, n, _ = u.shape
    bc, m, _ = uc.shape
    ug = u.reshape(b, n, S5_GROUPS, S5_GROUP_CH)
    ucg = uc.reshape(bc, m, S5_GROUPS, S5_GROUP_CH)
    zero = jnp.zeros((bc, S5_GROUPS, S5_STATE), F32)
    lat_re = lat_im = ctx_re = ctx_im = 0.0
    for sfx, reverse in (('f', False), ('b', True)):
        ab_re, ab_im, bb_re, bb_im = s5_discretise(lp['s5_a_re_' + sfx], lp['s5_a_im_' + sfx],
                                                   lp['s5_log_dt_' + sfx], lp['s5_b_re'], lp['s5_b_im'])
        hc_re, hc_im = s5_scan(ucg, ab_re, ab_im, bb_re, bb_im, zero, zero, reverse)
        end = 0 if reverse else -1
        hl_re, hl_im = s5_scan(ug, ab_re, ab_im, bb_re, bb_im, hc_re[:, end], hc_im[:, end], reverse)
        lat_re = lat_re + hl_re
        lat_im = lat_im + hl_im
        if need_ctx:
            ctx_re = ctx_re + hc_re
            ctx_im = ctx_im + hc_im
    y = s5_readout(lat_re, lat_im, u, lp)
    yc = s5_readout(ctx_re, ctx_im, uc, lp) if need_ctx else None
    return y, yc


def gqa_branch(pl, pc, lp, row, col, need_ctx):
    q, k, v = pl
    qc, kc, vc = pc
    n_grp = GQA_HEADS // GQA_KV_HEADS
    scale = GQA_HEAD_DIM ** -0.5

    def attend(qh, kh, vh):
        b, _, n, d = qh.shape
        o = block_attention(qh.reshape(b, GQA_KV_HEADS, n_grp, n, d), kh, vh, scale)
        return merge_heads(o.reshape(b, GQA_HEADS, n, vh.shape[-1]))

    qn, kn = lp['gqa_q_norm'], lp['gqa_k_norm']
    k_ctx = rms_norm(split_heads(kc, GQA_KV_HEADS), kn)
    v_ctx = split_heads(vc, GQA_KV_HEADS)
    q_lat = axial_rope(rms_norm(split_heads(q, GQA_HEADS), qn), row, col)
    k_lat = axial_rope(rms_norm(split_heads(k, GQA_KV_HEADS), kn), row, col)
    v_lat = split_heads(v, GQA_KV_HEADS)
    y = attend(q_lat, jnp.concatenate([k_lat, k_ctx], 2), jnp.concatenate([v_lat, v_ctx], 2))
    yc = attend(rms_norm(split_heads(qc, GQA_HEADS), qn), k_ctx, v_ctx) if need_ctx else None
    return y, yc


def retention_chunkwise(q, k, v, log_gamma, s0, strict):
    b, h, n, _ = q.shape
    dv = v.shape[-1]
    nc = n // RET_CHUNK
    pos = jnp.arange(RET_CHUNK, dtype=F32)
    diff = pos[:, None] - pos[None, :]
    mask = (diff > 0) if strict else (diff >= 0)
    lg = log_gamma[:, None, None]
    decay_in = jnp.where(mask, jnp.exp(lg * jnp.where(mask, diff, 0.0)), 0.0)
    decay_q = jnp.exp(log_gamma[:, None] * (pos + 1.0))[..., None]
    decay_k = jnp.exp(log_gamma[:, None] * (RET_CHUNK - 1.0 - pos))[..., None]
    decay_c = jnp.exp(lg * RET_CHUNK)

    def chunks(t):
        return jnp.moveaxis(t.astype(F32).reshape(b, h, nc, RET_CHUNK, t.shape[-1]), 2, 0)

    def step(s, qkv):
        qi, ki, vi = qkv
        scores = jnp.einsum('bhqd,bhkd->bhqk', qi, ki) * decay_in
        o = (jnp.einsum('bhqk,bhkv->bhqv', scores, vi)
             + jnp.einsum('bhqd,bhdv->bhqv', qi * decay_q, s))
        s_new = s * decay_c + jnp.einsum('bhkd,bhkv->bhdv', ki * decay_k, vi)
        return s_new, o

    s_fin, o = lax.scan(step, s0, (chunks(q), chunks(k), chunks(v)))
    return jnp.moveaxis(o, 0, 2).reshape(b, h, n, dv), s_fin


def retention_state(k, v, log_gamma):
    n = k.shape[2]
    w = jnp.exp(log_gamma[:, None] * (n - 1.0 - jnp.arange(n, dtype=F32)))
    return jnp.einsum('bhnd,hn,bhnv->bhdv', k.astype(F32), w, v.astype(F32))


def retention_readout(o, g, gain):
    oc = o - jnp.mean(o, -1, keepdims=True)
    on = oc * lax.rsqrt(jnp.mean(oc * oc, -1, keepdims=True) + NORM_EPS)
    return (merge_heads(on) * gain * jax.nn.silu(g.astype(F32))).astype(g.dtype)


def flip_seq(t):
    return jnp.flip(t, 2)


def retention_branch(pl, pc, lp, row, col, need_ctx):
    q, k, v, g = pl
    qc, kc, vc, gc = pc
    sk = RET_QK_DIM ** -0.5
    lg_f = -jnp.exp(lp['ret_decay_f'].astype(F32))
    lg_b = -jnp.exp(lp['ret_decay_b'].astype(F32))
    q_lat = axial_rope(split_heads(q, RET_HEADS), row, col)
    k_lat = axial_rope(split_heads(k, RET_HEADS), row, col) * sk
    v_lat = split_heads(v, RET_HEADS)
    k_ctx = split_heads(kc, RET_HEADS) * sk
    v_ctx = split_heads(vc, RET_HEADS)
    if need_ctx:
        q_ctx = split_heads(qc, RET_HEADS)
        zero = jnp.zeros((qc.shape[0], RET_HEADS, RET_QK_DIM, RET_V_DIM), F32)
        oc_f, s_f = retention_chunkwise(q_ctx, k_ctx, v_ctx, lg_f, zero, False)
        oc_b, s_b = retention_chunkwise(flip_seq(q_ctx), flip_seq(k_ctx), flip_seq(v_ctx), lg_b, zero, True)
        yc = retention_readout(oc_f + flip_seq(oc_b), gc, lp['ret_norm'])
    else:
        s_f = retention_state(k_ctx, v_ctx, lg_f)
        s_b = retention_state(flip_seq(k_ctx), flip_seq(v_ctx), lg_b)
        yc = None
    o_f, _ = retention_chunkwise(q_lat, k_lat, v_lat, lg_f, s_f, False)
    o_b, _ = retention_chunkwise(flip_seq(q_lat), flip_seq(k_lat), flip_seq(v_lat), lg_b, s_b, True)
    y = retention_readout(o_f + flip_seq(o_b), g, lp['ret_norm'])
    return y, yc


def mla_branch(pl, pc, lp, row, col, need_ctx):
    cq, ckv, kr = pl
    cqc, ckvc, krc = pc
    scale = (MLA_NOPE_DIM + MLA_ROPE_DIM) ** -0.5

    def queries(c_q, rotate):
        qh = split_heads(rms_norm(c_q, lp['mla_q_norm']) @ lp['mla_w_uq'], MLA_HEADS)
        q_nope, q_rope = qh[..., :MLA_NOPE_DIM], qh[..., MLA_NOPE_DIM:]
        if rotate:
            q_rope = axial_rope(q_rope, row, col)
        return jnp.concatenate([q_nope, q_rope], -1)[:, :, None]

    def keys_values(c_kv, k_r, rotate):
        kvh = split_heads(rms_norm(c_kv, lp['mla_kv_norm']) @ lp['mla_w_ukv'], MLA_HEADS)
        k_nope, v = kvh[..., :MLA_NOPE_DIM], kvh[..., MLA_NOPE_DIM:]
        k_rope = k_r[:, None]
        if rotate:
            k_rope = axial_rope(k_rope, row, col)
        k_rope = jnp.broadcast_to(k_rope, k_nope.shape[:-1] + (MLA_ROPE_DIM,))
        return jnp.concatenate([k_nope, k_rope], -1), v

    k_ctx, v_ctx = keys_values(ckvc, krc, False)
    k_lat, v_lat = keys_values(ckv, kr, True)
    y = merge_heads(block_attention(queries(cq, True), jnp.concatenate([k_lat, k_ctx], 2),
                                    jnp.concatenate([v_lat, v_ctx], 2), scale)[:, :, 0])
    yc = merge_heads(block_attention(queries(cqc, False), k_ctx, v_ctx, scale)[:, :, 0]) if need_ctx else None
    return y, yc


def merge_branches(h, outs, lp):
    o = jnp.stack(outs, 0)
    proj = jnp.einsum('kbnw,kwd->bnkd', o, lp['w_branch'])
    gates = jax.nn.sigmoid(h @ lp['w_gate'] + lp['b_gate']).reshape(proj.shape)
    return jnp.sum(gates * proj, axis=2) @ lp['w_out']


def token_mixer(h, hc, row, col, lp, need_ctx):
    pl = jnp.split(h @ lp['w_in'], IN_OFFSETS, axis=-1)
    pc = jnp.split(hc @ lp['w_in'], IN_OFFSETS, axis=-1)
    o_s5, oc_s5 = s5_branch(pl[0], pc[0], lp, need_ctx)
    o_gqa, oc_gqa = gqa_branch(pl[1:4], pc[1:4], lp, row, col, need_ctx)
    o_ret, oc_ret = retention_branch(pl[4:8], pc[4:8], lp, row, col, need_ctx)
    o_mla, oc_mla = mla_branch(pl[8:11], pc[8:11], lp, row, col, need_ctx)
    y = merge_branches(h, (o_s5, o_gqa, o_ret, o_mla), lp)
    yc = merge_branches(hc, (oc_s5, oc_gqa, oc_ret, oc_mla), lp) if need_ctx else None
    return y, yc


def expert_choice_ffn(h, lp):
    b, n, d = h.shape
    cap = EC_CAPACITY_FACTOR * n // N_EXPERTS
    aff = jax.nn.softmax((h @ lp['router_w']).astype(F32), axis=-1)
    gate, idx = lax.top_k(jnp.swapaxes(aff, 1, 2), cap)
    xs = jax.vmap(lambda hb, ib: hb[ib])(h, idx)
    a = jnp.einsum('becd,edf->becf', xs, lp['moe_w_gate'])
    u = jnp.einsum('becd,edf->becf', xs, lp['moe_w_up'])
    y = jnp.einsum('becf,efd->becd', jax.nn.silu(a) * u, lp['moe_w_down']) * gate[..., None].astype(h.dtype)
    return jax.vmap(lambda yb, ib: jnp.zeros((n, d), yb.dtype).at[ib.reshape(-1)].add(yb.reshape(-1, d)))(y, idx)


def setup_inputs(seed: int = 0) -> dict:
    key = jax.random.key(seed)
    keys = iter(jax.random.split(key, 48))
    L, D = DEPTH, D_MODEL
    G, P = S5_GROUPS, S5_STATE

    def nrm(shape, std):
        return std * jax.random.normal(next(keys), shape, F32)

    s5_n = jnp.arange(P, dtype=F32)
    ret_h = jnp.arange(RET_HEADS, dtype=F32)
    ret_decay0 = jnp.log(-jnp.log(1.0 - 2.0 ** (-5.0 - ret_h)))
    dt_lo, dt_hi = math.log(1e-3), math.log(1e-1)
    qk_mla = MLA_NOPE_DIM + MLA_ROPE_DIM
    return {
        'x': nrm((BATCH, SEQ, D), 1.0),
        'c': nrm((BATCH, D), 1.0),
        'ctx': nrm((BATCH, CTX_LEN, D), 1.0),
        'c_ctx': nrm((D,), 1.0),
        'ada_w': nrm((L, D, 6 * D), D ** -0.5),
        'ada_b': nrm((L, 6 * D), 0.02),
        'w_in': nrm((L, D, IN_TOTAL), D ** -0.5),
        's5_a_re_f': -0.5 + nrm((L, G, P), 0.01),
        's5_a_im_f': jnp.pi * s5_n + nrm((L, G, P), 0.01),
        's5_log_dt_f': jax.random.uniform(next(keys), (L, G), F32, dt_lo, dt_hi),
        's5_a_re_b': -0.5 + nrm((L, G, P), 0.01),
        's5_a_im_b': jnp.pi * s5_n + nrm((L, G, P), 0.01),
        's5_log_dt_b': jax.random.uniform(next(keys), (L, G), F32, dt_lo, dt_hi),
        's5_b_re': nrm((L, G, P, S5_GROUP_CH), (2 * S5_GROUP_CH) ** -0.5),
        's5_b_im': nrm((L, G, P, S5_GROUP_CH), (2 * S5_GROUP_CH) ** -0.5),
        's5_c_re': nrm((L, G, S5_GROUP_CH, P), P ** -0.5),
        's5_c_im': nrm((L, G, S5_GROUP_CH, P), P ** -0.5),
        's5_d': nrm((L, BRANCH_W), 1.0),
        's5_w_glu': nrm((L, BRANCH_W, BRANCH_W), BRANCH_W ** -0.5),
        'gqa_q_norm': 1.0 + nrm((L, GQA_HEAD_DIM), 0.02),
        'gqa_k_norm': 1.0 + nrm((L, GQA_HEAD_DIM), 0.02),
        'ret_decay_f': ret_decay0 + nrm((L, RET_HEADS), 0.05),
        'ret_decay_b': ret_decay0 + nrm((L, RET_HEADS), 0.05),
        'ret_norm': 1.0 + nrm((L, RET_HEADS * RET_V_DIM), 0.02),
        'mla_q_norm': 1.0 + nrm((L, MLA_Q_LORA), 0.02),
        'mla_kv_norm': 1.0 + nrm((L, MLA_KV_LORA), 0.02),
        'mla_w_uq': nrm((L, MLA_Q_LORA, MLA_HEADS * qk_mla), MLA_Q_LORA ** -0.5),
        'mla_w_ukv': nrm((L, MLA_KV_LORA, MLA_HEADS * (MLA_NOPE_DIM + MLA_V_DIM)), MLA_KV_LORA ** -0.5),
        'w_branch': nrm((L, N_BRANCH, BRANCH_W, D), BRANCH_W ** -0.5),
        'w_gate': nrm((L, D, N_BRANCH * D), D ** -0.5),
        'b_gate': nrm((L, N_BRANCH * D), 0.02),
        'w_out': nrm((L, D, D), DEEPNORM_BETA * D ** -0.5),
        'ln1_g': 1.0 + nrm((L, D), 0.02),
        'ln1_b': nrm((L, D), 0.02),
        'router_w': nrm((L, D, N_EXPERTS), D ** -0.5),
        'moe_w_gate': nrm((L, N_EXPERTS, D, EXPERT_FF), D ** -0.5),
        'moe_w_up': nrm((L, N_EXPERTS, D, EXPERT_FF), D ** -0.5),
        'moe_w_down': nrm((L, N_EXPERTS, EXPERT_FF, D), DEEPNORM_BETA * EXPERT_FF ** -0.5),
        'ln2_g': 1.0 + nrm((L, D), 0.02),
        'ln2_b': nrm((L, D), 0.02),
    }


def reference(x, c, ctx, c_ctx, ada_w, ada_b, w_in,
              s5_a_re_f, s5_a_im_f, s5_log_dt_f, s5_a_re_b, s5_a_im_b, s5_log_dt_b,
              s5_b_re, s5_b_im, s5_c_re, s5_c_im, s5_d, s5_w_glu,
              gqa_q_norm, gqa_k_norm, ret_decay_f, ret_decay_b, ret_norm,
              mla_q_norm, mla_kv_norm, mla_w_uq, mla_w_ukv,
              w_branch, w_gate, b_gate, w_out, ln1_g, ln1_b,
              router_w, moe_w_gate, moe_w_up, moe_w_down, ln2_g, ln2_b):
    n_lat = x.shape[1]
    rows = n_lat // GRID_W
    row = jnp.repeat(jnp.arange(rows, dtype=jnp.int32), GRID_W)
    col = jnp.tile(jnp.arange(GRID_W, dtype=jnp.int32), rows)
    cx = ctx
    for l in range(DEPTH):
        need_ctx = l < DEPTH - 1
        lp = {
            'w_in': w_in[l],
            's5_a_re_f': s5_a_re_f[l], 's5_a_im_f': s5_a_im_f[l], 's5_log_dt_f': s5_log_dt_f[l],
            's5_a_re_b': s5_a_re_b[l], 's5_a_im_b': s5_a_im_b[l], 's5_log_dt_b': s5_log_dt_b[l],
            's5_b_re': s5_b_re[l], 's5_b_im': s5_b_im[l], 's5_c_re': s5_c_re[l], 's5_c_im': s5_c_im[l],
            's5_d': s5_d[l], 's5_w_glu': s5_w_glu[l],
            'gqa_q_norm': gqa_q_norm[l], 'gqa_k_norm': gqa_k_norm[l],
            'ret_decay_f': ret_decay_f[l], 'ret_decay_b': ret_decay_b[l], 'ret_norm': ret_norm[l],
            'mla_q_norm': mla_q_norm[l], 'mla_kv_norm': mla_kv_norm[l],
            'mla_w_uq': mla_w_uq[l], 'mla_w_ukv': mla_w_ukv[l],
            'w_branch': w_branch[l], 'w_gate': w_gate[l], 'b_gate': b_gate[l], 'w_out': w_out[l],
            'router_w': router_w[l], 'moe_w_gate': moe_w_gate[l], 'moe_w_up': moe_w_up[l],
            'moe_w_down': moe_w_down[l],
        }
        mod = jax.nn.silu(c) @ ada_w[l] + ada_b[l]
        mod_c = jax.nn.silu(c_ctx) @ ada_w[l] + ada_b[l]
        sh1, sc1, g1, sh2, sc2, g2 = jnp.split(mod[:, None, :], 6, axis=-1)
        shc1, scc1, gc1, shc2, scc2, gc2 = jnp.split(mod_c, 6)
        h = modulate(x, sh1, sc1)
        hc = modulate(cx, shc1, scc1)
        y, yc = token_mixer(h, hc, row, col, lp, need_ctx)
        x = layer_norm(DEEPNORM_ALPHA * x + g1 * y, ln1_g[l], ln1_b[l])
        h = modulate(x, sh2, sc2)
        x = layer_norm(DEEPNORM_ALPHA * x + g2 * expert_choice_ffn(h, lp), ln2_g[l], ln2_b[l])
        if need_ctx:
            cx = layer_norm(DEEPNORM_ALPHA * cx + gc1 * yc, ln1_g[l], ln1_b[l])
            hc = modulate(cx, shc2, scc2)
            cx = layer_norm(DEEPNORM_ALPHA * cx + gc2 * expert_choice_ffn(hc, lp), ln2_g[l], ln2_b[l])
    return x
```

```cpp
#ifdef CPU_TEST
#include <cmath>
#include <cstdio>
#include <cstdlib>
#include <cstring>
#include <cstdint>
#include <functional>
#define __global__
#define __device__
#define __host__
#define __forceinline__ inline
#define __launch_bounds__(...)
#define __restrict__
struct dim3s { int x, y, z; };
static thread_local dim3s blockIdx, threadIdx, blockDim, gridDim;
typedef void* hipStream_t;
template <class F> static void cpu_launch(int grid, int block, F f) {
#pragma omp parallel for schedule(dynamic, 1)
  for (int b = 0; b < grid; ++b) {
    gridDim.x = grid; blockDim.x = block; blockIdx.x = b;
    for (int t = 0; t < block; ++t) { threadIdx.x = t; f(); }
  }
}
#define LAUNCH(kern, grid, block, ...) cpu_launch((grid), (block), [&]() { kern(__VA_ARGS__); })
static inline void hipMemsetAsync(void* p, int v, size_t n, hipStream_t) { memset(p, v, n); }
#else
#include <hip/hip_runtime.h>
#include <cstdio>
#include <cstdint>
#include <cstring>
#define LAUNCH(kern, grid, block, ...) hipLaunchKernelGGL(kern, dim3(grid), dim3(block), 0, stream, __VA_ARGS__)
#endif

typedef unsigned short bf16_t;

#ifndef CFG_DM
#define CFG_DM 2048
#define CFG_SEQ 4096
#define CFG_GRIDW 64
#define CFG_CTX 256
#define CFG_S5P 64
#define CFG_GHD 128
#define CFG_RCHUNK 128
#define CFG_MNOPE 128
#define CFG_MROPE 64
#define CFG_NE 16
#endif
constexpr int DM = CFG_DM, NB = 2, SEQ = CFG_SEQ, GRIDW = CFG_GRIDW, CTXL = CFG_CTX, NLAYER = 2;
constexpr int BW = DM / 4, S5CH = 16, S5G = BW / S5CH, S5P = CFG_S5P;
constexpr int GHD = CFG_GHD, GH = BW / GHD, GKV = GH / 2;
constexpr int RH = 4, RV = BW / RH, RQK = RV / 2;
constexpr int MQL = BW, MKVL = BW / 2, MH = 4, MNOPE = CFG_MNOPE, MROPE = CFG_MROPE, MV = BW / MH, MQK = MNOPE + MROPE;
constexpr int NE = CFG_NE, FF = DM / 2;
constexpr int NTOK = SEQ + CTXL, MROWS = NB * NTOK;
constexpr int OFF_U = 0, OFF_GQ = BW, OFF_GK = OFF_GQ + GH * GHD, OFF_GV = OFF_GK + GKV * GHD, OFF_RQ = OFF_GV + GKV * GHD, OFF_RK = OFF_RQ + RH * RQK,
              OFF_RV = OFF_RK + RH * RQK, OFF_RG = OFF_RV + RH * RV, OFF_CQ = OFF_RG + RH * RV, OFF_CKV = OFF_CQ + MQL, OFF_KR = OFF_CKV + MKVL, IN_TOTAL = OFF_KR + MROPE;
constexpr int PW = (IN_TOTAL + 255) / 256 * 256;
constexpr int CAP_L = 2 * SEQ / NE, CAP_C = 2 * CTXL / NE;
constexpr int XE = 2 * CAP_L + 2 * CAP_C, XEP = (XE + 255) / 256 * 256;
constexpr int XROWS = NE * XEP;
constexpr int NROPE_A = GHD / 4, NROPE_B = RQK / 4;
static_assert(MROPE / 4 == NROPE_B, "rope tables");
static_assert(MNOPE == MV, "kv split");
constexpr float NORM_EPS = 1e-6f;
constexpr float DN_ALPHA = 1.4142135623730951f;

enum { I_X = 0, I_C, I_CTX, I_CCTX, I_ADAW, I_ADAB, I_WIN, I_S5AREF, I_S5AIMF, I_S5DTF, I_S5AREB, I_S5AIMB, I_S5DTB, I_S5BRE, I_S5BIM, I_S5CRE, I_S5CIM, I_S5D, I_S5GLU,
       I_GQN, I_GKN, I_RDF, I_RDB, I_RNORM, I_MQN, I_MKVN, I_WUQ, I_WUKV, I_WBR, I_WGATE, I_BGATE, I_WOUT, I_LN1G, I_LN1B, I_ROUTER, I_MOEG, I_MOEU, I_MOED, I_LN2G, I_LN2B, N_IN };

constexpr size_t al256(size_t x) { return (x + 255) / 256 * 256; }
struct WsLayout {
  size_t bar, mod, rope_a, rope_b, s5tab, wt_in, wt_gate, wt_br, wt_out, wt_glu, wt_uq, wt_ukv, wt_gu, wt_dn;
  size_t x1, x2, h1, h2, regA  , qm, km, vm, z, oall, macc  , merged, aff, slot, gatev, xsrc, retst, s5st, end;
};
constexpr size_t SZ_P = (size_t)MROWS * PW * 2, SZ_PROJ = (size_t)MROWS * 4 * DM * 2;
constexpr size_t SZ_XS = (size_t)XROWS * DM * 2, SZ_ACT = (size_t)XROWS * FF * 2, SZ_YS = (size_t)XROWS * DM * 2;
constexpr size_t SZ_HS = (size_t)MROWS * S5G * S5P * 2 * 4;
constexpr size_t cmax(size_t a, size_t b) { return a > b ? a : b; }
constexpr WsLayout make_ws() {
  WsLayout w{}; size_t o = 0;
  w.bar = o; o += al256(16384);
  w.mod = o; o += al256((size_t)NLAYER * 3 * 6 * DM * 4);
  w.rope_a = o; o += al256((size_t)GRIDW * NROPE_A * 2 * 4);
  w.rope_b = o; o += al256((size_t)GRIDW * NROPE_B * 2 * 4);
  w.s5tab = o; o += al256((size_t)NLAYER * 2 * S5G * S5P * (2 + 2 * S5CH) * 4);
  w.wt_in = o; o += al256((size_t)NLAYER * PW * DM * 2);
  w.wt_gate = o; o += al256((size_t)NLAYER * 4 * DM * DM * 2);
  w.wt_br = o; o += al256((size_t)NLAYER * 4 * DM * BW * 2);
  w.wt_out = o; o += al256((size_t)NLAYER * DM * DM * 2);
  w.wt_glu = o; o += al256((size_t)NLAYER * BW * BW * 2);
  w.wt_uq = o; o += al256((size_t)NLAYER * MH * MQK * MQL * 2);
  w.wt_ukv = o; o += al256((size_t)NLAYER * MH * (MNOPE + MV) * MKVL * 2);
  w.wt_gu = o; o += al256((size_t)NLAYER * NE * 2 * FF * DM * 2);
  w.wt_dn = o; o += al256((size_t)NLAYER * NE * DM * FF * 2);
  w.x1 = o; o += al256((size_t)MROWS * DM * 4);
  w.x2 = o; o += al256((size_t)MROWS * DM * 4);
  w.h1 = o; o += al256((size_t)MROWS * DM * 2);
  w.h2 = o; o += al256((size_t)MROWS * DM * 2);
  w.regA = o; o += al256(cmax(cmax(SZ_P + SZ_PROJ, SZ_XS + SZ_ACT + SZ_YS), SZ_P + SZ_HS));
  w.qm = o; o += al256((size_t)MROWS * MH * MQK * 2);
  w.km = o; o += al256((size_t)MROWS * MH * MQK * 2);
  w.vm = o; o += al256((size_t)MROWS * MH * MV * 2);
  w.z = o; o += al256((size_t)MROWS * BW * 2);
  w.oall = o; o += al256((size_t)MROWS * DM * 2);
  w.macc = o; o += al256((size_t)MROWS * DM * 4);
  w.merged = o; o += al256((size_t)MROWS * DM * 2);
  w.aff = o; o += al256((size_t)MROWS * NE * 4);
  w.slot = o; o += al256((size_t)MROWS * NE * 4);
  w.gatev = o; o += al256((size_t)XROWS * 4);
  w.xsrc = o; o += al256((size_t)XROWS * 4);
  w.retst = o; o += al256((size_t)NB * RH * 2 * RQK * RV * 4);
  w.s5st = o; o += al256((size_t)NB * 2 * S5G * S5P * 2 * 4);
  w.end = o; return w;
}
constexpr WsLayout WS = make_ws();

struct Params {
  const float* in[N_IN];
  float* out;
  char* ws;
};

__host__ __device__ __forceinline__ float bf2f(bf16_t b) { union { unsigned u; float f; } c; c.u = ((unsigned)b) << 16; return c.f; }
__host__ __device__ __forceinline__ bf16_t f2bf(float f) { union { unsigned u; float f; } c; c.f = f; unsigned u = c.u; u += 0x7FFFu + ((u >> 16) & 1u); return (bf16_t)(u >> 16); }
__host__ __device__ __forceinline__ float sigmoidf_(float x) { return 1.f / (1.f + expf(-x)); }
__host__ __device__ __forceinline__ float siluf_(float x) { return x / (1.f + expf(-x)); }
__host__ __device__ __forceinline__ float gelu_tanh(float x) { return 0.5f * x * (1.f + tanhf(0.7978845608028654f * (x + 0.044715f * x * x * x))); }
__host__ __device__ __forceinline__ int row_b(int R) { return R / NTOK; }
__host__ __device__ __forceinline__ int row_t(int R) { return R % NTOK; }
__host__ __device__ __forceinline__ bool row_is_ctx(int R) { return (R % NTOK) >= SEQ; }
__host__ __device__ __forceinline__ int row_mod(int R) { return row_is_ctx(R) ? 2 : row_b(R); }
#define GSTRIDE(i, n) for (long i = (long)blockIdx.x * blockDim.x + threadIdx.x; i < (long)(n); i += (long)gridDim.x * blockDim.x)
#define WSP(T, p, field) ((T*)((p).ws + WS.field))

__global__ void nk_conv_t(bf16_t* dst, const float* src, int K, int N, int ldsrc, int Ndst) {
  GSTRIDE(i, (long)Ndst * K) { int n = (int)(i / K), k = (int)(i % K); dst[i] = n < N ? f2bf(src[(long)k * ldsrc + n]) : (bf16_t)0; }
}
__global__ void nk_conv_gu(bf16_t* dst, const float* wg, const float* wu) {
  GSTRIDE(i, (long)2 * FF * DM) { int j = (int)(i / DM), k = (int)(i % DM); int tile = j / 256, r = j % 256, f = tile * 128 + (r & 127);
    const float* s = (r < 128) ? wg : wu; dst[i] = f2bf(s[(long)k * FF + f]); }
}
__global__ void nk_mod(Params p) {
  float* mod = WSP(float, p, mod);
  GSTRIDE(i, (long)NLAYER * 3 * 6 * DM) { int j = (int)(i % (6 * DM)), r = (int)((i / (6 * DM)) % 3), l = (int)(i / (18 * DM));
    const float* cv = (r < 2) ? p.in[I_C] + (long)r * DM : p.in[I_CCTX]; const float* w = p.in[I_ADAW] + (long)l * DM * 6 * DM;
    float acc = 0.f; for (int k = 0; k < DM; ++k) acc += siluf_(cv[k]) * w[(long)k * 6 * DM + j];
    mod[i] = acc + p.in[I_ADAB][(long)l * 6 * DM + j]; }
}
__global__ void nk_rope_tab(Params p) {
  float* ta = WSP(float, p, rope_a); float* tb = WSP(float, p, rope_b);
  GSTRIDE(i, (long)GRIDW * (NROPE_A + NROPE_B)) { int pos = (int)(i / (NROPE_A + NROPE_B)), k = (int)(i % (NROPE_A + NROPE_B));
    if (k < NROPE_A) { float inv = powf(10000.f, -(float)k / NROPE_A), a = pos * inv; ta[(pos * NROPE_A + k) * 2] = cosf(a); ta[(pos * NROPE_A + k) * 2 + 1] = sinf(a); }
    else { int kk = k - NROPE_A; float inv = powf(10000.f, -(float)kk / NROPE_B), a = pos * inv; tb[(pos * NROPE_B + kk) * 2] = cosf(a); tb[(pos * NROPE_B + kk) * 2 + 1] = sinf(a); } }
}
constexpr int S5TW = 2 + 2 * S5CH;
__global__ void nk_s5tab(Params p) {
  float* tab = WSP(float, p, s5tab);
  GSTRIDE(i, (long)NLAYER * 2 * S5G * S5P) { int pp = (int)(i % S5P), g = (int)((i / S5P) % S5G), dir = (int)((i / (S5P * S5G)) % 2), l = (int)(i / (2 * S5P * S5G));
    const float a_re = p.in[dir ? I_S5AREB : I_S5AREF][(l * S5G + g) * S5P + pp], a_im = p.in[dir ? I_S5AIMB : I_S5AIMF][(l * S5G + g) * S5P + pp];
    const float dt = expf(p.in[dir ? I_S5DTB : I_S5DTF][l * S5G + g]);
    const float mag = expf(a_re * dt), ab_re = mag * cosf(a_im * dt), ab_im = mag * sinf(a_im * dt);
    const float den = a_re * a_re + a_im * a_im, nr = ab_re - 1.f, ni = ab_im;
    const float cr = (nr * a_re + ni * a_im) / den, ci = (ni * a_re - nr * a_im) / den;
    float* t = tab + i * S5TW; t[0] = ab_re; t[1] = ab_im;
    for (int c = 0; c < S5CH; ++c) { const float br = p.in[I_S5BRE][((l * S5G + g) * S5P + pp) * S5CH + c], bi = p.in[I_S5BIM][((l * S5G + g) * S5P + pp) * S5CH + c];
      t[2 + c] = cr * br - ci * bi; t[2 + S5CH + c] = cr * bi + ci * br; } }
}
__global__ void nk_load_x(Params p) {
  float* X2 = WSP(float, p, x2);
  GSTRIDE(i, (long)MROWS * DM) { int R = (int)(i / DM), d = (int)(i % DM), b = row_b(R), t = row_t(R);
    X2[i] = t < SEQ ? p.in[I_X][((long)b * SEQ + t) * DM + d] : p.in[I_CTX][((long)b * CTXL + (t - SEQ)) * DM + d]; }
}
__global__ void nk_ln_mod(Params p, bf16_t* H, const float* X, int l, int ch_sh, int ch_sc) {
  const float* mod = WSP(float, p, mod) + (long)l * 3 * 6 * DM;
  GSTRIDE(R, MROWS) { const float* x = X + R * DM; float s = 0.f; for (int d = 0; d < DM; ++d) s += x[d]; const float mean = s / DM;
    float v = 0.f; for (int d = 0; d < DM; ++d) { float c = x[d] - mean; v += c * c; } const float rs = 1.f / sqrtf(v / DM + NORM_EPS);
    const float* m = mod + (long)row_mod((int)R) * 6 * DM;
    for (int d = 0; d < DM; ++d) H[R * DM + d] = f2bf((x[d] - mean) * rs * (1.f + m[ch_sc * DM + d]) + m[ch_sh * DM + d]); }
}
template <class Epi> __global__ void nk_gemm(const bf16_t* A, long lda, const bf16_t* Bt, long ldb, int M, int N, int K, Epi epi) {
  GSTRIDE(i, (long)M * (N / 4)) { int m = (int)(i / (N / 4)), n = (int)(i % (N / 4)) * 4; float a0 = 0.f, a1 = 0.f, a2 = 0.f, a3 = 0.f;
    const bf16_t* ar = A + (long)m * lda; const bf16_t* b0 = Bt + (long)n * ldb;
    for (int k = 0; k < K; ++k) { const float a = bf2f(ar[k]); a0 += a * bf2f(b0[k]); a1 += a * bf2f(b0[ldb + k]); a2 += a * bf2f(b0[2 * ldb + k]); a3 += a * bf2f(b0[3 * ldb + k]); }
    epi(m, n, a0, a1, a2, a3); }
}
struct EpStoreBf16 { bf16_t* C; long ldc; __host__ __device__ void operator()(int m, int n, float a0, float a1, float a2, float a3) const {
  bf16_t* c = C + (long)m * ldc + n; c[0] = f2bf(a0); c[1] = f2bf(a1); c[2] = f2bf(a2); c[3] = f2bf(a3); } };
struct EpStoreF32 { float* C; long ldc; __host__ __device__ void operator()(int m, int n, float a0, float a1, float a2, float a3) const {
  float* c = C + (long)m * ldc + n; c[0] = a0; c[1] = a1; c[2] = a2; c[3] = a3; } };
struct EpKV { bf16_t* KM; bf16_t* VM; __host__ __device__ void operator()(int m, int n, float a0, float a1, float a2, float a3) const {
  const int h = n / (MNOPE + MV), r = n % (MNOPE + MV);
  bf16_t* c = (r < MNOPE) ? KM + (long)m * MH * MQK + h * MQK + r : VM + (long)m * MH * MV + h * MV + (r - MNOPE);
  c[0] = f2bf(a0); c[1] = f2bf(a1); c[2] = f2bf(a2); c[3] = f2bf(a3); } };
struct EpGlu { const bf16_t* Z; bf16_t* O; __host__ __device__ void operator()(int m, int n, float a0, float a1, float a2, float a3) const {
  const bf16_t* z = Z + (long)m * BW + n; bf16_t* o = O + (long)m * DM + n;
  o[0] = f2bf(bf2f(z[0]) * sigmoidf_(a0)); o[1] = f2bf(bf2f(z[1]) * sigmoidf_(a1)); o[2] = f2bf(bf2f(z[2]) * sigmoidf_(a2)); o[3] = f2bf(bf2f(z[3]) * sigmoidf_(a3)); } };
struct EpDown { const float* gate; bf16_t* Y; __host__ __device__ void operator()(int m, int n, float a0, float a1, float a2, float a3) const {
  const float g = gate[m]; bf16_t* y = Y + (long)m * DM + n; y[0] = f2bf(a0 * g); y[1] = f2bf(a1 * g); y[2] = f2bf(a2 * g); y[3] = f2bf(a3 * g); } };

__device__ __forceinline__ void rope_pair(bf16_t* x, int i1, int i2, float sc1, float sc2, bool rot, const float* cs) {
  const float c = rot ? cs[0] : 1.f, s = rot ? cs[1] : 0.f; const float a = bf2f(x[i1]) * sc1, b = bf2f(x[i2]) * sc2; x[i1] = f2bf(a * c - b * s); x[i2] = f2bf(a * s + b * c);
}
__global__ void nk_post_proj(Params p, int l) {
  bf16_t* P = WSP(bf16_t, p, regA); const float* ta = WSP(float, p, rope_a); const float* tb = WSP(float, p, rope_b);
  constexpr int NJ = GH + GKV + 2 * RH + 3;
  GSTRIDE(i, (long)MROWS * NJ) { const int R = (int)(i / NJ), j = (int)(i % NJ), t = row_t(R); const bool lat = t < SEQ; const int gr = lat ? t / GRIDW : 0, gc = lat ? t % GRIDW : 0;
    bf16_t* pr = P + (long)R * PW;
    if (j < GH + GKV) {
      bf16_t* x = pr + (j < GH ? OFF_GQ + j * GHD : OFF_GK + (j - GH) * GHD); const float* g = p.in[j < GH ? I_GQN : I_GKN] + l * GHD;
      float ss = 0.f; for (int d = 0; d < GHD; ++d) { float v = bf2f(x[d]); ss += v * v; } const float r = 1.f / sqrtf(ss / GHD + NORM_EPS);
      for (int hf = 0; hf < 2; ++hf) for (int k = 0; k < NROPE_A; ++k) { const int i1 = hf * 2 * NROPE_A + k, i2 = i1 + NROPE_A;
        rope_pair(x, i1, i2, r * g[i1], r * g[i2], lat, ta + ((hf ? gc : gr) * NROPE_A + k) * 2); }
    } else if (j < GH + GKV + 2 * RH) {
      const int jj = j - GH - GKV; const bool isk = jj >= RH; bf16_t* x = pr + (isk ? OFF_RK + (jj - RH) * RQK : OFF_RQ + jj * RQK); const float sc = isk ? 1.f / sqrtf((float)RQK) : 1.f;
      for (int hf = 0; hf < 2; ++hf) for (int k = 0; k < NROPE_B; ++k) { const int i1 = hf * 2 * NROPE_B + k, i2 = i1 + NROPE_B;
        rope_pair(x, i1, i2, sc, sc, lat, tb + ((hf ? gc : gr) * NROPE_B + k) * 2); }
    } else if (j == GH + GKV + 2 * RH) {
      bf16_t* x = pr + OFF_CQ; const float* g = p.in[I_MQN] + l * MQL; float ss = 0.f; for (int d = 0; d < MQL; ++d) { float v = bf2f(x[d]); ss += v * v; }
      const float r = 1.f / sqrtf(ss / MQL + NORM_EPS); for (int d = 0; d < MQL; ++d) x[d] = f2bf(bf2f(x[d]) * r * g[d]);
    } else if (j == GH + GKV + 2 * RH + 1) {
      bf16_t* x = pr + OFF_CKV; const float* g = p.in[I_MKVN] + l * MKVL; float ss = 0.f; for (int d = 0; d < MKVL; ++d) { float v = bf2f(x[d]); ss += v * v; }
      const float r = 1.f / sqrtf(ss / MKVL + NORM_EPS); for (int d = 0; d < MKVL; ++d) x[d] = f2bf(bf2f(x[d]) * r * g[d]);
    } else if (lat) {
      bf16_t* x = pr + OFF_KR;
      for (int hf = 0; hf < 2; ++hf) for (int k = 0; k < NROPE_B; ++k) { const int i1 = hf * 2 * NROPE_B + k, i2 = i1 + NROPE_B; rope_pair(x, i1, i2, 1.f, 1.f, true, tb + ((hf ? gc : gr) * NROPE_B + k) * 2); }
    } }
}
__global__ void nk_post_mla(Params p) {
  bf16_t* P = WSP(bf16_t, p, regA); bf16_t* QM = WSP(bf16_t, p, qm); bf16_t* KM = WSP(bf16_t, p, km); const float* tb = WSP(float, p, rope_b);
  GSTRIDE(i, (long)MROWS * MH) { const int R = (int)(i / MH), h = (int)(i % MH), t = row_t(R); const bool lat = t < SEQ;
    if (lat) { const int gr = t / GRIDW, gc = t % GRIDW; bf16_t* x = QM + (long)R * MH * MQK + h * MQK + MNOPE;
      for (int hf = 0; hf < 2; ++hf) for (int k = 0; k < NROPE_B; ++k) { const int i1 = hf * 2 * NROPE_B + k, i2 = i1 + NROPE_B; rope_pair(x, i1, i2, 1.f, 1.f, true, tb + ((hf ? gc : gr) * NROPE_B + k) * 2); } }
    for (int d = 0; d < MROPE; ++d) KM[(long)R * MH * MQK + h * MQK + MNOPE + d] = P[(long)R * PW + OFF_KR + d]; }
}
__global__ void nk_s5_scan(Params p, int l) {
  const bf16_t* P = WSP(bf16_t, p, regA); float* HS = (float*)(p.ws + WS.regA + SZ_P); const float* tab = WSP(float, p, s5tab);
  GSTRIDE(i, (long)NB * S5G * S5P) { const int pp = (int)(i % S5P), g = (int)((i / S5P) % S5G), b = (int)(i / (S5P * S5G));
    for (int dir = 0; dir < 2; ++dir) { const float* t = tab + ((((long)l * 2 + dir) * S5G + g) * S5P + pp) * S5TW; const float are = t[0], aim = t[1]; float hr = 0.f, hi = 0.f;
      for (int s = 0; s < NTOK; ++s) {
        int tt; if (!dir) tt = s < CTXL ? SEQ + s : s - CTXL; else tt = s < CTXL ? SEQ + (CTXL - 1 - s) : SEQ - 1 - (s - CTXL);
        const long R = (long)b * NTOK + tt; const bf16_t* u = P + R * PW + OFF_U + g * S5CH; float br = 0.f, bi = 0.f;
        for (int c = 0; c < S5CH; ++c) { const float uv = bf2f(u[c]); br += uv * t[2 + c]; bi += uv * t[2 + S5CH + c]; }
        const float nr = are * hr - aim * hi + br, ni = are * hi + aim * hr + bi; hr = nr; hi = ni;
        float* hs = HS + ((R * S5G + g) * S5P + pp) * 2; if (!dir) { hs[0] = hr; hs[1] = hi; } else { hs[0] += hr; hs[1] += hi; } } } }
}
__global__ void nk_s5_read(Params p, int l) {
  const bf16_t* P = WSP(bf16_t, p, regA); const float* HS = (const float*)(p.ws + WS.regA + SZ_P); bf16_t* Z = WSP(bf16_t, p, z);
  GSTRIDE(i, (long)MROWS * BW) { const long R = i / BW; const int c = (int)(i % BW), g = c / S5CH, ci = c % S5CH;
    const float* hs = HS + (R * S5G + g) * S5P * 2; const float* cre = p.in[I_S5CRE] + (((long)l * S5G + g) * S5CH + ci) * S5P; const float* cim = p.in[I_S5CIM] + (((long)l * S5G + g) * S5CH + ci) * S5P;
    float y = 0.f; for (int pp = 0; pp < S5P; ++pp) y += hs[2 * pp] * cre[pp] - hs[2 * pp + 1] * cim[pp];
    y += p.in[I_S5D][l * BW + c] * bf2f(P[R * PW + OFF_U + c]); Z[i] = f2bf(gelu_tanh(y)); }
}
template <int DQK, int DV> __global__ void __launch_bounds__(256) nk_attn(const bf16_t* Q, const bf16_t* K, const bf16_t* V, bf16_t* O, int ldq, int ldk, int ldv, int ldo, int H, int group, float scale) {
  GSTRIDE(i, (long)MROWS * H) { const int R = (int)(i / H), h = (int)(i % H), b = row_b(R), kh = h / group; const bool lat = !row_is_ctx(R);
    const bf16_t* q = Q + (long)R * ldq + h * DQK; float o[DV]; _Pragma("unroll") for (int d = 0; d < DV; ++d) o[d] = 0.f; float m = -1e30f, lsum = 0.f;
    for (int kk = lat ? 0 : SEQ; kk < NTOK; ++kk) { const long KR = (long)b * NTOK + kk; const bf16_t* kp = K + KR * ldk + kh * DQK; float s = 0.f;
      for (int d = 0; d < DQK; ++d) s += bf2f(q[d]) * bf2f(kp[d]); s *= scale;
      if (s > m) { const float corr = expf(m - s); lsum *= corr; _Pragma("unroll") for (int d = 0; d < DV; ++d) o[d] *= corr; m = s; }
      const float pw = expf(s - m); lsum += pw; const bf16_t* vp = V + KR * ldv + kh * DV; _Pragma("unroll") for (int d = 0; d < DV; ++d) o[d] += pw * bf2f(vp[d]); }
    const float inv = 1.f / lsum; _Pragma("unroll") for (int d = 0; d < DV; ++d) O[(long)R * ldo + h * DV + d] = f2bf(o[d] * inv); }
}
__global__ void __launch_bounds__(256) nk_ret(Params p, int l) {
  const bf16_t* P = WSP(bf16_t, p, regA); bf16_t* O = WSP(bf16_t, p, oall);
  GSTRIDE(i, (long)MROWS * RH) { const int R = (int)(i / RH), h = (int)(i % RH), b = row_b(R), t = row_t(R); const bool lat = t < SEQ;
    const float lgf = -expf(p.in[I_RDF][l * RH + h]), lgb = -expf(p.in[I_RDB][l * RH + h]);
    const bf16_t* q = P + (long)R * PW + OFF_RQ + h * RQK; float o[RV]; _Pragma("unroll") for (int d = 0; d < RV; ++d) o[d] = 0.f;
    for (int kk = lat ? 0 : SEQ; kk < NTOK; ++kk) { float w;
      if (lat) { if (kk < SEQ) w = kk <= t ? expf(lgf * (float)(t - kk)) : expf(lgb * (float)(kk - t)); else { const int j = kk - SEQ; w = expf(lgf * (float)(t + CTXL - j)) + expf(lgb * (float)(SEQ - t + j)); } }
      else { const int j = t - SEQ, j2 = kk - SEQ; w = j2 <= j ? expf(lgf * (float)(j - j2)) : expf(lgb * (float)(j2 - j)); }
      const long KR = (long)b * NTOK + kk; const bf16_t* kp = P + KR * PW + OFF_RK + h * RQK; float s = 0.f; for (int d = 0; d < RQK; ++d) s += bf2f(q[d]) * bf2f(kp[d]); s *= w;
      const bf16_t* vp = P + KR * PW + OFF_RV + h * RV; _Pragma("unroll") for (int d = 0; d < RV; ++d) o[d] += s * bf2f(vp[d]); }
    float mean = 0.f; _Pragma("unroll") for (int d = 0; d < RV; ++d) mean += o[d]; mean /= RV; float var = 0.f; _Pragma("unroll") for (int d = 0; d < RV; ++d) { const float c = o[d] - mean; var += c * c; }
    const float rs = 1.f / sqrtf(var / RV + NORM_EPS); const bf16_t* gp = P + (long)R * PW + OFF_RG + h * RV; const float* gain = p.in[I_RNORM] + l * BW + h * RV;
    _Pragma("unroll") for (int d = 0; d < RV; ++d) O[(long)R * DM + 2 * BW + h * RV + d] = f2bf((o[d] - mean) * rs * gain[d] * siluf_(bf2f(gp[d]))); }
}
__global__ void nk_gate_merge(Params p, int l) {
  const bf16_t* H = WSP(bf16_t, p, h1); const bf16_t* Wg = WSP(bf16_t, p, wt_gate) + (long)l * 4 * DM * DM; const bf16_t* PROJ = (const bf16_t*)(p.ws + WS.regA + SZ_P); bf16_t* MG = WSP(bf16_t, p, merged);
  const float* bg = p.in[I_BGATE] + (long)l * 4 * DM;
  GSTRIDE(i, (long)MROWS * DM) { const long R = i / DM; const int d = (int)(i % DM); const bf16_t* hr = H + R * DM; float acc = 0.f;
    for (int k = 0; k < 4; ++k) { const bf16_t* w = Wg + ((long)k * DM + d) * DM; float s = 0.f; for (int c = 0; c < DM; ++c) s += bf2f(hr[c]) * bf2f(w[c]);
      acc += sigmoidf_(s + bg[k * DM + d]) * bf2f(PROJ[R * 4 * DM + k * DM + d]); }
    MG[i] = f2bf(acc); }
}
__global__ void nk_ln1(Params p, int l) {
  const float* X2 = WSP(float, p, x2); const float* Y = WSP(float, p, macc); float* X1 = WSP(float, p, x1); bf16_t* H2 = WSP(bf16_t, p, h2); float* AFF = WSP(float, p, aff);
  const float* mod = WSP(float, p, mod) + (long)l * 3 * 6 * DM; const float* lg = p.in[I_LN1G] + l * DM; const float* lb = p.in[I_LN1B] + l * DM; const float* rw = p.in[I_ROUTER] + (long)l * DM * NE;
  GSTRIDE(R, MROWS) { const float* m = mod + (long)row_mod((int)R) * 6 * DM; const float* x = X2 + R * DM; const float* y = Y + R * DM; float* x1 = X1 + R * DM;
    float s = 0.f; for (int d = 0; d < DM; ++d) { const float v = DN_ALPHA * x[d] + m[2 * DM + d] * y[d]; x1[d] = v; s += v; } float mean = s / DM;
    float var = 0.f; for (int d = 0; d < DM; ++d) { const float c = x1[d] - mean; var += c * c; } float rs = 1.f / sqrtf(var / DM + NORM_EPS);
    s = 0.f; for (int d = 0; d < DM; ++d) { const float v = (x1[d] - mean) * rs * lg[d] + lb[d]; x1[d] = v; s += v; } mean = s / DM;
    var = 0.f; for (int d = 0; d < DM; ++d) { const float c = x1[d] - mean; var += c * c; } rs = 1.f / sqrtf(var / DM + NORM_EPS);
    float lo[NE]; _Pragma("unroll") for (int e = 0; e < NE; ++e) lo[e] = 0.f;
    for (int d = 0; d < DM; ++d) { const float hv = (x1[d] - mean) * rs * (1.f + m[4 * DM + d]) + m[3 * DM + d]; H2[R * DM + d] = f2bf(hv); _Pragma("unroll") for (int e = 0; e < NE; ++e) lo[e] += hv * rw[(long)d * NE + e]; }
    float mx = lo[0]; _Pragma("unroll") for (int e = 1; e < NE; ++e) mx = fmaxf(mx, lo[e]); float se = 0.f; _Pragma("unroll") for (int e = 0; e < NE; ++e) { lo[e] = expf(lo[e] - mx); se += lo[e]; }
    _Pragma("unroll") for (int e = 0; e < NE; ++e) AFF[R * NE + e] = lo[e] / se; }
}
__global__ void nk_topk(Params p, int with_ctx) {
  const float* AFF = WSP(float, p, aff); int* SLOT = WSP(int, p, slot); float* GV = WSP(float, p, gatev); int* XSRC = WSP(int, p, xsrc);
  GSTRIDE(i, (long)MROWS * NE) { const int R = (int)(i / NE), e = (int)(i % NE), b = row_b(R), t = row_t(R); const bool lat = t < SEQ;
    if (!lat && !with_ctx) { SLOT[i] = -1; continue; }
    const int k0 = lat ? 0 : SEQ, k1 = lat ? SEQ : NTOK, cap = lat ? CAP_L : CAP_C; const float a = AFF[i]; int rank = 0;
    for (int kk = k0; kk < k1; ++kk) { const float o = AFF[((long)b * NTOK + kk) * NE + e]; rank += (o > a || (o == a && kk < t)) ? 1 : 0; }
    if (rank < cap) { const int xr = e * XEP + (lat ? b * CAP_L : 2 * CAP_L + b * CAP_C) + rank; SLOT[i] = xr; GV[xr] = a; XSRC[xr] = R; } else SLOT[i] = -1; }
}
__global__ void nk_gather(Params p) {
  const int* XSRC = WSP(int, p, xsrc); const bf16_t* H2 = WSP(bf16_t, p, h2); bf16_t* XS = WSP(bf16_t, p, regA);
  GSTRIDE(i, (long)XROWS * DM) { const long xr = i / DM; const int d = (int)(i % DM), src = XSRC[xr]; XS[i] = src >= 0 ? H2[(long)src * DM + d] : (bf16_t)0; }
}
__global__ void nk_moe_up(Params p, int l) {
  const bf16_t* XS = WSP(bf16_t, p, regA); bf16_t* ACT = (bf16_t*)(p.ws + WS.regA + SZ_XS); const bf16_t* W = WSP(bf16_t, p, wt_gu) + (long)l * NE * 2 * FF * DM; const int* XSRC = WSP(int, p, xsrc);
  GSTRIDE(i, (long)XROWS * FF) { const long xr = i / FF; const int f = (int)(i % FF), e = (int)(xr / XEP); if (XSRC[xr] < 0) { ACT[i] = 0; continue; }
    const int jg = (f / 128) * 256 + (f % 128), ju = jg + 128; const bf16_t* x = XS + xr * DM; const bf16_t* wg = W + ((long)e * 2 * FF + jg) * DM; const bf16_t* wu = W + ((long)e * 2 * FF + ju) * DM;
    float a = 0.f, u = 0.f; for (int k = 0; k < DM; ++k) { const float xv = bf2f(x[k]); a += xv * bf2f(wg[k]); u += xv * bf2f(wu[k]); }
    ACT[i] = f2bf(siluf_(a) * u); }
}
__global__ void nk_ln2(Params p, int l, int last) {
  const float* X1 = WSP(float, p, x1); float* X2 = WSP(float, p, x2); const int* SLOT = WSP(int, p, slot); const bf16_t* YS = (const bf16_t*)(p.ws + WS.regA + SZ_XS + SZ_ACT);
  const float* mod = WSP(float, p, mod) + (long)l * 3 * 6 * DM; const float* lg = p.in[I_LN2G] + l * DM; const float* lb = p.in[I_LN2B] + l * DM;
  GSTRIDE(R, MROWS) { if (last && row_is_ctx((int)R)) continue; const float* m = mod + (long)row_mod((int)R) * 6 * DM; const float* x1 = X1 + R * DM; float* x2 = X2 + R * DM;
    float s = 0.f; for (int d = 0; d < DM; ++d) { float mo = 0.f; for (int e = 0; e < NE; ++e) { const int sl = SLOT[R * NE + e]; if (sl >= 0) mo += bf2f(YS[(long)sl * DM + d]); }
      const float v = DN_ALPHA * x1[d] + m[5 * DM + d] * mo; x2[d] = v; s += v; } const float mean = s / DM;
    float var = 0.f; for (int d = 0; d < DM; ++d) { const float c = x2[d] - mean; var += c * c; } const float rs = 1.f / sqrtf(var / DM + NORM_EPS);
    for (int d = 0; d < DM; ++d) { const float v = (x2[d] - mean) * rs * lg[d] + lb[d]; x2[d] = v; if (last) p.out[((long)row_b((int)R) * SEQ + row_t((int)R)) * DM + d] = v; } }
}
#ifdef CPU_TEST
void cpu_hook(const char* name, int l, Params& p);
#define HOOK(name) cpu_hook(name, l, p)
#else
#define HOOK(name)
#endif
#define NG(n) (int)((((long)(n)) + 255) / 256 < 65536 ? (((long)(n)) + 255) / 256 : 65536)

static void naive_prologue(Params& p, hipStream_t stream) {
  for (int l = 0; l < NLAYER; ++l) {
    LAUNCH(nk_conv_t, NG((long)PW * DM), 256, WSP(bf16_t, p, wt_in) + (long)l * PW * DM, p.in[I_WIN] + (long)l * DM * IN_TOTAL, DM, IN_TOTAL, IN_TOTAL, PW);
    LAUNCH(nk_conv_t, NG((long)4 * DM * DM), 256, WSP(bf16_t, p, wt_gate) + (long)l * 4 * DM * DM, p.in[I_WGATE] + (long)l * DM * 4 * DM, DM, 4 * DM, 4 * DM, 4 * DM);
    for (int k = 0; k < 4; ++k)
      LAUNCH(nk_conv_t, NG((long)DM * BW), 256, WSP(bf16_t, p, wt_br) + ((long)l * 4 + k) * DM * BW, p.in[I_WBR] + ((long)l * 4 + k) * BW * DM, BW, DM, DM, DM);
    LAUNCH(nk_conv_t, NG((long)DM * DM), 256, WSP(bf16_t, p, wt_out) + (long)l * DM * DM, p.in[I_WOUT] + (long)l * DM * DM, DM, DM, DM, DM);
    LAUNCH(nk_conv_t, NG((long)BW * BW), 256, WSP(bf16_t, p, wt_glu) + (long)l * BW * BW, p.in[I_S5GLU] + (long)l * BW * BW, BW, BW, BW, BW);
    LAUNCH(nk_conv_t, NG((long)MH * MQK * MQL), 256, WSP(bf16_t, p, wt_uq) + (long)l * MH * MQK * MQL, p.in[I_WUQ] + (long)l * MQL * MH * MQK, MQL, MH * MQK, MH * MQK, MH * MQK);
    LAUNCH(nk_conv_t, NG((long)MH * (MNOPE + MV) * MKVL), 256, WSP(bf16_t, p, wt_ukv) + (long)l * MH * (MNOPE + MV) * MKVL, p.in[I_WUKV] + (long)l * MKVL * MH * (MNOPE + MV), MKVL, MH * (MNOPE + MV), MH * (MNOPE + MV), MH * (MNOPE + MV));
    for (int e = 0; e < NE; ++e) {
      LAUNCH(nk_conv_gu, NG((long)2 * FF * DM), 256, WSP(bf16_t, p, wt_gu) + ((long)l * NE + e) * 2 * FF * DM, p.in[I_MOEG] + ((long)l * NE + e) * DM * FF, p.in[I_MOEU] + ((long)l * NE + e) * DM * FF);
      LAUNCH(nk_conv_t, NG((long)DM * FF), 256, WSP(bf16_t, p, wt_dn) + ((long)l * NE + e) * DM * FF, p.in[I_MOED] + ((long)l * NE + e) * FF * DM, FF, DM, DM, DM);
    }
  }
  LAUNCH(nk_mod, NG((long)NLAYER * 18 * DM), 256, p);
  LAUNCH(nk_rope_tab, 4, 256, p);
  LAUNCH(nk_s5tab, NG((long)NLAYER * 2 * S5G * S5P), 256, p);
  LAUNCH(nk_load_x, NG((long)MROWS * DM), 256, p);
}

#ifdef CPU_TEST
static void naive_layer(Params& p, int l, hipStream_t stream) {
  bf16_t* P = WSP(bf16_t, p, regA); bf16_t* PROJ = (bf16_t*)(p.ws + WS.regA + SZ_P); bf16_t* H1 = WSP(bf16_t, p, h1);
  bf16_t* QM = WSP(bf16_t, p, qm); bf16_t* KM = WSP(bf16_t, p, km); bf16_t* VM = WSP(bf16_t, p, vm); bf16_t* Z = WSP(bf16_t, p, z); bf16_t* OA = WSP(bf16_t, p, oall);
  LAUNCH(nk_ln_mod, NG(MROWS), 256, p, H1, (const float*)WSP(float, p, x2), l, 0, 1);
  HOOK("h");
  LAUNCH(nk_gemm<EpStoreBf16>, NG((long)MROWS * PW / 4), 256, (const bf16_t*)H1, (long)DM, (const bf16_t*)(WSP(bf16_t, p, wt_in) + (long)l * PW * DM), (long)DM, MROWS, PW, DM, EpStoreBf16{P, PW});
  LAUNCH(nk_post_proj, NG((long)MROWS * 17), 256, p, l);
  LAUNCH(nk_gemm<EpStoreBf16>, NG((long)MROWS * MH * MQK / 4), 256, (const bf16_t*)(P + OFF_CQ), (long)PW, (const bf16_t*)(WSP(bf16_t, p, wt_uq) + (long)l * MH * MQK * MQL), (long)MQL, MROWS, MH * MQK, MQL, EpStoreBf16{QM, MH * MQK});
  LAUNCH(nk_gemm<EpKV>, NG((long)MROWS * MH * (MNOPE + MV) / 4), 256, (const bf16_t*)(P + OFF_CKV), (long)PW, (const bf16_t*)(WSP(bf16_t, p, wt_ukv) + (long)l * MH * (MNOPE + MV) * MKVL), (long)MKVL, MROWS, MH * (MNOPE + MV), MKVL, EpKV{KM, VM});
  LAUNCH(nk_post_mla, NG((long)MROWS * MH), 256, p);
  LAUNCH(nk_s5_scan, NG((long)NB * S5G * S5P), 256, p, l);
  LAUNCH(nk_s5_read, NG((long)MROWS * BW), 256, p, l);
  LAUNCH(nk_gemm<EpGlu>, NG((long)MROWS * BW / 4), 256, (const bf16_t*)Z, (long)BW, (const bf16_t*)(WSP(bf16_t, p, wt_glu) + (long)l * BW * BW), (long)BW, MROWS, BW, BW, EpGlu{Z, OA});
  HOOK("o_s5");
  LAUNCH((nk_attn<GHD, GHD>), NG((long)MROWS * GH), 256, (const bf16_t*)(P + OFF_GQ), (const bf16_t*)(P + OFF_GK), (const bf16_t*)(P + OFF_GV), OA + BW, PW, PW, PW, DM, GH, GH / GKV, 1.f / sqrtf((float)GHD));
  HOOK("o_gqa");
  LAUNCH(nk_ret, NG((long)MROWS * RH), 256, p, l);
  HOOK("o_ret");
  LAUNCH((nk_attn<MQK, MV>), NG((long)MROWS * MH), 256, (const bf16_t*)QM, (const bf16_t*)KM, (const bf16_t*)VM, OA + 3 * BW, MH * MQK, MH * MQK, MH * MV, DM, MH, 1, 1.f / sqrtf((float)MQK));
  HOOK("o_mla");
  for (int k = 0; k < 4; ++k)
    LAUNCH(nk_gemm<EpStoreBf16>, NG((long)MROWS * DM / 4), 256, (const bf16_t*)(OA + k * BW), (long)DM, (const bf16_t*)(WSP(bf16_t, p, wt_br) + ((long)l * 4 + k) * DM * BW), (long)BW, MROWS, DM, BW, EpStoreBf16{PROJ + (long)k * DM, 4 * DM});
  LAUNCH(nk_gate_merge, NG((long)MROWS * DM), 256, p, l);
  LAUNCH(nk_gemm<EpStoreF32>, NG((long)MROWS * DM / 4), 256, (const bf16_t*)WSP(bf16_t, p, merged), (long)DM, (const bf16_t*)(WSP(bf16_t, p, wt_out) + (long)l * DM * DM), (long)DM, MROWS, DM, DM, EpStoreF32{WSP(float, p, macc), DM});
  HOOK("y");
  LAUNCH(nk_ln1, NG(MROWS), 256, p, l);
  HOOK("x1");
  hipMemsetAsync(p.ws + WS.xsrc, 0xFF, (size_t)XROWS * 4, stream);
  LAUNCH(nk_topk, NG((long)MROWS * NE), 256, p, l == 0 ? 1 : 0);
  LAUNCH(nk_gather, NG((long)XROWS * DM), 256, p);
  LAUNCH(nk_moe_up, NG((long)XROWS * FF), 256, p, l);
  bf16_t* ACT = (bf16_t*)(p.ws + WS.regA + SZ_XS); bf16_t* YS = (bf16_t*)(p.ws + WS.regA + SZ_XS + SZ_ACT);
  for (int e = 0; e < NE; ++e)
    LAUNCH(nk_gemm<EpDown>, NG((long)XEP * DM / 4), 256, (const bf16_t*)(ACT + (long)e * XEP * FF), (long)FF, (const bf16_t*)(WSP(bf16_t, p, wt_dn) + ((long)l * NE + e) * DM * FF), (long)FF, XEP, DM, FF,
           EpDown{WSP(float, p, gatev) + e * XEP, YS + (long)e * XEP * DM});
  LAUNCH(nk_ln2, NG(MROWS), 256, p, l, l == NLAYER - 1 ? 1 : 0);
  HOOK("x2");
}
#endif
#ifndef CPU_TEST
namespace pg8 {
#define PG8_LAS __attribute__((address_space(3)))
typedef short bf16x8 __attribute__((ext_vector_type(8)));
typedef float f32x4 __attribute__((ext_vector_type(4)));
typedef unsigned u32x4 __attribute__((ext_vector_type(4)));
constexpr int BM = 256, BK = 64, HALF = 128, HTB = HALF * BK * 2, STAGE_BYTES = 8 * HTB, NXCD = 8, WGM = 8;
__host__ __device__ __forceinline__ int lds_byte(int r, int c) { const int st = (r >> 4) * 2 + (c >> 5), rr = r & 15, cc = c & 31, ob = rr * 64 + cc * 2; return st * 1024 + (ob ^ (((ob >> 9) & 1) << 5)); }
__host__ __device__ __forceinline__ void stage_rc(int b, int& R, int& C) { const int st = b / 1024, sb = b % 1024, swz = sb ^ (((sb >> 9) & 1) << 5); R = (st >> 1) * 16 + swz / 64; C = (st & 1) * 32 + (swz % 64) / 2; }
__host__ __device__ __forceinline__ int perm32(int rho) { const int n = rho >> 4, i = rho & 15; return 8 * (i >> 2) + 4 * n + (i & 3); }

struct Unit { int pm, pn, aux; const char* A; const char* B; };
struct GemmG { int lda, ldb, K, pad; };

__device__ __forceinline__ bool tile_order(long L, int nM, int nN, int& pm, int& pn) {
  const int nwg = nM * nN; if (L >= nwg) return false;
  int wgid = (int)L; { const int q = nwg / NXCD, r = nwg % NXCD, xcd = wgid % NXCD, off = wgid / NXCD; wgid = (xcd < r ? xcd * (q + 1) : r * (q + 1) + (xcd - r) * q) + off; }
  const int nig = WGM * nN, gid = wgid / nig, fm = gid * WGM, gsz = (nM - fm) < WGM ? (nM - fm) : WGM;
  pm = fm + ((wgid % nig) % gsz); pn = (wgid % nig) / gsz; return true;
}
__device__ __forceinline__ unsigned cvt_pk_bf16(float lo, float hi) { unsigned r; asm volatile("v_cvt_pk_bf16_f32 %0, %1, %2" : "=v"(r) : "v"(lo), "v"(hi)); return r; }
__device__ __forceinline__ u32x4 pack8(const f32x4 a, const f32x4 b) { u32x4 w; w.x = cvt_pk_bf16(a[0], a[1]); w.y = cvt_pk_bf16(a[2], a[3]); w.z = cvt_pk_bf16(b[0], b[1]); w.w = cvt_pk_bf16(b[2], b[3]); return w; }
__device__ __forceinline__ void unpack8(const u32x4 w, f32x4& a, f32x4& b) {
  a[0] = __uint_as_float(w.x << 16); a[1] = __uint_as_float(w.x & 0xffff0000u); a[2] = __uint_as_float(w.y << 16); a[3] = __uint_as_float(w.y & 0xffff0000u);
  b[0] = __uint_as_float(w.z << 16); b[1] = __uint_as_float(w.z & 0xffff0000u); b[2] = __uint_as_float(w.w << 16); b[3] = __uint_as_float(w.w & 0xffff0000u); }
__device__ __forceinline__ float fast_sigmoid(float x) { return __builtin_amdgcn_rcpf(1.f + __builtin_amdgcn_exp2f(-1.4426950408889634f * x)); }
__device__ __forceinline__ f32x4 sigmoid4(f32x4 v) { f32x4 o; o[0] = fast_sigmoid(v[0]); o[1] = fast_sigmoid(v[1]); o[2] = fast_sigmoid(v[2]); o[3] = fast_sigmoid(v[3]); return o; }

template <class Epi, class Sched>
__device__ __forceinline__ void gemm_phase(PG8_LAS unsigned char* lds, const GemmG g, const Sched& S, const Epi& E) {
    const int tid = threadIdx.x, wid = __builtin_amdgcn_readfirstlane(tid >> 6), lane = tid & 63, wr = wid >> 2, wc = wid & 3, fr = lane & 15, fq = lane >> 4;
    const int K = g.K, nt = K / BK;
    unsigned voffA[2], voffB[2];
#pragma unroll
    for (int i = 0; i < 2; ++i) { int R, C; stage_rc(tid * 16 + i * 8192, R, C); const int Rb = (R & ~31) + perm32(R & 31);
        voffA[i] = (unsigned)(R * g.lda + C) * 2u; voffB[i] = (unsigned)(Rb * g.ldb + C) * 2u; }
    const size_t kstep = (size_t)(BK * 2);
    const size_t hsA = (size_t)HALF * g.lda * 2, hsB = (size_t)HALF * g.ldb * 2;
    const unsigned ldsw = (unsigned)wid * 1024u;
    const int aoff = lds_byte(wr * 64 + fr, fq * 8), boff = lds_byte(wc * 32 + fr, fq * 8);
#define PG8_SA(b, h) (((b) * 2 + (h)) * HTB)
#define PG8_SB(b, h) ((4 + (b) * 2 + (h)) * HTB)
#define PG8_STAGE(bufoff, gbase, voff) do { _Pragma("unroll") for (int _i = 0; _i < 2; ++_i) \
        __builtin_amdgcn_global_load_lds((const unsigned*)((const char*)(gbase) + (voff)[_i]), (PG8_LAS unsigned*)(lds + (bufoff) + ldsw + _i * 8192), 16, 0, 0); } while (0)
#define PG8_LDA(dst, b, h) do { _Pragma("unroll") for (int m = 0; m < 4; ++m) _Pragma("unroll") for (int k = 0; k < 2; ++k) dst[m][k] = *(const PG8_LAS bf16x8*)(lds + PG8_SA(b, h) + aoff + m * 2048 + k * 1024); } while (0)
#define PG8_LDB(dst, b, h) do { _Pragma("unroll") for (int n = 0; n < 2; ++n) _Pragma("unroll") for (int k = 0; k < 2; ++k) dst[n][k] = *(const PG8_LAS bf16x8*)(lds + PG8_SB(b, h) + boff + n * 2048 + k * 1024); } while (0)
#define PG8_MMA(ai, bj, At, Bt) do { __builtin_amdgcn_s_setprio(1); _Pragma("unroll") for (int m = 0; m < 4; ++m) _Pragma("unroll") for (int n = 0; n < 2; ++n) _Pragma("unroll") for (int k = 0; k < 2; ++k) \
        acc[ai][bj][m][n] = __builtin_amdgcn_mfma_f32_16x16x32_bf16(Bt[n][k], At[m][k], acc[ai][bj][m][n], 0, 0, 0); __builtin_amdgcn_s_setprio(0); } while (0)
#define PG8_WAIT_V(n) asm volatile("s_waitcnt vmcnt(" #n ")" ::: "memory")
#define PG8_WAIT_L(n) asm volatile("s_waitcnt lgkmcnt(" #n ")" ::: "memory")
#define PG8_BAR __builtin_amdgcn_s_barrier()
#define PG8_SCHED __builtin_amdgcn_sched_barrier(0)
    Unit cur, nxt; int ui = 0;
    if (!S.next(0, cur)) return;
    f32x4 acc[2][2][4][2];
#pragma unroll
    for (int a = 0; a < 2; ++a)
#pragma unroll
        for (int b = 0; b < 2; ++b)
#pragma unroll
            for (int m = 0; m < 4; ++m)
#pragma unroll
                for (int n = 0; n < 2; ++n) acc[a][b][m][n] = (f32x4){0.f, 0.f, 0.f, 0.f};
    bf16x8 At[4][2], B0[2][2], B1[2][2];
    const char* cA = cur.A; const char* cB = cur.B;
    PG8_STAGE(PG8_SB(0, 0), cB, voffB); PG8_STAGE(PG8_SA(0, 0), cA, voffA); PG8_STAGE(PG8_SB(0, 1), cB + hsB, voffB); PG8_STAGE(PG8_SA(0, 1), cA + hsA, voffA);
    if (wr == 1) PG8_BAR;
    PG8_WAIT_V(4); PG8_BAR;
    PG8_STAGE(PG8_SB(1, 0), cB + kstep, voffB); PG8_STAGE(PG8_SA(1, 0), cA + kstep, voffA); PG8_STAGE(PG8_SB(1, 1), cB + hsB + kstep, voffB);
    PG8_WAIT_V(6); PG8_BAR;
    for (;;) {
        const bool has_next = S.next(ui + 1, nxt);
        const char* nA = has_next ? nxt.A : cA; const char* nB = has_next ? nxt.B : cB;
        for (int t = 0; t < nt; t += 2) {
            const bool last = (t == nt - 2);
            const char* a1 = cA + (size_t)(t + 1) * kstep;
            const char* a2 = last ? nA : cA + (size_t)(t + 2) * kstep; const char* b2 = last ? nB : cB + (size_t)(t + 2) * kstep;
            const char* a3 = a2 + kstep; const char* b3 = b2 + kstep;
            PG8_LDB(B0, 0, 0); PG8_SCHED; PG8_LDA(At, 0, 0); PG8_STAGE(PG8_SA(1, 1), a1 + hsA, voffA);
            PG8_WAIT_L(8); PG8_BAR; PG8_WAIT_L(0); PG8_MMA(0, 0, At, B0); PG8_BAR; PG8_SCHED;
            PG8_LDB(B1, 0, 1); PG8_STAGE(PG8_SB(0, 0), b2, voffB);
            PG8_BAR; PG8_WAIT_L(0); PG8_MMA(0, 1, At, B1); PG8_BAR;
            PG8_LDA(At, 0, 1); PG8_STAGE(PG8_SA(0, 0), a2, voffA);
            PG8_BAR; PG8_WAIT_L(0); PG8_MMA(1, 0, At, B0); PG8_BAR; PG8_SCHED;
            PG8_STAGE(PG8_SB(0, 1), b2 + hsB, voffB);
            PG8_WAIT_V(6); PG8_BAR; PG8_MMA(1, 1, At, B1); PG8_BAR;
            PG8_LDB(B0, 1, 0); PG8_SCHED; PG8_LDA(At, 1, 0); PG8_STAGE(PG8_SA(0, 1), a2 + hsA, voffA);
            PG8_WAIT_L(8); PG8_BAR; PG8_WAIT_L(0); PG8_MMA(0, 0, At, B0); PG8_BAR; PG8_SCHED;
            PG8_LDB(B1, 1, 1); PG8_STAGE(PG8_SB(1, 0), b3, voffB);
            PG8_BAR; PG8_WAIT_L(0); PG8_MMA(0, 1, At, B1); PG8_BAR;
            PG8_LDA(At, 1, 1); PG8_STAGE(PG8_SA(1, 0), a3, voffA);
            PG8_BAR; PG8_WAIT_L(0); PG8_MMA(1, 0, At, B0); PG8_BAR; PG8_SCHED;
            PG8_STAGE(PG8_SB(1, 1), b3 + hsB, voffB);
            PG8_WAIT_V(6); PG8_BAR; PG8_MMA(1, 1, At, B1); PG8_BAR;
        }
        E(acc, cur, wr, wc, fr, fq);
        if (!has_next) break;
#pragma unroll
        for (int a = 0; a < 2; ++a)
#pragma unroll
            for (int b = 0; b < 2; ++b)
#pragma unroll
                for (int m = 0; m < 4; ++m)
#pragma unroll
                    for (int n = 0; n < 2; ++n) acc[a][b][m][n] = (f32x4){0.f, 0.f, 0.f, 0.f};
        cur = nxt; cA = nA; cB = nB; ++ui;
    }
    PG8_WAIT_V(0);
    if (wr == 0) PG8_BAR;
    PG8_BAR;
#undef PG8_SA
#undef PG8_SB
#undef PG8_STAGE
#undef PG8_LDA
#undef PG8_LDB
#undef PG8_MMA
#undef PG8_WAIT_V
#undef PG8_WAIT_L
#undef PG8_BAR
#undef PG8_SCHED
}

struct SchedGrid {
  const char* A; const char* B; int lda, ldb, nM, nN, skip_ctx, G, c, pad;
  __device__ __forceinline__ bool next(int i, Unit& u) const {
    int pm, pn; if (!tile_order((long)i * G + c, nM, nN, pm, pn)) return false;
    if (skip_ctx && pm >= NTOK / 256 - 1) pm += 1;
    u.pm = pm; u.pn = pn; u.aux = 0; u.A = A + (size_t)pm * BM * lda * 2; u.B = B + (size_t)pn * BM * ldb * 2; return true; }
};
struct SchedProj {
  const char* OA; const char* B; int nM, skip_ctx, G, c;
  __device__ __forceinline__ bool next(int i, Unit& u) const {
    int pm, pn; if (!tile_order((long)i * G + c, nM, 4 * DM / 256, pm, pn)) return false;
    if (skip_ctx && pm >= NTOK / 256 - 1) pm += 1;
    const int k = pn / (DM / 256);
    u.pm = pm; u.pn = pn; u.aux = k; u.A = OA + ((size_t)pm * BM * DM + (size_t)k * BW) * 2; u.B = B + (size_t)pn * BM * BW * 2; return true; }
};
struct SchedGate {
  const char* H; const char* B; int nM, skip_ctx, G, c;
  __device__ __forceinline__ bool next(int i, Unit& u) const {
    const int j = i >> 2, k = i & 3; int pm, pd; if (!tile_order((long)j * G + c, nM, DM / 256, pm, pd)) return false;
    if (skip_ctx && pm >= NTOK / 256 - 1) pm += 1;
    u.pm = pm; u.pn = pd; u.aux = k; u.A = H + (size_t)pm * BM * DM * 2; u.B = B + ((size_t)k * DM + (size_t)pd * BM) * DM * 2; return true; }
};
struct SchedMoe {
  const char* A; const char* B; int lda, ldb, nMl, nN; size_t wstride; int G, c;
  __device__ __forceinline__ bool next(int i, Unit& u) const {
    const long L = (long)i * G + c; if (L >= (long)NE * nMl * nN) return false;
    const int e = (int)(L / (nMl * nN)), rem = (int)(L % (nMl * nN)), pn = rem / nMl, pml = rem % nMl;
    u.pm = e * (XEP / 256) + pml; u.pn = pn; u.aux = e; u.A = A + (size_t)u.pm * BM * lda * 2; u.B = B + (size_t)e * wstride + (size_t)pn * BM * ldb * 2; return true; }
};

#define EPI_LOOP(...) _Pragma("unroll") for (int ai = 0; ai < 2; ++ai) _Pragma("unroll") for (int m = 0; m < 4; ++m) { const int trow = ai * HALF + wr * 64 + m * 16 + fr; \
    _Pragma("unroll") for (int bj = 0; bj < 2; ++bj) { const int tcol = bj * HALF + wc * 32 + 8 * fq; const f32x4 v0 = acc[ai][bj][m][0], v1 = acc[ai][bj][m][1]; __VA_ARGS__ } }
typedef f32x4 AccT[2][2][4][2];
struct EpiBf16 { bf16_t* O; int ldc, pad;
  __device__ __forceinline__ void operator()(const AccT& acc, const Unit& u, int wr, int wc, int fr, int fq) const {
    bf16_t* base = O + (size_t)u.pm * BM * ldc + (size_t)u.pn * BM;
    EPI_LOOP(*(u32x4*)(base + (size_t)trow * ldc + tcol) = pack8(v0, v1);) } };
struct EpiF32 { float* O; int ldc, pad;
  __device__ __forceinline__ void operator()(const AccT& acc, const Unit& u, int wr, int wc, int fr, int fq) const {
    float* base = O + (size_t)u.pm * BM * ldc + (size_t)u.pn * BM;
    EPI_LOOP(float* q = base + (size_t)trow * ldc + tcol; *(f32x4*)q = v0; *(f32x4*)(q + 4) = v1;) } };
struct EpiKVm { bf16_t* KM; bf16_t* VM;
  __device__ __forceinline__ void operator()(const AccT& acc, const Unit& u, int wr, int wc, int fr, int fq) const {
    EPI_LOOP(const size_t row = (size_t)u.pm * BM + trow; bf16_t* q = (bj == 0) ? KM + row * (MH * MQK) + u.pn * MQK + (tcol) : VM + row * (MH * MV) + u.pn * MV + (tcol - HALF);
             *(u32x4*)q = pack8(v0, v1);) } };
struct EpiGluO { const bf16_t* Z; bf16_t* O;
  __device__ __forceinline__ void operator()(const AccT& acc, const Unit& u, int wr, int wc, int fr, int fq) const {
    EPI_LOOP(const size_t row = (size_t)u.pm * BM + trow; const int col = u.pn * BM + tcol; f32x4 z0, z1; unpack8(*(const u32x4*)(Z + row * BW + col), z0, z1);
             *(u32x4*)(O + row * DM + col) = pack8(z0 * sigmoid4(v0), z1 * sigmoid4(v1));) } };
struct EpiGateMerge { const float* bg; const bf16_t* PROJ; float* MACC; bf16_t* MG;
  __device__ __forceinline__ void operator()(const AccT& acc, const Unit& u, int wr, int wc, int fr, int fq) const {
    const int k = u.aux;
    EPI_LOOP(const size_t row = (size_t)u.pm * BM + trow; const int d = u.pn * BM + tcol; const float* bp = bg + k * DM + d; f32x4 p0, p1; unpack8(*(const u32x4*)(PROJ + row * (4 * DM) + k * DM + d), p0, p1);
             f32x4 r0 = sigmoid4(v0 + *(const f32x4*)bp) * p0, r1 = sigmoid4(v1 + *(const f32x4*)(bp + 4)) * p1; float* mp = MACC + row * DM + d;
             if (k > 0) { r0 += *(const f32x4*)mp; r1 += *(const f32x4*)(mp + 4); }
             if (k < 3) { *(f32x4*)mp = r0; *(f32x4*)(mp + 4) = r1; } else *(u32x4*)(MG + row * DM + d) = pack8(r0, r1);) } };
struct EpiSwiGlu { bf16_t* ACT;
  __device__ __forceinline__ void operator()(const AccT& acc, const Unit& u, int wr, int wc, int fr, int fq) const {
#pragma unroll
    for (int ai = 0; ai < 2; ++ai)
#pragma unroll
      for (int m = 0; m < 4; ++m) { const size_t row = (size_t)u.pm * BM + ai * HALF + wr * 64 + m * 16 + fr; const int col = u.pn * HALF + wc * 32 + 8 * fq;
        const f32x4 g0 = acc[ai][0][m][0], g1 = acc[ai][0][m][1], u0 = acc[ai][1][m][0], u1 = acc[ai][1][m][1];
        *(u32x4*)(ACT + row * FF + col) = pack8(g0 * sigmoid4(g0) * u0, g1 * sigmoid4(g1) * u1); } } };
struct EpiDownG { const float* GV; bf16_t* YS;
  __device__ __forceinline__ void operator()(const AccT& acc, const Unit& u, int wr, int wc, int fr, int fq) const {
    EPI_LOOP(const size_t row = (size_t)u.pm * BM + trow; const float gv = GV[row]; *(u32x4*)(YS + row * DM + u.pn * BM + tcol) = pack8(v0 * gv, v1 * gv);) } };
}

template <class Epi, class Sched> __global__ __launch_bounds__(512, 2) void k_gemm_phase(pg8::GemmG g, Sched S, Epi E) {
  extern __shared__ __attribute__((aligned(16))) unsigned char shm[];
  S.G = gridDim.x; S.c = blockIdx.x;
  pg8::gemm_phase<Epi, Sched>((PG8_LAS unsigned char*)shm, g, S, E);
}
#endif
#ifndef CPU_TEST
static int g_ncu = 256;
template <class Epi, class Sched> static void launch_gemm(const pg8::GemmG& g, const Sched& S, const Epi& E, hipStream_t stream) {
  static bool attr = false;
  if (!attr) { hipFuncSetAttribute((const void*)k_gemm_phase<Epi, Sched>, hipFuncAttributeMaxDynamicSharedMemorySize, pg8::STAGE_BYTES); attr = true; }
  hipLaunchKernelGGL((k_gemm_phase<Epi, Sched>), dim3(g_ncu), dim3(512), pg8::STAGE_BYTES, stream, g, S, E);
}
static void gpu_layer(Params& p, int l, hipStream_t stream) {
  using namespace pg8;
  bf16_t* P = WSP(bf16_t, p, regA); bf16_t* PROJ = (bf16_t*)(p.ws + WS.regA + SZ_P); bf16_t* H1 = WSP(bf16_t, p, h1);
  bf16_t* QM = WSP(bf16_t, p, qm); bf16_t* KM = WSP(bf16_t, p, km); bf16_t* VM = WSP(bf16_t, p, vm); bf16_t* Z = WSP(bf16_t, p, z); bf16_t* OA = WSP(bf16_t, p, oall);
  const int last = (l == NLAYER - 1), nMfull = MROWS / 256, nMlat = last ? nMfull - 2 : nMfull;
  LAUNCH(nk_ln_mod, NG(MROWS), 256, p, H1, (const float*)WSP(float, p, x2), l, 0, 1);
  { SchedGrid S{(const char*)H1, (const char*)(WSP(bf16_t, p, wt_in) + (long)l * PW * DM), DM, DM, nMfull, PW / 256, 0, 0, 0, 0};
    launch_gemm(GemmG{DM, DM, DM, 0}, S, EpiBf16{P, PW, 0}, stream); }
  LAUNCH(nk_post_proj, NG((long)MROWS * 17), 256, p, l);
  { SchedGrid S{(const char*)(P + OFF_CQ), (const char*)(WSP(bf16_t, p, wt_uq) + (long)l * MH * MQK * MQL), PW, MQL, nMfull, MH * MQK / 256, 0, 0, 0, 0};
    launch_gemm(GemmG{PW, MQL, MQL, 0}, S, EpiBf16{QM, MH * MQK, 0}, stream); }
  { SchedGrid S{(const char*)(P + OFF_CKV), (const char*)(WSP(bf16_t, p, wt_ukv) + (long)l * MH * (MNOPE + MV) * MKVL), PW, MKVL, nMfull, MH, 0, 0, 0, 0};
    launch_gemm(GemmG{PW, MKVL, MKVL, 0}, S, EpiKVm{KM, VM}, stream); }
  LAUNCH(nk_post_mla, NG((long)MROWS * MH), 256, p);
  LAUNCH(nk_s5_scan, NG((long)NB * S5G * S5P), 256, p, l);
  LAUNCH(nk_s5_read, NG((long)MROWS * BW), 256, p, l);
  { SchedGrid S{(const char*)Z, (const char*)(WSP(bf16_t, p, wt_glu) + (long)l * BW * BW), BW, BW, nMfull, BW / 256, 0, 0, 0, 0};
    launch_gemm(GemmG{BW, BW, BW, 0}, S, EpiGluO{Z, OA}, stream); }
  LAUNCH((nk_attn<GHD, GHD>), NG((long)MROWS * GH), 256, (const bf16_t*)(P + OFF_GQ), (const bf16_t*)(P + OFF_GK), (const bf16_t*)(P + OFF_GV), OA + BW, PW, PW, PW, DM, GH, GH / GKV, 1.f / sqrtf((float)GHD));
  LAUNCH(nk_ret, NG((long)MROWS * RH), 256, p, l);
  LAUNCH((nk_attn<MQK, MV>), NG((long)MROWS * MH), 256, (const bf16_t*)QM, (const bf16_t*)KM, (const bf16_t*)VM, OA + 3 * BW, MH * MQK, MH * MQK, MH * MV, DM, MH, 1, 1.f / sqrtf((float)MQK));
  { SchedProj S{(const char*)OA, (const char*)(WSP(bf16_t, p, wt_br) + (long)l * 4 * DM * BW), nMlat, last, 0, 0};
    launch_gemm(GemmG{DM, BW, BW, 0}, S, EpiBf16{PROJ, 4 * DM, 0}, stream); }
  { SchedGate S{(const char*)H1, (const char*)(WSP(bf16_t, p, wt_gate) + (long)l * 4 * DM * DM), nMlat, last, 0, 0};
    launch_gemm(GemmG{DM, DM, DM, 0}, S, EpiGateMerge{p.in[I_BGATE] + (long)l * 4 * DM, PROJ, WSP(float, p, macc), WSP(bf16_t, p, merged)}, stream); }
  { SchedGrid S{(const char*)WSP(bf16_t, p, merged), (const char*)(WSP(bf16_t, p, wt_out) + (long)l * DM * DM), DM, DM, nMlat, DM / 256, last, 0, 0, 0};
    launch_gemm(GemmG{DM, DM, DM, 0}, S, EpiF32{WSP(float, p, macc), DM, 0}, stream); }
  LAUNCH(nk_ln1, NG(MROWS), 256, p, l);
  hipMemsetAsync(p.ws + WS.xsrc, 0xFF, (size_t)XROWS * 4, stream);
  LAUNCH(nk_topk, NG((long)MROWS * NE), 256, p, l == 0 ? 1 : 0);
  LAUNCH(nk_gather, NG((long)XROWS * DM), 256, p);
  bf16_t* XS = WSP(bf16_t, p, regA); bf16_t* ACT = (bf16_t*)(p.ws + WS.regA + SZ_XS); bf16_t* YS = (bf16_t*)(p.ws + WS.regA + SZ_XS + SZ_ACT);
  const int nMl = last ? (2 * CAP_L) / 256 : XEP / 256;
  { SchedMoe S{(const char*)XS, (const char*)(WSP(bf16_t, p, wt_gu) + (long)l * NE * 2 * FF * DM), DM, DM, nMl, 2 * FF / 256, (size_t)2 * FF * DM * 2, 0, 0};
    launch_gemm(GemmG{DM, DM, DM, 0}, S, EpiSwiGlu{ACT}, stream); }
  { SchedMoe S{(const char*)ACT, (const char*)(WSP(bf16_t, p, wt_dn) + (long)l * NE * DM * FF), FF, FF, nMl, DM / 256, (size_t)DM * FF * 2, 0, 0};
    launch_gemm(GemmG{FF, FF, FF, 0}, S, EpiDownG{WSP(float, p, gatev), YS}, stream); }
  LAUNCH(nk_ln2, NG(MROWS), 256, p, l, last);
}

extern "C" void kernel_launch(void* const* d_in, const int* in_sizes, int n_in, void* d_out, int out_size, void* d_ws, size_t ws_size, hipStream_t stream) {
  if (n_in != N_IN || ws_size < WS.end || out_size != NB * SEQ * DM) { fprintf(stderr, "kernel_launch: unexpected sizes n_in %d ws %zu (need %zu) out %d\n", n_in, ws_size, WS.end, out_size); return; }
  Params p; memset(&p, 0, sizeof(p));
  for (int i = 0; i < N_IN; ++i) p.in[i] = (const float*)d_in[i];
  p.out = (float*)d_out; p.ws = (char*)d_ws;
  naive_prologue(p, stream);
  for (int l = 0; l < NLAYER; ++l) gpu_layer(p, l, stream);
}
#endif
```

```cpp
#ifdef CPU_TEST
#include <cmath>
#include <cstdio>
#include <cstdlib>
#include <cstring>
#include <cstdint>
#include <functional>
#define __global__
#define __device__
#define __host__
#define __forceinline__ inline
#define __launch_bounds__(...)
#define __restrict__
struct dim3s { int x, y, z; };
static thread_local dim3s blockIdx, threadIdx, blockDim, gridDim;
typedef void* hipStream_t;
template <class F> static void cpu_launch(int grid, int block, F f) {
#pragma omp parallel for schedule(dynamic, 1)
  for (int b = 0; b < grid; ++b) {
    gridDim.x = grid; blockDim.x = block; blockIdx.x = b;
    for (int t = 0; t < block; ++t) { threadIdx.x = t; f(); }
  }
}
#define LAUNCH(kern, grid, block, ...) cpu_launch((grid), (block), [&]() { kern(__VA_ARGS__); })
static inline void hipMemsetAsync(void* p, int v, size_t n, hipStream_t) { memset(p, v, n); }
#else
#include <hip/hip_runtime.h>
#include <cstdio>
#include <cstdint>
#include <cstring>
#define LAUNCH(kern, grid, block, ...) hipLaunchKernelGGL(kern, dim3(grid), dim3(block), 0, stream, __VA_ARGS__)
#endif

typedef unsigned short bf16_t;

#ifndef CFG_DM
#define CFG_DM 2048
#define CFG_SEQ 4096
#define CFG_GRIDW 64
#define CFG_CTX 256
#define CFG_S5P 64
#define CFG_GHD 128
#define CFG_RCHUNK 128
#define CFG_MNOPE 128
#define CFG_MROPE 64
#define CFG_NE 16
#endif
constexpr int DM = CFG_DM, NB = 2, SEQ = CFG_SEQ, GRIDW = CFG_GRIDW, CTXL = CFG_CTX, NLAYER = 2;
constexpr int BW = DM / 4, S5CH = 16, S5G = BW / S5CH, S5P = CFG_S5P;
constexpr int GHD = CFG_GHD, GH = BW / GHD, GKV = GH / 2;
constexpr int RH = 4, RV = BW / RH, RQK = RV / 2;
constexpr int MQL = BW, MKVL = BW / 2, MH = 4, MNOPE = CFG_MNOPE, MROPE = CFG_MROPE, MV = BW / MH, MQK = MNOPE + MROPE;
constexpr int NE = CFG_NE, FF = DM / 2;
constexpr int NTOK = SEQ + CTXL, MROWS = NB * NTOK;
constexpr int OFF_U = 0, OFF_GQ = BW, OFF_GK = OFF_GQ + GH * GHD, OFF_GV = OFF_GK + GKV * GHD, OFF_RQ = OFF_GV + GKV * GHD, OFF_RK = OFF_RQ + RH * RQK,
              OFF_RV = OFF_RK + RH * RQK, OFF_RG = OFF_RV + RH * RV, OFF_CQ = OFF_RG + RH * RV, OFF_CKV = OFF_CQ + MQL, OFF_KR = OFF_CKV + MKVL, IN_TOTAL = OFF_KR + MROPE;
constexpr int PW = (IN_TOTAL + 255) / 256 * 256;
constexpr int CAP_L = 2 * SEQ / NE, CAP_C = 2 * CTXL / NE;
constexpr int XE = 2 * CAP_L + 2 * CAP_C, XEP = (XE + 255) / 256 * 256;
constexpr int XROWS = NE * XEP;
constexpr int NROPE_A = GHD / 4, NROPE_B = RQK / 4;
static_assert(MROPE / 4 == NROPE_B, "rope tables");
static_assert(MNOPE == MV, "kv split");
constexpr int S5LC = 16, S5NC = NTOK / S5LC, S5NN = NB * S5NC, S5NP = (S5NN + 255) / 256 * 256, S5K1 = S5LC * S5CH, S5K2 = 2 * S5P * 2;
constexpr int RCH = CFG_RCHUNK, RNC = NTOK / RCH;
constexpr float NORM_EPS = 1e-6f;
constexpr float DN_ALPHA = 1.4142135623730951f;

enum { I_X = 0, I_C, I_CTX, I_CCTX, I_ADAW, I_ADAB, I_WIN, I_S5AREF, I_S5AIMF, I_S5DTF, I_S5AREB, I_S5AIMB, I_S5DTB, I_S5BRE, I_S5BIM, I_S5CRE, I_S5CIM, I_S5D, I_S5GLU,
       I_GQN, I_GKN, I_RDF, I_RDB, I_RNORM, I_MQN, I_MKVN, I_WUQ, I_WUKV, I_WBR, I_WGATE, I_BGATE, I_WOUT, I_LN1G, I_LN1B, I_ROUTER, I_MOEG, I_MOEU, I_MOED, I_LN2G, I_LN2B, N_IN };

constexpr size_t al256(size_t x) { return (x + 255) / 256 * 256; }
struct WsLayout {
  size_t bar, mod, rope_a, rope_b, s5tab, wt_in, wt_gate, wt_br, wt_out, wt_glu, wt_uq, wt_ukv, wt_gu, wt_dn;
  size_t x1, x2, h1, h2, regA  , qm, km, vm, z, oall, macc  , merged, aff, slot, gatev, xsrc, retst, s5st, uh, s5e, s5sw, s5sv, rkv, rs, zrow, end;
};
constexpr size_t SZ_P = (size_t)MROWS * PW * 2, SZ_PROJ = (size_t)MROWS * 4 * DM * 2;
constexpr size_t SZ_XS = (size_t)XROWS * DM * 2, SZ_ACT = (size_t)XROWS * FF * 2, SZ_YS = (size_t)XROWS * DM * 2;
constexpr size_t SZ_HS = (size_t)MROWS * S5G * S5P * 2 * 4;
constexpr size_t cmax(size_t a, size_t b) { return a > b ? a : b; }
constexpr WsLayout make_ws() {
  WsLayout w{}; size_t o = 0;
  w.bar = o; o += al256(16384);
  w.mod = o; o += al256((size_t)NLAYER * 3 * 6 * DM * 4);
  w.rope_a = o; o += al256((size_t)GRIDW * NROPE_A * 2 * 4);
  w.rope_b = o; o += al256((size_t)GRIDW * NROPE_B * 2 * 4);
  w.s5tab = o; o += al256((size_t)NLAYER * 2 * S5G * S5P * (2 + 2 * S5CH) * 4);
  w.wt_in = o; o += al256((size_t)NLAYER * PW * DM * 2);
  w.wt_gate = o; o += al256((size_t)NLAYER * 4 * DM * DM * 2);
  w.wt_br = o; o += al256((size_t)NLAYER * 4 * DM * BW * 2);
  w.wt_out = o; o += al256((size_t)NLAYER * DM * DM * 2);
  w.wt_glu = o; o += al256((size_t)NLAYER * BW * BW * 2);
  w.wt_uq = o; o += al256((size_t)NLAYER * MH * MQK * MQL * 2);
  w.wt_ukv = o; o += al256((size_t)NLAYER * MH * (MNOPE + MV) * MKVL * 2);
  w.wt_gu = o; o += al256((size_t)NLAYER * NE * 2 * FF * DM * 2);
  w.wt_dn = o; o += al256((size_t)NLAYER * NE * DM * FF * 2);
  w.x1 = o; o += al256((size_t)MROWS * DM * 4);
  w.x2 = o; o += al256((size_t)MROWS * DM * 4);
  w.h1 = o; o += al256((size_t)MROWS * DM * 2);
  w.h2 = o; o += al256((size_t)MROWS * DM * 2);
  w.regA = o; o += al256(cmax(cmax(SZ_P + SZ_PROJ, SZ_XS + SZ_ACT + SZ_YS), SZ_P + SZ_HS));
  w.qm = o; o += al256((size_t)MROWS * MH * MQK * 2);
  w.km = o; o += al256((size_t)MROWS * MH * MQK * 2);
  w.vm = o; o += al256((size_t)MROWS * MH * MV * 2);
  w.z = o; o += al256((size_t)MROWS * BW * 2);
  w.oall = o; o += al256((size_t)MROWS * DM * 2);
  w.macc = o; o += al256((size_t)MROWS * DM * 4);
  w.merged = o; o += al256((size_t)MROWS * DM * 2);
  w.aff = o; o += al256((size_t)MROWS * NE * 4);
  w.slot = o; o += al256((size_t)MROWS * NE * 4);
  w.gatev = o; o += al256((size_t)XROWS * 4);
  w.xsrc = o; o += al256((size_t)XROWS * 4);
  w.retst = o; o += al256((size_t)NB * RH * 2 * RQK * RV * 4);
  w.s5st = o; o += al256((size_t)NB * 2 * S5G * S5P * 2 * 4);
  w.uh = o; o += al256((size_t)S5G * S5NP * (S5K1 + S5K2) * 2);
  w.s5e = o; o += al256((size_t)S5G * S5NP * S5K2 * 4);
  w.s5sw = o; o += al256((size_t)NLAYER * S5G * S5K2 * S5K1 * 2);
  w.s5sv = o; o += al256((size_t)NLAYER * S5G * S5K1 * (S5K1 + S5K2) * 2);
  w.rkv = o; o += al256((size_t)NB * RH * 2 * RNC * RV * RQK * 4);
  w.rs = o; o += al256((size_t)NB * RH * 2 * RNC * RV * RQK * 2);
  w.zrow = o; o += al256((size_t)DM * 2);
  w.end = o; return w;
}
constexpr WsLayout WS = make_ws();

struct Params {
  const float* in[N_IN];
  float* out;
  char* ws;
};

__host__ __device__ __forceinline__ float bf2f(bf16_t b) { union { unsigned u; float f; } c; c.u = ((unsigned)b) << 16; return c.f; }
__host__ __device__ __forceinline__ bf16_t f2bf(float f) { union { unsigned u; float f; } c; c.f = f; unsigned u = c.u; u += 0x7FFFu + ((u >> 16) & 1u); return (bf16_t)(u >> 16); }
__host__ __device__ __forceinline__ float sigmoidf_(float x) { return 1.f / (1.f + expf(-x)); }
__host__ __device__ __forceinline__ float siluf_(float x) { return x / (1.f + expf(-x)); }
__host__ __device__ __forceinline__ float gelu_tanh(float x) { return 0.5f * x * (1.f + tanhf(0.7978845608028654f * (x + 0.044715f * x * x * x))); }
__host__ __device__ __forceinline__ int row_b(int R) { return R / NTOK; }
__host__ __device__ __forceinline__ int row_t(int R) { return R % NTOK; }
__host__ __device__ __forceinline__ bool row_is_ctx(int R) { return (R % NTOK) >= SEQ; }
__host__ __device__ __forceinline__ int row_mod(int R) { return row_is_ctx(R) ? 2 : row_b(R); }
#define GSTRIDE(i, n) for (long i = (long)blockIdx.x * blockDim.x + threadIdx.x; i < (long)(n); i += (long)gridDim.x * blockDim.x)
#define WSP(T, p, field) ((T*)((p).ws + WS.field))

__global__ void nk_conv_t(bf16_t* dst, const float* src, int K, int N, int ldsrc, int Ndst) {
  GSTRIDE(i, (long)Ndst * K) { int n = (int)(i / K), k = (int)(i % K); dst[i] = n < N ? f2bf(src[(long)k * ldsrc + n]) : (bf16_t)0; }
}
__global__ void nk_conv_gu(bf16_t* dst, const float* wg, const float* wu) {
  GSTRIDE(i, (long)2 * FF * DM) { int j = (int)(i / DM), k = (int)(i % DM); int tile = j / 256, r = j % 256, f = tile * 128 + (r & 127);
    const float* s = (r < 128) ? wg : wu; dst[i] = f2bf(s[(long)k * FF + f]); }
}
__global__ void nk_mod(Params p) {
  float* mod = WSP(float, p, mod);
  GSTRIDE(i, (long)NLAYER * 3 * 6 * DM) { int j = (int)(i % (6 * DM)), r = (int)((i / (6 * DM)) % 3), l = (int)(i / (18 * DM));
    const float* cv = (r < 2) ? p.in[I_C] + (long)r * DM : p.in[I_CCTX]; const float* w = p.in[I_ADAW] + (long)l * DM * 6 * DM;
    float acc = 0.f; for (int k = 0; k < DM; ++k) acc += siluf_(cv[k]) * w[(long)k * 6 * DM + j];
    mod[i] = acc + p.in[I_ADAB][(long)l * 6 * DM + j]; }
}
__global__ void nk_rope_tab(Params p) {
  float* ta = WSP(float, p, rope_a); float* tb = WSP(float, p, rope_b);
  GSTRIDE(i, (long)GRIDW * (NROPE_A + NROPE_B)) { int pos = (int)(i / (NROPE_A + NROPE_B)), k = (int)(i % (NROPE_A + NROPE_B));
    if (k < NROPE_A) { float inv = powf(10000.f, -(float)k / NROPE_A), a = pos * inv; ta[(pos * NROPE_A + k) * 2] = cosf(a); ta[(pos * NROPE_A + k) * 2 + 1] = sinf(a); }
    else { int kk = k - NROPE_A; float inv = powf(10000.f, -(float)kk / NROPE_B), a = pos * inv; tb[(pos * NROPE_B + kk) * 2] = cosf(a); tb[(pos * NROPE_B + kk) * 2 + 1] = sinf(a); } }
}
constexpr int S5TW = 2 + 2 * S5CH;
__global__ void nk_s5tab(Params p) {
  float* tab = WSP(float, p, s5tab);
  GSTRIDE(i, (long)NLAYER * 2 * S5G * S5P) { int pp = (int)(i % S5P), g = (int)((i / S5P) % S5G), dir = (int)((i / (S5P * S5G)) % 2), l = (int)(i / (2 * S5P * S5G));
    const float a_re = p.in[dir ? I_S5AREB : I_S5AREF][(l * S5G + g) * S5P + pp], a_im = p.in[dir ? I_S5AIMB : I_S5AIMF][(l * S5G + g) * S5P + pp];
    const float dt = expf(p.in[dir ? I_S5DTB : I_S5DTF][l * S5G + g]);
    const float mag = expf(a_re * dt), ab_re = mag * cosf(a_im * dt), ab_im = mag * sinf(a_im * dt);
    const float den = a_re * a_re + a_im * a_im, nr = ab_re - 1.f, ni = ab_im;
    const float cr = (nr * a_re + ni * a_im) / den, ci = (ni * a_re - nr * a_im) / den;
    float* t = tab + i * S5TW; t[0] = ab_re; t[1] = ab_im;
    for (int c = 0; c < S5CH; ++c) { const float br = p.in[I_S5BRE][((l * S5G + g) * S5P + pp) * S5CH + c], bi = p.in[I_S5BIM][((l * S5G + g) * S5P + pp) * S5CH + c];
      t[2 + c] = cr * br - ci * bi; t[2 + S5CH + c] = cr * bi + ci * br; } }
}
__global__ void nk_load_x(Params p) {
  float* X2 = WSP(float, p, x2);
  GSTRIDE(i, (long)MROWS * DM) { int R = (int)(i / DM), d = (int)(i % DM), b = row_b(R), t = row_t(R);
    X2[i] = t < SEQ ? p.in[I_X][((long)b * SEQ + t) * DM + d] : p.in[I_CTX][((long)b * CTXL + (t - SEQ)) * DM + d]; }
}
__global__ void nk_ln_mod(Params p, bf16_t* H, const float* X, int l, int ch_sh, int ch_sc) {
  const float* mod = WSP(float, p, mod) + (long)l * 3 * 6 * DM;
  GSTRIDE(R, MROWS) { const float* x = X + R * DM; float s = 0.f; for (int d = 0; d < DM; ++d) s += x[d]; const float mean = s / DM;
    float v = 0.f; for (int d = 0; d < DM; ++d) { float c = x[d] - mean; v += c * c; } const float rs = 1.f / sqrtf(v / DM + NORM_EPS);
    const float* m = mod + (long)row_mod((int)R) * 6 * DM;
    for (int d = 0; d < DM; ++d) H[R * DM + d] = f2bf((x[d] - mean) * rs * (1.f + m[ch_sc * DM + d]) + m[ch_sh * DM + d]); }
}
template <class Epi> __global__ void nk_gemm(const bf16_t* A, long lda, const bf16_t* Bt, long ldb, int M, int N, int K, Epi epi) {
  GSTRIDE(i, (long)M * (N / 4)) { int m = (int)(i / (N / 4)), n = (int)(i % (N / 4)) * 4; float a0 = 0.f, a1 = 0.f, a2 = 0.f, a3 = 0.f;
    const bf16_t* ar = A + (long)m * lda; const bf16_t* b0 = Bt + (long)n * ldb;
    for (int k = 0; k < K; ++k) { const float a = bf2f(ar[k]); a0 += a * bf2f(b0[k]); a1 += a * bf2f(b0[ldb + k]); a2 += a * bf2f(b0[2 * ldb + k]); a3 += a * bf2f(b0[3 * ldb + k]); }
    epi(m, n, a0, a1, a2, a3); }
}
struct EpStoreBf16 { bf16_t* C; long ldc; __host__ __device__ void operator()(int m, int n, float a0, float a1, float a2, float a3) const {
  bf16_t* c = C + (long)m * ldc + n; c[0] = f2bf(a0); c[1] = f2bf(a1); c[2] = f2bf(a2); c[3] = f2bf(a3); } };
struct EpStoreF32 { float* C; long ldc; __host__ __device__ void operator()(int m, int n, float a0, float a1, float a2, float a3) const {
  float* c = C + (long)m * ldc + n; c[0] = a0; c[1] = a1; c[2] = a2; c[3] = a3; } };
struct EpKV { bf16_t* KM; bf16_t* VM; __host__ __device__ void operator()(int m, int n, float a0, float a1, float a2, float a3) const {
  const int h = n / (MNOPE + MV), r = n % (MNOPE + MV);
  bf16_t* c = (r < MNOPE) ? KM + (long)m * MH * MQK + h * MQK + r : VM + (long)m * MH * MV + h * MV + (r - MNOPE);
  c[0] = f2bf(a0); c[1] = f2bf(a1); c[2] = f2bf(a2); c[3] = f2bf(a3); } };
struct EpGlu { const bf16_t* Z; bf16_t* O; __host__ __device__ void operator()(int m, int n, float a0, float a1, float a2, float a3) const {
  const bf16_t* z = Z + (long)m * BW + n; bf16_t* o = O + (long)m * DM + n;
  o[0] = f2bf(bf2f(z[0]) * sigmoidf_(a0)); o[1] = f2bf(bf2f(z[1]) * sigmoidf_(a1)); o[2] = f2bf(bf2f(z[2]) * sigmoidf_(a2)); o[3] = f2bf(bf2f(z[3]) * sigmoidf_(a3)); } };
struct EpDown { const float* gate; bf16_t* Y; __host__ __device__ void operator()(int m, int n, float a0, float a1, float a2, float a3) const {
  const float g = gate[m]; bf16_t* y = Y + (long)m * DM + n; y[0] = f2bf(a0 * g); y[1] = f2bf(a1 * g); y[2] = f2bf(a2 * g); y[3] = f2bf(a3 * g); } };

__device__ __forceinline__ void rope_pair(bf16_t* x, int i1, int i2, float sc1, float sc2, bool rot, const float* cs) {
  const float c = rot ? cs[0] : 1.f, s = rot ? cs[1] : 0.f; const float a = bf2f(x[i1]) * sc1, b = bf2f(x[i2]) * sc2; x[i1] = f2bf(a * c - b * s); x[i2] = f2bf(a * s + b * c);
}
__global__ void nk_post_proj(Params p, int l) {
  bf16_t* P = WSP(bf16_t, p, regA); const float* ta = WSP(float, p, rope_a); const float* tb = WSP(float, p, rope_b);
  constexpr int NJ = GH + GKV + 2 * RH + 3;
  GSTRIDE(i, (long)MROWS * NJ) { const int R = (int)(i / NJ), j = (int)(i % NJ), t = row_t(R); const bool lat = t < SEQ; const int gr = lat ? t / GRIDW : 0, gc = lat ? t % GRIDW : 0;
    bf16_t* pr = P + (long)R * PW;
    if (j < GH + GKV) {
      bf16_t* x = pr + (j < GH ? OFF_GQ + j * GHD : OFF_GK + (j - GH) * GHD); const float* g = p.in[j < GH ? I_GQN : I_GKN] + l * GHD;
      float ss = 0.f; for (int d = 0; d < GHD; ++d) { float v = bf2f(x[d]); ss += v * v; } const float r = 1.f / sqrtf(ss / GHD + NORM_EPS);
      for (int hf = 0; hf < 2; ++hf) for (int k = 0; k < NROPE_A; ++k) { const int i1 = hf * 2 * NROPE_A + k, i2 = i1 + NROPE_A;
        rope_pair(x, i1, i2, r * g[i1], r * g[i2], lat, ta + ((hf ? gc : gr) * NROPE_A + k) * 2); }
    } else if (j < GH + GKV + 2 * RH) {
      const int jj = j - GH - GKV; const bool isk = jj >= RH; bf16_t* x = pr + (isk ? OFF_RK + (jj - RH) * RQK : OFF_RQ + jj * RQK); const float sc = isk ? 1.f / sqrtf((float)RQK) : 1.f;
      for (int hf = 0; hf < 2; ++hf) for (int k = 0; k < NROPE_B; ++k) { const int i1 = hf * 2 * NROPE_B + k, i2 = i1 + NROPE_B;
        rope_pair(x, i1, i2, sc, sc, lat, tb + ((hf ? gc : gr) * NROPE_B + k) * 2); }
    } else if (j == GH + GKV + 2 * RH) {
      bf16_t* x = pr + OFF_CQ; const float* g = p.in[I_MQN] + l * MQL; float ss = 0.f; for (int d = 0; d < MQL; ++d) { float v = bf2f(x[d]); ss += v * v; }
      const float r = 1.f / sqrtf(ss / MQL + NORM_EPS); for (int d = 0; d < MQL; ++d) x[d] = f2bf(bf2f(x[d]) * r * g[d]);
    } else if (j == GH + GKV + 2 * RH + 1) {
      bf16_t* x = pr + OFF_CKV; const float* g = p.in[I_MKVN] + l * MKVL; float ss = 0.f; for (int d = 0; d < MKVL; ++d) { float v = bf2f(x[d]); ss += v * v; }
      const float r = 1.f / sqrtf(ss / MKVL + NORM_EPS); for (int d = 0; d < MKVL; ++d) x[d] = f2bf(bf2f(x[d]) * r * g[d]);
    } else if (lat) {
      bf16_t* x = pr + OFF_KR;
      for (int hf = 0; hf < 2; ++hf) for (int k = 0; k < NROPE_B; ++k) { const int i1 = hf * 2 * NROPE_B + k, i2 = i1 + NROPE_B; rope_pair(x, i1, i2, 1.f, 1.f, true, tb + ((hf ? gc : gr) * NROPE_B + k) * 2); }
    } }
}
__global__ void nk_post_mla(Params p) {
  bf16_t* P = WSP(bf16_t, p, regA); bf16_t* QM = WSP(bf16_t, p, qm); bf16_t* KM = WSP(bf16_t, p, km); const float* tb = WSP(float, p, rope_b);
  GSTRIDE(i, (long)MROWS * MH) { const int R = (int)(i / MH), h = (int)(i % MH), t = row_t(R); const bool lat = t < SEQ;
    if (lat) { const int gr = t / GRIDW, gc = t % GRIDW; bf16_t* x = QM + (long)R * MH * MQK + h * MQK + MNOPE;
      for (int hf = 0; hf < 2; ++hf) for (int k = 0; k < NROPE_B; ++k) { const int i1 = hf * 2 * NROPE_B + k, i2 = i1 + NROPE_B; rope_pair(x, i1, i2, 1.f, 1.f, true, tb + ((hf ? gc : gr) * NROPE_B + k) * 2); } }
    for (int d = 0; d < MROPE; ++d) KM[(long)R * MH * MQK + h * MQK + MNOPE + d] = P[(long)R * PW + OFF_KR + d]; }
}
__global__ void nk_post_mla_q(Params p) {
  bf16_t* QM = WSP(bf16_t, p, qm); const float* tb = WSP(float, p, rope_b);
  GSTRIDE(i, (long)MROWS * MH) { const int R = (int)(i / MH), h = (int)(i % MH), t = row_t(R); const bool lat = t < SEQ;
    if (lat) { const int gr = t / GRIDW, gc = t % GRIDW; bf16_t* x = QM + (long)R * MH * MQK + h * MQK + MNOPE;
      for (int hf = 0; hf < 2; ++hf) for (int k = 0; k < NROPE_B; ++k) { const int i1 = hf * 2 * NROPE_B + k, i2 = i1 + NROPE_B; rope_pair(x, i1, i2, 1.f, 1.f, true, tb + ((hf ? gc : gr) * NROPE_B + k) * 2); } } }
}
__global__ void nk_s5_scan(Params p, int l) {
  const bf16_t* P = WSP(bf16_t, p, regA); float* HS = (float*)(p.ws + WS.regA + SZ_P); const float* tab = WSP(float, p, s5tab);
  GSTRIDE(i, (long)NB * S5G * S5P) { const int pp = (int)(i % S5P), g = (int)((i / S5P) % S5G), b = (int)(i / (S5P * S5G));
    for (int dir = 0; dir < 2; ++dir) { const float* t = tab + ((((long)l * 2 + dir) * S5G + g) * S5P + pp) * S5TW; const float are = t[0], aim = t[1]; float hr = 0.f, hi = 0.f;
      for (int s = 0; s < NTOK; ++s) {
        int tt; if (!dir) tt = s < CTXL ? SEQ + s : s - CTXL; else tt = s < CTXL ? SEQ + (CTXL - 1 - s) : SEQ - 1 - (s - CTXL);
        const long R = (long)b * NTOK + tt; const bf16_t* u = P + R * PW + OFF_U + g * S5CH; float br = 0.f, bi = 0.f;
        for (int c = 0; c < S5CH; ++c) { const float uv = bf2f(u[c]); br += uv * t[2 + c]; bi += uv * t[2 + S5CH + c]; }
        const float nr = are * hr - aim * hi + br, ni = are * hi + aim * hr + bi; hr = nr; hi = ni;
        float* hs = HS + ((R * S5G + g) * S5P + pp) * 2; if (!dir) { hs[0] = hr; hs[1] = hi; } else { hs[0] += hr; hs[1] += hi; } } } }
}
__global__ void nk_s5_read(Params p, int l) {
  const bf16_t* P = WSP(bf16_t, p, regA); const float* HS = (const float*)(p.ws + WS.regA + SZ_P); bf16_t* Z = WSP(bf16_t, p, z);
  GSTRIDE(i, (long)MROWS * BW) { const long R = i / BW; const int c = (int)(i % BW), g = c / S5CH, ci = c % S5CH;
    const float* hs = HS + (R * S5G + g) * S5P * 2; const float* cre = p.in[I_S5CRE] + (((long)l * S5G + g) * S5CH + ci) * S5P; const float* cim = p.in[I_S5CIM] + (((long)l * S5G + g) * S5CH + ci) * S5P;
    float y = 0.f; for (int pp = 0; pp < S5P; ++pp) y += hs[2 * pp] * cre[pp] - hs[2 * pp + 1] * cim[pp];
    y += p.in[I_S5D][l * BW + c] * bf2f(P[R * PW + OFF_U + c]); Z[i] = f2bf(gelu_tanh(y)); }
}
template <int DQK, int DV> __global__ void __launch_bounds__(256) nk_attn(const bf16_t* Q, const bf16_t* K, const bf16_t* V, bf16_t* O, int ldq, int ldk, int ldv, int ldo, int H, int group, float scale) {
  GSTRIDE(i, (long)MROWS * H) { const int R = (int)(i / H), h = (int)(i % H), b = row_b(R), kh = h / group; const bool lat = !row_is_ctx(R);
    const bf16_t* q = Q + (long)R * ldq + h * DQK; float o[DV]; _Pragma("unroll") for (int d = 0; d < DV; ++d) o[d] = 0.f; float m = -1e30f, lsum = 0.f;
    for (int kk = lat ? 0 : SEQ; kk < NTOK; ++kk) { const long KR = (long)b * NTOK + kk; const bf16_t* kp = K + KR * ldk + kh * DQK; float s = 0.f;
      for (int d = 0; d < DQK; ++d) s += bf2f(q[d]) * bf2f(kp[d]); s *= scale;
      if (s > m) { const float corr = expf(m - s); lsum *= corr; _Pragma("unroll") for (int d = 0; d < DV; ++d) o[d] *= corr; m = s; }
      const float pw = expf(s - m); lsum += pw; const bf16_t* vp = V + KR * ldv + kh * DV; _Pragma("unroll") for (int d = 0; d < DV; ++d) o[d] += pw * bf2f(vp[d]); }
    const float inv = 1.f / lsum; _Pragma("unroll") for (int d = 0; d < DV; ++d) O[(long)R * ldo + h * DV + d] = f2bf(o[d] * inv); }
}
__global__ void __launch_bounds__(256) nk_ret(Params p, int l) {
  const bf16_t* P = WSP(bf16_t, p, regA); bf16_t* O = WSP(bf16_t, p, oall);
  GSTRIDE(i, (long)MROWS * RH) { const int R = (int)(i / RH), h = (int)(i % RH), b = row_b(R), t = row_t(R); const bool lat = t < SEQ;
    const float lgf = -expf(p.in[I_RDF][l * RH + h]), lgb = -expf(p.in[I_RDB][l * RH + h]);
    const bf16_t* q = P + (long)R * PW + OFF_RQ + h * RQK; float o[RV]; _Pragma("unroll") for (int d = 0; d < RV; ++d) o[d] = 0.f;
    for (int kk = lat ? 0 : SEQ; kk < NTOK; ++kk) { float w;
      if (lat) { if (kk < SEQ) w = kk <= t ? expf(lgf * (float)(t - kk)) : expf(lgb * (float)(kk - t)); else { const int j = kk - SEQ; w = expf(lgf * (float)(t + CTXL - j)) + expf(lgb * (float)(SEQ - t + j)); } }
      else { const int j = t - SEQ, j2 = kk - SEQ; w = j2 <= j ? expf(lgf * (float)(j - j2)) : expf(lgb * (float)(j2 - j)); }
      const long KR = (long)b * NTOK + kk; const bf16_t* kp = P + KR * PW + OFF_RK + h * RQK; float s = 0.f; for (int d = 0; d < RQK; ++d) s += bf2f(q[d]) * bf2f(kp[d]); s *= w;
      const bf16_t* vp = P + KR * PW + OFF_RV + h * RV; _Pragma("unroll") for (int d = 0; d < RV; ++d) o[d] += s * bf2f(vp[d]); }
    float mean = 0.f; _Pragma("unroll") for (int d = 0; d < RV; ++d) mean += o[d]; mean /= RV; float var = 0.f; _Pragma("unroll") for (int d = 0; d < RV; ++d) { const float c = o[d] - mean; var += c * c; }
    const float rs = 1.f / sqrtf(var / RV + NORM_EPS); const bf16_t* gp = P + (long)R * PW + OFF_RG + h * RV; const float* gain = p.in[I_RNORM] + l * BW + h * RV;
    _Pragma("unroll") for (int d = 0; d < RV; ++d) O[(long)R * DM + 2 * BW + h * RV + d] = f2bf((o[d] - mean) * rs * gain[d] * siluf_(bf2f(gp[d]))); }
}
__global__ void nk_gate_merge(Params p, int l) {
  const bf16_t* H = WSP(bf16_t, p, h1); const bf16_t* Wg = WSP(bf16_t, p, wt_gate) + (long)l * 4 * DM * DM; const bf16_t* PROJ = (const bf16_t*)(p.ws + WS.regA + SZ_P); bf16_t* MG = WSP(bf16_t, p, merged);
  const float* bg = p.in[I_BGATE] + (long)l * 4 * DM;
  GSTRIDE(i, (long)MROWS * DM) { const long R = i / DM; const int d = (int)(i % DM); const bf16_t* hr = H + R * DM; float acc = 0.f;
    for (int k = 0; k < 4; ++k) { const bf16_t* w = Wg + ((long)k * DM + d) * DM; float s = 0.f; for (int c = 0; c < DM; ++c) s += bf2f(hr[c]) * bf2f(w[c]);
      acc += sigmoidf_(s + bg[k * DM + d]) * bf2f(PROJ[R * 4 * DM + k * DM + d]); }
    MG[i] = f2bf(acc); }
}
__global__ void nk_ln1(Params p, int l) {
  const float* X2 = WSP(float, p, x2); const float* Y = WSP(float, p, macc); float* X1 = WSP(float, p, x1); bf16_t* H2 = WSP(bf16_t, p, h2); float* AFF = WSP(float, p, aff);
  const float* mod = WSP(float, p, mod) + (long)l * 3 * 6 * DM; const float* lg = p.in[I_LN1G] + l * DM; const float* lb = p.in[I_LN1B] + l * DM; const float* rw = p.in[I_ROUTER] + (long)l * DM * NE;
  GSTRIDE(R, MROWS) { const float* m = mod + (long)row_mod((int)R) * 6 * DM; const float* x = X2 + R * DM; const float* y = Y + R * DM; float* x1 = X1 + R * DM;
    float s = 0.f; for (int d = 0; d < DM; ++d) { const float v = DN_ALPHA * x[d] + m[2 * DM + d] * y[d]; x1[d] = v; s += v; } float mean = s / DM;
    float var = 0.f; for (int d = 0; d < DM; ++d) { const float c = x1[d] - mean; var += c * c; } float rs = 1.f / sqrtf(var / DM + NORM_EPS);
    s = 0.f; for (int d = 0; d < DM; ++d) { const float v = (x1[d] - mean) * rs * lg[d] + lb[d]; x1[d] = v; s += v; } mean = s / DM;
    var = 0.f; for (int d = 0; d < DM; ++d) { const float c = x1[d] - mean; var += c * c; } rs = 1.f / sqrtf(var / DM + NORM_EPS);
    float lo[NE]; _Pragma("unroll") for (int e = 0; e < NE; ++e) lo[e] = 0.f;
    for (int d = 0; d < DM; ++d) { const float hv = (x1[d] - mean) * rs * (1.f + m[4 * DM + d]) + m[3 * DM + d]; H2[R * DM + d] = f2bf(hv); _Pragma("unroll") for (int e = 0; e < NE; ++e) lo[e] += hv * rw[(long)d * NE + e]; }
    float mx = lo[0]; _Pragma("unroll") for (int e = 1; e < NE; ++e) mx = fmaxf(mx, lo[e]); float se = 0.f; _Pragma("unroll") for (int e = 0; e < NE; ++e) { lo[e] = expf(lo[e] - mx); se += lo[e]; }
    _Pragma("unroll") for (int e = 0; e < NE; ++e) AFF[R * NE + e] = lo[e] / se; }
}
__global__ void nk_topk(Params p, int with_ctx) {
  const float* AFF = WSP(float, p, aff); int* SLOT = WSP(int, p, slot); float* GV = WSP(float, p, gatev); int* XSRC = WSP(int, p, xsrc);
  GSTRIDE(i, (long)MROWS * NE) { const int R = (int)(i / NE), e = (int)(i % NE), b = row_b(R), t = row_t(R); const bool lat = t < SEQ;
    if (!lat && !with_ctx) { SLOT[i] = -1; continue; }
    const int k0 = lat ? 0 : SEQ, k1 = lat ? SEQ : NTOK, cap = lat ? CAP_L : CAP_C; const float a = AFF[i]; int rank = 0;
    for (int kk = k0; kk < k1; ++kk) { const float o = AFF[((long)b * NTOK + kk) * NE + e]; rank += (o > a || (o == a && kk < t)) ? 1 : 0; }
    if (rank < cap) { const int xr = e * XEP + (lat ? b * CAP_L : 2 * CAP_L + b * CAP_C) + rank; SLOT[i] = xr; GV[xr] = a; XSRC[xr] = R; } else SLOT[i] = -1; }
}
__global__ void nk_gather(Params p) {
  const int* XSRC = WSP(int, p, xsrc); const bf16_t* H2 = WSP(bf16_t, p, h2); bf16_t* XS = WSP(bf16_t, p, regA);
  GSTRIDE(i, (long)XROWS * DM) { const long xr = i / DM; const int d = (int)(i % DM), src = XSRC[xr]; XS[i] = src >= 0 ? H2[(long)src * DM + d] : (bf16_t)0; }
}
__global__ void nk_moe_up(Params p, int l) {
  const bf16_t* XS = WSP(bf16_t, p, regA); bf16_t* ACT = (bf16_t*)(p.ws + WS.regA + SZ_XS); const bf16_t* W = WSP(bf16_t, p, wt_gu) + (long)l * NE * 2 * FF * DM; const int* XSRC = WSP(int, p, xsrc);
  GSTRIDE(i, (long)XROWS * FF) { const long xr = i / FF; const int f = (int)(i % FF), e = (int)(xr / XEP); if (XSRC[xr] < 0) { ACT[i] = 0; continue; }
    const int jg = (f / 128) * 256 + (f % 128), ju = jg + 128; const bf16_t* x = XS + xr * DM; const bf16_t* wg = W + ((long)e * 2 * FF + jg) * DM; const bf16_t* wu = W + ((long)e * 2 * FF + ju) * DM;
    float a = 0.f, u = 0.f; for (int k = 0; k < DM; ++k) { const float xv = bf2f(x[k]); a += xv * bf2f(wg[k]); u += xv * bf2f(wu[k]); }
    ACT[i] = f2bf(siluf_(a) * u); }
}
__global__ void nk_ln2(Params p, int l, int last) {
  const float* X1 = WSP(float, p, x1); float* X2 = WSP(float, p, x2); const int* SLOT = WSP(int, p, slot); const bf16_t* YS = (const bf16_t*)(p.ws + WS.regA + SZ_XS + SZ_ACT);
  const float* mod = WSP(float, p, mod) + (long)l * 3 * 6 * DM; const float* lg = p.in[I_LN2G] + l * DM; const float* lb = p.in[I_LN2B] + l * DM;
  GSTRIDE(R, MROWS) { if (last && row_is_ctx((int)R)) continue; const float* m = mod + (long)row_mod((int)R) * 6 * DM; const float* x1 = X1 + R * DM; float* x2 = X2 + R * DM;
    float s = 0.f; for (int d = 0; d < DM; ++d) { float mo = 0.f; for (int e = 0; e < NE; ++e) { const int sl = SLOT[R * NE + e]; if (sl >= 0) mo += bf2f(YS[(long)sl * DM + d]); }
      const float v = DN_ALPHA * x1[d] + m[5 * DM + d] * mo; x2[d] = v; s += v; } const float mean = s / DM;
    float var = 0.f; for (int d = 0; d < DM; ++d) { const float c = x2[d] - mean; var += c * c; } const float rs = 1.f / sqrtf(var / DM + NORM_EPS);
    for (int d = 0; d < DM; ++d) { const float v = (x2[d] - mean) * rs * lg[d] + lb[d]; x2[d] = v; if (last) p.out[((long)row_b((int)R) * SEQ + row_t((int)R)) * DM + d] = v; } }
}
#ifdef CPU_TEST
void cpu_hook(const char* name, int l, Params& p);
#define HOOK(name) cpu_hook(name, l, p)
#else
#define HOOK(name)
#endif
#define NG(n) (int)((((long)(n)) + 255) / 256 < 65536 ? (((long)(n)) + 255) / 256 : 65536)

static void naive_prologue(Params& p, hipStream_t stream) {
  for (int l = 0; l < NLAYER; ++l) {
    LAUNCH(nk_conv_t, NG((long)PW * DM), 256, WSP(bf16_t, p, wt_in) + (long)l * PW * DM, p.in[I_WIN] + (long)l * DM * IN_TOTAL, DM, IN_TOTAL, IN_TOTAL, PW);
    LAUNCH(nk_conv_t, NG((long)4 * DM * DM), 256, WSP(bf16_t, p, wt_gate) + (long)l * 4 * DM * DM, p.in[I_WGATE] + (long)l * DM * 4 * DM, DM, 4 * DM, 4 * DM, 4 * DM);
    for (int k = 0; k < 4; ++k)
      LAUNCH(nk_conv_t, NG((long)DM * BW), 256, WSP(bf16_t, p, wt_br) + ((long)l * 4 + k) * DM * BW, p.in[I_WBR] + ((long)l * 4 + k) * BW * DM, BW, DM, DM, DM);
    LAUNCH(nk_conv_t, NG((long)DM * DM), 256, WSP(bf16_t, p, wt_out) + (long)l * DM * DM, p.in[I_WOUT] + (long)l * DM * DM, DM, DM, DM, DM);
    LAUNCH(nk_conv_t, NG((long)BW * BW), 256, WSP(bf16_t, p, wt_glu) + (long)l * BW * BW, p.in[I_S5GLU] + (long)l * BW * BW, BW, BW, BW, BW);
    LAUNCH(nk_conv_t, NG((long)MH * MQK * MQL), 256, WSP(bf16_t, p, wt_uq) + (long)l * MH * MQK * MQL, p.in[I_WUQ] + (long)l * MQL * MH * MQK, MQL, MH * MQK, MH * MQK, MH * MQK);
    LAUNCH(nk_conv_t, NG((long)MH * (MNOPE + MV) * MKVL), 256, WSP(bf16_t, p, wt_ukv) + (long)l * MH * (MNOPE + MV) * MKVL, p.in[I_WUKV] + (long)l * MKVL * MH * (MNOPE + MV), MKVL, MH * (MNOPE + MV), MH * (MNOPE + MV), MH * (MNOPE + MV));
    for (int e = 0; e < NE; ++e) {
      LAUNCH(nk_conv_gu, NG((long)2 * FF * DM), 256, WSP(bf16_t, p, wt_gu) + ((long)l * NE + e) * 2 * FF * DM, p.in[I_MOEG] + ((long)l * NE + e) * DM * FF, p.in[I_MOEU] + ((long)l * NE + e) * DM * FF);
      LAUNCH(nk_conv_t, NG((long)DM * FF), 256, WSP(bf16_t, p, wt_dn) + ((long)l * NE + e) * DM * FF, p.in[I_MOED] + ((long)l * NE + e) * FF * DM, FF, DM, DM, DM);
    }
  }
  LAUNCH(nk_mod, NG((long)NLAYER * 18 * DM), 256, p);
  LAUNCH(nk_rope_tab, 4, 256, p);
  LAUNCH(nk_s5tab, NG((long)NLAYER * 2 * S5G * S5P), 256, p);
  LAUNCH(nk_load_x, NG((long)MROWS * DM), 256, p);
}

#ifdef CPU_TEST
static void naive_layer(Params& p, int l, hipStream_t stream) {
  bf16_t* P = WSP(bf16_t, p, regA); bf16_t* PROJ = (bf16_t*)(p.ws + WS.regA + SZ_P); bf16_t* H1 = WSP(bf16_t, p, h1);
  bf16_t* QM = WSP(bf16_t, p, qm); bf16_t* KM = WSP(bf16_t, p, km); bf16_t* VM = WSP(bf16_t, p, vm); bf16_t* Z = WSP(bf16_t, p, z); bf16_t* OA = WSP(bf16_t, p, oall);
  LAUNCH(nk_ln_mod, NG(MROWS), 256, p, H1, (const float*)WSP(float, p, x2), l, 0, 1);
  HOOK("h");
  LAUNCH(nk_gemm<EpStoreBf16>, NG((long)MROWS * PW / 4), 256, (const bf16_t*)H1, (long)DM, (const bf16_t*)(WSP(bf16_t, p, wt_in) + (long)l * PW * DM), (long)DM, MROWS, PW, DM, EpStoreBf16{P, PW});
  LAUNCH(nk_post_proj, NG((long)MROWS * 17), 256, p, l);
  LAUNCH(nk_gemm<EpStoreBf16>, NG((long)MROWS * MH * MQK / 4), 256, (const bf16_t*)(P + OFF_CQ), (long)PW, (const bf16_t*)(WSP(bf16_t, p, wt_uq) + (long)l * MH * MQK * MQL), (long)MQL, MROWS, MH * MQK, MQL, EpStoreBf16{QM, MH * MQK});
  LAUNCH(nk_gemm<EpKV>, NG((long)MROWS * MH * (MNOPE + MV) / 4), 256, (const bf16_t*)(P + OFF_CKV), (long)PW, (const bf16_t*)(WSP(bf16_t, p, wt_ukv) + (long)l * MH * (MNOPE + MV) * MKVL), (long)MKVL, MROWS, MH * (MNOPE + MV), MKVL, EpKV{KM, VM});
  LAUNCH(nk_post_mla, NG((long)MROWS * MH), 256, p);
  LAUNCH(nk_s5_scan, NG((long)NB * S5G * S5P), 256, p, l);
  LAUNCH(nk_s5_read, NG((long)MROWS * BW), 256, p, l);
  LAUNCH(nk_gemm<EpGlu>, NG((long)MROWS * BW / 4), 256, (const bf16_t*)Z, (long)BW, (const bf16_t*)(WSP(bf16_t, p, wt_glu) + (long)l * BW * BW), (long)BW, MROWS, BW, BW, EpGlu{Z, OA});
  HOOK("o_s5");
  LAUNCH((nk_attn<GHD, GHD>), NG((long)MROWS * GH), 256, (const bf16_t*)(P + OFF_GQ), (const bf16_t*)(P + OFF_GK), (const bf16_t*)(P + OFF_GV), OA + BW, PW, PW, PW, DM, GH, GH / GKV, 1.f / sqrtf((float)GHD));
  HOOK("o_gqa");
  LAUNCH(nk_ret, NG((long)MROWS * RH), 256, p, l);
  HOOK("o_ret");
  LAUNCH((nk_attn<MQK, MV>), NG((long)MROWS * MH), 256, (const bf16_t*)QM, (const bf16_t*)KM, (const bf16_t*)VM, OA + 3 * BW, MH * MQK, MH * MQK, MH * MV, DM, MH, 1, 1.f / sqrtf((float)MQK));
  HOOK("o_mla");
  for (int k = 0; k < 4; ++k)
    LAUNCH(nk_gemm<EpStoreBf16>, NG((long)MROWS * DM / 4), 256, (const bf16_t*)(OA + k * BW), (long)DM, (const bf16_t*)(WSP(bf16_t, p, wt_br) + ((long)l * 4 + k) * DM * BW), (long)BW, MROWS, DM, BW, EpStoreBf16{PROJ + (long)k * DM, 4 * DM});
  LAUNCH(nk_gate_merge, NG((long)MROWS * DM), 256, p, l);
  LAUNCH(nk_gemm<EpStoreF32>, NG((long)MROWS * DM / 4), 256, (const bf16_t*)WSP(bf16_t, p, merged), (long)DM, (const bf16_t*)(WSP(bf16_t, p, wt_out) + (long)l * DM * DM), (long)DM, MROWS, DM, DM, EpStoreF32{WSP(float, p, macc), DM});
  HOOK("y");
  LAUNCH(nk_ln1, NG(MROWS), 256, p, l);
  HOOK("x1");
  hipMemsetAsync(p.ws + WS.xsrc, 0xFF, (size_t)XROWS * 4, stream);
  LAUNCH(nk_topk, NG((long)MROWS * NE), 256, p, l == 0 ? 1 : 0);
  LAUNCH(nk_gather, NG((long)XROWS * DM), 256, p);
  LAUNCH(nk_moe_up, NG((long)XROWS * FF), 256, p, l);
  bf16_t* ACT = (bf16_t*)(p.ws + WS.regA + SZ_XS); bf16_t* YS = (bf16_t*)(p.ws + WS.regA + SZ_XS + SZ_ACT);
  for (int e = 0; e < NE; ++e)
    LAUNCH(nk_gemm<EpDown>, NG((long)XEP * DM / 4), 256, (const bf16_t*)(ACT + (long)e * XEP * FF), (long)FF, (const bf16_t*)(WSP(bf16_t, p, wt_dn) + ((long)l * NE + e) * DM * FF), (long)FF, XEP, DM, FF,
           EpDown{WSP(float, p, gatev) + e * XEP, YS + (long)e * XEP * DM});
  LAUNCH(nk_ln2, NG(MROWS), 256, p, l, l == NLAYER - 1 ? 1 : 0);
  HOOK("x2");
}
#endif
#ifndef CPU_TEST
namespace pg8 {
#define PG8_LAS __attribute__((address_space(3)))
typedef short bf16x8 __attribute__((ext_vector_type(8)));
typedef float f32x4 __attribute__((ext_vector_type(4)));
typedef unsigned u32x4 __attribute__((ext_vector_type(4)));
constexpr int BM = 256, BK = 64, HALF = 128, HTB = HALF * BK * 2, STAGE_BYTES = 8 * HTB, NXCD = 8, WGM = 8;
__host__ __device__ __forceinline__ int lds_byte(int r, int c) { const int st = (r >> 4) * 2 + (c >> 5), rr = r & 15, cc = c & 31, ob = rr * 64 + cc * 2; return st * 1024 + (ob ^ (((ob >> 9) & 1) << 5)); }
__host__ __device__ __forceinline__ void stage_rc(int b, int& R, int& C) { const int st = b / 1024, sb = b % 1024, swz = sb ^ (((sb >> 9) & 1) << 5); R = (st >> 1) * 16 + swz / 64; C = (st & 1) * 32 + (swz % 64) / 2; }
__host__ __device__ __forceinline__ int perm32(int rho) { const int n = rho >> 4, i = rho & 15; return 8 * (i >> 2) + 4 * n + (i & 3); }

struct Unit { int pm, pn, aux; const char* A; const char* B; };
struct GemmG { int lda, ldb, K, pad; };

__device__ __forceinline__ bool tile_order(long L, int nM, int nN, int& pm, int& pn) {
  const int nwg = nM * nN; if (L >= nwg) return false;
  int wgid = (int)L; { const int q = nwg / NXCD, r = nwg % NXCD, xcd = wgid % NXCD, off = wgid / NXCD; wgid = (xcd < r ? xcd * (q + 1) : r * (q + 1) + (xcd - r) * q) + off; }
  const int nig = WGM * nN, gid = wgid / nig, fm = gid * WGM, gsz = (nM - fm) < WGM ? (nM - fm) : WGM;
  pm = fm + ((wgid % nig) % gsz); pn = (wgid % nig) / gsz; return true;
}
__device__ __forceinline__ unsigned cvt_pk_bf16(float lo, float hi) { unsigned r; asm volatile("v_cvt_pk_bf16_f32 %0, %1, %2" : "=v"(r) : "v"(lo), "v"(hi)); return r; }
__device__ __forceinline__ u32x4 pack8(const f32x4 a, const f32x4 b) { u32x4 w; w.x = cvt_pk_bf16(a[0], a[1]); w.y = cvt_pk_bf16(a[2], a[3]); w.z = cvt_pk_bf16(b[0], b[1]); w.w = cvt_pk_bf16(b[2], b[3]); return w; }
__device__ __forceinline__ void unpack8(const u32x4 w, f32x4& a, f32x4& b) {
  a[0] = __uint_as_float(w.x << 16); a[1] = __uint_as_float(w.x & 0xffff0000u); a[2] = __uint_as_float(w.y << 16); a[3] = __uint_as_float(w.y & 0xffff0000u);
  b[0] = __uint_as_float(w.z << 16); b[1] = __uint_as_float(w.z & 0xffff0000u); b[2] = __uint_as_float(w.w << 16); b[3] = __uint_as_float(w.w & 0xffff0000u); }
__device__ __forceinline__ float fast_sigmoid(float x) { return __builtin_amdgcn_rcpf(1.f + __builtin_amdgcn_exp2f(-1.4426950408889634f * x)); }
__device__ __forceinline__ f32x4 sigmoid4(f32x4 v) { f32x4 o; o[0] = fast_sigmoid(v[0]); o[1] = fast_sigmoid(v[1]); o[2] = fast_sigmoid(v[2]); o[3] = fast_sigmoid(v[3]); return o; }

template <class Epi, class Sched>
__device__ __forceinline__ void gemm_phase(PG8_LAS unsigned char* lds, const GemmG g, const Sched& S, const Epi& E) {
    const int tid = threadIdx.x, wid = __builtin_amdgcn_readfirstlane(tid >> 6), lane = tid & 63, wr = wid >> 2, wc = wid & 3, fr = lane & 15, fq = lane >> 4;
    const int K = g.K, nt = K / BK;
    unsigned voffA[2], voffB[2];
#pragma unroll
    for (int i = 0; i < 2; ++i) { int R, C; stage_rc(tid * 16 + i * 8192, R, C); const int Rb = (R & ~31) + perm32(R & 31);
        voffA[i] = (unsigned)(R * g.lda + C) * 2u; voffB[i] = (unsigned)(Rb * g.ldb + C) * 2u; }
    const size_t kstep = (size_t)(BK * 2);
    const size_t hsA = (size_t)HALF * g.lda * 2, hsB = (size_t)HALF * g.ldb * 2;
    const unsigned ldsw = (unsigned)wid * 1024u;
    const int aoff = lds_byte(wr * 64 + fr, fq * 8), boff = lds_byte(wc * 32 + fr, fq * 8);
#define PG8_SA(b, h) (((b) * 2 + (h)) * HTB)
#define PG8_SB(b, h) ((4 + (b) * 2 + (h)) * HTB)
#define PG8_STAGE(bufoff, gbase, voff) do { _Pragma("unroll") for (int _i = 0; _i < 2; ++_i) \
        __builtin_amdgcn_global_load_lds((const unsigned*)((const char*)(gbase) + (voff)[_i]), (PG8_LAS unsigned*)(lds + (bufoff) + ldsw + _i * 8192), 16, 0, 0); } while (0)
#define PG8_LDA(dst, b, h) do { _Pragma("unroll") for (int m = 0; m < 4; ++m) _Pragma("unroll") for (int k = 0; k < 2; ++k) dst[m][k] = *(const PG8_LAS bf16x8*)(lds + PG8_SA(b, h) + aoff + m * 2048 + k * 1024); } while (0)
#define PG8_LDB(dst, b, h) do { _Pragma("unroll") for (int n = 0; n < 2; ++n) _Pragma("unroll") for (int k = 0; k < 2; ++k) dst[n][k] = *(const PG8_LAS bf16x8*)(lds + PG8_SB(b, h) + boff + n * 2048 + k * 1024); } while (0)
#define PG8_MMA(ai, bj, At, Bt) do { __builtin_amdgcn_s_setprio(1); _Pragma("unroll") for (int m = 0; m < 4; ++m) _Pragma("unroll") for (int n = 0; n < 2; ++n) _Pragma("unroll") for (int k = 0; k < 2; ++k) \
        acc[ai][bj][m][n] = __builtin_amdgcn_mfma_f32_16x16x32_bf16(Bt[n][k], At[m][k], acc[ai][bj][m][n], 0, 0, 0); __builtin_amdgcn_s_setprio(0); } while (0)
#define PG8_WAIT_V(n) asm volatile("s_waitcnt vmcnt(" #n ")" ::: "memory")
#define PG8_WAIT_L(n) asm volatile("s_waitcnt lgkmcnt(" #n ")" ::: "memory")
#define PG8_BAR __builtin_amdgcn_s_barrier()
#define PG8_SCHED __builtin_amdgcn_sched_barrier(0)
    Unit cur, nxt; int ui = 0;
    if (!S.next(0, cur)) return;
    f32x4 acc[2][2][4][2];
#pragma unroll
    for (int a = 0; a < 2; ++a)
#pragma unroll
        for (int b = 0; b < 2; ++b)
#pragma unroll
            for (int m = 0; m < 4; ++m)
#pragma unroll
                for (int n = 0; n < 2; ++n) acc[a][b][m][n] = (f32x4){0.f, 0.f, 0.f, 0.f};
    bf16x8 At[4][2], B0[2][2], B1[2][2];
    const char* cA = cur.A; const char* cB = cur.B;
    PG8_STAGE(PG8_SB(0, 0), cB, voffB); PG8_STAGE(PG8_SA(0, 0), cA, voffA); PG8_STAGE(PG8_SB(0, 1), cB + hsB, voffB); PG8_STAGE(PG8_SA(0, 1), cA + hsA, voffA);
    if (wr == 1) PG8_BAR;
    PG8_WAIT_V(4); PG8_BAR;
    PG8_STAGE(PG8_SB(1, 0), cB + kstep, voffB); PG8_STAGE(PG8_SA(1, 0), cA + kstep, voffA); PG8_STAGE(PG8_SB(1, 1), cB + hsB + kstep, voffB);
    PG8_WAIT_V(6); PG8_BAR;
    for (;;) {
        const bool has_next = S.next(ui + 1, nxt);
        const char* nA = has_next ? nxt.A : cA; const char* nB = has_next ? nxt.B : cB;
        for (int t = 0; t < nt; t += 2) {
            const bool last = (t == nt - 2);
            const char* a1 = cA + (size_t)(t + 1) * kstep;
            const char* a2 = last ? nA : cA + (size_t)(t + 2) * kstep; const char* b2 = last ? nB : cB + (size_t)(t + 2) * kstep;
            const char* a3 = a2 + kstep; const char* b3 = b2 + kstep;
            PG8_LDB(B0, 0, 0); PG8_SCHED; PG8_LDA(At, 0, 0); PG8_STAGE(PG8_SA(1, 1), a1 + hsA, voffA);
            PG8_WAIT_L(8); PG8_BAR; PG8_WAIT_L(0); PG8_MMA(0, 0, At, B0); PG8_BAR; PG8_SCHED;
            PG8_LDB(B1, 0, 1); PG8_STAGE(PG8_SB(0, 0), b2, voffB);
            PG8_BAR; PG8_WAIT_L(0); PG8_MMA(0, 1, At, B1); PG8_BAR;
            PG8_LDA(At, 0, 1); PG8_STAGE(PG8_SA(0, 0), a2, voffA);
            PG8_BAR; PG8_WAIT_L(0); PG8_MMA(1, 0, At, B0); PG8_BAR; PG8_SCHED;
            PG8_STAGE(PG8_SB(0, 1), b2 + hsB, voffB);
            PG8_WAIT_V(6); PG8_BAR; PG8_MMA(1, 1, At, B1); PG8_BAR;
            PG8_LDB(B0, 1, 0); PG8_SCHED; PG8_LDA(At, 1, 0); PG8_STAGE(PG8_SA(0, 1), a2 + hsA, voffA);
            PG8_WAIT_L(8); PG8_BAR; PG8_WAIT_L(0); PG8_MMA(0, 0, At, B0); PG8_BAR; PG8_SCHED;
            PG8_LDB(B1, 1, 1); PG8_STAGE(PG8_SB(1, 0), b3, voffB);
            PG8_BAR; PG8_WAIT_L(0); PG8_MMA(0, 1, At, B1); PG8_BAR;
            PG8_LDA(At, 1, 1); PG8_STAGE(PG8_SA(1, 0), a3, voffA);
            PG8_BAR; PG8_WAIT_L(0); PG8_MMA(1, 0, At, B0); PG8_BAR; PG8_SCHED;
            PG8_STAGE(PG8_SB(1, 1), b3 + hsB, voffB);
            PG8_WAIT_V(6); PG8_BAR; PG8_MMA(1, 1, At, B1); PG8_BAR;
        }
        E(acc, cur, wr, wc, fr, fq);
        if (!has_next) break;
#pragma unroll
        for (int a = 0; a < 2; ++a)
#pragma unroll
            for (int b = 0; b < 2; ++b)
#pragma unroll
                for (int m = 0; m < 4; ++m)
#pragma unroll
                    for (int n = 0; n < 2; ++n) acc[a][b][m][n] = (f32x4){0.f, 0.f, 0.f, 0.f};
        cur = nxt; cA = nA; cB = nB; ++ui;
    }
    PG8_WAIT_V(0);
    if (wr == 0) PG8_BAR;
    PG8_BAR;
#undef PG8_SA
#undef PG8_SB
#undef PG8_STAGE
#undef PG8_LDA
#undef PG8_LDB
#undef PG8_MMA
#undef PG8_WAIT_V
#undef PG8_WAIT_L
#undef PG8_BAR
#undef PG8_SCHED
}

struct SchedGrid {
  const char* A; const char* B; int lda, ldb, nM, nN, skip_ctx, G, c, pad;
  __device__ __forceinline__ bool next(int i, Unit& u) const {
    int pm, pn; if (!tile_order((long)i * G + c, nM, nN, pm, pn)) return false;
    if (skip_ctx && pm >= NTOK / 256 - 1) pm += 1;
    u.pm = pm; u.pn = pn; u.aux = 0; u.A = A + (size_t)pm * BM * lda * 2; u.B = B + (size_t)pn * BM * ldb * 2; return true; }
};
struct SchedProj {
  const char* OA; const char* B; int nM, skip_ctx, G, c;
  __device__ __forceinline__ bool next(int i, Unit& u) const {
    int pm, pn; if (!tile_order((long)i * G + c, nM, 4 * DM / 256, pm, pn)) return false;
    if (skip_ctx && pm >= NTOK / 256 - 1) pm += 1;
    const int k = pn / (DM / 256);
    u.pm = pm; u.pn = pn; u.aux = k; u.A = OA + ((size_t)pm * BM * DM + (size_t)k * BW) * 2; u.B = B + (size_t)pn * BM * BW * 2; return true; }
};
struct SchedGate {
  const char* H; const char* B; int nM, skip_ctx, G, c;
  __device__ __forceinline__ bool next(int i, Unit& u) const {
    const int j = i >> 2, k = i & 3; int pm, pd; if (!tile_order((long)j * G + c, nM, DM / 256, pm, pd)) return false;
    if (skip_ctx && pm >= NTOK / 256 - 1) pm += 1;
    u.pm = pm; u.pn = pd; u.aux = k; u.A = H + (size_t)pm * BM * DM * 2; u.B = B + ((size_t)k * DM + (size_t)pd * BM) * DM * 2; return true; }
};
struct SchedMoe {
  const char* A; const char* B; int lda, ldb, nMl, nN; size_t wstride; int G, c;
  __device__ __forceinline__ bool next(int i, Unit& u) const {
    const long L = (long)i * G + c; if (L >= (long)NE * nMl * nN) return false;
    const int e = (int)(L / (nMl * nN)), rem = (int)(L % (nMl * nN)), pn = rem / nMl, pml = rem % nMl;
    u.pm = e * (XEP / 256) + pml; u.pn = pn; u.aux = e; u.A = A + (size_t)u.pm * BM * lda * 2; u.B = B + (size_t)e * wstride + (size_t)pn * BM * ldb * 2; return true; }
};

#define EPI_LOOP(...) _Pragma("unroll") for (int ai = 0; ai < 2; ++ai) _Pragma("unroll") for (int m = 0; m < 4; ++m) { const int trow = ai * HALF + wr * 64 + m * 16 + fr; \
    _Pragma("unroll") for (int bj = 0; bj < 2; ++bj) { const int tcol = bj * HALF + wc * 32 + 8 * fq; const f32x4 v0 = acc[ai][bj][m][0], v1 = acc[ai][bj][m][1]; __VA_ARGS__ } }
typedef f32x4 AccT[2][2][4][2];
struct EpiBf16 { bf16_t* O; int ldc, pad;
  __device__ __forceinline__ void operator()(const AccT& acc, const Unit& u, int wr, int wc, int fr, int fq) const {
    bf16_t* base = O + (size_t)u.pm * BM * ldc + (size_t)u.pn * BM;
    EPI_LOOP(*(u32x4*)(base + (size_t)trow * ldc + tcol) = pack8(v0, v1);) } };
struct EpiF32 { float* O; int ldc, pad;
  __device__ __forceinline__ void operator()(const AccT& acc, const Unit& u, int wr, int wc, int fr, int fq) const {
    float* base = O + (size_t)u.pm * BM * ldc + (size_t)u.pn * BM;
    EPI_LOOP(float* q = base + (size_t)trow * ldc + tcol; *(f32x4*)q = v0; *(f32x4*)(q + 4) = v1;) } };
struct EpiKVm { bf16_t* KM; bf16_t* VM;
  __device__ __forceinline__ void operator()(const AccT& acc, const Unit& u, int wr, int wc, int fr, int fq) const {
    EPI_LOOP(const size_t row = (size_t)u.pm * BM + trow; bf16_t* q = (bj == 0) ? KM + row * (MH * MQK) + u.pn * MQK + (tcol) : VM + row * (MH * MV) + u.pn * MV + (tcol - HALF);
             *(u32x4*)q = pack8(v0, v1);) } };
struct EpiGluO { const bf16_t* Z; bf16_t* O;
  __device__ __forceinline__ void operator()(const AccT& acc, const Unit& u, int wr, int wc, int fr, int fq) const {
    EPI_LOOP(const size_t row = (size_t)u.pm * BM + trow; const int col = u.pn * BM + tcol; f32x4 z0, z1; unpack8(*(const u32x4*)(Z + row * BW + col), z0, z1);
             *(u32x4*)(O + row * DM + col) = pack8(z0 * sigmoid4(v0), z1 * sigmoid4(v1));) } };
struct EpiGateMerge { const float* bg; const bf16_t* PROJ; float* MACC; bf16_t* MG;
  __device__ __forceinline__ void operator()(const AccT& acc, const Unit& u, int wr, int wc, int fr, int fq) const {
    const int k = u.aux;
    EPI_LOOP(const size_t row = (size_t)u.pm * BM + trow; const int d = u.pn * BM + tcol; const float* bp = bg + k * DM + d; f32x4 p0, p1; unpack8(*(const u32x4*)(PROJ + row * (4 * DM) + k * DM + d), p0, p1);
             f32x4 r0 = sigmoid4(v0 + *(const f32x4*)bp) * p0, r1 = sigmoid4(v1 + *(const f32x4*)(bp + 4)) * p1; float* mp = MACC + row * DM + d;
             if (k > 0) { r0 += *(const f32x4*)mp; r1 += *(const f32x4*)(mp + 4); }
             if (k < 3) { *(f32x4*)mp = r0; *(f32x4*)(mp + 4) = r1; } else *(u32x4*)(MG + row * DM + d) = pack8(r0, r1);) } };
struct EpiSwiGlu { bf16_t* ACT;
  __device__ __forceinline__ void operator()(const AccT& acc, const Unit& u, int wr, int wc, int fr, int fq) const {
#pragma unroll
    for (int ai = 0; ai < 2; ++ai)
#pragma unroll
      for (int m = 0; m < 4; ++m) { const size_t row = (size_t)u.pm * BM + ai * HALF + wr * 64 + m * 16 + fr; const int col = u.pn * HALF + wc * 32 + 8 * fq;
        const f32x4 g0 = acc[ai][0][m][0], g1 = acc[ai][0][m][1], u0 = acc[ai][1][m][0], u1 = acc[ai][1][m][1];
        *(u32x4*)(ACT + row * FF + col) = pack8(g0 * sigmoid4(g0) * u0, g1 * sigmoid4(g1) * u1); } } };
struct EpiDownG { const float* GV; bf16_t* YS;
  __device__ __forceinline__ void operator()(const AccT& acc, const Unit& u, int wr, int wc, int fr, int fq) const {
    EPI_LOOP(const size_t row = (size_t)u.pm * BM + trow; const float gv = GV[row]; *(u32x4*)(YS + row * DM + u.pn * BM + tcol) = pack8(v0 * gv, v1 * gv);) } };

struct SchedS5 { const char* UH; const char* W; size_t wstride; int G, c;
  __device__ __forceinline__ bool next(int i, Unit& u) const {
    const long L = (long)i * G + c; if (L >= (long)S5G * (S5NP / 256)) return false; const int g = (int)(L / (S5NP / 256)), pm = (int)(L % (S5NP / 256));
    u.pm = pm; u.pn = 0; u.aux = g; u.A = UH + ((size_t)g * S5NP + (size_t)pm * BM) * (S5K1 + S5K2) * 2; u.B = W + (size_t)g * wstride; return true; }
};
struct EpiS5E { float* E;
  __device__ __forceinline__ void operator()(const AccT& acc, const Unit& u, int wr, int wc, int fr, int fq) const {
    float* base = E + ((size_t)u.aux * S5NP + (size_t)u.pm * BM) * S5K2;
    EPI_LOOP(float* q = base + (size_t)trow * S5K2 + tcol; *(f32x4*)q = v0; *(f32x4*)(q + 4) = v1;) } };
__device__ __forceinline__ float fast_gelu_tanh(float x) { const float t = 0.7978845608028654f * (x + 0.044715f * x * x * x); const float e = __builtin_amdgcn_exp2f(2.885390081777927f * t);
  return 0.5f * x * (2.f - 2.f * __builtin_amdgcn_rcpf(e + 1.f)); }
struct EpiS5Y { const bf16_t* P; const float* D; bf16_t* Z; int last, pad;
  __device__ __forceinline__ void operator()(const AccT& acc, const Unit& u, int wr, int wc, int fr, int fq) const {
    const int g = u.aux;
    EPI_LOOP(const int n = u.pm * BM + trow; const int b = n / S5NC, j = n % S5NC; if (n < S5NN && !(last && j >= SEQ / S5LC)) { const int a = tcol >> 4, i0 = tcol & 15; const size_t R = (size_t)b * NTOK + j * S5LC + a;
        f32x4 u0, u1; unpack8(*(const u32x4*)(P + R * PW + OFF_U + g * S5CH + i0), u0, u1); const float* dp = D + g * S5CH + i0; f32x4 y0 = v0 + *(const f32x4*)dp * u0, y1 = v1 + *(const f32x4*)(dp + 4) * u1;
        _Pragma("unroll") for (int q = 0; q < 4; ++q) { y0[q] = fast_gelu_tanh(y0[q]); y1[q] = fast_gelu_tanh(y1[q]); }
        *(u32x4*)(Z + R * BW + g * S5CH + i0) = pack8(y0, y1); }) } };
}

template <class Epi, class Sched> __global__ __launch_bounds__(512, 2) void k_gemm_phase(pg8::GemmG g, Sched S, Epi E) {
  extern __shared__ __attribute__((aligned(16))) unsigned char shm[];
  S.G = gridDim.x; S.c = blockIdx.x;
  pg8::gemm_phase<Epi, Sched>((PG8_LAS unsigned char*)shm, g, S, E);
}
#endif
#ifndef CPU_TEST
namespace ph {
using pg8::f32x4; using pg8::u32x4; using pg8::pack8; using pg8::unpack8;
#define LAS __attribute__((address_space(3)))
__device__ __forceinline__ float wave_sum(float v) { v += __shfl_xor(v, 32); v += __shfl_xor(v, 16); v += __shfl_xor(v, 8); v += __shfl_xor(v, 4); v += __shfl_xor(v, 2); v += __shfl_xor(v, 1); return v; }
__device__ __forceinline__ float wave_max(float v) { v = fmaxf(v, __shfl_xor(v, 32)); v = fmaxf(v, __shfl_xor(v, 16)); v = fmaxf(v, __shfl_xor(v, 8)); v = fmaxf(v, __shfl_xor(v, 4)); v = fmaxf(v, __shfl_xor(v, 2)); v = fmaxf(v, __shfl_xor(v, 1)); return v; }
__device__ __forceinline__ float sum8(const f32x4& a, const f32x4& b) { return ((a[0] + a[1]) + (a[2] + a[3])) + ((b[0] + b[1]) + (b[2] + b[3])); }
__device__ __forceinline__ const float* resid_row(const Params& p, int l, int R) {
  if (l == 0) { const int b = row_b(R), t = row_t(R); return t < SEQ ? p.in[I_X] + ((long)b * SEQ + t) * DM : p.in[I_CTX] + ((long)b * CTXL + (t - SEQ)) * DM; }
  return WSP(float, p, x2) + (long)R * DM;
}
constexpr int NCH = DM / 512;
static_assert(DM % 512 == 0, "row chunking");
struct RowV { f32x4 a[NCH], b[NCH]; };
__device__ __forceinline__ void row_load(RowV& v, const float* x, int lane) {
#pragma unroll
  for (int c = 0; c < NCH; ++c) { const float* q = x + c * 512 + lane * 8; v.a[c] = *(const f32x4*)q; v.b[c] = *(const f32x4*)(q + 4); } }
__device__ __forceinline__ void row_store(const RowV& v, float* x, int lane) {
#pragma unroll
  for (int c = 0; c < NCH; ++c) { float* q = x + c * 512 + lane * 8; *(f32x4*)q = v.a[c]; *(f32x4*)(q + 4) = v.b[c]; } }
__device__ __forceinline__ void row_stats(const RowV& v, float& mean, float& rstd) {
  float s = 0.f;
#pragma unroll
  for (int c = 0; c < NCH; ++c) s += sum8(v.a[c], v.b[c]);
  mean = wave_sum(s) * (1.f / DM); float q = 0.f;
#pragma unroll
  for (int c = 0; c < NCH; ++c) { const f32x4 da = v.a[c] - mean, db = v.b[c] - mean; q += sum8(da * da, db * db); }
  rstd = 1.f / sqrtf(wave_sum(q) * (1.f / DM) + NORM_EPS);
}
__device__ __forceinline__ void row_modulate_store(const RowV& v, float mean, float rstd, const float* sh, const float* sc, bf16_t* H, int lane) {
#pragma unroll
  for (int c = 0; c < NCH; ++c) { const int o = c * 512 + lane * 8; const f32x4 s0 = *(const f32x4*)(sc + o), s1 = *(const f32x4*)(sc + o + 4), h0 = *(const f32x4*)(sh + o), h1 = *(const f32x4*)(sh + o + 4);
    *(u32x4*)(H + o) = pack8((v.a[c] - mean) * rstd * (1.f + s0) + h0, (v.b[c] - mean) * rstd * (1.f + s1) + h1); } }

__device__ __forceinline__ void ph_ln_in(const Params& p, int l) {
  const int lane = threadIdx.x & 63, wv = threadIdx.x >> 6; const float* mod = WSP(float, p, mod) + (long)l * 18 * DM; bf16_t* H1 = WSP(bf16_t, p, h1);
  for (int R = blockIdx.x * 8 + wv; R < MROWS; R += gridDim.x * 8) { RowV v; row_load(v, resid_row(p, l, R), lane); float mean, rstd; row_stats(v, mean, rstd);
    const float* m = mod + (long)row_mod(R) * 6 * DM; row_modulate_store(v, mean, rstd, m, m + DM, H1 + (long)R * DM, lane); }
}
__device__ __forceinline__ void ph_ln1(const Params& p, int l, LAS unsigned char* lds) {
  const int lane = threadIdx.x & 63, wv = threadIdx.x >> 6; const float* mod = WSP(float, p, mod) + (long)l * 18 * DM; const int last = (l == NLAYER - 1);
  LAS float* rwt = (LAS float*)lds;
  { const float* rw = p.in[I_ROUTER] + (long)l * DM * NE; for (int i = threadIdx.x; i < DM * NE; i += 512) { const int d = i / NE, e = i % NE; rwt[e * DM + d] = rw[i]; } }
  __syncthreads();
  const float* Y = WSP(float, p, macc); float* X1 = WSP(float, p, x1); bf16_t* H2 = WSP(bf16_t, p, h2); float* AFF = WSP(float, p, aff);
  const float* lg = p.in[I_LN1G] + l * DM; const float* lb = p.in[I_LN1B] + l * DM;
  for (int R = blockIdx.x * 8 + wv; R < MROWS; R += gridDim.x * 8) { if (last && row_is_ctx(R)) continue;
    const float* m = mod + (long)row_mod(R) * 6 * DM; RowV v, y; row_load(v, resid_row(p, l, R), lane); row_load(y, Y + (long)R * DM, lane);
#pragma unroll
    for (int c = 0; c < NCH; ++c) { const int o = c * 512 + lane * 8; v.a[c] = DN_ALPHA * v.a[c] + *(const f32x4*)(m + 2 * DM + o) * y.a[c]; v.b[c] = DN_ALPHA * v.b[c] + *(const f32x4*)(m + 2 * DM + o + 4) * y.b[c]; }
    float mean, rstd; row_stats(v, mean, rstd);
#pragma unroll
    for (int c = 0; c < NCH; ++c) { const int o = c * 512 + lane * 8; v.a[c] = (v.a[c] - mean) * rstd * *(const f32x4*)(lg + o) + *(const f32x4*)(lb + o); v.b[c] = (v.b[c] - mean) * rstd * *(const f32x4*)(lg + o + 4) + *(const f32x4*)(lb + o + 4); }
    row_store(v, X1 + (long)R * DM, lane);
    row_stats(v, mean, rstd);
#pragma unroll
    for (int c = 0; c < NCH; ++c) { const int o = c * 512 + lane * 8; v.a[c] = (v.a[c] - mean) * rstd * (1.f + *(const f32x4*)(m + 4 * DM + o)) + *(const f32x4*)(m + 3 * DM + o);
      v.b[c] = (v.b[c] - mean) * rstd * (1.f + *(const f32x4*)(m + 4 * DM + o + 4)) + *(const f32x4*)(m + 3 * DM + o + 4); *(u32x4*)(H2 + (long)R * DM + o) = pack8(v.a[c], v.b[c]); }
    float mine = 0.f;
#pragma unroll
    for (int e = 0; e < NE; ++e) { float s = 0.f;
#pragma unroll
      for (int c = 0; c < NCH; ++c) { const LAS float* q = rwt + e * DM + c * 512 + lane * 8; const f32x4 w0 = *(const LAS f32x4*)q, w1 = *(const LAS f32x4*)(q + 4); s += sum8(v.a[c] * w0, v.b[c] * w1); }
      s = wave_sum(s); mine = (lane == e) ? s : mine; }
    float mx = lane < NE ? mine : -1e30f; mx = wave_max(mx); const float ex = lane < NE ? expf(mine - mx) : 0.f; const float se = wave_sum(ex);
    if (lane < NE) AFF[(long)R * NE + lane] = ex / se; }
}
__device__ __forceinline__ void ph_ln2(const Params& p, int l) {
  const int lane = threadIdx.x & 63, wv = threadIdx.x >> 6; const float* mod = WSP(float, p, mod) + (long)l * 18 * DM; const int last = (l == NLAYER - 1);
  const float* X1 = WSP(float, p, x1); float* X2 = WSP(float, p, x2); const int* SLOT = WSP(int, p, slot); const bf16_t* YS = (const bf16_t*)(p.ws + WS.regA + SZ_XS + SZ_ACT); bf16_t* H1 = WSP(bf16_t, p, h1);
  const float* lg = p.in[I_LN2G] + l * DM; const float* lb = p.in[I_LN2B] + l * DM;
  for (int R = blockIdx.x * 8 + wv; R < MROWS; R += gridDim.x * 8) { if (last && row_is_ctx(R)) continue;
    const float* m = mod + (long)row_mod(R) * 6 * DM; RowV v, acc; row_load(v, X1 + (long)R * DM, lane);
#pragma unroll
    for (int c = 0; c < NCH; ++c) { acc.a[c] = (f32x4){0.f, 0.f, 0.f, 0.f}; acc.b[c] = (f32x4){0.f, 0.f, 0.f, 0.f}; }
    const int myslot = lane < NE ? SLOT[(long)R * NE + lane] : -1;
    for (int e = 0; e < NE; ++e) { const int s = __shfl(myslot, e); if (s >= 0) { const bf16_t* yr = YS + (long)s * DM;
#pragma unroll
        for (int c = 0; c < NCH; ++c) { f32x4 t0, t1; unpack8(*(const u32x4*)(yr + c * 512 + lane * 8), t0, t1); acc.a[c] += t0; acc.b[c] += t1; } } }
#pragma unroll
    for (int c = 0; c < NCH; ++c) { const int o = c * 512 + lane * 8; v.a[c] = DN_ALPHA * v.a[c] + *(const f32x4*)(m + 5 * DM + o) * acc.a[c]; v.b[c] = DN_ALPHA * v.b[c] + *(const f32x4*)(m + 5 * DM + o + 4) * acc.b[c]; }
    float mean, rstd; row_stats(v, mean, rstd);
#pragma unroll
    for (int c = 0; c < NCH; ++c) { const int o = c * 512 + lane * 8; v.a[c] = (v.a[c] - mean) * rstd * *(const f32x4*)(lg + o) + *(const f32x4*)(lb + o); v.b[c] = (v.b[c] - mean) * rstd * *(const f32x4*)(lg + o + 4) + *(const f32x4*)(lb + o + 4); }
    if (last) { row_store(v, p.out + ((long)row_b(R) * SEQ + row_t(R)) * DM, lane); }
    else { row_store(v, X2 + (long)R * DM, lane); row_stats(v, mean, rstd); const float* mn = mod + 18 * DM + (long)row_mod(R) * 6 * DM; row_modulate_store(v, mean, rstd, mn, mn + DM, H1 + (long)R * DM, lane); } }
}

__device__ __forceinline__ void rope8(f32x4& a, f32x4& b, int xorl, bool first, const float* cs  ) {
#pragma unroll
  for (int j = 0; j < 4; ++j) { const float oa = __shfl_xor(a[j], xorl), ob = __shfl_xor(b[j], xorl);
    const float ca = cs[2 * j], sa = cs[2 * j + 1], cb = cs[8 + 2 * j], sb = cs[8 + 2 * j + 1];
    a[j] = a[j] * ca + (first ? -oa : oa) * sa; b[j] = b[j] * cb + (first ? -ob : ob) * sb; } }
__device__ __forceinline__ void ph_post_proj(const Params& p, int l) {
  static_assert(GHD == 128 && RQK == 64 && MROPE == 64 && MQL == 512 && MKVL == 256 && GH == 4 && GKV == 2 && RH == 4, "post_proj lane maps are written for the full-size config");
  const int lane = threadIdx.x & 63, wv = threadIdx.x >> 6; bf16_t* P = WSP(bf16_t, p, regA); bf16_t* KM = WSP(bf16_t, p, km); const float* ta = WSP(float, p, rope_a); const float* tb = WSP(float, p, rope_b);
  for (int R = blockIdx.x * 8 + wv; R < MROWS; R += gridDim.x * 8) { bf16_t* pr = P + (long)R * PW; const int t = row_t(R); const bool lat = t < SEQ; const int gr = lat ? t / GRIDW : 0, gc = lat ? t % GRIDW : 0;
    {
      const int g = lane >> 1, n = row_b(R) * S5NC + t / S5LC, a = t % S5LC; *(u32x4*)(WSP(bf16_t, p, uh) + ((long)g * S5NP + n) * (S5K1 + S5K2) + a * S5CH + (lane & 1) * 8) = *(const u32x4*)(pr + OFF_U + 8 * lane); }
    {
      const int j = lane & 15, hf = j >> 3; const bool first = !(j & 4); const float* cs = ta + ((hf ? gc : gr) * NROPE_A + ((8 * j) & 31)) * 2;
#pragma unroll
      for (int pass = 0; pass < 2; ++pass) { if (pass == 1 && lane >= 32) break; const int h = lane >> 4; bf16_t* x = pr + (pass ? OFF_GK : OFF_GQ) + h * GHD + 8 * j; const float* g = p.in[pass ? I_GKN : I_GQN] + l * GHD + 8 * j;
        f32x4 a, b; unpack8(*(const u32x4*)x, a, b); float ss = sum8(a * a, b * b); ss += __shfl_xor(ss, 8); ss += __shfl_xor(ss, 4); ss += __shfl_xor(ss, 2); ss += __shfl_xor(ss, 1);
        const float r = 1.f / sqrtf(ss * (1.f / GHD) + NORM_EPS); a = a * r * *(const f32x4*)g; b = b * r * *(const f32x4*)(g + 4);
        if (lat) rope8(a, b, 4, first, cs);
        *(u32x4*)x = pack8(a, b); } }
    {
      const int j = lane & 7, hf = j >> 2, h = (lane >> 3) & 3; const bool isk = lane >= 32, first = !(j & 2); bf16_t* x = pr + (isk ? OFF_RK : OFF_RQ) + h * RQK + 8 * j; const float sc = isk ? 0.125f : 1.f;
      f32x4 a, b; unpack8(*(const u32x4*)x, a, b); a = a * sc; b = b * sc;
      if (lat) rope8(a, b, 2, first, tb + ((hf ? gc : gr) * NROPE_B + ((8 * j) & 15)) * 2);
      *(u32x4*)x = pack8(a, b); }
    {
      bf16_t* x = pr + OFF_CQ + 8 * lane; const float* g = p.in[I_MQN] + l * MQL + 8 * lane; f32x4 a, b; unpack8(*(const u32x4*)x, a, b); const float ss = wave_sum(sum8(a * a, b * b));
      const float r = 1.f / sqrtf(ss * (1.f / MQL) + NORM_EPS); *(u32x4*)x = pack8(a * r * *(const f32x4*)g, b * r * *(const f32x4*)(g + 4)); }
    {
      if (lane < 32) { bf16_t* x = pr + OFF_CKV + 8 * lane; const float* g = p.in[I_MKVN] + l * MKVL + 8 * lane; f32x4 a, b; unpack8(*(const u32x4*)x, a, b); float ss = sum8(a * a, b * b);
        ss += __shfl_xor(ss, 16); ss += __shfl_xor(ss, 8); ss += __shfl_xor(ss, 4); ss += __shfl_xor(ss, 2); ss += __shfl_xor(ss, 1);
        const float r = 1.f / sqrtf(ss * (1.f / MKVL) + NORM_EPS); *(u32x4*)x = pack8(a * r * *(const f32x4*)g, b * r * *(const f32x4*)(g + 4)); }
      else if (lane < 40) { const int j = lane & 7, hf = j >> 2; const bool first = !(j & 2); bf16_t* x = pr + OFF_KR + 8 * j; f32x4 a, b; unpack8(*(const u32x4*)x, a, b);
        if (lat) rope8(a, b, 2, first, tb + ((hf ? gc : gr) * NROPE_B + ((8 * j) & 15)) * 2);
        const u32x4 w = pack8(a, b); *(u32x4*)x = w;
#pragma unroll
        for (int h = 0; h < MH; ++h) *(u32x4*)(KM + (long)R * MH * MQK + h * MQK + MNOPE + 8 * j) = w; } } }
}

struct ConvMat { bf16_t* dst; const float* src; const float* src2; int K, ld, ndst, nvalid, kind; };
constexpr int NMAT_L = 10 + 2 * NE, NMAT = NLAYER * NMAT_L;
__device__ __forceinline__ ConvMat conv_mat(const Params& p, int mi) {
  const int l = mi / NMAT_L, m = mi % NMAT_L; ConvMat c; c.src2 = nullptr; c.kind = 0;
  if (m == 0) { c.dst = WSP(bf16_t, p, wt_in) + (long)l * PW * DM; c.src = p.in[I_WIN] + (long)l * DM * IN_TOTAL; c.K = DM; c.ld = IN_TOTAL; c.ndst = PW; c.nvalid = IN_TOTAL; }
  else if (m == 1) { c.dst = WSP(bf16_t, p, wt_gate) + (long)l * 4 * DM * DM; c.src = p.in[I_WGATE] + (long)l * DM * 4 * DM; c.K = DM; c.ld = 4 * DM; c.ndst = 4 * DM; c.nvalid = 4 * DM; }
  else if (m < 6) { const int k = m - 2; c.dst = WSP(bf16_t, p, wt_br) + ((long)l * 4 + k) * DM * BW; c.src = p.in[I_WBR] + ((long)l * 4 + k) * BW * DM; c.K = BW; c.ld = DM; c.ndst = DM; c.nvalid = DM; }
  else if (m == 6) { c.dst = WSP(bf16_t, p, wt_out) + (long)l * DM * DM; c.src = p.in[I_WOUT] + (long)l * DM * DM; c.K = DM; c.ld = DM; c.ndst = DM; c.nvalid = DM; }
  else if (m == 7) { c.dst = WSP(bf16_t, p, wt_glu) + (long)l * BW * BW; c.src = p.in[I_S5GLU] + (long)l * BW * BW; c.K = BW; c.ld = BW; c.ndst = BW; c.nvalid = BW; }
  else if (m == 8) { c.dst = WSP(bf16_t, p, wt_uq) + (long)l * MH * MQK * MQL; c.src = p.in[I_WUQ] + (long)l * MQL * MH * MQK; c.K = MQL; c.ld = MH * MQK; c.ndst = MH * MQK; c.nvalid = MH * MQK; }
  else if (m == 9) { c.dst = WSP(bf16_t, p, wt_ukv) + (long)l * MH * (MNOPE + MV) * MKVL; c.src = p.in[I_WUKV] + (long)l * MKVL * MH * (MNOPE + MV); c.K = MKVL; c.ld = MH * (MNOPE + MV); c.ndst = MH * (MNOPE + MV); c.nvalid = c.ndst; }
  else if (m < 10 + NE) { const int e = m - 10; c.dst = WSP(bf16_t, p, wt_gu) + ((long)l * NE + e) * 2 * FF * DM; c.src = p.in[I_MOEG] + ((long)l * NE + e) * DM * FF; c.src2 = p.in[I_MOEU] + ((long)l * NE + e) * DM * FF;
    c.K = DM; c.ld = FF; c.ndst = 2 * FF; c.nvalid = 2 * FF; c.kind = 1; }
  else { const int e = m - 10 - NE; c.dst = WSP(bf16_t, p, wt_dn) + ((long)l * NE + e) * DM * FF; c.src = p.in[I_MOED] + ((long)l * NE + e) * FF * DM; c.K = FF; c.ld = DM; c.ndst = DM; c.nvalid = DM; }
  return c;
}
__device__ __forceinline__ void ph_conv(const Params& p, LAS unsigned char* lds) {
  const int tid = threadIdx.x, n = tid & 63, kp = tid >> 6; LAS unsigned* L = (LAS unsigned*)lds; int buf = 0;
  for (int mi = 0; mi < NMAT; ++mi) { const ConvMat c = conv_mat(p, mi); const int tk = c.K / 64, tn = c.ndst / 128, nt = tk * tn;
    for (int t = (blockIdx.x + mi * 29) % gridDim.x; t < nt; t += gridDim.x) { const int k0 = (t % tk) * 64, n0 = (t / tk) * 128;
      const float* s; int col0, nval;
      if (c.kind == 1) { const int tile = n0 / 256; s = (n0 & 128) ? c.src2 : c.src; col0 = tile * 128; nval = 128; } else { s = c.src; col0 = n0; nval = c.nvalid - n0; }
      LAS unsigned* Lb = L + buf * (128 * 33); buf ^= 1;
      float v[2][4][2];
#pragma unroll
      for (int hh = 0; hh < 2; ++hh)
#pragma unroll
        for (int i = 0; i < 4; ++i) { const int k = 2 * (kp + 8 * i), cn = hh * 64 + n; const bool ok = cn < nval; const float* q = s + (long)(k0 + k) * c.ld + col0 + cn;
          v[hh][i][0] = ok ? q[0] : 0.f; v[hh][i][1] = ok ? q[c.ld] : 0.f; }
#pragma unroll
      for (int hh = 0; hh < 2; ++hh)
#pragma unroll
        for (int i = 0; i < 4; ++i) Lb[(hh * 64 + n) * 33 + kp + 8 * i] = pg8::cvt_pk_bf16(v[hh][i][0], v[hh][i][1]);
      __syncthreads();
#pragma unroll
      for (int hh = 0; hh < 2; ++hh) { const int id = hh * 512 + tid, rn = id >> 3, kc = id & 7; const LAS unsigned* q = Lb + rn * 33 + kc * 4; u32x4 w; w.x = q[0]; w.y = q[1]; w.z = q[2]; w.w = q[3];
        *(u32x4*)(c.dst + (long)(n0 + rn) * c.K + k0 + kc * 8) = w; } } }
}
__device__ __forceinline__ void ph_mod(const Params& p, LAS unsigned char* lds) {
  const int tid = threadIdx.x; LAS float* sl = (LAS float*)lds; LAS float* part = sl + 3 * DM;
  for (int i = tid; i < 3 * DM; i += 512) { const int r = i / DM, k = i % DM; const float cv = r < 2 ? p.in[I_C][r * DM + k] : p.in[I_CCTX][k]; sl[i] = cv / (1.f + expf(-cv)); }
  __syncthreads();
  const int cg = tid & 31, ks = tid >> 5;
  constexpr int KS = DM / 16, NIT = NLAYER * (6 * DM / 128);
  for (int it = blockIdx.x; it < NIT; it += gridDim.x) { const int l = it / (6 * DM / 128), cb = it % (6 * DM / 128); const float* w = p.in[I_ADAW] + (long)l * DM * 6 * DM + cb * 128 + cg * 4;
    f32x4 a0 = {0.f, 0.f, 0.f, 0.f}, a1 = a0, a2 = a0;
#pragma unroll 8
    for (int k = ks * KS; k < (ks + 1) * KS; ++k) { const f32x4 wv = *(const f32x4*)(w + (long)k * 6 * DM); a0 += sl[k] * wv; a1 += sl[DM + k] * wv; a2 += sl[2 * DM + k] * wv; }
    LAS float* pp = part + (ks * 3) * 128 + cg * 4; *(LAS f32x4*)pp = a0; *(LAS f32x4*)(pp + 128) = a1; *(LAS f32x4*)(pp + 256) = a2;
    __syncthreads();
    if (tid < 384) { const int r = tid / 128, col = tid % 128; float s = 0.f;
#pragma unroll
      for (int q = 0; q < 16; ++q) s += part[(q * 3 + r) * 128 + col];
      WSP(float, p, mod)[((long)l * 3 + r) * 6 * DM + cb * 128 + col] = s + p.in[I_ADAB][(long)l * 6 * DM + cb * 128 + col]; }
    __syncthreads(); }
}
__device__ __forceinline__ void ph_tables(const Params& p) {
  const long gt = (long)blockIdx.x * 512 + threadIdx.x, gs = (long)gridDim.x * 512;
  float* ta = WSP(float, p, rope_a); float* tb = WSP(float, p, rope_b);
  for (long i = gt; i < (long)GRIDW * (NROPE_A + NROPE_B); i += gs) { const int pos = (int)(i / (NROPE_A + NROPE_B)), k = (int)(i % (NROPE_A + NROPE_B));
    if (k < NROPE_A) { const float a = pos * powf(10000.f, -(float)k / NROPE_A); ta[(pos * NROPE_A + k) * 2] = cosf(a); ta[(pos * NROPE_A + k) * 2 + 1] = sinf(a); }
    else { const int kk = k - NROPE_A; const float a = pos * powf(10000.f, -(float)kk / NROPE_B); tb[(pos * NROPE_B + kk) * 2] = cosf(a); tb[(pos * NROPE_B + kk) * 2 + 1] = sinf(a); } }
  float* tab = WSP(float, p, s5tab);
  for (long i = gt; i < (long)NLAYER * 2 * S5G * S5P; i += gs) { const int pp = (int)(i % S5P), g = (int)((i / S5P) % S5G), dir = (int)((i / (S5P * S5G)) % 2), l = (int)(i / (2 * S5P * S5G));
    const float a_re = p.in[dir ? I_S5AREB : I_S5AREF][(l * S5G + g) * S5P + pp], a_im = p.in[dir ? I_S5AIMB : I_S5AIMF][(l * S5G + g) * S5P + pp];
    const float dt = expf(p.in[dir ? I_S5DTB : I_S5DTF][l * S5G + g]);
    const float mag = expf(a_re * dt), ab_re = mag * cosf(a_im * dt), ab_im = mag * sinf(a_im * dt);
    const float den = a_re * a_re + a_im * a_im, nr = ab_re - 1.f, ni = ab_im;
    const float cr = (nr * a_re + ni * a_im) / den, ci = (ni * a_re - nr * a_im) / den;
    float* t = tab + i * S5TW; t[0] = ab_re; t[1] = ab_im;
    for (int c = 0; c < S5CH; ++c) { const float br = p.in[I_S5BRE][((l * S5G + g) * S5P + pp) * S5CH + c], bi = p.in[I_S5BIM][((l * S5G + g) * S5P + pp) * S5CH + c];
      t[2 + c] = cr * br - ci * bi; t[2 + S5CH + c] = cr * bi + ci * br; } }
}

__device__ __forceinline__ void ph_s5tables(const Params& p, LAS unsigned char* lds) {
  const int tid = threadIdx.x; LAS float* pw = (LAS float*)lds; LAS float* bb = pw + 2 * S5P * (S5LC + 1) * 2; LAS float* cc = bb + 2 * S5P * S5CH * 2; LAS float* T = cc + S5CH * S5P * 2;
  for (int item = blockIdx.x; item < NLAYER * S5G; item += gridDim.x) { const int l = item / S5G, g = item % S5G;
    for (int i = tid; i < 2 * S5P; i += 512) { const int dir = i / S5P, pp = i % S5P;
      const double a_re = p.in[dir ? I_S5AREB : I_S5AREF][(l * S5G + g) * S5P + pp], a_im = p.in[dir ? I_S5AIMB : I_S5AIMF][(l * S5G + g) * S5P + pp], dt = exp((double)p.in[dir ? I_S5DTB : I_S5DTF][l * S5G + g]);
      for (int k = 0; k <= S5LC; ++k) { const double mag = exp(a_re * dt * k), ang = a_im * dt * k; pw[((dir * S5P + pp) * (S5LC + 1) + k) * 2] = (float)(mag * cos(ang)); pw[((dir * S5P + pp) * (S5LC + 1) + k) * 2 + 1] = (float)(mag * sin(ang)); }
      const double mag = exp(a_re * dt), abr = mag * cos(a_im * dt), abi = mag * sin(a_im * dt), den = a_re * a_re + a_im * a_im, nr = abr - 1.0, ni = abi, cr = (nr * a_re + ni * a_im) / den, ci = (ni * a_re - nr * a_im) / den;
      for (int c = 0; c < S5CH; ++c) { const double br = p.in[I_S5BRE][((l * S5G + g) * S5P + pp) * S5CH + c], bi = p.in[I_S5BIM][((l * S5G + g) * S5P + pp) * S5CH + c];
        bb[((dir * S5P + pp) * S5CH + c) * 2] = (float)(cr * br - ci * bi); bb[((dir * S5P + pp) * S5CH + c) * 2 + 1] = (float)(cr * bi + ci * br); } }
    for (int i = tid; i < S5CH * S5P; i += 512) { cc[2 * i] = p.in[I_S5CRE][(long)(l * S5G + g) * S5CH * S5P + i]; cc[2 * i + 1] = p.in[I_S5CIM][(long)(l * S5G + g) * S5CH * S5P + i]; }
    __syncthreads();
    for (int e = tid; e < (2 * S5LC - 1) * S5CH * S5CH; e += 512) { const int tau = e / (S5CH * S5CH) - (S5LC - 1), i = (e % (S5CH * S5CH)) / S5CH, c = e % S5CH; float s = 0.f;
      for (int dir = 0; dir < 2; ++dir) { if (dir == 0 ? tau < 0 : tau > 0) continue; const int k = tau < 0 ? -tau : tau;
        for (int pp = 0; pp < S5P; ++pp) { const float cr_ = cc[(i * S5P + pp) * 2], ci_ = cc[(i * S5P + pp) * 2 + 1], ar = pw[((dir * S5P + pp) * (S5LC + 1) + k) * 2], ai = pw[((dir * S5P + pp) * (S5LC + 1) + k) * 2 + 1];
          const float br = bb[((dir * S5P + pp) * S5CH + c) * 2], bi = bb[((dir * S5P + pp) * S5CH + c) * 2 + 1]; const float zr = ar * br - ai * bi, zi = ar * bi + ai * br; s += cr_ * zr - ci_ * zi; } }
      T[e] = s; }
    __syncthreads();
    bf16_t* SW = WSP(bf16_t, p, s5sw) + (long)item * S5K2 * S5K1; bf16_t* SV = WSP(bf16_t, p, s5sv) + (long)item * S5K1 * (S5K1 + S5K2);
    for (int e = tid; e < S5K2 * S5K1; e += 512) { const int r = e / S5K1, col = e % S5K1, dir = r / (2 * S5P), pp = (r % (2 * S5P)) / 2, im = r & 1, a = col / S5CH, c = col % S5CH; const int k = dir ? a : (S5LC - 1 - a);
      const float ar = pw[((dir * S5P + pp) * (S5LC + 1) + k) * 2], ai = pw[((dir * S5P + pp) * (S5LC + 1) + k) * 2 + 1], br = bb[((dir * S5P + pp) * S5CH + c) * 2], bi = bb[((dir * S5P + pp) * S5CH + c) * 2 + 1];
      SW[e] = f2bf(im ? ar * bi + ai * br : ar * br - ai * bi); }
    for (int e = tid; e < S5K1 * (S5K1 + S5K2); e += 512) { const int r = e / (S5K1 + S5K2), k = e % (S5K1 + S5K2), a = r / S5CH, i = r % S5CH; float v;
      if (k < S5K1) { const int a2 = k / S5CH, c = k % S5CH; v = T[((a - a2) + (S5LC - 1)) * S5CH * S5CH + i * S5CH + c]; }
      else { const int kk = k - S5K1, dir = kk / (2 * S5P), pp = (kk % (2 * S5P)) / 2, im = kk & 1, pk = dir ? (S5LC - a) : (a + 1);
        const float cr_ = cc[(i * S5P + pp) * 2], ci_ = cc[(i * S5P + pp) * 2 + 1], ar = pw[((dir * S5P + pp) * (S5LC + 1) + pk) * 2], ai = pw[((dir * S5P + pp) * (S5LC + 1) + pk) * 2 + 1];
        v = im ? -(cr_ * ai + ci_ * ar) : (cr_ * ar - ci_ * ai); }
      SV[e] = f2bf(v); }
    __syncthreads(); }
}
__device__ __forceinline__ void ph_s5scan(const Params& p, int l) {
  const float* tab = WSP(float, p, s5tab); const float* E = WSP(float, p, s5e); bf16_t* UH = WSP(bf16_t, p, uh);
  for (long i = (long)blockIdx.x * 512 + threadIdx.x; i < (long)NB * S5G * 2 * S5P; i += (long)gridDim.x * 512) { const int pp = (int)(i % S5P), dir = (int)((i / S5P) % 2), g = (int)((i / (2 * S5P)) % S5G), b = (int)(i / (2 * S5P * S5G));
    const float* t = tab + ((((long)l * 2 + dir) * S5G + g) * S5P + pp) * S5TW; float ar = t[0], ai = t[1];
#pragma unroll
    for (int q = 0; q < 4; ++q) { const float nr = ar * ar - ai * ai, ni = 2.f * ar * ai; ar = nr; ai = ni; }
    float hr = 0.f, hi = 0.f; constexpr int NCX = CTXL / S5LC, NLT = SEQ / S5LC;
    for (int s0 = 0; s0 < S5NC; s0 += 8) { float er[8], ei[8]; long idx[8];
#pragma unroll
      for (int q = 0; q < 8; ++q) { const int s = s0 + q; const int j = dir == 0 ? (s < NCX ? NLT + s : s - NCX) : (s < NCX ? S5NC - 1 - s : NLT - 1 - (s - NCX)); idx[q] = (long)g * S5NP + b * S5NC + j;
        const float2 ev = *(const float2*)(E + idx[q] * S5K2 + dir * 2 * S5P + pp * 2); er[q] = ev.x; ei[q] = ev.y; }
#pragma unroll
      for (int q = 0; q < 8; ++q) { *(unsigned*)(UH + idx[q] * (S5K1 + S5K2) + S5K1 + dir * 2 * S5P + pp * 2) = pg8::cvt_pk_bf16(hr, hi);
        const float nr = ar * hr - ai * hi + er[q], ni = ar * hi + ai * hr + ei[q]; hr = nr; hi = ni; } } }
}
__device__ __forceinline__ void ph_topk(const Params& p, int l, LAS unsigned char* lds) {
  const int tid = threadIdx.x, lane = tid & 63, wv = tid >> 6; LAS unsigned* hist = (LAS unsigned*)lds; LAS unsigned* sh = hist + 256;
  const float* AFF = WSP(float, p, aff); int* SLOT = WSP(int, p, slot); float* GV = WSP(float, p, gatev); int* XSRC = WSP(int, p, xsrc);
  const int nprob = (l == 0 ? 4 : 2) * NE; constexpr int KPT = SEQ / 512;
  for (int pr = blockIdx.x; pr < nprob; pr += gridDim.x) { const int set = pr / NE, e = pr % NE, b = set & 1; const bool lat = set < 2; const int n = lat ? SEQ : CTXL, cap = lat ? CAP_L : CAP_C, R0 = b * NTOK + (lat ? 0 : SEQ);
    unsigned key[KPT];
#pragma unroll
    for (int k = 0; k < KPT; ++k) { const int i = tid + 512 * k; key[k] = i < n ? __float_as_uint(AFF[(long)(R0 + i) * NE + e]) : 0u; }
    unsigned prefix = 0u, mask = 0u, remaining = (unsigned)cap;
    for (int pass = 0; pass < 4; ++pass) { const int shift = 24 - 8 * pass;
      if (tid < 256) hist[tid] = 0u; __syncthreads();
#pragma unroll
      for (int k = 0; k < KPT; ++k) { const int i = tid + 512 * k; if (i < n && (key[k] & mask) == prefix) atomicAdd((unsigned*)&hist[(key[k] >> shift) & 255u], 1u); }
      __syncthreads();
      if (tid == 0) { unsigned cum = 0u; int d = 255; for (; d > 0; --d) { const unsigned h = hist[d]; if (cum + h >= remaining) break; cum += h; } sh[0] = (unsigned)d; sh[1] = remaining - cum; }
      __syncthreads();
      prefix |= sh[0] << shift; mask |= 0xFFu << shift; remaining = sh[1]; __syncthreads(); }
    const unsigned T = prefix, need_eq = remaining;
    unsigned base_gt = 0u, base_eq = 0u; int slotv[KPT];
#pragma unroll
    for (int k = 0; k < KPT; ++k) { const int i = tid + 512 * k; const bool gt = i < n && key[k] > T, eq = i < n && key[k] == T;
      const unsigned long long bg = __ballot(gt), be = __ballot(eq), lt = (1ull << lane) - 1ull;
      if (lane == 0) { sh[8 + wv] = (unsigned)__popcll(bg); sh[16 + wv] = (unsigned)__popcll(be); } __syncthreads();
      unsigned pg = 0u, pe = 0u, tg = 0u, te = 0u;
#pragma unroll
      for (int w = 0; w < 8; ++w) { const unsigned a = sh[8 + w], c = sh[16 + w]; pg += w < wv ? a : 0u; pe += w < wv ? c : 0u; tg += a; te += c; }
      const unsigned rg = base_gt + pg + (unsigned)__popcll(bg & lt), re = base_eq + pe + (unsigned)__popcll(be & lt);
      slotv[k] = gt ? (int)rg : (eq && re < need_eq ? -2 - (int)re : -1);
      base_gt += tg; base_eq += te; __syncthreads(); }
    const int xbase = e * XEP + (lat ? b * CAP_L : 2 * CAP_L + b * CAP_C);
#pragma unroll
    for (int k = 0; k < KPT; ++k) { const int i = tid + 512 * k; if (i < n) { int s = slotv[k]; if (s <= -2) s = (int)base_gt + (-2 - s);
        const long R = R0 + i; if (s >= 0) { const int xr = xbase + s; SLOT[R * NE + e] = xr; GV[xr] = __uint_as_float(key[k]); XSRC[xr] = (int)R; } else SLOT[R * NE + e] = -1; } }
    if (set == 3) for (int i = tid; i < XEP - XE; i += 512) XSRC[e * XEP + XE + i] = -1;
    __syncthreads(); }
}
__device__ __forceinline__ void ph_gather(const Params& p, int l) {
  const int lane = threadIdx.x & 63, wv = threadIdx.x >> 6; const int* XSRC = WSP(int, p, xsrc); const bf16_t* H2 = WSP(bf16_t, p, h2); bf16_t* XS = WSP(bf16_t, p, regA);
  const int rows_e = (l == 0) ? XEP : 2 * CAP_L, total = NE * rows_e;
  for (int it = blockIdx.x * 8 + wv; it < total; it += gridDim.x * 8) { const int e = it / rows_e, xr = e * XEP + it % rows_e; const int src = XSRC[xr];
#pragma unroll
    for (int c = 0; c < NCH; ++c) { const int o = c * 512 + lane * 8; u32x4 w = {0u, 0u, 0u, 0u}; if (src >= 0) w = *(const u32x4*)(H2 + (long)src * DM + o); *(u32x4*)(XS + (long)xr * DM + o) = w; } }
}
}
#endif
#ifndef CPU_TEST
namespace att {
#ifndef ATT_SD_MLA
#define ATT_SD_MLA 1
#endif
#ifndef ATT_SD_GQA
#define ATT_SD_GQA 2
#endif
using bf16x8 = __attribute__((ext_vector_type(8))) short;
using s16x4  = __attribute__((ext_vector_type(4))) short;
using f32x16 = __attribute__((ext_vector_type(16))) float;
using u32x4  = __attribute__((ext_vector_type(4))) unsigned;
constexpr int DV = 128, NW = 8, QBLK = 32, KVBLK = 64;
constexpr float THR = 8.f;
#define ATT_SBAR() __builtin_amdgcn_sched_barrier(0)
__device__ __forceinline__ int crow(int r, int hi) { return (r & 3) + 8 * (r >> 2) + 4 * hi; }
__device__ __forceinline__ unsigned cvtpk(float lo, float hi) { unsigned r; asm volatile("v_cvt_pk_bf16_f32 %0, %1, %2" : "=v"(r) : "v"(lo), "v"(hi)); return r; }
template <int DQK> constexpr size_t shm_k() { return (size_t)KVBLK * DQK * 2; }
constexpr size_t SHM_V = KVBLK * DV * 2;
template <int DQK> constexpr size_t shm_attn() { return 2 * SHM_V + 2 * shm_k<DQK>() + NW * 64 * 4; }

__device__ __forceinline__ void partialSM(f32x16& p0, f32x16& p1, float& m_reg, float& mn, float& alpha, const float C, const float thr_raw) {
  float pmax = p0[0];
#pragma unroll
  for (int r = 1; r < 16; ++r) pmax = fmaxf(pmax, p0[r]);
#pragma unroll
  for (int r = 0; r < 16; ++r) pmax = fmaxf(pmax, p1[r]);
  { auto rr = __builtin_amdgcn_permlane32_swap(__float_as_uint(pmax), __float_as_uint(pmax), false, false);
    pmax = fmaxf(__uint_as_float(rr[0]), __uint_as_float(rr[1])); }
  if (__builtin_expect(__all(pmax - m_reg <= thr_raw), 1)) { mn = m_reg; alpha = 1.f; }
  else { mn = fmaxf(m_reg, pmax); alpha = __builtin_amdgcn_exp2f((m_reg - mn) * C); m_reg = mn; }
  const float mnC = -mn * C;
#pragma unroll
  for (int r = 0; r < 16; ++r) p0[r] = fmaf(p0[r], C, mnC);
#pragma unroll
  for (int r = 0; r < 16; ++r) p1[r] = fmaf(p1[r], C, mnC);
#pragma unroll
  for (int r = 0; r < 16; ++r) p0[r] = __builtin_amdgcn_exp2f(p0[r]);
}
__device__ __forceinline__ void finishSM(f32x16& p0, f32x16& p1, float alpha, float& l_reg, bf16x8& pa0, bf16x8& pa1, bf16x8& pa2, bf16x8& pa3) {
#pragma unroll
  for (int r = 0; r < 16; ++r) p1[r] = __builtin_amdgcn_exp2f(p1[r]);
  float ps = 0;
#pragma unroll
  for (int r = 0; r < 16; ++r) ps += p0[r];
#pragma unroll
  for (int r = 0; r < 16; ++r) ps += p1[r];
  { auto rr = __builtin_amdgcn_permlane32_swap(__float_as_uint(ps), __float_as_uint(ps), false, false);
    ps = __uint_as_float(rr[0]) + __uint_as_float(rr[1]); }
  l_reg = l_reg * alpha + ps;
#define ATT_PK4(P, BASE, OUT) do { unsigned a0 = cvtpk(P[BASE + 0], P[BASE + 1]), a1 = cvtpk(P[BASE + 2], P[BASE + 3]);   \
    unsigned b0 = cvtpk(P[BASE + 4], P[BASE + 5]), b1 = cvtpk(P[BASE + 6], P[BASE + 7]);                              \
    auto r0 = __builtin_amdgcn_permlane32_swap(a0, b0, false, false); auto r1 = __builtin_amdgcn_permlane32_swap(a1, b1, false, false); \
    u32x4 w = {r0[0], r1[0], r0[1], r1[1]}; OUT = *reinterpret_cast<bf16x8*>(&w); } while (0)
  ATT_PK4(p0, 0, pa0); ATT_PK4(p0, 8, pa1); ATT_PK4(p1, 0, pa2); ATT_PK4(p1, 8, pa3);
#undef ATT_PK4
}
__device__ __forceinline__ bf16x8 bl(__amdgpu_buffer_rsrc_t r, int voff, int soff) { const u32x4 w = __builtin_amdgcn_raw_buffer_load_b128(r, voff, soff, 0); return *reinterpret_cast<const bf16x8*>(&w); }
template <int DQK> __device__ __forceinline__ int kswz(int row, int colB) { return row * (DQK * 2) + (colB ^ ((row & 7) << 4)); }
template <int DQK> __device__ __forceinline__ void qkt(f32x16& p0, f32x16& p1, const char* Ks, const bf16x8* qr, int r32, int hi) {
  p0 = f32x16{}; p1 = f32x16{};
#pragma unroll
  for (int d0 = 0; d0 < DQK / 16; ++d0) { const int cb = (d0 * 16 + hi * 8) * 2;
    bf16x8 b0 = *reinterpret_cast<const bf16x8*>(Ks + kswz<DQK>(r32, cb));
    bf16x8 b1 = *reinterpret_cast<const bf16x8*>(Ks + kswz<DQK>(32 + r32, cb));
    p0 = __builtin_amdgcn_mfma_f32_32x32x16_bf16(b0, qr[d0], p0, 0, 0, 0);
    p1 = __builtin_amdgcn_mfma_f32_32x32x16_bf16(b1, qr[d0], p1, 0, 0, 0); }
}
__device__ __forceinline__ int v_st(int k, int c) { const int kk = (k & ~0xC) | ((k & 4) << 1) | ((k & 8) >> 1); return ((kk >> 3) * 4 + (c >> 5)) * 512 + ((kk & 7) * 32 + (c & 31)) * 2; }
__device__ __forceinline__ int v_rd_base(int lane) { return ((lane & 3) << 3) | (((lane >> 2) & 3) << 6) | (((lane >> 4) & 1) << 5) | (((lane >> 5) & 1) << 8); }
constexpr int v_rd_off(int d0, int ks, int half) { return d0 * 512 + ks * 4096 + half * 2048; }
template <int OFF> __device__ __forceinline__ s16x4 tr_read(int vb) {
  s16x4 r; asm volatile("ds_read_b64_tr_b16 %0, %1 offset:%2" : "=&v"(r) : "v"(vb), "i"(OFF) : "memory"); return r;
}
template <int D0> __device__ __forceinline__ void pv_one(f32x16& od, int vb, bf16x8 pa0, bf16x8 pa1, bf16x8 pa2, bf16x8 pa3) {
  const s16x4 l0 = tr_read<v_rd_off(D0, 0, 0)>(vb), h0 = tr_read<v_rd_off(D0, 0, 1)>(vb), l1 = tr_read<v_rd_off(D0, 1, 0)>(vb), h1 = tr_read<v_rd_off(D0, 1, 1)>(vb);
  const s16x4 l2 = tr_read<v_rd_off(D0, 2, 0)>(vb), h2 = tr_read<v_rd_off(D0, 2, 1)>(vb), l3 = tr_read<v_rd_off(D0, 3, 0)>(vb), h3 = tr_read<v_rd_off(D0, 3, 1)>(vb);
  asm volatile("s_waitcnt lgkmcnt(0)" ::: "memory"); ATT_SBAR();
#define ATT_PK(L, H) (bf16x8){L[0], L[1], L[2], L[3], H[0], H[1], H[2], H[3]}
  od = __builtin_amdgcn_mfma_f32_32x32x16_bf16(pa0, ATT_PK(l0, h0), od, 0, 0, 0);
  od = __builtin_amdgcn_mfma_f32_32x32x16_bf16(pa1, ATT_PK(l1, h1), od, 0, 0, 0);
  od = __builtin_amdgcn_mfma_f32_32x32x16_bf16(pa2, ATT_PK(l2, h2), od, 0, 0, 0);
  od = __builtin_amdgcn_mfma_f32_32x32x16_bf16(pa3, ATT_PK(l3, h3), od, 0, 0, 0);
#undef ATT_PK
}
__device__ __forceinline__ void pv_d0(f32x16* o, int vb, bf16x8 pa0, bf16x8 pa1, bf16x8 pa2, bf16x8 pa3) {
  pv_one<0>(o[0], vb, pa0, pa1, pa2, pa3); pv_one<1>(o[1], vb, pa0, pa1, pa2, pa3); pv_one<2>(o[2], vb, pa0, pa1, pa2, pa3); pv_one<3>(o[3], vb, pa0, pa1, pa2, pa3);
}
template <int DQK, int LDQ, int LDK, int LDV, int LDO, int SDEPTH>
__device__ __forceinline__ void attn_body(const bf16_t* __restrict__ Qb, const bf16_t* __restrict__ Kh, const bf16_t* __restrict__ Vh, bf16_t* __restrict__ Ob, int seq, char* lds, const float scale) {
  constexpr int NKC = DQK / 64;
  constexpr size_t SHM_K = shm_k<DQK>();
  const float C = scale * 1.4426950408889634f, thr_raw = THR / scale;
  const int tid = threadIdx.x, wid = tid >> 6, lane = tid & 63, r32 = lane & 31, hi = lane >> 5;
  char* V_lds = lds; char* K_lds = lds + 2 * SHM_V;
  float* wsf = (float*)(lds + 2 * SHM_V + 2 * SHM_K) + wid * 64; float* li_l = wsf; float* al_l = wsf + 32;
  float m_reg = -1e30f, l_reg = 0; f32x16 o[4] = {}; bf16x8 qr[DQK / 16];
  const bf16_t* Qw = Qb + (long)(wid * QBLK + r32) * LDQ + hi * 8;
#pragma unroll
  for (int d0 = 0; d0 < DQK / 16; ++d0) qr[d0] = *reinterpret_cast<const bf16x8*>(Qw + d0 * 16);
  const int sr = tid >> 4, sc = (tid & 15) * 8, vst0 = v_st(sr, sc), vst1 = v_st(32 + sr, sc);
  int kgo[NKC], klo[NKC];
#pragma unroll
  for (int i = 0; i < NKC; ++i) { const int c = tid + 512 * i, kr = c / (DQK / 8), kc = (c % (DQK / 8)) * 8; kgo[i] = kr * LDK + kc; klo[i] = kswz<DQK>(kr, kc * 2); }
  const int vgo = sr * LDV + sc;
  const __amdgpu_buffer_rsrc_t rK = __builtin_amdgcn_make_buffer_rsrc((void*)Kh, 0, 0x7ffffffc, 0x00020000), rV = __builtin_amdgcn_make_buffer_rsrc((void*)Vh, 0, 0x7ffffffc, 0x00020000);
  const int vb0 = (int)(uintptr_t)V_lds + v_rd_base(lane);
  struct { bf16x8 vs0, vs1, ks[NKC]; } sr_[SDEPTH];
#define ATT_SLOAD(i, k0) do { const int _vo = (k0) * (LDV * 2), _ko = (k0) * (LDK * 2); sr_[i].vs0 = bl(rV, vgo * 2, _vo); sr_[i].vs1 = bl(rV, vgo * 2 + 64 * LDV, _vo); \
    _Pragma("unroll") for (int _c = 0; _c < NKC; ++_c) sr_[i].ks[_c] = bl(rK, kgo[_c] * 2, _ko); } while (0)
#define ATT_SWRITE(b, i) do { *(bf16x8*)(V_lds + (b) * SHM_V + vst0) = sr_[i].vs0; *(bf16x8*)(V_lds + (b) * SHM_V + vst1) = sr_[i].vs1; \
    _Pragma("unroll") for (int _c = 0; _c < NKC; ++_c) *(bf16x8*)(K_lds + (b) * SHM_K + klo[_c]) = sr_[i].ks[_c]; } while (0)
#define ATT_SWAIT() asm volatile("s_waitcnt vmcnt(%0)" :: "n"(SDEPTH == 2 ? 2 + NKC : 0) : "memory")
#define ATT_RESC(a) do { if (__any((a) < 1.f)) { if (hi == 0) al_l[r32] = (a); asm volatile("s_waitcnt lgkmcnt(0)" ::: "memory"); \
    _Pragma("unroll") for (int d = 0; d < 4; ++d) _Pragma("unroll") for (int r = 0; r < 16; ++r) o[d][r] *= al_l[crow(r, hi)]; } } while (0)
  f32x16 pA0, pA1, pB0, pB1; float mnA, mnB, alA, alB; bf16x8 pa0, pa1, pa2, pa3; const int NT = seq / KVBLK;
  constexpr int SE = 0, SO = SDEPTH - 1;
  ATT_SLOAD(SE, 0); asm volatile("s_waitcnt vmcnt(0)" ::: "memory"); ATT_SWRITE(0, SE); __syncthreads();
  qkt<DQK>(pA0, pA1, K_lds, qr, r32, hi); partialSM(pA0, pA1, m_reg, mnA, alA, C, thr_raw);
  ATT_SLOAD(SO, KVBLK); if (SDEPTH == 2) { if (2 < NT) ATT_SLOAD(SE, 2 * KVBLK); }
  ATT_SWAIT(); ATT_SWRITE(1, SO); __syncthreads();
  for (int j = 1; j + 1 < NT; j += 2) {
    ATT_SBAR(); qkt<DQK>(pB0, pB1, K_lds + SHM_K, qr, r32, hi);
    finishSM(pA0, pA1, alA, l_reg, pa0, pa1, pa2, pa3); ATT_SBAR();
    ATT_SLOAD(SO, (j + SDEPTH) * KVBLK); ATT_SBAR();
    pv_d0(o, vb0, pa0, pa1, pa2, pa3); partialSM(pB0, pB1, m_reg, mnB, alB, C, thr_raw);
    __syncthreads(); ATT_SWAIT(); ATT_SWRITE(0, SE);
    ATT_RESC(alB); __syncthreads();
    ATT_SBAR(); qkt<DQK>(pA0, pA1, K_lds, qr, r32, hi);
    finishSM(pB0, pB1, alB, l_reg, pa0, pa1, pa2, pa3); ATT_SBAR();
    if (SDEPTH == 1 || j + 3 < NT) ATT_SLOAD(SE, (j + 1 + SDEPTH) * KVBLK); ATT_SBAR();
    pv_d0(o, vb0 + (int)SHM_V, pa0, pa1, pa2, pa3); partialSM(pA0, pA1, m_reg, mnA, alA, C, thr_raw);
    __syncthreads(); ATT_SWAIT(); ATT_SWRITE(1, SO);
    ATT_RESC(alA); __syncthreads();
  }
  ATT_SBAR(); qkt<DQK>(pB0, pB1, K_lds + SHM_K, qr, r32, hi);
  finishSM(pA0, pA1, alA, l_reg, pa0, pa1, pa2, pa3); ATT_SBAR();
  pv_d0(o, vb0, pa0, pa1, pa2, pa3); partialSM(pB0, pB1, m_reg, mnB, alB, C, thr_raw);
  __syncthreads(); ATT_RESC(alB);
  finishSM(pB0, pB1, alB, l_reg, pa0, pa1, pa2, pa3); ATT_SBAR();
  pv_d0(o, vb0 + (int)SHM_V, pa0, pa1, pa2, pa3);
  if (hi == 0) li_l[r32] = l_reg; asm volatile("s_waitcnt lgkmcnt(0)" ::: "memory");
  float rli[16];
#pragma unroll
  for (int r = 0; r < 16; ++r) rli[r] = __builtin_amdgcn_rcpf(li_l[crow(r, hi)]);
  bf16_t* Ow = Ob + (long)(wid * QBLK) * LDO;
#pragma unroll
  for (int r = 0; r < 16; ++r) { const int orow = crow(r, hi);
#pragma unroll
    for (int d0 = 0; d0 < 4; ++d0) Ow[(long)orow * LDO + d0 * 32 + r32] = (bf16_t)(cvtpk(o[d0][r] * rli[r], 0.f) & 0xffffu); }
  __syncthreads();
#undef ATT_SLOAD
#undef ATT_SWRITE
#undef ATT_SWAIT
#undef ATT_RESC
}

template <int DQK, int LDQ, int LDK, int LDV, int LDO>
__device__ __forceinline__ void attn_body_s1(const bf16_t* __restrict__ Qb, const bf16_t* __restrict__ Kh, const bf16_t* __restrict__ Vh, bf16_t* __restrict__ Ob, int seq, char* lds, const float scale) {
  constexpr int NKC = DQK / 64; constexpr size_t SHM_K = shm_k<DQK>();
  const float C = scale * 1.4426950408889634f, thr_raw = THR / scale;
  const int tid = threadIdx.x, wid = tid >> 6, lane = tid & 63, r32 = lane & 31, hi = lane >> 5;
  char* V_lds = lds; char* K_lds = lds + 2 * SHM_V;
  float* wsf = (float*)(lds + 2 * SHM_V + 2 * SHM_K) + wid * 64; float* li_l = wsf; float* al_l = wsf + 32;
  float m_reg = -1e30f, l_reg = 0; f32x16 o[4] = {}; bf16x8 qr[DQK / 16];
  const bf16_t* Qw = Qb + (long)(wid * QBLK + r32) * LDQ + hi * 8;
#pragma unroll
  for (int d0 = 0; d0 < DQK / 16; ++d0) qr[d0] = *reinterpret_cast<const bf16x8*>(Qw + d0 * 16);
  const int sr = tid >> 4, sc = (tid & 15) * 8, vst0 = v_st(sr, sc), vst1 = v_st(32 + sr, sc);
  int kgo[NKC], klo[NKC];
#pragma unroll
  for (int i = 0; i < NKC; ++i) { const int c = tid + 512 * i, kr = c / (DQK / 8), kc = (c % (DQK / 8)) * 8; kgo[i] = kr * LDK + kc; klo[i] = kswz<DQK>(kr, kc * 2); }
  const int vgo = sr * LDV + sc;
  const __amdgpu_buffer_rsrc_t rK = __builtin_amdgcn_make_buffer_rsrc((void*)Kh, 0, 0x7ffffffc, 0x00020000), rV = __builtin_amdgcn_make_buffer_rsrc((void*)Vh, 0, 0x7ffffffc, 0x00020000);
  const int vb0 = (int)(uintptr_t)V_lds + v_rd_base(lane);
  bf16x8 vs0, vs1, ks[NKC];
#define ATT1_SLOAD(k0) do { const int _vo = (k0) * (LDV * 2), _ko = (k0) * (LDK * 2); vs0 = bl(rV, vgo * 2, _vo); vs1 = bl(rV, vgo * 2 + 64 * LDV, _vo); \
    _Pragma("unroll") for (int _c = 0; _c < NKC; ++_c) ks[_c] = bl(rK, kgo[_c] * 2, _ko); } while (0)
#define ATT1_SWRITE(b) do { *(bf16x8*)(V_lds + (b) * SHM_V + vst0) = vs0; *(bf16x8*)(V_lds + (b) * SHM_V + vst1) = vs1; \
    _Pragma("unroll") for (int _c = 0; _c < NKC; ++_c) *(bf16x8*)(K_lds + (b) * SHM_K + klo[_c]) = ks[_c]; } while (0)
  const int NT = seq / KVBLK;
  ATT1_SLOAD(0); asm volatile("s_waitcnt vmcnt(0)" ::: "memory"); ATT1_SWRITE(0);
  ATT1_SLOAD(KVBLK); asm volatile("s_waitcnt vmcnt(0)" ::: "memory"); ATT1_SWRITE(1); __syncthreads();
  for (int j = 0; j < NT; ++j) { const int b = j & 1;
    ATT_SBAR();
    f32x16 p0, p1; float mn, al; bf16x8 pa0, pa1, pa2, pa3;
    qkt<DQK>(p0, p1, K_lds + b * SHM_K, qr, r32, hi);
    partialSM(p0, p1, m_reg, mn, al, C, thr_raw);
    if (__any(al < 1.f)) { if (hi == 0) al_l[r32] = al; asm volatile("s_waitcnt lgkmcnt(0)" ::: "memory");
#pragma unroll
      for (int d = 0; d < 4; ++d)
#pragma unroll
        for (int r = 0; r < 16; ++r) o[d][r] *= al_l[crow(r, hi)]; }
    finishSM(p0, p1, al, l_reg, pa0, pa1, pa2, pa3); ATT_SBAR();
    if (j + 2 < NT) ATT1_SLOAD((j + 2) * KVBLK);
    ATT_SBAR();
    pv_d0(o, vb0 + b * (int)SHM_V, pa0, pa1, pa2, pa3);
    __syncthreads();
    if (j + 2 < NT) { asm volatile("s_waitcnt vmcnt(0)" ::: "memory"); ATT1_SWRITE(b); } }
  if (hi == 0) li_l[r32] = l_reg; asm volatile("s_waitcnt lgkmcnt(0)" ::: "memory");
  bf16_t* Ow = Ob + (long)(wid * QBLK) * LDO;
#pragma unroll
  for (int r = 0; r < 16; ++r) { const int orow = crow(r, hi); const float rl = __builtin_amdgcn_rcpf(li_l[orow]);
#pragma unroll
    for (int d0 = 0; d0 < 4; ++d0) Ow[(long)orow * LDO + d0 * 32 + r32] = (bf16_t)(cvtpk(o[d0][r] * rl, 0.f) & 0xffffu); }
  __syncthreads();
#undef ATT1_SLOAD
#undef ATT1_SWRITE
}
template <int TYPE> __device__ __forceinline__ void attn_unit(const Params& p, int u, char* lds) {
  bf16_t* P = WSP(bf16_t, p, regA); bf16_t* OA = WSP(bf16_t, p, oall);
  int type, b, h, qb;
  if (u < 256) { const int x = u & 7, idx = u >> 3; type = idx >> 4; qb = idx & 15; b = x >> 2; h = x & 3; }
  else { const int v = u - 256; type = v >> 3; b = (v >> 2) & 1; h = v & 3; qb = SEQ / 256; }
  const long q0 = (long)b * NTOK + qb * 256, k0 = (long)b * NTOK + (qb == SEQ / 256 ? SEQ : 0); const int seq = (qb == SEQ / 256) ? CTXL : NTOK;
  if (TYPE == 0) attn_body_s1<MQK, MH * MQK, MH * MQK, MH * MV, DM>(WSP(bf16_t, p, qm) + q0 * (MH * MQK) + h * MQK, WSP(bf16_t, p, km) + k0 * (MH * MQK) + h * MQK, WSP(bf16_t, p, vm) + k0 * (MH * MV) + h * MV,
                                                                 OA + q0 * DM + 3 * BW + h * MV, seq, lds, 0.07216878364870322f  );
  else attn_body<GHD, PW, PW, PW, DM, ATT_SD_GQA>(P + q0 * PW + OFF_GQ + h * GHD, P + k0 * PW + OFF_GK + (h / (GH / GKV)) * GHD, P + k0 * PW + OFF_GV + (h / (GH / GKV)) * GHD,
                                      OA + q0 * DM + BW + h * GHD, seq, lds, 0.08838834764831845f  );
}
}
template <int TYPE> __global__ __launch_bounds__(512, 2) void k_attn(Params p, int l) {
  extern __shared__ __attribute__((aligned(16))) unsigned char shm[];
  const int nu = 256 + (l == 0 ? 16 : 0);
  for (int u = blockIdx.x; u < nu; u += gridDim.x) { const int type = u < 256 ? ((u >> 3) >> 4) : ((u - 256) >> 3); if (type == TYPE) att::attn_unit<TYPE>(p, u, (char*)shm); }
}
#endif
#ifndef CPU_TEST
namespace ret {
using pg8::f32x4; using pg8::u32x4; using pg8::bf16x8;
static_assert(RCH == 128 && RQK == 64 && RV == 128, "retention tiles are written for chunk 128, qk 64, v 128");
constexpr int PT_ = 272, PS = 528, PQ = 144;
constexpr int LDS_A = 2 * 128 * PT_, LDS_C = 128 * PQ + 2 * 128 * PS + 2 * 132 * 4;
template <int NB, int KS> __device__ __forceinline__ void mma16(f32x4 (&acc)[NB], const LAS char* A, int lda, const LAS char* Bt, int ldb) {
  const int lane = threadIdx.x & 63, r = lane & 15, kq = lane >> 4;
#pragma unroll
  for (int s = 0; s < KS; ++s) { const bf16x8 a = *(const LAS bf16x8*)(A + r * lda + (s * 32 + kq * 8) * 2);
#pragma unroll
    for (int nb = 0; nb < NB; ++nb) { const bf16x8 bfr = *(const LAS bf16x8*)(Bt + (nb * 16 + r) * ldb + (s * 32 + kq * 8) * 2); acc[nb] = __builtin_amdgcn_mfma_f32_16x16x32_bf16(a, bfr, acc[nb], 0, 0, 0); } }
}
__device__ __forceinline__ long chunk_row0(int b, int cs) { return (long)b * NTOK + (cs < SEQ / RCH ? cs * RCH : SEQ + (cs - SEQ / RCH) * RCH); }
__device__ __forceinline__ void st16(LAS char* p, unsigned v) { *(LAS unsigned short*)p = (unsigned short)v; }
template <int NC, bool WEIGHT, int PT> __device__ __forceinline__ void stage_T(LAS char* T, LAS char* T2, const bf16_t* src, int ld, float lg1, float lg2) {
#pragma unroll
  for (int i = 0; i < NC / 4; ++i) { const int id = threadIdx.x + 512 * i, key = id & 127, c = id >> 7; const u32x4 w = *(const u32x4*)(src + (long)key * ld + 8 * c);
    if (!WEIGHT) {
      st16(T + (8 * c + 0) * PT + key * 2, w.x); st16(T + (8 * c + 1) * PT + key * 2, w.x >> 16); st16(T + (8 * c + 2) * PT + key * 2, w.y); st16(T + (8 * c + 3) * PT + key * 2, w.y >> 16);
      st16(T + (8 * c + 4) * PT + key * 2, w.z); st16(T + (8 * c + 5) * PT + key * 2, w.z >> 16); st16(T + (8 * c + 6) * PT + key * 2, w.w); st16(T + (8 * c + 7) * PT + key * 2, w.w >> 16);
    } else { f32x4 a, b2; pg8::unpack8(w, a, b2); const float w1 = __expf(lg1 * (float)(RCH - 1 - key)), w2 = __expf(lg2 * (float)key);
#pragma unroll
      for (int j = 0; j < 4; ++j) { st16(T + (8 * c + j) * PT + key * 2, pg8::cvt_pk_bf16(a[j] * w1, 0.f)); st16(T + (8 * c + 4 + j) * PT + key * 2, pg8::cvt_pk_bf16(b2[j] * w1, 0.f));
        st16(T2 + (8 * c + j) * PT + key * 2, pg8::cvt_pk_bf16(a[j] * w2, 0.f)); st16(T2 + (8 * c + 4 + j) * PT + key * 2, pg8::cvt_pk_bf16(b2[j] * w2, 0.f)); } } }
}
__device__ __forceinline__ void ret_a_unit(const Params& p, int l, int u, LAS char* lds) {
  const int cs = u % RNC, h = (u / RNC) % RH, b = u / (RNC * RH), wv = threadIdx.x >> 6, lane = threadIdx.x & 63;
  const float lgf = -__expf(p.in[I_RDF][l * RH + h]), lgb = -__expf(p.in[I_RDB][l * RH + h]);
  const bf16_t* P = WSP(bf16_t, p, regA) + chunk_row0(b, cs) * PW; LAS char* VT = lds; LAS char* KT = lds + 128 * PT_;
  stage_T<16, false, PT_>(VT, nullptr, P + OFF_RV + h * RV, PW, 0.f, 0.f);
  stage_T<8, true, PT_>(KT, KT + 64 * PT_, P + OFF_RK + h * RQK, PW, lgf, lgb);
  __syncthreads();
  f32x4 acc[8];
#pragma unroll
  for (int nb = 0; nb < 8; ++nb) acc[nb] = (f32x4){0.f, 0.f, 0.f, 0.f};
  mma16<8, 4>(acc, VT + wv * 16 * PT_, PT_, KT, PT_);
  float* RKV = WSP(float, p, rkv);
#pragma unroll
  for (int nb = 0; nb < 8; ++nb) { const int col = nb * 16 + (lane & 15), dir = col >> 6, dk = col & 63; float* o = RKV + ((((long)(b * RH + h) * 2 + dir) * RNC + cs) * RV + wv * 16 + (lane >> 4) * 4) * RQK + dk;
#pragma unroll
    for (int r = 0; r < 4; ++r) o[r * RQK] = acc[nb][r]; }
  __syncthreads();
}
__device__ __forceinline__ void ph_ret_scan(const Params& p, int l) {
  const float* RKV = WSP(float, p, rkv); bf16_t* RS = WSP(bf16_t, p, rs); constexpr int NL = SEQ / RCH, NCX = CTXL / RCH;
  for (long i = (long)blockIdx.x * 512 + threadIdx.x; i < (long)NB * RH * 2 * RV * RQK; i += (long)gridDim.x * 512) { const int e = (int)(i % (RV * RQK)), dir = (int)((i / (RV * RQK)) % 2), h = (int)((i / (2 * RV * RQK)) % RH), b = (int)(i / (2 * RV * RQK * RH));
    const float lg = -__expf(p.in[dir ? I_RDB : I_RDF][l * RH + h]), dec = __expf(lg * (float)RCH); const long base = (((long)(b * RH + h) * 2 + dir) * RNC) * (RV * RQK) + e; float S = 0.f;
    for (int s0 = 0; s0 < RNC; s0 += 17) { float kv[17]; int cs_[17];
#pragma unroll
      for (int q = 0; q < 17; ++q) { const int s = s0 + q; cs_[q] = dir == 0 ? (s < NCX ? NL + s : s - NCX) : (RNC - 1 - s); kv[q] = RKV[base + (long)cs_[q] * (RV * RQK)]; }
#pragma unroll
      for (int q = 0; q < 17; ++q) { RS[base + (long)cs_[q] * (RV * RQK)] = (bf16_t)(pg8::cvt_pk_bf16(S, 0.f) & 0xffffu); S = dec * S + kv[q]; } } }
}
__device__ __forceinline__ void ret_c_unit(const Params& p, int l, int u, LAS char* lds) {
  const int ncs = (l == NLAYER - 1) ? SEQ / RCH : RNC; const int cs = u % ncs, h = (u / ncs) % RH, b = u / (ncs * RH), tid = threadIdx.x, wv = tid >> 6, lane = tid & 63;
  const float lgf = -__expf(p.in[I_RDF][l * RH + h]), lgb = -__expf(p.in[I_RDB][l * RH + h]); const long R0 = chunk_row0(b, cs);
  const bf16_t* P = WSP(bf16_t, p, regA) + R0 * PW; LAS char* Ks = lds; LAS char* Ss = lds + 128 * PQ; LAS char* B2 = Ss + 128 * PS; LAS float* gf = (LAS float*)(B2 + 128 * PS); LAS float* gb = gf + 132;
  if (tid < 129) { gf[tid] = __expf(lgf * (float)tid); gb[tid] = __expf(lgb * (float)tid); }
#pragma unroll
  for (int i = 0; i < 2; ++i) { const int id = tid + 512 * i, row = id >> 3, c = id & 7; *(LAS u32x4*)(Ks + row * PQ + c * 16) = *(const u32x4*)(P + (long)row * PW + OFF_RK + h * RQK + 8 * c);
    *(LAS u32x4*)(Ss + row * PS + 256 + c * 16) = *(const u32x4*)(P + (long)row * PW + OFF_RQ + h * RQK + 8 * c); }
  stage_T<16, false, PS>(B2, nullptr, P + OFF_RV + h * RV, PW, 0.f, 0.f);
  { const bf16_t* RS = WSP(bf16_t, p, rs);
#pragma unroll
    for (int i = 0; i < 4; ++i) { const int id = tid + 512 * i, dir = id >> 10, dv = (id >> 3) & 127, c = id & 7;
      *(LAS u32x4*)(B2 + dv * PS + 256 + dir * 128 + c * 16) = *(const u32x4*)(RS + ((((long)(b * RH + h) * 2 + dir) * RNC + cs) * RV + dv) * RQK + 8 * c); } }
  __syncthreads();
  LAS char* myS = Ss + wv * 16 * PS;
  { f32x4 acc[8];
#pragma unroll
    for (int nb = 0; nb < 8; ++nb) acc[nb] = (f32x4){0.f, 0.f, 0.f, 0.f};
    mma16<8, 2>(acc, myS + 256, PS, Ks, PQ);
#pragma unroll
    for (int nb = 0; nb < 8; ++nb) { const int a2 = nb * 16 + (lane & 15);
#pragma unroll
      for (int r = 0; r < 4; ++r) { const int ar = (lane >> 4) * 4 + r, a = wv * 16 + ar; const float f = a2 <= a ? gf[a - a2] : gb[a2 - a]; st16(myS + ar * PS + a2 * 2, pg8::cvt_pk_bf16(acc[nb][r] * f, 0.f)); } } }
#pragma unroll
  for (int i = 0; i < 2; ++i) { const int id = lane + 64 * i, ar = id >> 3, c = id & 7, a = wv * 16 + ar; LAS char* q = myS + ar * PS + 256 + c * 16; f32x4 x0, x1; pg8::unpack8(*(const LAS u32x4*)q, x0, x1);
    const float sf = gf[a + 1], sb = gb[RCH - a]; *(LAS u32x4*)(q + 128) = pg8::pack8(x0 * sb, x1 * sb); *(LAS u32x4*)q = pg8::pack8(x0 * sf, x1 * sf); }
  asm volatile("s_waitcnt lgkmcnt(0)" ::: "memory");
  f32x4 o[8];
#pragma unroll
  for (int nb = 0; nb < 8; ++nb) o[nb] = (f32x4){0.f, 0.f, 0.f, 0.f};
  mma16<8, 8>(o, myS, PS, B2, PS);
  const float* gain = p.in[I_RNORM] + l * BW + h * RV; bf16_t* OA = WSP(bf16_t, p, oall);
#pragma unroll
  for (int r = 0; r < 4; ++r) { float s = 0.f;
#pragma unroll
    for (int nb = 0; nb < 8; ++nb) s += o[nb][r];
    s += __shfl_xor(s, 8); s += __shfl_xor(s, 4); s += __shfl_xor(s, 2); s += __shfl_xor(s, 1); const float mean = s * (1.f / RV); float q = 0.f;
#pragma unroll
    for (int nb = 0; nb < 8; ++nb) { const float d = o[nb][r] - mean; q += d * d; }
    q += __shfl_xor(q, 8); q += __shfl_xor(q, 4); q += __shfl_xor(q, 2); q += __shfl_xor(q, 1); const float rs = 1.f / sqrtf(q * (1.f / RV) + NORM_EPS);
    const long R = R0 + wv * 16 + (lane >> 4) * 4 + r;
#pragma unroll
    for (int nb = 0; nb < 8; ++nb) { const int dv = nb * 16 + (lane & 15); const float gt = bf2f(P[(R - R0) * PW + OFF_RG + h * RV + dv]);
      OA[R * DM + 2 * BW + h * RV + dv] = (bf16_t)(pg8::cvt_pk_bf16((o[nb][r] - mean) * rs * gain[dv] * gt * pg8::fast_sigmoid(gt), 0.f) & 0xffffu); } }
  __syncthreads();
}
}
template <int WHICH> __global__ __launch_bounds__(512, 2) void k_ret(Params p, int l) {
  extern __shared__ __attribute__((aligned(16))) unsigned char shm[]; LAS char* lds = (LAS char*)shm;
  if (WHICH == 0) for (int u = blockIdx.x; u < NB * RH * RNC; u += gridDim.x) ret::ret_a_unit(p, l, u, lds);
  if (WHICH == 1) ret::ph_ret_scan(p, l);
  if (WHICH == 2) { const int nu = NB * RH * ((l == NLAYER - 1) ? SEQ / RCH : RNC); for (int u = blockIdx.x; u < nu; u += gridDim.x) ret::ret_c_unit(p, l, u, lds); }
}
#endif
#ifndef CPU_TEST
static int g_ncu = 256;
template <class Epi, class Sched> static void launch_gemm(const pg8::GemmG& g, const Sched& S, const Epi& E, hipStream_t stream) {
  static bool attr = false;
  if (!attr) { (void)hipFuncSetAttribute((const void*)k_gemm_phase<Epi, Sched>, hipFuncAttributeMaxDynamicSharedMemorySize, pg8::STAGE_BYTES); attr = true; }
  hipLaunchKernelGGL((k_gemm_phase<Epi, Sched>), dim3(g_ncu), dim3(512), pg8::STAGE_BYTES, stream, g, S, E);
}

enum { PH_CONV = 0, PH_MOD, PH_TABLES, PH_LN_IN, PH_POST, PH_LN1, PH_TOPK, PH_GATHER, PH_LN2, PH_S5TAB, PH_S5SCAN };
template <int ID> __global__ __launch_bounds__(512, 2) void k_phase(Params p, int l) {
  extern __shared__ __attribute__((aligned(16))) unsigned char shm[]; LAS unsigned char* lds = (LAS unsigned char*)shm;
  if (ID == PH_CONV) ph::ph_conv(p, lds);
  if (ID == PH_MOD) ph::ph_mod(p, lds);
  if (ID == PH_TABLES) ph::ph_tables(p);
  if (ID == PH_LN_IN) ph::ph_ln_in(p, l);
  if (ID == PH_POST) ph::ph_post_proj(p, l);
  if (ID == PH_LN1) ph::ph_ln1(p, l, lds);
  if (ID == PH_TOPK) ph::ph_topk(p, l, lds);
  if (ID == PH_GATHER) ph::ph_gather(p, l);
  if (ID == PH_LN2) ph::ph_ln2(p, l);
  if (ID == PH_S5TAB) ph::ph_s5tables(p, lds);
  if (ID == PH_S5SCAN) ph::ph_s5scan(p, l);
}
template <int ID> static void launch_phase(const Params& p, int l, hipStream_t stream) {
  static bool attr = false;
  if (!attr) { (void)hipFuncSetAttribute((const void*)k_phase<ID>, hipFuncAttributeMaxDynamicSharedMemorySize, pg8::STAGE_BYTES); attr = true; }
  hipLaunchKernelGGL((k_phase<ID>), dim3(g_ncu), dim3(512), pg8::STAGE_BYTES, stream, p, l);
}
static void gpu_layer(Params& p, int l, hipStream_t stream) {
  using namespace pg8;
  bf16_t* P = WSP(bf16_t, p, regA); bf16_t* PROJ = (bf16_t*)(p.ws + WS.regA + SZ_P); bf16_t* H1 = WSP(bf16_t, p, h1);
  bf16_t* QM = WSP(bf16_t, p, qm); bf16_t* KM = WSP(bf16_t, p, km); bf16_t* VM = WSP(bf16_t, p, vm); bf16_t* Z = WSP(bf16_t, p, z); bf16_t* OA = WSP(bf16_t, p, oall);
  const int last = (l == NLAYER - 1), nMfull = MROWS / 256, nMlat = last ? nMfull - 2 : nMfull;
  if (l == 0) launch_phase<PH_LN_IN>(p, l, stream);
  { SchedGrid S{(const char*)H1, (const char*)(WSP(bf16_t, p, wt_in) + (long)l * PW * DM), DM, DM, nMfull, PW / 256, 0, 0, 0, 0};
    launch_gemm(GemmG{DM, DM, DM, 0}, S, EpiBf16{P, PW, 0}, stream); }
  launch_phase<PH_POST>(p, l, stream);
  { SchedGrid S{(const char*)(P + OFF_CQ), (const char*)(WSP(bf16_t, p, wt_uq) + (long)l * MH * MQK * MQL), PW, MQL, nMfull, MH * MQK / 256, 0, 0, 0, 0};
    launch_gemm(GemmG{PW, MQL, MQL, 0}, S, EpiBf16{QM, MH * MQK, 0}, stream); }
  { SchedGrid S{(const char*)(P + OFF_CKV), (const char*)(WSP(bf16_t, p, wt_ukv) + (long)l * MH * (MNOPE + MV) * MKVL), PW, MKVL, nMfull, MH, 0, 0, 0, 0};
    launch_gemm(GemmG{PW, MKVL, MKVL, 0}, S, EpiKVm{KM, VM}, stream); }
  LAUNCH(nk_post_mla_q, NG((long)MROWS * MH), 256, p);
  { SchedS5 S{(const char*)WSP(bf16_t, p, uh), (const char*)(WSP(bf16_t, p, s5sw) + (long)l * S5G * S5K2 * S5K1), (size_t)S5K2 * S5K1 * 2, 0, 0};
    launch_gemm(GemmG{S5K1 + S5K2, S5K1, S5K1, 0}, S, EpiS5E{WSP(float, p, s5e)}, stream); }
  launch_phase<PH_S5SCAN>(p, l, stream);
  { SchedS5 S{(const char*)WSP(bf16_t, p, uh), (const char*)(WSP(bf16_t, p, s5sv) + (long)l * S5G * S5K1 * (S5K1 + S5K2)), (size_t)S5K1 * (S5K1 + S5K2) * 2, 0, 0};
    launch_gemm(GemmG{S5K1 + S5K2, S5K1 + S5K2, S5K1 + S5K2, 0}, S, EpiS5Y{P, p.in[I_S5D] + (long)l * BW, Z, last, 0}, stream); }
  { SchedGrid S{(const char*)Z, (const char*)(WSP(bf16_t, p, wt_glu) + (long)l * BW * BW), BW, BW, nMfull, BW / 256, 0, 0, 0, 0};
    launch_gemm(GemmG{BW, BW, BW, 0}, S, EpiGluO{Z, OA}, stream); }
  { static bool at = false; if (!at) { (void)hipFuncSetAttribute((const void*)k_attn<0>, hipFuncAttributeMaxDynamicSharedMemorySize, (int)att::shm_attn<MQK>());
      (void)hipFuncSetAttribute((const void*)k_attn<1>, hipFuncAttributeMaxDynamicSharedMemorySize, (int)att::shm_attn<GHD>()); at = true; }
    hipLaunchKernelGGL((k_attn<0>), dim3(g_ncu), dim3(512), att::shm_attn<MQK>(), stream, p, l);
    hipLaunchKernelGGL((k_attn<1>), dim3(g_ncu), dim3(512), att::shm_attn<GHD>(), stream, p, l); }
  { static bool at = false; if (!at) { (void)hipFuncSetAttribute((const void*)k_ret<0>, hipFuncAttributeMaxDynamicSharedMemorySize, ret::LDS_C); (void)hipFuncSetAttribute((const void*)k_ret<2>, hipFuncAttributeMaxDynamicSharedMemorySize, ret::LDS_C); at = true; }
    hipLaunchKernelGGL((k_ret<0>), dim3(g_ncu), dim3(512), ret::LDS_C, stream, p, l);
    hipLaunchKernelGGL((k_ret<1>), dim3(g_ncu), dim3(512), 0, stream, p, l);
    hipLaunchKernelGGL((k_ret<2>), dim3(g_ncu), dim3(512), ret::LDS_C, stream, p, l); }
  { SchedProj S{(const char*)OA, (const char*)(WSP(bf16_t, p, wt_br) + (long)l * 4 * DM * BW), nMlat, last, 0, 0};
    launch_gemm(GemmG{DM, BW, BW, 0}, S, EpiBf16{PROJ, 4 * DM, 0}, stream); }
  { SchedGate S{(const char*)H1, (const char*)(WSP(bf16_t, p, wt_gate) + (long)l * 4 * DM * DM), nMlat, last, 0, 0};
    launch_gemm(GemmG{DM, DM, DM, 0}, S, EpiGateMerge{p.in[I_BGATE] + (long)l * 4 * DM, PROJ, WSP(float, p, macc), WSP(bf16_t, p, merged)}, stream); }
  { SchedGrid S{(const char*)WSP(bf16_t, p, merged), (const char*)(WSP(bf16_t, p, wt_out) + (long)l * DM * DM), DM, DM, nMlat, DM / 256, last, 0, 0, 0};
    launch_gemm(GemmG{DM, DM, DM, 0}, S, EpiF32{WSP(float, p, macc), DM, 0}, stream); }
  launch_phase<PH_LN1>(p, l, stream);
  launch_phase<PH_TOPK>(p, l, stream);
  launch_phase<PH_GATHER>(p, l, stream);
  bf16_t* XS = WSP(bf16_t, p, regA); bf16_t* ACT = (bf16_t*)(p.ws + WS.regA + SZ_XS); bf16_t* YS = (bf16_t*)(p.ws + WS.regA + SZ_XS + SZ_ACT);
  const int nMl = last ? (2 * CAP_L) / 256 : XEP / 256;
  { SchedMoe S{(const char*)XS, (const char*)(WSP(bf16_t, p, wt_gu) + (long)l * NE * 2 * FF * DM), DM, DM, nMl, 2 * FF / 256, (size_t)2 * FF * DM * 2, 0, 0};
    launch_gemm(GemmG{DM, DM, DM, 0}, S, EpiSwiGlu{ACT}, stream); }
  { SchedMoe S{(const char*)ACT, (const char*)(WSP(bf16_t, p, wt_dn) + (long)l * NE * DM * FF), FF, FF, nMl, DM / 256, (size_t)DM * FF * 2, 0, 0};
    launch_gemm(GemmG{FF, FF, FF, 0}, S, EpiDownG{WSP(float, p, gatev), YS}, stream); }
  launch_phase<PH_LN2>(p, l, stream);
}

extern "C" void kernel_launch(void* const* d_in, const int* in_sizes, int n_in, void* d_out, int out_size, void* d_ws, size_t ws_size, hipStream_t stream) {
  if (n_in != N_IN || ws_size < WS.end || out_size != NB * SEQ * DM) { fprintf(stderr, "kernel_launch: unexpected sizes n_in %d ws %zu (need %zu) out %d\n", n_in, ws_size, WS.end, out_size); return; }
  Params p; memset(&p, 0, sizeof(p));
  for (int i = 0; i < N_IN; ++i) p.in[i] = (const float*)d_in[i];
  p.out = (float*)d_out; p.ws = (char*)d_ws;
  launch_phase<PH_CONV>(p, 0, stream); launch_phase<PH_MOD>(p, 0, stream); launch_phase<PH_TABLES>(p, 0, stream); launch_phase<PH_S5TAB>(p, 0, stream);
  for (int l = 0; l < NLAYER; ++l) gpu_layer(p, l, stream);
}
#endif
```

```cpp
#ifdef CPU_TEST
#include <cmath>
#include <cstdio>
#include <cstdlib>
#include <cstring>
#include <cstdint>
#include <functional>
#define __global__
#define __device__
#define __host__
#define __forceinline__ inline
#define __launch_bounds__(...)
#define __restrict__
struct dim3s { int x, y, z; };
static thread_local dim3s blockIdx, threadIdx, blockDim, gridDim;
typedef void* hipStream_t;
template <class F> static void cpu_launch(int grid, int block, F f) {
#pragma omp parallel for schedule(dynamic, 1)
  for (int b = 0; b < grid; ++b) {
    gridDim.x = grid; blockDim.x = block; blockIdx.x = b;
    for (int t = 0; t < block; ++t) { threadIdx.x = t; f(); }
  }
}
#define LAUNCH(kern, grid, block, ...) cpu_launch((grid), (block), [&]() { kern(__VA_ARGS__); })
static inline void hipMemsetAsync(void* p, int v, size_t n, hipStream_t) { memset(p, v, n); }
#else
#include <hip/hip_runtime.h>
#include <cstdio>
#include <cstdint>
#include <cstring>
#define LAUNCH(kern, grid, block, ...) hipLaunchKernelGGL(kern, dim3(grid), dim3(block), 0, stream, __VA_ARGS__)
#endif

typedef unsigned short bf16_t;

#ifndef CFG_DM
#define CFG_DM 2048
#define CFG_SEQ 4096
#define CFG_GRIDW 64
#define CFG_CTX 256
#define CFG_S5P 64
#define CFG_GHD 128
#define CFG_RCHUNK 128
#define CFG_MNOPE 128
#define CFG_MROPE 64
#define CFG_NE 16
#endif
constexpr int DM = CFG_DM, NB = 2, SEQ = CFG_SEQ, GRIDW = CFG_GRIDW, CTXL = CFG_CTX, NLAYER = 2;
constexpr int BW = DM / 4, S5CH = 16, S5G = BW / S5CH, S5P = CFG_S5P;
constexpr int GHD = CFG_GHD, GH = BW / GHD, GKV = GH / 2;
constexpr int RH = 4, RV = BW / RH, RQK = RV / 2;
constexpr int MQL = BW, MKVL = BW / 2, MH = 4, MNOPE = CFG_MNOPE, MROPE = CFG_MROPE, MV = BW / MH, MQK = MNOPE + MROPE;
constexpr int NE = CFG_NE, FF = DM / 2;
constexpr int NTOK = SEQ + CTXL, MROWS = NB * NTOK;
constexpr int OFF_U = 0, OFF_GQ = BW, OFF_GK = OFF_GQ + GH * GHD, OFF_GV = OFF_GK + GKV * GHD, OFF_RQ = OFF_GV + GKV * GHD, OFF_RK = OFF_RQ + RH * RQK,
              OFF_RV = OFF_RK + RH * RQK, OFF_RG = OFF_RV + RH * RV, OFF_CQ = OFF_RG + RH * RV, OFF_CKV = OFF_CQ + MQL, OFF_KR = OFF_CKV + MKVL, IN_TOTAL = OFF_KR + MROPE;
constexpr int PW = (IN_TOTAL + 255) / 256 * 256;
constexpr int CAP_L = 2 * SEQ / NE, CAP_C = 2 * CTXL / NE;
constexpr int XE = 2 * CAP_L + 2 * CAP_C, XEP = (XE + 255) / 256 * 256;
constexpr int XROWS = NE * XEP;
constexpr int NROPE_A = GHD / 4, NROPE_B = RQK / 4;
static_assert(MROPE / 4 == NROPE_B, "rope tables");
static_assert(MNOPE == MV, "kv split");
constexpr int S5LC = 16, S5NC = NTOK / S5LC, S5NN = NB * S5NC, S5NP = (S5NN + 255) / 256 * 256, S5K1 = S5LC * S5CH, S5K2 = 2 * S5P * 2;
constexpr int RCH = CFG_RCHUNK, RNC = NTOK / RCH;
constexpr float NORM_EPS = 1e-6f;
constexpr float DN_ALPHA = 1.4142135623730951f;

enum { I_X = 0, I_C, I_CTX, I_CCTX, I_ADAW, I_ADAB, I_WIN, I_S5AREF, I_S5AIMF, I_S5DTF, I_S5AREB, I_S5AIMB, I_S5DTB, I_S5BRE, I_S5BIM, I_S5CRE, I_S5CIM, I_S5D, I_S5GLU,
       I_GQN, I_GKN, I_RDF, I_RDB, I_RNORM, I_MQN, I_MKVN, I_WUQ, I_WUKV, I_WBR, I_WGATE, I_BGATE, I_WOUT, I_LN1G, I_LN1B, I_ROUTER, I_MOEG, I_MOEU, I_MOED, I_LN2G, I_LN2B, N_IN };

constexpr size_t al256(size_t x) { return (x + 255) / 256 * 256; }
struct WsLayout {
  size_t bar, mod, rope_a, rope_b, s5tab, wt_in, wt_gate, wt_br, wt_out, wt_glu, wt_uq, wt_ukv, wt_gu, wt_dn;
  size_t x1, x2, h1, h2, regA  , qm, km, vm, z, oall, macc  , merged, aff, slot, gatev, xsrc, retst, s5st, uh, s5e, s5sw, s5sv, rkv, rs, zrow, end;
};
constexpr size_t SZ_P = (size_t)MROWS * PW * 2, SZ_PROJ = (size_t)MROWS * 4 * DM * 2;
constexpr size_t SZ_XS = (size_t)XROWS * DM * 2, SZ_ACT = (size_t)XROWS * FF * 2, SZ_YS = (size_t)XROWS * DM * 2;
constexpr size_t SZ_HS = (size_t)MROWS * S5G * S5P * 2 * 4;
constexpr size_t cmax(size_t a, size_t b) { return a > b ? a : b; }
constexpr WsLayout make_ws() {
  WsLayout w{}; size_t o = 0;
  w.bar = o; o += al256(16384);
  w.mod = o; o += al256((size_t)NLAYER * 3 * 6 * DM * 4);
  w.rope_a = o; o += al256((size_t)GRIDW * NROPE_A * 2 * 4);
  w.rope_b = o; o += al256((size_t)GRIDW * NROPE_B * 2 * 4);
  w.s5tab = o; o += al256((size_t)NLAYER * 2 * S5G * S5P * (2 + 2 * S5CH) * 4);
  w.wt_in = o; o += al256((size_t)NLAYER * PW * DM * 2);
  w.wt_gate = o; o += al256((size_t)NLAYER * 4 * DM * DM * 2);
  w.wt_br = o; o += al256((size_t)NLAYER * 4 * DM * BW * 2);
  w.wt_out = o; o += al256((size_t)NLAYER * DM * DM * 2);
  w.wt_glu = o; o += al256((size_t)NLAYER * BW * BW * 2);
  w.wt_uq = o; o += al256((size_t)NLAYER * MH * MQK * MQL * 2);
  w.wt_ukv = o; o += al256((size_t)NLAYER * MH * (MNOPE + MV) * MKVL * 2);
  w.wt_gu = o; o += al256((size_t)NLAYER * NE * 2 * FF * DM * 2);
  w.wt_dn = o; o += al256((size_t)NLAYER * NE * DM * FF * 2);
  w.x1 = o; o += al256((size_t)MROWS * DM * 4);
  w.x2 = o; o += al256((size_t)MROWS * DM * 4);
  w.h1 = o; o += al256((size_t)MROWS * DM * 2);
  w.h2 = o; o += al256((size_t)MROWS * DM * 2);
  w.regA = o; o += al256(cmax(cmax(SZ_P + SZ_PROJ, SZ_XS + SZ_ACT + SZ_YS), SZ_P + SZ_HS));
  w.qm = o; o += al256((size_t)MROWS * MH * MQK * 2);
  w.km = o; o += al256((size_t)MROWS * MH * MQK * 2);
  w.vm = o; o += al256((size_t)MROWS * MH * MV * 2);
  w.z = o; o += al256((size_t)MROWS * BW * 2);
  w.oall = o; o += al256((size_t)MROWS * DM * 2);
  w.macc = o; o += al256((size_t)MROWS * DM * 4);
  w.merged = o; o += al256((size_t)MROWS * DM * 2);
  w.aff = o; o += al256((size_t)MROWS * NE * 4);
  w.slot = o; o += al256((size_t)MROWS * NE * 4);
  w.gatev = o; o += al256((size_t)XROWS * 4);
  w.xsrc = o; o += al256((size_t)XROWS * 4);
  w.retst = o; o += al256((size_t)NB * RH * 2 * RQK * RV * 4);
  w.s5st = o; o += al256((size_t)NB * 2 * S5G * S5P * 2 * 4);
  w.uh = o; o += al256((size_t)S5G * S5NP * (S5K1 + S5K2) * 2);
  w.s5e = o; o += al256((size_t)S5G * S5NP * S5K2 * 4);
  w.s5sw = o; o += al256((size_t)NLAYER * S5G * S5K2 * S5K1 * 2);
  w.s5sv = o; o += al256((size_t)NLAYER * S5G * S5K1 * (S5K1 + S5K2) * 2);
  w.rkv = o; o += al256((size_t)NB * RH * 2 * RNC * RV * RQK * 4);
  w.rs = o; o += al256((size_t)NB * RH * 2 * RNC * RV * RQK * 2);
  w.zrow = o; o += al256((size_t)DM * 2);
  w.end = o; return w;
}
constexpr WsLayout WS = make_ws();

struct Params {
  const float* in[N_IN];
  float* out;
  char* ws;
};

__host__ __device__ __forceinline__ float bf2f(bf16_t b) { union { unsigned u; float f; } c; c.u = ((unsigned)b) << 16; return c.f; }
__host__ __device__ __forceinline__ bf16_t f2bf(float f) { union { unsigned u; float f; } c; c.f = f; unsigned u = c.u; u += 0x7FFFu + ((u >> 16) & 1u); return (bf16_t)(u >> 16); }
__host__ __device__ __forceinline__ float sigmoidf_(float x) { return 1.f / (1.f + expf(-x)); }
__host__ __device__ __forceinline__ float siluf_(float x) { return x / (1.f + expf(-x)); }
__host__ __device__ __forceinline__ float gelu_tanh(float x) { return 0.5f * x * (1.f + tanhf(0.7978845608028654f * (x + 0.044715f * x * x * x))); }
__host__ __device__ __forceinline__ int row_b(int R) { return R / NTOK; }
__host__ __device__ __forceinline__ int row_t(int R) { return R % NTOK; }
__host__ __device__ __forceinline__ bool row_is_ctx(int R) { return (R % NTOK) >= SEQ; }
__host__ __device__ __forceinline__ int row_mod(int R) { return row_is_ctx(R) ? 2 : row_b(R); }
#ifndef CPU_TEST
__device__ __forceinline__ int ph_tid() { int t = threadIdx.x; asm volatile("" : "+v"(t)); return t; }
#endif
#define GSTRIDE(i, n) for (long i = (long)blockIdx.x * blockDim.x + threadIdx.x; i < (long)(n); i += (long)gridDim.x * blockDim.x)
#define WSP(T, p, field) ((T*)((p).ws + WS.field))

__global__ void nk_conv_t(bf16_t* dst, const float* src, int K, int N, int ldsrc, int Ndst) {
  GSTRIDE(i, (long)Ndst * K) { int n = (int)(i / K), k = (int)(i % K); dst[i] = n < N ? f2bf(src[(long)k * ldsrc + n]) : (bf16_t)0; }
}
__global__ void nk_conv_gu(bf16_t* dst, const float* wg, const float* wu) {
  GSTRIDE(i, (long)2 * FF * DM) { int j = (int)(i / DM), k = (int)(i % DM); int tile = j / 256, r = j % 256, f = tile * 128 + (r & 127);
    const float* s = (r < 128) ? wg : wu; dst[i] = f2bf(s[(long)k * FF + f]); }
}
__global__ void nk_mod(Params p) {
  float* mod = WSP(float, p, mod);
  GSTRIDE(i, (long)NLAYER * 3 * 6 * DM) { int j = (int)(i % (6 * DM)), r = (int)((i / (6 * DM)) % 3), l = (int)(i / (18 * DM));
    const float* cv = (r < 2) ? p.in[I_C] + (long)r * DM : p.in[I_CCTX]; const float* w = p.in[I_ADAW] + (long)l * DM * 6 * DM;
    float acc = 0.f; for (int k = 0; k < DM; ++k) acc += siluf_(cv[k]) * w[(long)k * 6 * DM + j];
    mod[i] = acc + p.in[I_ADAB][(long)l * 6 * DM + j]; }
}
__global__ void nk_rope_tab(Params p) {
  float* ta = WSP(float, p, rope_a); float* tb = WSP(float, p, rope_b);
  GSTRIDE(i, (long)GRIDW * (NROPE_A + NROPE_B)) { int pos = (int)(i / (NROPE_A + NROPE_B)), k = (int)(i % (NROPE_A + NROPE_B));
    if (k < NROPE_A) { float inv = powf(10000.f, -(float)k / NROPE_A), a = pos * inv; ta[(pos * NROPE_A + k) * 2] = cosf(a); ta[(pos * NROPE_A + k) * 2 + 1] = sinf(a); }
    else { int kk = k - NROPE_A; float inv = powf(10000.f, -(float)kk / NROPE_B), a = pos * inv; tb[(pos * NROPE_B + kk) * 2] = cosf(a); tb[(pos * NROPE_B + kk) * 2 + 1] = sinf(a); } }
}
constexpr int S5TW = 2 + 2 * S5CH;
__global__ void nk_s5tab(Params p) {
  float* tab = WSP(float, p, s5tab);
  GSTRIDE(i, (long)NLAYER * 2 * S5G * S5P) { int pp = (int)(i % S5P), g = (int)((i / S5P) % S5G), dir = (int)((i / (S5P * S5G)) % 2), l = (int)(i / (2 * S5P * S5G));
    const float a_re = p.in[dir ? I_S5AREB : I_S5AREF][(l * S5G + g) * S5P + pp], a_im = p.in[dir ? I_S5AIMB : I_S5AIMF][(l * S5G + g) * S5P + pp];
    const float dt = expf(p.in[dir ? I_S5DTB : I_S5DTF][l * S5G + g]);
    const float mag = expf(a_re * dt), ab_re = mag * cosf(a_im * dt), ab_im = mag * sinf(a_im * dt);
    const float den = a_re * a_re + a_im * a_im, nr = ab_re - 1.f, ni = ab_im;
    const float cr = (nr * a_re + ni * a_im) / den, ci = (ni * a_re - nr * a_im) / den;
    float* t = tab + i * S5TW; t[0] = ab_re; t[1] = ab_im;
    for (int c = 0; c < S5CH; ++c) { const float br = p.in[I_S5BRE][((l * S5G + g) * S5P + pp) * S5CH + c], bi = p.in[I_S5BIM][((l * S5G + g) * S5P + pp) * S5CH + c];
      t[2 + c] = cr * br - ci * bi; t[2 + S5CH + c] = cr * bi + ci * br; } }
}
__global__ void nk_load_x(Params p) {
  float* X2 = WSP(float, p, x2);
  GSTRIDE(i, (long)MROWS * DM) { int R = (int)(i / DM), d = (int)(i % DM), b = row_b(R), t = row_t(R);
    X2[i] = t < SEQ ? p.in[I_X][((long)b * SEQ + t) * DM + d] : p.in[I_CTX][((long)b * CTXL + (t - SEQ)) * DM + d]; }
}
__global__ void nk_ln_mod(Params p, bf16_t* H, const float* X, int l, int ch_sh, int ch_sc) {
  const float* mod = WSP(float, p, mod) + (long)l * 3 * 6 * DM;
  GSTRIDE(R, MROWS) { const float* x = X + R * DM; float s = 0.f; for (int d = 0; d < DM; ++d) s += x[d]; const float mean = s / DM;
    float v = 0.f; for (int d = 0; d < DM; ++d) { float c = x[d] - mean; v += c * c; } const float rs = 1.f / sqrtf(v / DM + NORM_EPS);
    const float* m = mod + (long)row_mod((int)R) * 6 * DM;
    for (int d = 0; d < DM; ++d) H[R * DM + d] = f2bf((x[d] - mean) * rs * (1.f + m[ch_sc * DM + d]) + m[ch_sh * DM + d]); }
}
template <class Epi> __global__ void nk_gemm(const bf16_t* A, long lda, const bf16_t* Bt, long ldb, int M, int N, int K, Epi epi) {
  GSTRIDE(i, (long)M * (N / 4)) { int m = (int)(i / (N / 4)), n = (int)(i % (N / 4)) * 4; float a0 = 0.f, a1 = 0.f, a2 = 0.f, a3 = 0.f;
    const bf16_t* ar = A + (long)m * lda; const bf16_t* b0 = Bt + (long)n * ldb;
    for (int k = 0; k < K; ++k) { const float a = bf2f(ar[k]); a0 += a * bf2f(b0[k]); a1 += a * bf2f(b0[ldb + k]); a2 += a * bf2f(b0[2 * ldb + k]); a3 += a * bf2f(b0[3 * ldb + k]); }
    epi(m, n, a0, a1, a2, a3); }
}
struct EpStoreBf16 { bf16_t* C; long ldc; __host__ __device__ void operator()(int m, int n, float a0, float a1, float a2, float a3) const {
  bf16_t* c = C + (long)m * ldc + n; c[0] = f2bf(a0); c[1] = f2bf(a1); c[2] = f2bf(a2); c[3] = f2bf(a3); } };
struct EpStoreF32 { float* C; long ldc; __host__ __device__ void operator()(int m, int n, float a0, float a1, float a2, float a3) const {
  float* c = C + (long)m * ldc + n; c[0] = a0; c[1] = a1; c[2] = a2; c[3] = a3; } };
struct EpKV { bf16_t* KM; bf16_t* VM; __host__ __device__ void operator()(int m, int n, float a0, float a1, float a2, float a3) const {
  const int h = n / (MNOPE + MV), r = n % (MNOPE + MV);
  bf16_t* c = (r < MNOPE) ? KM + (long)m * MH * MQK + h * MQK + r : VM + (long)m * MH * MV + h * MV + (r - MNOPE);
  c[0] = f2bf(a0); c[1] = f2bf(a1); c[2] = f2bf(a2); c[3] = f2bf(a3); } };
struct EpGlu { const bf16_t* Z; bf16_t* O; __host__ __device__ void operator()(int m, int n, float a0, float a1, float a2, float a3) const {
  const bf16_t* z = Z + (long)m * BW + n; bf16_t* o = O + (long)m * DM + n;
  o[0] = f2bf(bf2f(z[0]) * sigmoidf_(a0)); o[1] = f2bf(bf2f(z[1]) * sigmoidf_(a1)); o[2] = f2bf(bf2f(z[2]) * sigmoidf_(a2)); o[3] = f2bf(bf2f(z[3]) * sigmoidf_(a3)); } };
struct EpDown { const float* gate; bf16_t* Y; __host__ __device__ void operator()(int m, int n, float a0, float a1, float a2, float a3) const {
  const float g = gate[m]; bf16_t* y = Y + (long)m * DM + n; y[0] = f2bf(a0 * g); y[1] = f2bf(a1 * g); y[2] = f2bf(a2 * g); y[3] = f2bf(a3 * g); } };

__device__ __forceinline__ void rope_pair(bf16_t* x, int i1, int i2, float sc1, float sc2, bool rot, const float* cs) {
  const float c = rot ? cs[0] : 1.f, s = rot ? cs[1] : 0.f; const float a = bf2f(x[i1]) * sc1, b = bf2f(x[i2]) * sc2; x[i1] = f2bf(a * c - b * s); x[i2] = f2bf(a * s + b * c);
}
__global__ void nk_post_proj(Params p, int l) {
  bf16_t* P = WSP(bf16_t, p, regA); const float* ta = WSP(float, p, rope_a); const float* tb = WSP(float, p, rope_b);
  constexpr int NJ = GH + GKV + 2 * RH + 3;
  GSTRIDE(i, (long)MROWS * NJ) { const int R = (int)(i / NJ), j = (int)(i % NJ), t = row_t(R); const bool lat = t < SEQ; const int gr = lat ? t / GRIDW : 0, gc = lat ? t % GRIDW : 0;
    bf16_t* pr = P + (long)R * PW;
    if (j < GH + GKV) {
      bf16_t* x = pr + (j < GH ? OFF_GQ + j * GHD : OFF_GK + (j - GH) * GHD); const float* g = p.in[j < GH ? I_GQN : I_GKN] + l * GHD;
      float ss = 0.f; for (int d = 0; d < GHD; ++d) { float v = bf2f(x[d]); ss += v * v; } const float r = 1.f / sqrtf(ss / GHD + NORM_EPS);
      for (int hf = 0; hf < 2; ++hf) for (int k = 0; k < NROPE_A; ++k) { const int i1 = hf * 2 * NROPE_A + k, i2 = i1 + NROPE_A;
        rope_pair(x, i1, i2, r * g[i1], r * g[i2], lat, ta + ((hf ? gc : gr) * NROPE_A + k) * 2); }
    } else if (j < GH + GKV + 2 * RH) {
      const int jj = j - GH - GKV; const bool isk = jj >= RH; bf16_t* x = pr + (isk ? OFF_RK + (jj - RH) * RQK : OFF_RQ + jj * RQK); const float sc = isk ? 1.f / sqrtf((float)RQK) : 1.f;
      for (int hf = 0; hf < 2; ++hf) for (int k = 0; k < NROPE_B; ++k) { const int i1 = hf * 2 * NROPE_B + k, i2 = i1 + NROPE_B;
        rope_pair(x, i1, i2, sc, sc, lat, tb + ((hf ? gc : gr) * NROPE_B + k) * 2); }
    } else if (j == GH + GKV + 2 * RH) {
      bf16_t* x = pr + OFF_CQ; const float* g = p.in[I_MQN] + l * MQL; float ss = 0.f; for (int d = 0; d < MQL; ++d) { float v = bf2f(x[d]); ss += v * v; }
      const float r = 1.f / sqrtf(ss / MQL + NORM_EPS); for (int d = 0; d < MQL; ++d) x[d] = f2bf(bf2f(x[d]) * r * g[d]);
    } else if (j == GH + GKV + 2 * RH + 1) {
      bf16_t* x = pr + OFF_CKV; const float* g = p.in[I_MKVN] + l * MKVL; float ss = 0.f; for (int d = 0; d < MKVL; ++d) { float v = bf2f(x[d]); ss += v * v; }
      const float r = 1.f / sqrtf(ss / MKVL + NORM_EPS); for (int d = 0; d < MKVL; ++d) x[d] = f2bf(bf2f(x[d]) * r * g[d]);
    } else if (lat) {
      bf16_t* x = pr + OFF_KR;
      for (int hf = 0; hf < 2; ++hf) for (int k = 0; k < NROPE_B; ++k) { const int i1 = hf * 2 * NROPE_B + k, i2 = i1 + NROPE_B; rope_pair(x, i1, i2, 1.f, 1.f, true, tb + ((hf ? gc : gr) * NROPE_B + k) * 2); }
    } }
}
__global__ void nk_post_mla(Params p) {
  bf16_t* P = WSP(bf16_t, p, regA); bf16_t* QM = WSP(bf16_t, p, qm); bf16_t* KM = WSP(bf16_t, p, km); const float* tb = WSP(float, p, rope_b);
  GSTRIDE(i, (long)MROWS * MH) { const int R = (int)(i / MH), h = (int)(i % MH), t = row_t(R); const bool lat = t < SEQ;
    if (lat) { const int gr = t / GRIDW, gc = t % GRIDW; bf16_t* x = QM + (long)R * MH * MQK + h * MQK + MNOPE;
      for (int hf = 0; hf < 2; ++hf) for (int k = 0; k < NROPE_B; ++k) { const int i1 = hf * 2 * NROPE_B + k, i2 = i1 + NROPE_B; rope_pair(x, i1, i2, 1.f, 1.f, true, tb + ((hf ? gc : gr) * NROPE_B + k) * 2); } }
    for (int d = 0; d < MROPE; ++d) KM[(long)R * MH * MQK + h * MQK + MNOPE + d] = P[(long)R * PW + OFF_KR + d]; }
}
__global__ void nk_post_mla_q(Params p) {
  bf16_t* QM = WSP(bf16_t, p, qm); const float* tb = WSP(float, p, rope_b);
  GSTRIDE(i, (long)MROWS * MH) { const int R = (int)(i / MH), h = (int)(i % MH), t = row_t(R); const bool lat = t < SEQ;
    if (lat) { const int gr = t / GRIDW, gc = t % GRIDW; bf16_t* x = QM + (long)R * MH * MQK + h * MQK + MNOPE;
      for (int hf = 0; hf < 2; ++hf) for (int k = 0; k < NROPE_B; ++k) { const int i1 = hf * 2 * NROPE_B + k, i2 = i1 + NROPE_B; rope_pair(x, i1, i2, 1.f, 1.f, true, tb + ((hf ? gc : gr) * NROPE_B + k) * 2); } } }
}
__global__ void nk_s5_scan(Params p, int l) {
  const bf16_t* P = WSP(bf16_t, p, regA); float* HS = (float*)(p.ws + WS.regA + SZ_P); const float* tab = WSP(float, p, s5tab);
  GSTRIDE(i, (long)NB * S5G * S5P) { const int pp = (int)(i % S5P), g = (int)((i / S5P) % S5G), b = (int)(i / (S5P * S5G));
    for (int dir = 0; dir < 2; ++dir) { const float* t = tab + ((((long)l * 2 + dir) * S5G + g) * S5P + pp) * S5TW; const float are = t[0], aim = t[1]; float hr = 0.f, hi = 0.f;
      for (int s = 0; s < NTOK; ++s) {
        int tt; if (!dir) tt = s < CTXL ? SEQ + s : s - CTXL; else tt = s < CTXL ? SEQ + (CTXL - 1 - s) : SEQ - 1 - (s - CTXL);
        const long R = (long)b * NTOK + tt; const bf16_t* u = P + R * PW + OFF_U + g * S5CH; float br = 0.f, bi = 0.f;
        for (int c = 0; c < S5CH; ++c) { const float uv = bf2f(u[c]); br += uv * t[2 + c]; bi += uv * t[2 + S5CH + c]; }
        const float nr = are * hr - aim * hi + br, ni = are * hi + aim * hr + bi; hr = nr; hi = ni;
        float* hs = HS + ((R * S5G + g) * S5P + pp) * 2; if (!dir) { hs[0] = hr; hs[1] = hi; } else { hs[0] += hr; hs[1] += hi; } } } }
}
__global__ void nk_s5_read(Params p, int l) {
  const bf16_t* P = WSP(bf16_t, p, regA); const float* HS = (const float*)(p.ws + WS.regA + SZ_P); bf16_t* Z = WSP(bf16_t, p, z);
  GSTRIDE(i, (long)MROWS * BW) { const long R = i / BW; const int c = (int)(i % BW), g = c / S5CH, ci = c % S5CH;
    const float* hs = HS + (R * S5G + g) * S5P * 2; const float* cre = p.in[I_S5CRE] + (((long)l * S5G + g) * S5CH + ci) * S5P; const float* cim = p.in[I_S5CIM] + (((long)l * S5G + g) * S5CH + ci) * S5P;
    float y = 0.f; for (int pp = 0; pp < S5P; ++pp) y += hs[2 * pp] * cre[pp] - hs[2 * pp + 1] * cim[pp];
    y += p.in[I_S5D][l * BW + c] * bf2f(P[R * PW + OFF_U + c]); Z[i] = f2bf(gelu_tanh(y)); }
}
template <int DQK, int DV> __global__ void __launch_bounds__(256) nk_attn(const bf16_t* Q, const bf16_t* K, const bf16_t* V, bf16_t* O, int ldq, int ldk, int ldv, int ldo, int H, int group, float scale) {
  GSTRIDE(i, (long)MROWS * H) { const int R = (int)(i / H), h = (int)(i % H), b = row_b(R), kh = h / group; const bool lat = !row_is_ctx(R);
    const bf16_t* q = Q + (long)R * ldq + h * DQK; float o[DV]; _Pragma("unroll") for (int d = 0; d < DV; ++d) o[d] = 0.f; float m = -1e30f, lsum = 0.f;
    for (int kk = lat ? 0 : SEQ; kk < NTOK; ++kk) { const long KR = (long)b * NTOK + kk; const bf16_t* kp = K + KR * ldk + kh * DQK; float s = 0.f;
      for (int d = 0; d < DQK; ++d) s += bf2f(q[d]) * bf2f(kp[d]); s *= scale;
      if (s > m) { const float corr = expf(m - s); lsum *= corr; _Pragma("unroll") for (int d = 0; d < DV; ++d) o[d] *= corr; m = s; }
      const float pw = expf(s - m); lsum += pw; const bf16_t* vp = V + KR * ldv + kh * DV; _Pragma("unroll") for (int d = 0; d < DV; ++d) o[d] += pw * bf2f(vp[d]); }
    const float inv = 1.f / lsum; _Pragma("unroll") for (int d = 0; d < DV; ++d) O[(long)R * ldo + h * DV + d] = f2bf(o[d] * inv); }
}
__global__ void __launch_bounds__(256) nk_ret(Params p, int l) {
  const bf16_t* P = WSP(bf16_t, p, regA); bf16_t* O = WSP(bf16_t, p, oall);
  GSTRIDE(i, (long)MROWS * RH) { const int R = (int)(i / RH), h = (int)(i % RH), b = row_b(R), t = row_t(R); const bool lat = t < SEQ;
    const float lgf = -expf(p.in[I_RDF][l * RH + h]), lgb = -expf(p.in[I_RDB][l * RH + h]);
    const bf16_t* q = P + (long)R * PW + OFF_RQ + h * RQK; float o[RV]; _Pragma("unroll") for (int d = 0; d < RV; ++d) o[d] = 0.f;
    for (int kk = lat ? 0 : SEQ; kk < NTOK; ++kk) { float w;
      if (lat) { if (kk < SEQ) w = kk <= t ? expf(lgf * (float)(t - kk)) : expf(lgb * (float)(kk - t)); else { const int j = kk - SEQ; w = expf(lgf * (float)(t + CTXL - j)) + expf(lgb * (float)(SEQ - t + j)); } }
      else { const int j = t - SEQ, j2 = kk - SEQ; w = j2 <= j ? expf(lgf * (float)(j - j2)) : expf(lgb * (float)(j2 - j)); }
      const long KR = (long)b * NTOK + kk; const bf16_t* kp = P + KR * PW + OFF_RK + h * RQK; float s = 0.f; for (int d = 0; d < RQK; ++d) s += bf2f(q[d]) * bf2f(kp[d]); s *= w;
      const bf16_t* vp = P + KR * PW + OFF_RV + h * RV; _Pragma("unroll") for (int d = 0; d < RV; ++d) o[d] += s * bf2f(vp[d]); }
    float mean = 0.f; _Pragma("unroll") for (int d = 0; d < RV; ++d) mean += o[d]; mean /= RV; float var = 0.f; _Pragma("unroll") for (int d = 0; d < RV; ++d) { const float c = o[d] - mean; var += c * c; }
    const float rs = 1.f / sqrtf(var / RV + NORM_EPS); const bf16_t* gp = P + (long)R * PW + OFF_RG + h * RV; const float* gain = p.in[I_RNORM] + l * BW + h * RV;
    _Pragma("unroll") for (int d = 0; d < RV; ++d) O[(long)R * DM + 2 * BW + h * RV + d] = f2bf((o[d] - mean) * rs * gain[d] * siluf_(bf2f(gp[d]))); }
}
__global__ void nk_gate_merge(Params p, int l) {
  const bf16_t* H = WSP(bf16_t, p, h1); const bf16_t* Wg = WSP(bf16_t, p, wt_gate) + (long)l * 4 * DM * DM; const bf16_t* PROJ = (const bf16_t*)(p.ws + WS.regA + SZ_P); bf16_t* MG = WSP(bf16_t, p, merged);
  const float* bg = p.in[I_BGATE] + (long)l * 4 * DM;
  GSTRIDE(i, (long)MROWS * DM) { const long R = i / DM; const int d = (int)(i % DM); const bf16_t* hr = H + R * DM; float acc = 0.f;
    for (int k = 0; k < 4; ++k) { const bf16_t* w = Wg + ((long)k * DM + d) * DM; float s = 0.f; for (int c = 0; c < DM; ++c) s += bf2f(hr[c]) * bf2f(w[c]);
      acc += sigmoidf_(s + bg[k * DM + d]) * bf2f(PROJ[R * 4 * DM + k * DM + d]); }
    MG[i] = f2bf(acc); }
}
__global__ void nk_ln1(Params p, int l) {
  const float* X2 = WSP(float, p, x2); const float* Y = WSP(float, p, macc); float* X1 = WSP(float, p, x1); bf16_t* H2 = WSP(bf16_t, p, h2); float* AFF = WSP(float, p, aff);
  const float* mod = WSP(float, p, mod) + (long)l * 3 * 6 * DM; const float* lg = p.in[I_LN1G] + l * DM; const float* lb = p.in[I_LN1B] + l * DM; const float* rw = p.in[I_ROUTER] + (long)l * DM * NE;
  GSTRIDE(R, MROWS) { const float* m = mod + (long)row_mod((int)R) * 6 * DM; const float* x = X2 + R * DM; const float* y = Y + R * DM; float* x1 = X1 + R * DM;
    float s = 0.f; for (int d = 0; d < DM; ++d) { const float v = DN_ALPHA * x[d] + m[2 * DM + d] * y[d]; x1[d] = v; s += v; } float mean = s / DM;
    float var = 0.f; for (int d = 0; d < DM; ++d) { const float c = x1[d] - mean; var += c * c; } float rs = 1.f / sqrtf(var / DM + NORM_EPS);
    s = 0.f; for (int d = 0; d < DM; ++d) { const float v = (x1[d] - mean) * rs * lg[d] + lb[d]; x1[d] = v; s += v; } mean = s / DM;
    var = 0.f; for (int d = 0; d < DM; ++d) { const float c = x1[d] - mean; var += c * c; } rs = 1.f / sqrtf(var / DM + NORM_EPS);
    float lo[NE]; _Pragma("unroll") for (int e = 0; e < NE; ++e) lo[e] = 0.f;
    for (int d = 0; d < DM; ++d) { const float hv = (x1[d] - mean) * rs * (1.f + m[4 * DM + d]) + m[3 * DM + d]; H2[R * DM + d] = f2bf(hv); _Pragma("unroll") for (int e = 0; e < NE; ++e) lo[e] += hv * rw[(long)d * NE + e]; }
    float mx = lo[0]; _Pragma("unroll") for (int e = 1; e < NE; ++e) mx = fmaxf(mx, lo[e]); float se = 0.f; _Pragma("unroll") for (int e = 0; e < NE; ++e) { lo[e] = expf(lo[e] - mx); se += lo[e]; }
    _Pragma("unroll") for (int e = 0; e < NE; ++e) AFF[R * NE + e] = lo[e] / se; }
}
__global__ void nk_topk(Params p, int with_ctx) {
  const float* AFF = WSP(float, p, aff); int* SLOT = WSP(int, p, slot); float* GV = WSP(float, p, gatev); int* XSRC = WSP(int, p, xsrc);
  GSTRIDE(i, (long)MROWS * NE) { const int R = (int)(i / NE), e = (int)(i % NE), b = row_b(R), t = row_t(R); const bool lat = t < SEQ;
    if (!lat && !with_ctx) { SLOT[i] = -1; continue; }
    const int k0 = lat ? 0 : SEQ, k1 = lat ? SEQ : NTOK, cap = lat ? CAP_L : CAP_C; const float a = AFF[i]; int rank = 0;
    for (int kk = k0; kk < k1; ++kk) { const float o = AFF[((long)b * NTOK + kk) * NE + e]; rank += (o > a || (o == a && kk < t)) ? 1 : 0; }
    if (rank < cap) { const int xr = e * XEP + (lat ? b * CAP_L : 2 * CAP_L + b * CAP_C) + rank; SLOT[i] = xr; GV[xr] = a; XSRC[xr] = R; } else SLOT[i] = -1; }
}
__global__ void nk_gather(Params p) {
  const int* XSRC = WSP(int, p, xsrc); const bf16_t* H2 = WSP(bf16_t, p, h2); bf16_t* XS = WSP(bf16_t, p, regA);
  GSTRIDE(i, (long)XROWS * DM) { const long xr = i / DM; const int d = (int)(i % DM), src = XSRC[xr]; XS[i] = src >= 0 ? H2[(long)src * DM + d] : (bf16_t)0; }
}
__global__ void nk_moe_up(Params p, int l) {
  const bf16_t* XS = WSP(bf16_t, p, regA); bf16_t* ACT = (bf16_t*)(p.ws + WS.regA + SZ_XS); const bf16_t* W = WSP(bf16_t, p, wt_gu) + (long)l * NE * 2 * FF * DM; const int* XSRC = WSP(int, p, xsrc);
  GSTRIDE(i, (long)XROWS * FF) { const long xr = i / FF; const int f = (int)(i % FF), e = (int)(xr / XEP); if (XSRC[xr] < 0) { ACT[i] = 0; continue; }
    const int jg = (f / 128) * 256 + (f % 128), ju = jg + 128; const bf16_t* x = XS + xr * DM; const bf16_t* wg = W + ((long)e * 2 * FF + jg) * DM; const bf16_t* wu = W + ((long)e * 2 * FF + ju) * DM;
    float a = 0.f, u = 0.f; for (int k = 0; k < DM; ++k) { const float xv = bf2f(x[k]); a += xv * bf2f(wg[k]); u += xv * bf2f(wu[k]); }
    ACT[i] = f2bf(siluf_(a) * u); }
}
__global__ void nk_ln2(Params p, int l, int last) {
  const float* X1 = WSP(float, p, x1); float* X2 = WSP(float, p, x2); const int* SLOT = WSP(int, p, slot); const bf16_t* YS = (const bf16_t*)(p.ws + WS.regA + SZ_XS + SZ_ACT);
  const float* mod = WSP(float, p, mod) + (long)l * 3 * 6 * DM; const float* lg = p.in[I_LN2G] + l * DM; const float* lb = p.in[I_LN2B] + l * DM;
  GSTRIDE(R, MROWS) { if (last && row_is_ctx((int)R)) continue; const float* m = mod + (long)row_mod((int)R) * 6 * DM; const float* x1 = X1 + R * DM; float* x2 = X2 + R * DM;
    float s = 0.f; for (int d = 0; d < DM; ++d) { float mo = 0.f; for (int e = 0; e < NE; ++e) { const int sl = SLOT[R * NE + e]; if (sl >= 0) mo += bf2f(YS[(long)sl * DM + d]); }
      const float v = DN_ALPHA * x1[d] + m[5 * DM + d] * mo; x2[d] = v; s += v; } const float mean = s / DM;
    float var = 0.f; for (int d = 0; d < DM; ++d) { const float c = x2[d] - mean; var += c * c; } const float rs = 1.f / sqrtf(var / DM + NORM_EPS);
    for (int d = 0; d < DM; ++d) { const float v = (x2[d] - mean) * rs * lg[d] + lb[d]; x2[d] = v; if (last) p.out[((long)row_b((int)R) * SEQ + row_t((int)R)) * DM + d] = v; } }
}
#ifdef CPU_TEST
void cpu_hook(const char* name, int l, Params& p);
#define HOOK(name) cpu_hook(name, l, p)
#else
#define HOOK(name)
#endif
#define NG(n) (int)((((long)(n)) + 255) / 256 < 65536 ? (((long)(n)) + 255) / 256 : 65536)

static void naive_prologue(Params& p, hipStream_t stream) {
  for (int l = 0; l < NLAYER; ++l) {
    LAUNCH(nk_conv_t, NG((long)PW * DM), 256, WSP(bf16_t, p, wt_in) + (long)l * PW * DM, p.in[I_WIN] + (long)l * DM * IN_TOTAL, DM, IN_TOTAL, IN_TOTAL, PW);
    LAUNCH(nk_conv_t, NG((long)4 * DM * DM), 256, WSP(bf16_t, p, wt_gate) + (long)l * 4 * DM * DM, p.in[I_WGATE] + (long)l * DM * 4 * DM, DM, 4 * DM, 4 * DM, 4 * DM);
    for (int k = 0; k < 4; ++k)
      LAUNCH(nk_conv_t, NG((long)DM * BW), 256, WSP(bf16_t, p, wt_br) + ((long)l * 4 + k) * DM * BW, p.in[I_WBR] + ((long)l * 4 + k) * BW * DM, BW, DM, DM, DM);
    LAUNCH(nk_conv_t, NG((long)DM * DM), 256, WSP(bf16_t, p, wt_out) + (long)l * DM * DM, p.in[I_WOUT] + (long)l * DM * DM, DM, DM, DM, DM);
    LAUNCH(nk_conv_t, NG((long)BW * BW), 256, WSP(bf16_t, p, wt_glu) + (long)l * BW * BW, p.in[I_S5GLU] + (long)l * BW * BW, BW, BW, BW, BW);
    LAUNCH(nk_conv_t, NG((long)MH * MQK * MQL), 256, WSP(bf16_t, p, wt_uq) + (long)l * MH * MQK * MQL, p.in[I_WUQ] + (long)l * MQL * MH * MQK, MQL, MH * MQK, MH * MQK, MH * MQK);
    LAUNCH(nk_conv_t, NG((long)MH * (MNOPE + MV) * MKVL), 256, WSP(bf16_t, p, wt_ukv) + (long)l * MH * (MNOPE + MV) * MKVL, p.in[I_WUKV] + (long)l * MKVL * MH * (MNOPE + MV), MKVL, MH * (MNOPE + MV), MH * (MNOPE + MV), MH * (MNOPE + MV));
    for (int e = 0; e < NE; ++e) {
      LAUNCH(nk_conv_gu, NG((long)2 * FF * DM), 256, WSP(bf16_t, p, wt_gu) + ((long)l * NE + e) * 2 * FF * DM, p.in[I_MOEG] + ((long)l * NE + e) * DM * FF, p.in[I_MOEU] + ((long)l * NE + e) * DM * FF);
      LAUNCH(nk_conv_t, NG((long)DM * FF), 256, WSP(bf16_t, p, wt_dn) + ((long)l * NE + e) * DM * FF, p.in[I_MOED] + ((long)l * NE + e) * FF * DM, FF, DM, DM, DM);
    }
  }
  LAUNCH(nk_mod, NG((long)NLAYER * 18 * DM), 256, p);
  LAUNCH(nk_rope_tab, 4, 256, p);
  LAUNCH(nk_s5tab, NG((long)NLAYER * 2 * S5G * S5P), 256, p);
  LAUNCH(nk_load_x, NG((long)MROWS * DM), 256, p);
}

#ifdef CPU_TEST
static void naive_layer(Params& p, int l, hipStream_t stream) {
  bf16_t* P = WSP(bf16_t, p, regA); bf16_t* PROJ = (bf16_t*)(p.ws + WS.regA + SZ_P); bf16_t* H1 = WSP(bf16_t, p, h1);
  bf16_t* QM = WSP(bf16_t, p, qm); bf16_t* KM = WSP(bf16_t, p, km); bf16_t* VM = WSP(bf16_t, p, vm); bf16_t* Z = WSP(bf16_t, p, z); bf16_t* OA = WSP(bf16_t, p, oall);
  LAUNCH(nk_ln_mod, NG(MROWS), 256, p, H1, (const float*)WSP(float, p, x2), l, 0, 1);
  HOOK("h");
  LAUNCH(nk_gemm<EpStoreBf16>, NG((long)MROWS * PW / 4), 256, (const bf16_t*)H1, (long)DM, (const bf16_t*)(WSP(bf16_t, p, wt_in) + (long)l * PW * DM), (long)DM, MROWS, PW, DM, EpStoreBf16{P, PW});
  LAUNCH(nk_post_proj, NG((long)MROWS * 17), 256, p, l);
  LAUNCH(nk_gemm<EpStoreBf16>, NG((long)MROWS * MH * MQK / 4), 256, (const bf16_t*)(P + OFF_CQ), (long)PW, (const bf16_t*)(WSP(bf16_t, p, wt_uq) + (long)l * MH * MQK * MQL), (long)MQL, MROWS, MH * MQK, MQL, EpStoreBf16{QM, MH * MQK});
  LAUNCH(nk_gemm<EpKV>, NG((long)MROWS * MH * (MNOPE + MV) / 4), 256, (const bf16_t*)(P + OFF_CKV), (long)PW, (const bf16_t*)(WSP(bf16_t, p, wt_ukv) + (long)l * MH * (MNOPE + MV) * MKVL), (long)MKVL, MROWS, MH * (MNOPE + MV), MKVL, EpKV{KM, VM});
  LAUNCH(nk_post_mla, NG((long)MROWS * MH), 256, p);
  LAUNCH(nk_s5_scan, NG((long)NB * S5G * S5P), 256, p, l);
  LAUNCH(nk_s5_read, NG((long)MROWS * BW), 256, p, l);
  LAUNCH(nk_gemm<EpGlu>, NG((long)MROWS * BW / 4), 256, (const bf16_t*)Z, (long)BW, (const bf16_t*)(WSP(bf16_t, p, wt_glu) + (long)l * BW * BW), (long)BW, MROWS, BW, BW, EpGlu{Z, OA});
  HOOK("o_s5");
  LAUNCH((nk_attn<GHD, GHD>), NG((long)MROWS * GH), 256, (const bf16_t*)(P + OFF_GQ), (const bf16_t*)(P + OFF_GK), (const bf16_t*)(P + OFF_GV), OA + BW, PW, PW, PW, DM, GH, GH / GKV, 1.f / sqrtf((float)GHD));
  HOOK("o_gqa");
  LAUNCH(nk_ret, NG((long)MROWS * RH), 256, p, l);
  HOOK("o_ret");
  LAUNCH((nk_attn<MQK, MV>), NG((long)MROWS * MH), 256, (const bf16_t*)QM, (const bf16_t*)KM, (const bf16_t*)VM, OA + 3 * BW, MH * MQK, MH * MQK, MH * MV, DM, MH, 1, 1.f / sqrtf((float)MQK));
  HOOK("o_mla");
  for (int k = 0; k < 4; ++k)
    LAUNCH(nk_gemm<EpStoreBf16>, NG((long)MROWS * DM / 4), 256, (const bf16_t*)(OA + k * BW), (long)DM, (const bf16_t*)(WSP(bf16_t, p, wt_br) + ((long)l * 4 + k) * DM * BW), (long)BW, MROWS, DM, BW, EpStoreBf16{PROJ + (long)k * DM, 4 * DM});
  LAUNCH(nk_gate_merge, NG((long)MROWS * DM), 256, p, l);
  LAUNCH(nk_gemm<EpStoreF32>, NG((long)MROWS * DM / 4), 256, (const bf16_t*)WSP(bf16_t, p, merged), (long)DM, (const bf16_t*)(WSP(bf16_t, p, wt_out) + (long)l * DM * DM), (long)DM, MROWS, DM, DM, EpStoreF32{WSP(float, p, macc), DM});
  HOOK("y");
  LAUNCH(nk_ln1, NG(MROWS), 256, p, l);
  HOOK("x1");
  hipMemsetAsync(p.ws + WS.xsrc, 0xFF, (size_t)XROWS * 4, stream);
  LAUNCH(nk_topk, NG((long)MROWS * NE), 256, p, l == 0 ? 1 : 0);
  LAUNCH(nk_gather, NG((long)XROWS * DM), 256, p);
  LAUNCH(nk_moe_up, NG((long)XROWS * FF), 256, p, l);
  bf16_t* ACT = (bf16_t*)(p.ws + WS.regA + SZ_XS); bf16_t* YS = (bf16_t*)(p.ws + WS.regA + SZ_XS + SZ_ACT);
  for (int e = 0; e < NE; ++e)
    LAUNCH(nk_gemm<EpDown>, NG((long)XEP * DM / 4), 256, (const bf16_t*)(ACT + (long)e * XEP * FF), (long)FF, (const bf16_t*)(WSP(bf16_t, p, wt_dn) + ((long)l * NE + e) * DM * FF), (long)FF, XEP, DM, FF,
           EpDown{WSP(float, p, gatev) + e * XEP, YS + (long)e * XEP * DM});
  LAUNCH(nk_ln2, NG(MROWS), 256, p, l, l == NLAYER - 1 ? 1 : 0);
  HOOK("x2");
}
#endif
#ifndef CPU_TEST
namespace pg8 {
#define PG8_LAS __attribute__((address_space(3)))
typedef short bf16x8 __attribute__((ext_vector_type(8)));
typedef float f32x4 __attribute__((ext_vector_type(4)));
typedef unsigned u32x4 __attribute__((ext_vector_type(4)));
constexpr int BM = 256, BK = 64, HALF = 128, HTB = HALF * BK * 2, STAGE_BYTES = 8 * HTB, NXCD = 8, WGM = 8;
__host__ __device__ __forceinline__ int lds_byte(int r, int c) { const int st = (r >> 4) * 2 + (c >> 5), rr = r & 15, cc = c & 31, ob = rr * 64 + cc * 2; return st * 1024 + (ob ^ (((ob >> 9) & 1) << 5)); }
__host__ __device__ __forceinline__ void stage_rc(int b, int& R, int& C) { const int st = b / 1024, sb = b % 1024, swz = sb ^ (((sb >> 9) & 1) << 5); R = (st >> 1) * 16 + swz / 64; C = (st & 1) * 32 + (swz % 64) / 2; }
__host__ __device__ __forceinline__ int perm32(int rho) { const int n = rho >> 4, i = rho & 15; return 8 * (i >> 2) + 4 * n + (i & 3); }

struct Unit { int pm, pn, aux; const char* A; const char* B; };
struct GemmG { int lda, ldb, K, pad; };

__device__ __forceinline__ bool tile_order(long L, int nM, int nN, int& pm, int& pn) {
  const int nwg = nM * nN; if (L >= nwg) return false;
  int wgid = (int)L; { const int q = nwg / NXCD, r = nwg % NXCD, xcd = wgid % NXCD, off = wgid / NXCD; wgid = (xcd < r ? xcd * (q + 1) : r * (q + 1) + (xcd - r) * q) + off; }
  const int nig = WGM * nN, gid = wgid / nig, fm = gid * WGM, gsz = (nM - fm) < WGM ? (nM - fm) : WGM;
  pm = fm + ((wgid % nig) % gsz); pn = (wgid % nig) / gsz; return true;
}
__device__ __forceinline__ unsigned cvt_pk_bf16(float lo, float hi) { unsigned r; asm volatile("v_cvt_pk_bf16_f32 %0, %1, %2" : "=v"(r) : "v"(lo), "v"(hi)); return r; }
__device__ __forceinline__ u32x4 pack8(const f32x4 a, const f32x4 b) { u32x4 w; w.x = cvt_pk_bf16(a[0], a[1]); w.y = cvt_pk_bf16(a[2], a[3]); w.z = cvt_pk_bf16(b[0], b[1]); w.w = cvt_pk_bf16(b[2], b[3]); return w; }
__device__ __forceinline__ void unpack8(const u32x4 w, f32x4& a, f32x4& b) {
  a[0] = __uint_as_float(w.x << 16); a[1] = __uint_as_float(w.x & 0xffff0000u); a[2] = __uint_as_float(w.y << 16); a[3] = __uint_as_float(w.y & 0xffff0000u);
  b[0] = __uint_as_float(w.z << 16); b[1] = __uint_as_float(w.z & 0xffff0000u); b[2] = __uint_as_float(w.w << 16); b[3] = __uint_as_float(w.w & 0xffff0000u); }
__device__ __forceinline__ float fast_sigmoid(float x) { return __builtin_amdgcn_rcpf(1.f + __builtin_amdgcn_exp2f(-1.4426950408889634f * x)); }
__device__ __forceinline__ f32x4 sigmoid4(f32x4 v) { f32x4 o; o[0] = fast_sigmoid(v[0]); o[1] = fast_sigmoid(v[1]); o[2] = fast_sigmoid(v[2]); o[3] = fast_sigmoid(v[3]); return o; }

template <class Epi, class Sched>
__device__ __forceinline__ void gemm_phase(PG8_LAS unsigned char* lds, const GemmG g, const Sched& S, const Epi& E) {
    const int tid = ph_tid(), wid = __builtin_amdgcn_readfirstlane(tid >> 6), lane = tid & 63, wr = wid >> 2, wc = wid & 3, fr = lane & 15, fq = lane >> 4;
    const int K = g.K, nt = K / BK;
    unsigned voffA[2], voffB[2];
#pragma unroll
    for (int i = 0; i < 2; ++i) { int R, C; stage_rc(tid * 16 + i * 8192, R, C); const int Rb = (R & ~31) + perm32(R & 31);
        voffA[i] = (unsigned)(R * g.lda + C) * 2u; voffB[i] = (unsigned)(Rb * g.ldb + C) * 2u; }
    const size_t kstep = (size_t)(BK * 2);
    const size_t hsA = (size_t)HALF * g.lda * 2, hsB = (size_t)HALF * g.ldb * 2;
    const unsigned ldsw = (unsigned)wid * 1024u;
    const int aoff = lds_byte(wr * 64 + fr, fq * 8), boff = lds_byte(wc * 32 + fr, fq * 8);
#define PG8_SA(b, h) (((b) * 2 + (h)) * HTB)
#define PG8_SB(b, h) ((4 + (b) * 2 + (h)) * HTB)
#define PG8_STAGE(bufoff, gbase, voff) do { _Pragma("unroll") for (int _i = 0; _i < 2; ++_i) \
        __builtin_amdgcn_global_load_lds((const unsigned*)((const char*)(gbase) + (voff)[_i]), (PG8_LAS unsigned*)(lds + (bufoff) + ldsw + _i * 8192), 16, 0, 0); } while (0)
#define PG8_LDA(dst, b, h) do { _Pragma("unroll") for (int m = 0; m < 4; ++m) _Pragma("unroll") for (int k = 0; k < 2; ++k) dst[m][k] = *(const PG8_LAS bf16x8*)(lds + PG8_SA(b, h) + aoff + m * 2048 + k * 1024); } while (0)
#define PG8_LDB(dst, b, h) do { _Pragma("unroll") for (int n = 0; n < 2; ++n) _Pragma("unroll") for (int k = 0; k < 2; ++k) dst[n][k] = *(const PG8_LAS bf16x8*)(lds + PG8_SB(b, h) + boff + n * 2048 + k * 1024); } while (0)
#define PG8_MMA(ai, bj, At, Bt) do { __builtin_amdgcn_s_setprio(1); _Pragma("unroll") for (int m = 0; m < 4; ++m) _Pragma("unroll") for (int n = 0; n < 2; ++n) _Pragma("unroll") for (int k = 0; k < 2; ++k) \
        acc[ai][bj][m][n] = __builtin_amdgcn_mfma_f32_16x16x32_bf16(Bt[n][k], At[m][k], acc[ai][bj][m][n], 0, 0, 0); __builtin_amdgcn_s_setprio(0); } while (0)
#define PG8_WAIT_V(n) asm volatile("s_waitcnt vmcnt(" #n ")" ::: "memory")
#define PG8_WAIT_L(n) asm volatile("s_waitcnt lgkmcnt(" #n ")" ::: "memory")
#define PG8_BAR __builtin_amdgcn_s_barrier()
#define PG8_SCHED __builtin_amdgcn_sched_barrier(0)
    Unit cur, nxt; int ui = 0;
    if (!S.next(0, cur)) return;
    f32x4 acc[2][2][4][2];
#pragma unroll
    for (int a = 0; a < 2; ++a)
#pragma unroll
        for (int b = 0; b < 2; ++b)
#pragma unroll
            for (int m = 0; m < 4; ++m)
#pragma unroll
                for (int n = 0; n < 2; ++n) acc[a][b][m][n] = (f32x4){0.f, 0.f, 0.f, 0.f};
    bf16x8 At[4][2], B0[2][2], B1[2][2];
    const char* cA = cur.A; const char* cB = cur.B;
    PG8_STAGE(PG8_SB(0, 0), cB, voffB); PG8_STAGE(PG8_SA(0, 0), cA, voffA); PG8_STAGE(PG8_SB(0, 1), cB + hsB, voffB); PG8_STAGE(PG8_SA(0, 1), cA + hsA, voffA);
    if (wr == 1) PG8_BAR;
    PG8_WAIT_V(4); PG8_BAR;
    PG8_STAGE(PG8_SB(1, 0), cB + kstep, voffB); PG8_STAGE(PG8_SA(1, 0), cA + kstep, voffA); PG8_STAGE(PG8_SB(1, 1), cB + hsB + kstep, voffB);
    PG8_WAIT_V(6); PG8_BAR;
    for (;;) {
        const bool has_next = S.next(ui + 1, nxt);
        const char* nA = has_next ? nxt.A : cA; const char* nB = has_next ? nxt.B : cB;
        for (int t = 0; t < nt; t += 2) {
            const bool last = (t == nt - 2);
            const char* a1 = cA + (size_t)(t + 1) * kstep;
            const char* a2 = last ? nA : cA + (size_t)(t + 2) * kstep; const char* b2 = last ? nB : cB + (size_t)(t + 2) * kstep;
            const char* a3 = a2 + kstep; const char* b3 = b2 + kstep;
            PG8_LDB(B0, 0, 0); PG8_SCHED; PG8_LDA(At, 0, 0); PG8_STAGE(PG8_SA(1, 1), a1 + hsA, voffA);
            PG8_WAIT_L(8); PG8_BAR; PG8_WAIT_L(0); PG8_MMA(0, 0, At, B0); PG8_BAR; PG8_SCHED;
            PG8_LDB(B1, 0, 1); PG8_STAGE(PG8_SB(0, 0), b2, voffB);
            PG8_BAR; PG8_WAIT_L(0); PG8_MMA(0, 1, At, B1); PG8_BAR;
            PG8_LDA(At, 0, 1); PG8_STAGE(PG8_SA(0, 0), a2, voffA);
            PG8_BAR; PG8_WAIT_L(0); PG8_MMA(1, 0, At, B0); PG8_BAR; PG8_SCHED;
            PG8_STAGE(PG8_SB(0, 1), b2 + hsB, voffB);
            PG8_WAIT_V(6); PG8_BAR; PG8_MMA(1, 1, At, B1); PG8_BAR;
            PG8_LDB(B0, 1, 0); PG8_SCHED; PG8_LDA(At, 1, 0); PG8_STAGE(PG8_SA(0, 1), a2 + hsA, voffA);
            PG8_WAIT_L(8); PG8_BAR; PG8_WAIT_L(0); PG8_MMA(0, 0, At, B0); PG8_BAR; PG8_SCHED;
            PG8_LDB(B1, 1, 1); PG8_STAGE(PG8_SB(1, 0), b3, voffB);
            PG8_BAR; PG8_WAIT_L(0); PG8_MMA(0, 1, At, B1); PG8_BAR;
            PG8_LDA(At, 1, 1); PG8_STAGE(PG8_SA(1, 0), a3, voffA);
            PG8_BAR; PG8_WAIT_L(0); PG8_MMA(1, 0, At, B0); PG8_BAR; PG8_SCHED;
            PG8_STAGE(PG8_SB(1, 1), b3 + hsB, voffB);
            PG8_WAIT_V(6); PG8_BAR; PG8_MMA(1, 1, At, B1); PG8_BAR;
        }
        { int efr = fr, efq = fq; asm volatile("" : "+v"(efr), "+v"(efq)); E(acc, cur, wr, wc, efr, efq); }
        if (!has_next) break;
#pragma unroll
        for (int a = 0; a < 2; ++a)
#pragma unroll
            for (int b = 0; b < 2; ++b)
#pragma unroll
                for (int m = 0; m < 4; ++m)
#pragma unroll
                    for (int n = 0; n < 2; ++n) acc[a][b][m][n] = (f32x4){0.f, 0.f, 0.f, 0.f};
        cur = nxt; cA = nA; cB = nB; ++ui;
    }
    PG8_WAIT_V(0);
    if (wr == 0) PG8_BAR;
    PG8_BAR;
#undef PG8_SA
#undef PG8_SB
#undef PG8_STAGE
#undef PG8_LDA
#undef PG8_LDB
#undef PG8_MMA
#undef PG8_WAIT_V
#undef PG8_WAIT_L
#undef PG8_BAR
#undef PG8_SCHED
}

struct SchedGrid {
  const char* A; const char* B; int lda, ldb, nM, nN, skip_ctx, G, c, pad;
  __device__ __forceinline__ bool next(int i, Unit& u) const {
    int pm, pn; if (!tile_order((long)i * G + c, nM, nN, pm, pn)) return false;
    if (skip_ctx && pm >= NTOK / 256 - 1) pm += 1;
    u.pm = pm; u.pn = pn; u.aux = 0; u.A = A + (size_t)pm * BM * lda * 2; u.B = B + (size_t)pn * BM * ldb * 2; return true; }
};
struct SchedProj {
  const char* OA; const char* B; int nM, skip_ctx, G, c;
  __device__ __forceinline__ bool next(int i, Unit& u) const {
    int pm, pn; if (!tile_order((long)i * G + c, nM, 4 * DM / 256, pm, pn)) return false;
    if (skip_ctx && pm >= NTOK / 256 - 1) pm += 1;
    const int k = pn / (DM / 256);
    u.pm = pm; u.pn = pn; u.aux = k; u.A = OA + ((size_t)pm * BM * DM + (size_t)k * BW) * 2; u.B = B + (size_t)pn * BM * BW * 2; return true; }
};
struct SchedGate {
  const char* H; const char* B; int nM, skip_ctx, G, c;
  __device__ __forceinline__ bool next(int i, Unit& u) const {
    const int j = i >> 2, k = i & 3; int pm, pd; if (!tile_order((long)j * G + c, nM, DM / 256, pm, pd)) return false;
    if (skip_ctx && pm >= NTOK / 256 - 1) pm += 1;
    u.pm = pm; u.pn = pd; u.aux = k; u.A = H + (size_t)pm * BM * DM * 2; u.B = B + ((size_t)k * DM + (size_t)pd * BM) * DM * 2; return true; }
};
struct SchedMoe {
  const char* A; const char* B; int lda, ldb, nMl, nN; size_t wstride; int G, c;
  __device__ __forceinline__ bool next(int i, Unit& u) const {
    const long L = (long)i * G + c; if (L >= (long)NE * nMl * nN) return false;
    const int e = (int)(L / (nMl * nN)), rem = (int)(L % (nMl * nN)), pn = rem / nMl, pml = rem % nMl;
    u.pm = e * (XEP / 256) + pml; u.pn = pn; u.aux = e; u.A = A + (size_t)u.pm * BM * lda * 2; u.B = B + (size_t)e * wstride + (size_t)pn * BM * ldb * 2; return true; }
};

#define EPI_LOOP(...) _Pragma("unroll") for (int ai = 0; ai < 2; ++ai) _Pragma("unroll") for (int m = 0; m < 4; ++m) { const int trow = ai * HALF + wr * 64 + m * 16 + fr; \
    _Pragma("unroll") for (int bj = 0; bj < 2; ++bj) { const int tcol = bj * HALF + wc * 32 + 8 * fq; const f32x4 v0 = acc[ai][bj][m][0], v1 = acc[ai][bj][m][1]; __VA_ARGS__ } }
typedef f32x4 AccT[2][2][4][2];
struct EpiBf16 { bf16_t* O; int ldc, pad;
  __device__ __forceinline__ void operator()(const AccT& acc, const Unit& u, int wr, int wc, int fr, int fq) const {
    bf16_t* base = O + (size_t)u.pm * BM * ldc + (size_t)u.pn * BM;
    EPI_LOOP(*(u32x4*)(base + (size_t)trow * ldc + tcol) = pack8(v0, v1);) } };
struct EpiF32 { float* O; int ldc, pad;
  __device__ __forceinline__ void operator()(const AccT& acc, const Unit& u, int wr, int wc, int fr, int fq) const {
    float* base = O + (size_t)u.pm * BM * ldc + (size_t)u.pn * BM;
    EPI_LOOP(float* q = base + (size_t)trow * ldc + tcol; *(f32x4*)q = v0; *(f32x4*)(q + 4) = v1;) } };
struct EpiKVm { bf16_t* KM; bf16_t* VM;
  __device__ __forceinline__ void operator()(const AccT& acc, const Unit& u, int wr, int wc, int fr, int fq) const {
    bf16_t* kb = KM + (size_t)u.pm * BM * (MH * MQK) + u.pn * MQK; bf16_t* vb = VM + (size_t)u.pm * BM * (MH * MV) + u.pn * MV;
    EPI_LOOP(bf16_t* q = (bj == 0) ? kb + trow * (MH * MQK) + tcol : vb + trow * (MH * MV) + (tcol - HALF); *(u32x4*)q = pack8(v0, v1);) } };
struct EpiGluO { const bf16_t* Z; bf16_t* O;
  __device__ __forceinline__ void operator()(const AccT& acc, const Unit& u, int wr, int wc, int fr, int fq) const {
    EPI_LOOP(const size_t row = (size_t)u.pm * BM + trow; const int col = u.pn * BM + tcol; f32x4 z0, z1; unpack8(*(const u32x4*)(Z + row * BW + col), z0, z1);
             *(u32x4*)(O + row * DM + col) = pack8(z0 * sigmoid4(v0), z1 * sigmoid4(v1));) } };
struct EpiGateMerge { const float* bg; const bf16_t* PROJ; float* MACC; bf16_t* MG;
  __device__ __forceinline__ void operator()(const AccT& acc, const Unit& u, int wr, int wc, int fr, int fq) const {
    const int k = u.aux;
    EPI_LOOP(const size_t row = (size_t)u.pm * BM + trow; const int d = u.pn * BM + tcol; const float* bp = bg + k * DM + d; f32x4 p0, p1; unpack8(*(const u32x4*)(PROJ + row * (4 * DM) + k * DM + d), p0, p1);
             f32x4 r0 = sigmoid4(v0 + *(const f32x4*)bp) * p0, r1 = sigmoid4(v1 + *(const f32x4*)(bp + 4)) * p1; float* mp = MACC + row * DM + d;
             if (k > 0) { r0 += *(const f32x4*)mp; r1 += *(const f32x4*)(mp + 4); }
             if (k < 3) { *(f32x4*)mp = r0; *(f32x4*)(mp + 4) = r1; } else *(u32x4*)(MG + row * DM + d) = pack8(r0, r1);) } };
struct EpiSwiGlu { bf16_t* ACT;
  __device__ __forceinline__ void operator()(const AccT& acc, const Unit& u, int wr, int wc, int fr, int fq) const {
#pragma unroll
    for (int ai = 0; ai < 2; ++ai)
#pragma unroll
      for (int m = 0; m < 4; ++m) { const size_t row = (size_t)u.pm * BM + ai * HALF + wr * 64 + m * 16 + fr; const int col = u.pn * HALF + wc * 32 + 8 * fq;
        const f32x4 g0 = acc[ai][0][m][0], g1 = acc[ai][0][m][1], u0 = acc[ai][1][m][0], u1 = acc[ai][1][m][1];
        *(u32x4*)(ACT + row * FF + col) = pack8(g0 * sigmoid4(g0) * u0, g1 * sigmoid4(g1) * u1); } } };
struct EpiDownG { const float* GV; bf16_t* YS;
  __device__ __forceinline__ void operator()(const AccT& acc, const Unit& u, int wr, int wc, int fr, int fq) const {
    EPI_LOOP(const size_t row = (size_t)u.pm * BM + trow; const float gv = GV[row]; *(u32x4*)(YS + row * DM + u.pn * BM + tcol) = pack8(v0 * gv, v1 * gv);) } };

struct SchedS5 { const char* UH; const char* W; size_t wstride; int G, c;
  __device__ __forceinline__ bool next(int i, Unit& u) const {
    const long L = (long)i * G + c; if (L >= (long)S5G * (S5NP / 256)) return false; const int g = (int)(L / (S5NP / 256)), pm = (int)(L % (S5NP / 256));
    u.pm = pm; u.pn = 0; u.aux = g; u.A = UH + ((size_t)g * S5NP + (size_t)pm * BM) * (S5K1 + S5K2) * 2; u.B = W + (size_t)g * wstride; return true; }
};
struct EpiS5E { float* E;
  __device__ __forceinline__ void operator()(const AccT& acc, const Unit& u, int wr, int wc, int fr, int fq) const {
    float* base = E + ((size_t)u.aux * S5NP + (size_t)u.pm * BM) * S5K2;
    EPI_LOOP(float* q = base + (size_t)trow * S5K2 + tcol; *(f32x4*)q = v0; *(f32x4*)(q + 4) = v1;) } };
__device__ __forceinline__ float fast_gelu_tanh(float x) { const float t = 0.7978845608028654f * (x + 0.044715f * x * x * x); const float e = __builtin_amdgcn_exp2f(2.885390081777927f * t);
  return 0.5f * x * (2.f - 2.f * __builtin_amdgcn_rcpf(e + 1.f)); }
struct EpiS5Y { const bf16_t* P; const float* D; bf16_t* Z; int last, pad;
  __device__ __forceinline__ void operator()(const AccT& acc, const Unit& u, int wr, int wc, int fr, int fq) const {
    const int g = u.aux;
    EPI_LOOP(const int n = u.pm * BM + trow; const int b = n / S5NC, j = n % S5NC; if (n < S5NN && !(last && j >= SEQ / S5LC)) { const int a = tcol >> 4, i0 = tcol & 15; const size_t R = (size_t)b * NTOK + j * S5LC + a;
        f32x4 u0, u1; unpack8(*(const u32x4*)(P + R * PW + OFF_U + g * S5CH + i0), u0, u1); const float* dp = D + g * S5CH + i0; f32x4 y0 = v0 + *(const f32x4*)dp * u0, y1 = v1 + *(const f32x4*)(dp + 4) * u1;
        _Pragma("unroll") for (int q = 0; q < 4; ++q) { y0[q] = fast_gelu_tanh(y0[q]); y1[q] = fast_gelu_tanh(y1[q]); }
        *(u32x4*)(Z + R * BW + g * S5CH + i0) = pack8(y0, y1); }) } };

struct EpiQM { bf16_t* QM; const float* tb;
  __device__ __forceinline__ void operator()(const AccT& acc, const Unit& u, int wr, int wc, int fr, int fq) const {
    const bool lat_tile = (u.pm % (NTOK / BM)) < SEQ / BM; bf16_t* base = QM + (size_t)u.pm * BM * (MH * MQK) + u.pn * BM; const int t0 = (u.pm % (NTOK / BM)) * BM;
    EPI_LOOP(const int cr = (u.pn * BM + tcol) % MQK; f32x4 a = v0, b2 = v1;
      if (cr >= MNOPE && lat_tile) { const int t = t0 + trow, hf = (cr - MNOPE) >> 5, off = (cr - MNOPE) & 31; const float* cs = tb + (((hf ? t % GRIDW : t / GRIDW)) * NROPE_B + (off & 15)) * 2;
        _Pragma("unroll") for (int j = 0; j < 4; ++j) { const float oa = __shfl_xor(a[j], 32), ob = __shfl_xor(b2[j], 32); const float ca = cs[2 * j], sa = cs[2 * j + 1], cb = cs[8 + 2 * j], sb = cs[8 + 2 * j + 1];
          a[j] = a[j] * ca + (fq < 2 ? -oa : oa) * sa; b2[j] = b2[j] * cb + (fq < 2 ? -ob : ob) * sb; } }
      *(u32x4*)(base + trow * (MH * MQK) + tcol) = pack8(a, b2);) } };
}

template <class Epi, class Sched> __global__ __launch_bounds__(512, 2) void k_gemm_phase(pg8::GemmG g, Sched S, Epi E) {
  extern __shared__ __attribute__((aligned(16))) unsigned char shm[];
  S.G = gridDim.x; S.c = blockIdx.x;
  pg8::gemm_phase<Epi, Sched>((PG8_LAS unsigned char*)shm, g, S, E);
}
#endif
#ifndef CPU_TEST
namespace ph {
using pg8::f32x4; using pg8::u32x4; using pg8::pack8; using pg8::unpack8;
#define LAS __attribute__((address_space(3)))
__device__ __forceinline__ float wave_sum(float v) { v += __shfl_xor(v, 32); v += __shfl_xor(v, 16); v += __shfl_xor(v, 8); v += __shfl_xor(v, 4); v += __shfl_xor(v, 2); v += __shfl_xor(v, 1); return v; }
__device__ __forceinline__ float wave_max(float v) { v = fmaxf(v, __shfl_xor(v, 32)); v = fmaxf(v, __shfl_xor(v, 16)); v = fmaxf(v, __shfl_xor(v, 8)); v = fmaxf(v, __shfl_xor(v, 4)); v = fmaxf(v, __shfl_xor(v, 2)); v = fmaxf(v, __shfl_xor(v, 1)); return v; }
__device__ __forceinline__ float sum8(const f32x4& a, const f32x4& b) { return ((a[0] + a[1]) + (a[2] + a[3])) + ((b[0] + b[1]) + (b[2] + b[3])); }
__device__ __forceinline__ const float* resid_row(const Params& p, int l, int R) {
  if (l == 0) { const int b = row_b(R), t = row_t(R); return t < SEQ ? p.in[I_X] + ((long)b * SEQ + t) * DM : p.in[I_CTX] + ((long)b * CTXL + (t - SEQ)) * DM; }
  return WSP(float, p, x2) + (long)R * DM;
}
constexpr int NCH = DM / 512;
static_assert(DM % 512 == 0, "row chunking");
struct RowV { f32x4 a[NCH], b[NCH]; };
__device__ __forceinline__ void row_load(RowV& v, const float* x, int lane) {
#pragma unroll
  for (int c = 0; c < NCH; ++c) { const float* q = x + c * 512 + lane * 8; v.a[c] = *(const f32x4*)q; v.b[c] = *(const f32x4*)(q + 4); } }
__device__ __forceinline__ void row_store(const RowV& v, float* x, int lane) {
#pragma unroll
  for (int c = 0; c < NCH; ++c) { float* q = x + c * 512 + lane * 8; *(f32x4*)q = v.a[c]; *(f32x4*)(q + 4) = v.b[c]; } }
__device__ __forceinline__ void row_stats(const RowV& v, float& mean, float& rstd) {
  float s = 0.f;
#pragma unroll
  for (int c = 0; c < NCH; ++c) s += sum8(v.a[c], v.b[c]);
  mean = wave_sum(s) * (1.f / DM); float q = 0.f;
#pragma unroll
  for (int c = 0; c < NCH; ++c) { const f32x4 da = v.a[c] - mean, db = v.b[c] - mean; q += sum8(da * da, db * db); }
  rstd = 1.f / sqrtf(wave_sum(q) * (1.f / DM) + NORM_EPS);
}
__device__ __forceinline__ void row_modulate_store(const RowV& v, float mean, float rstd, const float* sh, const float* sc, bf16_t* H, int lane) {
#pragma unroll
  for (int c = 0; c < NCH; ++c) { const int o = c * 512 + lane * 8; const f32x4 s0 = *(const f32x4*)(sc + o), s1 = *(const f32x4*)(sc + o + 4), h0 = *(const f32x4*)(sh + o), h1 = *(const f32x4*)(sh + o + 4);
    *(u32x4*)(H + o) = pack8((v.a[c] - mean) * rstd * (1.f + s0) + h0, (v.b[c] - mean) * rstd * (1.f + s1) + h1); } }

__device__ __forceinline__ void ph_ln_in(const Params& p, int l) {
  const int tid_ = ph_tid(), lane = tid_ & 63, wv = tid_ >> 6; const float* mod = WSP(float, p, mod) + (long)l * 18 * DM; bf16_t* H1 = WSP(bf16_t, p, h1);
  for (int R = blockIdx.x * 8 + wv; R < MROWS; R += gridDim.x * 8) { RowV v; row_load(v, resid_row(p, l, R), lane); float mean, rstd; row_stats(v, mean, rstd);
    const float* m = mod + (long)row_mod(R) * 6 * DM; row_modulate_store(v, mean, rstd, m, m + DM, H1 + (long)R * DM, lane); }
}
__device__ __forceinline__ void ph_ln1(const Params& p, int l, LAS unsigned char* lds) {
  const int tid_ = ph_tid(), lane = tid_ & 63, wv = tid_ >> 6; const float* mod = WSP(float, p, mod) + (long)l * 18 * DM; const int last = (l == NLAYER - 1);
  LAS float* rwt = (LAS float*)lds;
  { const float* rw = p.in[I_ROUTER] + (long)l * DM * NE; for (int i = tid_; i < DM * NE; i += 512) { const int d = i / NE, e = i % NE; rwt[e * DM + d] = rw[i]; } }
  __syncthreads();
  const float* Y = WSP(float, p, macc); float* X1 = WSP(float, p, x1); bf16_t* H2 = WSP(bf16_t, p, h2); float* AFF = WSP(float, p, aff);
  const float* lg = p.in[I_LN1G] + l * DM; const float* lb = p.in[I_LN1B] + l * DM;
  for (int R = blockIdx.x * 8 + wv; R < MROWS; R += gridDim.x * 8) { if (last && row_is_ctx(R)) continue;
    const float* m = mod + (long)row_mod(R) * 6 * DM; RowV v, y; row_load(v, resid_row(p, l, R), lane); row_load(y, Y + (long)R * DM, lane);
#pragma unroll
    for (int c = 0; c < NCH; ++c) { const int o = c * 512 + lane * 8; v.a[c] = DN_ALPHA * v.a[c] + *(const f32x4*)(m + 2 * DM + o) * y.a[c]; v.b[c] = DN_ALPHA * v.b[c] + *(const f32x4*)(m + 2 * DM + o + 4) * y.b[c]; }
    float mean, rstd; row_stats(v, mean, rstd);
#pragma unroll
    for (int c = 0; c < NCH; ++c) { const int o = c * 512 + lane * 8; v.a[c] = (v.a[c] - mean) * rstd * *(const f32x4*)(lg + o) + *(const f32x4*)(lb + o); v.b[c] = (v.b[c] - mean) * rstd * *(const f32x4*)(lg + o + 4) + *(const f32x4*)(lb + o + 4); }
    row_store(v, X1 + (long)R * DM, lane);
    row_stats(v, mean, rstd);
#pragma unroll
    for (int c = 0; c < NCH; ++c) { const int o = c * 512 + lane * 8; v.a[c] = (v.a[c] - mean) * rstd * (1.f + *(const f32x4*)(m + 4 * DM + o)) + *(const f32x4*)(m + 3 * DM + o);
      v.b[c] = (v.b[c] - mean) * rstd * (1.f + *(const f32x4*)(m + 4 * DM + o + 4)) + *(const f32x4*)(m + 3 * DM + o + 4); *(u32x4*)(H2 + (long)R * DM + o) = pack8(v.a[c], v.b[c]); }
    float mine = 0.f;
#pragma unroll
    for (int e = 0; e < NE; ++e) { float s = 0.f;
#pragma unroll
      for (int c = 0; c < NCH; ++c) { const LAS float* q = rwt + e * DM + c * 512 + lane * 8; const f32x4 w0 = *(const LAS f32x4*)q, w1 = *(const LAS f32x4*)(q + 4); s += sum8(v.a[c] * w0, v.b[c] * w1); }
      s = wave_sum(s); mine = (lane == e) ? s : mine; }
    float mx = lane < NE ? mine : -1e30f; mx = wave_max(mx); const float ex = lane < NE ? expf(mine - mx) : 0.f; const float se = wave_sum(ex);
    if (lane < NE) AFF[(long)R * NE + lane] = ex / se; }
}
__device__ __forceinline__ void ph_ln2(const Params& p, int l) {
  const int tid_ = ph_tid(), lane = tid_ & 63, wv = tid_ >> 6; const float* mod = WSP(float, p, mod) + (long)l * 18 * DM; const int last = (l == NLAYER - 1);
  const float* X1 = WSP(float, p, x1); float* X2 = WSP(float, p, x2); const int* SLOT = WSP(int, p, slot); const bf16_t* YS = (const bf16_t*)(p.ws + WS.regA + SZ_XS + SZ_ACT); bf16_t* H1 = WSP(bf16_t, p, h1);
  const float* lg = p.in[I_LN2G] + l * DM; const float* lb = p.in[I_LN2B] + l * DM;
  for (int R = blockIdx.x * 8 + wv; R < MROWS; R += gridDim.x * 8) { if (last && row_is_ctx(R)) continue;
    const float* m = mod + (long)row_mod(R) * 6 * DM; RowV v, acc; row_load(v, X1 + (long)R * DM, lane);
#pragma unroll
    for (int c = 0; c < NCH; ++c) { acc.a[c] = (f32x4){0.f, 0.f, 0.f, 0.f}; acc.b[c] = (f32x4){0.f, 0.f, 0.f, 0.f}; }
    const int myslot = lane < NE ? SLOT[(long)R * NE + lane] : -1;
    for (int e = 0; e < NE; ++e) { const int s = __shfl(myslot, e); if (s >= 0) { const bf16_t* yr = YS + (long)s * DM;
#pragma unroll
        for (int c = 0; c < NCH; ++c) { f32x4 t0, t1; unpack8(*(const u32x4*)(yr + c * 512 + lane * 8), t0, t1); acc.a[c] += t0; acc.b[c] += t1; } } }
#pragma unroll
    for (int c = 0; c < NCH; ++c) { const int o = c * 512 + lane * 8; v.a[c] = DN_ALPHA * v.a[c] + *(const f32x4*)(m + 5 * DM + o) * acc.a[c]; v.b[c] = DN_ALPHA * v.b[c] + *(const f32x4*)(m + 5 * DM + o + 4) * acc.b[c]; }
    float mean, rstd; row_stats(v, mean, rstd);
#pragma unroll
    for (int c = 0; c < NCH; ++c) { const int o = c * 512 + lane * 8; v.a[c] = (v.a[c] - mean) * rstd * *(const f32x4*)(lg + o) + *(const f32x4*)(lb + o); v.b[c] = (v.b[c] - mean) * rstd * *(const f32x4*)(lg + o + 4) + *(const f32x4*)(lb + o + 4); }
    if (last) { row_store(v, p.out + ((long)row_b(R) * SEQ + row_t(R)) * DM, lane); }
    else { row_store(v, X2 + (long)R * DM, lane); row_stats(v, mean, rstd); const float* mn = mod + 18 * DM + (long)row_mod(R) * 6 * DM; row_modulate_store(v, mean, rstd, mn, mn + DM, H1 + (long)R * DM, lane); } }
}

__device__ __forceinline__ void rope8(f32x4& a, f32x4& b, int xorl, bool first, const float* cs  ) {
#pragma unroll
  for (int j = 0; j < 4; ++j) { const float oa = __shfl_xor(a[j], xorl), ob = __shfl_xor(b[j], xorl);
    const float ca = cs[2 * j], sa = cs[2 * j + 1], cb = cs[8 + 2 * j], sb = cs[8 + 2 * j + 1];
    a[j] = a[j] * ca + (first ? -oa : oa) * sa; b[j] = b[j] * cb + (first ? -ob : ob) * sb; } }
__device__ __forceinline__ void ph_post_proj(const Params& p, int l) {
  static_assert(GHD == 128 && RQK == 64 && MROPE == 64 && MQL == 512 && MKVL == 256 && GH == 4 && GKV == 2 && RH == 4, "post_proj lane maps are written for the full-size config");
  const int tid_ = ph_tid(), lane = tid_ & 63, wv = tid_ >> 6; bf16_t* P = WSP(bf16_t, p, regA); bf16_t* KM = WSP(bf16_t, p, km); const float* ta = WSP(float, p, rope_a); const float* tb = WSP(float, p, rope_b);
  for (int R = blockIdx.x * 8 + wv; R < MROWS; R += gridDim.x * 8) { bf16_t* pr = P + (long)R * PW; const int t = row_t(R); const bool lat = t < SEQ; const int gr = lat ? t / GRIDW : 0, gc = lat ? t % GRIDW : 0;
    {
      const int g = lane >> 1, n = row_b(R) * S5NC + t / S5LC, a = t % S5LC; *(u32x4*)(WSP(bf16_t, p, uh) + ((long)g * S5NP + n) * (S5K1 + S5K2) + a * S5CH + (lane & 1) * 8) = *(const u32x4*)(pr + OFF_U + 8 * lane); }
    {
      const int j = lane & 15, hf = j >> 3; const bool first = !(j & 4); const float* cs = ta + ((hf ? gc : gr) * NROPE_A + ((8 * j) & 31)) * 2;
#pragma unroll
      for (int pass = 0; pass < 2; ++pass) { if (pass == 1 && lane >= 32) break; const int h = lane >> 4; bf16_t* x = pr + (pass ? OFF_GK : OFF_GQ) + h * GHD + 8 * j; const float* g = p.in[pass ? I_GKN : I_GQN] + l * GHD + 8 * j;
        f32x4 a, b; unpack8(*(const u32x4*)x, a, b); float ss = sum8(a * a, b * b); ss += __shfl_xor(ss, 8); ss += __shfl_xor(ss, 4); ss += __shfl_xor(ss, 2); ss += __shfl_xor(ss, 1);
        const float r = 1.f / sqrtf(ss * (1.f / GHD) + NORM_EPS); a = a * r * *(const f32x4*)g; b = b * r * *(const f32x4*)(g + 4);
        if (lat) rope8(a, b, 4, first, cs);
        *(u32x4*)x = pack8(a, b); } }
    {
      const int j = lane & 7, hf = j >> 2, h = (lane >> 3) & 3; const bool isk = lane >= 32, first = !(j & 2); bf16_t* x = pr + (isk ? OFF_RK : OFF_RQ) + h * RQK + 8 * j; const float sc = isk ? 0.125f : 1.f;
      f32x4 a, b; unpack8(*(const u32x4*)x, a, b); a = a * sc; b = b * sc;
      if (lat) rope8(a, b, 2, first, tb + ((hf ? gc : gr) * NROPE_B + ((8 * j) & 15)) * 2);
      *(u32x4*)x = pack8(a, b); }
    {
      bf16_t* x = pr + OFF_CQ + 8 * lane; const float* g = p.in[I_MQN] + l * MQL + 8 * lane; f32x4 a, b; unpack8(*(const u32x4*)x, a, b); const float ss = wave_sum(sum8(a * a, b * b));
      const float r = 1.f / sqrtf(ss * (1.f / MQL) + NORM_EPS); *(u32x4*)x = pack8(a * r * *(const f32x4*)g, b * r * *(const f32x4*)(g + 4)); }
    {
      if (lane < 32) { bf16_t* x = pr + OFF_CKV + 8 * lane; const float* g = p.in[I_MKVN] + l * MKVL + 8 * lane; f32x4 a, b; unpack8(*(const u32x4*)x, a, b); float ss = sum8(a * a, b * b);
        ss += __shfl_xor(ss, 16); ss += __shfl_xor(ss, 8); ss += __shfl_xor(ss, 4); ss += __shfl_xor(ss, 2); ss += __shfl_xor(ss, 1);
        const float r = 1.f / sqrtf(ss * (1.f / MKVL) + NORM_EPS); *(u32x4*)x = pack8(a * r * *(const f32x4*)g, b * r * *(const f32x4*)(g + 4)); }
      else if (lane < 40) { const int j = lane & 7, hf = j >> 2; const bool first = !(j & 2); bf16_t* x = pr + OFF_KR + 8 * j; f32x4 a, b; unpack8(*(const u32x4*)x, a, b);
        if (lat) rope8(a, b, 2, first, tb + ((hf ? gc : gr) * NROPE_B + ((8 * j) & 15)) * 2);
        const u32x4 w = pack8(a, b); *(u32x4*)x = w;
#pragma unroll
        for (int h = 0; h < MH; ++h) *(u32x4*)(KM + (long)R * MH * MQK + h * MQK + MNOPE + 8 * j) = w; } } }
}

struct ConvMat { bf16_t* dst; const float* src; const float* src2; int K, ld, ndst, nvalid, kind; };
constexpr int NMAT_L = 10 + 2 * NE, NMAT = NLAYER * NMAT_L;
__device__ __forceinline__ ConvMat conv_mat(const Params& p, int mi) {
  const int l = mi / NMAT_L, m = mi % NMAT_L; ConvMat c; c.src2 = nullptr; c.kind = 0;
  if (m == 0) { c.dst = WSP(bf16_t, p, wt_in) + (long)l * PW * DM; c.src = p.in[I_WIN] + (long)l * DM * IN_TOTAL; c.K = DM; c.ld = IN_TOTAL; c.ndst = PW; c.nvalid = IN_TOTAL; }
  else if (m == 1) { c.dst = WSP(bf16_t, p, wt_gate) + (long)l * 4 * DM * DM; c.src = p.in[I_WGATE] + (long)l * DM * 4 * DM; c.K = DM; c.ld = 4 * DM; c.ndst = 4 * DM; c.nvalid = 4 * DM; }
  else if (m < 6) { const int k = m - 2; c.dst = WSP(bf16_t, p, wt_br) + ((long)l * 4 + k) * DM * BW; c.src = p.in[I_WBR] + ((long)l * 4 + k) * BW * DM; c.K = BW; c.ld = DM; c.ndst = DM; c.nvalid = DM; }
  else if (m == 6) { c.dst = WSP(bf16_t, p, wt_out) + (long)l * DM * DM; c.src = p.in[I_WOUT] + (long)l * DM * DM; c.K = DM; c.ld = DM; c.ndst = DM; c.nvalid = DM; }
  else if (m == 7) { c.dst = WSP(bf16_t, p, wt_glu) + (long)l * BW * BW; c.src = p.in[I_S5GLU] + (long)l * BW * BW; c.K = BW; c.ld = BW; c.ndst = BW; c.nvalid = BW; }
  else if (m == 8) { c.dst = WSP(bf16_t, p, wt_uq) + (long)l * MH * MQK * MQL; c.src = p.in[I_WUQ] + (long)l * MQL * MH * MQK; c.K = MQL; c.ld = MH * MQK; c.ndst = MH * MQK; c.nvalid = MH * MQK; }
  else if (m == 9) { c.dst = WSP(bf16_t, p, wt_ukv) + (long)l * MH * (MNOPE + MV) * MKVL; c.src = p.in[I_WUKV] + (long)l * MKVL * MH * (MNOPE + MV); c.K = MKVL; c.ld = MH * (MNOPE + MV); c.ndst = MH * (MNOPE + MV); c.nvalid = c.ndst; }
  else if (m < 10 + NE) { const int e = m - 10; c.dst = WSP(bf16_t, p, wt_gu) + ((long)l * NE + e) * 2 * FF * DM; c.src = p.in[I_MOEG] + ((long)l * NE + e) * DM * FF; c.src2 = p.in[I_MOEU] + ((long)l * NE + e) * DM * FF;
    c.K = DM; c.ld = FF; c.ndst = 2 * FF; c.nvalid = 2 * FF; c.kind = 1; }
  else { const int e = m - 10 - NE; c.dst = WSP(bf16_t, p, wt_dn) + ((long)l * NE + e) * DM * FF; c.src = p.in[I_MOED] + ((long)l * NE + e) * FF * DM; c.K = FF; c.ld = DM; c.ndst = DM; c.nvalid = DM; }
  return c;
}
__device__ __forceinline__ void ph_conv(const Params& p, LAS unsigned char* lds) {
  const int tid = ph_tid(), n = tid & 63, kp = tid >> 6; LAS unsigned* L = (LAS unsigned*)lds; int buf = 0;
  for (int mi = 0; mi < NMAT; ++mi) { const ConvMat c = conv_mat(p, mi); const int tk = c.K / 64, tn = c.ndst / 128, nt = tk * tn;
    for (int t = (blockIdx.x + mi * 29) % gridDim.x; t < nt; t += gridDim.x) { const int k0 = (t % tk) * 64, n0 = (t / tk) * 128;
      const float* s; int col0, nval;
      if (c.kind == 1) { const int tile = n0 / 256; s = (n0 & 128) ? c.src2 : c.src; col0 = tile * 128; nval = 128; } else { s = c.src; col0 = n0; nval = c.nvalid - n0; }
      LAS unsigned* Lb = L + buf * (128 * 33); buf ^= 1;
      float v[2][4][2];
#pragma unroll
      for (int hh = 0; hh < 2; ++hh)
#pragma unroll
        for (int i = 0; i < 4; ++i) { const int k = 2 * (kp + 8 * i), cn = hh * 64 + n; const bool ok = cn < nval; const float* q = s + (long)(k0 + k) * c.ld + col0 + cn;
          v[hh][i][0] = ok ? q[0] : 0.f; v[hh][i][1] = ok ? q[c.ld] : 0.f; }
#pragma unroll
      for (int hh = 0; hh < 2; ++hh)
#pragma unroll
        for (int i = 0; i < 4; ++i) Lb[(hh * 64 + n) * 33 + kp + 8 * i] = pg8::cvt_pk_bf16(v[hh][i][0], v[hh][i][1]);
      __syncthreads();
#pragma unroll
      for (int hh = 0; hh < 2; ++hh) { const int id = hh * 512 + tid, rn = id >> 3, kc = id & 7; const LAS unsigned* q = Lb + rn * 33 + kc * 4; u32x4 w; w.x = q[0]; w.y = q[1]; w.z = q[2]; w.w = q[3];
        *(u32x4*)(c.dst + (long)(n0 + rn) * c.K + k0 + kc * 8) = w; } } }
}
__device__ __forceinline__ void ph_mod(const Params& p, LAS unsigned char* lds) {
  const int tid = ph_tid(); LAS float* sl = (LAS float*)lds; LAS float* part = sl + 3 * DM;
  for (int i = tid; i < 3 * DM; i += 512) { const int r = i / DM, k = i % DM; const float cv = r < 2 ? p.in[I_C][r * DM + k] : p.in[I_CCTX][k]; sl[i] = cv / (1.f + expf(-cv)); }
  __syncthreads();
  const int cg = tid & 31, ks = tid >> 5;
  constexpr int KS = DM / 16, NIT = NLAYER * (6 * DM / 128);
  for (int it = blockIdx.x; it < NIT; it += gridDim.x) { const int l = it / (6 * DM / 128), cb = it % (6 * DM / 128); const float* w = p.in[I_ADAW] + (long)l * DM * 6 * DM + cb * 128 + cg * 4;
    f32x4 a0 = {0.f, 0.f, 0.f, 0.f}, a1 = a0, a2 = a0;
#pragma unroll 8
    for (int k = ks * KS; k < (ks + 1) * KS; ++k) { const f32x4 wv = *(const f32x4*)(w + (long)k * 6 * DM); a0 += sl[k] * wv; a1 += sl[DM + k] * wv; a2 += sl[2 * DM + k] * wv; }
    LAS float* pp = part + (ks * 3) * 128 + cg * 4; *(LAS f32x4*)pp = a0; *(LAS f32x4*)(pp + 128) = a1; *(LAS f32x4*)(pp + 256) = a2;
    __syncthreads();
    if (tid < 384) { const int r = tid / 128, col = tid % 128; float s = 0.f;
#pragma unroll
      for (int q = 0; q < 16; ++q) s += part[(q * 3 + r) * 128 + col];
      WSP(float, p, mod)[((long)l * 3 + r) * 6 * DM + cb * 128 + col] = s + p.in[I_ADAB][(long)l * 6 * DM + cb * 128 + col]; }
    __syncthreads(); }
}
__device__ __forceinline__ void ph_tables(const Params& p) {
  const long gt = (long)blockIdx.x * 512 + ph_tid(), gs = (long)gridDim.x * 512;
  float* ta = WSP(float, p, rope_a); float* tb = WSP(float, p, rope_b);
  for (long i = gt; i < (long)GRIDW * (NROPE_A + NROPE_B); i += gs) { const int pos = (int)(i / (NROPE_A + NROPE_B)), k = (int)(i % (NROPE_A + NROPE_B));
    if (k < NROPE_A) { const float a = pos * powf(10000.f, -(float)k / NROPE_A); ta[(pos * NROPE_A + k) * 2] = cosf(a); ta[(pos * NROPE_A + k) * 2 + 1] = sinf(a); }
    else { const int kk = k - NROPE_A; const float a = pos * powf(10000.f, -(float)kk / NROPE_B); tb[(pos * NROPE_B + kk) * 2] = cosf(a); tb[(pos * NROPE_B + kk) * 2 + 1] = sinf(a); } }
  float* tab = WSP(float, p, s5tab);
  for (long i = gt; i < (long)NLAYER * 2 * S5G * S5P; i += gs) { const int pp = (int)(i % S5P), g = (int)((i / S5P) % S5G), dir = (int)((i / (S5P * S5G)) % 2), l = (int)(i / (2 * S5P * S5G));
    const float a_re = p.in[dir ? I_S5AREB : I_S5AREF][(l * S5G + g) * S5P + pp], a_im = p.in[dir ? I_S5AIMB : I_S5AIMF][(l * S5G + g) * S5P + pp];
    const float dt = expf(p.in[dir ? I_S5DTB : I_S5DTF][l * S5G + g]);
    const float mag = expf(a_re * dt), ab_re = mag * cosf(a_im * dt), ab_im = mag * sinf(a_im * dt);
    const float den = a_re * a_re + a_im * a_im, nr = ab_re - 1.f, ni = ab_im;
    const float cr = (nr * a_re + ni * a_im) / den, ci = (ni * a_re - nr * a_im) / den;
    float* t = tab + i * S5TW; t[0] = ab_re; t[1] = ab_im;
    for (int c = 0; c < S5CH; ++c) { const float br = p.in[I_S5BRE][((l * S5G + g) * S5P + pp) * S5CH + c], bi = p.in[I_S5BIM][((l * S5G + g) * S5P + pp) * S5CH + c];
      t[2 + c] = cr * br - ci * bi; t[2 + S5CH + c] = cr * bi + ci * br; } }
}

__device__ __forceinline__ void ph_s5tables(const Params& p, LAS unsigned char* lds) {
  const int tid = ph_tid(); LAS float* pw = (LAS float*)lds; LAS float* bb = pw + 2 * S5P * (S5LC + 1) * 2; LAS float* cc = bb + 2 * S5P * S5CH * 2; LAS float* T = cc + S5CH * S5P * 2;
  for (int item = blockIdx.x; item < NLAYER * S5G; item += gridDim.x) { const int l = item / S5G, g = item % S5G;
    for (int i = tid; i < 2 * S5P; i += 512) { const int dir = i / S5P, pp = i % S5P;
      const double a_re = p.in[dir ? I_S5AREB : I_S5AREF][(l * S5G + g) * S5P + pp], a_im = p.in[dir ? I_S5AIMB : I_S5AIMF][(l * S5G + g) * S5P + pp], dt = exp((double)p.in[dir ? I_S5DTB : I_S5DTF][l * S5G + g]);
      for (int k = 0; k <= S5LC; ++k) { const double mag = exp(a_re * dt * k), ang = a_im * dt * k; pw[((dir * S5P + pp) * (S5LC + 1) + k) * 2] = (float)(mag * cos(ang)); pw[((dir * S5P + pp) * (S5LC + 1) + k) * 2 + 1] = (float)(mag * sin(ang)); }
      const double mag = exp(a_re * dt), abr = mag * cos(a_im * dt), abi = mag * sin(a_im * dt), den = a_re * a_re + a_im * a_im, nr = abr - 1.0, ni = abi, cr = (nr * a_re + ni * a_im) / den, ci = (ni * a_re - nr * a_im) / den;
      for (int c = 0; c < S5CH; ++c) { const double br = p.in[I_S5BRE][((l * S5G + g) * S5P + pp) * S5CH + c], bi = p.in[I_S5BIM][((l * S5G + g) * S5P + pp) * S5CH + c];
        bb[((dir * S5P + pp) * S5CH + c) * 2] = (float)(cr * br - ci * bi); bb[((dir * S5P + pp) * S5CH + c) * 2 + 1] = (float)(cr * bi + ci * br); } }
    for (int i = tid; i < S5CH * S5P; i += 512) { cc[2 * i] = p.in[I_S5CRE][(long)(l * S5G + g) * S5CH * S5P + i]; cc[2 * i + 1] = p.in[I_S5CIM][(long)(l * S5G + g) * S5CH * S5P + i]; }
    __syncthreads();
    for (int e = tid; e < (2 * S5LC - 1) * S5CH * S5CH; e += 512) { const int tau = e / (S5CH * S5CH) - (S5LC - 1), i = (e % (S5CH * S5CH)) / S5CH, c = e % S5CH; float s = 0.f;
      for (int dir = 0; dir < 2; ++dir) { if (dir == 0 ? tau < 0 : tau > 0) continue; const int k = tau < 0 ? -tau : tau;
        for (int pp = 0; pp < S5P; ++pp) { const float cr_ = cc[(i * S5P + pp) * 2], ci_ = cc[(i * S5P + pp) * 2 + 1], ar = pw[((dir * S5P + pp) * (S5LC + 1) + k) * 2], ai = pw[((dir * S5P + pp) * (S5LC + 1) + k) * 2 + 1];
          const float br = bb[((dir * S5P + pp) * S5CH + c) * 2], bi = bb[((dir * S5P + pp) * S5CH + c) * 2 + 1]; const float zr = ar * br - ai * bi, zi = ar * bi + ai * br; s += cr_ * zr - ci_ * zi; } }
      T[e] = s; }
    __syncthreads();
    bf16_t* SW = WSP(bf16_t, p, s5sw) + (long)item * S5K2 * S5K1; bf16_t* SV = WSP(bf16_t, p, s5sv) + (long)item * S5K1 * (S5K1 + S5K2);
    for (int e = tid; e < S5K2 * S5K1; e += 512) { const int r = e / S5K1, col = e % S5K1, dir = r / (2 * S5P), pp = (r % (2 * S5P)) / 2, im = r & 1, a = col / S5CH, c = col % S5CH; const int k = dir ? a : (S5LC - 1 - a);
      const float ar = pw[((dir * S5P + pp) * (S5LC + 1) + k) * 2], ai = pw[((dir * S5P + pp) * (S5LC + 1) + k) * 2 + 1], br = bb[((dir * S5P + pp) * S5CH + c) * 2], bi = bb[((dir * S5P + pp) * S5CH + c) * 2 + 1];
      SW[e] = f2bf(im ? ar * bi + ai * br : ar * br - ai * bi); }
    for (int e = tid; e < S5K1 * (S5K1 + S5K2); e += 512) { const int r = e / (S5K1 + S5K2), k = e % (S5K1 + S5K2), a = r / S5CH, i = r % S5CH; float v;
      if (k < S5K1) { const int a2 = k / S5CH, c = k % S5CH; v = T[((a - a2) + (S5LC - 1)) * S5CH * S5CH + i * S5CH + c]; }
      else { const int kk = k - S5K1, dir = kk / (2 * S5P), pp = (kk % (2 * S5P)) / 2, im = kk & 1, pk = dir ? (S5LC - a) : (a + 1);
        const float cr_ = cc[(i * S5P + pp) * 2], ci_ = cc[(i * S5P + pp) * 2 + 1], ar = pw[((dir * S5P + pp) * (S5LC + 1) + pk) * 2], ai = pw[((dir * S5P + pp) * (S5LC + 1) + pk) * 2 + 1];
        v = im ? -(cr_ * ai + ci_ * ar) : (cr_ * ar - ci_ * ai); }
      SV[e] = f2bf(v); }
    __syncthreads(); }
}
__device__ __forceinline__ void ph_s5scan(const Params& p, int l) {
  const float* tab = WSP(float, p, s5tab); const float* E = WSP(float, p, s5e); bf16_t* UH = WSP(bf16_t, p, uh);
  for (long i = (long)blockIdx.x * 512 + ph_tid(); i < (long)NB * S5G * 2 * S5P; i += (long)gridDim.x * 512) { const int pp = (int)(i % S5P), dir = (int)((i / S5P) % 2), g = (int)((i / (2 * S5P)) % S5G), b = (int)(i / (2 * S5P * S5G));
    const float* t = tab + ((((long)l * 2 + dir) * S5G + g) * S5P + pp) * S5TW; float ar = t[0], ai = t[1];
#pragma unroll
    for (int q = 0; q < 4; ++q) { const float nr = ar * ar - ai * ai, ni = 2.f * ar * ai; ar = nr; ai = ni; }
    float hr = 0.f, hi = 0.f; constexpr int NCX = CTXL / S5LC, NLT = SEQ / S5LC;
    for (int s0 = 0; s0 < S5NC; s0 += 8) { float er[8], ei[8]; long idx[8];
#pragma unroll
      for (int q = 0; q < 8; ++q) { const int s = s0 + q; const int j = dir == 0 ? (s < NCX ? NLT + s : s - NCX) : (s < NCX ? S5NC - 1 - s : NLT - 1 - (s - NCX)); idx[q] = (long)g * S5NP + b * S5NC + j;
        const float2 ev = *(const float2*)(E + idx[q] * S5K2 + dir * 2 * S5P + pp * 2); er[q] = ev.x; ei[q] = ev.y; }
#pragma unroll
      for (int q = 0; q < 8; ++q) { *(unsigned*)(UH + idx[q] * (S5K1 + S5K2) + S5K1 + dir * 2 * S5P + pp * 2) = pg8::cvt_pk_bf16(hr, hi);
        const float nr = ar * hr - ai * hi + er[q], ni = ar * hi + ai * hr + ei[q]; hr = nr; hi = ni; } } }
}
__device__ __forceinline__ void ph_topk(const Params& p, int l, LAS unsigned char* lds) {
  const int tid = ph_tid(), lane = tid & 63, wv = tid >> 6; LAS unsigned* hist = (LAS unsigned*)lds; LAS unsigned* sh = hist + 256;
  const float* AFF = WSP(float, p, aff); int* SLOT = WSP(int, p, slot); float* GV = WSP(float, p, gatev); int* XSRC = WSP(int, p, xsrc);
  const int nprob = (l == 0 ? 4 : 2) * NE; constexpr int KPT = SEQ / 512;
  for (int pr = blockIdx.x; pr < nprob; pr += gridDim.x) { const int set = pr / NE, e = pr % NE, b = set & 1; const bool lat = set < 2; const int n = lat ? SEQ : CTXL, cap = lat ? CAP_L : CAP_C, R0 = b * NTOK + (lat ? 0 : SEQ);
    unsigned key[KPT];
#pragma unroll
    for (int k = 0; k < KPT; ++k) { const int i = tid + 512 * k; key[k] = i < n ? __float_as_uint(AFF[(long)(R0 + i) * NE + e]) : 0u; }
    unsigned prefix = 0u, mask = 0u, remaining = (unsigned)cap;
    for (int pass = 0; pass < 4; ++pass) { const int shift = 24 - 8 * pass;
      if (tid < 256) hist[tid] = 0u; __syncthreads();
#pragma unroll
      for (int k = 0; k < KPT; ++k) { const int i = tid + 512 * k; if (i < n && (key[k] & mask) == prefix) atomicAdd((unsigned*)&hist[(key[k] >> shift) & 255u], 1u); }
      __syncthreads();
      if (tid == 0) { unsigned cum = 0u; int d = 255; for (; d > 0; --d) { const unsigned h = hist[d]; if (cum + h >= remaining) break; cum += h; } sh[0] = (unsigned)d; sh[1] = remaining - cum; }
      __syncthreads();
      prefix |= sh[0] << shift; mask |= 0xFFu << shift; remaining = sh[1]; __syncthreads(); }
    const unsigned T = prefix, need_eq = remaining;
    unsigned base_gt = 0u, base_eq = 0u; int slotv[KPT];
#pragma unroll
    for (int k = 0; k < KPT; ++k) { const int i = tid + 512 * k; const bool gt = i < n && key[k] > T, eq = i < n && key[k] == T;
      const unsigned long long bg = __ballot(gt), be = __ballot(eq), lt = (1ull << lane) - 1ull;
      if (lane == 0) { sh[8 + wv] = (unsigned)__popcll(bg); sh[16 + wv] = (unsigned)__popcll(be); } __syncthreads();
      unsigned pg = 0u, pe = 0u, tg = 0u, te = 0u;
#pragma unroll
      for (int w = 0; w < 8; ++w) { const unsigned a = sh[8 + w], c = sh[16 + w]; pg += w < wv ? a : 0u; pe += w < wv ? c : 0u; tg += a; te += c; }
      const unsigned rg = base_gt + pg + (unsigned)__popcll(bg & lt), re = base_eq + pe + (unsigned)__popcll(be & lt);
      slotv[k] = gt ? (int)rg : (eq && re < need_eq ? -2 - (int)re : -1);
      base_gt += tg; base_eq += te; __syncthreads(); }
    const int xbase = e * XEP + (lat ? b * CAP_L : 2 * CAP_L + b * CAP_C);
#pragma unroll
    for (int k = 0; k < KPT; ++k) { const int i = tid + 512 * k; if (i < n) { int s = slotv[k]; if (s <= -2) s = (int)base_gt + (-2 - s);
        const long R = R0 + i; if (s >= 0) { const int xr = xbase + s; SLOT[R * NE + e] = xr; GV[xr] = __uint_as_float(key[k]); XSRC[xr] = (int)R; } else SLOT[R * NE + e] = -1; } }
    if (set == 3) for (int i = tid; i < XEP - XE; i += 512) XSRC[e * XEP + XE + i] = -1;
    __syncthreads(); }
}
__device__ __forceinline__ void ph_gather(const Params& p, int l) {
  const int tid_ = ph_tid(), lane = tid_ & 63, wv = tid_ >> 6; const int* XSRC = WSP(int, p, xsrc); const bf16_t* H2 = WSP(bf16_t, p, h2); bf16_t* XS = WSP(bf16_t, p, regA);
  const int rows_e = (l == 0) ? XEP : 2 * CAP_L, total = NE * rows_e;
  for (int it = blockIdx.x * 8 + wv; it < total; it += gridDim.x * 8) { const int e = it / rows_e, xr = e * XEP + it % rows_e; const int src = XSRC[xr];
#pragma unroll
    for (int c = 0; c < NCH; ++c) { const int o = c * 512 + lane * 8; u32x4 w = {0u, 0u, 0u, 0u}; if (src >= 0) w = *(const u32x4*)(H2 + (long)src * DM + o); *(u32x4*)(XS + (long)xr * DM + o) = w; } }
}
}
#endif
#ifndef CPU_TEST
namespace att {
#ifndef ATT_SD_MLA
#define ATT_SD_MLA 1
#endif
#ifndef ATT_SD_GQA
#define ATT_SD_GQA 2
#endif
using bf16x8 = __attribute__((ext_vector_type(8))) short;
using s16x4  = __attribute__((ext_vector_type(4))) short;
using f32x16 = __attribute__((ext_vector_type(16))) float;
using u32x4  = __attribute__((ext_vector_type(4))) unsigned;
constexpr int DV = 128, NW = 8, QBLK = 32, KVBLK = 64;
constexpr float THR = 8.f;
#define ATT_SBAR() __builtin_amdgcn_sched_barrier(0)
__device__ __forceinline__ int crow(int r, int hi) { return (r & 3) + 8 * (r >> 2) + 4 * hi; }
__device__ __forceinline__ unsigned cvtpk(float lo, float hi) { unsigned r; asm volatile("v_cvt_pk_bf16_f32 %0, %1, %2" : "=v"(r) : "v"(lo), "v"(hi)); return r; }
template <int DQK> constexpr size_t shm_k() { return (size_t)KVBLK * DQK * 2; }
constexpr size_t SHM_V = KVBLK * DV * 2;
template <int DQK> constexpr size_t shm_attn() { return 2 * SHM_V + 2 * shm_k<DQK>() + NW * 64 * 4; }

__device__ __forceinline__ void partialSM(f32x16& p0, f32x16& p1, float& m_reg, float& mn, float& alpha, const float C, const float thr_raw) {
  float pmax = p0[0];
#pragma unroll
  for (int r = 1; r < 16; ++r) pmax = fmaxf(pmax, p0[r]);
#pragma unroll
  for (int r = 0; r < 16; ++r) pmax = fmaxf(pmax, p1[r]);
  { auto rr = __builtin_amdgcn_permlane32_swap(__float_as_uint(pmax), __float_as_uint(pmax), false, false);
    pmax = fmaxf(__uint_as_float(rr[0]), __uint_as_float(rr[1])); }
  if (__builtin_expect(__all(pmax - m_reg <= thr_raw), 1)) { mn = m_reg; alpha = 1.f; }
  else { mn = fmaxf(m_reg, pmax); alpha = __builtin_amdgcn_exp2f((m_reg - mn) * C); m_reg = mn; }
  const float mnC = -mn * C;
#pragma unroll
  for (int r = 0; r < 16; ++r) p0[r] = fmaf(p0[r], C, mnC);
#pragma unroll
  for (int r = 0; r < 16; ++r) p1[r] = fmaf(p1[r], C, mnC);
#pragma unroll
  for (int r = 0; r < 16; ++r) p0[r] = __builtin_amdgcn_exp2f(p0[r]);
}
__device__ __forceinline__ void finishSM(f32x16& p0, f32x16& p1, float alpha, float& l_reg, bf16x8& pa0, bf16x8& pa1, bf16x8& pa2, bf16x8& pa3) {
#pragma unroll
  for (int r = 0; r < 16; ++r) p1[r] = __builtin_amdgcn_exp2f(p1[r]);
  float ps = 0;
#pragma unroll
  for (int r = 0; r < 16; ++r) ps += p0[r];
#pragma unroll
  for (int r = 0; r < 16; ++r) ps += p1[r];
  { auto rr = __builtin_amdgcn_permlane32_swap(__float_as_uint(ps), __float_as_uint(ps), false, false);
    ps = __uint_as_float(rr[0]) + __uint_as_float(rr[1]); }
  l_reg = l_reg * alpha + ps;
#define ATT_PK4(P, BASE, OUT) do { unsigned a0 = cvtpk(P[BASE + 0], P[BASE + 1]), a1 = cvtpk(P[BASE + 2], P[BASE + 3]);   \
    unsigned b0 = cvtpk(P[BASE + 4], P[BASE + 5]), b1 = cvtpk(P[BASE + 6], P[BASE + 7]);                              \
    auto r0 = __builtin_amdgcn_permlane32_swap(a0, b0, false, false); auto r1 = __builtin_amdgcn_permlane32_swap(a1, b1, false, false); \
    u32x4 w = {r0[0], r1[0], r0[1], r1[1]}; OUT = *reinterpret_cast<bf16x8*>(&w); } while (0)
  ATT_PK4(p0, 0, pa0); ATT_PK4(p0, 8, pa1); ATT_PK4(p1, 0, pa2); ATT_PK4(p1, 8, pa3);
#undef ATT_PK4
}
__device__ __forceinline__ bf16x8 bl(__amdgpu_buffer_rsrc_t r, int voff, int soff) { const u32x4 w = __builtin_amdgcn_raw_buffer_load_b128(r, voff, soff, 0); return *reinterpret_cast<const bf16x8*>(&w); }
template <int DQK> __device__ __forceinline__ int kswz(int row, int colB) { return row * (DQK * 2) + (colB ^ ((row & 7) << 4)); }
template <int DQK> __device__ __forceinline__ void qkt(f32x16& p0, f32x16& p1, const char* Ks, const bf16x8* qr, int r32, int hi) {
  p0 = f32x16{}; p1 = f32x16{};
#pragma unroll
  for (int d0 = 0; d0 < DQK / 16; ++d0) { const int cb = (d0 * 16 + hi * 8) * 2;
    bf16x8 b0 = *reinterpret_cast<const bf16x8*>(Ks + kswz<DQK>(r32, cb));
    bf16x8 b1 = *reinterpret_cast<const bf16x8*>(Ks + kswz<DQK>(32 + r32, cb));
    p0 = __builtin_amdgcn_mfma_f32_32x32x16_bf16(b0, qr[d0], p0, 0, 0, 0);
    p1 = __builtin_amdgcn_mfma_f32_32x32x16_bf16(b1, qr[d0], p1, 0, 0, 0); }
}
__device__ __forceinline__ int v_st(int k, int c) { const int kk = (k & ~0xC) | ((k & 4) << 1) | ((k & 8) >> 1); return ((kk >> 3) * 4 + (c >> 5)) * 512 + ((kk & 7) * 32 + (c & 31)) * 2; }
__device__ __forceinline__ int v_rd_base(int lane) { return ((lane & 3) << 3) | (((lane >> 2) & 3) << 6) | (((lane >> 4) & 1) << 5) | (((lane >> 5) & 1) << 8); }
constexpr int v_rd_off(int d0, int ks, int half) { return d0 * 512 + ks * 4096 + half * 2048; }
template <int OFF> __device__ __forceinline__ s16x4 tr_read(int vb) {
  s16x4 r; asm volatile("ds_read_b64_tr_b16 %0, %1 offset:%2" : "=&v"(r) : "v"(vb), "i"(OFF) : "memory"); return r;
}
template <int D0> __device__ __forceinline__ void pv_one(f32x16& od, int vb, bf16x8 pa0, bf16x8 pa1, bf16x8 pa2, bf16x8 pa3) {
  const s16x4 l0 = tr_read<v_rd_off(D0, 0, 0)>(vb), h0 = tr_read<v_rd_off(D0, 0, 1)>(vb), l1 = tr_read<v_rd_off(D0, 1, 0)>(vb), h1 = tr_read<v_rd_off(D0, 1, 1)>(vb);
  const s16x4 l2 = tr_read<v_rd_off(D0, 2, 0)>(vb), h2 = tr_read<v_rd_off(D0, 2, 1)>(vb), l3 = tr_read<v_rd_off(D0, 3, 0)>(vb), h3 = tr_read<v_rd_off(D0, 3, 1)>(vb);
  asm volatile("s_waitcnt lgkmcnt(0)" ::: "memory"); ATT_SBAR();
#define ATT_PK(L, H) (bf16x8){L[0], L[1], L[2], L[3], H[0], H[1], H[2], H[3]}
  od = __builtin_amdgcn_mfma_f32_32x32x16_bf16(pa0, ATT_PK(l0, h0), od, 0, 0, 0);
  od = __builtin_amdgcn_mfma_f32_32x32x16_bf16(pa1, ATT_PK(l1, h1), od, 0, 0, 0);
  od = __builtin_amdgcn_mfma_f32_32x32x16_bf16(pa2, ATT_PK(l2, h2), od, 0, 0, 0);
  od = __builtin_amdgcn_mfma_f32_32x32x16_bf16(pa3, ATT_PK(l3, h3), od, 0, 0, 0);
#undef ATT_PK
}
__device__ __forceinline__ void pv_d0(f32x16* o, int vb, bf16x8 pa0, bf16x8 pa1, bf16x8 pa2, bf16x8 pa3) {
  pv_one<0>(o[0], vb, pa0, pa1, pa2, pa3); pv_one<1>(o[1], vb, pa0, pa1, pa2, pa3); pv_one<2>(o[2], vb, pa0, pa1, pa2, pa3); pv_one<3>(o[3], vb, pa0, pa1, pa2, pa3);
}
template <int DQK, int LDQ, int LDK, int LDV, int LDO, int SDEPTH>
__device__ __forceinline__ void attn_body(const bf16_t* __restrict__ Qb, const bf16_t* __restrict__ Kh, const bf16_t* __restrict__ Vh, bf16_t* __restrict__ Ob, int seq, char* lds, const float scale) {
  constexpr int NKC = DQK / 64;
  constexpr size_t SHM_K = shm_k<DQK>();
  const float C = scale * 1.4426950408889634f, thr_raw = THR / scale;
  const int tid = ph_tid(), wid = tid >> 6, lane = tid & 63, r32 = lane & 31, hi = lane >> 5;
  char* V_lds = lds; char* K_lds = lds + 2 * SHM_V;
  float* wsf = (float*)(lds + 2 * SHM_V + 2 * SHM_K) + wid * 64; float* li_l = wsf; float* al_l = wsf + 32;
  float m_reg = -1e30f, l_reg = 0; f32x16 o[4] = {}; bf16x8 qr[DQK / 16];
  const bf16_t* Qw = Qb + (long)(wid * QBLK + r32) * LDQ + hi * 8;
#pragma unroll
  for (int d0 = 0; d0 < DQK / 16; ++d0) qr[d0] = *reinterpret_cast<const bf16x8*>(Qw + d0 * 16);
  const int sr = tid >> 4, sc = (tid & 15) * 8, vst0 = v_st(sr, sc), vst1 = v_st(32 + sr, sc);
  int kgo[NKC], klo[NKC];
#pragma unroll
  for (int i = 0; i < NKC; ++i) { const int c = tid + 512 * i, kr = c / (DQK / 8), kc = (c % (DQK / 8)) * 8; kgo[i] = kr * LDK + kc; klo[i] = kswz<DQK>(kr, kc * 2); }
  const int vgo = sr * LDV + sc;
  const __amdgpu_buffer_rsrc_t rK = __builtin_amdgcn_make_buffer_rsrc((void*)Kh, 0, 0x7ffffffc, 0x00020000), rV = __builtin_amdgcn_make_buffer_rsrc((void*)Vh, 0, 0x7ffffffc, 0x00020000);
  const int vb0 = (int)(uintptr_t)V_lds + v_rd_base(lane);
  struct { bf16x8 vs0, vs1, ks[NKC]; } sr_[SDEPTH];
#define ATT_SLOAD(i, k0) do { const int _vo = (k0) * (LDV * 2), _ko = (k0) * (LDK * 2); sr_[i].vs0 = bl(rV, vgo * 2, _vo); sr_[i].vs1 = bl(rV, vgo * 2 + 64 * LDV, _vo); \
    _Pragma("unroll") for (int _c = 0; _c < NKC; ++_c) sr_[i].ks[_c] = bl(rK, kgo[_c] * 2, _ko); } while (0)
#define ATT_SWRITE(b, i) do { *(bf16x8*)(V_lds + (b) * SHM_V + vst0) = sr_[i].vs0; *(bf16x8*)(V_lds + (b) * SHM_V + vst1) = sr_[i].vs1; \
    _Pragma("unroll") for (int _c = 0; _c < NKC; ++_c) *(bf16x8*)(K_lds + (b) * SHM_K + klo[_c]) = sr_[i].ks[_c]; } while (0)
#define ATT_SWAIT() asm volatile("s_waitcnt vmcnt(%0)" :: "n"(SDEPTH == 2 ? 2 + NKC : 0) : "memory")
#define ATT_RESC(a) do { if (__any((a) < 1.f)) { if (hi == 0) al_l[r32] = (a); asm volatile("s_waitcnt lgkmcnt(0)" ::: "memory"); \
    _Pragma("unroll") for (int d = 0; d < 4; ++d) _Pragma("unroll") for (int r = 0; r < 16; ++r) o[d][r] *= al_l[crow(r, hi)]; } } while (0)
  f32x16 pA0, pA1, pB0, pB1; float mnA, mnB, alA, alB; bf16x8 pa0, pa1, pa2, pa3; const int NT = seq / KVBLK;
  constexpr int SE = 0, SO = SDEPTH - 1;
  ATT_SLOAD(SE, 0); asm volatile("s_waitcnt vmcnt(0)" ::: "memory"); ATT_SWRITE(0, SE); __syncthreads();
  qkt<DQK>(pA0, pA1, K_lds, qr, r32, hi); partialSM(pA0, pA1, m_reg, mnA, alA, C, thr_raw);
  ATT_SLOAD(SO, KVBLK); if (SDEPTH == 2) { if (2 < NT) ATT_SLOAD(SE, 2 * KVBLK); }
  ATT_SWAIT(); ATT_SWRITE(1, SO); __syncthreads();
  for (int j = 1; j + 1 < NT; j += 2) {
    ATT_SBAR(); qkt<DQK>(pB0, pB1, K_lds + SHM_K, qr, r32, hi);
    finishSM(pA0, pA1, alA, l_reg, pa0, pa1, pa2, pa3); ATT_SBAR();
    ATT_SLOAD(SO, (j + SDEPTH) * KVBLK); ATT_SBAR();
    pv_d0(o, vb0, pa0, pa1, pa2, pa3); partialSM(pB0, pB1, m_reg, mnB, alB, C, thr_raw);
    __syncthreads(); ATT_SWAIT(); ATT_SWRITE(0, SE);
    ATT_RESC(alB); __syncthreads();
    ATT_SBAR(); qkt<DQK>(pA0, pA1, K_lds, qr, r32, hi);
    finishSM(pB0, pB1, alB, l_reg, pa0, pa1, pa2, pa3); ATT_SBAR();
    if (SDEPTH == 1 || j + 3 < NT) ATT_SLOAD(SE, (j + 1 + SDEPTH) * KVBLK); ATT_SBAR();
    pv_d0(o, vb0 + (int)SHM_V, pa0, pa1, pa2, pa3); partialSM(pA0, pA1, m_reg, mnA, alA, C, thr_raw);
    __syncthreads(); ATT_SWAIT(); ATT_SWRITE(1, SO);
    ATT_RESC(alA); __syncthreads();
  }
  ATT_SBAR(); qkt<DQK>(pB0, pB1, K_lds + SHM_K, qr, r32, hi);
  finishSM(pA0, pA1, alA, l_reg, pa0, pa1, pa2, pa3); ATT_SBAR();
  pv_d0(o, vb0, pa0, pa1, pa2, pa3); partialSM(pB0, pB1, m_reg, mnB, alB, C, thr_raw);
  __syncthreads(); ATT_RESC(alB);
  finishSM(pB0, pB1, alB, l_reg, pa0, pa1, pa2, pa3); ATT_SBAR();
  pv_d0(o, vb0 + (int)SHM_V, pa0, pa1, pa2, pa3);
  { const int t2 = ph_tid(), l2 = t2 & 63, w2 = t2 >> 6, r2 = l2 & 31, h2 = l2 >> 5;
    float* li2 = (float*)(lds + 2 * SHM_V + 2 * SHM_K) + w2 * 64;
    if (h2 == 0) li2[r2] = l_reg; asm volatile("s_waitcnt lgkmcnt(0)" ::: "memory");
    bf16_t* Ow = Ob + (w2 * QBLK) * LDO + r2;
#pragma unroll
    for (int r = 0; r < 16; ++r) { const int orow = crow(r, h2); const float rl = __builtin_amdgcn_rcpf(li2[orow]);
#pragma unroll
      for (int d0 = 0; d0 < 4; ++d0) Ow[orow * LDO + d0 * 32] = (bf16_t)(cvtpk(o[d0][r] * rl, 0.f) & 0xffffu); } }
  __syncthreads();
#undef ATT_SLOAD
#undef ATT_SWRITE
#undef ATT_SWAIT
#undef ATT_RESC
}

template <int DQK, int LDQ, int LDK, int LDV, int LDO>
__device__ __forceinline__ void attn_body_s1(const bf16_t* __restrict__ Qb, const bf16_t* __restrict__ Kh, const bf16_t* __restrict__ Vh, bf16_t* __restrict__ Ob, int seq, char* lds, const float scale) {
  constexpr int NKC = DQK / 64; constexpr size_t SHM_K = shm_k<DQK>();
  const float C = scale * 1.4426950408889634f, thr_raw = THR / scale;
  const int tid = ph_tid(), wid = tid >> 6, lane = tid & 63, r32 = lane & 31, hi = lane >> 5;
  char* V_lds = lds; char* K_lds = lds + 2 * SHM_V;
  float* wsf = (float*)(lds + 2 * SHM_V + 2 * SHM_K) + wid * 64; float* li_l = wsf; float* al_l = wsf + 32;
  float m_reg = -1e30f, l_reg = 0; f32x16 o[4] = {}; bf16x8 qr[DQK / 16];
  const bf16_t* Qw = Qb + (long)(wid * QBLK + r32) * LDQ + hi * 8;
#pragma unroll
  for (int d0 = 0; d0 < DQK / 16; ++d0) qr[d0] = *reinterpret_cast<const bf16x8*>(Qw + d0 * 16);
  const int sr = tid >> 4, sc = (tid & 15) * 8, vst0 = v_st(sr, sc), vst1 = v_st(32 + sr, sc);
  int kgo[NKC], klo[NKC];
#pragma unroll
  for (int i = 0; i < NKC; ++i) { const int c = tid + 512 * i, kr = c / (DQK / 8), kc = (c % (DQK / 8)) * 8; kgo[i] = kr * LDK + kc; klo[i] = kswz<DQK>(kr, kc * 2); }
  const int vgo = sr * LDV + sc;
  const __amdgpu_buffer_rsrc_t rK = __builtin_amdgcn_make_buffer_rsrc((void*)Kh, 0, 0x7ffffffc, 0x00020000), rV = __builtin_amdgcn_make_buffer_rsrc((void*)Vh, 0, 0x7ffffffc, 0x00020000);
  const int vb0 = (int)(uintptr_t)V_lds + v_rd_base(lane);
  bf16x8 vs0, vs1, ks[NKC];
#define ATT1_SLOAD(k0) do { const int _vo = (k0) * (LDV * 2), _ko = (k0) * (LDK * 2); vs0 = bl(rV, vgo * 2, _vo); vs1 = bl(rV, vgo * 2 + 64 * LDV, _vo); \
    _Pragma("unroll") for (int _c = 0; _c < NKC; ++_c) ks[_c] = bl(rK, kgo[_c] * 2, _ko); } while (0)
#define ATT1_SWRITE(b) do { *(bf16x8*)(V_lds + (b) * SHM_V + vst0) = vs0; *(bf16x8*)(V_lds + (b) * SHM_V + vst1) = vs1; \
    _Pragma("unroll") for (int _c = 0; _c < NKC; ++_c) *(bf16x8*)(K_lds + (b) * SHM_K + klo[_c]) = ks[_c]; } while (0)
  const int NT = seq / KVBLK;
  ATT1_SLOAD(0); asm volatile("s_waitcnt vmcnt(0)" ::: "memory"); ATT1_SWRITE(0);
  ATT1_SLOAD(KVBLK); asm volatile("s_waitcnt vmcnt(0)" ::: "memory"); ATT1_SWRITE(1); __syncthreads();
  for (int j = 0; j < NT; ++j) { const int b = j & 1;
    ATT_SBAR();
    f32x16 p0, p1; float mn, al; bf16x8 pa0, pa1, pa2, pa3;
    qkt<DQK>(p0, p1, K_lds + b * SHM_K, qr, r32, hi);
    partialSM(p0, p1, m_reg, mn, al, C, thr_raw);
    if (__any(al < 1.f)) { if (hi == 0) al_l[r32] = al; asm volatile("s_waitcnt lgkmcnt(0)" ::: "memory");
#pragma unroll
      for (int d = 0; d < 4; ++d)
#pragma unroll
        for (int r = 0; r < 16; ++r) o[d][r] *= al_l[crow(r, hi)]; }
    finishSM(p0, p1, al, l_reg, pa0, pa1, pa2, pa3); ATT_SBAR();
    if (j + 2 < NT) ATT1_SLOAD((j + 2) * KVBLK);
    ATT_SBAR();
    pv_d0(o, vb0 + b * (int)SHM_V, pa0, pa1, pa2, pa3);
    __syncthreads();
    if (j + 2 < NT) { asm volatile("s_waitcnt vmcnt(0)" ::: "memory"); ATT1_SWRITE(b); } }
  { const int t2 = ph_tid(), l2 = t2 & 63, w2 = t2 >> 6, r2 = l2 & 31, h2 = l2 >> 5;
    float* li2 = (float*)(lds + 2 * SHM_V + 2 * SHM_K) + w2 * 64;
    if (h2 == 0) li2[r2] = l_reg; asm volatile("s_waitcnt lgkmcnt(0)" ::: "memory");
    bf16_t* Ow = Ob + (w2 * QBLK) * LDO + r2;
#pragma unroll
    for (int r = 0; r < 16; ++r) { const int orow = crow(r, h2); const float rl = __builtin_amdgcn_rcpf(li2[orow]);
#pragma unroll
      for (int d0 = 0; d0 < 4; ++d0) Ow[orow * LDO + d0 * 32] = (bf16_t)(cvtpk(o[d0][r] * rl, 0.f) & 0xffffu); } }
  __syncthreads();
#undef ATT1_SLOAD
#undef ATT1_SWRITE
}
template <int TYPE> __device__ __forceinline__ void attn_unit(const Params& p, int u, char* lds) {
  bf16_t* P = WSP(bf16_t, p, regA); bf16_t* OA = WSP(bf16_t, p, oall);
  int type, b, h, qb;
  if (u < 256) { const int x = u & 7, idx = u >> 3; type = idx >> 4; qb = idx & 15; b = x >> 2; h = x & 3; }
  else { const int v = u - 256; type = v >> 3; b = (v >> 2) & 1; h = v & 3; qb = SEQ / 256; }
  const long q0 = (long)b * NTOK + qb * 256, k0 = (long)b * NTOK + (qb == SEQ / 256 ? SEQ : 0); const int seq = (qb == SEQ / 256) ? CTXL : NTOK;
  if (TYPE == 0) attn_body_s1<MQK, MH * MQK, MH * MQK, MH * MV, DM>(WSP(bf16_t, p, qm) + q0 * (MH * MQK) + h * MQK, WSP(bf16_t, p, km) + k0 * (MH * MQK) + h * MQK, WSP(bf16_t, p, vm) + k0 * (MH * MV) + h * MV,
                                                                 OA + q0 * DM + 3 * BW + h * MV, seq, lds, 0.07216878364870322f  );
  else attn_body<GHD, PW, PW, PW, DM, ATT_SD_GQA>(P + q0 * PW + OFF_GQ + h * GHD, P + k0 * PW + OFF_GK + (h / (GH / GKV)) * GHD, P + k0 * PW + OFF_GV + (h / (GH / GKV)) * GHD,
                                      OA + q0 * DM + BW + h * GHD, seq, lds, 0.08838834764831845f  );
}
}
template <int TYPE> __global__ __launch_bounds__(512, 2) void k_attn(Params p, int l) {
  extern __shared__ __attribute__((aligned(16))) unsigned char shm[];
  const int nu = 256 + (l == 0 ? 16 : 0);
  for (int u = blockIdx.x; u < nu; u += gridDim.x) { const int type = u < 256 ? ((u >> 3) >> 4) : ((u - 256) >> 3); if (type == TYPE) att::attn_unit<TYPE>(p, u, (char*)shm); }
}
#endif
#ifndef CPU_TEST
namespace ret {
using pg8::f32x4; using pg8::u32x4; using pg8::bf16x8;
static_assert(RCH == 128 && RQK == 64 && RV == 128, "retention tiles are written for chunk 128, qk 64, v 128");
constexpr int PT_ = 272, PS = 528, PQ = 144;
constexpr int LDS_A = 2 * 128 * PT_, LDS_C = 128 * PQ + 2 * 128 * PS + 2 * 132 * 4;
template <int NB, int KS> __device__ __forceinline__ void mma16(f32x4 (&acc)[NB], const LAS char* A, int lda, const LAS char* Bt, int ldb) {
  const int lane = ph_tid() & 63, r = lane & 15, kq = lane >> 4;
#pragma unroll
  for (int s = 0; s < KS; ++s) { const bf16x8 a = *(const LAS bf16x8*)(A + r * lda + (s * 32 + kq * 8) * 2);
#pragma unroll
    for (int nb = 0; nb < NB; ++nb) { const bf16x8 bfr = *(const LAS bf16x8*)(Bt + (nb * 16 + r) * ldb + (s * 32 + kq * 8) * 2); acc[nb] = __builtin_amdgcn_mfma_f32_16x16x32_bf16(a, bfr, acc[nb], 0, 0, 0); } }
}
__device__ __forceinline__ long chunk_row0(int b, int cs) { return (long)b * NTOK + (cs < SEQ / RCH ? cs * RCH : SEQ + (cs - SEQ / RCH) * RCH); }
__device__ __forceinline__ void st16(LAS char* p, unsigned v) { *(LAS unsigned short*)p = (unsigned short)v; }
template <int NC, bool WEIGHT, int PT> __device__ __forceinline__ void stage_T(LAS char* T, LAS char* T2, const bf16_t* src, int ld, float lg1, float lg2) {
  const int tidq = ph_tid();
#pragma unroll
  for (int i = 0; i < NC / 4; ++i) { const int id = tidq + 512 * i, key = id & 127, c = id >> 7; const u32x4 w = *(const u32x4*)(src + (long)key * ld + 8 * c);
    if (!WEIGHT) {
      st16(T + (8 * c + 0) * PT + key * 2, w.x); st16(T + (8 * c + 1) * PT + key * 2, w.x >> 16); st16(T + (8 * c + 2) * PT + key * 2, w.y); st16(T + (8 * c + 3) * PT + key * 2, w.y >> 16);
      st16(T + (8 * c + 4) * PT + key * 2, w.z); st16(T + (8 * c + 5) * PT + key * 2, w.z >> 16); st16(T + (8 * c + 6) * PT + key * 2, w.w); st16(T + (8 * c + 7) * PT + key * 2, w.w >> 16);
    } else { f32x4 a, b2; pg8::unpack8(w, a, b2); const float w1 = __expf(lg1 * (float)(RCH - 1 - key)), w2 = __expf(lg2 * (float)key);
#pragma unroll
      for (int j = 0; j < 4; ++j) { st16(T + (8 * c + j) * PT + key * 2, pg8::cvt_pk_bf16(a[j] * w1, 0.f)); st16(T + (8 * c + 4 + j) * PT + key * 2, pg8::cvt_pk_bf16(b2[j] * w1, 0.f));
        st16(T2 + (8 * c + j) * PT + key * 2, pg8::cvt_pk_bf16(a[j] * w2, 0.f)); st16(T2 + (8 * c + 4 + j) * PT + key * 2, pg8::cvt_pk_bf16(b2[j] * w2, 0.f)); } } }
}
__device__ __forceinline__ void ret_a_unit(const Params& p, int l, int u, LAS char* lds) {
  const int cs = u % RNC, h = (u / RNC) % RH, b = u / (RNC * RH), tidu = ph_tid(), wv = tidu >> 6, lane = tidu & 63;
  const float lgf = -__expf(p.in[I_RDF][l * RH + h]), lgb = -__expf(p.in[I_RDB][l * RH + h]);
  const bf16_t* P = WSP(bf16_t, p, regA) + chunk_row0(b, cs) * PW; LAS char* VT = lds; LAS char* KT = lds + 128 * PT_;
  stage_T<16, false, PT_>(VT, nullptr, P + OFF_RV + h * RV, PW, 0.f, 0.f);
  stage_T<8, true, PT_>(KT, KT + 64 * PT_, P + OFF_RK + h * RQK, PW, lgf, lgb);
  __syncthreads();
  f32x4 acc[8];
#pragma unroll
  for (int nb = 0; nb < 8; ++nb) acc[nb] = (f32x4){0.f, 0.f, 0.f, 0.f};
  mma16<8, 4>(acc, VT + wv * 16 * PT_, PT_, KT, PT_);
  float* RKV = WSP(float, p, rkv);
#pragma unroll
  for (int nb = 0; nb < 8; ++nb) { const int col = nb * 16 + (lane & 15), dir = col >> 6, dk = col & 63; float* o = RKV + ((((long)(b * RH + h) * 2 + dir) * RNC + cs) * RV + wv * 16 + (lane >> 4) * 4) * RQK + dk;
#pragma unroll
    for (int r = 0; r < 4; ++r) o[r * RQK] = acc[nb][r]; }
  __syncthreads();
}
__device__ __forceinline__ void ph_ret_scan(const Params& p, int l) {
  const float* RKV = WSP(float, p, rkv); bf16_t* RS = WSP(bf16_t, p, rs); constexpr int NL = SEQ / RCH, NCX = CTXL / RCH;
  for (long i = (long)blockIdx.x * 512 + ph_tid(); i < (long)NB * RH * 2 * RV * RQK; i += (long)gridDim.x * 512) { const int e = (int)(i % (RV * RQK)), dir = (int)((i / (RV * RQK)) % 2), h = (int)((i / (2 * RV * RQK)) % RH), b = (int)(i / (2 * RV * RQK * RH));
    const float lg = -__expf(p.in[dir ? I_RDB : I_RDF][l * RH + h]), dec = __expf(lg * (float)RCH); const long base = (((long)(b * RH + h) * 2 + dir) * RNC) * (RV * RQK) + e; float S = 0.f;
    for (int s0 = 0; s0 < RNC; s0 += 17) { float kv[17]; int cs_[17];
#pragma unroll
      for (int q = 0; q < 17; ++q) { const int s = s0 + q; cs_[q] = dir == 0 ? (s < NCX ? NL + s : s - NCX) : (RNC - 1 - s); kv[q] = RKV[base + (long)cs_[q] * (RV * RQK)]; }
#pragma unroll
      for (int q = 0; q < 17; ++q) { RS[base + (long)cs_[q] * (RV * RQK)] = (bf16_t)(pg8::cvt_pk_bf16(S, 0.f) & 0xffffu); S = dec * S + kv[q]; } } }
}
__device__ __forceinline__ void ret_c_unit(const Params& p, int l, int u, LAS char* lds) {
  const int ncs = (l == NLAYER - 1) ? SEQ / RCH : RNC; const int cs = u % ncs, h = (u / ncs) % RH, b = u / (ncs * RH), tid = ph_tid(), wv = tid >> 6, lane = tid & 63;
  const float lgf = -__expf(p.in[I_RDF][l * RH + h]), lgb = -__expf(p.in[I_RDB][l * RH + h]); const long R0 = chunk_row0(b, cs);
  const bf16_t* P = WSP(bf16_t, p, regA) + R0 * PW; LAS char* Ks = lds; LAS char* Ss = lds + 128 * PQ; LAS char* B2 = Ss + 128 * PS; LAS float* gf = (LAS float*)(B2 + 128 * PS); LAS float* gb = gf + 132;
  if (tid < 129) { gf[tid] = __expf(lgf * (float)tid); gb[tid] = __expf(lgb * (float)tid); }
#pragma unroll
  for (int i = 0; i < 2; ++i) { const int id = tid + 512 * i, row = id >> 3, c = id & 7; *(LAS u32x4*)(Ks + row * PQ + c * 16) = *(const u32x4*)(P + (long)row * PW + OFF_RK + h * RQK + 8 * c);
    *(LAS u32x4*)(Ss + row * PS + 256 + c * 16) = *(const u32x4*)(P + (long)row * PW + OFF_RQ + h * RQK + 8 * c); }
  stage_T<16, false, PS>(B2, nullptr, P + OFF_RV + h * RV, PW, 0.f, 0.f);
  { const bf16_t* RS = WSP(bf16_t, p, rs);
#pragma unroll
    for (int i = 0; i < 4; ++i) { const int id = tid + 512 * i, dir = id >> 10, dv = (id >> 3) & 127, c = id & 7;
      *(LAS u32x4*)(B2 + dv * PS + 256 + dir * 128 + c * 16) = *(const u32x4*)(RS + ((((long)(b * RH + h) * 2 + dir) * RNC + cs) * RV + dv) * RQK + 8 * c); } }
  __syncthreads();
  LAS char* myS = Ss + wv * 16 * PS;
  { f32x4 acc[8];
#pragma unroll
    for (int nb = 0; nb < 8; ++nb) acc[nb] = (f32x4){0.f, 0.f, 0.f, 0.f};
    mma16<8, 2>(acc, myS + 256, PS, Ks, PQ);
#pragma unroll
    for (int nb = 0; nb < 8; ++nb) { const int a2 = nb * 16 + (lane & 15);
#pragma unroll
      for (int r = 0; r < 4; ++r) { const int ar = (lane >> 4) * 4 + r, a = wv * 16 + ar; const float f = a2 <= a ? gf[a - a2] : gb[a2 - a]; st16(myS + ar * PS + a2 * 2, pg8::cvt_pk_bf16(acc[nb][r] * f, 0.f)); } } }
#pragma unroll
  for (int i = 0; i < 2; ++i) { const int id = lane + 64 * i, ar = id >> 3, c = id & 7, a = wv * 16 + ar; LAS char* q = myS + ar * PS + 256 + c * 16; f32x4 x0, x1; pg8::unpack8(*(const LAS u32x4*)q, x0, x1);
    const float sf = gf[a + 1], sb = gb[RCH - a]; *(LAS u32x4*)(q + 128) = pg8::pack8(x0 * sb, x1 * sb); *(LAS u32x4*)q = pg8::pack8(x0 * sf, x1 * sf); }
  asm volatile("s_waitcnt lgkmcnt(0)" ::: "memory");
  f32x4 o[8];
#pragma unroll
  for (int nb = 0; nb < 8; ++nb) o[nb] = (f32x4){0.f, 0.f, 0.f, 0.f};
  mma16<8, 8>(o, myS, PS, B2, PS);
  const float* gain = p.in[I_RNORM] + l * BW + h * RV; bf16_t* OA = WSP(bf16_t, p, oall);
#pragma unroll
  for (int r = 0; r < 4; ++r) { float s = 0.f;
#pragma unroll
    for (int nb = 0; nb < 8; ++nb) s += o[nb][r];
    s += __shfl_xor(s, 8); s += __shfl_xor(s, 4); s += __shfl_xor(s, 2); s += __shfl_xor(s, 1); const float mean = s * (1.f / RV); float q = 0.f;
#pragma unroll
    for (int nb = 0; nb < 8; ++nb) { const float d = o[nb][r] - mean; q += d * d; }
    q += __shfl_xor(q, 8); q += __shfl_xor(q, 4); q += __shfl_xor(q, 2); q += __shfl_xor(q, 1); const float rs = 1.f / sqrtf(q * (1.f / RV) + NORM_EPS);
    const long R = R0 + wv * 16 + (lane >> 4) * 4 + r;
#pragma unroll
    for (int nb = 0; nb < 8; ++nb) { const int dv = nb * 16 + (lane & 15); const float gt = bf2f(P[(R - R0) * PW + OFF_RG + h * RV + dv]);
      OA[R * DM + 2 * BW + h * RV + dv] = (bf16_t)(pg8::cvt_pk_bf16((o[nb][r] - mean) * rs * gain[dv] * gt * pg8::fast_sigmoid(gt), 0.f) & 0xffffu); } }
  __syncthreads();
}
}
template <int WHICH> __global__ __launch_bounds__(512, 2) void k_ret(Params p, int l) {
  extern __shared__ __attribute__((aligned(16))) unsigned char shm[]; LAS char* lds = (LAS char*)shm;
  if (WHICH == 0) for (int u = blockIdx.x; u < NB * RH * RNC; u += gridDim.x) ret::ret_a_unit(p, l, u, lds);
  if (WHICH == 1) ret::ph_ret_scan(p, l);
  if (WHICH == 2) { const int nu = NB * RH * ((l == NLAYER - 1) ? SEQ / RCH : RNC); for (int u = blockIdx.x; u < nu; u += gridDim.x) ret::ret_c_unit(p, l, u, lds); }
}
#endif
#ifndef CPU_TEST
#define XB_TMO      128
#define XB_XCNT(j)  (256  + 64 * (j))
#define XB_XSUB(j)  (1280 + 64 * (j))
#define XB_XGEN(j)  (2304 + 64 * (j))
#define XB_TOP      3328
#define XB_TOPGEN   3392
#define XCD_BAR_WORDS 3456
#define XB_SPIN_CAP (1u << 18)

__device__ __forceinline__ unsigned xb_ld(unsigned* p)              { return __hip_atomic_load(p, __ATOMIC_RELAXED, __HIP_MEMORY_SCOPE_AGENT); }
__device__ __forceinline__ unsigned xb_add(unsigned* p, unsigned v) { return __hip_atomic_fetch_add(p, v, __ATOMIC_RELAXED, __HIP_MEMORY_SCOPE_AGENT); }
__device__ __forceinline__ unsigned xb_xcc_id() { return (unsigned)__builtin_amdgcn_s_getreg((3 << 11) | 20) & 0xFu; }
#define XB_SPIN(cond, bar) do { unsigned _sp = 0; while (cond) { __builtin_amdgcn_s_sleep(1); \
    if ((++_sp & 255u) == 0u) { if (xb_ld(&(bar)[XB_TMO])) break; if (_sp > XB_SPIN_CAP) { atomicAdd(&(bar)[XB_TMO], 1u); break; } } } } while (0)

struct XcdBarrier {
    unsigned* bar; unsigned x;
    volatile LAS unsigned* st;
};

__device__ __forceinline__ XcdBarrier xcd_barrier_post(unsigned* bar, volatile LAS unsigned* st) {
    XcdBarrier b; b.bar = bar; b.x = xb_xcc_id(); b.st = st;
    if (threadIdx.x == 0) (void)xb_add(&bar[XB_XCNT(b.x)], 1u);
    return b;
}
__device__ __forceinline__ void xcd_barrier_complete(unsigned* bar, unsigned x, unsigned& nloc, unsigned& nx) {
    const unsigned G = gridDim.x * gridDim.y * gridDim.z;
    unsigned sum, cnt, mine, sp = 0u;
    for (;;) {
        sum = 0u; cnt = 0u; mine = 0u;
#pragma unroll
        for (unsigned j = 0; j < 16; ++j) { const unsigned c = xb_ld(&bar[XB_XCNT(j)]); sum += c; cnt += (c > 0u) ? 1u : 0u; mine = (j == x) ? c : mine; }
        if (sum == G) break;
        __builtin_amdgcn_s_sleep(1);
        if ((++sp & 255u) == 0u) { if (xb_ld(&bar[XB_TMO])) break; if (sp > XB_SPIN_CAP) { atomicAdd(&bar[XB_TMO], 1u); break; } }
    }
    nloc = mine > 0u ? mine : 1u; nx = cnt > 0u ? cnt : 1u;
}

__device__ __forceinline__ void xcd_barrier(const XcdBarrier& b) {
    asm volatile("s_waitcnt vmcnt(0)" ::: "memory");
    __syncthreads();
    if (threadIdx.x == 0) {
        unsigned* bar = b.bar;
        __builtin_amdgcn_s_waitcnt(0);
        unsigned nloc = b.st[0], nx = b.st[1];
        if (nloc == 0u) { xcd_barrier_complete(bar, b.x, nloc, nx); b.st[0] = nloc; b.st[1] = nx; }
        const unsigned old = xb_add(&bar[XB_XSUB(b.x)], 1u);
        const unsigned gen = old / nloc;
        if (old + 1u == (gen + 1u) * nloc) {
            __builtin_amdgcn_fence(__ATOMIC_RELEASE, "agent");
            asm volatile("s_waitcnt vmcnt(0)" ::: "memory");
            const unsigned og = xb_add(&bar[XB_TOP], 1u);
            const unsigned tg = og / nx;
            if (og + 1u == (tg + 1u) * nx) xb_add(&bar[XB_TOPGEN], 1u);
            else XB_SPIN(xb_ld(&bar[XB_TOPGEN]) == tg, bar);
            __builtin_amdgcn_fence(__ATOMIC_ACQUIRE, "agent");
            xb_add(&bar[XB_XGEN(b.x)], 1u);
            asm volatile("s_waitcnt vmcnt(0)" ::: "memory");
        } else {
            XB_SPIN(xb_ld(&bar[XB_XGEN(b.x)]) == gen, bar);
            __builtin_amdgcn_fence(__ATOMIC_ACQUIRE, "agent");
            asm volatile("s_waitcnt vmcnt(0)" ::: "memory");
        }
    }
    __syncthreads();
}

#endif
#ifndef CPU_TEST
#include <type_traits>
constexpr int MEGA_LDS = ((ret::LDS_C > pg8::STAGE_BYTES ? ret::LDS_C : pg8::STAGE_BYTES) + 255) / 256 * 256 + 256;
__device__ __forceinline__ int rotc(int off) { const int G = gridDim.x; return (int)((blockIdx.x + G - (off % G)) % G); }

__global__ __launch_bounds__(512, 2) void mega(Params p) {
  extern __shared__ __attribute__((aligned(16))) unsigned char shm[];
  LAS unsigned char* lds = (LAS unsigned char*)shm; char* ldsg = (char*)shm;
  LAS unsigned* xbw = (LAS unsigned*)(lds + MEGA_LDS - 16);
  if (threadIdx.x < 4) xbw[threadIdx.x] = 0u;
  __syncthreads();
  XcdBarrier bar = xcd_barrier_post((unsigned*)(p.ws + WS.bar), (volatile LAS unsigned*)xbw);
  using namespace pg8;
  const int G = gridDim.x;
  bf16_t* P = WSP(bf16_t, p, regA); bf16_t* PROJ = (bf16_t*)(p.ws + WS.regA + SZ_P); bf16_t* H1 = WSP(bf16_t, p, h1);
  bf16_t* QM = WSP(bf16_t, p, qm); bf16_t* KM = WSP(bf16_t, p, km); bf16_t* VM = WSP(bf16_t, p, vm); bf16_t* Z = WSP(bf16_t, p, z); bf16_t* OA = WSP(bf16_t, p, oall);
  bf16_t* XS = WSP(bf16_t, p, regA); bf16_t* ACT = (bf16_t*)(p.ws + WS.regA + SZ_XS); bf16_t* YS = (bf16_t*)(p.ws + WS.regA + SZ_XS + SZ_ACT);
  constexpr int nMfull = MROWS / 256;

  ph::ph_s5tables(p, lds);
  ph::ph_tables(p);
  ph::ph_mod(p, lds);
  ph::ph_conv(p, lds);
  xcd_barrier(bar);
  ph::ph_ln_in(p, 0);
  xcd_barrier(bar);

  auto layer = [&](auto LC) { constexpr int l = decltype(LC)::value; constexpr int last = (l == NLAYER - 1), nMlat = last ? nMfull - 2 : nMfull;
    { SchedGrid S{(const char*)H1, (const char*)(WSP(bf16_t, p, wt_in) + (long)l * PW * DM), DM, DM, nMfull, PW / 256, 0, G, (int)blockIdx.x, 0};
      gemm_phase(lds, GemmG{DM, DM, DM, 0}, S, EpiBf16{P, PW, 0}); }
    xcd_barrier(bar);
    ph::ph_post_proj(p, l);
    xcd_barrier(bar);
    { SchedGrid S{(const char*)(P + OFF_CQ), (const char*)(WSP(bf16_t, p, wt_uq) + (long)l * MH * MQK * MQL), PW, MQL, nMfull, MH * MQK / 256, 0, G, rotc(0), 0};
      gemm_phase(lds, GemmG{PW, MQL, MQL, 0}, S, EpiQM{QM, WSP(float, p, rope_b)}); }
    { SchedGrid S{(const char*)(P + OFF_CKV), (const char*)(WSP(bf16_t, p, wt_ukv) + (long)l * MH * (MNOPE + MV) * MKVL), PW, MKVL, nMfull, MH, 0, G, rotc(102), 0};
      gemm_phase(lds, GemmG{PW, MKVL, MKVL, 0}, S, EpiKVm{KM, VM}); }
    { SchedS5 S{(const char*)WSP(bf16_t, p, uh), (const char*)(WSP(bf16_t, p, s5sw) + (long)l * S5G * S5K2 * S5K1), (size_t)S5K2 * S5K1 * 2, G, rotc(238)};
      gemm_phase(lds, GemmG{S5K1 + S5K2, S5K1, S5K1, 0}, S, EpiS5E{WSP(float, p, s5e)}); }
    for (int u = rotc(78); u < NB * RH * RNC; u += G) ret::ret_a_unit(p, l, u, (LAS char*)lds);
    xcd_barrier(bar);
    ph::ph_s5scan(p, l);
    ret::ph_ret_scan(p, l);
    xcd_barrier(bar);
    { const int w = blockIdx.x;
      if (w < 128) att::attn_unit<0>(p, w, ldsg); else if (w < 256) att::attn_unit<1>(p, w, ldsg);
      if (!last) { if (w >= 224 && w < 232) att::attn_unit<0>(p, 256 + (w - 224), ldsg); else if (w >= 232 && w < 240) att::attn_unit<1>(p, 256 + (w - 224), ldsg); } }
    { SchedS5 S{(const char*)WSP(bf16_t, p, uh), (const char*)(WSP(bf16_t, p, s5sv) + (long)l * S5G * S5K1 * (S5K1 + S5K2)), (size_t)S5K1 * (S5K1 + S5K2) * 2, G, rotc(128)};
      gemm_phase(lds, GemmG{S5K1 + S5K2, S5K1 + S5K2, S5K1 + S5K2, 0}, S, EpiS5Y{P, p.in[I_S5D] + (long)l * BW, Z, last, 0}); }
    { const int nu = NB * RH * (last ? SEQ / RCH : RNC); for (int u = rotc(128); u < nu; u += G) ret::ret_c_unit(p, l, u, (LAS char*)lds); }
    xcd_barrier(bar);
    { SchedGrid S{(const char*)Z, (const char*)(WSP(bf16_t, p, wt_glu) + (long)l * BW * BW), BW, BW, nMlat, BW / 256, last, G, (int)blockIdx.x, 0};
      gemm_phase(lds, GemmG{BW, BW, BW, 0}, S, EpiGluO{Z, OA}); }
    xcd_barrier(bar);
    { SchedProj S{(const char*)OA, (const char*)(WSP(bf16_t, p, wt_br) + (long)l * 4 * DM * BW), nMlat, last, G, (int)blockIdx.x};
      gemm_phase(lds, GemmG{DM, BW, BW, 0}, S, EpiBf16{PROJ, 4 * DM, 0}); }
    xcd_barrier(bar);
    { SchedGate S{(const char*)H1, (const char*)(WSP(bf16_t, p, wt_gate) + (long)l * 4 * DM * DM), nMlat, last, G, (int)blockIdx.x};
      gemm_phase(lds, GemmG{DM, DM, DM, 0}, S, EpiGateMerge{p.in[I_BGATE] + (long)l * 4 * DM, PROJ, WSP(float, p, macc), WSP(bf16_t, p, merged)}); }
    xcd_barrier(bar);
    { SchedGrid S{(const char*)WSP(bf16_t, p, merged), (const char*)(WSP(bf16_t, p, wt_out) + (long)l * DM * DM), DM, DM, nMlat, DM / 256, last, G, (int)blockIdx.x, 0};
      gemm_phase(lds, GemmG{DM, DM, DM, 0}, S, EpiF32{WSP(float, p, macc), DM, 0}); }
    xcd_barrier(bar);
    ph::ph_ln1(p, l, lds);
    xcd_barrier(bar);
    ph::ph_topk(p, l, lds);
    xcd_barrier(bar);
    ph::ph_gather(p, l);
    xcd_barrier(bar);
    const int nMl = last ? (2 * CAP_L) / 256 : XEP / 256;
    { SchedMoe S{(const char*)XS, (const char*)(WSP(bf16_t, p, wt_gu) + (long)l * NE * 2 * FF * DM), DM, DM, nMl, 2 * FF / 256, (size_t)2 * FF * DM * 2, G, (int)blockIdx.x};
      gemm_phase(lds, GemmG{DM, DM, DM, 0}, S, EpiSwiGlu{ACT}); }
    xcd_barrier(bar);
    { SchedMoe S{(const char*)ACT, (const char*)(WSP(bf16_t, p, wt_dn) + (long)l * NE * DM * FF), FF, FF, nMl, DM / 256, (size_t)DM * FF * 2, G, (int)blockIdx.x};
      gemm_phase(lds, GemmG{FF, FF, FF, 0}, S, EpiDownG{WSP(float, p, gatev), YS}); }
    xcd_barrier(bar);
    ph::ph_ln2(p, l);
    if (!last) xcd_barrier(bar);
  };
  layer(std::integral_constant<int, 0>{});
  layer(std::integral_constant<int, 1>{});
}

extern "C" void kernel_launch(void* const* d_in, const int* in_sizes, int n_in, void* d_out, int out_size, void* d_ws, size_t ws_size, hipStream_t stream) {
  if (n_in != N_IN || ws_size < WS.end || out_size != NB * SEQ * DM) { fprintf(stderr, "kernel_launch: unexpected sizes n_in %d ws %zu (need %zu) out %d\n", n_in, ws_size, WS.end, out_size); return; }
  static int grid = 0;
  if (!grid) { int dev = 0, cus = 0, per_cu = 0; (void)hipGetDevice(&dev); (void)hipDeviceGetAttribute(&cus, hipDeviceAttributeMultiprocessorCount, dev);
    (void)hipFuncSetAttribute((const void*)mega, hipFuncAttributeMaxDynamicSharedMemorySize, MEGA_LDS);
    (void)hipOccupancyMaxActiveBlocksPerMultiprocessor(&per_cu, (const void*)mega, 512, MEGA_LDS);
    if (per_cu < 1) { fprintf(stderr, "kernel_launch: occupancy query says %d blocks per CU\n", per_cu); return; }
    grid = cus > 256 ? 256 : cus; }
  Params p; memset(&p, 0, sizeof(p));
  for (int i = 0; i < N_IN; ++i) p.in[i] = (const float*)d_in[i];
  p.out = (float*)d_out; p.ws = (char*)d_ws;
  (void)hipMemsetAsync((char*)d_ws + WS.bar, 0, XCD_BAR_WORDS * sizeof(unsigned), stream);
  hipLaunchKernelGGL(mega, dim3(grid), dim3(512), MEGA_LDS, stream, p);
}
#endif
```

```cpp
#ifdef CPU_TEST
#include <cmath>
#include <cstdio>
#include <cstdlib>
#include <cstring>
#include <cstdint>
#include <functional>
#define __global__
#define __device__
#define __host__
#define __forceinline__ inline
#define __launch_bounds__(...)
#define __restrict__
struct dim3s { int x, y, z; };
static thread_local dim3s blockIdx, threadIdx, blockDim, gridDim;
typedef void* hipStream_t;
template <class F> static void cpu_launch(int grid, int block, F f) {
#pragma omp parallel for schedule(dynamic, 1)
  for (int b = 0; b < grid; ++b) {
    gridDim.x = grid; blockDim.x = block; blockIdx.x = b;
    for (int t = 0; t < block; ++t) { threadIdx.x = t; f(); }
  }
}
#define LAUNCH(kern, grid, block, ...) cpu_launch((grid), (block), [&]() { kern(__VA_ARGS__); })
static inline void hipMemsetAsync(void* p, int v, size_t n, hipStream_t) { memset(p, v, n); }
#else
#include <hip/hip_runtime.h>
#include <cstdio>
#include <cstdint>
#include <cstring>
#define LAUNCH(kern, grid, block, ...) hipLaunchKernelGGL(kern, dim3(grid), dim3(block), 0, stream, __VA_ARGS__)
#endif

typedef unsigned short bf16_t;

#ifndef CFG_DM
#define CFG_DM 2048
#define CFG_SEQ 4096
#define CFG_GRIDW 64
#define CFG_CTX 256
#define CFG_S5P 64
#define CFG_GHD 128
#define CFG_RCHUNK 128
#define CFG_MNOPE 128
#define CFG_MROPE 64
#define CFG_NE 16
#endif
constexpr int DM = CFG_DM, NB = 2, SEQ = CFG_SEQ, GRIDW = CFG_GRIDW, CTXL = CFG_CTX, NLAYER = 2;
constexpr int BW = DM / 4, S5CH = 16, S5G = BW / S5CH, S5P = CFG_S5P;
constexpr int GHD = CFG_GHD, GH = BW / GHD, GKV = GH / 2;
constexpr int RH = 4, RV = BW / RH, RQK = RV / 2;
constexpr int MQL = BW, MKVL = BW / 2, MH = 4, MNOPE = CFG_MNOPE, MROPE = CFG_MROPE, MV = BW / MH, MQK = MNOPE + MROPE;
constexpr int NE = CFG_NE, FF = DM / 2;
constexpr int NTOK = SEQ + CTXL, MROWS = NB * NTOK;
constexpr int OFF_U = 0, OFF_GQ = BW, OFF_GK = OFF_GQ + GH * GHD, OFF_GV = OFF_GK + GKV * GHD, OFF_RQ = OFF_GV + GKV * GHD, OFF_RK = OFF_RQ + RH * RQK,
              OFF_RV = OFF_RK + RH * RQK, OFF_RG = OFF_RV + RH * RV, OFF_CQ = OFF_RG + RH * RV, OFF_CKV = OFF_CQ + MQL, OFF_KR = OFF_CKV + MKVL, IN_TOTAL = OFF_KR + MROPE;
constexpr int PW = (IN_TOTAL + 255) / 256 * 256;
constexpr int CAP_L = 2 * SEQ / NE, CAP_C = 2 * CTXL / NE;
constexpr int XE = 2 * CAP_L + 2 * CAP_C, XEP = (XE + 255) / 256 * 256;
constexpr int XROWS = NE * XEP;
constexpr int NROPE_A = GHD / 4, NROPE_B = RQK / 4;
static_assert(MROPE / 4 == NROPE_B, "rope tables");
static_assert(MNOPE == MV, "kv split");
constexpr int S5LC = 16, S5NC = NTOK / S5LC, S5NN = NB * S5NC, S5NP = (S5NN + 255) / 256 * 256, S5K1 = S5LC * S5CH, S5K2 = 2 * S5P * 2;
constexpr int RCH = CFG_RCHUNK, RNC = NTOK / RCH;
constexpr float NORM_EPS = 1e-6f;
constexpr float DN_ALPHA = 1.4142135623730951f;

enum { I_X = 0, I_C, I_CTX, I_CCTX, I_ADAW, I_ADAB, I_WIN, I_S5AREF, I_S5AIMF, I_S5DTF, I_S5AREB, I_S5AIMB, I_S5DTB, I_S5BRE, I_S5BIM, I_S5CRE, I_S5CIM, I_S5D, I_S5GLU,
       I_GQN, I_GKN, I_RDF, I_RDB, I_RNORM, I_MQN, I_MKVN, I_WUQ, I_WUKV, I_WBR, I_WGATE, I_BGATE, I_WOUT, I_LN1G, I_LN1B, I_ROUTER, I_MOEG, I_MOEU, I_MOED, I_LN2G, I_LN2B, N_IN };

constexpr size_t al256(size_t x) { return (x + 255) / 256 * 256; }
struct WsLayout {
  size_t bar, mod, rope_a, rope_b, s5tab, wt_in, wt_gate, wt_br, wt_out, wt_glu, wt_uq, wt_ukv, wt_gu, wt_dn;
  size_t x1, x2, h1, h2, regA  , qm, km, vm, z, oall, macc  , merged, aff, slot, gatev, xsrc, retst, s5st, uh, s5e, s5sw, s5sv, rkv, rs, zrow, gctx, krp, yslab, end;
};
constexpr size_t SZ_P = (size_t)MROWS * PW * 2, SZ_PROJ = (size_t)MROWS * 4 * DM * 2;
constexpr size_t SZ_XS = (size_t)XROWS * DM * 2, SZ_ACT = (size_t)XROWS * FF * 2, SZ_YS = (size_t)XROWS * DM * 2;
constexpr size_t SZ_HS = (size_t)MROWS * S5G * S5P * 2 * 4;
constexpr size_t cmax(size_t a, size_t b) { return a > b ? a : b; }
constexpr WsLayout make_ws() {
  WsLayout w{}; size_t o = 0;
  w.bar = o; o += al256(16384);
  w.mod = o; o += al256((size_t)NLAYER * 3 * 6 * DM * 4);
  w.rope_a = o; o += al256((size_t)GRIDW * NROPE_A * 2 * 4);
  w.rope_b = o; o += al256((size_t)GRIDW * NROPE_B * 2 * 4);
  w.s5tab = o; o += al256((size_t)NLAYER * 2 * S5G * S5P * (2 + 2 * S5CH) * 4);
  w.wt_in = o; o += al256((size_t)NLAYER * PW * DM * 2);
  w.wt_gate = o; o += al256((size_t)NLAYER * 4 * DM * DM * 2);
  w.wt_br = o; o += al256((size_t)NLAYER * 4 * DM * BW * 2);
  w.wt_out = o; o += al256((size_t)NLAYER * DM * DM * 2);
  w.wt_glu = o; o += al256((size_t)NLAYER * BW * BW * 2);
  w.wt_uq = o; o += al256((size_t)NLAYER * MH * MQK * MQL * 2);
  w.wt_ukv = o; o += al256((size_t)NLAYER * MH * (MNOPE + MV) * MKVL * 2);
  w.wt_gu = o; o += al256((size_t)NLAYER * NE * 2 * FF * DM * 2);
  w.wt_dn = o; o += al256((size_t)NLAYER * NE * DM * FF * 2);
  w.x1 = o; o += al256((size_t)MROWS * DM * 4);
  w.x2 = o; o += al256((size_t)MROWS * DM * 4);
  w.h1 = o; o += al256((size_t)MROWS * DM * 2);
  w.h2 = o; o += al256((size_t)MROWS * DM * 2);
  w.regA = o; o += al256(cmax(cmax(SZ_P + SZ_PROJ, SZ_XS + SZ_ACT + SZ_YS), SZ_P + SZ_HS));
  w.qm = o; o += al256((size_t)MROWS * MH * MQK * 2);
  w.km = o; o += al256((size_t)MROWS * MH * MQK * 2);
  w.vm = o; o += al256((size_t)MROWS * MH * MV * 2);
  w.z = o; o += al256((size_t)MROWS * BW * 2);
  w.oall = o; o += al256((size_t)MROWS * DM * 2);
  w.macc = o; o += al256((size_t)MROWS * DM * 4);
  w.merged = o; o += al256((size_t)MROWS * DM * 2);
  w.aff = o; o += al256((size_t)MROWS * NE * 4);
  w.slot = o; o += al256((size_t)MROWS * NE * 4);
  w.gatev = o; o += al256((size_t)XROWS * 4);
  w.xsrc = o; o += al256((size_t)XROWS * 4);
  w.retst = o; o += al256((size_t)NB * RH * 2 * RQK * RV * 4);
  w.s5st = o; o += al256((size_t)NB * 2 * S5G * S5P * 2 * 4);
  w.uh = o; o += al256((size_t)S5G * S5NP * (S5K1 + S5K2) * 2);
  w.s5e = o; o += al256((size_t)S5G * S5NP * S5K2 * 4);
  w.s5sw = o; o += al256((size_t)NLAYER * S5G * S5K2 * S5K1 * 2);
  w.s5sv = o; o += al256((size_t)NLAYER * S5G * S5K1 * (S5K1 + S5K2) * 2);
  w.rkv = o; o += al256((size_t)NB * RH * 2 * RNC * RV * RQK * 4);
  w.rs = o; o += al256((size_t)NB * RH * 2 * RNC * RV * RQK * 2);
  w.zrow = o; o += al256((size_t)DM * 2);
  w.gctx = o; o += al256((size_t)NB * CTXL * 4 * DM * 2);
  w.krp = o; o += al256((size_t)2 * MROWS * MROPE * 4);
  w.yslab = o; o += al256((size_t)4 * NB * CTXL * DM * 4);
  w.end = o; return w;
}
constexpr WsLayout WS = make_ws();

struct Params {
  const float* in[N_IN];
  float* out;
  char* ws;
};

__host__ __device__ __forceinline__ float bf2f(bf16_t b) { union { unsigned u; float f; } c; c.u = ((unsigned)b) << 16; return c.f; }
__host__ __device__ __forceinline__ bf16_t f2bf(float f) { union { unsigned u; float f; } c; c.f = f; unsigned u = c.u; u += 0x7FFFu + ((u >> 16) & 1u); return (bf16_t)(u >> 16); }
__host__ __device__ __forceinline__ float sigmoidf_(float x) { return 1.f / (1.f + expf(-x)); }
__host__ __device__ __forceinline__ float siluf_(float x) { return x / (1.f + expf(-x)); }
__host__ __device__ __forceinline__ float gelu_tanh(float x) { return 0.5f * x * (1.f + tanhf(0.7978845608028654f * (x + 0.044715f * x * x * x))); }
__host__ __device__ __forceinline__ int row_b(int R) { return R / NTOK; }
__host__ __device__ __forceinline__ int row_t(int R) { return R % NTOK; }
__host__ __device__ __forceinline__ bool row_is_ctx(int R) { return (R % NTOK) >= SEQ; }
__host__ __device__ __forceinline__ int row_mod(int R) { return row_is_ctx(R) ? 2 : row_b(R); }
#ifndef CPU_TEST
__device__ __forceinline__ int ph_bid() { int b = blockIdx.x; asm volatile("" : "+s"(b)); return b; }
__device__ __forceinline__ int ph_tid() { int t = threadIdx.x; asm volatile("" : "+v"(t)); return t; }
#endif
#define GSTRIDE(i, n) for (long i = (long)blockIdx.x * blockDim.x + threadIdx.x; i < (long)(n); i += (long)gridDim.x * blockDim.x)
#define WSP(T, p, field) ((T*)((p).ws + WS.field))

__global__ void nk_conv_t(bf16_t* dst, const float* src, int K, int N, int ldsrc, int Ndst) {
  GSTRIDE(i, (long)Ndst * K) { int n = (int)(i / K), k = (int)(i % K); dst[i] = n < N ? f2bf(src[(long)k * ldsrc + n]) : (bf16_t)0; }
}
__global__ void nk_conv_gu(bf16_t* dst, const float* wg, const float* wu) {
  GSTRIDE(i, (long)2 * FF * DM) { int j = (int)(i / DM), k = (int)(i % DM); int tile = j / 256, r = j % 256, f = tile * 128 + (r & 127);
    const float* s = (r < 128) ? wg : wu; dst[i] = f2bf(s[(long)k * FF + f]); }
}
__global__ void nk_mod(Params p) {
  float* mod = WSP(float, p, mod);
  GSTRIDE(i, (long)NLAYER * 3 * 6 * DM) { int j = (int)(i % (6 * DM)), r = (int)((i / (6 * DM)) % 3), l = (int)(i / (18 * DM));
    const float* cv = (r < 2) ? p.in[I_C] + (long)r * DM : p.in[I_CCTX]; const float* w = p.in[I_ADAW] + (long)l * DM * 6 * DM;
    float acc = 0.f; for (int k = 0; k < DM; ++k) acc += siluf_(cv[k]) * w[(long)k * 6 * DM + j];
    mod[i] = acc + p.in[I_ADAB][(long)l * 6 * DM + j]; }
}
__global__ void nk_rope_tab(Params p) {
  float* ta = WSP(float, p, rope_a); float* tb = WSP(float, p, rope_b);
  GSTRIDE(i, (long)GRIDW * (NROPE_A + NROPE_B)) { int pos = (int)(i / (NROPE_A + NROPE_B)), k = (int)(i % (NROPE_A + NROPE_B));
    if (k < NROPE_A) { float inv = powf(10000.f, -(float)k / NROPE_A), a = pos * inv; ta[(pos * NROPE_A + k) * 2] = cosf(a); ta[(pos * NROPE_A + k) * 2 + 1] = sinf(a); }
    else { int kk = k - NROPE_A; float inv = powf(10000.f, -(float)kk / NROPE_B), a = pos * inv; tb[(pos * NROPE_B + kk) * 2] = cosf(a); tb[(pos * NROPE_B + kk) * 2 + 1] = sinf(a); } }
}
constexpr int S5TW = 2 + 2 * S5CH;
__global__ void nk_s5tab(Params p) {
  float* tab = WSP(float, p, s5tab);
  GSTRIDE(i, (long)NLAYER * 2 * S5G * S5P) { int pp = (int)(i % S5P), g = (int)((i / S5P) % S5G), dir = (int)((i / (S5P * S5G)) % 2), l = (int)(i / (2 * S5P * S5G));
    const float a_re = p.in[dir ? I_S5AREB : I_S5AREF][(l * S5G + g) * S5P + pp], a_im = p.in[dir ? I_S5AIMB : I_S5AIMF][(l * S5G + g) * S5P + pp];
    const float dt = expf(p.in[dir ? I_S5DTB : I_S5DTF][l * S5G + g]);
    const float mag = expf(a_re * dt), ab_re = mag * cosf(a_im * dt), ab_im = mag * sinf(a_im * dt);
    const float den = a_re * a_re + a_im * a_im, nr = ab_re - 1.f, ni = ab_im;
    const float cr = (nr * a_re + ni * a_im) / den, ci = (ni * a_re - nr * a_im) / den;
    float* t = tab + i * S5TW; t[0] = ab_re; t[1] = ab_im;
    for (int c = 0; c < S5CH; ++c) { const float br = p.in[I_S5BRE][((l * S5G + g) * S5P + pp) * S5CH + c], bi = p.in[I_S5BIM][((l * S5G + g) * S5P + pp) * S5CH + c];
      t[2 + c] = cr * br - ci * bi; t[2 + S5CH + c] = cr * bi + ci * br; } }
}
__global__ void nk_load_x(Params p) {
  float* X2 = WSP(float, p, x2);
  GSTRIDE(i, (long)MROWS * DM) { int R = (int)(i / DM), d = (int)(i % DM), b = row_b(R), t = row_t(R);
    X2[i] = t < SEQ ? p.in[I_X][((long)b * SEQ + t) * DM + d] : p.in[I_CTX][((long)b * CTXL + (t - SEQ)) * DM + d]; }
}
__global__ void nk_ln_mod(Params p, bf16_t* H, const float* X, int l, int ch_sh, int ch_sc) {
  const float* mod = WSP(float, p, mod) + (long)l * 3 * 6 * DM;
  GSTRIDE(R, MROWS) { const float* x = X + R * DM; float s = 0.f; for (int d = 0; d < DM; ++d) s += x[d]; const float mean = s / DM;
    float v = 0.f; for (int d = 0; d < DM; ++d) { float c = x[d] - mean; v += c * c; } const float rs = 1.f / sqrtf(v / DM + NORM_EPS);
    const float* m = mod + (long)row_mod((int)R) * 6 * DM;
    for (int d = 0; d < DM; ++d) H[R * DM + d] = f2bf((x[d] - mean) * rs * (1.f + m[ch_sc * DM + d]) + m[ch_sh * DM + d]); }
}
template <class Epi> __global__ void nk_gemm(const bf16_t* A, long lda, const bf16_t* Bt, long ldb, int M, int N, int K, Epi epi) {
  GSTRIDE(i, (long)M * (N / 4)) { int m = (int)(i / (N / 4)), n = (int)(i % (N / 4)) * 4; float a0 = 0.f, a1 = 0.f, a2 = 0.f, a3 = 0.f;
    const bf16_t* ar = A + (long)m * lda; const bf16_t* b0 = Bt + (long)n * ldb;
    for (int k = 0; k < K; ++k) { const float a = bf2f(ar[k]); a0 += a * bf2f(b0[k]); a1 += a * bf2f(b0[ldb + k]); a2 += a * bf2f(b0[2 * ldb + k]); a3 += a * bf2f(b0[3 * ldb + k]); }
    epi(m, n, a0, a1, a2, a3); }
}
struct EpStoreBf16 { bf16_t* C; long ldc; __host__ __device__ void operator()(int m, int n, float a0, float a1, float a2, float a3) const {
  bf16_t* c = C + (long)m * ldc + n; c[0] = f2bf(a0); c[1] = f2bf(a1); c[2] = f2bf(a2); c[3] = f2bf(a3); } };
struct EpStoreF32 { float* C; long ldc; __host__ __device__ void operator()(int m, int n, float a0, float a1, float a2, float a3) const {
  float* c = C + (long)m * ldc + n; c[0] = a0; c[1] = a1; c[2] = a2; c[3] = a3; } };
struct EpKV { bf16_t* KM; bf16_t* VM; __host__ __device__ void operator()(int m, int n, float a0, float a1, float a2, float a3) const {
  const int h = n / (MNOPE + MV), r = n % (MNOPE + MV);
  bf16_t* c = (r < MNOPE) ? KM + (long)m * MH * MQK + h * MQK + r : VM + (long)m * MH * MV + h * MV + (r - MNOPE);
  c[0] = f2bf(a0); c[1] = f2bf(a1); c[2] = f2bf(a2); c[3] = f2bf(a3); } };
struct EpGlu { const bf16_t* Z; bf16_t* O; __host__ __device__ void operator()(int m, int n, float a0, float a1, float a2, float a3) const {
  const bf16_t* z = Z + (long)m * BW + n; bf16_t* o = O + (long)m * DM + n;
  o[0] = f2bf(bf2f(z[0]) * sigmoidf_(a0)); o[1] = f2bf(bf2f(z[1]) * sigmoidf_(a1)); o[2] = f2bf(bf2f(z[2]) * sigmoidf_(a2)); o[3] = f2bf(bf2f(z[3]) * sigmoidf_(a3)); } };
struct EpDown { const float* gate; bf16_t* Y; __host__ __device__ void operator()(int m, int n, float a0, float a1, float a2, float a3) const {
  const float g = gate[m]; bf16_t* y = Y + (long)m * DM + n; y[0] = f2bf(a0 * g); y[1] = f2bf(a1 * g); y[2] = f2bf(a2 * g); y[3] = f2bf(a3 * g); } };

__device__ __forceinline__ void rope_pair(bf16_t* x, int i1, int i2, float sc1, float sc2, bool rot, const float* cs) {
  const float c = rot ? cs[0] : 1.f, s = rot ? cs[1] : 0.f; const float a = bf2f(x[i1]) * sc1, b = bf2f(x[i2]) * sc2; x[i1] = f2bf(a * c - b * s); x[i2] = f2bf(a * s + b * c);
}
__global__ void nk_post_proj(Params p, int l) {
  bf16_t* P = WSP(bf16_t, p, regA); const float* ta = WSP(float, p, rope_a); const float* tb = WSP(float, p, rope_b);
  constexpr int NJ = GH + GKV + 2 * RH + 3;
  GSTRIDE(i, (long)MROWS * NJ) { const int R = (int)(i / NJ), j = (int)(i % NJ), t = row_t(R); const bool lat = t < SEQ; const int gr = lat ? t / GRIDW : 0, gc = lat ? t % GRIDW : 0;
    bf16_t* pr = P + (long)R * PW;
    if (j < GH + GKV) {
      bf16_t* x = pr + (j < GH ? OFF_GQ + j * GHD : OFF_GK + (j - GH) * GHD); const float* g = p.in[j < GH ? I_GQN : I_GKN] + l * GHD;
      float ss = 0.f; for (int d = 0; d < GHD; ++d) { float v = bf2f(x[d]); ss += v * v; } const float r = 1.f / sqrtf(ss / GHD + NORM_EPS);
      for (int hf = 0; hf < 2; ++hf) for (int k = 0; k < NROPE_A; ++k) { const int i1 = hf * 2 * NROPE_A + k, i2 = i1 + NROPE_A;
        rope_pair(x, i1, i2, r * g[i1], r * g[i2], lat, ta + ((hf ? gc : gr) * NROPE_A + k) * 2); }
    } else if (j < GH + GKV + 2 * RH) {
      const int jj = j - GH - GKV; const bool isk = jj >= RH; bf16_t* x = pr + (isk ? OFF_RK + (jj - RH) * RQK : OFF_RQ + jj * RQK); const float sc = isk ? 1.f / sqrtf((float)RQK) : 1.f;
      for (int hf = 0; hf < 2; ++hf) for (int k = 0; k < NROPE_B; ++k) { const int i1 = hf * 2 * NROPE_B + k, i2 = i1 + NROPE_B;
        rope_pair(x, i1, i2, sc, sc, lat, tb + ((hf ? gc : gr) * NROPE_B + k) * 2); }
    } else if (j == GH + GKV + 2 * RH) {
      bf16_t* x = pr + OFF_CQ; const float* g = p.in[I_MQN] + l * MQL; float ss = 0.f; for (int d = 0; d < MQL; ++d) { float v = bf2f(x[d]); ss += v * v; }
      const float r = 1.f / sqrtf(ss / MQL + NORM_EPS); for (int d = 0; d < MQL; ++d) x[d] = f2bf(bf2f(x[d]) * r * g[d]);
    } else if (j == GH + GKV + 2 * RH + 1) {
      bf16_t* x = pr + OFF_CKV; const float* g = p.in[I_MKVN] + l * MKVL; float ss = 0.f; for (int d = 0; d < MKVL; ++d) { float v = bf2f(x[d]); ss += v * v; }
      const float r = 1.f / sqrtf(ss / MKVL + NORM_EPS); for (int d = 0; d < MKVL; ++d) x[d] = f2bf(bf2f(x[d]) * r * g[d]);
    } else if (lat) {
      bf16_t* x = pr + OFF_KR;
      for (int hf = 0; hf < 2; ++hf) for (int k = 0; k < NROPE_B; ++k) { const int i1 = hf * 2 * NROPE_B + k, i2 = i1 + NROPE_B; rope_pair(x, i1, i2, 1.f, 1.f, true, tb + ((hf ? gc : gr) * NROPE_B + k) * 2); }
    } }
}
__global__ void nk_post_mla(Params p) {
  bf16_t* P = WSP(bf16_t, p, regA); bf16_t* QM = WSP(bf16_t, p, qm); bf16_t* KM = WSP(bf16_t, p, km); const float* tb = WSP(float, p, rope_b);
  GSTRIDE(i, (long)MROWS * MH) { const int R = (int)(i / MH), h = (int)(i % MH), t = row_t(R); const bool lat = t < SEQ;
    if (lat) { const int gr = t / GRIDW, gc = t % GRIDW; bf16_t* x = QM + (long)R * MH * MQK + h * MQK + MNOPE;
      for (int hf = 0; hf < 2; ++hf) for (int k = 0; k < NROPE_B; ++k) { const int i1 = hf * 2 * NROPE_B + k, i2 = i1 + NROPE_B; rope_pair(x, i1, i2, 1.f, 1.f, true, tb + ((hf ? gc : gr) * NROPE_B + k) * 2); } }
    for (int d = 0; d < MROPE; ++d) KM[(long)R * MH * MQK + h * MQK + MNOPE + d] = P[(long)R * PW + OFF_KR + d]; }
}
__global__ void nk_post_mla_q(Params p) {
  bf16_t* QM = WSP(bf16_t, p, qm); const float* tb = WSP(float, p, rope_b);
  GSTRIDE(i, (long)MROWS * MH) { const int R = (int)(i / MH), h = (int)(i % MH), t = row_t(R); const bool lat = t < SEQ;
    if (lat) { const int gr = t / GRIDW, gc = t % GRIDW; bf16_t* x = QM + (long)R * MH * MQK + h * MQK + MNOPE;
      for (int hf = 0; hf < 2; ++hf) for (int k = 0; k < NROPE_B; ++k) { const int i1 = hf * 2 * NROPE_B + k, i2 = i1 + NROPE_B; rope_pair(x, i1, i2, 1.f, 1.f, true, tb + ((hf ? gc : gr) * NROPE_B + k) * 2); } } }
}
__global__ void nk_s5_scan(Params p, int l) {
  const bf16_t* P = WSP(bf16_t, p, regA); float* HS = (float*)(p.ws + WS.regA + SZ_P); const float* tab = WSP(float, p, s5tab);
  GSTRIDE(i, (long)NB * S5G * S5P) { const int pp = (int)(i % S5P), g = (int)((i / S5P) % S5G), b = (int)(i / (S5P * S5G));
    for (int dir = 0; dir < 2; ++dir) { const float* t = tab + ((((long)l * 2 + dir) * S5G + g) * S5P + pp) * S5TW; const float are = t[0], aim = t[1]; float hr = 0.f, hi = 0.f;
      for (int s = 0; s < NTOK; ++s) {
        int tt; if (!dir) tt = s < CTXL ? SEQ + s : s - CTXL; else tt = s < CTXL ? SEQ + (CTXL - 1 - s) : SEQ - 1 - (s - CTXL);
        const long R = (long)b * NTOK + tt; const bf16_t* u = P + R * PW + OFF_U + g * S5CH; float br = 0.f, bi = 0.f;
        for (int c = 0; c < S5CH; ++c) { const float uv = bf2f(u[c]); br += uv * t[2 + c]; bi += uv * t[2 + S5CH + c]; }
        const float nr = are * hr - aim * hi + br, ni = are * hi + aim * hr + bi; hr = nr; hi = ni;
        float* hs = HS + ((R * S5G + g) * S5P + pp) * 2; if (!dir) { hs[0] = hr; hs[1] = hi; } else { hs[0] += hr; hs[1] += hi; } } } }
}
__global__ void nk_s5_read(Params p, int l) {
  const bf16_t* P = WSP(bf16_t, p, regA); const float* HS = (const float*)(p.ws + WS.regA + SZ_P); bf16_t* Z = WSP(bf16_t, p, z);
  GSTRIDE(i, (long)MROWS * BW) { const long R = i / BW; const int c = (int)(i % BW), g = c / S5CH, ci = c % S5CH;
    const float* hs = HS + (R * S5G + g) * S5P * 2; const float* cre = p.in[I_S5CRE] + (((long)l * S5G + g) * S5CH + ci) * S5P; const float* cim = p.in[I_S5CIM] + (((long)l * S5G + g) * S5CH + ci) * S5P;
    float y = 0.f; for (int pp = 0; pp < S5P; ++pp) y += hs[2 * pp] * cre[pp] - hs[2 * pp + 1] * cim[pp];
    y += p.in[I_S5D][l * BW + c] * bf2f(P[R * PW + OFF_U + c]); Z[i] = f2bf(gelu_tanh(y)); }
}
template <int DQK, int DV> __global__ void __launch_bounds__(256) nk_attn(const bf16_t* Q, const bf16_t* K, const bf16_t* V, bf16_t* O, int ldq, int ldk, int ldv, int ldo, int H, int group, float scale) {
  GSTRIDE(i, (long)MROWS * H) { const int R = (int)(i / H), h = (int)(i % H), b = row_b(R), kh = h / group; const bool lat = !row_is_ctx(R);
    const bf16_t* q = Q + (long)R * ldq + h * DQK; float o[DV]; _Pragma("unroll") for (int d = 0; d < DV; ++d) o[d] = 0.f; float m = -1e30f, lsum = 0.f;
    for (int kk = lat ? 0 : SEQ; kk < NTOK; ++kk) { const long KR = (long)b * NTOK + kk; const bf16_t* kp = K + KR * ldk + kh * DQK; float s = 0.f;
      for (int d = 0; d < DQK; ++d) s += bf2f(q[d]) * bf2f(kp[d]); s *= scale;
      if (s > m) { const float corr = expf(m - s); lsum *= corr; _Pragma("unroll") for (int d = 0; d < DV; ++d) o[d] *= corr; m = s; }
      const float pw = expf(s - m); lsum += pw; const bf16_t* vp = V + KR * ldv + kh * DV; _Pragma("unroll") for (int d = 0; d < DV; ++d) o[d] += pw * bf2f(vp[d]); }
    const float inv = 1.f / lsum; _Pragma("unroll") for (int d = 0; d < DV; ++d) O[(long)R * ldo + h * DV + d] = f2bf(o[d] * inv); }
}
__global__ void __launch_bounds__(256) nk_ret(Params p, int l) {
  const bf16_t* P = WSP(bf16_t, p, regA); bf16_t* O = WSP(bf16_t, p, oall);
  GSTRIDE(i, (long)MROWS * RH) { const int R = (int)(i / RH), h = (int)(i % RH), b = row_b(R), t = row_t(R); const bool lat = t < SEQ;
    const float lgf = -expf(p.in[I_RDF][l * RH + h]), lgb = -expf(p.in[I_RDB][l * RH + h]);
    const bf16_t* q = P + (long)R * PW + OFF_RQ + h * RQK; float o[RV]; _Pragma("unroll") for (int d = 0; d < RV; ++d) o[d] = 0.f;
    for (int kk = lat ? 0 : SEQ; kk < NTOK; ++kk) { float w;
      if (lat) { if (kk < SEQ) w = kk <= t ? expf(lgf * (float)(t - kk)) : expf(lgb * (float)(kk - t)); else { const int j = kk - SEQ; w = expf(lgf * (float)(t + CTXL - j)) + expf(lgb * (float)(SEQ - t + j)); } }
      else { const int j = t - SEQ, j2 = kk - SEQ; w = j2 <= j ? expf(lgf * (float)(j - j2)) : expf(lgb * (float)(j2 - j)); }
      const long KR = (long)b * NTOK + kk; const bf16_t* kp = P + KR * PW + OFF_RK + h * RQK; float s = 0.f; for (int d = 0; d < RQK; ++d) s += bf2f(q[d]) * bf2f(kp[d]); s *= w;
      const bf16_t* vp = P + KR * PW + OFF_RV + h * RV; _Pragma("unroll") for (int d = 0; d < RV; ++d) o[d] += s * bf2f(vp[d]); }
    float mean = 0.f; _Pragma("unroll") for (int d = 0; d < RV; ++d) mean += o[d]; mean /= RV; float var = 0.f; _Pragma("unroll") for (int d = 0; d < RV; ++d) { const float c = o[d] - mean; var += c * c; }
    const float rs = 1.f / sqrtf(var / RV + NORM_EPS); const bf16_t* gp = P + (long)R * PW + OFF_RG + h * RV; const float* gain = p.in[I_RNORM] + l * BW + h * RV;
    _Pragma("unroll") for (int d = 0; d < RV; ++d) O[(long)R * DM + 2 * BW + h * RV + d] = f2bf((o[d] - mean) * rs * gain[d] * siluf_(bf2f(gp[d]))); }
}
__global__ void nk_gate_merge(Params p, int l) {
  const bf16_t* H = WSP(bf16_t, p, h1); const bf16_t* Wg = WSP(bf16_t, p, wt_gate) + (long)l * 4 * DM * DM; const bf16_t* PROJ = (const bf16_t*)(p.ws + WS.regA + SZ_P); bf16_t* MG = WSP(bf16_t, p, merged);
  const float* bg = p.in[I_BGATE] + (long)l * 4 * DM;
  GSTRIDE(i, (long)MROWS * DM) { const long R = i / DM; const int d = (int)(i % DM); const bf16_t* hr = H + R * DM; float acc = 0.f;
    for (int k = 0; k < 4; ++k) { const bf16_t* w = Wg + ((long)k * DM + d) * DM; float s = 0.f; for (int c = 0; c < DM; ++c) s += bf2f(hr[c]) * bf2f(w[c]);
      acc += sigmoidf_(s + bg[k * DM + d]) * bf2f(PROJ[R * 4 * DM + k * DM + d]); }
    MG[i] = f2bf(acc); }
}
__global__ void nk_ln1(Params p, int l) {
  const float* X2 = WSP(float, p, x2); const float* Y = WSP(float, p, macc); float* X1 = WSP(float, p, x1); bf16_t* H2 = WSP(bf16_t, p, h2); float* AFF = WSP(float, p, aff);
  const float* mod = WSP(float, p, mod) + (long)l * 3 * 6 * DM; const float* lg = p.in[I_LN1G] + l * DM; const float* lb = p.in[I_LN1B] + l * DM; const float* rw = p.in[I_ROUTER] + (long)l * DM * NE;
  GSTRIDE(R, MROWS) { const float* m = mod + (long)row_mod((int)R) * 6 * DM; const float* x = X2 + R * DM; const float* y = Y + R * DM; float* x1 = X1 + R * DM;
    float s = 0.f; for (int d = 0; d < DM; ++d) { const float v = DN_ALPHA * x[d] + m[2 * DM + d] * y[d]; x1[d] = v; s += v; } float mean = s / DM;
    float var = 0.f; for (int d = 0; d < DM; ++d) { const float c = x1[d] - mean; var += c * c; } float rs = 1.f / sqrtf(var / DM + NORM_EPS);
    s = 0.f; for (int d = 0; d < DM; ++d) { const float v = (x1[d] - mean) * rs * lg[d] + lb[d]; x1[d] = v; s += v; } mean = s / DM;
    var = 0.f; for (int d = 0; d < DM; ++d) { const float c = x1[d] - mean; var += c * c; } rs = 1.f / sqrtf(var / DM + NORM_EPS);
    float lo[NE]; _Pragma("unroll") for (int e = 0; e < NE; ++e) lo[e] = 0.f;
    for (int d = 0; d < DM; ++d) { const float hv = (x1[d] - mean) * rs * (1.f + m[4 * DM + d]) + m[3 * DM + d]; H2[R * DM + d] = f2bf(hv); _Pragma("unroll") for (int e = 0; e < NE; ++e) lo[e] += hv * rw[(long)d * NE + e]; }
    float mx = lo[0]; _Pragma("unroll") for (int e = 1; e < NE; ++e) mx = fmaxf(mx, lo[e]); float se = 0.f; _Pragma("unroll") for (int e = 0; e < NE; ++e) { lo[e] = expf(lo[e] - mx); se += lo[e]; }
    _Pragma("unroll") for (int e = 0; e < NE; ++e) AFF[R * NE + e] = lo[e] / se; }
}
__global__ void nk_topk(Params p, int with_ctx) {
  const float* AFF = WSP(float, p, aff); int* SLOT = WSP(int, p, slot); float* GV = WSP(float, p, gatev); int* XSRC = WSP(int, p, xsrc);
  GSTRIDE(i, (long)MROWS * NE) { const int R = (int)(i / NE), e = (int)(i % NE), b = row_b(R), t = row_t(R); const bool lat = t < SEQ;
    if (!lat && !with_ctx) { SLOT[i] = -1; continue; }
    const int k0 = lat ? 0 : SEQ, k1 = lat ? SEQ : NTOK, cap = lat ? CAP_L : CAP_C; const float a = AFF[i]; int rank = 0;
    for (int kk = k0; kk < k1; ++kk) { const float o = AFF[((long)b * NTOK + kk) * NE + e]; rank += (o > a || (o == a && kk < t)) ? 1 : 0; }
    if (rank < cap) { const int xr = e * XEP + (lat ? b * CAP_L : 2 * CAP_L + b * CAP_C) + rank; SLOT[i] = xr; GV[xr] = a; XSRC[xr] = R; } else SLOT[i] = -1; }
}
__global__ void nk_gather(Params p) {
  const int* XSRC = WSP(int, p, xsrc); const bf16_t* H2 = WSP(bf16_t, p, h2); bf16_t* XS = WSP(bf16_t, p, regA);
  GSTRIDE(i, (long)XROWS * DM) { const long xr = i / DM; const int d = (int)(i % DM), src = XSRC[xr]; XS[i] = src >= 0 ? H2[(long)src * DM + d] : (bf16_t)0; }
}
__global__ void nk_moe_up(Params p, int l) {
  const bf16_t* XS = WSP(bf16_t, p, regA); bf16_t* ACT = (bf16_t*)(p.ws + WS.regA + SZ_XS); const bf16_t* W = WSP(bf16_t, p, wt_gu) + (long)l * NE * 2 * FF * DM; const int* XSRC = WSP(int, p, xsrc);
  GSTRIDE(i, (long)XROWS * FF) { const long xr = i / FF; const int f = (int)(i % FF), e = (int)(xr / XEP); if (XSRC[xr] < 0) { ACT[i] = 0; continue; }
    const int jg = (f / 128) * 256 + (f % 128), ju = jg + 128; const bf16_t* x = XS + xr * DM; const bf16_t* wg = W + ((long)e * 2 * FF + jg) * DM; const bf16_t* wu = W + ((long)e * 2 * FF + ju) * DM;
    float a = 0.f, u = 0.f; for (int k = 0; k < DM; ++k) { const float xv = bf2f(x[k]); a += xv * bf2f(wg[k]); u += xv * bf2f(wu[k]); }
    ACT[i] = f2bf(siluf_(a) * u); }
}
__global__ void nk_ln2(Params p, int l, int last) {
  const float* X1 = WSP(float, p, x1); float* X2 = WSP(float, p, x2); const int* SLOT = WSP(int, p, slot); const bf16_t* YS = (const bf16_t*)(p.ws + WS.regA + SZ_XS + SZ_ACT);
  const float* mod = WSP(float, p, mod) + (long)l * 3 * 6 * DM; const float* lg = p.in[I_LN2G] + l * DM; const float* lb = p.in[I_LN2B] + l * DM;
  GSTRIDE(R, MROWS) { if (last && row_is_ctx((int)R)) continue; const float* m = mod + (long)row_mod((int)R) * 6 * DM; const float* x1 = X1 + R * DM; float* x2 = X2 + R * DM;
    float s = 0.f; for (int d = 0; d < DM; ++d) { float mo = 0.f; for (int e = 0; e < NE; ++e) { const int sl = SLOT[R * NE + e]; if (sl >= 0) mo += bf2f(YS[(long)sl * DM + d]); }
      const float v = DN_ALPHA * x1[d] + m[5 * DM + d] * mo; x2[d] = v; s += v; } const float mean = s / DM;
    float var = 0.f; for (int d = 0; d < DM; ++d) { const float c = x2[d] - mean; var += c * c; } const float rs = 1.f / sqrtf(var / DM + NORM_EPS);
    for (int d = 0; d < DM; ++d) { const float v = (x2[d] - mean) * rs * lg[d] + lb[d]; x2[d] = v; if (last) p.out[((long)row_b((int)R) * SEQ + row_t((int)R)) * DM + d] = v; } }
}
#ifdef CPU_TEST
void cpu_hook(const char* name, int l, Params& p);
#define HOOK(name) cpu_hook(name, l, p)
#else
#define HOOK(name)
#endif
#define NG(n) (int)((((long)(n)) + 255) / 256 < 65536 ? (((long)(n)) + 255) / 256 : 65536)

static void naive_prologue(Params& p, hipStream_t stream) {
  for (int l = 0; l < NLAYER; ++l) {
    LAUNCH(nk_conv_t, NG((long)PW * DM), 256, WSP(bf16_t, p, wt_in) + (long)l * PW * DM, p.in[I_WIN] + (long)l * DM * IN_TOTAL, DM, IN_TOTAL, IN_TOTAL, PW);
    LAUNCH(nk_conv_t, NG((long)4 * DM * DM), 256, WSP(bf16_t, p, wt_gate) + (long)l * 4 * DM * DM, p.in[I_WGATE] + (long)l * DM * 4 * DM, DM, 4 * DM, 4 * DM, 4 * DM);
    for (int k = 0; k < 4; ++k)
      LAUNCH(nk_conv_t, NG((long)DM * BW), 256, WSP(bf16_t, p, wt_br) + ((long)l * 4 + k) * DM * BW, p.in[I_WBR] + ((long)l * 4 + k) * BW * DM, BW, DM, DM, DM);
    LAUNCH(nk_conv_t, NG((long)DM * DM), 256, WSP(bf16_t, p, wt_out) + (long)l * DM * DM, p.in[I_WOUT] + (long)l * DM * DM, DM, DM, DM, DM);
    LAUNCH(nk_conv_t, NG((long)BW * BW), 256, WSP(bf16_t, p, wt_glu) + (long)l * BW * BW, p.in[I_S5GLU] + (long)l * BW * BW, BW, BW, BW, BW);
    LAUNCH(nk_conv_t, NG((long)MH * MQK * MQL), 256, WSP(bf16_t, p, wt_uq) + (long)l * MH * MQK * MQL, p.in[I_WUQ] + (long)l * MQL * MH * MQK, MQL, MH * MQK, MH * MQK, MH * MQK);
    LAUNCH(nk_conv_t, NG((long)MH * (MNOPE + MV) * MKVL), 256, WSP(bf16_t, p, wt_ukv) + (long)l * MH * (MNOPE + MV) * MKVL, p.in[I_WUKV] + (long)l * MKVL * MH * (MNOPE + MV), MKVL, MH * (MNOPE + MV), MH * (MNOPE + MV), MH * (MNOPE + MV));
    for (int e = 0; e < NE; ++e) {
      LAUNCH(nk_conv_gu, NG((long)2 * FF * DM), 256, WSP(bf16_t, p, wt_gu) + ((long)l * NE + e) * 2 * FF * DM, p.in[I_MOEG] + ((long)l * NE + e) * DM * FF, p.in[I_MOEU] + ((long)l * NE + e) * DM * FF);
      LAUNCH(nk_conv_t, NG((long)DM * FF), 256, WSP(bf16_t, p, wt_dn) + ((long)l * NE + e) * DM * FF, p.in[I_MOED] + ((long)l * NE + e) * FF * DM, FF, DM, DM, DM);
    }
  }
  LAUNCH(nk_mod, NG((long)NLAYER * 18 * DM), 256, p);
  LAUNCH(nk_rope_tab, 4, 256, p);
  LAUNCH(nk_s5tab, NG((long)NLAYER * 2 * S5G * S5P), 256, p);
  LAUNCH(nk_load_x, NG((long)MROWS * DM), 256, p);
}

#ifdef CPU_TEST
static void naive_layer(Params& p, int l, hipStream_t stream) {
  bf16_t* P = WSP(bf16_t, p, regA); bf16_t* PROJ = (bf16_t*)(p.ws + WS.regA + SZ_P); bf16_t* H1 = WSP(bf16_t, p, h1);
  bf16_t* QM = WSP(bf16_t, p, qm); bf16_t* KM = WSP(bf16_t, p, km); bf16_t* VM = WSP(bf16_t, p, vm); bf16_t* Z = WSP(bf16_t, p, z); bf16_t* OA = WSP(bf16_t, p, oall);
  LAUNCH(nk_ln_mod, NG(MROWS), 256, p, H1, (const float*)WSP(float, p, x2), l, 0, 1);
  HOOK("h");
  LAUNCH(nk_gemm<EpStoreBf16>, NG((long)MROWS * PW / 4), 256, (const bf16_t*)H1, (long)DM, (const bf16_t*)(WSP(bf16_t, p, wt_in) + (long)l * PW * DM), (long)DM, MROWS, PW, DM, EpStoreBf16{P, PW});
  LAUNCH(nk_post_proj, NG((long)MROWS * 17), 256, p, l);
  LAUNCH(nk_gemm<EpStoreBf16>, NG((long)MROWS * MH * MQK / 4), 256, (const bf16_t*)(P + OFF_CQ), (long)PW, (const bf16_t*)(WSP(bf16_t, p, wt_uq) + (long)l * MH * MQK * MQL), (long)MQL, MROWS, MH * MQK, MQL, EpStoreBf16{QM, MH * MQK});
  LAUNCH(nk_gemm<EpKV>, NG((long)MROWS * MH * (MNOPE + MV) / 4), 256, (const bf16_t*)(P + OFF_CKV), (long)PW, (const bf16_t*)(WSP(bf16_t, p, wt_ukv) + (long)l * MH * (MNOPE + MV) * MKVL), (long)MKVL, MROWS, MH * (MNOPE + MV), MKVL, EpKV{KM, VM});
  LAUNCH(nk_post_mla, NG((long)MROWS * MH), 256, p);
  LAUNCH(nk_s5_scan, NG((long)NB * S5G * S5P), 256, p, l);
  LAUNCH(nk_s5_read, NG((long)MROWS * BW), 256, p, l);
  LAUNCH(nk_gemm<EpGlu>, NG((long)MROWS * BW / 4), 256, (const bf16_t*)Z, (long)BW, (const bf16_t*)(WSP(bf16_t, p, wt_glu) + (long)l * BW * BW), (long)BW, MROWS, BW, BW, EpGlu{Z, OA});
  HOOK("o_s5");
  LAUNCH((nk_attn<GHD, GHD>), NG((long)MROWS * GH), 256, (const bf16_t*)(P + OFF_GQ), (const bf16_t*)(P + OFF_GK), (const bf16_t*)(P + OFF_GV), OA + BW, PW, PW, PW, DM, GH, GH / GKV, 1.f / sqrtf((float)GHD));
  HOOK("o_gqa");
  LAUNCH(nk_ret, NG((long)MROWS * RH), 256, p, l);
  HOOK("o_ret");
  LAUNCH((nk_attn<MQK, MV>), NG((long)MROWS * MH), 256, (const bf16_t*)QM, (const bf16_t*)KM, (const bf16_t*)VM, OA + 3 * BW, MH * MQK, MH * MQK, MH * MV, DM, MH, 1, 1.f / sqrtf((float)MQK));
  HOOK("o_mla");
  for (int k = 0; k < 4; ++k)
    LAUNCH(nk_gemm<EpStoreBf16>, NG((long)MROWS * DM / 4), 256, (const bf16_t*)(OA + k * BW), (long)DM, (const bf16_t*)(WSP(bf16_t, p, wt_br) + ((long)l * 4 + k) * DM * BW), (long)BW, MROWS, DM, BW, EpStoreBf16{PROJ + (long)k * DM, 4 * DM});
  LAUNCH(nk_gate_merge, NG((long)MROWS * DM), 256, p, l);
  LAUNCH(nk_gemm<EpStoreF32>, NG((long)MROWS * DM / 4), 256, (const bf16_t*)WSP(bf16_t, p, merged), (long)DM, (const bf16_t*)(WSP(bf16_t, p, wt_out) + (long)l * DM * DM), (long)DM, MROWS, DM, DM, EpStoreF32{WSP(float, p, macc), DM});
  HOOK("y");
  LAUNCH(nk_ln1, NG(MROWS), 256, p, l);
  HOOK("x1");
  hipMemsetAsync(p.ws + WS.xsrc, 0xFF, (size_t)XROWS * 4, stream);
  LAUNCH(nk_topk, NG((long)MROWS * NE), 256, p, l == 0 ? 1 : 0);
  LAUNCH(nk_gather, NG((long)XROWS * DM), 256, p);
  LAUNCH(nk_moe_up, NG((long)XROWS * FF), 256, p, l);
  bf16_t* ACT = (bf16_t*)(p.ws + WS.regA + SZ_XS); bf16_t* YS = (bf16_t*)(p.ws + WS.regA + SZ_XS + SZ_ACT);
  for (int e = 0; e < NE; ++e)
    LAUNCH(nk_gemm<EpDown>, NG((long)XEP * DM / 4), 256, (const bf16_t*)(ACT + (long)e * XEP * FF), (long)FF, (const bf16_t*)(WSP(bf16_t, p, wt_dn) + ((long)l * NE + e) * DM * FF), (long)FF, XEP, DM, FF,
           EpDown{WSP(float, p, gatev) + e * XEP, YS + (long)e * XEP * DM});
  LAUNCH(nk_ln2, NG(MROWS), 256, p, l, l == NLAYER - 1 ? 1 : 0);
  HOOK("x2");
}
#endif
#ifndef CPU_TEST
#ifndef PG8_SP2
#define PG8_SP2 true
#endif
namespace pg8 {
#define PG8_LAS __attribute__((address_space(3)))
typedef short bf16x8 __attribute__((ext_vector_type(8)));
typedef float f32x4 __attribute__((ext_vector_type(4)));
typedef unsigned u32x4 __attribute__((ext_vector_type(4)));
constexpr int BM = 256, BK = 64, HALF = 128, HTB = HALF * BK * 2, STAGE_BYTES = 8 * HTB, NXCD = 8, WGM = 8;
__host__ __device__ __forceinline__ int lds_byte(int r, int c) { const int st = (r >> 4) * 2 + (c >> 5), rr = r & 15, cc = c & 31, ob = rr * 64 + cc * 2; return st * 1024 + (ob ^ (((ob >> 9) & 1) << 5)); }
__host__ __device__ __forceinline__ void stage_rc(int b, int& R, int& C) { const int st = b / 1024, sb = b % 1024, swz = sb ^ (((sb >> 9) & 1) << 5); R = (st >> 1) * 16 + swz / 64; C = (st & 1) * 32 + (swz % 64) / 2; }
__host__ __device__ __forceinline__ int perm32(int rho) { const int n = rho >> 4, i = rho & 15; return 8 * (i >> 2) + 4 * n + (i & 3); }

struct Unit { int pm, pn, aux; const char* A; const char* B; };
struct GemmG { int lda, ldb, K, bmode; };

__device__ __forceinline__ bool tile_order(long L, int nM, int nN, int& pm, int& pn) {
  const int nwg = nM * nN; if (L >= nwg) return false;
  int wgid = (int)L; { const int q = nwg / NXCD, r = nwg % NXCD, xcd = wgid % NXCD, off = wgid / NXCD; wgid = (xcd < r ? xcd * (q + 1) : r * (q + 1) + (xcd - r) * q) + off; }
  const int nig = WGM * nN, gid = wgid / nig, fm = gid * WGM, gsz = (nM - fm) < WGM ? (nM - fm) : WGM;
  pm = fm + ((wgid % nig) % gsz); pn = (wgid % nig) / gsz; return true;
}
__device__ __forceinline__ unsigned cvt_pk_bf16(float lo, float hi) { unsigned r; asm volatile("v_cvt_pk_bf16_f32 %0, %1, %2" : "=v"(r) : "v"(lo), "v"(hi)); return r; }
__device__ __forceinline__ u32x4 pack8(const f32x4 a, const f32x4 b) { u32x4 w; w.x = cvt_pk_bf16(a[0], a[1]); w.y = cvt_pk_bf16(a[2], a[3]); w.z = cvt_pk_bf16(b[0], b[1]); w.w = cvt_pk_bf16(b[2], b[3]); return w; }
__device__ __forceinline__ void unpack8(const u32x4 w, f32x4& a, f32x4& b) {
  a[0] = __uint_as_float(w.x << 16); a[1] = __uint_as_float(w.x & 0xffff0000u); a[2] = __uint_as_float(w.y << 16); a[3] = __uint_as_float(w.y & 0xffff0000u);
  b[0] = __uint_as_float(w.z << 16); b[1] = __uint_as_float(w.z & 0xffff0000u); b[2] = __uint_as_float(w.w << 16); b[3] = __uint_as_float(w.w & 0xffff0000u); }
#ifndef MK_NT
#define MK_NT 0
#endif
template <class T> __device__ __forceinline__ void st_out(T* p, const T v) { if (MK_NT) __builtin_nontemporal_store(v, p); else *p = v; }
__device__ __forceinline__ float fast_sigmoid(float x) { return __builtin_amdgcn_rcpf(1.f + __builtin_amdgcn_exp2f(-1.4426950408889634f * x)); }
__device__ __forceinline__ f32x4 sigmoid4(f32x4 v) { f32x4 o; o[0] = fast_sigmoid(v[0]); o[1] = fast_sigmoid(v[1]); o[2] = fast_sigmoid(v[2]); o[3] = fast_sigmoid(v[3]); return o; }

template <bool ALIGN = true, bool SP2 = PG8_SP2, class Epi, class Sched>
__device__ __forceinline__ void gemm_phase(PG8_LAS unsigned char* lds, const GemmG g, const Sched& S, const Epi& E) {
    const int tid = ph_tid(), wid = __builtin_amdgcn_readfirstlane(tid >> 6), lane = tid & 63, wr = wid >> 2, wc = wid & 3, fr = lane & 15, fq = lane >> 4;
    const int K = g.K, nt = K / BK;
    unsigned voffA[2], voffB[2];
#pragma unroll
    for (int i = 0; i < 2; ++i) { int R, C; stage_rc(tid * 16 + i * 8192, R, C); const int Rb = (R & ~31) + perm32(R & 31);
        const int wrow = g.bmode ? (((Rb >> 4) & 1) * DM + 16 * ((Rb >> 5) & 3) + (Rb & 15)) : Rb;
        voffA[i] = (unsigned)(R * g.lda + C) * 2u; voffB[i] = (unsigned)(wrow * g.ldb + C) * 2u; }
    const size_t kstep = (size_t)(BK * 2);
    const size_t hsA = (size_t)HALF * g.lda * 2, hsB = (size_t)(g.bmode ? 2 * DM : HALF) * g.ldb * 2;
    const unsigned ldsw = (unsigned)wid * 1024u;
    const int aoff = lds_byte(wr * 64 + fr, fq * 8), boff = lds_byte(wc * 32 + fr, fq * 8);
#define PG8_SA(b, h) (((b) * 2 + (h)) * HTB)
#define PG8_SB(b, h) ((4 + (b) * 2 + (h)) * HTB)
#define PG8_STAGE(bufoff, gbase, voff) do { _Pragma("unroll") for (int _i = 0; _i < 2; ++_i) \
        __builtin_amdgcn_global_load_lds((const unsigned*)((const char*)(gbase) + (voff)[_i]), (PG8_LAS unsigned*)(lds + (bufoff) + ldsw + _i * 8192), 16, 0, 0); } while (0)
#define PG8_LDA(dst, b, h) do { _Pragma("unroll") for (int m = 0; m < 4; ++m) _Pragma("unroll") for (int k = 0; k < 2; ++k) dst[m][k] = *(const PG8_LAS bf16x8*)(lds + PG8_SA(b, h) + aoff + m * 2048 + k * 1024); } while (0)
#define PG8_LDB(dst, b, h) do { _Pragma("unroll") for (int n = 0; n < 2; ++n) _Pragma("unroll") for (int k = 0; k < 2; ++k) dst[n][k] = *(const PG8_LAS bf16x8*)(lds + PG8_SB(b, h) + boff + n * 2048 + k * 1024); } while (0)
#define PG8_MMA(ai, bj, At, Bt) do { __builtin_amdgcn_s_setprio(1); _Pragma("unroll") for (int m = 0; m < 4; ++m) _Pragma("unroll") for (int n = 0; n < 2; ++n) _Pragma("unroll") for (int k = 0; k < 2; ++k) \
        acc[ai][bj][m][n] = __builtin_amdgcn_mfma_f32_16x16x32_bf16(Bt[n][k], At[m][k], acc[ai][bj][m][n], 0, 0, 0); __builtin_amdgcn_s_setprio(0); } while (0)
#define PG8_WAIT_V(n) asm volatile("s_waitcnt vmcnt(" #n ")" ::: "memory")
#define PG8_WAIT_L(n) asm volatile("s_waitcnt lgkmcnt(" #n ")" ::: "memory")
#define PG8_BAR __builtin_amdgcn_s_barrier()
#define PG8_SCHED __builtin_amdgcn_sched_barrier(0)
    Unit cur, nxt; int ui = 0;
    if (!S.next(0, cur)) return;
    f32x4 acc[2][2][4][2];
#pragma unroll
    for (int a = 0; a < 2; ++a)
#pragma unroll
        for (int b = 0; b < 2; ++b)
#pragma unroll
            for (int m = 0; m < 4; ++m)
#pragma unroll
                for (int n = 0; n < 2; ++n) acc[a][b][m][n] = (f32x4){0.f, 0.f, 0.f, 0.f};
    bf16x8 At[4][2], B0[2][2], B1[2][2];
    const char* cA = cur.A; const char* cB = cur.B;
    if constexpr (SP2) {
      PG8_STAGE(PG8_SB(0, 0), cB, voffB); PG8_STAGE(PG8_SB(0, 1), cB + hsB, voffB); PG8_STAGE(PG8_SA(0, 0), cA, voffA); PG8_STAGE(PG8_SA(0, 1), cA + hsA, voffA);
      if (wr == 1) PG8_BAR;
      PG8_WAIT_V(2); PG8_BAR;
      PG8_STAGE(PG8_SB(1, 0), cB + kstep, voffB); PG8_STAGE(PG8_SA(1, 0), cA + kstep, voffA); PG8_STAGE(PG8_SB(1, 1), cB + hsB + kstep, voffB);
      PG8_WAIT_V(6); PG8_BAR;
    } else {
    PG8_STAGE(PG8_SB(0, 0), cB, voffB); PG8_STAGE(PG8_SA(0, 0), cA, voffA); PG8_STAGE(PG8_SB(0, 1), cB + hsB, voffB); PG8_STAGE(PG8_SA(0, 1), cA + hsA, voffA);
    if (wr == 1) PG8_BAR;
    PG8_WAIT_V(4); PG8_BAR;
    PG8_STAGE(PG8_SB(1, 0), cB + kstep, voffB); PG8_STAGE(PG8_SA(1, 0), cA + kstep, voffA); PG8_STAGE(PG8_SB(1, 1), cB + hsB + kstep, voffB);
    PG8_WAIT_V(6); PG8_BAR;
    }
    for (;;) {
        const bool has_next = S.next(ui + 1, nxt);
        const char* nA = has_next ? nxt.A : cA; const char* nB = has_next ? nxt.B : cB;
        for (int t = 0; t < nt; t += 2) {
            const bool last = (t == nt - 2);
            const char* a1 = cA + (size_t)(t + 1) * kstep;
            const char* a2 = last ? nA : cA + (size_t)(t + 2) * kstep; const char* b2 = last ? nB : cB + (size_t)(t + 2) * kstep;
            const char* a3 = a2 + kstep; const char* b3 = b2 + kstep;
            if constexpr (SP2) {
            PG8_LDB(B0, 0, 0); PG8_LDB(B1, 0, 1); PG8_SCHED; PG8_LDA(At, 0, 0); PG8_STAGE(PG8_SA(1, 1), a1 + hsA, voffA);
            PG8_WAIT_V(8); PG8_WAIT_L(0); PG8_BAR; PG8_MMA(0, 0, At, B0); PG8_MMA(0, 1, At, B1); PG8_BAR; PG8_SCHED;
            PG8_LDA(At, 0, 1); PG8_STAGE(PG8_SB(0, 0), b2, voffB); PG8_STAGE(PG8_SB(0, 1), b2 + hsB, voffB); PG8_STAGE(PG8_SA(0, 0), a2, voffA);
            PG8_WAIT_V(8); PG8_WAIT_L(0); PG8_BAR; PG8_MMA(1, 0, At, B0); PG8_MMA(1, 1, At, B1); PG8_BAR; PG8_SCHED;
            PG8_LDB(B0, 1, 0); PG8_LDB(B1, 1, 1); PG8_SCHED; PG8_LDA(At, 1, 0); PG8_STAGE(PG8_SA(0, 1), a2 + hsA, voffA);
            PG8_WAIT_V(8); PG8_WAIT_L(0); PG8_BAR; PG8_MMA(0, 0, At, B0); PG8_MMA(0, 1, At, B1); PG8_BAR; PG8_SCHED;
            PG8_LDA(At, 1, 1); PG8_STAGE(PG8_SB(1, 0), b3, voffB); PG8_STAGE(PG8_SB(1, 1), b3 + hsB, voffB); PG8_STAGE(PG8_SA(1, 0), a3, voffA);
            PG8_WAIT_V(8); PG8_WAIT_L(0); PG8_BAR; PG8_MMA(1, 0, At, B0); PG8_MMA(1, 1, At, B1); PG8_BAR; PG8_SCHED;
            } else {
            PG8_LDB(B0, 0, 0); PG8_SCHED; PG8_LDA(At, 0, 0); PG8_STAGE(PG8_SA(1, 1), a1 + hsA, voffA);
            PG8_WAIT_L(8); PG8_BAR; PG8_WAIT_L(0); PG8_MMA(0, 0, At, B0); PG8_BAR; PG8_SCHED;
            PG8_LDB(B1, 0, 1); PG8_STAGE(PG8_SB(0, 0), b2, voffB);
            PG8_BAR; PG8_WAIT_L(0); PG8_MMA(0, 1, At, B1); PG8_BAR;
            PG8_LDA(At, 0, 1); PG8_STAGE(PG8_SA(0, 0), a2, voffA);
            PG8_BAR; PG8_WAIT_L(0); PG8_MMA(1, 0, At, B0); PG8_BAR; PG8_SCHED;
            PG8_STAGE(PG8_SB(0, 1), b2 + hsB, voffB);
            PG8_WAIT_V(6); PG8_BAR; PG8_MMA(1, 1, At, B1); PG8_BAR;
            PG8_LDB(B0, 1, 0); PG8_SCHED; PG8_LDA(At, 1, 0); PG8_STAGE(PG8_SA(0, 1), a2 + hsA, voffA);
            PG8_WAIT_L(8); PG8_BAR; PG8_WAIT_L(0); PG8_MMA(0, 0, At, B0); PG8_BAR; PG8_SCHED;
            PG8_LDB(B1, 1, 1); PG8_STAGE(PG8_SB(1, 0), b3, voffB);
            PG8_BAR; PG8_WAIT_L(0); PG8_MMA(0, 1, At, B1); PG8_BAR;
            PG8_LDA(At, 1, 1); PG8_STAGE(PG8_SA(1, 0), a3, voffA);
            PG8_BAR; PG8_WAIT_L(0); PG8_MMA(1, 0, At, B0); PG8_BAR; PG8_SCHED;
            PG8_STAGE(PG8_SB(1, 1), b3 + hsB, voffB);
            PG8_WAIT_V(6); PG8_BAR; PG8_MMA(1, 1, At, B1); PG8_BAR;
            }
        }
        if (ALIGN && wr == 0) PG8_BAR;
        { int efr = fr, efq = fq; asm volatile("" : "+v"(efr), "+v"(efq)); E(acc, cur, wr, wc, efr, efq); }
        if (!has_next) break;
#pragma unroll
        for (int a = 0; a < 2; ++a)
#pragma unroll
            for (int b = 0; b < 2; ++b)
#pragma unroll
                for (int m = 0; m < 4; ++m)
#pragma unroll
                    for (int n = 0; n < 2; ++n) acc[a][b][m][n] = (f32x4){0.f, 0.f, 0.f, 0.f};
        cur = nxt; cA = nA; cB = nB; ++ui;
        if (ALIGN && wr == 1) PG8_BAR;
    }
    PG8_WAIT_V(0);
    if (!ALIGN && wr == 0) PG8_BAR;
    PG8_BAR;
#undef PG8_SA
#undef PG8_SB
#undef PG8_STAGE
#undef PG8_LDA
#undef PG8_LDB
#undef PG8_MMA
#undef PG8_WAIT_V
#undef PG8_WAIT_L
#undef PG8_BAR
#undef PG8_SCHED
}

template <bool ALIGN = true, bool SP2 = PG8_SP2, class Epi, class Sched>
__device__ __forceinline__ void gemm_phase_gather(PG8_LAS unsigned char* lds, const GemmG g, const Sched& S, const Epi& E, const char* Abase, const int* rowidx, const unsigned zoff) {
    const int tid = ph_tid(), wid = __builtin_amdgcn_readfirstlane(tid >> 6), lane = tid & 63, wr = wid >> 2, wc = wid & 3, fr = lane & 15, fq = lane >> 4;
    const int K = g.K, nt = K / BK;
    unsigned voffB[2];
#pragma unroll
    for (int i = 0; i < 2; ++i) { int R, C; stage_rc(tid * 16 + i * 8192, R, C); const int Rb = (R & ~31) + perm32(R & 31);
        const int wrow = g.bmode ? (((Rb >> 4) & 1) * DM + 16 * ((Rb >> 5) & 3) + (Rb & 15)) : Rb;
        voffB[i] = (unsigned)(wrow * g.ldb + C) * 2u; }
    unsigned vc0[2], vc1[2], vn0[2], vn1[2];
#define PG8_GOFF(dst0, dst1, u) do { const int _t = ph_tid(); _Pragma("unroll") for (int _i = 0; _i < 2; ++_i) { int _R, _C; stage_rc(_t * 16 + _i * 8192, _R, _C); const int _r0 = rowidx[(u).pm * BM + _R], _r1 = rowidx[(u).pm * BM + HALF + _R]; \
        dst0[_i] = (_r0 >= 0 ? (unsigned)_r0 * (unsigned)(g.lda * 2) : zoff) + (unsigned)_C * 2u; dst1[_i] = (_r1 >= 0 ? (unsigned)_r1 * (unsigned)(g.lda * 2) : zoff) + (unsigned)_C * 2u; } } while (0)
    const size_t kstep = (size_t)(BK * 2);
    const size_t hsB = (size_t)(g.bmode ? 2 * DM : HALF) * g.ldb * 2;
    const unsigned ldsw = (unsigned)wid * 1024u;
    const int aoff = lds_byte(wr * 64 + fr, fq * 8), boff = lds_byte(wc * 32 + fr, fq * 8);
#define PG8_SA(b, h) (((b) * 2 + (h)) * HTB)
#define PG8_SB(b, h) ((4 + (b) * 2 + (h)) * HTB)
#define PG8_STAGE(bufoff, gbase, voff) do { _Pragma("unroll") for (int _i = 0; _i < 2; ++_i) \
        __builtin_amdgcn_global_load_lds((const unsigned*)((const char*)(gbase) + (voff)[_i]), (PG8_LAS unsigned*)(lds + (bufoff) + ldsw + _i * 8192), 16, 0, 0); } while (0)
#define PG8_LDA(dst, b, h) do { _Pragma("unroll") for (int m = 0; m < 4; ++m) _Pragma("unroll") for (int k = 0; k < 2; ++k) dst[m][k] = *(const PG8_LAS bf16x8*)(lds + PG8_SA(b, h) + aoff + m * 2048 + k * 1024); } while (0)
#define PG8_LDB(dst, b, h) do { _Pragma("unroll") for (int n = 0; n < 2; ++n) _Pragma("unroll") for (int k = 0; k < 2; ++k) dst[n][k] = *(const PG8_LAS bf16x8*)(lds + PG8_SB(b, h) + boff + n * 2048 + k * 1024); } while (0)
#define PG8_MMA(ai, bj, At, Bt) do { __builtin_amdgcn_s_setprio(1); _Pragma("unroll") for (int m = 0; m < 4; ++m) _Pragma("unroll") for (int n = 0; n < 2; ++n) _Pragma("unroll") for (int k = 0; k < 2; ++k) \
        acc[ai][bj][m][n] = __builtin_amdgcn_mfma_f32_16x16x32_bf16(Bt[n][k], At[m][k], acc[ai][bj][m][n], 0, 0, 0); __builtin_amdgcn_s_setprio(0); } while (0)
#define PG8_WAIT_V(n) asm volatile("s_waitcnt vmcnt(" #n ")" ::: "memory")
#define PG8_WAIT_L(n) asm volatile("s_waitcnt lgkmcnt(" #n ")" ::: "memory")
#define PG8_BAR __builtin_amdgcn_s_barrier()
#define PG8_SCHED __builtin_amdgcn_sched_barrier(0)
    Unit cur, nxt; int ui = 0;
    if (!S.next(0, cur)) return;
    f32x4 acc[2][2][4][2];
#pragma unroll
    for (int a = 0; a < 2; ++a)
#pragma unroll
        for (int b = 0; b < 2; ++b)
#pragma unroll
            for (int m = 0; m < 4; ++m)
#pragma unroll
                for (int n = 0; n < 2; ++n) acc[a][b][m][n] = (f32x4){0.f, 0.f, 0.f, 0.f};
    bf16x8 At[4][2], B0[2][2], B1[2][2];
    const char* cA = Abase; const char* cB = cur.B;
    PG8_GOFF(vc0, vc1, cur);
    if constexpr (SP2) {
      PG8_STAGE(PG8_SB(0, 0), cB, voffB); PG8_STAGE(PG8_SB(0, 1), cB + hsB, voffB); PG8_STAGE(PG8_SA(0, 0), cA, vc0); PG8_STAGE(PG8_SA(0, 1), cA, vc1);
      if (wr == 1) PG8_BAR;
      PG8_WAIT_V(2); PG8_BAR;
      PG8_STAGE(PG8_SB(1, 0), cB + kstep, voffB); PG8_STAGE(PG8_SA(1, 0), cA + kstep, vc0); PG8_STAGE(PG8_SB(1, 1), cB + hsB + kstep, voffB);
      PG8_WAIT_V(6); PG8_BAR;
    } else {
    PG8_STAGE(PG8_SB(0, 0), cB, voffB); PG8_STAGE(PG8_SA(0, 0), cA, vc0); PG8_STAGE(PG8_SB(0, 1), cB + hsB, voffB); PG8_STAGE(PG8_SA(0, 1), cA, vc1);
    if (wr == 1) PG8_BAR;
    PG8_WAIT_V(4); PG8_BAR;
    PG8_STAGE(PG8_SB(1, 0), cB + kstep, voffB); PG8_STAGE(PG8_SA(1, 0), cA + kstep, vc0); PG8_STAGE(PG8_SB(1, 1), cB + hsB + kstep, voffB);
    PG8_WAIT_V(6); PG8_BAR;
    }
    for (;;) {
        const bool has_next = S.next(ui + 1, nxt);
        const char* nB = has_next ? nxt.B : cB;
        if (has_next) { PG8_GOFF(vn0, vn1, nxt); } else {
#pragma unroll
          for (int _i = 0; _i < 2; ++_i) { vn0[_i] = vc0[_i]; vn1[_i] = vc1[_i]; } }
        for (int t = 0; t < nt; t += 2) {
            const bool last = (t == nt - 2);
            const char* a1 = cA + (size_t)(t + 1) * kstep;
            const char* a2 = last ? cA : cA + (size_t)(t + 2) * kstep; const char* b2 = last ? nB : cB + (size_t)(t + 2) * kstep;
            const char* a3 = a2 + kstep; const char* b3 = b2 + kstep;
            if constexpr (SP2) {
            PG8_LDB(B0, 0, 0); PG8_LDB(B1, 0, 1); PG8_SCHED; PG8_LDA(At, 0, 0); PG8_STAGE(PG8_SA(1, 1), a1, vc1);
            PG8_WAIT_V(8); PG8_WAIT_L(0); PG8_BAR; PG8_MMA(0, 0, At, B0); PG8_MMA(0, 1, At, B1); PG8_BAR; PG8_SCHED;
            PG8_LDA(At, 0, 1); PG8_STAGE(PG8_SB(0, 0), b2, voffB); PG8_STAGE(PG8_SB(0, 1), b2 + hsB, voffB); if (last) PG8_STAGE(PG8_SA(0, 0), a2, vn0); else PG8_STAGE(PG8_SA(0, 0), a2, vc0);
            PG8_WAIT_V(8); PG8_WAIT_L(0); PG8_BAR; PG8_MMA(1, 0, At, B0); PG8_MMA(1, 1, At, B1); PG8_BAR; PG8_SCHED;
            PG8_LDB(B0, 1, 0); PG8_LDB(B1, 1, 1); PG8_SCHED; PG8_LDA(At, 1, 0); if (last) PG8_STAGE(PG8_SA(0, 1), a2, vn1); else PG8_STAGE(PG8_SA(0, 1), a2, vc1);
            PG8_WAIT_V(8); PG8_WAIT_L(0); PG8_BAR; PG8_MMA(0, 0, At, B0); PG8_MMA(0, 1, At, B1); PG8_BAR; PG8_SCHED;
            PG8_LDA(At, 1, 1); PG8_STAGE(PG8_SB(1, 0), b3, voffB); PG8_STAGE(PG8_SB(1, 1), b3 + hsB, voffB); if (last) PG8_STAGE(PG8_SA(1, 0), a3, vn0); else PG8_STAGE(PG8_SA(1, 0), a3, vc0);
            PG8_WAIT_V(8); PG8_WAIT_L(0); PG8_BAR; PG8_MMA(1, 0, At, B0); PG8_MMA(1, 1, At, B1); PG8_BAR; PG8_SCHED;
            } else {
            PG8_LDB(B0, 0, 0); PG8_SCHED; PG8_LDA(At, 0, 0); PG8_STAGE(PG8_SA(1, 1), a1, vc1);
            PG8_WAIT_L(8); PG8_BAR; PG8_WAIT_L(0); PG8_MMA(0, 0, At, B0); PG8_BAR; PG8_SCHED;
            PG8_LDB(B1, 0, 1); PG8_STAGE(PG8_SB(0, 0), b2, voffB);
            PG8_BAR; PG8_WAIT_L(0); PG8_MMA(0, 1, At, B1); PG8_BAR;
            PG8_LDA(At, 0, 1); if (last) PG8_STAGE(PG8_SA(0, 0), a2, vn0); else PG8_STAGE(PG8_SA(0, 0), a2, vc0);
            PG8_BAR; PG8_WAIT_L(0); PG8_MMA(1, 0, At, B0); PG8_BAR; PG8_SCHED;
            PG8_STAGE(PG8_SB(0, 1), b2 + hsB, voffB);
            PG8_WAIT_V(6); PG8_BAR; PG8_MMA(1, 1, At, B1); PG8_BAR;
            PG8_LDB(B0, 1, 0); PG8_SCHED; PG8_LDA(At, 1, 0); if (last) PG8_STAGE(PG8_SA(0, 1), a2, vn1); else PG8_STAGE(PG8_SA(0, 1), a2, vc1);
            PG8_WAIT_L(8); PG8_BAR; PG8_WAIT_L(0); PG8_MMA(0, 0, At, B0); PG8_BAR; PG8_SCHED;
            PG8_LDB(B1, 1, 1); PG8_STAGE(PG8_SB(1, 0), b3, voffB);
            PG8_BAR; PG8_WAIT_L(0); PG8_MMA(0, 1, At, B1); PG8_BAR;
            PG8_LDA(At, 1, 1); if (last) PG8_STAGE(PG8_SA(1, 0), a3, vn0); else PG8_STAGE(PG8_SA(1, 0), a3, vc0);
            PG8_BAR; PG8_WAIT_L(0); PG8_MMA(1, 0, At, B0); PG8_BAR; PG8_SCHED;
            PG8_STAGE(PG8_SB(1, 1), b3 + hsB, voffB);
            PG8_WAIT_V(6); PG8_BAR; PG8_MMA(1, 1, At, B1); PG8_BAR;
            }
        }
        if (ALIGN && wr == 0) PG8_BAR;
        { int efr = fr, efq = fq; asm volatile("" : "+v"(efr), "+v"(efq)); E(acc, cur, wr, wc, efr, efq); }
        if (!has_next) break;
#pragma unroll
        for (int a = 0; a < 2; ++a)
#pragma unroll
            for (int b = 0; b < 2; ++b)
#pragma unroll
                for (int m = 0; m < 4; ++m)
#pragma unroll
                    for (int n = 0; n < 2; ++n) acc[a][b][m][n] = (f32x4){0.f, 0.f, 0.f, 0.f};
        cur = nxt; cB = nB; ++ui;
#pragma unroll
        for (int _i = 0; _i < 2; ++_i) { vc0[_i] = vn0[_i]; vc1[_i] = vn1[_i]; }
        if (ALIGN && wr == 1) PG8_BAR;
    }
    PG8_WAIT_V(0);
    if (!ALIGN && wr == 0) PG8_BAR;
    PG8_BAR;
#undef PG8_GOFF
#undef PG8_SA
#undef PG8_SB
#undef PG8_STAGE
#undef PG8_LDA
#undef PG8_LDB
#undef PG8_MMA
#undef PG8_WAIT_V
#undef PG8_WAIT_L
#undef PG8_BAR
#undef PG8_SCHED
}

struct SchedGrid {
  const char* A; const char* B; int lda, ldb, nM, nN, skip_ctx, G, c, pad;
  __device__ __forceinline__ bool next(int i, Unit& u) const {
    int pm, pn; if (!tile_order((long)i * G + c, nM, nN, pm, pn)) return false;
    if (skip_ctx && pm >= NTOK / 256 - 1) pm += 1;
    u.pm = pm; u.pn = pn; u.aux = 0; u.A = A + (size_t)pm * BM * lda * 2; u.B = B + (size_t)pn * BM * ldb * 2; return true; }
};
struct SchedProj {
  const char* OA; const char* B; int nM, skip_ctx, G, c;
  __device__ __forceinline__ bool next(int i, Unit& u) const {
    int pm, pn; if (!tile_order((long)i * G + c, nM, 4 * DM / 256, pm, pn)) return false;
    if (skip_ctx && pm >= NTOK / 256 - 1) pm += 1;
    const int k = pn / (DM / 256);
    u.pm = pm; u.pn = pn; u.aux = k; u.A = OA + ((size_t)pm * BM * DM + (size_t)k * BW) * 2; u.B = B + (size_t)pn * BM * BW * 2; return true; }
};
struct SchedGate {
  const char* H; const char* B; int nM, skip_ctx, G, c;
  __device__ __forceinline__ bool next(int i, Unit& u) const {
    const int j = i >> 2, k = i & 3; int pm, pd; if (!tile_order((long)j * G + c, nM, DM / 256, pm, pd)) return false;
    if (skip_ctx && pm >= NTOK / 256 - 1) pm += 1;
    u.pm = pm; u.pn = pd; u.aux = k; u.A = H + (size_t)pm * BM * DM * 2; u.B = B + ((size_t)k * DM + (size_t)pd * BM) * DM * 2; return true; }
};
struct SchedMoe {
  const char* A; const char* B; int lda, ldb, nMl, nN; size_t wstride; int G, c, xcd, pad;
  __device__ __forceinline__ bool next(int i, Unit& u) const {
    int e, rem; const int per_e = nMl * nN;
    if (xcd) { const int x = c & 7, idx = c >> 3, wpx = G >> 3, j = i * wpx + idx; if (j >= (NE / 8) * per_e) return false; e = x + 8 * (j / per_e); rem = j % per_e; }
    else { const long L = (long)i * G + c; if (L >= (long)NE * per_e) return false; e = (int)(L / per_e); rem = (int)(L % per_e); }
    const int pn = rem / nMl, pml = rem % nMl;
    u.pm = e * (XEP / 256) + pml; u.pn = pn; u.aux = e; u.A = A + (size_t)u.pm * BM * lda * 2; u.B = B + (size_t)e * wstride + (size_t)pn * BM * ldb * 2; return true; }
};

#define EPI_LOOP(...) _Pragma("unroll") for (int ai = 0; ai < 2; ++ai) _Pragma("unroll") for (int m = 0; m < 4; ++m) { const int trow = ai * HALF + wr * 64 + m * 16 + fr; \
    _Pragma("unroll") for (int bj = 0; bj < 2; ++bj) { const int tcol = bj * HALF + wc * 32 + 8 * fq; const f32x4 v0 = acc[ai][bj][m][0], v1 = acc[ai][bj][m][1]; __VA_ARGS__ } }
typedef f32x4 AccT[2][2][4][2];
struct EpiBf16 { bf16_t* O; int ldc, pad;
  __device__ __forceinline__ void operator()(const AccT& acc, const Unit& u, int wr, int wc, int fr, int fq) const {
    bf16_t* base = O + (size_t)u.pm * BM * ldc + (size_t)u.pn * BM;
    EPI_LOOP(st_out((u32x4*)(base + (size_t)trow * ldc + tcol), pack8(v0, v1));) } };
struct EpiF32 { float* O; int ldc, pad;
  __device__ __forceinline__ void operator()(const AccT& acc, const Unit& u, int wr, int wc, int fr, int fq) const {
    float* base = O + (size_t)u.pm * BM * ldc + (size_t)u.pn * BM;
    EPI_LOOP(float* q = base + (size_t)trow * ldc + tcol; st_out((f32x4*)q, v0); st_out((f32x4*)(q + 4), v1);) } };
struct EpiKVm { bf16_t* KM; bf16_t* VM;
  __device__ __forceinline__ void operator()(const AccT& acc, const Unit& u, int wr, int wc, int fr, int fq) const {
    bf16_t* kb = KM + (size_t)u.pm * BM * (MH * MQK) + u.pn * MQK; bf16_t* vb = VM + (size_t)u.pm * BM * (MH * MV) + u.pn * MV;
    EPI_LOOP(bf16_t* q = (bj == 0) ? kb + trow * (MH * MQK) + tcol : vb + trow * (MH * MV) + (tcol - HALF); *(u32x4*)q = pack8(v0, v1);) } };
struct EpiGluO { const bf16_t* Z; bf16_t* O;
  __device__ __forceinline__ void operator()(const AccT& acc, const Unit& u, int wr, int wc, int fr, int fq) const {
    EPI_LOOP(const size_t row = (size_t)u.pm * BM + trow; const int col = u.pn * BM + tcol; f32x4 z0, z1; unpack8(*(const u32x4*)(Z + row * BW + col), z0, z1);
             *(u32x4*)(O + row * DM + col) = pack8(z0 * sigmoid4(v0), z1 * sigmoid4(v1));) } };
struct EpiGateMerge { const float* bg; const bf16_t* PROJ; float* MACC; bf16_t* MG;
  __device__ __forceinline__ void operator()(const AccT& acc, const Unit& u, int wr, int wc, int fr, int fq) const {
    const int k = u.aux; const bf16_t* pb = PROJ + (size_t)u.pm * BM * (4 * DM) + k * DM + u.pn * BM; float* mb = MACC + (size_t)u.pm * BM * DM + u.pn * BM; bf16_t* gb = MG + (size_t)u.pm * BM * DM + u.pn * BM;
    const float* bp0 = bg + k * DM + u.pn * BM;
#pragma unroll
    for (int ai = 0; ai < 2; ++ai)
#pragma unroll
      for (int bj = 0; bj < 2; ++bj) { const int tcol = bj * HALF + wc * 32 + 8 * fq; u32x4 pj[4]; f32x4 m0[4], m1[4];
#pragma unroll
        for (int m = 0; m < 4; ++m) { const int trow = ai * HALF + wr * 64 + m * 16 + fr; pj[m] = *(const u32x4*)(pb + trow * (4 * DM) + tcol);
          if (k > 0) { m0[m] = *(const f32x4*)(mb + trow * DM + tcol); m1[m] = *(const f32x4*)(mb + trow * DM + tcol + 4); } }
        const f32x4 b0 = *(const f32x4*)(bp0 + tcol), b1 = *(const f32x4*)(bp0 + tcol + 4);
#pragma unroll
        for (int m = 0; m < 4; ++m) { const int trow = ai * HALF + wr * 64 + m * 16 + fr; f32x4 p0, p1; unpack8(pj[m], p0, p1);
          f32x4 r0 = sigmoid4(acc[ai][bj][m][0] + b0) * p0, r1 = sigmoid4(acc[ai][bj][m][1] + b1) * p1;
          if (k > 0) { r0 += m0[m]; r1 += m1[m]; }
          if (k < 3) { *(f32x4*)(mb + trow * DM + tcol) = r0; *(f32x4*)(mb + trow * DM + tcol + 4) = r1; } else *(u32x4*)(gb + trow * DM + tcol) = pack8(r0, r1); } } } };
struct EpiSwiGlu { bf16_t* ACT;
  __device__ __forceinline__ void operator()(const AccT& acc, const Unit& u, int wr, int wc, int fr, int fq) const {
#pragma unroll
    for (int ai = 0; ai < 2; ++ai)
#pragma unroll
      for (int m = 0; m < 4; ++m) { const size_t row = (size_t)u.pm * BM + ai * HALF + wr * 64 + m * 16 + fr; const int col = u.pn * HALF + wc * 32 + 8 * fq;
        const f32x4 g0 = acc[ai][0][m][0], g1 = acc[ai][0][m][1], u0 = acc[ai][1][m][0], u1 = acc[ai][1][m][1];
        st_out((u32x4*)(ACT + row * FF + col), pack8(g0 * sigmoid4(g0) * u0, g1 * sigmoid4(g1) * u1)); } } };
struct EpiDownG { const float* GV; bf16_t* YS;
  __device__ __forceinline__ void operator()(const AccT& acc, const Unit& u, int wr, int wc, int fr, int fq) const {
    EPI_LOOP(const size_t row = (size_t)u.pm * BM + trow; const float gv = GV[row]; *(u32x4*)(YS + row * DM + u.pn * BM + tcol) = pack8(v0 * gv, v1 * gv);) } };

struct SchedS5 { const char* UH; const char* W; size_t wstride; int G, c;
  __device__ __forceinline__ bool next(int i, Unit& u) const {
    const long L = (long)i * G + c; if (L >= (long)S5G * (S5NP / 256)) return false; const int g = (int)(L / (S5NP / 256)), pm = (int)(L % (S5NP / 256));
    u.pm = pm; u.pn = 0; u.aux = g; u.A = UH + ((size_t)g * S5NP + (size_t)pm * BM) * (S5K1 + S5K2) * 2; u.B = W + (size_t)g * wstride; return true; }
};
struct EpiS5E { float* E;
  __device__ __forceinline__ void operator()(const AccT& acc, const Unit& u, int wr, int wc, int fr, int fq) const {
    float* base = E + ((size_t)u.aux * S5NP + (size_t)u.pm * BM) * S5K2;
    EPI_LOOP(float* q = base + (size_t)trow * S5K2 + tcol; *(f32x4*)q = v0; *(f32x4*)(q + 4) = v1;) } };
__device__ __forceinline__ float fast_gelu_tanh(float x) { const float t = 0.7978845608028654f * (x + 0.044715f * x * x * x); const float e = __builtin_amdgcn_exp2f(2.885390081777927f * t);
  return 0.5f * x * (2.f - 2.f * __builtin_amdgcn_rcpf(e + 1.f)); }
struct EpiS5Y { const bf16_t* P; const float* D; bf16_t* Z; int last, pad;
  __device__ __forceinline__ void operator()(const AccT& acc, const Unit& u, int wr, int wc, int fr, int fq) const {
    const int g = u.aux;
#pragma unroll
    for (int ai = 0; ai < 2; ++ai) { u32x4 uu[4][2]; bool ok[4]; long Rr[4];
#pragma unroll
      for (int m = 0; m < 4; ++m) { const int n = u.pm * BM + ai * HALF + wr * 64 + m * 16 + fr; const int b = n / S5NC, j = n % S5NC; ok[m] = n < S5NN && !(last && j >= SEQ / S5LC);
#pragma unroll
        for (int bj = 0; bj < 2; ++bj) { const int tcol = bj * HALF + wc * 32 + 8 * fq, a = tcol >> 4, i0 = tcol & 15; const long R = (long)b * NTOK + j * S5LC + a; if (bj == 0) Rr[m] = R - a;
          uu[m][bj] = ok[m] ? *(const u32x4*)(P + R * PW + OFF_U + g * S5CH + i0) : (u32x4){0u, 0u, 0u, 0u}; } }
#pragma unroll
      for (int bj = 0; bj < 2; ++bj) { const int tcol = bj * HALF + wc * 32 + 8 * fq, a = tcol >> 4, i0 = tcol & 15; const float* dp = D + g * S5CH + i0; const f32x4 d0 = *(const f32x4*)dp, d1 = *(const f32x4*)(dp + 4);
#pragma unroll
        for (int m = 0; m < 4; ++m) if (ok[m]) { f32x4 u0, u1; unpack8(uu[m][bj], u0, u1); f32x4 y0 = acc[ai][bj][m][0] + d0 * u0, y1 = acc[ai][bj][m][1] + d1 * u1;
#pragma unroll
          for (int q = 0; q < 4; ++q) { y0[q] = fast_gelu_tanh(y0[q]); y1[q] = fast_gelu_tanh(y1[q]); }
          *(u32x4*)(Z + (Rr[m] + a) * BW + g * S5CH + i0) = pack8(y0, y1); } } } } };
struct SchedGateCtx { const char* H; const char* B; int G, c;
  __device__ __forceinline__ bool next(int i, Unit& u) const {
    const int L = i * G + c; if (L >= 2 * (4 * DM / BM)) return false; const int ct = L / (4 * DM / BM), pn = L % (4 * DM / BM), pm = ct * (NTOK / BM) + SEQ / BM;
    u.pm = pm; u.pn = pn; u.aux = ct; u.A = H + (size_t)pm * BM * DM * 2; u.B = B + (size_t)pn * BM * DM * 2; return true; }
};
struct EpiGateCtx { const float* bg; bf16_t* GC;
  __device__ __forceinline__ void operator()(const AccT& acc, const Unit& u, int wr, int wc, int fr, int fq) const {
    bf16_t* base = GC + (size_t)u.aux * BM * (4 * DM) + u.pn * BM; const float* bp = bg + u.pn * BM;
    EPI_LOOP(*(u32x4*)(base + trow * (4 * DM) + tcol) = pack8(sigmoid4(v0 + *(const f32x4*)(bp + tcol)), sigmoid4(v1 + *(const f32x4*)(bp + tcol + 4)));) } };
struct SchedProjW { const char* OA; const char* B; int nM, skip_ctx, G, c, nA, ua, ub, pad;
  __device__ __forceinline__ bool next(int i, Unit& u) const {
    long L; if (c < nA) { if (i >= ua) return false; L = (long)c * ua + i; } else { if (i >= ub) return false; L = (long)nA * ua + (long)(c - nA) * ub + i; }
    int pm, pn; if (!tile_order(L, nM, 4 * DM / 256, pm, pn)) return false;
    if (skip_ctx && pm >= NTOK / 256 - 1) pm += 1;
    const int k = pn / (DM / 256);
    u.pm = pm; u.pn = pn; u.aux = k; u.A = OA + ((size_t)pm * BM * DM + (size_t)k * BW) * 2; u.B = B + (size_t)pn * BM * BW * 2; return true; }
};

struct SchedGate4 { const char* H; const char* B; int G, c;
  __device__ __forceinline__ bool next(int i, Unit& u) const {
    int pm, pd; if (!tile_order((long)i * G + c, MROWS / BM - 2, DM / 64, pm, pd)) return false;
    if (pm >= NTOK / BM - 1) pm += 1;
    u.pm = pm; u.pn = pd; u.aux = 0; u.A = H + (size_t)pm * BM * DM * 2; u.B = B + (size_t)pd * 64 * DM * 2; return true; }
};
struct EpiGate4 { const float* bg; const bf16_t* PROJ; bf16_t* MG;
  __device__ __forceinline__ void operator()(const AccT& acc, const Unit& u, int wr, int wc, int fr, int fq) const {
    const int kb = fq >> 1, d0 = u.pn * 64 + 16 * wc + 8 * (fq & 1); const bf16_t* pb = PROJ + (size_t)u.pm * BM * (4 * DM) + kb * DM + d0; bf16_t* gb = MG + (size_t)u.pm * BM * DM + d0;
    const float* bp = bg + kb * DM + d0; const f32x4 b00 = *(const f32x4*)bp, b01 = *(const f32x4*)(bp + 4), b10 = *(const f32x4*)(bp + 2 * DM), b11 = *(const f32x4*)(bp + 2 * DM + 4);
    u32x4 p0[2][4], p1[2][4];
#pragma unroll
    for (int ai = 0; ai < 2; ++ai)
#pragma unroll
      for (int m = 0; m < 4; ++m) { const int trow = ai * HALF + wr * 64 + m * 16 + fr; p0[ai][m] = *(const u32x4*)(pb + trow * (4 * DM)); p1[ai][m] = *(const u32x4*)(pb + trow * (4 * DM) + 2 * DM); }
#pragma unroll
    for (int ai = 0; ai < 2; ++ai)
#pragma unroll
      for (int m = 0; m < 4; ++m) { const int trow = ai * HALF + wr * 64 + m * 16 + fr; f32x4 q0, q1, q2, q3; unpack8(p0[ai][m], q0, q1); unpack8(p1[ai][m], q2, q3);
        f32x4 r0 = sigmoid4(acc[ai][0][m][0] + b00) * q0 + sigmoid4(acc[ai][1][m][0] + b10) * q2, r1 = sigmoid4(acc[ai][0][m][1] + b01) * q1 + sigmoid4(acc[ai][1][m][1] + b11) * q3;
#pragma unroll
        for (int j = 0; j < 4; ++j) { r0[j] += __shfl_xor(r0[j], 32); r1[j] += __shfl_xor(r1[j], 32); }
        if (kb == 0) st_out((u32x4*)(gb + trow * DM), pack8(r0, r1)); } } };

struct SchedKR { const char* H; const char* B; int G, c;
  __device__ __forceinline__ bool next(int i, Unit& u) const {
    const int L = i * G + c; if (L >= MROWS / BM) return false;
    u.pm = L; u.pn = PW / BM - 1; u.aux = 0; u.A = H + (size_t)L * BM * DM * 2; u.B = B + (size_t)(PW / BM - 1) * BM * DM * 2; return true; }
};
struct EpiKR { bf16_t* KM; const float* tb;
  __device__ __forceinline__ void operator()(const AccT& acc, const Unit& u, int wr, int wc, int fr, int fq) const {
    static_assert(IN_TOTAL - OFF_KR == 64 && OFF_KR == (PW / BM - 1) * BM, "rope key = first 64 columns of the last column tile");
    if (wc >= 2) return;
    const bool lat_tile = (u.pm % (NTOK / BM)) < SEQ / BM; const int t0 = (u.pm % (NTOK / BM)) * BM; bf16_t* base = KM + (size_t)u.pm * BM * (MH * MQK) + MNOPE + wc * 32 + 8 * fq;
#pragma unroll
    for (int ai = 0; ai < 2; ++ai)
#pragma unroll
      for (int m = 0; m < 4; ++m) { const int trow = ai * HALF + wr * 64 + m * 16 + fr; f32x4 a = acc[ai][0][m][0], b2 = acc[ai][0][m][1];
        if (lat_tile) { const int t = t0 + trow; const float* cs = tb + ((wc ? t % GRIDW : t / GRIDW) * NROPE_B + ((8 * fq) & 15)) * 2;
#pragma unroll
          for (int j = 0; j < 4; ++j) { const float oa = __shfl_xor(a[j], 32), ob = __shfl_xor(b2[j], 32); const float ca = cs[2 * j], sa = cs[2 * j + 1], cb = cs[8 + 2 * j], sb = cs[8 + 2 * j + 1];
            a[j] = a[j] * ca + (fq < 2 ? -oa : oa) * sa; b2[j] = b2[j] * cb + (fq < 2 ? -ob : ob) * sb; } }
        const u32x4 w = pack8(a, b2);
#pragma unroll
        for (int h = 0; h < MH; ++h) *(u32x4*)(base + trow * (MH * MQK) + h * MQK) = w; } } };

struct SchedKR2 { const char* H; const char* B; int G, c;
  __device__ __forceinline__ bool next(int i, Unit& u) const {
    const int L = i * G + c; if (L >= 2 * (MROWS / BM)) return false; const int pm = L >> 1, kh = L & 1;
    u.pm = pm; u.pn = PW / BM - 1; u.aux = kh; u.A = H + ((size_t)pm * BM * DM + (size_t)kh * (DM / 2)) * 2; u.B = B + ((size_t)(PW / BM - 1) * BM * DM + (size_t)kh * (DM / 2)) * 2; return true; }
};
struct EpiKRpart { float* KRP;
  __device__ __forceinline__ void operator()(const AccT& acc, const Unit& u, int wr, int wc, int fr, int fq) const {
    if (wc >= 2) return;
    float* base = KRP + ((size_t)u.aux * MROWS + (size_t)u.pm * BM) * MROPE + wc * 32 + 8 * fq;
#pragma unroll
    for (int ai = 0; ai < 2; ++ai)
#pragma unroll
      for (int m = 0; m < 4; ++m) { const int trow = ai * HALF + wr * 64 + m * 16 + fr; float* q = base + trow * MROPE; *(f32x4*)q = acc[ai][0][m][0]; *(f32x4*)(q + 4) = acc[ai][0][m][1]; } } };

struct SchedOutCtx { const char* MG; const char* B; int G, c;
  __device__ __forceinline__ bool next(int i, Unit& u) const {
    const int L = i * G + c; if (L >= 2 * (DM / BM) * 4) return false; const int kq = L & 3, pn = (L >> 2) % (DM / BM), ct = L / (4 * (DM / BM)), pm = ct * (NTOK / BM) + SEQ / BM;
    u.pm = ct; u.pn = pn; u.aux = kq; u.A = MG + ((size_t)pm * BM * DM + (size_t)kq * (DM / 4)) * 2; u.B = B + ((size_t)pn * BM * DM + (size_t)kq * (DM / 4)) * 2; return true; }
};
struct EpiSlab { float* Y;
  __device__ __forceinline__ void operator()(const AccT& acc, const Unit& u, int wr, int wc, int fr, int fq) const {
    float* base = Y + ((size_t)u.aux * NB * CTXL + (size_t)u.pm * BM) * DM + u.pn * BM;
    EPI_LOOP(float* q = base + (size_t)trow * DM + tcol; *(f32x4*)q = v0; *(f32x4*)(q + 4) = v1;) } };
struct EpiQM { bf16_t* QM; const float* tb;
  __device__ __forceinline__ void operator()(const AccT& acc, const Unit& u, int wr, int wc, int fr, int fq) const {
    const bool lat_tile = (u.pm % (NTOK / BM)) < SEQ / BM; bf16_t* base = QM + (size_t)u.pm * BM * (MH * MQK) + u.pn * BM; const int t0 = (u.pm % (NTOK / BM)) * BM;
    EPI_LOOP(const int cr = (u.pn * BM + tcol) % MQK; f32x4 a = v0, b2 = v1;
      if (cr >= MNOPE && lat_tile) { const int t = t0 + trow, hf = (cr - MNOPE) >> 5, off = (cr - MNOPE) & 31; const float* cs = tb + (((hf ? t % GRIDW : t / GRIDW)) * NROPE_B + (off & 15)) * 2;
        _Pragma("unroll") for (int j = 0; j < 4; ++j) { const float oa = __shfl_xor(a[j], 32), ob = __shfl_xor(b2[j], 32); const float ca = cs[2 * j], sa = cs[2 * j + 1], cb = cs[8 + 2 * j], sb = cs[8 + 2 * j + 1];
          a[j] = a[j] * ca + (fq < 2 ? -oa : oa) * sa; b2[j] = b2[j] * cb + (fq < 2 ? -ob : ob) * sb; } }
      *(u32x4*)(base + trow * (MH * MQK) + tcol) = pack8(a, b2);) } };
}

template <class Epi, class Sched> __global__ __launch_bounds__(512, 2) void k_gemm_phase(pg8::GemmG g, Sched S, Epi E) {
  extern __shared__ __attribute__((aligned(16))) unsigned char shm[];
  S.G = gridDim.x; S.c = blockIdx.x;
  pg8::gemm_phase<Epi, Sched>((PG8_LAS unsigned char*)shm, g, S, E);
}
#endif
#ifndef CPU_TEST
namespace ph {
using pg8::f32x4; using pg8::u32x4; using pg8::pack8; using pg8::unpack8;
#define LAS __attribute__((address_space(3)))
__device__ __forceinline__ float wave_sum(float v) { v += __shfl_xor(v, 32); v += __shfl_xor(v, 16); v += __shfl_xor(v, 8); v += __shfl_xor(v, 4); v += __shfl_xor(v, 2); v += __shfl_xor(v, 1); return v; }
__device__ __forceinline__ float wave_max(float v) { v = fmaxf(v, __shfl_xor(v, 32)); v = fmaxf(v, __shfl_xor(v, 16)); v = fmaxf(v, __shfl_xor(v, 8)); v = fmaxf(v, __shfl_xor(v, 4)); v = fmaxf(v, __shfl_xor(v, 2)); v = fmaxf(v, __shfl_xor(v, 1)); return v; }
__device__ __forceinline__ float sum8(const f32x4& a, const f32x4& b) { return ((a[0] + a[1]) + (a[2] + a[3])) + ((b[0] + b[1]) + (b[2] + b[3])); }
__device__ __forceinline__ const float* resid_row(const Params& p, int l, int R) {
  const int b = row_b(R), t = row_t(R); return t < SEQ ? p.in[I_X] + ((long)b * SEQ + t) * DM : p.in[I_CTX] + ((long)b * CTXL + (t - SEQ)) * DM;
}

constexpr int NCH = DM / 512;
static_assert(DM % 512 == 0, "row chunking");
struct RowV { f32x4 a[NCH], b[NCH]; };
__device__ __forceinline__ void row_load(RowV& v, const float* x, int lane) {
#pragma unroll
  for (int c = 0; c < NCH; ++c) { const float* q = x + c * 512 + lane * 8; v.a[c] = *(const f32x4*)q; v.b[c] = *(const f32x4*)(q + 4); } }
__device__ __forceinline__ void row_store(const RowV& v, float* x, int lane) {
#pragma unroll
  for (int c = 0; c < NCH; ++c) { float* q = x + c * 512 + lane * 8; *(f32x4*)q = v.a[c]; *(f32x4*)(q + 4) = v.b[c]; } }
__device__ __forceinline__ void row_load_bf(RowV& v, const bf16_t* x, int lane) {
#pragma unroll
  for (int c = 0; c < NCH; ++c) unpack8(*(const u32x4*)(x + c * 512 + lane * 8), v.a[c], v.b[c]); }
__device__ __forceinline__ void row_store_bf(const RowV& v, bf16_t* x, int lane) {
#pragma unroll
  for (int c = 0; c < NCH; ++c) *(u32x4*)(x + c * 512 + lane * 8) = pack8(v.a[c], v.b[c]); }
__device__ __forceinline__ void resid_load(RowV& v, const Params& p, int l, int R, int lane) {
  if (l == 0) row_load(v, resid_row(p, l, R), lane); else row_load_bf(v, WSP(bf16_t, p, x2) + (long)R * DM, lane);
}
__device__ __forceinline__ void row_stats(const RowV& v, float& mean, float& rstd) {
  float s = 0.f;
#pragma unroll
  for (int c = 0; c < NCH; ++c) s += sum8(v.a[c], v.b[c]);
  mean = wave_sum(s) * (1.f / DM); float q = 0.f;
#pragma unroll
  for (int c = 0; c < NCH; ++c) { const f32x4 da = v.a[c] - mean, db = v.b[c] - mean; q += sum8(da * da, db * db); }
  rstd = 1.f / sqrtf(wave_sum(q) * (1.f / DM) + NORM_EPS);
}
__device__ __forceinline__ void row_modulate_store(const RowV& v, float mean, float rstd, const float* sh, const float* sc, bf16_t* H, int lane) {
#pragma unroll
  for (int c = 0; c < NCH; ++c) { const int o = c * 512 + lane * 8; const f32x4 s0 = *(const f32x4*)(sc + o), s1 = *(const f32x4*)(sc + o + 4), h0 = *(const f32x4*)(sh + o), h1 = *(const f32x4*)(sh + o + 4);
    *(u32x4*)(H + o) = pack8((v.a[c] - mean) * rstd * (1.f + s0) + h0, (v.b[c] - mean) * rstd * (1.f + s1) + h1); } }

__device__ __forceinline__ void ph_ln_in(const Params& p, int l) {
  const int tid_ = ph_tid(), lane = tid_ & 63, wv = tid_ >> 6; const float* mod = WSP(float, p, mod) + (long)l * 18 * DM; bf16_t* H1 = WSP(bf16_t, p, h1);
  for (int R = blockIdx.x * 8 + wv; R < MROWS; R += gridDim.x * 8) { RowV v; resid_load(v, p, l, R, lane); float mean, rstd; row_stats(v, mean, rstd);
    const float* m = mod + (long)row_mod(R) * 6 * DM; row_modulate_store(v, mean, rstd, m, m + DM, H1 + (long)R * DM, lane); }
}
__device__ __forceinline__ void ph_ln1(const Params& p, int l, LAS unsigned char* lds) {
  const int tid_ = ph_tid(), lane = tid_ & 63, wv = tid_ >> 6; const float* mod = WSP(float, p, mod) + (long)l * 18 * DM; const int last = (l == NLAYER - 1);
  LAS float* rwt = (LAS float*)lds;
  { const float* rw = p.in[I_ROUTER] + (long)l * DM * NE; for (int i = tid_; i < DM * NE; i += 512) { const int e = i / DM, d = i % DM; rwt[i] = rw[d * NE + e]; } }
  __syncthreads();
  const bf16_t* Y = WSP(bf16_t, p, macc); bf16_t* X1 = WSP(bf16_t, p, x1); bf16_t* H2 = WSP(bf16_t, p, h2); float* AFF = WSP(float, p, aff);
  const float* lg = p.in[I_LN1G] + l * DM; const float* lb = p.in[I_LN1B] + l * DM;
  for (int R = blockIdx.x * 8 + wv; R < MROWS; R += gridDim.x * 8) { if (last && row_is_ctx(R)) continue;
    const float* m = mod + (long)row_mod(R) * 6 * DM; RowV v, y; resid_load(v, p, l, R, lane);
#pragma unroll
    for (int c = 0; c < NCH; ++c) unpack8(*(const u32x4*)(Y + (long)R * DM + c * 512 + lane * 8), y.a[c], y.b[c]);
#pragma unroll
    for (int c = 0; c < NCH; ++c) { const int o = c * 512 + lane * 8; v.a[c] = DN_ALPHA * v.a[c] + *(const f32x4*)(m + 2 * DM + o) * y.a[c]; v.b[c] = DN_ALPHA * v.b[c] + *(const f32x4*)(m + 2 * DM + o + 4) * y.b[c]; }
    float mean, rstd; row_stats(v, mean, rstd);
#pragma unroll
    for (int c = 0; c < NCH; ++c) { const int o = c * 512 + lane * 8; v.a[c] = (v.a[c] - mean) * rstd * *(const f32x4*)(lg + o) + *(const f32x4*)(lb + o); v.b[c] = (v.b[c] - mean) * rstd * *(const f32x4*)(lg + o + 4) + *(const f32x4*)(lb + o + 4); }
    row_store_bf(v, X1 + (long)R * DM, lane);
    row_stats(v, mean, rstd);
#pragma unroll
    for (int c = 0; c < NCH; ++c) { const int o = c * 512 + lane * 8; v.a[c] = (v.a[c] - mean) * rstd * (1.f + *(const f32x4*)(m + 4 * DM + o)) + *(const f32x4*)(m + 3 * DM + o);
      v.b[c] = (v.b[c] - mean) * rstd * (1.f + *(const f32x4*)(m + 4 * DM + o + 4)) + *(const f32x4*)(m + 3 * DM + o + 4); *(u32x4*)(H2 + (long)R * DM + o) = pack8(v.a[c], v.b[c]); }
    float s[NE];
#pragma unroll
    for (int e = 0; e < NE; ++e) { float a = 0.f;
#pragma unroll
      for (int c = 0; c < NCH; ++c) { const LAS float* q = rwt + e * DM + c * 512 + lane * 8; const f32x4 w0 = *(const LAS f32x4*)q, w1 = *(const LAS f32x4*)(q + 4); a += sum8(v.a[c] * w0, v.b[c] * w1); }
      s[e] = a; }
    static_assert(NE == 16, "router reduce-scatter is written for 16 experts");
    { const bool b5 = lane & 32, b4 = lane & 16, b3 = lane & 8, b2 = lane & 4; float t8[8], t4[4], t2[2];
#pragma unroll
      for (int j = 0; j < 8; ++j) { const float snd = b5 ? s[j] : s[j + 8], kp = b5 ? s[j + 8] : s[j]; t8[j] = kp + __shfl_xor(snd, 32); }
#pragma unroll
      for (int j = 0; j < 4; ++j) { const float snd = b4 ? t8[j] : t8[j + 4], kp = b4 ? t8[j + 4] : t8[j]; t4[j] = kp + __shfl_xor(snd, 16); }
#pragma unroll
      for (int j = 0; j < 2; ++j) { const float snd = b3 ? t4[j] : t4[j + 2], kp = b3 ? t4[j + 2] : t4[j]; t2[j] = kp + __shfl_xor(snd, 8); }
      float lg_ = (b2 ? t2[1] : t2[0]) + __shfl_xor(b2 ? t2[0] : t2[1], 4); lg_ += __shfl_xor(lg_, 2); lg_ += __shfl_xor(lg_, 1);
      const int e = ((lane >> 2) & 1) | (((lane >> 3) & 1) << 1) | (((lane >> 4) & 1) << 2) | (((lane >> 5) & 1) << 3);
      const float mx = wave_max(lg_), ex = expf(lg_ - mx), se = wave_sum(ex) * 0.25f;
      if ((lane & 3) == 0) AFF[(long)R * NE + e] = ex / se; } }
}
__device__ __forceinline__ void ph_ln2(const Params& p, int l) {
  const int tid_ = ph_tid(), lane = tid_ & 63, wv = tid_ >> 6; const float* mod = WSP(float, p, mod) + (long)l * 18 * DM; const int last = (l == NLAYER - 1);
  const bf16_t* X1 = WSP(bf16_t, p, x1); bf16_t* X2 = WSP(bf16_t, p, x2); const int* SLOT = WSP(int, p, slot); const bf16_t* YS = (const bf16_t*)(p.ws + WS.regA + SZ_XS + SZ_ACT); bf16_t* H1 = WSP(bf16_t, p, h1);
  const float* lg = p.in[I_LN2G] + l * DM; const float* lb = p.in[I_LN2B] + l * DM;
  for (int R = blockIdx.x * 8 + wv; R < MROWS; R += gridDim.x * 8) { if (last && row_is_ctx(R)) continue;
    const float* m = mod + (long)row_mod(R) * 6 * DM; RowV v, acc; row_load_bf(v, X1 + (long)R * DM, lane);
#pragma unroll
    for (int c = 0; c < NCH; ++c) { acc.a[c] = (f32x4){0.f, 0.f, 0.f, 0.f}; acc.b[c] = (f32x4){0.f, 0.f, 0.f, 0.f}; }
    const int myslot = lane < NE ? SLOT[(long)R * NE + lane] : -1;
    const float mygate = myslot >= 0 ? WSP(float, p, gatev)[myslot] : 0.f;
    for (int e = 0; e < NE; ++e) { const int s = __shfl(myslot, e); const float gq = __shfl(mygate, e); if (s >= 0) { const bf16_t* yr = YS + (long)s * DM;
#pragma unroll
        for (int c = 0; c < NCH; ++c) { f32x4 t0, t1; unpack8(*(const u32x4*)(yr + c * 512 + lane * 8), t0, t1); acc.a[c] += gq * t0; acc.b[c] += gq * t1; } } }
#pragma unroll
    for (int c = 0; c < NCH; ++c) { const int o = c * 512 + lane * 8; v.a[c] = DN_ALPHA * v.a[c] + *(const f32x4*)(m + 5 * DM + o) * acc.a[c]; v.b[c] = DN_ALPHA * v.b[c] + *(const f32x4*)(m + 5 * DM + o + 4) * acc.b[c]; }
    float mean, rstd; row_stats(v, mean, rstd);
#pragma unroll
    for (int c = 0; c < NCH; ++c) { const int o = c * 512 + lane * 8; v.a[c] = (v.a[c] - mean) * rstd * *(const f32x4*)(lg + o) + *(const f32x4*)(lb + o); v.b[c] = (v.b[c] - mean) * rstd * *(const f32x4*)(lg + o + 4) + *(const f32x4*)(lb + o + 4); }
#ifdef MK_WAITPROBE
    if (last) { const unsigned long long* st = (const unsigned long long*)(p.ws + WS.bar + 14336); const float dus = floorf((float)st[40] * 0.01f / 50.f) * 50.f, sc = 1.f + sqrtf(dus * 1e-4f);
      _Pragma("unroll") for (int c = 0; c < NCH; ++c) { v.a[c] = v.a[c] * sc; v.b[c] = v.b[c] * sc; } }
#endif
#ifdef MK_PROBE_A
    if (last) { const unsigned long long* st = (const unsigned long long*)(p.ws + WS.bar + 14336); const float dus = (float)(st[MK_PROBE_B] - st[MK_PROBE_A]) * 0.01f, sc = 1.f + sqrtf(dus * 1e-4f);
      _Pragma("unroll") for (int c = 0; c < NCH; ++c) { v.a[c] = v.a[c] * sc; v.b[c] = v.b[c] * sc; } }
#endif
    if (last) { row_store(v, p.out + ((long)row_b(R) * SEQ + row_t(R)) * DM, lane); }
    else { row_store_bf(v, X2 + (long)R * DM, lane); row_stats(v, mean, rstd); const float* mn = mod + 18 * DM + (long)row_mod(R) * 6 * DM; row_modulate_store(v, mean, rstd, mn, mn + DM, H1 + (long)R * DM, lane); } }
}

__device__ __forceinline__ void rope8(f32x4& a, f32x4& b, int xorl, bool first, const float* cs  ) {
#pragma unroll
  for (int j = 0; j < 4; ++j) { const float oa = __shfl_xor(a[j], xorl), ob = __shfl_xor(b[j], xorl);
    const float ca = cs[2 * j], sa = cs[2 * j + 1], cb = cs[8 + 2 * j], sb = cs[8 + 2 * j + 1];
    a[j] = a[j] * ca + (first ? -oa : oa) * sa; b[j] = b[j] * cb + (first ? -ob : ob) * sb; } }
__device__ __forceinline__ void ph_post_proj(const Params& p, int l) {
  static_assert(GHD == 128 && RQK == 64 && MROPE == 64 && MQL == 512 && MKVL == 256 && GH == 4 && GKV == 2 && RH == 4, "post_proj lane maps are written for the full-size config");
  const int tid_ = ph_tid(), lane = tid_ & 63, wv = tid_ >> 6; bf16_t* P = WSP(bf16_t, p, regA); bf16_t* KM = WSP(bf16_t, p, km); const float* ta = WSP(float, p, rope_a); const float* tb = WSP(float, p, rope_b);
  for (int R = blockIdx.x * 8 + wv; R < MROWS; R += gridDim.x * 8) { bf16_t* pr = P + (long)R * PW; const int t = row_t(R); const bool lat = t < SEQ; const int gr = lat ? t / GRIDW : 0, gc = lat ? t % GRIDW : 0;
    {
      const int g = lane >> 1, n = row_b(R) * S5NC + t / S5LC, a = t % S5LC; *(u32x4*)(WSP(bf16_t, p, uh) + ((long)g * S5NP + n) * (S5K1 + S5K2) + a * S5CH + (lane & 1) * 8) = *(const u32x4*)(pr + OFF_U + 8 * lane); }
    {
      const int j = lane & 15, hf = j >> 3; const bool first = !(j & 4); const float* cs = ta + ((hf ? gc : gr) * NROPE_A + ((8 * j) & 31)) * 2;
#pragma unroll
      for (int pass = 0; pass < 2; ++pass) { if (pass == 1 && lane >= 32) break; const int h = lane >> 4; bf16_t* x = pr + (pass ? OFF_GK : OFF_GQ) + h * GHD + 8 * j; const float* g = p.in[pass ? I_GKN : I_GQN] + l * GHD + 8 * j;
        f32x4 a, b; unpack8(*(const u32x4*)x, a, b); float ss = sum8(a * a, b * b); ss += __shfl_xor(ss, 8); ss += __shfl_xor(ss, 4); ss += __shfl_xor(ss, 2); ss += __shfl_xor(ss, 1);
        const float r = 1.f / sqrtf(ss * (1.f / GHD) + NORM_EPS); a = a * r * *(const f32x4*)g; b = b * r * *(const f32x4*)(g + 4);
        if (lat) rope8(a, b, 4, first, cs);
        *(u32x4*)x = pack8(a, b); } }
    {
      const int j = lane & 7, hf = j >> 2, h = (lane >> 3) & 3; const bool isk = lane >= 32, first = !(j & 2); bf16_t* x = pr + (isk ? OFF_RK : OFF_RQ) + h * RQK + 8 * j; const float sc = isk ? 0.125f : 1.f;
      f32x4 a, b; unpack8(*(const u32x4*)x, a, b); a = a * sc; b = b * sc;
      if (lat) rope8(a, b, 2, first, tb + ((hf ? gc : gr) * NROPE_B + ((8 * j) & 15)) * 2);
      *(u32x4*)x = pack8(a, b); }
    {
      bf16_t* x = pr + OFF_CQ + 8 * lane; const float* g = p.in[I_MQN] + l * MQL + 8 * lane; f32x4 a, b; unpack8(*(const u32x4*)x, a, b); const float ss = wave_sum(sum8(a * a, b * b));
      const float r = 1.f / sqrtf(ss * (1.f / MQL) + NORM_EPS); *(u32x4*)x = pack8(a * r * *(const f32x4*)g, b * r * *(const f32x4*)(g + 4)); }
    {
      if (lane < 32) { bf16_t* x = pr + OFF_CKV + 8 * lane; const float* g = p.in[I_MKVN] + l * MKVL + 8 * lane; f32x4 a, b; unpack8(*(const u32x4*)x, a, b); float ss = sum8(a * a, b * b);
        ss += __shfl_xor(ss, 16); ss += __shfl_xor(ss, 8); ss += __shfl_xor(ss, 4); ss += __shfl_xor(ss, 2); ss += __shfl_xor(ss, 1);
        const float r = 1.f / sqrtf(ss * (1.f / MKVL) + NORM_EPS); *(u32x4*)x = pack8(a * r * *(const f32x4*)g, b * r * *(const f32x4*)(g + 4)); }
      } }
}

struct ConvMat { bf16_t* dst; const float* src; const float* src2; int K, ld, ndst, nvalid, kind; };
constexpr int NMAT_L = 10 + 2 * NE, NMAT = NLAYER * NMAT_L;
__device__ __forceinline__ ConvMat conv_mat(const Params& p, int mi) {
  const int l = mi / NMAT_L, m = mi % NMAT_L; ConvMat c; c.src2 = nullptr; c.kind = 0;
  if (m == 0) { c.dst = WSP(bf16_t, p, wt_in) + (long)l * PW * DM; c.src = p.in[I_WIN] + (long)l * DM * IN_TOTAL; c.K = DM; c.ld = IN_TOTAL; c.ndst = PW; c.nvalid = IN_TOTAL; }
  else if (m == 1) { c.dst = WSP(bf16_t, p, wt_gate) + (long)l * 4 * DM * DM; c.src = p.in[I_WGATE] + (long)l * DM * 4 * DM; c.K = DM; c.ld = 4 * DM; c.ndst = 4 * DM; c.nvalid = 4 * DM; }
  else if (m < 6) { const int k = m - 2; c.dst = WSP(bf16_t, p, wt_br) + ((long)l * 4 + k) * DM * BW; c.src = p.in[I_WBR] + ((long)l * 4 + k) * BW * DM; c.K = BW; c.ld = DM; c.ndst = DM; c.nvalid = DM; }
  else if (m == 6) { c.dst = WSP(bf16_t, p, wt_out) + (long)l * DM * DM; c.src = p.in[I_WOUT] + (long)l * DM * DM; c.K = DM; c.ld = DM; c.ndst = DM; c.nvalid = DM; }
  else if (m == 7) { c.dst = WSP(bf16_t, p, wt_glu) + (long)l * BW * BW; c.src = p.in[I_S5GLU] + (long)l * BW * BW; c.K = BW; c.ld = BW; c.ndst = BW; c.nvalid = BW; }
  else if (m == 8) { c.dst = WSP(bf16_t, p, wt_uq) + (long)l * MH * MQK * MQL; c.src = p.in[I_WUQ] + (long)l * MQL * MH * MQK; c.K = MQL; c.ld = MH * MQK; c.ndst = MH * MQK; c.nvalid = MH * MQK; }
  else if (m == 9) { c.dst = WSP(bf16_t, p, wt_ukv) + (long)l * MH * (MNOPE + MV) * MKVL; c.src = p.in[I_WUKV] + (long)l * MKVL * MH * (MNOPE + MV); c.K = MKVL; c.ld = MH * (MNOPE + MV); c.ndst = MH * (MNOPE + MV); c.nvalid = c.ndst; }
  else if (m < 10 + NE) { const int e = m - 10; c.dst = WSP(bf16_t, p, wt_gu) + ((long)l * NE + e) * 2 * FF * DM; c.src = p.in[I_MOEG] + ((long)l * NE + e) * DM * FF; c.src2 = p.in[I_MOEU] + ((long)l * NE + e) * DM * FF;
    c.K = DM; c.ld = FF; c.ndst = 2 * FF; c.nvalid = 2 * FF; c.kind = 1; }
  else { const int e = m - 10 - NE; c.dst = WSP(bf16_t, p, wt_dn) + ((long)l * NE + e) * DM * FF; c.src = p.in[I_MOED] + ((long)l * NE + e) * FF * DM; c.K = FF; c.ld = DM; c.ndst = DM; c.nvalid = DM; }
  return c;
}
__device__ __forceinline__ void conv_tile(const ConvMat& c, int t, LAS unsigned* Lb, int tid) {
  const int n = tid & 63, kp = tid >> 6, tk = c.K / 64; const int k0 = (t % tk) * 64, n0 = (t / tk) * 128;
  const float* s; int col0, nval;
  if (c.kind == 1) { const int tile = n0 / 256; s = (n0 & 128) ? c.src2 : c.src; col0 = tile * 128; nval = 128; } else { s = c.src; col0 = n0; nval = c.nvalid - n0; }
  float v[2][4][2];
#pragma unroll
  for (int hh = 0; hh < 2; ++hh)
#pragma unroll
    for (int i = 0; i < 4; ++i) { const int k = 2 * (kp + 8 * i), cn = hh * 64 + n; const bool ok = cn < nval; const float* q = s + (long)(k0 + k) * c.ld + col0 + cn;
      v[hh][i][0] = ok ? q[0] : 0.f; v[hh][i][1] = ok ? q[c.ld] : 0.f; }
#pragma unroll
  for (int hh = 0; hh < 2; ++hh)
#pragma unroll
    for (int i = 0; i < 4; ++i) Lb[(hh * 64 + n) * 33 + kp + 8 * i] = pg8::cvt_pk_bf16(v[hh][i][0], v[hh][i][1]);
  __syncthreads();
#pragma unroll
  for (int hh = 0; hh < 2; ++hh) { const int id = hh * 512 + tid, rn = id >> 3, kc = id & 7; const LAS unsigned* q = Lb + rn * 33 + kc * 4; u32x4 w; w.x = q[0]; w.y = q[1]; w.z = q[2]; w.w = q[3];
    *(u32x4*)(c.dst + (long)(n0 + rn) * c.K + k0 + kc * 8) = w; }
}
constexpr int CONV_CHUNK = 16;
__device__ __forceinline__ void ph_conv(const Params& p, LAS unsigned char* lds, unsigned* counter) {
  const int tid = ph_tid(); LAS unsigned* L = (LAS unsigned*)lds; LAS unsigned* nxt = L + 2 * 128 * 33; int buf = 0;
  int mi = 0; long mbase = 0; ConvMat c = conv_mat(p, 0); long mnt = (long)(c.K / 64) * (c.ndst / 128);
  for (;;) {
    if (tid == 0) *nxt = atomicAdd(counter, 1u);
    __syncthreads(); const long first = (long)(*nxt) * CONV_CHUNK; __syncthreads();
    bool done = false;
    for (int q = 0; q < CONV_CHUNK; ++q) { const long gtile = first + q;
      while (gtile >= mbase + mnt) { mbase += mnt; ++mi; if (mi >= NMAT) { done = true; break; } c = conv_mat(p, mi); mnt = (long)(c.K / 64) * (c.ndst / 128); }
      if (done) break;
      conv_tile(c, (int)(gtile - mbase), L + buf * (128 * 33), tid); buf ^= 1; }
    if (done) break; }
}
__device__ __forceinline__ void ph_mod(const Params& p, LAS unsigned char* lds, int wg) {
  const int tid = ph_tid(); LAS float* sl = (LAS float*)lds; LAS float* part = sl + 3 * DM;
  for (int i = tid; i < 3 * DM; i += 512) { const int r = i / DM, k = i % DM; const float cv = r < 2 ? p.in[I_C][r * DM + k] : p.in[I_CCTX][k]; sl[i] = cv / (1.f + expf(-cv)); }
  __syncthreads();
  const int cg = tid & 31, ks = tid >> 5;
  constexpr int KS = DM / 16, NIT = NLAYER * (6 * DM / 128);
  if (wg >= NIT) return;
  for (int it = wg; it < NIT; it += gridDim.x) { const int l = it / (6 * DM / 128), cb = it % (6 * DM / 128); const float* w = p.in[I_ADAW] + (long)l * DM * 6 * DM + cb * 128 + cg * 4;
    f32x4 a0 = {0.f, 0.f, 0.f, 0.f}, a1 = a0, a2 = a0;
#pragma unroll 8
    for (int k = ks * KS; k < (ks + 1) * KS; ++k) { const f32x4 wv = *(const f32x4*)(w + (long)k * 6 * DM); a0 += sl[k] * wv; a1 += sl[DM + k] * wv; a2 += sl[2 * DM + k] * wv; }
    LAS float* pp = part + (ks * 3) * 128 + cg * 4; *(LAS f32x4*)pp = a0; *(LAS f32x4*)(pp + 128) = a1; *(LAS f32x4*)(pp + 256) = a2;
    __syncthreads();
    if (tid < 384) { const int r = tid / 128, col = tid % 128; float s = 0.f;
#pragma unroll
      for (int q = 0; q < 16; ++q) s += part[(q * 3 + r) * 128 + col];
      WSP(float, p, mod)[((long)l * 3 + r) * 6 * DM + cb * 128 + col] = s + p.in[I_ADAB][(long)l * 6 * DM + cb * 128 + col]; }
    __syncthreads(); }
}
__device__ __forceinline__ void ph_tables(const Params& p) {
  const long gt = (long)blockIdx.x * 512 + ph_tid(), gs = (long)gridDim.x * 512;
  float* ta = WSP(float, p, rope_a); float* tb = WSP(float, p, rope_b);
  for (long i = gt; i < (long)GRIDW * (NROPE_A + NROPE_B); i += gs) { const int pos = (int)(i / (NROPE_A + NROPE_B)), k = (int)(i % (NROPE_A + NROPE_B));
    if (k < NROPE_A) { const float a = pos * powf(10000.f, -(float)k / NROPE_A); ta[(pos * NROPE_A + k) * 2] = cosf(a); ta[(pos * NROPE_A + k) * 2 + 1] = sinf(a); }
    else { const int kk = k - NROPE_A; const float a = pos * powf(10000.f, -(float)kk / NROPE_B); tb[(pos * NROPE_B + kk) * 2] = cosf(a); tb[(pos * NROPE_B + kk) * 2 + 1] = sinf(a); } }
  for (long i = gt; i < DM / 2; i += gs) WSP(unsigned, p, zrow)[i] = 0u;
  float* tab = WSP(float, p, s5tab);
  for (long i = gt; i < (long)NLAYER * 2 * S5G * S5P; i += gs) { const int pp = (int)(i % S5P), g = (int)((i / S5P) % S5G), dir = (int)((i / (S5P * S5G)) % 2), l = (int)(i / (2 * S5P * S5G));
    const float a_re = p.in[dir ? I_S5AREB : I_S5AREF][(l * S5G + g) * S5P + pp], a_im = p.in[dir ? I_S5AIMB : I_S5AIMF][(l * S5G + g) * S5P + pp];
    const float dt = expf(p.in[dir ? I_S5DTB : I_S5DTF][l * S5G + g]);
    const float mag = expf(a_re * dt), ab_re = mag * cosf(a_im * dt), ab_im = mag * sinf(a_im * dt);
    const float den = a_re * a_re + a_im * a_im, nr = ab_re - 1.f, ni = ab_im;
    const float cr = (nr * a_re + ni * a_im) / den, ci = (ni * a_re - nr * a_im) / den;
    float* t = tab + i * S5TW; t[0] = ab_re; t[1] = ab_im;
    for (int c = 0; c < S5CH; ++c) { const float br = p.in[I_S5BRE][((l * S5G + g) * S5P + pp) * S5CH + c], bi = p.in[I_S5BIM][((l * S5G + g) * S5P + pp) * S5CH + c];
      t[2 + c] = cr * br - ci * bi; t[2 + S5CH + c] = cr * bi + ci * br; } }
}

__device__ __forceinline__ void ph_s5tables(const Params& p, LAS unsigned char* lds) {
  const int tid = ph_tid(); LAS float* pw = (LAS float*)lds; LAS float* bb = pw + 2 * S5P * (S5LC + 1) * 2; LAS float* cc = bb + 2 * S5P * S5CH * 2; LAS float* T = cc + S5CH * S5P * 2;
  for (int item = blockIdx.x; item < NLAYER * S5G; item += gridDim.x) { const int l = item / S5G, g = item % S5G;
    for (int i = tid; i < 2 * S5P; i += 512) { const int dir = i / S5P, pp = i % S5P;
      const double a_re = p.in[dir ? I_S5AREB : I_S5AREF][(l * S5G + g) * S5P + pp], a_im = p.in[dir ? I_S5AIMB : I_S5AIMF][(l * S5G + g) * S5P + pp], dt = exp((double)p.in[dir ? I_S5DTB : I_S5DTF][l * S5G + g]);
      for (int k = 0; k <= S5LC; ++k) { const double mag = exp(a_re * dt * k), ang = a_im * dt * k; pw[((dir * S5P + pp) * (S5LC + 1) + k) * 2] = (float)(mag * cos(ang)); pw[((dir * S5P + pp) * (S5LC + 1) + k) * 2 + 1] = (float)(mag * sin(ang)); }
      const double mag = exp(a_re * dt), abr = mag * cos(a_im * dt), abi = mag * sin(a_im * dt), den = a_re * a_re + a_im * a_im, nr = abr - 1.0, ni = abi, cr = (nr * a_re + ni * a_im) / den, ci = (ni * a_re - nr * a_im) / den;
      for (int c = 0; c < S5CH; ++c) { const double br = p.in[I_S5BRE][((l * S5G + g) * S5P + pp) * S5CH + c], bi = p.in[I_S5BIM][((l * S5G + g) * S5P + pp) * S5CH + c];
        bb[((dir * S5P + pp) * S5CH + c) * 2] = (float)(cr * br - ci * bi); bb[((dir * S5P + pp) * S5CH + c) * 2 + 1] = (float)(cr * bi + ci * br); } }
    for (int i = tid; i < S5CH * S5P; i += 512) { cc[2 * i] = p.in[I_S5CRE][(long)(l * S5G + g) * S5CH * S5P + i]; cc[2 * i + 1] = p.in[I_S5CIM][(long)(l * S5G + g) * S5CH * S5P + i]; }
    __syncthreads();
    for (int e = tid; e < (2 * S5LC - 1) * S5CH * S5CH; e += 512) { const int tau = e / (S5CH * S5CH) - (S5LC - 1), i = (e % (S5CH * S5CH)) / S5CH, c = e % S5CH; float s = 0.f;
      for (int dir = 0; dir < 2; ++dir) { if (dir == 0 ? tau < 0 : tau > 0) continue; const int k = tau < 0 ? -tau : tau;
        for (int pp = 0; pp < S5P; ++pp) { const float cr_ = cc[(i * S5P + pp) * 2], ci_ = cc[(i * S5P + pp) * 2 + 1], ar = pw[((dir * S5P + pp) * (S5LC + 1) + k) * 2], ai = pw[((dir * S5P + pp) * (S5LC + 1) + k) * 2 + 1];
          const float br = bb[((dir * S5P + pp) * S5CH + c) * 2], bi = bb[((dir * S5P + pp) * S5CH + c) * 2 + 1]; const float zr = ar * br - ai * bi, zi = ar * bi + ai * br; s += cr_ * zr - ci_ * zi; } }
      T[e] = s; }
    __syncthreads();
    bf16_t* SW = WSP(bf16_t, p, s5sw) + (long)item * S5K2 * S5K1; bf16_t* SV = WSP(bf16_t, p, s5sv) + (long)item * S5K1 * (S5K1 + S5K2);
    for (int e = tid; e < S5K2 * S5K1; e += 512) { const int r = e / S5K1, col = e % S5K1, dir = r / (2 * S5P), pp = (r % (2 * S5P)) / 2, im = r & 1, a = col / S5CH, c = col % S5CH; const int k = dir ? a : (S5LC - 1 - a);
      const float ar = pw[((dir * S5P + pp) * (S5LC + 1) + k) * 2], ai = pw[((dir * S5P + pp) * (S5LC + 1) + k) * 2 + 1], br = bb[((dir * S5P + pp) * S5CH + c) * 2], bi = bb[((dir * S5P + pp) * S5CH + c) * 2 + 1];
      SW[e] = f2bf(im ? ar * bi + ai * br : ar * br - ai * bi); }
    for (int e = tid; e < S5K1 * (S5K1 + S5K2); e += 512) { const int r = e / (S5K1 + S5K2), k = e % (S5K1 + S5K2), a = r / S5CH, i = r % S5CH; float v;
      if (k < S5K1) { const int a2 = k / S5CH, c = k % S5CH; v = T[((a - a2) + (S5LC - 1)) * S5CH * S5CH + i * S5CH + c]; }
      else { const int kk = k - S5K1, dir = kk / (2 * S5P), pp = (kk % (2 * S5P)) / 2, im = kk & 1, pk = dir ? (S5LC - a) : (a + 1);
        const float cr_ = cc[(i * S5P + pp) * 2], ci_ = cc[(i * S5P + pp) * 2 + 1], ar = pw[((dir * S5P + pp) * (S5LC + 1) + pk) * 2], ai = pw[((dir * S5P + pp) * (S5LC + 1) + pk) * 2 + 1];
        v = im ? -(cr_ * ai + ci_ * ar) : (cr_ * ar - ci_ * ai); }
      SV[e] = f2bf(v); }
    __syncthreads(); }
}
__device__ __forceinline__ void ph_s5scan(const Params& p, int l) {
  const float* tab = WSP(float, p, s5tab); const float* E = WSP(float, p, s5e); bf16_t* UH = WSP(bf16_t, p, uh);
  for (long i = (long)blockIdx.x * 512 + ph_tid(); i < (long)NB * S5G * 2 * S5P; i += (long)gridDim.x * 512) { const int pp = (int)(i % S5P), dir = (int)((i / S5P) % 2), g = (int)((i / (2 * S5P)) % S5G), b = (int)(i / (2 * S5P * S5G));
    const float* t = tab + ((((long)l * 2 + dir) * S5G + g) * S5P + pp) * S5TW; float ar = t[0], ai = t[1];
#pragma unroll
    for (int q = 0; q < 4; ++q) { const float nr = ar * ar - ai * ai, ni = 2.f * ar * ai; ar = nr; ai = ni; }
    float hr = 0.f, hi = 0.f; constexpr int NCX = CTXL / S5LC, NLT = SEQ / S5LC;
    for (int s0 = 0; s0 < S5NC; s0 += 8) { float er[8], ei[8]; long idx[8];
#pragma unroll
      for (int q = 0; q < 8; ++q) { const int s = s0 + q; const int j = dir == 0 ? (s < NCX ? NLT + s : s - NCX) : (s < NCX ? S5NC - 1 - s : NLT - 1 - (s - NCX)); idx[q] = (long)g * S5NP + b * S5NC + j;
        const float2 ev = *(const float2*)(E + idx[q] * S5K2 + dir * 2 * S5P + pp * 2); er[q] = ev.x; ei[q] = ev.y; }
#pragma unroll
      for (int q = 0; q < 8; ++q) { *(unsigned*)(UH + idx[q] * (S5K1 + S5K2) + S5K1 + dir * 2 * S5P + pp * 2) = pg8::cvt_pk_bf16(hr, hi);
        const float nr = ar * hr - ai * hi + er[q], ni = ar * hi + ai * hr + ei[q]; hr = nr; hi = ni; } } }
}

__device__ __forceinline__ void ph_merge_ctx(const Params& p) {
  const bf16_t* GC = WSP(bf16_t, p, gctx); const bf16_t* PROJ = (const bf16_t*)(p.ws + WS.regA + SZ_P); bf16_t* MG = WSP(bf16_t, p, merged);
  for (long i = (long)blockIdx.x * 512 + ph_tid(); i < (long)NB * CTXL * DM / 8; i += (long)gridDim.x * 512) { const int r = (int)(i / (DM / 8)), d = (int)(i % (DM / 8)) * 8; const long R = (long)(r / CTXL) * NTOK + SEQ + r % CTXL;
    f32x4 s0 = {0.f, 0.f, 0.f, 0.f}, s1 = s0;
#pragma unroll
    for (int k = 0; k < 4; ++k) { f32x4 g0, g1, q0, q1; unpack8(*(const u32x4*)(GC + (long)r * 4 * DM + k * DM + d), g0, g1); unpack8(*(const u32x4*)(PROJ + R * 4 * DM + k * DM + d), q0, q1); s0 += g0 * q0; s1 += g1 * q1; }
    *(u32x4*)(MG + R * DM + d) = pack8(s0, s1); }
}

__device__ __forceinline__ void ph_kr_combine(const Params& p) {
  const float* KRP = WSP(float, p, krp); bf16_t* KM = WSP(bf16_t, p, km); const float* tb = WSP(float, p, rope_b);
  for (long i = (long)blockIdx.x * 512 + ph_tid(); i < (long)MROWS * (MROPE / 8); i += (long)gridDim.x * 512) { const int R = (int)(i / (MROPE / 8)), c = (int)(i % (MROPE / 8)), t = row_t(R);
    const float* q0 = KRP + (long)R * MROPE; const float* q1 = q0 + (long)MROWS * MROPE;
    f32x4 a = *(const f32x4*)(q0 + 8 * c) + *(const f32x4*)(q1 + 8 * c), b = *(const f32x4*)(q0 + 8 * c + 4) + *(const f32x4*)(q1 + 8 * c + 4);
    if (t < SEQ) { const int cp = c ^ 2; const f32x4 oa = *(const f32x4*)(q0 + 8 * cp) + *(const f32x4*)(q1 + 8 * cp), ob = *(const f32x4*)(q0 + 8 * cp + 4) + *(const f32x4*)(q1 + 8 * cp + 4);
      const bool first = !(c & 2); const int hf = c >> 2; const float* cs = tb + ((hf ? t % GRIDW : t / GRIDW) * NROPE_B + ((8 * c) & 15)) * 2;
#pragma unroll
      for (int j = 0; j < 4; ++j) { a[j] = a[j] * cs[2 * j] + (first ? -oa[j] : oa[j]) * cs[2 * j + 1]; b[j] = b[j] * cs[8 + 2 * j] + (first ? -ob[j] : ob[j]) * cs[8 + 2 * j + 1]; } }
    const u32x4 w = pack8(a, b);
#pragma unroll
    for (int h = 0; h < MH; ++h) *(u32x4*)(KM + (long)R * MH * MQK + h * MQK + MNOPE + 8 * c) = w; }
}
__device__ __forceinline__ void ph_topk(const Params& p, int l, LAS unsigned char* lds) {
  const int tid = ph_tid(), lane = tid & 63, wv = tid >> 6; LAS unsigned* hist = (LAS unsigned*)lds; LAS unsigned* sh = hist + 256;
  const float* AFF = WSP(float, p, aff); int* SLOT = WSP(int, p, slot); float* GV = WSP(float, p, gatev); int* XSRC = WSP(int, p, xsrc);
  const int nprob = (l == 0 ? 4 : 2) * NE; constexpr int KPT = SEQ / 512;
  for (int pr = blockIdx.x; pr < nprob; pr += gridDim.x) { const int set = pr / NE, e = pr % NE, b = set & 1; const bool lat = set < 2; const int n = lat ? SEQ : CTXL, cap = lat ? CAP_L : CAP_C, R0 = b * NTOK + (lat ? 0 : SEQ);
    unsigned key[KPT];
#pragma unroll
    for (int k = 0; k < KPT; ++k) { const int i = tid + 512 * k; key[k] = i < n ? __float_as_uint(AFF[(long)(R0 + i) * NE + e]) : 0u; }
    unsigned prefix = 0u, mask = 0u, remaining = (unsigned)cap;
    for (int pass = 0; pass < 4; ++pass) { const int shift = 24 - 8 * pass;
      if (tid < 256) hist[tid] = 0u; __syncthreads();
#pragma unroll
      for (int k = 0; k < KPT; ++k) { const int i = tid + 512 * k; if (i < n && (key[k] & mask) == prefix) atomicAdd((unsigned*)&hist[(key[k] >> shift) & 255u], 1u); }
      __syncthreads();
      if (wv == 0) {
        unsigned h0 = hist[255 - 4 * lane], h1 = hist[254 - 4 * lane], h2 = hist[253 - 4 * lane], h3 = hist[252 - 4 * lane]; const unsigned tot = h0 + h1 + h2 + h3; unsigned inc = tot;
#pragma unroll
        for (int o = 1; o < 64; o <<= 1) { const unsigned t = __shfl_up(inc, o); if (lane >= o) inc += t; }
        const unsigned exc = inc - tot; const bool hit = exc < remaining && inc >= remaining; const unsigned long long bm = __ballot(hit);
        if (bm == 0ull) { if (lane == 0) { sh[0] = 0u; sh[1] = remaining; } }
        else if (lane == (int)__builtin_ctzll(bm)) { unsigned cum = exc; int d = 255 - 4 * lane;
          if (cum + h0 < remaining) { cum += h0; --d; if (cum + h1 < remaining) { cum += h1; --d; if (cum + h2 < remaining) { cum += h2; --d; } } }
          sh[0] = (unsigned)d; sh[1] = remaining - cum; } }
      __syncthreads();
      prefix |= sh[0] << shift; mask |= 0xFFu << shift; remaining = sh[1]; __syncthreads(); }
    const unsigned T = prefix, need_eq = remaining;
    unsigned base_gt = 0u, base_eq = 0u; int slotv[KPT];
#pragma unroll
    for (int k = 0; k < KPT; ++k) { const int i = tid + 512 * k; const bool gt = i < n && key[k] > T, eq = i < n && key[k] == T;
      const unsigned long long bg = __ballot(gt), be = __ballot(eq), lt = (1ull << lane) - 1ull;
      if (lane == 0) { sh[8 + wv] = (unsigned)__popcll(bg); sh[16 + wv] = (unsigned)__popcll(be); } __syncthreads();
      unsigned pg = 0u, pe = 0u, tg = 0u, te = 0u;
#pragma unroll
      for (int w = 0; w < 8; ++w) { const unsigned a = sh[8 + w], c = sh[16 + w]; pg += w < wv ? a : 0u; pe += w < wv ? c : 0u; tg += a; te += c; }
      const unsigned rg = base_gt + pg + (unsigned)__popcll(bg & lt), re = base_eq + pe + (unsigned)__popcll(be & lt);
      slotv[k] = gt ? (int)rg : (eq && re < need_eq ? -2 - (int)re : -1);
      base_gt += tg; base_eq += te; __syncthreads(); }
    const int xbase = e * XEP + (lat ? b * CAP_L : 2 * CAP_L + b * CAP_C);
#pragma unroll
    for (int k = 0; k < KPT; ++k) { const int i = tid + 512 * k; if (i < n) { int s = slotv[k]; if (s <= -2) s = (int)base_gt + (-2 - s);
        const long R = R0 + i; if (s >= 0) { const int xr = xbase + s; SLOT[R * NE + e] = xr; GV[xr] = __uint_as_float(key[k]); XSRC[xr] = (int)R; } else SLOT[R * NE + e] = -1; } }
    if (set == 3) for (int i = tid; i < XEP - XE; i += 512) XSRC[e * XEP + XE + i] = -1;
    __syncthreads(); }
}
__device__ __forceinline__ void ph_gather(const Params& p, int l) {
  const int tid_ = ph_tid(), lane = tid_ & 63, wv = tid_ >> 6; const int* XSRC = WSP(int, p, xsrc); const bf16_t* H2 = WSP(bf16_t, p, h2); bf16_t* XS = WSP(bf16_t, p, regA);
  const int rows_e = (l == 0) ? XEP : 2 * CAP_L, total = NE * rows_e;
  for (int it = blockIdx.x * 8 + wv; it < total; it += gridDim.x * 8) { const int e = it / rows_e, xr = e * XEP + it % rows_e; const int src = XSRC[xr];
#pragma unroll
    for (int c = 0; c < NCH; ++c) { const int o = c * 512 + lane * 8; u32x4 w = {0u, 0u, 0u, 0u}; if (src >= 0) w = *(const u32x4*)(H2 + (long)src * DM + o); *(u32x4*)(XS + (long)xr * DM + o) = w; } }
}
}
#endif
#ifndef CPU_TEST
namespace att {
#ifndef ATT_SD_MLA
#define ATT_SD_MLA 1
#endif
#ifndef ATT_SD_GQA
#define ATT_SD_GQA 2
#endif
using bf16x8 = __attribute__((ext_vector_type(8))) short;
using s16x4  = __attribute__((ext_vector_type(4))) short;
using f32x16 = __attribute__((ext_vector_type(16))) float;
using u32x4  = __attribute__((ext_vector_type(4))) unsigned;
constexpr int DV = 128, NW = 8, QBLK = 32, KVBLK = 64;
constexpr float THR = 8.f;
#define ATT_SBAR() __builtin_amdgcn_sched_barrier(0)
__device__ __forceinline__ int crow(int r, int hi) { return (r & 3) + 8 * (r >> 2) + 4 * hi; }
__device__ __forceinline__ unsigned cvtpk(float lo, float hi) { unsigned r; asm volatile("v_cvt_pk_bf16_f32 %0, %1, %2" : "=v"(r) : "v"(lo), "v"(hi)); return r; }
template <int DQK> constexpr size_t shm_k() { return (size_t)KVBLK * DQK * 2; }
constexpr size_t SHM_V = KVBLK * DV * 2;
constexpr int QL_PITCH = 144;
template <int DQK> constexpr size_t shm_attn() { return 2 * SHM_V + 2 * shm_k<DQK>() + NW * 64 * 4 + (DQK > 128 ? 256 * QL_PITCH : 0); }

__device__ __forceinline__ void partialSM(f32x16& p0, f32x16& p1, float& m_reg, float& mn, float& alpha, const float C, const float thr_raw) {
  float pmax = p0[0];
#pragma unroll
  for (int r = 1; r < 16; ++r) pmax = fmaxf(pmax, p0[r]);
#pragma unroll
  for (int r = 0; r < 16; ++r) pmax = fmaxf(pmax, p1[r]);
  { auto rr = __builtin_amdgcn_permlane32_swap(__float_as_uint(pmax), __float_as_uint(pmax), false, false);
    pmax = fmaxf(__uint_as_float(rr[0]), __uint_as_float(rr[1])); }
  if (__builtin_expect(__all(pmax - m_reg <= thr_raw), 1)) { mn = m_reg; alpha = 1.f; }
  else { mn = fmaxf(m_reg, pmax); alpha = __builtin_amdgcn_exp2f((m_reg - mn) * C); m_reg = mn; }
  const float mnC = -mn * C;
#pragma unroll
  for (int r = 0; r < 16; ++r) p0[r] = fmaf(p0[r], C, mnC);
#pragma unroll
  for (int r = 0; r < 16; ++r) p1[r] = fmaf(p1[r], C, mnC);
#pragma unroll
  for (int r = 0; r < 16; ++r) p0[r] = __builtin_amdgcn_exp2f(p0[r]);
}
__device__ __forceinline__ void finishSM(f32x16& p0, f32x16& p1, float alpha, float& l_reg, bf16x8& pa0, bf16x8& pa1, bf16x8& pa2, bf16x8& pa3) {
#pragma unroll
  for (int r = 0; r < 16; ++r) p1[r] = __builtin_amdgcn_exp2f(p1[r]);
  float ps = 0;
#pragma unroll
  for (int r = 0; r < 16; ++r) ps += p0[r];
#pragma unroll
  for (int r = 0; r < 16; ++r) ps += p1[r];
  { auto rr = __builtin_amdgcn_permlane32_swap(__float_as_uint(ps), __float_as_uint(ps), false, false);
    ps = __uint_as_float(rr[0]) + __uint_as_float(rr[1]); }
  l_reg = l_reg * alpha + ps;
#define ATT_PK4(P, BASE, OUT) do { unsigned a0 = cvtpk(P[BASE + 0], P[BASE + 1]), a1 = cvtpk(P[BASE + 2], P[BASE + 3]);   \
    unsigned b0 = cvtpk(P[BASE + 4], P[BASE + 5]), b1 = cvtpk(P[BASE + 6], P[BASE + 7]);                              \
    auto r0 = __builtin_amdgcn_permlane32_swap(a0, b0, false, false); auto r1 = __builtin_amdgcn_permlane32_swap(a1, b1, false, false); \
    u32x4 w = {r0[0], r1[0], r0[1], r1[1]}; OUT = *reinterpret_cast<bf16x8*>(&w); } while (0)
  ATT_PK4(p0, 0, pa0); ATT_PK4(p0, 8, pa1); ATT_PK4(p1, 0, pa2); ATT_PK4(p1, 8, pa3);
#undef ATT_PK4
}
__device__ __forceinline__ bf16x8 bl(__amdgpu_buffer_rsrc_t r, int voff, int soff) { const u32x4 w = __builtin_amdgcn_raw_buffer_load_b128(r, voff, soff, 0); return *reinterpret_cast<const bf16x8*>(&w); }
template <int DQK> __device__ __forceinline__ int kswz(int row, int colB) { return row * (DQK * 2) + (colB ^ ((row & 7) << 4)); }
template <int DQK, int QL> __device__ __forceinline__ void qkt(f32x16& p0, f32x16& p1, const char* Ks, const bf16x8* qr, const char* qlds, const int (&ka)[4]) {
  p0 = f32x16{}; p1 = f32x16{};
#pragma unroll
  for (int d0 = 0; d0 < DQK / 16; ++d0) { const char* kp = Ks + ka[d0 & 3] + (d0 >> 2) * 128;
    bf16x8 b0 = *reinterpret_cast<const bf16x8*>(kp);
    bf16x8 b1 = *reinterpret_cast<const bf16x8*>(kp + 32 * DQK * 2);
    const bf16x8 q = (d0 < DQK / 16 - QL) ? qr[d0] : *reinterpret_cast<const bf16x8*>(qlds + (d0 - (DQK / 16 - QL)) * 32);
    p0 = __builtin_amdgcn_mfma_f32_32x32x16_bf16(b0, q, p0, 0, 0, 0);
    p1 = __builtin_amdgcn_mfma_f32_32x32x16_bf16(b1, q, p1, 0, 0, 0); }
}
__device__ __forceinline__ int v_st(int k, int c) { const int kk = (k & ~0xC) | ((k & 4) << 1) | ((k & 8) >> 1); return ((kk >> 3) * 4 + (c >> 5)) * 512 + ((kk & 7) * 32 + (c & 31)) * 2; }
__device__ __forceinline__ int v_rd_base(int lane) { return ((lane & 3) << 3) | (((lane >> 2) & 3) << 6) | (((lane >> 4) & 1) << 5) | (((lane >> 5) & 1) << 8); }
constexpr int v_rd_off(int d0, int ks, int half) { return d0 * 512 + ks * 4096 + half * 2048; }
template <int OFF> __device__ __forceinline__ s16x4 tr_read(int vb) {
  s16x4 r; asm volatile("ds_read_b64_tr_b16 %0, %1 offset:%2" : "=&v"(r) : "v"(vb), "i"(OFF) : "memory"); return r;
}
template <int D0> __device__ __forceinline__ void pv_one(f32x16& od, int vb, bf16x8 pa0, bf16x8 pa1, bf16x8 pa2, bf16x8 pa3) {
  const s16x4 l0 = tr_read<v_rd_off(D0, 0, 0)>(vb), h0 = tr_read<v_rd_off(D0, 0, 1)>(vb), l1 = tr_read<v_rd_off(D0, 1, 0)>(vb), h1 = tr_read<v_rd_off(D0, 1, 1)>(vb);
  const s16x4 l2 = tr_read<v_rd_off(D0, 2, 0)>(vb), h2 = tr_read<v_rd_off(D0, 2, 1)>(vb), l3 = tr_read<v_rd_off(D0, 3, 0)>(vb), h3 = tr_read<v_rd_off(D0, 3, 1)>(vb);
  asm volatile("s_waitcnt lgkmcnt(0)" ::: "memory"); ATT_SBAR();
#define ATT_PK(L, H) (bf16x8){L[0], L[1], L[2], L[3], H[0], H[1], H[2], H[3]}
  od = __builtin_amdgcn_mfma_f32_32x32x16_bf16(pa0, ATT_PK(l0, h0), od, 0, 0, 0);
  od = __builtin_amdgcn_mfma_f32_32x32x16_bf16(pa1, ATT_PK(l1, h1), od, 0, 0, 0);
  od = __builtin_amdgcn_mfma_f32_32x32x16_bf16(pa2, ATT_PK(l2, h2), od, 0, 0, 0);
  od = __builtin_amdgcn_mfma_f32_32x32x16_bf16(pa3, ATT_PK(l3, h3), od, 0, 0, 0);
#undef ATT_PK
}
__device__ __forceinline__ void pv_d0(f32x16* o, int vb, bf16x8 pa0, bf16x8 pa1, bf16x8 pa2, bf16x8 pa3) {
  pv_one<0>(o[0], vb, pa0, pa1, pa2, pa3); pv_one<1>(o[1], vb, pa0, pa1, pa2, pa3); pv_one<2>(o[2], vb, pa0, pa1, pa2, pa3); pv_one<3>(o[3], vb, pa0, pa1, pa2, pa3);
}
template <int DQK, int LDQ, int LDK, int LDV, int LDO, int SDEPTH, int QL>
__device__ __forceinline__ void attn_body(const bf16_t* __restrict__ Qb, const bf16_t* __restrict__ Kh, const bf16_t* __restrict__ Vh, bf16_t* __restrict__ Ob, int seq, char* lds, const float scale) {
  constexpr int NKC = DQK / 64;
  constexpr size_t SHM_K = shm_k<DQK>();
  const float C = scale * 1.4426950408889634f, thr_raw = THR / scale;
  const int tid = ph_tid(), wid = tid >> 6, lane = tid & 63, r32 = lane & 31, hi = lane >> 5;
  char* V_lds = lds; char* K_lds = lds + 2 * SHM_V;
  float* wsf = (float*)(lds + 2 * SHM_V + 2 * SHM_K) + wid * 64; float* li_l = wsf; float* al_l = wsf + 32;
  float m_reg = -1e30f, l_reg = 0; f32x16 o[4] = {}; bf16x8 qr[DQK / 16 - QL];
  const bf16_t* Qw = Qb + (long)(wid * QBLK + r32) * LDQ + hi * 8;
#pragma unroll
  for (int d0 = 0; d0 < DQK / 16 - QL; ++d0) qr[d0] = *reinterpret_cast<const bf16x8*>(Qw + d0 * 16);
  char* qlds = lds + 2 * SHM_V + 2 * SHM_K + NW * 64 * 4 + (wid * QBLK + r32) * QL_PITCH + hi * 16;
#pragma unroll
  for (int d0 = 0; d0 < QL; ++d0) *reinterpret_cast<bf16x8*>(qlds + d0 * 32) = *reinterpret_cast<const bf16x8*>(Qw + (DQK / 16 - QL + d0) * 16);
  const int sr = tid >> 4, sc = (tid & 15) * 8, vst0 = v_st(sr, sc), vst1 = v_st(32 + sr, sc);
  int kgo[NKC], klo[NKC];
#pragma unroll
  for (int i = 0; i < NKC; ++i) { const int c = tid + 512 * i, kr = c / (DQK / 8), kc = (c % (DQK / 8)) * 8; kgo[i] = kr * LDK + kc; klo[i] = kswz<DQK>(kr, kc * 2); }
  const int vgo = sr * LDV + sc;
  int ka[4];
#pragma unroll
  for (int q = 0; q < 4; ++q) ka[q] = r32 * (DQK * 2) + ((q * 32 + hi * 16) ^ ((r32 & 7) << 4));
  const __amdgpu_buffer_rsrc_t rK = __builtin_amdgcn_make_buffer_rsrc((void*)Kh, 0, 0x7ffffffc, 0x00020000), rV = __builtin_amdgcn_make_buffer_rsrc((void*)Vh, 0, 0x7ffffffc, 0x00020000);
  const int vb0 = (int)(uintptr_t)V_lds + v_rd_base(lane);
  struct { bf16x8 vs0, vs1, ks[NKC]; } sr_[SDEPTH];
#define ATT_SLOAD(i, k0) do { const int _vo = (k0) * (LDV * 2), _ko = (k0) * (LDK * 2); sr_[i].vs0 = bl(rV, vgo * 2, _vo); sr_[i].vs1 = bl(rV, vgo * 2 + 64 * LDV, _vo); \
    _Pragma("unroll") for (int _c = 0; _c < NKC; ++_c) sr_[i].ks[_c] = bl(rK, kgo[_c] * 2, _ko); } while (0)
#define ATT_SWRITE(b, i) do { *(bf16x8*)(V_lds + (b) * SHM_V + vst0) = sr_[i].vs0; *(bf16x8*)(V_lds + (b) * SHM_V + vst1) = sr_[i].vs1; \
    _Pragma("unroll") for (int _c = 0; _c < NKC; ++_c) *(bf16x8*)(K_lds + (b) * SHM_K + klo[_c]) = sr_[i].ks[_c]; } while (0)
#define ATT_SWAIT() asm volatile("s_waitcnt vmcnt(%0)" :: "n"(SDEPTH == 2 ? 2 + NKC : 0) : "memory")
#define ATT_RESC(a) do { if (__any((a) < 1.f)) { if (hi == 0) al_l[r32] = (a); asm volatile("s_waitcnt lgkmcnt(0)" ::: "memory"); \
    _Pragma("unroll") for (int d = 0; d < 4; ++d) _Pragma("unroll") for (int r = 0; r < 16; ++r) o[d][r] *= al_l[crow(r, hi)]; } } while (0)
  f32x16 pA0, pA1, pB0, pB1; float mnA, mnB, alA, alB; bf16x8 pa0, pa1, pa2, pa3; const int NT = seq / KVBLK;
  constexpr int SE = 0, SO = SDEPTH - 1;
  ATT_SLOAD(SE, 0); asm volatile("s_waitcnt vmcnt(0)" ::: "memory"); ATT_SWRITE(0, SE); __syncthreads();
  qkt<DQK, QL>(pA0, pA1, K_lds, qr, qlds, ka); partialSM(pA0, pA1, m_reg, mnA, alA, C, thr_raw);
  ATT_SLOAD(SO, KVBLK); if (SDEPTH == 2) { if (2 < NT) ATT_SLOAD(SE, 2 * KVBLK); }
  ATT_SWAIT(); ATT_SWRITE(1, SO); __syncthreads();
  for (int j = 1; j + 1 < NT; j += 2) {
    ATT_SBAR(); qkt<DQK, QL>(pB0, pB1, K_lds + SHM_K, qr, qlds, ka);
    finishSM(pA0, pA1, alA, l_reg, pa0, pa1, pa2, pa3); ATT_SBAR();
    ATT_SLOAD(SO, (j + SDEPTH) * KVBLK); ATT_SBAR();
    pv_d0(o, vb0, pa0, pa1, pa2, pa3); partialSM(pB0, pB1, m_reg, mnB, alB, C, thr_raw);
    __syncthreads(); ATT_SWAIT(); ATT_SWRITE(0, SE);
    ATT_RESC(alB); __syncthreads();
    ATT_SBAR(); qkt<DQK, QL>(pA0, pA1, K_lds, qr, qlds, ka);
    finishSM(pB0, pB1, alB, l_reg, pa0, pa1, pa2, pa3); ATT_SBAR();
    if (SDEPTH == 1 || j + 3 < NT) ATT_SLOAD(SE, (j + 1 + SDEPTH) * KVBLK); ATT_SBAR();
    pv_d0(o, vb0 + (int)SHM_V, pa0, pa1, pa2, pa3); partialSM(pA0, pA1, m_reg, mnA, alA, C, thr_raw);
    __syncthreads(); ATT_SWAIT(); ATT_SWRITE(1, SO);
    ATT_RESC(alA); __syncthreads();
  }
  ATT_SBAR(); qkt<DQK, QL>(pB0, pB1, K_lds + SHM_K, qr, qlds, ka);
  finishSM(pA0, pA1, alA, l_reg, pa0, pa1, pa2, pa3); ATT_SBAR();
  pv_d0(o, vb0, pa0, pa1, pa2, pa3); partialSM(pB0, pB1, m_reg, mnB, alB, C, thr_raw);
  __syncthreads(); ATT_RESC(alB);
  finishSM(pB0, pB1, alB, l_reg, pa0, pa1, pa2, pa3); ATT_SBAR();
  pv_d0(o, vb0 + (int)SHM_V, pa0, pa1, pa2, pa3);
  { const int t2 = ph_tid(), l2 = t2 & 63, w2 = t2 >> 6, r2 = l2 & 31, h2 = l2 >> 5;
    float* li2 = (float*)(lds + 2 * SHM_V + 2 * SHM_K) + w2 * 64;
    if (h2 == 0) li2[r2] = l_reg; asm volatile("s_waitcnt lgkmcnt(0)" ::: "memory");
    bf16_t* Ow = Ob + (w2 * QBLK) * LDO + r2;
#pragma unroll
    for (int r = 0; r < 16; ++r) { const int orow = crow(r, h2); const float rl = __builtin_amdgcn_rcpf(li2[orow]);
#pragma unroll
      for (int d0 = 0; d0 < 4; ++d0) Ow[orow * LDO + d0 * 32] = (bf16_t)(cvtpk(o[d0][r] * rl, 0.f) & 0xffffu); } }
  __syncthreads();
#undef ATT_SLOAD
#undef ATT_SWRITE
#undef ATT_SWAIT
#undef ATT_RESC
}

template <int DQK, int LDQ, int LDK, int LDV, int LDO>
__device__ __forceinline__ void attn_body_s1(const bf16_t* __restrict__ Qb, const bf16_t* __restrict__ Kh, const bf16_t* __restrict__ Vh, bf16_t* __restrict__ Ob, int seq, char* lds, const float scale) {
  constexpr int NKC = DQK / 64; constexpr size_t SHM_K = shm_k<DQK>();
  const float C = scale * 1.4426950408889634f, thr_raw = THR / scale;
  const int tid = ph_tid(), wid = tid >> 6, lane = tid & 63, r32 = lane & 31, hi = lane >> 5;
  char* V_lds = lds; char* K_lds = lds + 2 * SHM_V;
  float* wsf = (float*)(lds + 2 * SHM_V + 2 * SHM_K) + wid * 64; float* li_l = wsf; float* al_l = wsf + 32;
  float m_reg = -1e30f, l_reg = 0; f32x16 o[4] = {}; bf16x8 qr[DQK / 16];
  const bf16_t* Qw = Qb + (long)(wid * QBLK + r32) * LDQ + hi * 8;
#pragma unroll
  for (int d0 = 0; d0 < DQK / 16; ++d0) qr[d0] = *reinterpret_cast<const bf16x8*>(Qw + d0 * 16);
  const int sr = tid >> 4, sc = (tid & 15) * 8, vst0 = v_st(sr, sc), vst1 = v_st(32 + sr, sc);
  int kgo[NKC], klo[NKC];
#pragma unroll
  for (int i = 0; i < NKC; ++i) { const int c = tid + 512 * i, kr = c / (DQK / 8), kc = (c % (DQK / 8)) * 8; kgo[i] = kr * LDK + kc; klo[i] = kswz<DQK>(kr, kc * 2); }
  const int vgo = sr * LDV + sc;
  int ka[4];
#pragma unroll
  for (int q = 0; q < 4; ++q) ka[q] = r32 * (DQK * 2) + ((q * 32 + hi * 16) ^ ((r32 & 7) << 4));
  const __amdgpu_buffer_rsrc_t rK = __builtin_amdgcn_make_buffer_rsrc((void*)Kh, 0, 0x7ffffffc, 0x00020000), rV = __builtin_amdgcn_make_buffer_rsrc((void*)Vh, 0, 0x7ffffffc, 0x00020000);
  const int vb0 = (int)(uintptr_t)V_lds + v_rd_base(lane);
  bf16x8 vs0, vs1, ks[NKC];
#define ATT1_SLOAD(k0) do { const int _vo = (k0) * (LDV * 2), _ko = (k0) * (LDK * 2); vs0 = bl(rV, vgo * 2, _vo); vs1 = bl(rV, vgo * 2 + 64 * LDV, _vo); \
    _Pragma("unroll") for (int _c = 0; _c < NKC; ++_c) ks[_c] = bl(rK, kgo[_c] * 2, _ko); } while (0)
#define ATT1_SWRITE(b) do { *(bf16x8*)(V_lds + (b) * SHM_V + vst0) = vs0; *(bf16x8*)(V_lds + (b) * SHM_V + vst1) = vs1; \
    _Pragma("unroll") for (int _c = 0; _c < NKC; ++_c) *(bf16x8*)(K_lds + (b) * SHM_K + klo[_c]) = ks[_c]; } while (0)
  const int NT = seq / KVBLK;
  ATT1_SLOAD(0); asm volatile("s_waitcnt vmcnt(0)" ::: "memory"); ATT1_SWRITE(0);
  ATT1_SLOAD(KVBLK); asm volatile("s_waitcnt vmcnt(0)" ::: "memory"); ATT1_SWRITE(1); __syncthreads();
  for (int j = 0; j < NT; ++j) { const int b = j & 1;
    ATT_SBAR();
    f32x16 p0, p1; float mn, al; bf16x8 pa0, pa1, pa2, pa3;
    qkt<DQK, 0>(p0, p1, K_lds + b * SHM_K, qr, nullptr, ka);
    partialSM(p0, p1, m_reg, mn, al, C, thr_raw);
    if (__any(al < 1.f)) { if (hi == 0) al_l[r32] = al; asm volatile("s_waitcnt lgkmcnt(0)" ::: "memory");
#pragma unroll
      for (int d = 0; d < 4; ++d)
#pragma unroll
        for (int r = 0; r < 16; ++r) o[d][r] *= al_l[crow(r, hi)]; }
    finishSM(p0, p1, al, l_reg, pa0, pa1, pa2, pa3); ATT_SBAR();
    if (j + 2 < NT) ATT1_SLOAD((j + 2) * KVBLK);
    ATT_SBAR();
    pv_d0(o, vb0 + b * (int)SHM_V, pa0, pa1, pa2, pa3);
    __syncthreads();
    if (j + 2 < NT) { asm volatile("s_waitcnt vmcnt(0)" ::: "memory"); ATT1_SWRITE(b); } }
  { const int t2 = ph_tid(), l2 = t2 & 63, w2 = t2 >> 6, r2 = l2 & 31, h2 = l2 >> 5;
    float* li2 = (float*)(lds + 2 * SHM_V + 2 * SHM_K) + w2 * 64;
    if (h2 == 0) li2[r2] = l_reg; asm volatile("s_waitcnt lgkmcnt(0)" ::: "memory");
    bf16_t* Ow = Ob + (w2 * QBLK) * LDO + r2;
#pragma unroll
    for (int r = 0; r < 16; ++r) { const int orow = crow(r, h2); const float rl = __builtin_amdgcn_rcpf(li2[orow]);
#pragma unroll
      for (int d0 = 0; d0 < 4; ++d0) Ow[orow * LDO + d0 * 32] = (bf16_t)(cvtpk(o[d0][r] * rl, 0.f) & 0xffffu); } }
  __syncthreads();
#undef ATT1_SLOAD
#undef ATT1_SWRITE
}
template <int TYPE> __device__ __forceinline__ void attn_unit(const Params& p, int u, char* lds) {
  bf16_t* P = WSP(bf16_t, p, regA); bf16_t* OA = WSP(bf16_t, p, oall);
  int type, b, h, qb;
  if (u < 256) { const int x = u & 7, idx = u >> 3; type = idx >> 4; qb = idx & 15; b = x >> 2; h = x & 3; }
  else { const int v = u - 256; type = v >> 3; b = (v >> 2) & 1; h = v & 3; qb = SEQ / 256; }
  const long q0 = (long)b * NTOK + qb * 256, k0 = (long)b * NTOK + (qb == SEQ / 256 ? SEQ : 0); const int seq = (qb == SEQ / 256) ? CTXL : NTOK;
  if (TYPE == 0) attn_body<MQK, MH * MQK, MH * MQK, MH * MV, DM, 1, 0>(WSP(bf16_t, p, qm) + q0 * (MH * MQK) + h * MQK, WSP(bf16_t, p, km) + k0 * (MH * MQK) + h * MQK, WSP(bf16_t, p, vm) + k0 * (MH * MV) + h * MV,
                                                                 OA + q0 * DM + 3 * BW + h * MV, seq, lds, 0.07216878364870322f  );
  else attn_body<GHD, PW, PW, PW, DM, ATT_SD_GQA, 0>(P + q0 * PW + OFF_GQ + h * GHD, P + k0 * PW + OFF_GK + (h / (GH / GKV)) * GHD, P + k0 * PW + OFF_GV + (h / (GH / GKV)) * GHD,
                                      OA + q0 * DM + BW + h * GHD, seq, lds, 0.08838834764831845f  );
}
}
template <int TYPE> __global__ __launch_bounds__(512, 2) void k_attn(Params p, int l) {
  extern __shared__ __attribute__((aligned(16))) unsigned char shm[];
  const int nu = 256 + (l == 0 ? 16 : 0);
  for (int u = blockIdx.x; u < nu; u += gridDim.x) { const int type = u < 256 ? ((u >> 3) >> 4) : ((u - 256) >> 3); if (type == TYPE) att::attn_unit<TYPE>(p, u, (char*)shm); }
}
#endif
#ifndef CPU_TEST
namespace ret {
using pg8::f32x4; using pg8::u32x4; using pg8::bf16x8;
static_assert(RCH == 128 && RQK == 64 && RV == 128, "retention tiles are written for chunk 128, qk 64, v 128");
constexpr int PT_ = 272, PS = 528, PQ = 144;
constexpr int LDS_A = 2 * 128 * PT_, LDS_C = 128 * PQ + 2 * 128 * PS + 2 * 132 * 4;
template <int NB, int KS> __device__ __forceinline__ void mma16(f32x4 (&acc)[NB], const LAS char* A, int lda, const LAS char* Bt, int ldb) {
  const int lane = ph_tid() & 63, r = lane & 15, kq = lane >> 4;
#pragma unroll
  for (int s = 0; s < KS; ++s) { const bf16x8 a = *(const LAS bf16x8*)(A + r * lda + (s * 32 + kq * 8) * 2);
#pragma unroll
    for (int nb = 0; nb < NB; ++nb) { const bf16x8 bfr = *(const LAS bf16x8*)(Bt + (nb * 16 + r) * ldb + (s * 32 + kq * 8) * 2); acc[nb] = __builtin_amdgcn_mfma_f32_16x16x32_bf16(a, bfr, acc[nb], 0, 0, 0); } }
}
__device__ __forceinline__ long chunk_row0(int b, int cs) { return (long)b * NTOK + (cs < SEQ / RCH ? cs * RCH : SEQ + (cs - SEQ / RCH) * RCH); }
__device__ __forceinline__ void st16(LAS char* p, unsigned v) { *(LAS unsigned short*)p = (unsigned short)v; }
template <int NC, bool WEIGHT, int PT> __device__ __forceinline__ void stage_T(LAS char* T, LAS char* T2, const bf16_t* src, int ld, float lg1, float lg2) {
  const int tidq = ph_tid();
#pragma unroll
  for (int i = 0; i < NC / 4; ++i) { const int id = tidq + 512 * i, key = id & 127, c = id >> 7; const u32x4 w = *(const u32x4*)(src + (long)key * ld + 8 * c);
    if (!WEIGHT) {
      st16(T + (8 * c + 0) * PT + key * 2, w.x); st16(T + (8 * c + 1) * PT + key * 2, w.x >> 16); st16(T + (8 * c + 2) * PT + key * 2, w.y); st16(T + (8 * c + 3) * PT + key * 2, w.y >> 16);
      st16(T + (8 * c + 4) * PT + key * 2, w.z); st16(T + (8 * c + 5) * PT + key * 2, w.z >> 16); st16(T + (8 * c + 6) * PT + key * 2, w.w); st16(T + (8 * c + 7) * PT + key * 2, w.w >> 16);
    } else { f32x4 a, b2; pg8::unpack8(w, a, b2); const float w1 = __expf(lg1 * (float)(RCH - 1 - key)), w2 = __expf(lg2 * (float)key);
#pragma unroll
      for (int j = 0; j < 4; ++j) { st16(T + (8 * c + j) * PT + key * 2, pg8::cvt_pk_bf16(a[j] * w1, 0.f)); st16(T + (8 * c + 4 + j) * PT + key * 2, pg8::cvt_pk_bf16(b2[j] * w1, 0.f));
        st16(T2 + (8 * c + j) * PT + key * 2, pg8::cvt_pk_bf16(a[j] * w2, 0.f)); st16(T2 + (8 * c + 4 + j) * PT + key * 2, pg8::cvt_pk_bf16(b2[j] * w2, 0.f)); } } }
}
__device__ __forceinline__ void ret_a_unit(const Params& p, int l, int u, LAS char* lds) {
  const int cs = u % RNC, h = (u / RNC) % RH, b = u / (RNC * RH), tidu = ph_tid(), wv = tidu >> 6, lane = tidu & 63;
  const float lgf = -__expf(p.in[I_RDF][l * RH + h]), lgb = -__expf(p.in[I_RDB][l * RH + h]);
  const bf16_t* P = WSP(bf16_t, p, regA) + chunk_row0(b, cs) * PW; LAS char* VT = lds; LAS char* KT = lds + 128 * PT_;
  stage_T<16, false, PT_>(VT, nullptr, P + OFF_RV + h * RV, PW, 0.f, 0.f);
  stage_T<8, true, PT_>(KT, KT + 64 * PT_, P + OFF_RK + h * RQK, PW, lgf, lgb);
  __syncthreads();
  f32x4 acc[8];
#pragma unroll
  for (int nb = 0; nb < 8; ++nb) acc[nb] = (f32x4){0.f, 0.f, 0.f, 0.f};
  mma16<8, 4>(acc, VT + wv * 16 * PT_, PT_, KT, PT_);
  float* RKV = WSP(float, p, rkv);
#pragma unroll
  for (int nb = 0; nb < 8; ++nb) { const int col = nb * 16 + (lane & 15), dir = col >> 6, dk = col & 63; float* o = RKV + ((((long)(b * RH + h) * 2 + dir) * RNC + cs) * RV + wv * 16 + (lane >> 4) * 4) * RQK + dk;
#pragma unroll
    for (int r = 0; r < 4; ++r) o[r * RQK] = acc[nb][r]; }
  __syncthreads();
}
__device__ __forceinline__ void ph_ret_scan(const Params& p, int l) {
  const float* RKV = WSP(float, p, rkv); bf16_t* RS = WSP(bf16_t, p, rs); constexpr int NL = SEQ / RCH, NCX = CTXL / RCH;
  for (long i = (long)blockIdx.x * 512 + ph_tid(); i < (long)NB * RH * 2 * RV * RQK; i += (long)gridDim.x * 512) { const int e = (int)(i % (RV * RQK)), dir = (int)((i / (RV * RQK)) % 2), h = (int)((i / (2 * RV * RQK)) % RH), b = (int)(i / (2 * RV * RQK * RH));
    const float lg = -__expf(p.in[dir ? I_RDB : I_RDF][l * RH + h]), dec = __expf(lg * (float)RCH); const long base = (((long)(b * RH + h) * 2 + dir) * RNC) * (RV * RQK) + e; float S = 0.f;
    for (int s0 = 0; s0 < RNC; s0 += 17) { float kv[17]; int cs_[17];
#pragma unroll
      for (int q = 0; q < 17; ++q) { const int s = s0 + q; cs_[q] = dir == 0 ? (s < NCX ? NL + s : s - NCX) : (RNC - 1 - s); kv[q] = RKV[base + (long)cs_[q] * (RV * RQK)]; }
#pragma unroll
      for (int q = 0; q < 17; ++q) { RS[base + (long)cs_[q] * (RV * RQK)] = (bf16_t)(pg8::cvt_pk_bf16(S, 0.f) & 0xffffu); S = dec * S + kv[q]; } } }
}
__device__ __forceinline__ void ret_c_unit(const Params& p, int l, int u, LAS char* lds) {
  const int ncs = (l == NLAYER - 1) ? SEQ / RCH : RNC; const int cs = u % ncs, h = (u / ncs) % RH, b = u / (ncs * RH), tid = ph_tid(), wv = tid >> 6, lane = tid & 63;
  const float lgf = -__expf(p.in[I_RDF][l * RH + h]), lgb = -__expf(p.in[I_RDB][l * RH + h]); const long R0 = chunk_row0(b, cs);
  const bf16_t* P = WSP(bf16_t, p, regA) + R0 * PW; LAS char* Ks = lds; LAS char* Ss = lds + 128 * PQ; LAS char* B2 = Ss + 128 * PS; LAS float* gf = (LAS float*)(B2 + 128 * PS); LAS float* gb = gf + 132;
  if (tid < 129) { gf[tid] = __expf(lgf * (float)tid); gb[tid] = __expf(lgb * (float)tid); }
#pragma unroll
  for (int i = 0; i < 2; ++i) { const int id = tid + 512 * i, row = id >> 3, c = id & 7; *(LAS u32x4*)(Ks + row * PQ + c * 16) = *(const u32x4*)(P + (long)row * PW + OFF_RK + h * RQK + 8 * c);
    *(LAS u32x4*)(Ss + row * PS + 256 + c * 16) = *(const u32x4*)(P + (long)row * PW + OFF_RQ + h * RQK + 8 * c); }
  stage_T<16, false, PS>(B2, nullptr, P + OFF_RV + h * RV, PW, 0.f, 0.f);
  { const bf16_t* RS = WSP(bf16_t, p, rs);
#pragma unroll
    for (int i = 0; i < 4; ++i) { const int id = tid + 512 * i, dir = id >> 10, dv = (id >> 3) & 127, c = id & 7;
      *(LAS u32x4*)(B2 + dv * PS + 256 + dir * 128 + c * 16) = *(const u32x4*)(RS + ((((long)(b * RH + h) * 2 + dir) * RNC + cs) * RV + dv) * RQK + 8 * c); } }
  __syncthreads();
  LAS char* myS = Ss + wv * 16 * PS;
  { f32x4 acc[8];
#pragma unroll
    for (int nb = 0; nb < 8; ++nb) acc[nb] = (f32x4){0.f, 0.f, 0.f, 0.f};
    mma16<8, 2>(acc, myS + 256, PS, Ks, PQ);
#pragma unroll
    for (int nb = 0; nb < 8; ++nb) { const int a2 = nb * 16 + (lane & 15);
#pragma unroll
      for (int r = 0; r < 4; ++r) { const int ar = (lane >> 4) * 4 + r, a = wv * 16 + ar; const float f = a2 <= a ? gf[a - a2] : gb[a2 - a]; st16(myS + ar * PS + a2 * 2, pg8::cvt_pk_bf16(acc[nb][r] * f, 0.f)); } } }
#pragma unroll
  for (int i = 0; i < 2; ++i) { const int id = lane + 64 * i, ar = id >> 3, c = id & 7, a = wv * 16 + ar; LAS char* q = myS + ar * PS + 256 + c * 16; f32x4 x0, x1; pg8::unpack8(*(const LAS u32x4*)q, x0, x1);
    const float sf = gf[a + 1], sb = gb[RCH - a]; *(LAS u32x4*)(q + 128) = pg8::pack8(x0 * sb, x1 * sb); *(LAS u32x4*)q = pg8::pack8(x0 * sf, x1 * sf); }
  asm volatile("s_waitcnt lgkmcnt(0)" ::: "memory");
  f32x4 o[8];
#pragma unroll
  for (int nb = 0; nb < 8; ++nb) o[nb] = (f32x4){0.f, 0.f, 0.f, 0.f};
  mma16<8, 8>(o, myS, PS, B2, PS);
#pragma unroll
  for (int r = 0; r < 4; ++r) { float s = 0.f;
#pragma unroll
    for (int nb = 0; nb < 8; ++nb) s += o[nb][r];
    s += __shfl_xor(s, 8); s += __shfl_xor(s, 4); s += __shfl_xor(s, 2); s += __shfl_xor(s, 1); const float mean = s * (1.f / RV); float q = 0.f;
#pragma unroll
    for (int nb = 0; nb < 8; ++nb) { const float d = o[nb][r] - mean; q += d * d; }
    q += __shfl_xor(q, 8); q += __shfl_xor(q, 4); q += __shfl_xor(q, 2); q += __shfl_xor(q, 1); const float rs = 1.f / sqrtf(q * (1.f / RV) + NORM_EPS);
    const int ar = (lane >> 4) * 4 + r;
#pragma unroll
    for (int nb = 0; nb < 8; ++nb) *(LAS float*)(myS + ar * PS + (nb * 16 + (lane & 15)) * 4) = (o[nb][r] - mean) * rs; }
  asm volatile("s_waitcnt lgkmcnt(0)" ::: "memory");
  { const float* gain = p.in[I_RNORM] + l * BW + h * RV; bf16_t* OA = WSP(bf16_t, p, oall); const int ar = lane >> 2, c4 = lane & 3; const long R = R0 + wv * 16 + ar;
    u32x4 gt[4];
#pragma unroll
    for (int it = 0; it < 4; ++it) gt[it] = *(const u32x4*)(P + (long)(wv * 16 + ar) * PW + OFF_RG + h * RV + (c4 + 4 * it) * 8);
#pragma unroll
    for (int it = 0; it < 4; ++it) { const int dv = (c4 + 4 * it) * 8; const LAS float* q = (const LAS float*)(myS + ar * PS + dv * 4); f32x4 x0 = *(const LAS f32x4*)q, x1 = *(const LAS f32x4*)(q + 4), g0, g1; pg8::unpack8(gt[it], g0, g1);
      x0 = x0 * *(const f32x4*)(gain + dv) * g0 * pg8::sigmoid4(g0); x1 = x1 * *(const f32x4*)(gain + dv + 4) * g1 * pg8::sigmoid4(g1);
      *(u32x4*)(OA + R * DM + 2 * BW + h * RV + dv) = pg8::pack8(x0, x1); } }
  __syncthreads();
}
}
template <int WHICH> __global__ __launch_bounds__(512, 2) void k_ret(Params p, int l) {
  extern __shared__ __attribute__((aligned(16))) unsigned char shm[]; LAS char* lds = (LAS char*)shm;
  if (WHICH == 0) for (int u = blockIdx.x; u < NB * RH * RNC; u += gridDim.x) ret::ret_a_unit(p, l, u, lds);
  if (WHICH == 1) ret::ph_ret_scan(p, l);
  if (WHICH == 2) { const int nu = NB * RH * ((l == NLAYER - 1) ? SEQ / RCH : RNC); for (int u = blockIdx.x; u < nu; u += gridDim.x) ret::ret_c_unit(p, l, u, lds); }
}
#endif
#ifndef CPU_TEST
#define XB_TMO      128
#define XB_XCNT(j)  (256  + 64 * (j))
#define XB_XSUB(j)  (1280 + 64 * (j))
#define XB_XGEN(j)  (2304 + 64 * (j))
#define XB_TOP      3328
#define XB_TOPGEN   3392
#define XCD_BAR_WORDS 3456
#define XB_SPIN_CAP (1u << 18)

__device__ __forceinline__ unsigned xb_ld(unsigned* p)              { return __hip_atomic_load(p, __ATOMIC_RELAXED, __HIP_MEMORY_SCOPE_AGENT); }
__device__ __forceinline__ unsigned xb_add(unsigned* p, unsigned v) { return __hip_atomic_fetch_add(p, v, __ATOMIC_RELAXED, __HIP_MEMORY_SCOPE_AGENT); }
__device__ __forceinline__ unsigned xb_xcc_id() { return (unsigned)__builtin_amdgcn_s_getreg((3 << 11) | 20) & 0xFu; }
#define XB_SPIN(cond, bar) do { unsigned _sp = 0; while (cond) { __builtin_amdgcn_s_sleep(1); \
    if ((++_sp & 255u) == 0u) { if (xb_ld(&(bar)[XB_TMO])) break; if (_sp > XB_SPIN_CAP) { atomicAdd(&(bar)[XB_TMO], 1u); break; } } } } while (0)

struct XcdBarrier {
    unsigned* bar; unsigned x;
    volatile LAS unsigned* st;
};

__device__ __forceinline__ XcdBarrier xcd_barrier_post(unsigned* bar, volatile LAS unsigned* st) {
    XcdBarrier b; b.bar = bar; b.x = xb_xcc_id(); b.st = st;
    if (threadIdx.x == 0) (void)xb_add(&bar[XB_XCNT(b.x)], 1u);
    return b;
}
__device__ __forceinline__ void xcd_barrier_complete(unsigned* bar, unsigned x, unsigned& nloc, unsigned& nx) {
    const unsigned G = gridDim.x * gridDim.y * gridDim.z;
    unsigned sum, cnt, mine, sp = 0u;
    for (;;) {
        sum = 0u; cnt = 0u; mine = 0u;
#pragma unroll
        for (unsigned j = 0; j < 16; ++j) { const unsigned c = xb_ld(&bar[XB_XCNT(j)]); sum += c; cnt += (c > 0u) ? 1u : 0u; mine = (j == x) ? c : mine; }
        if (sum == G) break;
        __builtin_amdgcn_s_sleep(1);
        if ((++sp & 255u) == 0u) { if (xb_ld(&bar[XB_TMO])) break; if (sp > XB_SPIN_CAP) { atomicAdd(&bar[XB_TMO], 1u); break; } }
    }
    nloc = mine > 0u ? mine : 1u; nx = cnt > 0u ? cnt : 1u;
}

__device__ __forceinline__ void xcd_barrier(const XcdBarrier& b) {
    asm volatile("s_waitcnt vmcnt(0)" ::: "memory");
    __syncthreads();
    if (threadIdx.x == 0) {
        unsigned* bar = b.bar;
        __builtin_amdgcn_s_waitcnt(0);
        unsigned nloc = b.st[0], nx = b.st[1];
        if (nloc == 0u) { xcd_barrier_complete(bar, b.x, nloc, nx); b.st[0] = nloc; b.st[1] = nx; }
        const unsigned old = xb_add(&bar[XB_XSUB(b.x)], 1u);
        const unsigned gen = old / nloc;
        if (old + 1u == (gen + 1u) * nloc) {
            __builtin_amdgcn_fence(__ATOMIC_RELEASE, "agent");
            asm volatile("s_waitcnt vmcnt(0)" ::: "memory");
            const unsigned og = xb_add(&bar[XB_TOP], 1u);
            const unsigned tg = og / nx;
            if (og + 1u == (tg + 1u) * nx) xb_add(&bar[XB_TOPGEN], 1u);
            else XB_SPIN(xb_ld(&bar[XB_TOPGEN]) == tg, bar);
            __builtin_amdgcn_fence(__ATOMIC_ACQUIRE, "agent");
            xb_add(&bar[XB_XGEN(b.x)], 1u);
            asm volatile("s_waitcnt vmcnt(0)" ::: "memory");
        } else {
            XB_SPIN(xb_ld(&bar[XB_XGEN(b.x)]) == gen, bar);
            __builtin_amdgcn_fence(__ATOMIC_ACQUIRE, "agent");
            asm volatile("s_waitcnt vmcnt(0)" ::: "memory");
        }
    }
    __syncthreads();
}

#endif
#ifndef CPU_TEST
#include <type_traits>
constexpr int MEGA_LDS = ((ret::LDS_C > pg8::STAGE_BYTES ? ret::LDS_C : pg8::STAGE_BYTES) + 255) / 256 * 256 + 256;
typedef const __attribute__((address_space(4))) Params* KParamsPtr;
__device__ __forceinline__ Params kparams() {
#if defined(__HIP_DEVICE_COMPILE__)
  KParamsPtr k = (KParamsPtr)__builtin_amdgcn_kernarg_segment_ptr(); asm volatile("" : "+s"(k)); Params r; __builtin_memcpy(&r, k, sizeof(Params)); return r;
#else
  return Params{};
#endif
}
__device__ __forceinline__ int rotc(int off) { const int G = gridDim.x; return (int)((ph_bid() + G - (off % G)) % G); }

#ifndef MK_XCD_UP
#define MK_XCD_UP 1
#endif
#ifndef MK_XCD_DN
#define MK_XCD_DN 1
#endif
#ifndef MK_DBL
#define MK_DBL 0
#endif
#define REPS(id) ((MK_DBL) == (id) ? 2 : 1)
#ifndef MK_WAITMASK
#define MK_WAITMASK 0xffffffffffffffffull
#endif
#ifdef MK_WAITPROBE
#define BARX() do { const unsigned long long t0_ = wall_clock64(); xcd_barrier(bar); if ((MK_WAITMASK >> bidx_) & 1ull) wait_acc += wall_clock64() - t0_; ++bidx_; if (blockIdx.x == (MK_WAITPROBE) && threadIdx.x == 0) ((unsigned long long*)(p.ws + WS.bar + 14336))[40] = wait_acc; } while (0)
#else
#define BARX() do { xcd_barrier(bar); if ((MK_DBL) == 99) xcd_barrier(bar); } while (0)
#endif
#ifdef MK_PROBE_A
#define STAMP(k) do { if (blockIdx.x == 0 && threadIdx.x == 0) ((unsigned long long*)(p.ws + WS.bar + 14336))[k] = wall_clock64(); } while (0)
#else
#define STAMP(k) do { } while (0)
#endif
__global__ __launch_bounds__(512, 2) void mega(Params p_unused_) {
#define p (kparams())
  extern __shared__ __attribute__((aligned(16))) unsigned char shm[];
  LAS unsigned char* lds = (LAS unsigned char*)shm; char* ldsg = (char*)shm;
  LAS unsigned* xbw = (LAS unsigned*)(lds + MEGA_LDS - 16);
  if (threadIdx.x < 4) xbw[threadIdx.x] = 0u;
  __syncthreads();
  XcdBarrier bar = xcd_barrier_post((unsigned*)(p.ws + WS.bar), (volatile LAS unsigned*)xbw);
  STAMP(0);
#ifdef MK_WAITPROBE
  unsigned long long wait_acc = 0ull; int bidx_ = 0;
#endif
  using namespace pg8;
  const int G = gridDim.x;
#define P WSP(bf16_t, p, regA)
#define PROJ ((bf16_t*)(p.ws + WS.regA + SZ_P))
#define H1 WSP(bf16_t, p, h1)
#define QM WSP(bf16_t, p, qm)
#define KM WSP(bf16_t, p, km)
#define VM WSP(bf16_t, p, vm)
#define Z WSP(bf16_t, p, z)
#define OA WSP(bf16_t, p, oall)
#define XS WSP(bf16_t, p, regA)
#define ACT ((bf16_t*)(p.ws + WS.regA + SZ_XS))
#define YS ((bf16_t*)(p.ws + WS.regA + SZ_XS + SZ_ACT))
  constexpr int nMfull = MROWS / 256;

#ifdef MK_NANFILL
  {
    u32x4* q = (u32x4*)(p.ws + WS.x1); const long n1 = (long)(WS.s5sw - WS.x1) / 16; const u32x4 nanv = {0x7FC07FC0u, 0x7FC07FC0u, 0x7FC07FC0u, 0x7FC07FC0u};
    for (long i = (long)blockIdx.x * 512 + threadIdx.x; i < n1; i += (long)gridDim.x * 512) q[i] = nanv;
    u32x4* q2 = (u32x4*)(p.ws + WS.rkv); const long n2 = (long)(WS.end - WS.rkv) / 16;
    for (long i = (long)blockIdx.x * 512 + threadIdx.x; i < n2; i += (long)gridDim.x * 512) q2[i] = nanv; }
#endif
_Pragma("unroll") for (int rep_ = 0; rep_ < REPS(11); ++rep_) {
  ph::ph_s5tables(p, lds);
  ph::ph_tables(p);
  ph::ph_mod(p, lds, rotc(64));
    }
_Pragma("unroll") for (int rep_ = 0; rep_ < REPS(1); ++rep_) {
  ph::ph_conv(p, lds, (unsigned*)(p.ws + WS.bar) + XCD_BAR_WORDS);
    }
  BARX();
  STAMP(1);
_Pragma("unroll") for (int rep_ = 0; rep_ < REPS(19); ++rep_) {
  ph::ph_ln_in(p, 0);
    }
  BARX();
  STAMP(2);

  auto layer = [&](auto LC) { constexpr int l = decltype(LC)::value; constexpr int last = (l == NLAYER - 1), nMlat = last ? nMfull - 2 : nMfull;
_Pragma("unroll") for (int rep_ = 0; rep_ < REPS(2); ++rep_) {
    { SchedGrid S{(const char*)H1, (const char*)(WSP(bf16_t, p, wt_in) + (long)l * PW * DM), DM, DM, nMfull, PW / 256 - 1, 0, G, ph_bid(), 0};
      gemm_phase(lds, GemmG{DM, DM, DM, 0}, S, EpiBf16{P, PW, 0}); }
    }
    BARX();
    STAMP(2 + 15 * l + 1);
    ph::ph_post_proj(p, l);
    BARX();
    STAMP(2 + 15 * l + 2);
_Pragma("unroll") for (int rep_ = 0; rep_ < REPS(12); ++rep_) {
    { constexpr int NKR = MROWS / 256;
      const int vw = ph_bid() - NKR, G2 = G - NKR;
      if (vw < 0) { SchedKR S{(const char*)H1, (const char*)(WSP(bf16_t, p, wt_in) + (long)l * PW * DM), G, ph_bid()};
        gemm_phase<false, PG8_SP2>(lds, GemmG{DM, DM, DM, 0}, S, EpiKR{KM, WSP(float, p, rope_b)}); }
      else {
        { SchedGrid S{(const char*)(P + OFF_CQ), (const char*)(WSP(bf16_t, p, wt_uq) + (long)l * MH * MQK * MQL), PW, MQL, nMfull, MH * MQK / 256, 0, G2, vw, 0};
          gemm_phase<false, PG8_SP2>(lds, GemmG{PW, MQL, MQL, 0}, S, EpiQM{QM, WSP(float, p, rope_b)}); }
        { SchedGrid S{(const char*)(P + OFF_CKV), (const char*)(WSP(bf16_t, p, wt_ukv) + (long)l * MH * (MNOPE + MV) * MKVL), PW, MKVL, nMfull, MH, 0, G2, (vw + G2 - 102) % G2, 0};
          gemm_phase<false, PG8_SP2>(lds, GemmG{PW, MKVL, MKVL, 0}, S, EpiKVm{KM, VM}); }
        { SchedS5 S{(const char*)WSP(bf16_t, p, uh), (const char*)(WSP(bf16_t, p, s5sw) + (long)l * S5G * S5K2 * S5K1), (size_t)S5K2 * S5K1 * 2, G2, (vw + G2 - (238 % G2)) % G2};
          gemm_phase<false, PG8_SP2>(lds, GemmG{S5K1 + S5K2, S5K1, S5K1, 0}, S, EpiS5E{WSP(float, p, s5e)}); }
        for (int u = (vw + G2 - ((238 + 96) % G2)) % G2; u < NB * RH * RNC; u += G2) ret::ret_a_unit(p, l, u, (LAS char*)lds); } }
    }
    BARX();
    STAMP(2 + 15 * l + 3);
_Pragma("unroll") for (int rep_ = 0; rep_ < REPS(13); ++rep_) {
    ph::ph_s5scan(p, l);
    ret::ph_ret_scan(p, l);
    }
    BARX();
    STAMP(2 + 15 * l + 4);
_Pragma("unroll") for (int rep_ = 0; rep_ < REPS(4); ++rep_) {
_Pragma("unroll") for (int rq_ = 0; rq_ < REPS(21); ++rq_) {
    { const int w = ph_bid();
      if (w < 128) att::attn_unit<0>(p, w, ldsg); else if (w < 256) att::attn_unit<1>(p, w, ldsg);
      if (!last) { if (w >= 224 && w < 232) att::attn_unit<0>(p, 256 + (w - 224), ldsg); else if (w >= 240 && w < 248) att::attn_unit<1>(p, 256 + 8 + (w - 240), ldsg); } }
    }
_Pragma("unroll") for (int rq_ = 0; rq_ < REPS(22); ++rq_) {
    { SchedS5 S{(const char*)WSP(bf16_t, p, uh), (const char*)(WSP(bf16_t, p, s5sv) + (long)l * S5G * S5K1 * (S5K1 + S5K2)), (size_t)S5K1 * (S5K1 + S5K2) * 2, 96, ph_bid() - 128};
      if (ph_bid() >= 128 && ph_bid() < 224) gemm_phase<false, PG8_SP2>(lds, GemmG{S5K1 + S5K2, S5K1 + S5K2, S5K1 + S5K2, 0}, S, EpiS5Y{P, p.in[I_S5D] + (long)l * BW, Z, last, 0}); }
    }
_Pragma("unroll") for (int rq_ = 0; rq_ < REPS(23); ++rq_) {
    { const int nu = NB * RH * (last ? SEQ / RCH : RNC), w = ph_bid();
      if (w >= 128) for (int u = w - 128; u < nu; u += 128) ret::ret_c_unit(p, l, u, (LAS char*)lds); }
    }
    }
    BARX();
    STAMP(2 + 15 * l + 5);
_Pragma("unroll") for (int rep_ = 0; rep_ < REPS(14); ++rep_) {
    { SchedGrid S{(const char*)Z, (const char*)(WSP(bf16_t, p, wt_glu) + (long)l * BW * BW), BW, BW, nMlat, BW / 256, last, G, ph_bid(), 0};
      gemm_phase<false, PG8_SP2>(lds, GemmG{BW, BW, BW, 0}, S, EpiGluO{Z, OA}); }
    }
    BARX();
    STAMP(2 + 15 * l + 6);
_Pragma("unroll") for (int rep_ = 0; rep_ < REPS(6); ++rep_) {
    if (!last) { SchedGateCtx S{(const char*)H1, (const char*)(WSP(bf16_t, p, wt_gate) + (long)l * 4 * DM * DM), G, ph_bid()};
      gemm_phase(lds, GemmG{DM, DM, DM, 0}, S, EpiGateCtx{p.in[I_BGATE] + (long)l * 4 * DM, WSP(bf16_t, p, gctx)}); }
    { SchedProjW S{(const char*)OA, (const char*)(WSP(bf16_t, p, wt_br) + (long)l * 4 * DM * BW), nMlat, last, G, ph_bid(), last ? 0 : 64, 2, last ? 4 : 5, 0};
      gemm_phase(lds, GemmG{DM, BW, BW, 0}, S, EpiBf16{PROJ, 4 * DM, 0}); }
    }
    BARX();
    STAMP(2 + 15 * l + 7);
_Pragma("unroll") for (int rep_ = 0; rep_ < REPS(7); ++rep_) {
    if (!last) ph::ph_merge_ctx(p);
    { SchedGate4 S{(const char*)H1, (const char*)(WSP(bf16_t, p, wt_gate) + (long)l * 4 * DM * DM), G, ph_bid()};
      gemm_phase(lds, GemmG{DM, DM, DM, 1}, S, EpiGate4{p.in[I_BGATE] + (long)l * 4 * DM, PROJ, WSP(bf16_t, p, merged)}); }
    }
    BARX();
    STAMP(2 + 15 * l + 8);
_Pragma("unroll") for (int rep_ = 0; rep_ < REPS(8); ++rep_) {
    { SchedGrid S{(const char*)WSP(bf16_t, p, merged), (const char*)(WSP(bf16_t, p, wt_out) + (long)l * DM * DM), DM, DM, nMlat, DM / 256, last, G, ph_bid(), 0};
      gemm_phase(lds, GemmG{DM, DM, DM, 0}, S, EpiBf16{WSP(bf16_t, p, macc), DM, 0}); }
    }
    BARX();
    STAMP(2 + 15 * l + 9);
_Pragma("unroll") for (int rep_ = 0; rep_ < REPS(15); ++rep_) {
    ph::ph_ln1(p, l, lds);
    }
    BARX();
    STAMP(2 + 15 * l + 10);
_Pragma("unroll") for (int rep_ = 0; rep_ < REPS(16); ++rep_) {
    ph::ph_topk(p, l, lds);
    }
    BARX();
    STAMP(2 + 15 * l + 11);
    const int nMl = last ? (2 * CAP_L) / 256 : XEP / 256;
_Pragma("unroll") for (int rep_ = 0; rep_ < REPS(9); ++rep_) {
    { SchedMoe S{(const char*)XS, (const char*)(WSP(bf16_t, p, wt_gu) + (long)l * NE * 2 * FF * DM), DM, DM, nMl, 2 * FF / 256, (size_t)2 * FF * DM * 2, G, ph_bid(), MK_XCD_UP, 0};
      gemm_phase_gather(lds, GemmG{DM, DM, DM, 0}, S, EpiSwiGlu{ACT}, (const char*)WSP(bf16_t, p, h2), (const int*)WSP(int, p, xsrc), (unsigned)(WS.zrow - WS.h2)); }
    }
    BARX();
    STAMP(2 + 15 * l + 13);
_Pragma("unroll") for (int rep_ = 0; rep_ < REPS(10); ++rep_) {
    { SchedMoe S{(const char*)ACT, (const char*)(WSP(bf16_t, p, wt_dn) + (long)l * NE * DM * FF), FF, FF, nMl, DM / 256, (size_t)DM * FF * 2, G, ph_bid(), MK_XCD_DN, 0};
      gemm_phase(lds, GemmG{FF, FF, FF, 0}, S, EpiBf16{YS, DM, 0}); }
    }
    BARX();
    STAMP(2 + 15 * l + 14);
_Pragma("unroll") for (int rep_ = 0; rep_ < REPS(18); ++rep_) {
    ph::ph_ln2(p, l);
    }
    if (!last) BARX();
    if (!last) STAMP(2 + 15 * l + 15);
  };
  layer(std::integral_constant<int, 0>{});
  layer(std::integral_constant<int, 1>{});
#undef p
#undef P
#undef PROJ
#undef H1
#undef QM
#undef KM
#undef VM
#undef Z
#undef OA
#undef XS
#undef ACT
#undef YS
}

extern "C" void kernel_launch(void* const* d_in, const int* in_sizes, int n_in, void* d_out, int out_size, void* d_ws, size_t ws_size, hipStream_t stream) {
  if (n_in != N_IN || ws_size < WS.end || out_size != NB * SEQ * DM) { fprintf(stderr, "kernel_launch: unexpected sizes n_in %d ws %zu (need %zu) out %d\n", n_in, ws_size, WS.end, out_size); return; }
  static int grid = 0;
  if (!grid) { int dev = 0, cus = 0, per_cu = 0; (void)hipGetDevice(&dev); (void)hipDeviceGetAttribute(&cus, hipDeviceAttributeMultiprocessorCount, dev);
    (void)hipFuncSetAttribute((const void*)mega, hipFuncAttributeMaxDynamicSharedMemorySize, MEGA_LDS);
    (void)hipOccupancyMaxActiveBlocksPerMultiprocessor(&per_cu, (const void*)mega, 512, MEGA_LDS);
    if (per_cu < 1) { fprintf(stderr, "kernel_launch: occupancy query says %d blocks per CU\n", per_cu); return; }
    grid = cus > 256 ? 256 : cus; }
  Params p; memset(&p, 0, sizeof(p));
  for (int i = 0; i < N_IN; ++i) p.in[i] = (const float*)d_in[i];
  p.out = (float*)d_out; p.ws = (char*)d_ws;
  (void)hipMemsetAsync((char*)d_ws + WS.bar, 0, (XCD_BAR_WORDS + 64) * sizeof(unsigned), stream);
  hipLaunchKernelGGL(mega, dim3(grid), dim3(512), MEGA_LDS, stream, p);
}
#endif
```

```cpp
#ifdef CPU_TEST
#include <cmath>
#include <cstdio>
#include <cstdlib>
#include <cstring>
#include <cstdint>
#include <functional>
#define __global__
#define __device__
#define __host__
#define __forceinline__ inline
#define __launch_bounds__(...)
#define __restrict__
struct dim3s { int x, y, z; };
static thread_local dim3s blockIdx, threadIdx, blockDim, gridDim;
typedef void* hipStream_t;
template <class F> static void cpu_launch(int grid, int block, F f) {
#pragma omp parallel for schedule(dynamic, 1)
  for (int b = 0; b < grid; ++b) {
    gridDim.x = grid; blockDim.x = block; blockIdx.x = b;
    for (int t = 0; t < block; ++t) { threadIdx.x = t; f(); }
  }
}
#define LAUNCH(kern, grid, block, ...) cpu_launch((grid), (block), [&]() { kern(__VA_ARGS__); })
static inline void hipMemsetAsync(void* p, int v, size_t n, hipStream_t) { memset(p, v, n); }
#else
#include <hip/hip_runtime.h>
#include <cstdio>
#include <cstdint>
#include <cstring>
#define LAUNCH(kern, grid, block, ...) hipLaunchKernelGGL(kern, dim3(grid), dim3(block), 0, stream, __VA_ARGS__)
#endif

typedef unsigned short bf16_t;

#ifndef CFG_DM
#define CFG_DM 2048
#define CFG_SEQ 4096
#define CFG_GRIDW 64
#define CFG_CTX 256
#define CFG_S5P 64
#define CFG_GHD 128
#define CFG_RCHUNK 128
#define CFG_MNOPE 128
#define CFG_MROPE 64
#define CFG_NE 16
#endif
constexpr int DM = CFG_DM, NB = 2, SEQ = CFG_SEQ, GRIDW = CFG_GRIDW, CTXL = CFG_CTX, NLAYER = 2;
constexpr int BW = DM / 4, S5CH = 16, S5G = BW / S5CH, S5P = CFG_S5P;
constexpr int GHD = CFG_GHD, GH = BW / GHD, GKV = GH / 2;
constexpr int RH = 4, RV = BW / RH, RQK = RV / 2;
constexpr int MQL = BW, MKVL = BW / 2, MH = 4, MNOPE = CFG_MNOPE, MROPE = CFG_MROPE, MV = BW / MH, MQK = MNOPE + MROPE;
constexpr int NE = CFG_NE, FF = DM / 2;
constexpr int NTOK = SEQ + CTXL, MROWS = NB * NTOK;
constexpr int OFF_U = 0, OFF_GQ = BW, OFF_GK = OFF_GQ + GH * GHD, OFF_GV = OFF_GK + GKV * GHD, OFF_RQ = OFF_GV + GKV * GHD, OFF_RK = OFF_RQ + RH * RQK,
              OFF_RV = OFF_RK + RH * RQK, OFF_RG = OFF_RV + RH * RV, OFF_CQ = OFF_RG + RH * RV, OFF_CKV = OFF_CQ + MQL, OFF_KR = OFF_CKV + MKVL, IN_TOTAL = OFF_KR + MROPE;
constexpr int PW = (IN_TOTAL + 255) / 256 * 256;
constexpr int CAP_L = 2 * SEQ / NE, CAP_C = 2 * CTXL / NE;
constexpr int XE = 2 * CAP_L + 2 * CAP_C, XEP = (XE + 255) / 256 * 256;
constexpr int XROWS = NE * XEP;
constexpr int NROPE_A = GHD / 4, NROPE_B = RQK / 4;
static_assert(MROPE / 4 == NROPE_B, "rope tables");
static_assert(MNOPE == MV, "kv split");
constexpr int S5LC = 16, S5NC = NTOK / S5LC, S5NN = NB * S5NC, S5NP = (S5NN + 255) / 256 * 256, S5K1 = S5LC * S5CH, S5K2 = 2 * S5P * 2;
constexpr int RCH = CFG_RCHUNK, RNC = NTOK / RCH;
constexpr float NORM_EPS = 1e-6f;
constexpr float DN_ALPHA = 1.4142135623730951f;

enum { I_X = 0, I_C, I_CTX, I_CCTX, I_ADAW, I_ADAB, I_WIN, I_S5AREF, I_S5AIMF, I_S5DTF, I_S5AREB, I_S5AIMB, I_S5DTB, I_S5BRE, I_S5BIM, I_S5CRE, I_S5CIM, I_S5D, I_S5GLU,
       I_GQN, I_GKN, I_RDF, I_RDB, I_RNORM, I_MQN, I_MKVN, I_WUQ, I_WUKV, I_WBR, I_WGATE, I_BGATE, I_WOUT, I_LN1G, I_LN1B, I_ROUTER, I_MOEG, I_MOEU, I_MOED, I_LN2G, I_LN2B, N_IN };

constexpr size_t al256(size_t x) { return (x + 255) / 256 * 256; }
struct WsLayout {
  size_t bar, mod, rope_a, rope_b, s5tab, wt_in, wt_gate, wt_br, wt_out, wt_glu, wt_uq, wt_ukv, wt_gu, wt_dn;
  size_t x1, x2, h1, h2, regA  , qm, km, vm, z, oall, macc  , merged, aff, slot, gatev, xsrc, retst, s5st, uh, s5e, s5sw, s5sv, rkv, rs, zrow, gctx, krp, yslab, end;
};
constexpr size_t SZ_P = (size_t)MROWS * PW * 2, SZ_PROJ = (size_t)MROWS * 4 * DM * 2;
constexpr size_t SZ_XS = (size_t)XROWS * DM * 2, SZ_ACT = (size_t)XROWS * FF * 2, SZ_YS = (size_t)XROWS * DM * 2;
constexpr size_t SZ_HS = (size_t)MROWS * S5G * S5P * 2 * 4;
constexpr size_t cmax(size_t a, size_t b) { return a > b ? a : b; }
constexpr WsLayout make_ws() {
  WsLayout w{}; size_t o = 0;
  w.bar = o; o += al256(32768);
  w.mod = o; o += al256((size_t)NLAYER * 3 * 6 * DM * 4);
  w.rope_a = o; o += al256((size_t)GRIDW * NROPE_A * 2 * 4);
  w.rope_b = o; o += al256((size_t)GRIDW * NROPE_B * 2 * 4);
  w.s5tab = o; o += al256((size_t)NLAYER * 2 * S5G * S5P * (2 + 2 * S5CH) * 4);
  w.wt_in = o; o += al256((size_t)NLAYER * PW * DM * 2);
  w.wt_gate = o; o += al256((size_t)NLAYER * 4 * DM * DM * 2);
  w.wt_br = o; o += al256((size_t)NLAYER * 4 * DM * BW * 2);
  w.wt_out = o; o += al256((size_t)NLAYER * DM * DM * 2);
  w.wt_glu = o; o += al256((size_t)NLAYER * BW * BW * 2);
  w.wt_uq = o; o += al256((size_t)NLAYER * MH * MQK * MQL * 2);
  w.wt_ukv = o; o += al256((size_t)NLAYER * MH * (MNOPE + MV) * MKVL * 2);
  w.wt_gu = o; o += al256((size_t)NLAYER * NE * 2 * FF * DM * 2);
  w.wt_dn = o; o += al256((size_t)NLAYER * NE * DM * FF * 2);
  w.x1 = o; o += al256((size_t)MROWS * DM * 4);
  w.x2 = o; o += al256((size_t)MROWS * DM * 4);
  w.h1 = o; o += al256((size_t)MROWS * DM * 2);
  w.h2 = o; o += al256((size_t)MROWS * DM * 2);
  w.regA = o; o += al256(cmax(cmax(SZ_P + SZ_PROJ, SZ_XS + SZ_ACT + SZ_YS), SZ_P + SZ_HS));
  w.qm = o; o += al256((size_t)MROWS * MH * MQK * 2);
  w.km = o; o += al256((size_t)MROWS * MH * MQK * 2);
  w.vm = o; o += al256((size_t)MROWS * MH * MV * 2);
  w.z = o; o += al256((size_t)MROWS * BW * 2);
  w.oall = o; o += al256((size_t)MROWS * DM * 2);
  w.macc = o; o += al256((size_t)MROWS * DM * 4);
  w.merged = o; o += al256((size_t)MROWS * DM * 2);
  w.aff = o; o += al256((size_t)MROWS * NE * 4);
  w.slot = o; o += al256((size_t)MROWS * NE * 4);
  w.gatev = o; o += al256((size_t)XROWS * 4);
  w.xsrc = o; o += al256((size_t)XROWS * 4);
  w.retst = o; o += al256((size_t)NB * RH * 2 * RQK * RV * 4);
  w.s5st = o; o += al256((size_t)NB * 2 * S5G * S5P * 2 * 4);
  w.uh = o; o += al256((size_t)S5G * S5NP * (S5K1 + S5K2) * 2);
  w.s5e = o; o += al256((size_t)S5G * S5NP * S5K2 * 4);
  w.s5sw = o; o += al256((size_t)NLAYER * S5G * S5K2 * S5K1 * 2);
  w.s5sv = o; o += al256((size_t)NLAYER * S5G * S5K1 * (S5K1 + S5K2) * 2);
  w.rkv = o; o += al256((size_t)NB * RH * 2 * RNC * RV * RQK * 4);
  w.rs = o; o += al256((size_t)NB * RH * 2 * RNC * RV * RQK * 2);
  w.zrow = o; o += al256((size_t)DM * 2);
  w.gctx = o; o += al256((size_t)NB * CTXL * 4 * DM * 2);
  w.krp = o; o += al256((size_t)2 * MROWS * MROPE * 4);
  w.yslab = o; o += al256((size_t)4 * NB * CTXL * DM * 4);
  w.end = o; return w;
}
constexpr WsLayout WS = make_ws();

struct Params {
  const float* in[N_IN];
  float* out;
  char* ws;
};

__host__ __device__ __forceinline__ float bf2f(bf16_t b) { union { unsigned u; float f; } c; c.u = ((unsigned)b) << 16; return c.f; }
__host__ __device__ __forceinline__ bf16_t f2bf(float f) { union { unsigned u; float f; } c; c.f = f; unsigned u = c.u; u += 0x7FFFu + ((u >> 16) & 1u); return (bf16_t)(u >> 16); }
__host__ __device__ __forceinline__ float sigmoidf_(float x) { return 1.f / (1.f + expf(-x)); }
__host__ __device__ __forceinline__ float siluf_(float x) { return x / (1.f + expf(-x)); }
__host__ __device__ __forceinline__ float gelu_tanh(float x) { return 0.5f * x * (1.f + tanhf(0.7978845608028654f * (x + 0.044715f * x * x * x))); }
__host__ __device__ __forceinline__ int row_b(int R) { return R / NTOK; }
__host__ __device__ __forceinline__ int row_t(int R) { return R % NTOK; }
__host__ __device__ __forceinline__ bool row_is_ctx(int R) { return (R % NTOK) >= SEQ; }
__host__ __device__ __forceinline__ int row_mod(int R) { return row_is_ctx(R) ? 2 : row_b(R); }
#ifndef CPU_TEST
__device__ __forceinline__ int ph_bid() { int b = blockIdx.x; asm volatile("" : "+s"(b)); return b; }
__device__ __forceinline__ int ph_tid() { int t = threadIdx.x; asm volatile("" : "+v"(t)); return t; }
#endif
#define GSTRIDE(i, n) for (long i = (long)blockIdx.x * blockDim.x + threadIdx.x; i < (long)(n); i += (long)gridDim.x * blockDim.x)
#define WSP(T, p, field) ((T*)((p).ws + WS.field))

__global__ void nk_conv_t(bf16_t* dst, const float* src, int K, int N, int ldsrc, int Ndst) {
  GSTRIDE(i, (long)Ndst * K) { int n = (int)(i / K), k = (int)(i % K); dst[i] = n < N ? f2bf(src[(long)k * ldsrc + n]) : (bf16_t)0; }
}
__global__ void nk_conv_gu(bf16_t* dst, const float* wg, const float* wu) {
  GSTRIDE(i, (long)2 * FF * DM) { int j = (int)(i / DM), k = (int)(i % DM); int tile = j / 256, r = j % 256, f = tile * 128 + (r & 127);
    const float* s = (r < 128) ? wg : wu; dst[i] = f2bf(s[(long)k * FF + f]); }
}
__global__ void nk_mod(Params p) {
  float* mod = WSP(float, p, mod);
  GSTRIDE(i, (long)NLAYER * 3 * 6 * DM) { int j = (int)(i % (6 * DM)), r = (int)((i / (6 * DM)) % 3), l = (int)(i / (18 * DM));
    const float* cv = (r < 2) ? p.in[I_C] + (long)r * DM : p.in[I_CCTX]; const float* w = p.in[I_ADAW] + (long)l * DM * 6 * DM;
    float acc = 0.f; for (int k = 0; k < DM; ++k) acc += siluf_(cv[k]) * w[(long)k * 6 * DM + j];
    mod[i] = acc + p.in[I_ADAB][(long)l * 6 * DM + j]; }
}
__global__ void nk_rope_tab(Params p) {
  float* ta = WSP(float, p, rope_a); float* tb = WSP(float, p, rope_b);
  GSTRIDE(i, (long)GRIDW * (NROPE_A + NROPE_B)) { int pos = (int)(i / (NROPE_A + NROPE_B)), k = (int)(i % (NROPE_A + NROPE_B));
    if (k < NROPE_A) { float inv = powf(10000.f, -(float)k / NROPE_A), a = pos * inv; ta[(pos * NROPE_A + k) * 2] = cosf(a); ta[(pos * NROPE_A + k) * 2 + 1] = sinf(a); }
    else { int kk = k - NROPE_A; float inv = powf(10000.f, -(float)kk / NROPE_B), a = pos * inv; tb[(pos * NROPE_B + kk) * 2] = cosf(a); tb[(pos * NROPE_B + kk) * 2 + 1] = sinf(a); } }
}
constexpr int S5TW = 2 + 2 * S5CH;
__global__ void nk_s5tab(Params p) {
  float* tab = WSP(float, p, s5tab);
  GSTRIDE(i, (long)NLAYER * 2 * S5G * S5P) { int pp = (int)(i % S5P), g = (int)((i / S5P) % S5G), dir = (int)((i / (S5P * S5G)) % 2), l = (int)(i / (2 * S5P * S5G));
    const float a_re = p.in[dir ? I_S5AREB : I_S5AREF][(l * S5G + g) * S5P + pp], a_im = p.in[dir ? I_S5AIMB : I_S5AIMF][(l * S5G + g) * S5P + pp];
    const float dt = expf(p.in[dir ? I_S5DTB : I_S5DTF][l * S5G + g]);
    const float mag = expf(a_re * dt), ab_re = mag * cosf(a_im * dt), ab_im = mag * sinf(a_im * dt);
    const float den = a_re * a_re + a_im * a_im, nr = ab_re - 1.f, ni = ab_im;
    const float cr = (nr * a_re + ni * a_im) / den, ci = (ni * a_re - nr * a_im) / den;
    float* t = tab + i * S5TW; t[0] = ab_re; t[1] = ab_im;
    for (int c = 0; c < S5CH; ++c) { const float br = p.in[I_S5BRE][((l * S5G + g) * S5P + pp) * S5CH + c], bi = p.in[I_S5BIM][((l * S5G + g) * S5P + pp) * S5CH + c];
      t[2 + c] = cr * br - ci * bi; t[2 + S5CH + c] = cr * bi + ci * br; } }
}
__global__ void nk_load_x(Params p) {
  float* X2 = WSP(float, p, x2);
  GSTRIDE(i, (long)MROWS * DM) { int R = (int)(i / DM), d = (int)(i % DM), b = row_b(R), t = row_t(R);
    X2[i] = t < SEQ ? p.in[I_X][((long)b * SEQ + t) * DM + d] : p.in[I_CTX][((long)b * CTXL + (t - SEQ)) * DM + d]; }
}
__global__ void nk_ln_mod(Params p, bf16_t* H, const float* X, int l, int ch_sh, int ch_sc) {
  const float* mod = WSP(float, p, mod) + (long)l * 3 * 6 * DM;
  GSTRIDE(R, MROWS) { const float* x = X + R * DM; float s = 0.f; for (int d = 0; d < DM; ++d) s += x[d]; const float mean = s / DM;
    float v = 0.f; for (int d = 0; d < DM; ++d) { float c = x[d] - mean; v += c * c; } const float rs = 1.f / sqrtf(v / DM + NORM_EPS);
    const float* m = mod + (long)row_mod((int)R) * 6 * DM;
    for (int d = 0; d < DM; ++d) H[R * DM + d] = f2bf((x[d] - mean) * rs * (1.f + m[ch_sc * DM + d]) + m[ch_sh * DM + d]); }
}
template <class Epi> __global__ void nk_gemm(const bf16_t* A, long lda, const bf16_t* Bt, long ldb, int M, int N, int K, Epi epi) {
  GSTRIDE(i, (long)M * (N / 4)) { int m = (int)(i / (N / 4)), n = (int)(i % (N / 4)) * 4; float a0 = 0.f, a1 = 0.f, a2 = 0.f, a3 = 0.f;
    const bf16_t* ar = A + (long)m * lda; const bf16_t* b0 = Bt + (long)n * ldb;
    for (int k = 0; k < K; ++k) { const float a = bf2f(ar[k]); a0 += a * bf2f(b0[k]); a1 += a * bf2f(b0[ldb + k]); a2 += a * bf2f(b0[2 * ldb + k]); a3 += a * bf2f(b0[3 * ldb + k]); }
    epi(m, n, a0, a1, a2, a3); }
}
struct EpStoreBf16 { bf16_t* C; long ldc; __host__ __device__ void operator()(int m, int n, float a0, float a1, float a2, float a3) const {
  bf16_t* c = C + (long)m * ldc + n; c[0] = f2bf(a0); c[1] = f2bf(a1); c[2] = f2bf(a2); c[3] = f2bf(a3); } };
struct EpStoreF32 { float* C; long ldc; __host__ __device__ void operator()(int m, int n, float a0, float a1, float a2, float a3) const {
  float* c = C + (long)m * ldc + n; c[0] = a0; c[1] = a1; c[2] = a2; c[3] = a3; } };
struct EpKV { bf16_t* KM; bf16_t* VM; __host__ __device__ void operator()(int m, int n, float a0, float a1, float a2, float a3) const {
  const int h = n / (MNOPE + MV), r = n % (MNOPE + MV);
  bf16_t* c = (r < MNOPE) ? KM + (long)m * MH * MQK + h * MQK + r : VM + (long)m * MH * MV + h * MV + (r - MNOPE);
  c[0] = f2bf(a0); c[1] = f2bf(a1); c[2] = f2bf(a2); c[3] = f2bf(a3); } };
struct EpGlu { const bf16_t* Z; bf16_t* O; __host__ __device__ void operator()(int m, int n, float a0, float a1, float a2, float a3) const {
  const bf16_t* z = Z + (long)m * BW + n; bf16_t* o = O + (long)m * DM + n;
  o[0] = f2bf(bf2f(z[0]) * sigmoidf_(a0)); o[1] = f2bf(bf2f(z[1]) * sigmoidf_(a1)); o[2] = f2bf(bf2f(z[2]) * sigmoidf_(a2)); o[3] = f2bf(bf2f(z[3]) * sigmoidf_(a3)); } };
struct EpDown { const float* gate; bf16_t* Y; __host__ __device__ void operator()(int m, int n, float a0, float a1, float a2, float a3) const {
  const float g = gate[m]; bf16_t* y = Y + (long)m * DM + n; y[0] = f2bf(a0 * g); y[1] = f2bf(a1 * g); y[2] = f2bf(a2 * g); y[3] = f2bf(a3 * g); } };

__device__ __forceinline__ void rope_pair(bf16_t* x, int i1, int i2, float sc1, float sc2, bool rot, const float* cs) {
  const float c = rot ? cs[0] : 1.f, s = rot ? cs[1] : 0.f; const float a = bf2f(x[i1]) * sc1, b = bf2f(x[i2]) * sc2; x[i1] = f2bf(a * c - b * s); x[i2] = f2bf(a * s + b * c);
}
__global__ void nk_post_proj(Params p, int l) {
  bf16_t* P = WSP(bf16_t, p, regA); const float* ta = WSP(float, p, rope_a); const float* tb = WSP(float, p, rope_b);
  constexpr int NJ = GH + GKV + 2 * RH + 3;
  GSTRIDE(i, (long)MROWS * NJ) { const int R = (int)(i / NJ), j = (int)(i % NJ), t = row_t(R); const bool lat = t < SEQ; const int gr = lat ? t / GRIDW : 0, gc = lat ? t % GRIDW : 0;
    bf16_t* pr = P + (long)R * PW;
    if (j < GH + GKV) {
      bf16_t* x = pr + (j < GH ? OFF_GQ + j * GHD : OFF_GK + (j - GH) * GHD); const float* g = p.in[j < GH ? I_GQN : I_GKN] + l * GHD;
      float ss = 0.f; for (int d = 0; d < GHD; ++d) { float v = bf2f(x[d]); ss += v * v; } const float r = 1.f / sqrtf(ss / GHD + NORM_EPS);
      for (int hf = 0; hf < 2; ++hf) for (int k = 0; k < NROPE_A; ++k) { const int i1 = hf * 2 * NROPE_A + k, i2 = i1 + NROPE_A;
        rope_pair(x, i1, i2, r * g[i1], r * g[i2], lat, ta + ((hf ? gc : gr) * NROPE_A + k) * 2); }
    } else if (j < GH + GKV + 2 * RH) {
      const int jj = j - GH - GKV; const bool isk = jj >= RH; bf16_t* x = pr + (isk ? OFF_RK + (jj - RH) * RQK : OFF_RQ + jj * RQK); const float sc = isk ? 1.f / sqrtf((float)RQK) : 1.f;
      for (int hf = 0; hf < 2; ++hf) for (int k = 0; k < NROPE_B; ++k) { const int i1 = hf * 2 * NROPE_B + k, i2 = i1 + NROPE_B;
        rope_pair(x, i1, i2, sc, sc, lat, tb + ((hf ? gc : gr) * NROPE_B + k) * 2); }
    } else if (j == GH + GKV + 2 * RH) {
      bf16_t* x = pr + OFF_CQ; const float* g = p.in[I_MQN] + l * MQL; float ss = 0.f; for (int d = 0; d < MQL; ++d) { float v = bf2f(x[d]); ss += v * v; }
      const float r = 1.f / sqrtf(ss / MQL + NORM_EPS); for (int d = 0; d < MQL; ++d) x[d] = f2bf(bf2f(x[d]) * r * g[d]);
    } else if (j == GH + GKV + 2 * RH + 1) {
      bf16_t* x = pr + OFF_CKV; const float* g = p.in[I_MKVN] + l * MKVL; float ss = 0.f; for (int d = 0; d < MKVL; ++d) { float v = bf2f(x[d]); ss += v * v; }
      const float r = 1.f / sqrtf(ss / MKVL + NORM_EPS); for (int d = 0; d < MKVL; ++d) x[d] = f2bf(bf2f(x[d]) * r * g[d]);
    } else if (lat) {
      bf16_t* x = pr + OFF_KR;
      for (int hf = 0; hf < 2; ++hf) for (int k = 0; k < NROPE_B; ++k) { const int i1 = hf * 2 * NROPE_B + k, i2 = i1 + NROPE_B; rope_pair(x, i1, i2, 1.f, 1.f, true, tb + ((hf ? gc : gr) * NROPE_B + k) * 2); }
    } }
}
__global__ void nk_post_mla(Params p) {
  bf16_t* P = WSP(bf16_t, p, regA); bf16_t* QM = WSP(bf16_t, p, qm); bf16_t* KM = WSP(bf16_t, p, km); const float* tb = WSP(float, p, rope_b);
  GSTRIDE(i, (long)MROWS * MH) { const int R = (int)(i / MH), h = (int)(i % MH), t = row_t(R); const bool lat = t < SEQ;
    if (lat) { const int gr = t / GRIDW, gc = t % GRIDW; bf16_t* x = QM + (long)R * MH * MQK + h * MQK + MNOPE;
      for (int hf = 0; hf < 2; ++hf) for (int k = 0; k < NROPE_B; ++k) { const int i1 = hf * 2 * NROPE_B + k, i2 = i1 + NROPE_B; rope_pair(x, i1, i2, 1.f, 1.f, true, tb + ((hf ? gc : gr) * NROPE_B + k) * 2); } }
    for (int d = 0; d < MROPE; ++d) KM[(long)R * MH * MQK + h * MQK + MNOPE + d] = P[(long)R * PW + OFF_KR + d]; }
}
__global__ void nk_post_mla_q(Params p) {
  bf16_t* QM = WSP(bf16_t, p, qm); const float* tb = WSP(float, p, rope_b);
  GSTRIDE(i, (long)MROWS * MH) { const int R = (int)(i / MH), h = (int)(i % MH), t = row_t(R); const bool lat = t < SEQ;
    if (lat) { const int gr = t / GRIDW, gc = t % GRIDW; bf16_t* x = QM + (long)R * MH * MQK + h * MQK + MNOPE;
      for (int hf = 0; hf < 2; ++hf) for (int k = 0; k < NROPE_B; ++k) { const int i1 = hf * 2 * NROPE_B + k, i2 = i1 + NROPE_B; rope_pair(x, i1, i2, 1.f, 1.f, true, tb + ((hf ? gc : gr) * NROPE_B + k) * 2); } } }
}
__global__ void nk_s5_scan(Params p, int l) {
  const bf16_t* P = WSP(bf16_t, p, regA); float* HS = (float*)(p.ws + WS.regA + SZ_P); const float* tab = WSP(float, p, s5tab);
  GSTRIDE(i, (long)NB * S5G * S5P) { const int pp = (int)(i % S5P), g = (int)((i / S5P) % S5G), b = (int)(i / (S5P * S5G));
    for (int dir = 0; dir < 2; ++dir) { const float* t = tab + ((((long)l * 2 + dir) * S5G + g) * S5P + pp) * S5TW; const float are = t[0], aim = t[1]; float hr = 0.f, hi = 0.f;
      for (int s = 0; s < NTOK; ++s) {
        int tt; if (!dir) tt = s < CTXL ? SEQ + s : s - CTXL; else tt = s < CTXL ? SEQ + (CTXL - 1 - s) : SEQ - 1 - (s - CTXL);
        const long R = (long)b * NTOK + tt; const bf16_t* u = P + R * PW + OFF_U + g * S5CH; float br = 0.f, bi = 0.f;
        for (int c = 0; c < S5CH; ++c) { const float uv = bf2f(u[c]); br += uv * t[2 + c]; bi += uv * t[2 + S5CH + c]; }
        const float nr = are * hr - aim * hi + br, ni = are * hi + aim * hr + bi; hr = nr; hi = ni;
        float* hs = HS + ((R * S5G + g) * S5P + pp) * 2; if (!dir) { hs[0] = hr; hs[1] = hi; } else { hs[0] += hr; hs[1] += hi; } } } }
}
__global__ void nk_s5_read(Params p, int l) {
  const bf16_t* P = WSP(bf16_t, p, regA); const float* HS = (const float*)(p.ws + WS.regA + SZ_P); bf16_t* Z = WSP(bf16_t, p, z);
  GSTRIDE(i, (long)MROWS * BW) { const long R = i / BW; const int c = (int)(i % BW), g = c / S5CH, ci = c % S5CH;
    const float* hs = HS + (R * S5G + g) * S5P * 2; const float* cre = p.in[I_S5CRE] + (((long)l * S5G + g) * S5CH + ci) * S5P; const float* cim = p.in[I_S5CIM] + (((long)l * S5G + g) * S5CH + ci) * S5P;
    float y = 0.f; for (int pp = 0; pp < S5P; ++pp) y += hs[2 * pp] * cre[pp] - hs[2 * pp + 1] * cim[pp];
    y += p.in[I_S5D][l * BW + c] * bf2f(P[R * PW + OFF_U + c]); Z[i] = f2bf(gelu_tanh(y)); }
}
template <int DQK, int DV> __global__ void __launch_bounds__(256) nk_attn(const bf16_t* Q, const bf16_t* K, const bf16_t* V, bf16_t* O, int ldq, int ldk, int ldv, int ldo, int H, int group, float scale) {
  GSTRIDE(i, (long)MROWS * H) { const int R = (int)(i / H), h = (int)(i % H), b = row_b(R), kh = h / group; const bool lat = !row_is_ctx(R);
    const bf16_t* q = Q + (long)R * ldq + h * DQK; float o[DV]; _Pragma("unroll") for (int d = 0; d < DV; ++d) o[d] = 0.f; float m = -1e30f, lsum = 0.f;
    for (int kk = lat ? 0 : SEQ; kk < NTOK; ++kk) { const long KR = (long)b * NTOK + kk; const bf16_t* kp = K + KR * ldk + kh * DQK; float s = 0.f;
      for (int d = 0; d < DQK; ++d) s += bf2f(q[d]) * bf2f(kp[d]); s *= scale;
      if (s > m) { const float corr = expf(m - s); lsum *= corr; _Pragma("unroll") for (int d = 0; d < DV; ++d) o[d] *= corr; m = s; }
      const float pw = expf(s - m); lsum += pw; const bf16_t* vp = V + KR * ldv + kh * DV; _Pragma("unroll") for (int d = 0; d < DV; ++d) o[d] += pw * bf2f(vp[d]); }
    const float inv = 1.f / lsum; _Pragma("unroll") for (int d = 0; d < DV; ++d) O[(long)R * ldo + h * DV + d] = f2bf(o[d] * inv); }
}
__global__ void __launch_bounds__(256) nk_ret(Params p, int l) {
  const bf16_t* P = WSP(bf16_t, p, regA); bf16_t* O = WSP(bf16_t, p, oall);
  GSTRIDE(i, (long)MROWS * RH) { const int R = (int)(i / RH), h = (int)(i % RH), b = row_b(R), t = row_t(R); const bool lat = t < SEQ;
    const float lgf = -expf(p.in[I_RDF][l * RH + h]), lgb = -expf(p.in[I_RDB][l * RH + h]);
    const bf16_t* q = P + (long)R * PW + OFF_RQ + h * RQK; float o[RV]; _Pragma("unroll") for (int d = 0; d < RV; ++d) o[d] = 0.f;
    for (int kk = lat ? 0 : SEQ; kk < NTOK; ++kk) { float w;
      if (lat) { if (kk < SEQ) w = kk <= t ? expf(lgf * (float)(t - kk)) : expf(lgb * (float)(kk - t)); else { const int j = kk - SEQ; w = expf(lgf * (float)(t + CTXL - j)) + expf(lgb * (float)(SEQ - t + j)); } }
      else { const int j = t - SEQ, j2 = kk - SEQ; w = j2 <= j ? expf(lgf * (float)(j - j2)) : expf(lgb * (float)(j2 - j)); }
      const long KR = (long)b * NTOK + kk; const bf16_t* kp = P + KR * PW + OFF_RK + h * RQK; float s = 0.f; for (int d = 0; d < RQK; ++d) s += bf2f(q[d]) * bf2f(kp[d]); s *= w;
      const bf16_t* vp = P + KR * PW + OFF_RV + h * RV; _Pragma("unroll") for (int d = 0; d < RV; ++d) o[d] += s * bf2f(vp[d]); }
    float mean = 0.f; _Pragma("unroll") for (int d = 0; d < RV; ++d) mean += o[d]; mean /= RV; float var = 0.f; _Pragma("unroll") for (int d = 0; d < RV; ++d) { const float c = o[d] - mean; var += c * c; }
    const float rs = 1.f / sqrtf(var / RV + NORM_EPS); const bf16_t* gp = P + (long)R * PW + OFF_RG + h * RV; const float* gain = p.in[I_RNORM] + l * BW + h * RV;
    _Pragma("unroll") for (int d = 0; d < RV; ++d) O[(long)R * DM + 2 * BW + h * RV + d] = f2bf((o[d] - mean) * rs * gain[d] * siluf_(bf2f(gp[d]))); }
}
__global__ void nk_gate_merge(Params p, int l) {
  const bf16_t* H = WSP(bf16_t, p, h1); const bf16_t* Wg = WSP(bf16_t, p, wt_gate) + (long)l * 4 * DM * DM; const bf16_t* PROJ = (const bf16_t*)(p.ws + WS.regA + SZ_P); bf16_t* MG = WSP(bf16_t, p, merged);
  const float* bg = p.in[I_BGATE] + (long)l * 4 * DM;
  GSTRIDE(i, (long)MROWS * DM) { const long R = i / DM; const int d = (int)(i % DM); const bf16_t* hr = H + R * DM; float acc = 0.f;
    for (int k = 0; k < 4; ++k) { const bf16_t* w = Wg + ((long)k * DM + d) * DM; float s = 0.f; for (int c = 0; c < DM; ++c) s += bf2f(hr[c]) * bf2f(w[c]);
      acc += sigmoidf_(s + bg[k * DM + d]) * bf2f(PROJ[R * 4 * DM + k * DM + d]); }
    MG[i] = f2bf(acc); }
}
__global__ void nk_ln1(Params p, int l) {
  const float* X2 = WSP(float, p, x2); const float* Y = WSP(float, p, macc); float* X1 = WSP(float, p, x1); bf16_t* H2 = WSP(bf16_t, p, h2); float* AFF = WSP(float, p, aff);
  const float* mod = WSP(float, p, mod) + (long)l * 3 * 6 * DM; const float* lg = p.in[I_LN1G] + l * DM; const float* lb = p.in[I_LN1B] + l * DM; const float* rw = p.in[I_ROUTER] + (long)l * DM * NE;
  GSTRIDE(R, MROWS) { const float* m = mod + (long)row_mod((int)R) * 6 * DM; const float* x = X2 + R * DM; const float* y = Y + R * DM; float* x1 = X1 + R * DM;
    float s = 0.f; for (int d = 0; d < DM; ++d) { const float v = DN_ALPHA * x[d] + m[2 * DM + d] * y[d]; x1[d] = v; s += v; } float mean = s / DM;
    float var = 0.f; for (int d = 0; d < DM; ++d) { const float c = x1[d] - mean; var += c * c; } float rs = 1.f / sqrtf(var / DM + NORM_EPS);
    s = 0.f; for (int d = 0; d < DM; ++d) { const float v = (x1[d] - mean) * rs * lg[d] + lb[d]; x1[d] = v; s += v; } mean = s / DM;
    var = 0.f; for (int d = 0; d < DM; ++d) { const float c = x1[d] - mean; var += c * c; } rs = 1.f / sqrtf(var / DM + NORM_EPS);
    float lo[NE]; _Pragma("unroll") for (int e = 0; e < NE; ++e) lo[e] = 0.f;
    for (int d = 0; d < DM; ++d) { const float hv = (x1[d] - mean) * rs * (1.f + m[4 * DM + d]) + m[3 * DM + d]; H2[R * DM + d] = f2bf(hv); _Pragma("unroll") for (int e = 0; e < NE; ++e) lo[e] += hv * rw[(long)d * NE + e]; }
    float mx = lo[0]; _Pragma("unroll") for (int e = 1; e < NE; ++e) mx = fmaxf(mx, lo[e]); float se = 0.f; _Pragma("unroll") for (int e = 0; e < NE; ++e) { lo[e] = expf(lo[e] - mx); se += lo[e]; }
    _Pragma("unroll") for (int e = 0; e < NE; ++e) AFF[R * NE + e] = lo[e] / se; }
}
__global__ void nk_topk(Params p, int with_ctx) {
  const float* AFF = WSP(float, p, aff); int* SLOT = WSP(int, p, slot); float* GV = WSP(float, p, gatev); int* XSRC = WSP(int, p, xsrc);
  GSTRIDE(i, (long)MROWS * NE) { const int R = (int)(i / NE), e = (int)(i % NE), b = row_b(R), t = row_t(R); const bool lat = t < SEQ;
    if (!lat && !with_ctx) { SLOT[i] = -1; continue; }
    const int k0 = lat ? 0 : SEQ, k1 = lat ? SEQ : NTOK, cap = lat ? CAP_L : CAP_C; const float a = AFF[i]; int rank = 0;
    for (int kk = k0; kk < k1; ++kk) { const float o = AFF[((long)b * NTOK + kk) * NE + e]; rank += (o > a || (o == a && kk < t)) ? 1 : 0; }
    if (rank < cap) { const int xr = e * XEP + (lat ? b * CAP_L : 2 * CAP_L + b * CAP_C) + rank; SLOT[i] = xr; GV[xr] = a; XSRC[xr] = R; } else SLOT[i] = -1; }
}
__global__ void nk_gather(Params p) {
  const int* XSRC = WSP(int, p, xsrc); const bf16_t* H2 = WSP(bf16_t, p, h2); bf16_t* XS = WSP(bf16_t, p, regA);
  GSTRIDE(i, (long)XROWS * DM) { const long xr = i / DM; const int d = (int)(i % DM), src = XSRC[xr]; XS[i] = src >= 0 ? H2[(long)src * DM + d] : (bf16_t)0; }
}
__global__ void nk_moe_up(Params p, int l) {
  const bf16_t* XS = WSP(bf16_t, p, regA); bf16_t* ACT = (bf16_t*)(p.ws + WS.regA + SZ_XS); const bf16_t* W = WSP(bf16_t, p, wt_gu) + (long)l * NE * 2 * FF * DM; const int* XSRC = WSP(int, p, xsrc);
  GSTRIDE(i, (long)XROWS * FF) { const long xr = i / FF; const int f = (int)(i % FF), e = (int)(xr / XEP); if (XSRC[xr] < 0) { ACT[i] = 0; continue; }
    const int jg = (f / 128) * 256 + (f % 128), ju = jg + 128; const bf16_t* x = XS + xr * DM; const bf16_t* wg = W + ((long)e * 2 * FF + jg) * DM; const bf16_t* wu = W + ((long)e * 2 * FF + ju) * DM;
    float a = 0.f, u = 0.f; for (int k = 0; k < DM; ++k) { const float xv = bf2f(x[k]); a += xv * bf2f(wg[k]); u += xv * bf2f(wu[k]); }
    ACT[i] = f2bf(siluf_(a) * u); }
}
__global__ void nk_ln2(Params p, int l, int last) {
  const float* X1 = WSP(float, p, x1); float* X2 = WSP(float, p, x2); const int* SLOT = WSP(int, p, slot); const bf16_t* YS = (const bf16_t*)(p.ws + WS.regA + SZ_XS + SZ_ACT);
  const float* mod = WSP(float, p, mod) + (long)l * 3 * 6 * DM; const float* lg = p.in[I_LN2G] + l * DM; const float* lb = p.in[I_LN2B] + l * DM;
  GSTRIDE(R, MROWS) { if (last && row_is_ctx((int)R)) continue; const float* m = mod + (long)row_mod((int)R) * 6 * DM; const float* x1 = X1 + R * DM; float* x2 = X2 + R * DM;
    float s = 0.f; for (int d = 0; d < DM; ++d) { float mo = 0.f; for (int e = 0; e < NE; ++e) { const int sl = SLOT[R * NE + e]; if (sl >= 0) mo += bf2f(YS[(long)sl * DM + d]); }
      const float v = DN_ALPHA * x1[d] + m[5 * DM + d] * mo; x2[d] = v; s += v; } const float mean = s / DM;
    float var = 0.f; for (int d = 0; d < DM; ++d) { const float c = x2[d] - mean; var += c * c; } const float rs = 1.f / sqrtf(var / DM + NORM_EPS);
    for (int d = 0; d < DM; ++d) { const float v = (x2[d] - mean) * rs * lg[d] + lb[d]; x2[d] = v; if (last) p.out[((long)row_b((int)R) * SEQ + row_t((int)R)) * DM + d] = v; } }
}
#ifdef CPU_TEST
void cpu_hook(const char* name, int l, Params& p);
#define HOOK(name) cpu_hook(name, l, p)
#else
#define HOOK(name)
#endif
#define NG(n) (int)((((long)(n)) + 255) / 256 < 65536 ? (((long)(n)) + 255) / 256 : 65536)

static void naive_prologue(Params& p, hipStream_t stream) {
  for (int l = 0; l < NLAYER; ++l) {
    LAUNCH(nk_conv_t, NG((long)PW * DM), 256, WSP(bf16_t, p, wt_in) + (long)l * PW * DM, p.in[I_WIN] + (long)l * DM * IN_TOTAL, DM, IN_TOTAL, IN_TOTAL, PW);
    LAUNCH(nk_conv_t, NG((long)4 * DM * DM), 256, WSP(bf16_t, p, wt_gate) + (long)l * 4 * DM * DM, p.in[I_WGATE] + (long)l * DM * 4 * DM, DM, 4 * DM, 4 * DM, 4 * DM);
    for (int k = 0; k < 4; ++k)
      LAUNCH(nk_conv_t, NG((long)DM * BW), 256, WSP(bf16_t, p, wt_br) + ((long)l * 4 + k) * DM * BW, p.in[I_WBR] + ((long)l * 4 + k) * BW * DM, BW, DM, DM, DM);
    LAUNCH(nk_conv_t, NG((long)DM * DM), 256, WSP(bf16_t, p, wt_out) + (long)l * DM * DM, p.in[I_WOUT] + (long)l * DM * DM, DM, DM, DM, DM);
    LAUNCH(nk_conv_t, NG((long)BW * BW), 256, WSP(bf16_t, p, wt_glu) + (long)l * BW * BW, p.in[I_S5GLU] + (long)l * BW * BW, BW, BW, BW, BW);
    LAUNCH(nk_conv_t, NG((long)MH * MQK * MQL), 256, WSP(bf16_t, p, wt_uq) + (long)l * MH * MQK * MQL, p.in[I_WUQ] + (long)l * MQL * MH * MQK, MQL, MH * MQK, MH * MQK, MH * MQK);
    LAUNCH(nk_conv_t, NG((long)MH * (MNOPE + MV) * MKVL), 256, WSP(bf16_t, p, wt_ukv) + (long)l * MH * (MNOPE + MV) * MKVL, p.in[I_WUKV] + (long)l * MKVL * MH * (MNOPE + MV), MKVL, MH * (MNOPE + MV), MH * (MNOPE + MV), MH * (MNOPE + MV));
    for (int e = 0; e < NE; ++e) {
      LAUNCH(nk_conv_gu, NG((long)2 * FF * DM), 256, WSP(bf16_t, p, wt_gu) + ((long)l * NE + e) * 2 * FF * DM, p.in[I_MOEG] + ((long)l * NE + e) * DM * FF, p.in[I_MOEU] + ((long)l * NE + e) * DM * FF);
      LAUNCH(nk_conv_t, NG((long)DM * FF), 256, WSP(bf16_t, p, wt_dn) + ((long)l * NE + e) * DM * FF, p.in[I_MOED] + ((long)l * NE + e) * FF * DM, FF, DM, DM, DM);
    }
  }
  LAUNCH(nk_mod, NG((long)NLAYER * 18 * DM), 256, p);
  LAUNCH(nk_rope_tab, 4, 256, p);
  LAUNCH(nk_s5tab, NG((long)NLAYER * 2 * S5G * S5P), 256, p);
  LAUNCH(nk_load_x, NG((long)MROWS * DM), 256, p);
}

#ifdef CPU_TEST
static void naive_layer(Params& p, int l, hipStream_t stream) {
  bf16_t* P = WSP(bf16_t, p, regA); bf16_t* PROJ = (bf16_t*)(p.ws + WS.regA + SZ_P); bf16_t* H1 = WSP(bf16_t, p, h1);
  bf16_t* QM = WSP(bf16_t, p, qm); bf16_t* KM = WSP(bf16_t, p, km); bf16_t* VM = WSP(bf16_t, p, vm); bf16_t* Z = WSP(bf16_t, p, z); bf16_t* OA = WSP(bf16_t, p, oall);
  LAUNCH(nk_ln_mod, NG(MROWS), 256, p, H1, (const float*)WSP(float, p, x2), l, 0, 1);
  HOOK("h");
  LAUNCH(nk_gemm<EpStoreBf16>, NG((long)MROWS * PW / 4), 256, (const bf16_t*)H1, (long)DM, (const bf16_t*)(WSP(bf16_t, p, wt_in) + (long)l * PW * DM), (long)DM, MROWS, PW, DM, EpStoreBf16{P, PW});
  LAUNCH(nk_post_proj, NG((long)MROWS * 17), 256, p, l);
  LAUNCH(nk_gemm<EpStoreBf16>, NG((long)MROWS * MH * MQK / 4), 256, (const bf16_t*)(P + OFF_CQ), (long)PW, (const bf16_t*)(WSP(bf16_t, p, wt_uq) + (long)l * MH * MQK * MQL), (long)MQL, MROWS, MH * MQK, MQL, EpStoreBf16{QM, MH * MQK});
  LAUNCH(nk_gemm<EpKV>, NG((long)MROWS * MH * (MNOPE + MV) / 4), 256, (const bf16_t*)(P + OFF_CKV), (long)PW, (const bf16_t*)(WSP(bf16_t, p, wt_ukv) + (long)l * MH * (MNOPE + MV) * MKVL), (long)MKVL, MROWS, MH * (MNOPE + MV), MKVL, EpKV{KM, VM});
  LAUNCH(nk_post_mla, NG((long)MROWS * MH), 256, p);
  LAUNCH(nk_s5_scan, NG((long)NB * S5G * S5P), 256, p, l);
  LAUNCH(nk_s5_read, NG((long)MROWS * BW), 256, p, l);
  LAUNCH(nk_gemm<EpGlu>, NG((long)MROWS * BW / 4), 256, (const bf16_t*)Z, (long)BW, (const bf16_t*)(WSP(bf16_t, p, wt_glu) + (long)l * BW * BW), (long)BW, MROWS, BW, BW, EpGlu{Z, OA});
  HOOK("o_s5");
  LAUNCH((nk_attn<GHD, GHD>), NG((long)MROWS * GH), 256, (const bf16_t*)(P + OFF_GQ), (const bf16_t*)(P + OFF_GK), (const bf16_t*)(P + OFF_GV), OA + BW, PW, PW, PW, DM, GH, GH / GKV, 1.f / sqrtf((float)GHD));
  HOOK("o_gqa");
  LAUNCH(nk_ret, NG((long)MROWS * RH), 256, p, l);
  HOOK("o_ret");
  LAUNCH((nk_attn<MQK, MV>), NG((long)MROWS * MH), 256, (const bf16_t*)QM, (const bf16_t*)KM, (const bf16_t*)VM, OA + 3 * BW, MH * MQK, MH * MQK, MH * MV, DM, MH, 1, 1.f / sqrtf((float)MQK));
  HOOK("o_mla");
  for (int k = 0; k < 4; ++k)
    LAUNCH(nk_gemm<EpStoreBf16>, NG((long)MROWS * DM / 4), 256, (const bf16_t*)(OA + k * BW), (long)DM, (const bf16_t*)(WSP(bf16_t, p, wt_br) + ((long)l * 4 + k) * DM * BW), (long)BW, MROWS, DM, BW, EpStoreBf16{PROJ + (long)k * DM, 4 * DM});
  LAUNCH(nk_gate_merge, NG((long)MROWS * DM), 256, p, l);
  LAUNCH(nk_gemm<EpStoreF32>, NG((long)MROWS * DM / 4), 256, (const bf16_t*)WSP(bf16_t, p, merged), (long)DM, (const bf16_t*)(WSP(bf16_t, p, wt_out) + (long)l * DM * DM), (long)DM, MROWS, DM, DM, EpStoreF32{WSP(float, p, macc), DM});
  HOOK("y");
  LAUNCH(nk_ln1, NG(MROWS), 256, p, l);
  HOOK("x1");
  hipMemsetAsync(p.ws + WS.xsrc, 0xFF, (size_t)XROWS * 4, stream);
  LAUNCH(nk_topk, NG((long)MROWS * NE), 256, p, l == 0 ? 1 : 0);
  LAUNCH(nk_gather, NG((long)XROWS * DM), 256, p);
  LAUNCH(nk_moe_up, NG((long)XROWS * FF), 256, p, l);
  bf16_t* ACT = (bf16_t*)(p.ws + WS.regA + SZ_XS); bf16_t* YS = (bf16_t*)(p.ws + WS.regA + SZ_XS + SZ_ACT);
  for (int e = 0; e < NE; ++e)
    LAUNCH(nk_gemm<EpDown>, NG((long)XEP * DM / 4), 256, (const bf16_t*)(ACT + (long)e * XEP * FF), (long)FF, (const bf16_t*)(WSP(bf16_t, p, wt_dn) + ((long)l * NE + e) * DM * FF), (long)FF, XEP, DM, FF,
           EpDown{WSP(float, p, gatev) + e * XEP, YS + (long)e * XEP * DM});
  LAUNCH(nk_ln2, NG(MROWS), 256, p, l, l == NLAYER - 1 ? 1 : 0);
  HOOK("x2");
}
#endif
#ifndef CPU_TEST
#ifndef PG8_SP2
#define PG8_SP2 true
#endif
namespace pg8 {
#define PG8_LAS __attribute__((address_space(3)))
typedef short bf16x8 __attribute__((ext_vector_type(8)));
typedef float f32x4 __attribute__((ext_vector_type(4)));
typedef unsigned u32x4 __attribute__((ext_vector_type(4)));
constexpr int BM = 256, BK = 64, HALF = 128, HTB = HALF * BK * 2, STAGE_BYTES = 8 * HTB, NXCD = 8, WGM = 8;
__host__ __device__ __forceinline__ int lds_byte(int r, int c) { const int st = (r >> 4) * 2 + (c >> 5), rr = r & 15, cc = c & 31, ob = rr * 64 + cc * 2; return st * 1024 + (ob ^ (((ob >> 9) & 1) << 5)); }
__host__ __device__ __forceinline__ void stage_rc(int b, int& R, int& C) { const int st = b / 1024, sb = b % 1024, swz = sb ^ (((sb >> 9) & 1) << 5); R = (st >> 1) * 16 + swz / 64; C = (st & 1) * 32 + (swz % 64) / 2; }
__host__ __device__ __forceinline__ int perm32(int rho) { const int n = rho >> 4, i = rho & 15; return 8 * (i >> 2) + 4 * n + (i & 3); }

struct Unit { int pm, pn, aux; const char* A; const char* B; };
struct GemmG { int lda, ldb, K, bmode; };

__device__ __forceinline__ bool tile_order(long L, int nM, int nN, int& pm, int& pn) {
  const int nwg = nM * nN; if (L >= nwg) return false;
  int wgid = (int)L; { const int q = nwg / NXCD, r = nwg % NXCD, xcd = wgid % NXCD, off = wgid / NXCD; wgid = (xcd < r ? xcd * (q + 1) : r * (q + 1) + (xcd - r) * q) + off; }
  const int nig = WGM * nN, gid = wgid / nig, fm = gid * WGM, gsz = (nM - fm) < WGM ? (nM - fm) : WGM;
  pm = fm + ((wgid % nig) % gsz); pn = (wgid % nig) / gsz; return true;
}
__device__ __forceinline__ unsigned cvt_pk_bf16(float lo, float hi) { unsigned r; asm volatile("v_cvt_pk_bf16_f32 %0, %1, %2" : "=v"(r) : "v"(lo), "v"(hi)); return r; }
__device__ __forceinline__ u32x4 pack8(const f32x4 a, const f32x4 b) { u32x4 w; w.x = cvt_pk_bf16(a[0], a[1]); w.y = cvt_pk_bf16(a[2], a[3]); w.z = cvt_pk_bf16(b[0], b[1]); w.w = cvt_pk_bf16(b[2], b[3]); return w; }
__device__ __forceinline__ void unpack8(const u32x4 w, f32x4& a, f32x4& b) {
  a[0] = __uint_as_float(w.x << 16); a[1] = __uint_as_float(w.x & 0xffff0000u); a[2] = __uint_as_float(w.y << 16); a[3] = __uint_as_float(w.y & 0xffff0000u);
  b[0] = __uint_as_float(w.z << 16); b[1] = __uint_as_float(w.z & 0xffff0000u); b[2] = __uint_as_float(w.w << 16); b[3] = __uint_as_float(w.w & 0xffff0000u); }
#ifndef MK_NT
#define MK_NT 0
#endif
template <class T> __device__ __forceinline__ void st_out(T* p, const T v) { if (MK_NT) __builtin_nontemporal_store(v, p); else *p = v; }
__device__ __forceinline__ float fast_sigmoid(float x) { return __builtin_amdgcn_rcpf(1.f + __builtin_amdgcn_exp2f(-1.4426950408889634f * x)); }
__device__ __forceinline__ f32x4 sigmoid4(f32x4 v) { f32x4 o; o[0] = fast_sigmoid(v[0]); o[1] = fast_sigmoid(v[1]); o[2] = fast_sigmoid(v[2]); o[3] = fast_sigmoid(v[3]); return o; }

template <bool ALIGN = true, bool SP2 = PG8_SP2, class Epi, class Sched>
__device__ __forceinline__ void gemm_phase(PG8_LAS unsigned char* lds, const GemmG g, const Sched& S, const Epi& E) {
    const int tid = ph_tid(), wid = __builtin_amdgcn_readfirstlane(tid >> 6), lane = tid & 63, wr = wid >> 2, wc = wid & 3, fr = lane & 15, fq = lane >> 4;
    const int K = g.K, nt = K / BK;
    unsigned voffA[2], voffB[2];
#pragma unroll
    for (int i = 0; i < 2; ++i) { int R, C; stage_rc(tid * 16 + i * 8192, R, C); const int Rb = (R & ~31) + perm32(R & 31);
        const int wrow = g.bmode ? (((Rb >> 4) & 1) * DM + 16 * ((Rb >> 5) & 3) + (Rb & 15)) : Rb;
        voffA[i] = (unsigned)(R * g.lda + C) * 2u; voffB[i] = (unsigned)(wrow * g.ldb + C) * 2u; }
    const size_t kstep = (size_t)(BK * 2);
    const size_t hsA = (size_t)HALF * g.lda * 2, hsB = (size_t)(g.bmode ? 2 * DM : HALF) * g.ldb * 2;
    const unsigned ldsw = (unsigned)wid * 1024u;
    const int aoff = lds_byte(wr * 64 + fr, fq * 8), boff = lds_byte(wc * 32 + fr, fq * 8);
#define PG8_SA(b, h) (((b) * 2 + (h)) * HTB)
#define PG8_SB(b, h) ((4 + (b) * 2 + (h)) * HTB)
#define PG8_STAGE(bufoff, gbase, voff) do { _Pragma("unroll") for (int _i = 0; _i < 2; ++_i) \
        __builtin_amdgcn_global_load_lds((const unsigned*)((const char*)(gbase) + (voff)[_i]), (PG8_LAS unsigned*)(lds + (bufoff) + ldsw + _i * 8192), 16, 0, 0); } while (0)
#define PG8_LDA(dst, b, h) do { _Pragma("unroll") for (int m = 0; m < 4; ++m) _Pragma("unroll") for (int k = 0; k < 2; ++k) dst[m][k] = *(const PG8_LAS bf16x8*)(lds + PG8_SA(b, h) + aoff + m * 2048 + k * 1024); } while (0)
#define PG8_LDB(dst, b, h) do { _Pragma("unroll") for (int n = 0; n < 2; ++n) _Pragma("unroll") for (int k = 0; k < 2; ++k) dst[n][k] = *(const PG8_LAS bf16x8*)(lds + PG8_SB(b, h) + boff + n * 2048 + k * 1024); } while (0)
#define PG8_MMA(ai, bj, At, Bt) do { __builtin_amdgcn_s_setprio(1); _Pragma("unroll") for (int m = 0; m < 4; ++m) _Pragma("unroll") for (int n = 0; n < 2; ++n) _Pragma("unroll") for (int k = 0; k < 2; ++k) \
        acc[ai][bj][m][n] = __builtin_amdgcn_mfma_f32_16x16x32_bf16(Bt[n][k], At[m][k], acc[ai][bj][m][n], 0, 0, 0); __builtin_amdgcn_s_setprio(0); } while (0)
#define PG8_WAIT_V(n) asm volatile("s_waitcnt vmcnt(" #n ")" ::: "memory")
#define PG8_WAIT_L(n) asm volatile("s_waitcnt lgkmcnt(" #n ")" ::: "memory")
#define PG8_BAR __builtin_amdgcn_s_barrier()
#define PG8_SCHED __builtin_amdgcn_sched_barrier(0)
    Unit cur, nxt; int ui = 0;
    if (!S.next(0, cur)) return;
    f32x4 acc[2][2][4][2];
#pragma unroll
    for (int a = 0; a < 2; ++a)
#pragma unroll
        for (int b = 0; b < 2; ++b)
#pragma unroll
            for (int m = 0; m < 4; ++m)
#pragma unroll
                for (int n = 0; n < 2; ++n) acc[a][b][m][n] = (f32x4){0.f, 0.f, 0.f, 0.f};
    bf16x8 At[4][2], B0[2][2], B1[2][2];
    const char* cA = cur.A; const char* cB = cur.B;
    if constexpr (SP2) {
      PG8_STAGE(PG8_SB(0, 0), cB, voffB); PG8_STAGE(PG8_SB(0, 1), cB + hsB, voffB); PG8_STAGE(PG8_SA(0, 0), cA, voffA); PG8_STAGE(PG8_SA(0, 1), cA + hsA, voffA);
      if (wr == 1) PG8_BAR;
      PG8_WAIT_V(2); PG8_BAR;
      PG8_STAGE(PG8_SB(1, 0), cB + kstep, voffB); PG8_STAGE(PG8_SA(1, 0), cA + kstep, voffA); PG8_STAGE(PG8_SB(1, 1), cB + hsB + kstep, voffB);
      PG8_WAIT_V(6); PG8_BAR;
    } else {
    PG8_STAGE(PG8_SB(0, 0), cB, voffB); PG8_STAGE(PG8_SA(0, 0), cA, voffA); PG8_STAGE(PG8_SB(0, 1), cB + hsB, voffB); PG8_STAGE(PG8_SA(0, 1), cA + hsA, voffA);
    if (wr == 1) PG8_BAR;
    PG8_WAIT_V(4); PG8_BAR;
    PG8_STAGE(PG8_SB(1, 0), cB + kstep, voffB); PG8_STAGE(PG8_SA(1, 0), cA + kstep, voffA); PG8_STAGE(PG8_SB(1, 1), cB + hsB + kstep, voffB);
    PG8_WAIT_V(6); PG8_BAR;
    }
    for (;;) {
        const bool has_next = S.next(ui + 1, nxt);
        const char* nA = has_next ? nxt.A : cA; const char* nB = has_next ? nxt.B : cB;
        for (int t = 0; t < nt; t += 2) {
            const bool last = (t == nt - 2);
            const char* a1 = cA + (size_t)(t + 1) * kstep;
            const char* a2 = last ? nA : cA + (size_t)(t + 2) * kstep; const char* b2 = last ? nB : cB + (size_t)(t + 2) * kstep;
            const char* a3 = a2 + kstep; const char* b3 = b2 + kstep;
            if constexpr (SP2) {
            PG8_LDB(B0, 0, 0); PG8_LDB(B1, 0, 1); PG8_SCHED; PG8_LDA(At, 0, 0); PG8_STAGE(PG8_SA(1, 1), a1 + hsA, voffA);
            PG8_WAIT_V(8); PG8_WAIT_L(0); PG8_BAR; PG8_MMA(0, 0, At, B0); PG8_MMA(0, 1, At, B1); PG8_BAR; PG8_SCHED;
            PG8_LDA(At, 0, 1); PG8_STAGE(PG8_SB(0, 0), b2, voffB); PG8_STAGE(PG8_SB(0, 1), b2 + hsB, voffB); PG8_STAGE(PG8_SA(0, 0), a2, voffA);
            PG8_WAIT_V(8); PG8_WAIT_L(0); PG8_BAR; PG8_MMA(1, 0, At, B0); PG8_MMA(1, 1, At, B1); PG8_BAR; PG8_SCHED;
            PG8_LDB(B0, 1, 0); PG8_LDB(B1, 1, 1); PG8_SCHED; PG8_LDA(At, 1, 0); PG8_STAGE(PG8_SA(0, 1), a2 + hsA, voffA);
            PG8_WAIT_V(8); PG8_WAIT_L(0); PG8_BAR; PG8_MMA(0, 0, At, B0); PG8_MMA(0, 1, At, B1); PG8_BAR; PG8_SCHED;
            PG8_LDA(At, 1, 1); PG8_STAGE(PG8_SB(1, 0), b3, voffB); PG8_STAGE(PG8_SB(1, 1), b3 + hsB, voffB); PG8_STAGE(PG8_SA(1, 0), a3, voffA);
            PG8_WAIT_V(8); PG8_WAIT_L(0); PG8_BAR; PG8_MMA(1, 0, At, B0); PG8_MMA(1, 1, At, B1); PG8_BAR; PG8_SCHED;
            } else {
            PG8_LDB(B0, 0, 0); PG8_SCHED; PG8_LDA(At, 0, 0); PG8_STAGE(PG8_SA(1, 1), a1 + hsA, voffA);
            PG8_WAIT_L(8); PG8_BAR; PG8_WAIT_L(0); PG8_MMA(0, 0, At, B0); PG8_BAR; PG8_SCHED;
            PG8_LDB(B1, 0, 1); PG8_STAGE(PG8_SB(0, 0), b2, voffB);
            PG8_BAR; PG8_WAIT_L(0); PG8_MMA(0, 1, At, B1); PG8_BAR;
            PG8_LDA(At, 0, 1); PG8_STAGE(PG8_SA(0, 0), a2, voffA);
            PG8_BAR; PG8_WAIT_L(0); PG8_MMA(1, 0, At, B0); PG8_BAR; PG8_SCHED;
            PG8_STAGE(PG8_SB(0, 1), b2 + hsB, voffB);
            PG8_WAIT_V(6); PG8_BAR; PG8_MMA(1, 1, At, B1); PG8_BAR;
            PG8_LDB(B0, 1, 0); PG8_SCHED; PG8_LDA(At, 1, 0); PG8_STAGE(PG8_SA(0, 1), a2 + hsA, voffA);
            PG8_WAIT_L(8); PG8_BAR; PG8_WAIT_L(0); PG8_MMA(0, 0, At, B0); PG8_BAR; PG8_SCHED;
            PG8_LDB(B1, 1, 1); PG8_STAGE(PG8_SB(1, 0), b3, voffB);
            PG8_BAR; PG8_WAIT_L(0); PG8_MMA(0, 1, At, B1); PG8_BAR;
            PG8_LDA(At, 1, 1); PG8_STAGE(PG8_SA(1, 0), a3, voffA);
            PG8_BAR; PG8_WAIT_L(0); PG8_MMA(1, 0, At, B0); PG8_BAR; PG8_SCHED;
            PG8_STAGE(PG8_SB(1, 1), b3 + hsB, voffB);
            PG8_WAIT_V(6); PG8_BAR; PG8_MMA(1, 1, At, B1); PG8_BAR;
            }
        }
        if (ALIGN && wr == 0) PG8_BAR;
        { int efr = fr, efq = fq; asm volatile("" : "+v"(efr), "+v"(efq)); E(acc, cur, wr, wc, efr, efq); }
        if (!has_next) break;
#pragma unroll
        for (int a = 0; a < 2; ++a)
#pragma unroll
            for (int b = 0; b < 2; ++b)
#pragma unroll
                for (int m = 0; m < 4; ++m)
#pragma unroll
                    for (int n = 0; n < 2; ++n) acc[a][b][m][n] = (f32x4){0.f, 0.f, 0.f, 0.f};
        cur = nxt; cA = nA; cB = nB; ++ui;
        if (ALIGN && wr == 1) PG8_BAR;
    }
    PG8_WAIT_V(0);
    if (!ALIGN && wr == 0) PG8_BAR;
    PG8_BAR;
#undef PG8_SA
#undef PG8_SB
#undef PG8_STAGE
#undef PG8_LDA
#undef PG8_LDB
#undef PG8_MMA
#undef PG8_WAIT_V
#undef PG8_WAIT_L
#undef PG8_BAR
#undef PG8_SCHED
}

template <bool ALIGN = true, bool SP2 = PG8_SP2, class Epi, class Sched>
__device__ __forceinline__ void gemm_phase_gather(PG8_LAS unsigned char* lds, const GemmG g, const Sched& S, const Epi& E, const char* Abase, const int* rowidx, const unsigned zoff) {
    const int tid = ph_tid(), wid = __builtin_amdgcn_readfirstlane(tid >> 6), lane = tid & 63, wr = wid >> 2, wc = wid & 3, fr = lane & 15, fq = lane >> 4;
    const int K = g.K, nt = K / BK;
    unsigned voffB[2];
#pragma unroll
    for (int i = 0; i < 2; ++i) { int R, C; stage_rc(tid * 16 + i * 8192, R, C); const int Rb = (R & ~31) + perm32(R & 31);
        const int wrow = g.bmode ? (((Rb >> 4) & 1) * DM + 16 * ((Rb >> 5) & 3) + (Rb & 15)) : Rb;
        voffB[i] = (unsigned)(wrow * g.ldb + C) * 2u; }
    unsigned vc0[2], vc1[2], vn0[2], vn1[2];
#define PG8_GOFF(dst0, dst1, u) do { const int _t = ph_tid(); _Pragma("unroll") for (int _i = 0; _i < 2; ++_i) { int _R, _C; stage_rc(_t * 16 + _i * 8192, _R, _C); const int _r0 = rowidx[(u).pm * BM + _R], _r1 = rowidx[(u).pm * BM + HALF + _R]; \
        dst0[_i] = (_r0 >= 0 ? (unsigned)_r0 * (unsigned)(g.lda * 2) : zoff) + (unsigned)_C * 2u; dst1[_i] = (_r1 >= 0 ? (unsigned)_r1 * (unsigned)(g.lda * 2) : zoff) + (unsigned)_C * 2u; } } while (0)
    const size_t kstep = (size_t)(BK * 2);
    const size_t hsB = (size_t)(g.bmode ? 2 * DM : HALF) * g.ldb * 2;
    const unsigned ldsw = (unsigned)wid * 1024u;
    const int aoff = lds_byte(wr * 64 + fr, fq * 8), boff = lds_byte(wc * 32 + fr, fq * 8);
#define PG8_SA(b, h) (((b) * 2 + (h)) * HTB)
#define PG8_SB(b, h) ((4 + (b) * 2 + (h)) * HTB)
#define PG8_STAGE(bufoff, gbase, voff) do { _Pragma("unroll") for (int _i = 0; _i < 2; ++_i) \
        __builtin_amdgcn_global_load_lds((const unsigned*)((const char*)(gbase) + (voff)[_i]), (PG8_LAS unsigned*)(lds + (bufoff) + ldsw + _i * 8192), 16, 0, 0); } while (0)
#define PG8_LDA(dst, b, h) do { _Pragma("unroll") for (int m = 0; m < 4; ++m) _Pragma("unroll") for (int k = 0; k < 2; ++k) dst[m][k] = *(const PG8_LAS bf16x8*)(lds + PG8_SA(b, h) + aoff + m * 2048 + k * 1024); } while (0)
#define PG8_LDB(dst, b, h) do { _Pragma("unroll") for (int n = 0; n < 2; ++n) _Pragma("unroll") for (int k = 0; k < 2; ++k) dst[n][k] = *(const PG8_LAS bf16x8*)(lds + PG8_SB(b, h) + boff + n * 2048 + k * 1024); } while (0)
#define PG8_MMA(ai, bj, At, Bt) do { __builtin_amdgcn_s_setprio(1); _Pragma("unroll") for (int m = 0; m < 4; ++m) _Pragma("unroll") for (int n = 0; n < 2; ++n) _Pragma("unroll") for (int k = 0; k < 2; ++k) \
        acc[ai][bj][m][n] = __builtin_amdgcn_mfma_f32_16x16x32_bf16(Bt[n][k], At[m][k], acc[ai][bj][m][n], 0, 0, 0); __builtin_amdgcn_s_setprio(0); } while (0)
#define PG8_WAIT_V(n) asm volatile("s_waitcnt vmcnt(" #n ")" ::: "memory")
#define PG8_WAIT_L(n) asm volatile("s_waitcnt lgkmcnt(" #n ")" ::: "memory")
#define PG8_BAR __builtin_amdgcn_s_barrier()
#define PG8_SCHED __builtin_amdgcn_sched_barrier(0)
    Unit cur, nxt; int ui = 0;
    if (!S.next(0, cur)) return;
    f32x4 acc[2][2][4][2];
#pragma unroll
    for (int a = 0; a < 2; ++a)
#pragma unroll
        for (int b = 0; b < 2; ++b)
#pragma unroll
            for (int m = 0; m < 4; ++m)
#pragma unroll
                for (int n = 0; n < 2; ++n) acc[a][b][m][n] = (f32x4){0.f, 0.f, 0.f, 0.f};
    bf16x8 At[4][2], B0[2][2], B1[2][2];
    const char* cA = Abase; const char* cB = cur.B;
    PG8_GOFF(vc0, vc1, cur);
    if constexpr (SP2) {
      PG8_STAGE(PG8_SB(0, 0), cB, voffB); PG8_STAGE(PG8_SB(0, 1), cB + hsB, voffB); PG8_STAGE(PG8_SA(0, 0), cA, vc0); PG8_STAGE(PG8_SA(0, 1), cA, vc1);
      if (wr == 1) PG8_BAR;
      PG8_WAIT_V(2); PG8_BAR;
      PG8_STAGE(PG8_SB(1, 0), cB + kstep, voffB); PG8_STAGE(PG8_SA(1, 0), cA + kstep, vc0); PG8_STAGE(PG8_SB(1, 1), cB + hsB + kstep, voffB);
      PG8_WAIT_V(6); PG8_BAR;
    } else {
    PG8_STAGE(PG8_SB(0, 0), cB, voffB); PG8_STAGE(PG8_SA(0, 0), cA, vc0); PG8_STAGE(PG8_SB(0, 1), cB + hsB, voffB); PG8_STAGE(PG8_SA(0, 1), cA, vc1);
    if (wr == 1) PG8_BAR;
    PG8_WAIT_V(4); PG8_BAR;
    PG8_STAGE(PG8_SB(1, 0), cB + kstep, voffB); PG8_STAGE(PG8_SA(1, 0), cA + kstep, vc0); PG8_STAGE(PG8_SB(1, 1), cB + hsB + kstep, voffB);
    PG8_WAIT_V(6); PG8_BAR;
    }
    for (;;) {
        const bool has_next = S.next(ui + 1, nxt);
        const char* nB = has_next ? nxt.B : cB;
        if (has_next) { PG8_GOFF(vn0, vn1, nxt); } else {
#pragma unroll
          for (int _i = 0; _i < 2; ++_i) { vn0[_i] = vc0[_i]; vn1[_i] = vc1[_i]; } }
        for (int t = 0; t < nt; t += 2) {
            const bool last = (t == nt - 2);
            const char* a1 = cA + (size_t)(t + 1) * kstep;
            const char* a2 = last ? cA : cA + (size_t)(t + 2) * kstep; const char* b2 = last ? nB : cB + (size_t)(t + 2) * kstep;
            const char* a3 = a2 + kstep; const char* b3 = b2 + kstep;
            if constexpr (SP2) {
            PG8_LDB(B0, 0, 0); PG8_LDB(B1, 0, 1); PG8_SCHED; PG8_LDA(At, 0, 0); PG8_STAGE(PG8_SA(1, 1), a1, vc1);
            PG8_WAIT_V(8); PG8_WAIT_L(0); PG8_BAR; PG8_MMA(0, 0, At, B0); PG8_MMA(0, 1, At, B1); PG8_BAR; PG8_SCHED;
            PG8_LDA(At, 0, 1); PG8_STAGE(PG8_SB(0, 0), b2, voffB); PG8_STAGE(PG8_SB(0, 1), b2 + hsB, voffB); if (last) PG8_STAGE(PG8_SA(0, 0), a2, vn0); else PG8_STAGE(PG8_SA(0, 0), a2, vc0);
            PG8_WAIT_V(8); PG8_WAIT_L(0); PG8_BAR; PG8_MMA(1, 0, At, B0); PG8_MMA(1, 1, At, B1); PG8_BAR; PG8_SCHED;
            PG8_LDB(B0, 1, 0); PG8_LDB(B1, 1, 1); PG8_SCHED; PG8_LDA(At, 1, 0); if (last) PG8_STAGE(PG8_SA(0, 1), a2, vn1); else PG8_STAGE(PG8_SA(0, 1), a2, vc1);
            PG8_WAIT_V(8); PG8_WAIT_L(0); PG8_BAR; PG8_MMA(0, 0, At, B0); PG8_MMA(0, 1, At, B1); PG8_BAR; PG8_SCHED;
            PG8_LDA(At, 1, 1); PG8_STAGE(PG8_SB(1, 0), b3, voffB); PG8_STAGE(PG8_SB(1, 1), b3 + hsB, voffB); if (last) PG8_STAGE(PG8_SA(1, 0), a3, vn0); else PG8_STAGE(PG8_SA(1, 0), a3, vc0);
            PG8_WAIT_V(8); PG8_WAIT_L(0); PG8_BAR; PG8_MMA(1, 0, At, B0); PG8_MMA(1, 1, At, B1); PG8_BAR; PG8_SCHED;
            } else {
            PG8_LDB(B0, 0, 0); PG8_SCHED; PG8_LDA(At, 0, 0); PG8_STAGE(PG8_SA(1, 1), a1, vc1);
            PG8_WAIT_L(8); PG8_BAR; PG8_WAIT_L(0); PG8_MMA(0, 0, At, B0); PG8_BAR; PG8_SCHED;
            PG8_LDB(B1, 0, 1); PG8_STAGE(PG8_SB(0, 0), b2, voffB);
            PG8_BAR; PG8_WAIT_L(0); PG8_MMA(0, 1, At, B1); PG8_BAR;
            PG8_LDA(At, 0, 1); if (last) PG8_STAGE(PG8_SA(0, 0), a2, vn0); else PG8_STAGE(PG8_SA(0, 0), a2, vc0);
            PG8_BAR; PG8_WAIT_L(0); PG8_MMA(1, 0, At, B0); PG8_BAR; PG8_SCHED;
            PG8_STAGE(PG8_SB(0, 1), b2 + hsB, voffB);
            PG8_WAIT_V(6); PG8_BAR; PG8_MMA(1, 1, At, B1); PG8_BAR;
            PG8_LDB(B0, 1, 0); PG8_SCHED; PG8_LDA(At, 1, 0); if (last) PG8_STAGE(PG8_SA(0, 1), a2, vn1); else PG8_STAGE(PG8_SA(0, 1), a2, vc1);
            PG8_WAIT_L(8); PG8_BAR; PG8_WAIT_L(0); PG8_MMA(0, 0, At, B0); PG8_BAR; PG8_SCHED;
            PG8_LDB(B1, 1, 1); PG8_STAGE(PG8_SB(1, 0), b3, voffB);
            PG8_BAR; PG8_WAIT_L(0); PG8_MMA(0, 1, At, B1); PG8_BAR;
            PG8_LDA(At, 1, 1); if (last) PG8_STAGE(PG8_SA(1, 0), a3, vn0); else PG8_STAGE(PG8_SA(1, 0), a3, vc0);
            PG8_BAR; PG8_WAIT_L(0); PG8_MMA(1, 0, At, B0); PG8_BAR; PG8_SCHED;
            PG8_STAGE(PG8_SB(1, 1), b3 + hsB, voffB);
            PG8_WAIT_V(6); PG8_BAR; PG8_MMA(1, 1, At, B1); PG8_BAR;
            }
        }
        if (ALIGN && wr == 0) PG8_BAR;
        { int efr = fr, efq = fq; asm volatile("" : "+v"(efr), "+v"(efq)); E(acc, cur, wr, wc, efr, efq); }
        if (!has_next) break;
#pragma unroll
        for (int a = 0; a < 2; ++a)
#pragma unroll
            for (int b = 0; b < 2; ++b)
#pragma unroll
                for (int m = 0; m < 4; ++m)
#pragma unroll
                    for (int n = 0; n < 2; ++n) acc[a][b][m][n] = (f32x4){0.f, 0.f, 0.f, 0.f};
        cur = nxt; cB = nB; ++ui;
#pragma unroll
        for (int _i = 0; _i < 2; ++_i) { vc0[_i] = vn0[_i]; vc1[_i] = vn1[_i]; }
        if (ALIGN && wr == 1) PG8_BAR;
    }
    PG8_WAIT_V(0);
    if (!ALIGN && wr == 0) PG8_BAR;
    PG8_BAR;
#undef PG8_GOFF
#undef PG8_SA
#undef PG8_SB
#undef PG8_STAGE
#undef PG8_LDA
#undef PG8_LDB
#undef PG8_MMA
#undef PG8_WAIT_V
#undef PG8_WAIT_L
#undef PG8_BAR
#undef PG8_SCHED
}

struct SchedGrid {
  const char* A; const char* B; int lda, ldb, nM, nN, skip_ctx, G, c, pad;
  __device__ __forceinline__ bool next(int i, Unit& u) const {
    int pm, pn; if (!tile_order((long)i * G + c, nM, nN, pm, pn)) return false;
    if (skip_ctx && pm >= NTOK / 256 - 1) pm += 1;
    u.pm = pm; u.pn = pn; u.aux = 0; u.A = A + (size_t)pm * BM * lda * 2; u.B = B + (size_t)pn * BM * ldb * 2; return true; }
};
struct SchedProj {
  const char* OA; const char* B; int nM, skip_ctx, G, c;
  __device__ __forceinline__ bool next(int i, Unit& u) const {
    int pm, pn; if (!tile_order((long)i * G + c, nM, 4 * DM / 256, pm, pn)) return false;
    if (skip_ctx && pm >= NTOK / 256 - 1) pm += 1;
    const int k = pn / (DM / 256);
    u.pm = pm; u.pn = pn; u.aux = k; u.A = OA + ((size_t)pm * BM * DM + (size_t)k * BW) * 2; u.B = B + (size_t)pn * BM * BW * 2; return true; }
};
struct SchedGate {
  const char* H; const char* B; int nM, skip_ctx, G, c;
  __device__ __forceinline__ bool next(int i, Unit& u) const {
    const int j = i >> 2, k = i & 3; int pm, pd; if (!tile_order((long)j * G + c, nM, DM / 256, pm, pd)) return false;
    if (skip_ctx && pm >= NTOK / 256 - 1) pm += 1;
    u.pm = pm; u.pn = pd; u.aux = k; u.A = H + (size_t)pm * BM * DM * 2; u.B = B + ((size_t)k * DM + (size_t)pd * BM) * DM * 2; return true; }
};
struct SchedMoe {
  const char* A; const char* B; int lda, ldb, nMl, nN; size_t wstride; int G, c, xcd, pad;
  __device__ __forceinline__ bool next(int i, Unit& u) const {
    int e, rem; const int per_e = nMl * nN;
    if (xcd) { const int x = c & 7, idx = c >> 3, wpx = G >> 3, j = i * wpx + idx; if (j >= (NE / 8) * per_e) return false; e = x + 8 * (j / per_e); rem = j % per_e; }
    else { const long L = (long)i * G + c; if (L >= (long)NE * per_e) return false; e = (int)(L / per_e); rem = (int)(L % per_e); }
    const int pn = rem / nMl, pml = rem % nMl;
    u.pm = e * (XEP / 256) + pml; u.pn = pn; u.aux = e; u.A = A + (size_t)u.pm * BM * lda * 2; u.B = B + (size_t)e * wstride + (size_t)pn * BM * ldb * 2; return true; }
};

#define EPI_LOOP(...) _Pragma("unroll") for (int ai = 0; ai < 2; ++ai) _Pragma("unroll") for (int m = 0; m < 4; ++m) { const int trow = ai * HALF + wr * 64 + m * 16 + fr; \
    _Pragma("unroll") for (int bj = 0; bj < 2; ++bj) { const int tcol = bj * HALF + wc * 32 + 8 * fq; const f32x4 v0 = acc[ai][bj][m][0], v1 = acc[ai][bj][m][1]; __VA_ARGS__ } }
typedef f32x4 AccT[2][2][4][2];
struct EpiBf16 { bf16_t* O; int ldc, pad;
  __device__ __forceinline__ void operator()(const AccT& acc, const Unit& u, int wr, int wc, int fr, int fq) const {
    bf16_t* base = O + (size_t)u.pm * BM * ldc + (size_t)u.pn * BM;
    EPI_LOOP(st_out((u32x4*)(base + (size_t)trow * ldc + tcol), pack8(v0, v1));) } };
struct EpiF32 { float* O; int ldc, pad;
  __device__ __forceinline__ void operator()(const AccT& acc, const Unit& u, int wr, int wc, int fr, int fq) const {
    float* base = O + (size_t)u.pm * BM * ldc + (size_t)u.pn * BM;
    EPI_LOOP(float* q = base + (size_t)trow * ldc + tcol; st_out((f32x4*)q, v0); st_out((f32x4*)(q + 4), v1);) } };
struct EpiKVm { bf16_t* KM; bf16_t* VM;
  __device__ __forceinline__ void operator()(const AccT& acc, const Unit& u, int wr, int wc, int fr, int fq) const {
    bf16_t* kb = KM + (size_t)u.pm * BM * (MH * MQK) + u.pn * MQK; bf16_t* vb = VM + (size_t)u.pm * BM * (MH * MV) + u.pn * MV;
    EPI_LOOP(bf16_t* q = (bj == 0) ? kb + trow * (MH * MQK) + tcol : vb + trow * (MH * MV) + (tcol - HALF); *(u32x4*)q = pack8(v0, v1);) } };
struct EpiGluO { const bf16_t* Z; bf16_t* O;
  __device__ __forceinline__ void operator()(const AccT& acc, const Unit& u, int wr, int wc, int fr, int fq) const {
    EPI_LOOP(const size_t row = (size_t)u.pm * BM + trow; const int col = u.pn * BM + tcol; f32x4 z0, z1; unpack8(*(const u32x4*)(Z + row * BW + col), z0, z1);
             *(u32x4*)(O + row * DM + col) = pack8(z0 * sigmoid4(v0), z1 * sigmoid4(v1));) } };
struct EpiGateMerge { const float* bg; const bf16_t* PROJ; float* MACC; bf16_t* MG;
  __device__ __forceinline__ void operator()(const AccT& acc, const Unit& u, int wr, int wc, int fr, int fq) const {
    const int k = u.aux; const bf16_t* pb = PROJ + (size_t)u.pm * BM * (4 * DM) + k * DM + u.pn * BM; float* mb = MACC + (size_t)u.pm * BM * DM + u.pn * BM; bf16_t* gb = MG + (size_t)u.pm * BM * DM + u.pn * BM;
    const float* bp0 = bg + k * DM + u.pn * BM;
#pragma unroll
    for (int ai = 0; ai < 2; ++ai)
#pragma unroll
      for (int bj = 0; bj < 2; ++bj) { const int tcol = bj * HALF + wc * 32 + 8 * fq; u32x4 pj[4]; f32x4 m0[4], m1[4];
#pragma unroll
        for (int m = 0; m < 4; ++m) { const int trow = ai * HALF + wr * 64 + m * 16 + fr; pj[m] = *(const u32x4*)(pb + trow * (4 * DM) + tcol);
          if (k > 0) { m0[m] = *(const f32x4*)(mb + trow * DM + tcol); m1[m] = *(const f32x4*)(mb + trow * DM + tcol + 4); } }
        const f32x4 b0 = *(const f32x4*)(bp0 + tcol), b1 = *(const f32x4*)(bp0 + tcol + 4);
#pragma unroll
        for (int m = 0; m < 4; ++m) { const int trow = ai * HALF + wr * 64 + m * 16 + fr; f32x4 p0, p1; unpack8(pj[m], p0, p1);
          f32x4 r0 = sigmoid4(acc[ai][bj][m][0] + b0) * p0, r1 = sigmoid4(acc[ai][bj][m][1] + b1) * p1;
          if (k > 0) { r0 += m0[m]; r1 += m1[m]; }
          if (k < 3) { *(f32x4*)(mb + trow * DM + tcol) = r0; *(f32x4*)(mb + trow * DM + tcol + 4) = r1; } else *(u32x4*)(gb + trow * DM + tcol) = pack8(r0, r1); } } } };
struct EpiSwiGlu { bf16_t* ACT;
  __device__ __forceinline__ void operator()(const AccT& acc, const Unit& u, int wr, int wc, int fr, int fq) const {
#pragma unroll
    for (int ai = 0; ai < 2; ++ai)
#pragma unroll
      for (int m = 0; m < 4; ++m) { const size_t row = (size_t)u.pm * BM + ai * HALF + wr * 64 + m * 16 + fr; const int col = u.pn * HALF + wc * 32 + 8 * fq;
        const f32x4 g0 = acc[ai][0][m][0], g1 = acc[ai][0][m][1], u0 = acc[ai][1][m][0], u1 = acc[ai][1][m][1];
        st_out((u32x4*)(ACT + row * FF + col), pack8(g0 * sigmoid4(g0) * u0, g1 * sigmoid4(g1) * u1)); } } };
struct EpiDownG { const float* GV; bf16_t* YS;
  __device__ __forceinline__ void operator()(const AccT& acc, const Unit& u, int wr, int wc, int fr, int fq) const {
    EPI_LOOP(const size_t row = (size_t)u.pm * BM + trow; const float gv = GV[row]; *(u32x4*)(YS + row * DM + u.pn * BM + tcol) = pack8(v0 * gv, v1 * gv);) } };

struct SchedS5 { const char* UH; const char* W; size_t wstride; int G, c;
  __device__ __forceinline__ bool next(int i, Unit& u) const {
    const long L = (long)i * G + c; if (L >= (long)S5G * (S5NP / 256)) return false; const int g = (int)(L / (S5NP / 256)), pm = (int)(L % (S5NP / 256));
    u.pm = pm; u.pn = 0; u.aux = g; u.A = UH + ((size_t)g * S5NP + (size_t)pm * BM) * (S5K1 + S5K2) * 2; u.B = W + (size_t)g * wstride; return true; }
};
struct EpiS5E { float* E;
  __device__ __forceinline__ void operator()(const AccT& acc, const Unit& u, int wr, int wc, int fr, int fq) const {
    float* base = E + ((size_t)u.aux * S5NP + (size_t)u.pm * BM) * S5K2;
    EPI_LOOP(float* q = base + (size_t)trow * S5K2 + tcol; *(f32x4*)q = v0; *(f32x4*)(q + 4) = v1;) } };
__device__ __forceinline__ float fast_gelu_tanh(float x) { const float t = 0.7978845608028654f * (x + 0.044715f * x * x * x); const float e = __builtin_amdgcn_exp2f(2.885390081777927f * t);
  return 0.5f * x * (2.f - 2.f * __builtin_amdgcn_rcpf(e + 1.f)); }
struct EpiS5Y { const bf16_t* P; const float* D; bf16_t* Z; int last, pad;
  __device__ __forceinline__ void operator()(const AccT& acc, const Unit& u, int wr, int wc, int fr, int fq) const {
    const int g = u.aux;
#pragma unroll
    for (int ai = 0; ai < 2; ++ai) { u32x4 uu[4][2]; bool ok[4]; long Rr[4];
#pragma unroll
      for (int m = 0; m < 4; ++m) { const int n = u.pm * BM + ai * HALF + wr * 64 + m * 16 + fr; const int b = n / S5NC, j = n % S5NC; ok[m] = n < S5NN && !(last && j >= SEQ / S5LC);
#pragma unroll
        for (int bj = 0; bj < 2; ++bj) { const int tcol = bj * HALF + wc * 32 + 8 * fq, a = tcol >> 4, i0 = tcol & 15; const long R = (long)b * NTOK + j * S5LC + a; if (bj == 0) Rr[m] = R - a;
          uu[m][bj] = ok[m] ? *(const u32x4*)(P + R * PW + OFF_U + g * S5CH + i0) : (u32x4){0u, 0u, 0u, 0u}; } }
#pragma unroll
      for (int bj = 0; bj < 2; ++bj) { const int tcol = bj * HALF + wc * 32 + 8 * fq, a = tcol >> 4, i0 = tcol & 15; const float* dp = D + g * S5CH + i0; const f32x4 d0 = *(const f32x4*)dp, d1 = *(const f32x4*)(dp + 4);
#pragma unroll
        for (int m = 0; m < 4; ++m) if (ok[m]) { f32x4 u0, u1; unpack8(uu[m][bj], u0, u1); f32x4 y0 = acc[ai][bj][m][0] + d0 * u0, y1 = acc[ai][bj][m][1] + d1 * u1;
#pragma unroll
          for (int q = 0; q < 4; ++q) { y0[q] = fast_gelu_tanh(y0[q]); y1[q] = fast_gelu_tanh(y1[q]); }
          *(u32x4*)(Z + (Rr[m] + a) * BW + g * S5CH + i0) = pack8(y0, y1); } } } } };
struct SchedGateCtx { const char* H; const char* B; int G, c;
  __device__ __forceinline__ bool next(int i, Unit& u) const {
    const int L = i * G + c; if (L >= 2 * (4 * DM / BM)) return false; const int ct = L / (4 * DM / BM), pn = L % (4 * DM / BM), pm = ct * (NTOK / BM) + SEQ / BM;
    u.pm = pm; u.pn = pn; u.aux = ct; u.A = H + (size_t)pm * BM * DM * 2; u.B = B + (size_t)pn * BM * DM * 2; return true; }
};
struct EpiGateCtx { const float* bg; bf16_t* GC;
  __device__ __forceinline__ void operator()(const AccT& acc, const Unit& u, int wr, int wc, int fr, int fq) const {
    bf16_t* base = GC + (size_t)u.aux * BM * (4 * DM) + u.pn * BM; const float* bp = bg + u.pn * BM;
    EPI_LOOP(*(u32x4*)(base + trow * (4 * DM) + tcol) = pack8(sigmoid4(v0 + *(const f32x4*)(bp + tcol)), sigmoid4(v1 + *(const f32x4*)(bp + tcol + 4)));) } };
struct SchedProjW { const char* OA; const char* B; int nM, skip_ctx, G, c, nA, ua, ub, pad;
  __device__ __forceinline__ bool next(int i, Unit& u) const {
    long L; if (c < nA) { if (i >= ua) return false; L = (long)c * ua + i; } else { if (i >= ub) return false; L = (long)nA * ua + (long)(c - nA) * ub + i; }
    int pm, pn; if (!tile_order(L, nM, 4 * DM / 256, pm, pn)) return false;
    if (skip_ctx && pm >= NTOK / 256 - 1) pm += 1;
    const int k = pn / (DM / 256);
    u.pm = pm; u.pn = pn; u.aux = k; u.A = OA + ((size_t)pm * BM * DM + (size_t)k * BW) * 2; u.B = B + (size_t)pn * BM * BW * 2; return true; }
};

struct SchedGate4 { const char* H; const char* B; int G, c;
  __device__ __forceinline__ bool next(int i, Unit& u) const {
    int pm, pd; if (!tile_order((long)i * G + c, MROWS / BM - 2, DM / 64, pm, pd)) return false;
    if (pm >= NTOK / BM - 1) pm += 1;
    u.pm = pm; u.pn = pd; u.aux = 0; u.A = H + (size_t)pm * BM * DM * 2; u.B = B + (size_t)pd * 64 * DM * 2; return true; }
};
struct EpiGate4 { const float* bg; const bf16_t* PROJ; bf16_t* MG;
  __device__ __forceinline__ void operator()(const AccT& acc, const Unit& u, int wr, int wc, int fr, int fq) const {
    const int kb = fq >> 1, d0 = u.pn * 64 + 16 * wc + 8 * (fq & 1); const bf16_t* pb = PROJ + (size_t)u.pm * BM * (4 * DM) + kb * DM + d0; bf16_t* gb = MG + (size_t)u.pm * BM * DM + d0;
    const float* bp = bg + kb * DM + d0; const f32x4 b00 = *(const f32x4*)bp, b01 = *(const f32x4*)(bp + 4), b10 = *(const f32x4*)(bp + 2 * DM), b11 = *(const f32x4*)(bp + 2 * DM + 4);
    u32x4 p0[2][4], p1[2][4];
#pragma unroll
    for (int ai = 0; ai < 2; ++ai)
#pragma unroll
      for (int m = 0; m < 4; ++m) { const int trow = ai * HALF + wr * 64 + m * 16 + fr; p0[ai][m] = *(const u32x4*)(pb + trow * (4 * DM)); p1[ai][m] = *(const u32x4*)(pb + trow * (4 * DM) + 2 * DM); }
#pragma unroll
    for (int ai = 0; ai < 2; ++ai)
#pragma unroll
      for (int m = 0; m < 4; ++m) { const int trow = ai * HALF + wr * 64 + m * 16 + fr; f32x4 q0, q1, q2, q3; unpack8(p0[ai][m], q0, q1); unpack8(p1[ai][m], q2, q3);
        f32x4 r0 = sigmoid4(acc[ai][0][m][0] + b00) * q0 + sigmoid4(acc[ai][1][m][0] + b10) * q2, r1 = sigmoid4(acc[ai][0][m][1] + b01) * q1 + sigmoid4(acc[ai][1][m][1] + b11) * q3;
#pragma unroll
        for (int j = 0; j < 4; ++j) { r0[j] += __shfl_xor(r0[j], 32); r1[j] += __shfl_xor(r1[j], 32); }
        if (kb == 0) st_out((u32x4*)(gb + trow * DM), pack8(r0, r1)); } } };

struct SchedKR { const char* H; const char* B; int G, c;
  __device__ __forceinline__ bool next(int i, Unit& u) const {
    const int L = i * G + c; if (L >= MROWS / BM) return false;
    u.pm = L; u.pn = PW / BM - 1; u.aux = 0; u.A = H + (size_t)L * BM * DM * 2; u.B = B + (size_t)(PW / BM - 1) * BM * DM * 2; return true; }
};
struct EpiKR { bf16_t* KM; const float* tb;
  __device__ __forceinline__ void operator()(const AccT& acc, const Unit& u, int wr, int wc, int fr, int fq) const {
    static_assert(IN_TOTAL - OFF_KR == 64 && OFF_KR == (PW / BM - 1) * BM, "rope key = first 64 columns of the last column tile");
    if (wc >= 2) return;
    const bool lat_tile = (u.pm % (NTOK / BM)) < SEQ / BM; const int t0 = (u.pm % (NTOK / BM)) * BM; bf16_t* base = KM + (size_t)u.pm * BM * (MH * MQK) + MNOPE + wc * 32 + 8 * fq;
#pragma unroll
    for (int ai = 0; ai < 2; ++ai)
#pragma unroll
      for (int m = 0; m < 4; ++m) { const int trow = ai * HALF + wr * 64 + m * 16 + fr; f32x4 a = acc[ai][0][m][0], b2 = acc[ai][0][m][1];
        if (lat_tile) { const int t = t0 + trow; const float* cs = tb + ((wc ? t % GRIDW : t / GRIDW) * NROPE_B + ((8 * fq) & 15)) * 2;
#pragma unroll
          for (int j = 0; j < 4; ++j) { const float oa = __shfl_xor(a[j], 32), ob = __shfl_xor(b2[j], 32); const float ca = cs[2 * j], sa = cs[2 * j + 1], cb = cs[8 + 2 * j], sb = cs[8 + 2 * j + 1];
            a[j] = a[j] * ca + (fq < 2 ? -oa : oa) * sa; b2[j] = b2[j] * cb + (fq < 2 ? -ob : ob) * sb; } }
        const u32x4 w = pack8(a, b2);
#pragma unroll
        for (int h = 0; h < MH; ++h) *(u32x4*)(base + trow * (MH * MQK) + h * MQK) = w; } } };

struct SchedKR2 { const char* H; const char* B; int G, c;
  __device__ __forceinline__ bool next(int i, Unit& u) const {
    const int L = i * G + c; if (L >= 2 * (MROWS / BM)) return false; const int pm = L >> 1, kh = L & 1;
    u.pm = pm; u.pn = PW / BM - 1; u.aux = kh; u.A = H + ((size_t)pm * BM * DM + (size_t)kh * (DM / 2)) * 2; u.B = B + ((size_t)(PW / BM - 1) * BM * DM + (size_t)kh * (DM / 2)) * 2; return true; }
};
struct EpiKRpart { float* KRP;
  __device__ __forceinline__ void operator()(const AccT& acc, const Unit& u, int wr, int wc, int fr, int fq) const {
    if (wc >= 2) return;
    float* base = KRP + ((size_t)u.aux * MROWS + (size_t)u.pm * BM) * MROPE + wc * 32 + 8 * fq;
#pragma unroll
    for (int ai = 0; ai < 2; ++ai)
#pragma unroll
      for (int m = 0; m < 4; ++m) { const int trow = ai * HALF + wr * 64 + m * 16 + fr; float* q = base + trow * MROPE; *(f32x4*)q = acc[ai][0][m][0]; *(f32x4*)(q + 4) = acc[ai][0][m][1]; } } };

struct SchedOutCtx { const char* MG; const char* B; int G, c;
  __device__ __forceinline__ bool next(int i, Unit& u) const {
    const int L = i * G + c; if (L >= 2 * (DM / BM) * 4) return false; const int kq = L & 3, pn = (L >> 2) % (DM / BM), ct = L / (4 * (DM / BM)), pm = ct * (NTOK / BM) + SEQ / BM;
    u.pm = ct; u.pn = pn; u.aux = kq; u.A = MG + ((size_t)pm * BM * DM + (size_t)kq * (DM / 4)) * 2; u.B = B + ((size_t)pn * BM * DM + (size_t)kq * (DM / 4)) * 2; return true; }
};
struct EpiSlab { float* Y;
  __device__ __forceinline__ void operator()(const AccT& acc, const Unit& u, int wr, int wc, int fr, int fq) const {
    float* base = Y + ((size_t)u.aux * NB * CTXL + (size_t)u.pm * BM) * DM + u.pn * BM;
    EPI_LOOP(float* q = base + (size_t)trow * DM + tcol; *(f32x4*)q = v0; *(f32x4*)(q + 4) = v1;) } };
struct EpiQM { bf16_t* QM; const float* tb;
  __device__ __forceinline__ void operator()(const AccT& acc, const Unit& u, int wr, int wc, int fr, int fq) const {
    const bool lat_tile = (u.pm % (NTOK / BM)) < SEQ / BM; bf16_t* base = QM + (size_t)u.pm * BM * (MH * MQK) + u.pn * BM; const int t0 = (u.pm % (NTOK / BM)) * BM;
    EPI_LOOP(const int cr = (u.pn * BM + tcol) % MQK; f32x4 a = v0, b2 = v1;
      if (cr >= MNOPE && lat_tile) { const int t = t0 + trow, hf = (cr - MNOPE) >> 5, off = (cr - MNOPE) & 31; const float* cs = tb + (((hf ? t % GRIDW : t / GRIDW)) * NROPE_B + (off & 15)) * 2;
        _Pragma("unroll") for (int j = 0; j < 4; ++j) { const float oa = __shfl_xor(a[j], 32), ob = __shfl_xor(b2[j], 32); const float ca = cs[2 * j], sa = cs[2 * j + 1], cb = cs[8 + 2 * j], sb = cs[8 + 2 * j + 1];
          a[j] = a[j] * ca + (fq < 2 ? -oa : oa) * sa; b2[j] = b2[j] * cb + (fq < 2 ? -ob : ob) * sb; } }
      *(u32x4*)(base + trow * (MH * MQK) + tcol) = pack8(a, b2);) } };
}

template <class Epi, class Sched> __global__ __launch_bounds__(512, 2) void k_gemm_phase(pg8::GemmG g, Sched S, Epi E) {
  extern __shared__ __attribute__((aligned(16))) unsigned char shm[];
  S.G = gridDim.x; S.c = blockIdx.x;
  pg8::gemm_phase<Epi, Sched>((PG8_LAS unsigned char*)shm, g, S, E);
}
#endif
#ifndef CPU_TEST
namespace ph {
using pg8::f32x4; using pg8::u32x4; using pg8::pack8; using pg8::unpack8;
#define LAS __attribute__((address_space(3)))
__device__ __forceinline__ float wave_sum(float v) { v += __shfl_xor(v, 32); v += __shfl_xor(v, 16); v += __shfl_xor(v, 8); v += __shfl_xor(v, 4); v += __shfl_xor(v, 2); v += __shfl_xor(v, 1); return v; }
__device__ __forceinline__ float wave_max(float v) { v = fmaxf(v, __shfl_xor(v, 32)); v = fmaxf(v, __shfl_xor(v, 16)); v = fmaxf(v, __shfl_xor(v, 8)); v = fmaxf(v, __shfl_xor(v, 4)); v = fmaxf(v, __shfl_xor(v, 2)); v = fmaxf(v, __shfl_xor(v, 1)); return v; }
__device__ __forceinline__ float sum8(const f32x4& a, const f32x4& b) { return ((a[0] + a[1]) + (a[2] + a[3])) + ((b[0] + b[1]) + (b[2] + b[3])); }
__device__ __forceinline__ const float* resid_row(const Params& p, int l, int R) {
  const int b = row_b(R), t = row_t(R); return t < SEQ ? p.in[I_X] + ((long)b * SEQ + t) * DM : p.in[I_CTX] + ((long)b * CTXL + (t - SEQ)) * DM;
}

constexpr int NCH = DM / 512;
static_assert(DM % 512 == 0, "row chunking");
struct RowV { f32x4 a[NCH], b[NCH]; };
__device__ __forceinline__ void row_load(RowV& v, const float* x, int lane) {
#pragma unroll
  for (int c = 0; c < NCH; ++c) { const float* q = x + c * 512 + lane * 8; v.a[c] = *(const f32x4*)q; v.b[c] = *(const f32x4*)(q + 4); } }
__device__ __forceinline__ void row_store(const RowV& v, float* x, int lane) {
#pragma unroll
  for (int c = 0; c < NCH; ++c) { float* q = x + c * 512 + lane * 8; *(f32x4*)q = v.a[c]; *(f32x4*)(q + 4) = v.b[c]; } }
__device__ __forceinline__ void row_load_nt(RowV& v, const float* x, int lane) {
#pragma unroll
  for (int c = 0; c < NCH; ++c) { const float* q = x + c * 512 + lane * 8; v.a[c] = __builtin_nontemporal_load((const f32x4*)q); v.b[c] = __builtin_nontemporal_load((const f32x4*)(q + 4)); } }
__device__ __forceinline__ void row_load_bf_nt(RowV& v, const bf16_t* x, int lane) {
#pragma unroll
  for (int c = 0; c < NCH; ++c) unpack8(__builtin_nontemporal_load((const u32x4*)(x + c * 512 + lane * 8)), v.a[c], v.b[c]); }
__device__ __forceinline__ void row_store_bf_nt(const RowV& v, bf16_t* x, int lane) {
#pragma unroll
  for (int c = 0; c < NCH; ++c) __builtin_nontemporal_store(pack8(v.a[c], v.b[c]), (u32x4*)(x + c * 512 + lane * 8)); }
__device__ __forceinline__ void row_load_bf(RowV& v, const bf16_t* x, int lane) {
#pragma unroll
  for (int c = 0; c < NCH; ++c) unpack8(*(const u32x4*)(x + c * 512 + lane * 8), v.a[c], v.b[c]); }
__device__ __forceinline__ void row_store_bf(const RowV& v, bf16_t* x, int lane) {
#pragma unroll
  for (int c = 0; c < NCH; ++c) *(u32x4*)(x + c * 512 + lane * 8) = pack8(v.a[c], v.b[c]); }
__device__ __forceinline__ void resid_load(RowV& v, const Params& p, int l, int R, int lane) {
  if (l == 0) row_load_nt(v, resid_row(p, l, R), lane); else row_load_bf_nt(v, WSP(bf16_t, p, x2) + (long)R * DM, lane);
}
__device__ __forceinline__ void row_stats(const RowV& v, float& mean, float& rstd) {
  float s = 0.f;
#pragma unroll
  for (int c = 0; c < NCH; ++c) s += sum8(v.a[c], v.b[c]);
  mean = wave_sum(s) * (1.f / DM); float q = 0.f;
#pragma unroll
  for (int c = 0; c < NCH; ++c) { const f32x4 da = v.a[c] - mean, db = v.b[c] - mean; q += sum8(da * da, db * db); }
  rstd = 1.f / sqrtf(wave_sum(q) * (1.f / DM) + NORM_EPS);
}
__device__ __forceinline__ void row_modulate_store(const RowV& v, float mean, float rstd, const float* sh, const float* sc, bf16_t* H, int lane) {
#pragma unroll
  for (int c = 0; c < NCH; ++c) { const int o = c * 512 + lane * 8; const f32x4 s0 = *(const f32x4*)(sc + o), s1 = *(const f32x4*)(sc + o + 4), h0 = *(const f32x4*)(sh + o), h1 = *(const f32x4*)(sh + o + 4);
    *(u32x4*)(H + o) = pack8((v.a[c] - mean) * rstd * (1.f + s0) + h0, (v.b[c] - mean) * rstd * (1.f + s1) + h1); } }

__device__ __forceinline__ void ph_ln_in(const Params& p, int l) {
  const int tid_ = ph_tid(), lane = tid_ & 63, wv = tid_ >> 6; const float* mod = WSP(float, p, mod) + (long)l * 18 * DM; bf16_t* H1 = WSP(bf16_t, p, h1);
  for (int R = blockIdx.x * 8 + wv; R < MROWS; R += gridDim.x * 8) { RowV v; resid_load(v, p, l, R, lane); float mean, rstd; row_stats(v, mean, rstd);
    const float* m = mod + (long)row_mod(R) * 6 * DM; row_modulate_store(v, mean, rstd, m, m + DM, H1 + (long)R * DM, lane); }
}
__device__ __forceinline__ void ph_ln1(const Params& p, int l, LAS unsigned char* lds) {
  const int tid_ = ph_tid(), lane = tid_ & 63, wv = tid_ >> 6; const float* mod = WSP(float, p, mod) + (long)l * 18 * DM; const int last = (l == NLAYER - 1);
  LAS float* rwt = (LAS float*)lds;
  { const float* rw = p.in[I_ROUTER] + (long)l * DM * NE; for (int i = tid_; i < DM * NE; i += 512) { const int e = i / DM, d = i % DM; rwt[i] = rw[d * NE + e]; } }
  __syncthreads();
  const bf16_t* Y = WSP(bf16_t, p, macc); bf16_t* X1 = WSP(bf16_t, p, x1); bf16_t* H2 = WSP(bf16_t, p, h2); float* AFF = WSP(float, p, aff);
  const float* lg = p.in[I_LN1G] + l * DM; const float* lb = p.in[I_LN1B] + l * DM;
  for (int R = blockIdx.x * 8 + wv; R < MROWS; R += gridDim.x * 8) { if (last && row_is_ctx(R)) continue;
    const float* m = mod + (long)row_mod(R) * 6 * DM; RowV v, y; resid_load(v, p, l, R, lane);
#pragma unroll
    for (int c = 0; c < NCH; ++c) unpack8(__builtin_nontemporal_load((const u32x4*)(Y + (long)R * DM + c * 512 + lane * 8)), y.a[c], y.b[c]);
#pragma unroll
    for (int c = 0; c < NCH; ++c) { const int o = c * 512 + lane * 8; v.a[c] = DN_ALPHA * v.a[c] + *(const f32x4*)(m + 2 * DM + o) * y.a[c]; v.b[c] = DN_ALPHA * v.b[c] + *(const f32x4*)(m + 2 * DM + o + 4) * y.b[c]; }
    float mean, rstd; row_stats(v, mean, rstd);
#pragma unroll
    for (int c = 0; c < NCH; ++c) { const int o = c * 512 + lane * 8; v.a[c] = (v.a[c] - mean) * rstd * *(const f32x4*)(lg + o) + *(const f32x4*)(lb + o); v.b[c] = (v.b[c] - mean) * rstd * *(const f32x4*)(lg + o + 4) + *(const f32x4*)(lb + o + 4); }
    row_store_bf_nt(v, X1 + (long)R * DM, lane);
    row_stats(v, mean, rstd);
#pragma unroll
    for (int c = 0; c < NCH; ++c) { const int o = c * 512 + lane * 8; v.a[c] = (v.a[c] - mean) * rstd * (1.f + *(const f32x4*)(m + 4 * DM + o)) + *(const f32x4*)(m + 3 * DM + o);
      v.b[c] = (v.b[c] - mean) * rstd * (1.f + *(const f32x4*)(m + 4 * DM + o + 4)) + *(const f32x4*)(m + 3 * DM + o + 4); *(u32x4*)(H2 + (long)R * DM + o) = pack8(v.a[c], v.b[c]); }
    float s[NE];
#pragma unroll
    for (int e = 0; e < NE; ++e) { float a = 0.f;
#pragma unroll
      for (int c = 0; c < NCH; ++c) { const LAS float* q = rwt + e * DM + c * 512 + lane * 8; const f32x4 w0 = *(const LAS f32x4*)q, w1 = *(const LAS f32x4*)(q + 4); a += sum8(v.a[c] * w0, v.b[c] * w1); }
      s[e] = a; }
    static_assert(NE == 16, "router reduce-scatter is written for 16 experts");
    { const bool b5 = lane & 32, b4 = lane & 16, b3 = lane & 8, b2 = lane & 4; float t8[8], t4[4], t2[2];
#pragma unroll
      for (int j = 0; j < 8; ++j) { const float snd = b5 ? s[j] : s[j + 8], kp = b5 ? s[j + 8] : s[j]; t8[j] = kp + __shfl_xor(snd, 32); }
#pragma unroll
      for (int j = 0; j < 4; ++j) { const float snd = b4 ? t8[j] : t8[j + 4], kp = b4 ? t8[j + 4] : t8[j]; t4[j] = kp + __shfl_xor(snd, 16); }
#pragma unroll
      for (int j = 0; j < 2; ++j) { const float snd = b3 ? t4[j] : t4[j + 2], kp = b3 ? t4[j + 2] : t4[j]; t2[j] = kp + __shfl_xor(snd, 8); }
      float lg_ = (b2 ? t2[1] : t2[0]) + __shfl_xor(b2 ? t2[0] : t2[1], 4); lg_ += __shfl_xor(lg_, 2); lg_ += __shfl_xor(lg_, 1);
      const int e = ((lane >> 2) & 1) | (((lane >> 3) & 1) << 1) | (((lane >> 4) & 1) << 2) | (((lane >> 5) & 1) << 3);
      const float mx = wave_max(lg_), ex = expf(lg_ - mx), se = wave_sum(ex) * 0.25f;
      if ((lane & 3) == 0) AFF[(long)R * NE + e] = ex / se; } }
}
__device__ __forceinline__ void ph_ln2(const Params& p, int l) {
  const int tid_ = ph_tid(), lane = tid_ & 63, wv = tid_ >> 6; const float* mod = WSP(float, p, mod) + (long)l * 18 * DM; const int last = (l == NLAYER - 1);
  const bf16_t* X1 = WSP(bf16_t, p, x1); bf16_t* X2 = WSP(bf16_t, p, x2); const int* SLOT = WSP(int, p, slot); const bf16_t* YS = (const bf16_t*)(p.ws + WS.regA + SZ_XS + SZ_ACT); bf16_t* H1 = WSP(bf16_t, p, h1);
  const float* lg = p.in[I_LN2G] + l * DM; const float* lb = p.in[I_LN2B] + l * DM;
  for (int R = blockIdx.x * 8 + wv; R < MROWS; R += gridDim.x * 8) { if (last && row_is_ctx(R)) continue;
    const float* m = mod + (long)row_mod(R) * 6 * DM; RowV v, acc; row_load_bf_nt(v, X1 + (long)R * DM, lane);
#pragma unroll
    for (int c = 0; c < NCH; ++c) { acc.a[c] = (f32x4){0.f, 0.f, 0.f, 0.f}; acc.b[c] = (f32x4){0.f, 0.f, 0.f, 0.f}; }
    const int myslot = lane < NE ? SLOT[(long)R * NE + lane] : -1;
    const float mygate = myslot >= 0 ? WSP(float, p, gatev)[myslot] : 0.f;
    for (int e = 0; e < NE; ++e) { const int s = __shfl(myslot, e); const float gq = __shfl(mygate, e); if (s >= 0) { const bf16_t* yr = YS + (long)s * DM;
#pragma unroll
        for (int c = 0; c < NCH; ++c) { f32x4 t0, t1; unpack8(__builtin_nontemporal_load((const u32x4*)(yr + c * 512 + lane * 8)), t0, t1); acc.a[c] += gq * t0; acc.b[c] += gq * t1; } } }
#pragma unroll
    for (int c = 0; c < NCH; ++c) { const int o = c * 512 + lane * 8; v.a[c] = DN_ALPHA * v.a[c] + *(const f32x4*)(m + 5 * DM + o) * acc.a[c]; v.b[c] = DN_ALPHA * v.b[c] + *(const f32x4*)(m + 5 * DM + o + 4) * acc.b[c]; }
    float mean, rstd; row_stats(v, mean, rstd);
#pragma unroll
    for (int c = 0; c < NCH; ++c) { const int o = c * 512 + lane * 8; v.a[c] = (v.a[c] - mean) * rstd * *(const f32x4*)(lg + o) + *(const f32x4*)(lb + o); v.b[c] = (v.b[c] - mean) * rstd * *(const f32x4*)(lg + o + 4) + *(const f32x4*)(lb + o + 4); }
#ifdef MK_QPROBE
    if (last) { const unsigned long long* st = (const unsigned long long*)(p.ws + WS.bar + 30720); const float fr = floorf(20.f * (float)st[41] / 32992.f) * 0.05f, sc = 1.f + sqrtf(fr * 0.1f);
      _Pragma("unroll") for (int c = 0; c < NCH; ++c) { v.a[c] = v.a[c] * sc; v.b[c] = v.b[c] * sc; } }
#endif
#ifdef MK_WAITPROBE
    if (last) { const unsigned long long* st = (const unsigned long long*)(p.ws + WS.bar + 30720); const float dus = floorf((float)st[40] * 0.01f / 50.f) * 50.f, sc = 1.f + sqrtf(dus * 1e-4f);
      _Pragma("unroll") for (int c = 0; c < NCH; ++c) { v.a[c] = v.a[c] * sc; v.b[c] = v.b[c] * sc; } }
#endif
#ifdef MK_PROBE_A
    if (last) { const unsigned long long* st = (const unsigned long long*)(p.ws + WS.bar + 30720); const float dus = (float)(st[MK_PROBE_B] - st[MK_PROBE_A]) * 0.01f, sc = 1.f + sqrtf(dus * 1e-4f);
      _Pragma("unroll") for (int c = 0; c < NCH; ++c) { v.a[c] = v.a[c] * sc; v.b[c] = v.b[c] * sc; } }
#endif
    if (last) { float* po = p.out + ((long)row_b(R) * SEQ + row_t(R)) * DM;
#pragma unroll
      for (int c = 0; c < NCH; ++c) { float* q = po + c * 512 + lane * 8; __builtin_nontemporal_store(v.a[c], (f32x4*)q); __builtin_nontemporal_store(v.b[c], (f32x4*)(q + 4)); } }
    else { row_store_bf_nt(v, X2 + (long)R * DM, lane); row_stats(v, mean, rstd); const float* mn = mod + 18 * DM + (long)row_mod(R) * 6 * DM; row_modulate_store(v, mean, rstd, mn, mn + DM, H1 + (long)R * DM, lane); } }
}

__device__ __forceinline__ void rope8(f32x4& a, f32x4& b, int xorl, bool first, const float* cs  ) {
#pragma unroll
  for (int j = 0; j < 4; ++j) { const float oa = __shfl_xor(a[j], xorl), ob = __shfl_xor(b[j], xorl);
    const float ca = cs[2 * j], sa = cs[2 * j + 1], cb = cs[8 + 2 * j], sb = cs[8 + 2 * j + 1];
    a[j] = a[j] * ca + (first ? -oa : oa) * sa; b[j] = b[j] * cb + (first ? -ob : ob) * sb; } }
__device__ __forceinline__ void ph_post_proj(const Params& p, int l) {
  static_assert(GHD == 128 && RQK == 64 && MROPE == 64 && MQL == 512 && MKVL == 256 && GH == 4 && GKV == 2 && RH == 4, "post_proj lane maps are written for the full-size config");
  const int tid_ = ph_tid(), lane = tid_ & 63, wv = tid_ >> 6; bf16_t* P = WSP(bf16_t, p, regA); bf16_t* KM = WSP(bf16_t, p, km); const float* ta = WSP(float, p, rope_a); const float* tb = WSP(float, p, rope_b);
  for (int R = blockIdx.x * 8 + wv; R < MROWS; R += gridDim.x * 8) { bf16_t* pr = P + (long)R * PW; const int t = row_t(R); const bool lat = t < SEQ; const int gr = lat ? t / GRIDW : 0, gc = lat ? t % GRIDW : 0;
    {
      const int g = lane >> 1, n = row_b(R) * S5NC + t / S5LC, a = t % S5LC; *(u32x4*)(WSP(bf16_t, p, uh) + ((long)g * S5NP + n) * (S5K1 + S5K2) + a * S5CH + (lane & 1) * 8) = *(const u32x4*)(pr + OFF_U + 8 * lane); }
    {
      const int j = lane & 15, hf = j >> 3; const bool first = !(j & 4); const float* cs = ta + ((hf ? gc : gr) * NROPE_A + ((8 * j) & 31)) * 2;
#pragma unroll
      for (int pass = 0; pass < 2; ++pass) { if (pass == 1 && lane >= 32) break; const int h = lane >> 4; bf16_t* x = pr + (pass ? OFF_GK : OFF_GQ) + h * GHD + 8 * j; const float* g = p.in[pass ? I_GKN : I_GQN] + l * GHD + 8 * j;
        f32x4 a, b; unpack8(*(const u32x4*)x, a, b); float ss = sum8(a * a, b * b); ss += __shfl_xor(ss, 8); ss += __shfl_xor(ss, 4); ss += __shfl_xor(ss, 2); ss += __shfl_xor(ss, 1);
        const float r = 1.f / sqrtf(ss * (1.f / GHD) + NORM_EPS); a = a * r * *(const f32x4*)g; b = b * r * *(const f32x4*)(g + 4);
        if (lat) rope8(a, b, 4, first, cs);
        *(u32x4*)x = pack8(a, b); } }
    {
      const int j = lane & 7, hf = j >> 2, h = (lane >> 3) & 3; const bool isk = lane >= 32, first = !(j & 2); bf16_t* x = pr + (isk ? OFF_RK : OFF_RQ) + h * RQK + 8 * j; const float sc = isk ? 0.125f : 1.f;
      f32x4 a, b; unpack8(*(const u32x4*)x, a, b); a = a * sc; b = b * sc;
      if (lat) rope8(a, b, 2, first, tb + ((hf ? gc : gr) * NROPE_B + ((8 * j) & 15)) * 2);
      *(u32x4*)x = pack8(a, b); }
    {
      bf16_t* x = pr + OFF_CQ + 8 * lane; const float* g = p.in[I_MQN] + l * MQL + 8 * lane; f32x4 a, b; unpack8(*(const u32x4*)x, a, b); const float ss = wave_sum(sum8(a * a, b * b));
      const float r = 1.f / sqrtf(ss * (1.f / MQL) + NORM_EPS); *(u32x4*)x = pack8(a * r * *(const f32x4*)g, b * r * *(const f32x4*)(g + 4)); }
    {
      if (lane < 32) { bf16_t* x = pr + OFF_CKV + 8 * lane; const float* g = p.in[I_MKVN] + l * MKVL + 8 * lane; f32x4 a, b; unpack8(*(const u32x4*)x, a, b); float ss = sum8(a * a, b * b);
        ss += __shfl_xor(ss, 16); ss += __shfl_xor(ss, 8); ss += __shfl_xor(ss, 4); ss += __shfl_xor(ss, 2); ss += __shfl_xor(ss, 1);
        const float r = 1.f / sqrtf(ss * (1.f / MKVL) + NORM_EPS); *(u32x4*)x = pack8(a * r * *(const f32x4*)g, b * r * *(const f32x4*)(g + 4)); }
      } }
}

struct ConvMat { bf16_t* dst; const float* src; const float* src2; int K, ld, ndst, nvalid, kind; };
constexpr int NMAT_L = 10 + 2 * NE, NMAT = NLAYER * NMAT_L;
__device__ __forceinline__ ConvMat conv_mat(const Params& p, int mi) {
  const int l = mi / NMAT_L, m = mi % NMAT_L; ConvMat c; c.src2 = nullptr; c.kind = 0;
  if (m == 0) { c.dst = WSP(bf16_t, p, wt_in) + (long)l * PW * DM; c.src = p.in[I_WIN] + (long)l * DM * IN_TOTAL; c.K = DM; c.ld = IN_TOTAL; c.ndst = PW; c.nvalid = IN_TOTAL; }
  else if (m == 1) { c.dst = WSP(bf16_t, p, wt_gate) + (long)l * 4 * DM * DM; c.src = p.in[I_WGATE] + (long)l * DM * 4 * DM; c.K = DM; c.ld = 4 * DM; c.ndst = 4 * DM; c.nvalid = 4 * DM; }
  else if (m < 6) { const int k = m - 2; c.dst = WSP(bf16_t, p, wt_br) + ((long)l * 4 + k) * DM * BW; c.src = p.in[I_WBR] + ((long)l * 4 + k) * BW * DM; c.K = BW; c.ld = DM; c.ndst = DM; c.nvalid = DM; }
  else if (m == 6) { c.dst = WSP(bf16_t, p, wt_out) + (long)l * DM * DM; c.src = p.in[I_WOUT] + (long)l * DM * DM; c.K = DM; c.ld = DM; c.ndst = DM; c.nvalid = DM; }
  else if (m == 7) { c.dst = WSP(bf16_t, p, wt_glu) + (long)l * BW * BW; c.src = p.in[I_S5GLU] + (long)l * BW * BW; c.K = BW; c.ld = BW; c.ndst = BW; c.nvalid = BW; }
  else if (m == 8) { c.dst = WSP(bf16_t, p, wt_uq) + (long)l * MH * MQK * MQL; c.src = p.in[I_WUQ] + (long)l * MQL * MH * MQK; c.K = MQL; c.ld = MH * MQK; c.ndst = MH * MQK; c.nvalid = MH * MQK; }
  else if (m == 9) { c.dst = WSP(bf16_t, p, wt_ukv) + (long)l * MH * (MNOPE + MV) * MKVL; c.src = p.in[I_WUKV] + (long)l * MKVL * MH * (MNOPE + MV); c.K = MKVL; c.ld = MH * (MNOPE + MV); c.ndst = MH * (MNOPE + MV); c.nvalid = c.ndst; }
  else if (m < 10 + NE) { const int e = m - 10; c.dst = WSP(bf16_t, p, wt_gu) + ((long)l * NE + e) * 2 * FF * DM; c.src = p.in[I_MOEG] + ((long)l * NE + e) * DM * FF; c.src2 = p.in[I_MOEU] + ((long)l * NE + e) * DM * FF;
    c.K = DM; c.ld = FF; c.ndst = 2 * FF; c.nvalid = 2 * FF; c.kind = 1; }
  else { const int e = m - 10 - NE; c.dst = WSP(bf16_t, p, wt_dn) + ((long)l * NE + e) * DM * FF; c.src = p.in[I_MOED] + ((long)l * NE + e) * FF * DM; c.K = FF; c.ld = DM; c.ndst = DM; c.nvalid = DM; }
  return c;
}
__device__ __forceinline__ void conv_tile(const ConvMat& c, int t, LAS unsigned* Lb, int tid) {
  const int n = tid & 63, kp = tid >> 6, tk = c.K / 64; const int k0 = (t % tk) * 64, n0 = (t / tk) * 128;
  const float* s; int col0, nval;
  if (c.kind == 1) { const int tile = n0 / 256; s = (n0 & 128) ? c.src2 : c.src; col0 = tile * 128; nval = 128; } else { s = c.src; col0 = n0; nval = c.nvalid - n0; }
  float v[2][4][2];
#pragma unroll
  for (int hh = 0; hh < 2; ++hh)
#pragma unroll
    for (int i = 0; i < 4; ++i) { const int k = 2 * (kp + 8 * i), cn = hh * 64 + n; const bool ok = cn < nval; const float* q = s + (long)(k0 + k) * c.ld + col0 + cn;
      v[hh][i][0] = ok ? __builtin_nontemporal_load(q) : 0.f; v[hh][i][1] = ok ? __builtin_nontemporal_load(q + c.ld) : 0.f; }
#pragma unroll
  for (int hh = 0; hh < 2; ++hh)
#pragma unroll
    for (int i = 0; i < 4; ++i) Lb[(hh * 64 + n) * 33 + kp + 8 * i] = pg8::cvt_pk_bf16(v[hh][i][0], v[hh][i][1]);
  __syncthreads();
#pragma unroll
  for (int hh = 0; hh < 2; ++hh) { const int id = hh * 512 + tid, rn = id >> 3, kc = id & 7; const LAS unsigned* q = Lb + rn * 33 + kc * 4; u32x4 w; w.x = q[0]; w.y = q[1]; w.z = q[2]; w.w = q[3];
    __builtin_nontemporal_store(w, (u32x4*)(c.dst + (long)(n0 + rn) * c.K + k0 + kc * 8)); }
}
constexpr int tiles_of(int K, int ndst) { return (K / 64) * (ndst / 128); }
constexpr int CT_DENSE_L = tiles_of(DM, PW) + tiles_of(DM, 4 * DM) + 4 * tiles_of(BW, DM) + tiles_of(DM, DM) + tiles_of(BW, BW) + tiles_of(MQL, MH * MQK) + tiles_of(MKVL, MH * (MNOPE + MV));
constexpr int CT_MOE_L = NE * (tiles_of(DM, 2 * FF) + tiles_of(FF, DM));
constexpr int CT_LAYER = CT_DENSE_L + CT_MOE_L, CT_TOTAL = NLAYER * CT_LAYER;
constexpr int CLAIM_DRAIN = 16, CLAIM_IDLE = 2, BG_STOP_EARLY = 0;
__device__ __forceinline__ bool conv_locate(const Params& p, int gtile, ConvMat& c, int& lt) {
  if (gtile >= CT_TOTAL) return false;
  const int l = gtile / CT_LAYER; int r = gtile % CT_LAYER, m = 0;
  if (r < CT_DENSE_L) { for (;; ++m) { c = conv_mat(p, l * NMAT_L + m); const int nt = tiles_of(c.K, c.ndst); if (r < nt) break; r -= nt; } }
  else { r -= CT_DENSE_L; constexpr int tg = tiles_of(DM, 2 * FF), td = tiles_of(FF, DM);
    if (r < NE * tg) { m = 10 + r / tg; r %= tg; } else { r -= NE * tg; m = 10 + NE + r / td; r %= td; }
    c = conv_mat(p, l * NMAT_L + m); }
  lt = r; return true;
}
template <int CLAIM> __device__ __forceinline__ bool conv_work(const Params& p, LAS unsigned char* lds, unsigned* counter, int target, unsigned* arr) {
  const int tid = ph_tid(); LAS unsigned* L = (LAS unsigned*)lds; LAS unsigned* nxt = L + 2 * 128 * 33; int buf = 0; bool alive = true;
  for (;;) {
    if (tid == 0) { unsigned v = 0xFFFFFFFFu;
      const bool go = target > 0 ? (int)__hip_atomic_load(counter, __ATOMIC_RELAXED, __HIP_MEMORY_SCOPE_AGENT) < target
                                 : __hip_atomic_load(arr, __ATOMIC_RELAXED, __HIP_MEMORY_SCOPE_AGENT) + BG_STOP_EARLY < gridDim.x;
      if (go) v = __hip_atomic_fetch_add(counter, (unsigned)CLAIM, __ATOMIC_RELAXED, __HIP_MEMORY_SCOPE_AGENT);
      *nxt = v; }
    __syncthreads(); const unsigned claim = *nxt; __syncthreads();
    if (claim == 0xFFFFFFFFu) break;
    if ((int)claim >= CT_TOTAL) { alive = false; break; }
    for (int q = 0; q < CLAIM; ++q) { ConvMat c; int lt; if (conv_locate(p, (int)claim + q, c, lt)) { conv_tile(c, lt, L + buf * (128 * 33), tid); buf ^= 1; } }
    __syncthreads(); }
  return alive;
}
__device__ __forceinline__ void ph_mod(const Params& p, LAS unsigned char* lds, int wg) {
  const int tid = ph_tid(); LAS float* sl = (LAS float*)lds; LAS float* part = sl + 3 * DM;
  for (int i = tid; i < 3 * DM; i += 512) { const int r = i / DM, k = i % DM; const float cv = r < 2 ? p.in[I_C][r * DM + k] : p.in[I_CCTX][k]; sl[i] = cv / (1.f + expf(-cv)); }
  __syncthreads();
  const int cg = tid & 31, ks = tid >> 5;
  constexpr int KS = DM / 16, NIT = NLAYER * (6 * DM / 128);
  if (wg >= NIT) return;
  for (int it = wg; it < NIT; it += gridDim.x) { const int l = it / (6 * DM / 128), cb = it % (6 * DM / 128); const float* w = p.in[I_ADAW] + (long)l * DM * 6 * DM + cb * 128 + cg * 4;
    f32x4 a0 = {0.f, 0.f, 0.f, 0.f}, a1 = a0, a2 = a0;
#pragma unroll 8
    for (int k = ks * KS; k < (ks + 1) * KS; ++k) { const f32x4 wv = __builtin_nontemporal_load((const f32x4*)(w + (long)k * 6 * DM)); a0 += sl[k] * wv; a1 += sl[DM + k] * wv; a2 += sl[2 * DM + k] * wv; }
    LAS float* pp = part + (ks * 3) * 128 + cg * 4; *(LAS f32x4*)pp = a0; *(LAS f32x4*)(pp + 128) = a1; *(LAS f32x4*)(pp + 256) = a2;
    __syncthreads();
    if (tid < 384) { const int r = tid / 128, col = tid % 128; float s = 0.f;
#pragma unroll
      for (int q = 0; q < 16; ++q) s += part[(q * 3 + r) * 128 + col];
      WSP(float, p, mod)[((long)l * 3 + r) * 6 * DM + cb * 128 + col] = s + p.in[I_ADAB][(long)l * 6 * DM + cb * 128 + col]; }
    __syncthreads(); }
}
__device__ __forceinline__ void ph_tables(const Params& p) {
  const long gt = (long)blockIdx.x * 512 + ph_tid(), gs = (long)gridDim.x * 512;
  float* ta = WSP(float, p, rope_a); float* tb = WSP(float, p, rope_b);
  for (long i = gt; i < (long)GRIDW * (NROPE_A + NROPE_B); i += gs) { const int pos = (int)(i / (NROPE_A + NROPE_B)), k = (int)(i % (NROPE_A + NROPE_B));
    if (k < NROPE_A) { const float a = pos * powf(10000.f, -(float)k / NROPE_A); ta[(pos * NROPE_A + k) * 2] = cosf(a); ta[(pos * NROPE_A + k) * 2 + 1] = sinf(a); }
    else { const int kk = k - NROPE_A; const float a = pos * powf(10000.f, -(float)kk / NROPE_B); tb[(pos * NROPE_B + kk) * 2] = cosf(a); tb[(pos * NROPE_B + kk) * 2 + 1] = sinf(a); } }
  for (long i = gt; i < DM / 2; i += gs) WSP(unsigned, p, zrow)[i] = 0u;
  float* tab = WSP(float, p, s5tab);
  for (long i = gt; i < (long)NLAYER * 2 * S5G * S5P; i += gs) { const int pp = (int)(i % S5P), g = (int)((i / S5P) % S5G), dir = (int)((i / (S5P * S5G)) % 2), l = (int)(i / (2 * S5P * S5G));
    const float a_re = p.in[dir ? I_S5AREB : I_S5AREF][(l * S5G + g) * S5P + pp], a_im = p.in[dir ? I_S5AIMB : I_S5AIMF][(l * S5G + g) * S5P + pp];
    const float dt = expf(p.in[dir ? I_S5DTB : I_S5DTF][l * S5G + g]);
    const float mag = expf(a_re * dt), ab_re = mag * cosf(a_im * dt), ab_im = mag * sinf(a_im * dt);
    const float den = a_re * a_re + a_im * a_im, nr = ab_re - 1.f, ni = ab_im;
    const float cr = (nr * a_re + ni * a_im) / den, ci = (ni * a_re - nr * a_im) / den;
    float* t = tab + i * S5TW; t[0] = ab_re; t[1] = ab_im;
    for (int c = 0; c < S5CH; ++c) { const float br = p.in[I_S5BRE][((l * S5G + g) * S5P + pp) * S5CH + c], bi = p.in[I_S5BIM][((l * S5G + g) * S5P + pp) * S5CH + c];
      t[2 + c] = cr * br - ci * bi; t[2 + S5CH + c] = cr * bi + ci * br; } }
}

__device__ __forceinline__ void ph_s5tables(const Params& p, LAS unsigned char* lds) {
  const int tid = ph_tid(); LAS float* pw = (LAS float*)lds; LAS float* bb = pw + 2 * S5P * (S5LC + 1) * 2; LAS float* cc = bb + 2 * S5P * S5CH * 2; LAS float* T = cc + S5CH * S5P * 2;
  for (int item = blockIdx.x; item < NLAYER * S5G; item += gridDim.x) { const int l = item / S5G, g = item % S5G;
    for (int i = tid; i < 2 * S5P; i += 512) { const int dir = i / S5P, pp = i % S5P;
      const double a_re = p.in[dir ? I_S5AREB : I_S5AREF][(l * S5G + g) * S5P + pp], a_im = p.in[dir ? I_S5AIMB : I_S5AIMF][(l * S5G + g) * S5P + pp], dt = exp((double)p.in[dir ? I_S5DTB : I_S5DTF][l * S5G + g]);
      for (int k = 0; k <= S5LC; ++k) { const double mag = exp(a_re * dt * k), ang = a_im * dt * k; pw[((dir * S5P + pp) * (S5LC + 1) + k) * 2] = (float)(mag * cos(ang)); pw[((dir * S5P + pp) * (S5LC + 1) + k) * 2 + 1] = (float)(mag * sin(ang)); }
      const double mag = exp(a_re * dt), abr = mag * cos(a_im * dt), abi = mag * sin(a_im * dt), den = a_re * a_re + a_im * a_im, nr = abr - 1.0, ni = abi, cr = (nr * a_re + ni * a_im) / den, ci = (ni * a_re - nr * a_im) / den;
      for (int c = 0; c < S5CH; ++c) { const double br = p.in[I_S5BRE][((l * S5G + g) * S5P + pp) * S5CH + c], bi = p.in[I_S5BIM][((l * S5G + g) * S5P + pp) * S5CH + c];
        bb[((dir * S5P + pp) * S5CH + c) * 2] = (float)(cr * br - ci * bi); bb[((dir * S5P + pp) * S5CH + c) * 2 + 1] = (float)(cr * bi + ci * br); } }
    for (int i = tid; i < S5CH * S5P; i += 512) { cc[2 * i] = p.in[I_S5CRE][(long)(l * S5G + g) * S5CH * S5P + i]; cc[2 * i + 1] = p.in[I_S5CIM][(long)(l * S5G + g) * S5CH * S5P + i]; }
    __syncthreads();
    for (int e = tid; e < (2 * S5LC - 1) * S5CH * S5CH; e += 512) { const int tau = e / (S5CH * S5CH) - (S5LC - 1), i = (e % (S5CH * S5CH)) / S5CH, c = e % S5CH; float s = 0.f;
      for (int dir = 0; dir < 2; ++dir) { if (dir == 0 ? tau < 0 : tau > 0) continue; const int k = tau < 0 ? -tau : tau;
        for (int pp = 0; pp < S5P; ++pp) { const float cr_ = cc[(i * S5P + pp) * 2], ci_ = cc[(i * S5P + pp) * 2 + 1], ar = pw[((dir * S5P + pp) * (S5LC + 1) + k) * 2], ai = pw[((dir * S5P + pp) * (S5LC + 1) + k) * 2 + 1];
          const float br = bb[((dir * S5P + pp) * S5CH + c) * 2], bi = bb[((dir * S5P + pp) * S5CH + c) * 2 + 1]; const float zr = ar * br - ai * bi, zi = ar * bi + ai * br; s += cr_ * zr - ci_ * zi; } }
      T[e] = s; }
    __syncthreads();
    bf16_t* SW = WSP(bf16_t, p, s5sw) + (long)item * S5K2 * S5K1; bf16_t* SV = WSP(bf16_t, p, s5sv) + (long)item * S5K1 * (S5K1 + S5K2);
    for (int e = tid; e < S5K2 * S5K1; e += 512) { const int r = e / S5K1, col = e % S5K1, dir = r / (2 * S5P), pp = (r % (2 * S5P)) / 2, im = r & 1, a = col / S5CH, c = col % S5CH; const int k = dir ? a : (S5LC - 1 - a);
      const float ar = pw[((dir * S5P + pp) * (S5LC + 1) + k) * 2], ai = pw[((dir * S5P + pp) * (S5LC + 1) + k) * 2 + 1], br = bb[((dir * S5P + pp) * S5CH + c) * 2], bi = bb[((dir * S5P + pp) * S5CH + c) * 2 + 1];
      SW[e] = f2bf(im ? ar * bi + ai * br : ar * br - ai * bi); }
    for (int e = tid; e < S5K1 * (S5K1 + S5K2); e += 512) { const int r = e / (S5K1 + S5K2), k = e % (S5K1 + S5K2), a = r / S5CH, i = r % S5CH; float v;
      if (k < S5K1) { const int a2 = k / S5CH, c = k % S5CH; v = T[((a - a2) + (S5LC - 1)) * S5CH * S5CH + i * S5CH + c]; }
      else { const int kk = k - S5K1, dir = kk / (2 * S5P), pp = (kk % (2 * S5P)) / 2, im = kk & 1, pk = dir ? (S5LC - a) : (a + 1);
        const float cr_ = cc[(i * S5P + pp) * 2], ci_ = cc[(i * S5P + pp) * 2 + 1], ar = pw[((dir * S5P + pp) * (S5LC + 1) + pk) * 2], ai = pw[((dir * S5P + pp) * (S5LC + 1) + pk) * 2 + 1];
        v = im ? -(cr_ * ai + ci_ * ar) : (cr_ * ar - ci_ * ai); }
      SV[e] = f2bf(v); }
    __syncthreads(); }
}
__device__ __forceinline__ void ph_s5scan(const Params& p, int l) {
  const float* tab = WSP(float, p, s5tab); const float* E = WSP(float, p, s5e); bf16_t* UH = WSP(bf16_t, p, uh);
  for (long i = (long)blockIdx.x * 512 + ph_tid(); i < (long)NB * S5G * 2 * S5P; i += (long)gridDim.x * 512) { const int pp = (int)(i % S5P), dir = (int)((i / S5P) % 2), g = (int)((i / (2 * S5P)) % S5G), b = (int)(i / (2 * S5P * S5G));
    const float* t = tab + ((((long)l * 2 + dir) * S5G + g) * S5P + pp) * S5TW; float ar = t[0], ai = t[1];
#pragma unroll
    for (int q = 0; q < 4; ++q) { const float nr = ar * ar - ai * ai, ni = 2.f * ar * ai; ar = nr; ai = ni; }
    float hr = 0.f, hi = 0.f; constexpr int NCX = CTXL / S5LC, NLT = SEQ / S5LC;
    for (int s0 = 0; s0 < S5NC; s0 += 8) { float er[8], ei[8]; long idx[8];
#pragma unroll
      for (int q = 0; q < 8; ++q) { const int s = s0 + q; const int j = dir == 0 ? (s < NCX ? NLT + s : s - NCX) : (s < NCX ? S5NC - 1 - s : NLT - 1 - (s - NCX)); idx[q] = (long)g * S5NP + b * S5NC + j;
        const float2 ev = *(const float2*)(E + idx[q] * S5K2 + dir * 2 * S5P + pp * 2); er[q] = ev.x; ei[q] = ev.y; }
#pragma unroll
      for (int q = 0; q < 8; ++q) { *(unsigned*)(UH + idx[q] * (S5K1 + S5K2) + S5K1 + dir * 2 * S5P + pp * 2) = pg8::cvt_pk_bf16(hr, hi);
        const float nr = ar * hr - ai * hi + er[q], ni = ar * hi + ai * hr + ei[q]; hr = nr; hi = ni; } } }
}

__device__ __forceinline__ void ph_merge_ctx(const Params& p) {
  const bf16_t* GC = WSP(bf16_t, p, gctx); const bf16_t* PROJ = (const bf16_t*)(p.ws + WS.regA + SZ_P); bf16_t* MG = WSP(bf16_t, p, merged);
  for (long i = (long)blockIdx.x * 512 + ph_tid(); i < (long)NB * CTXL * DM / 8; i += (long)gridDim.x * 512) { const int r = (int)(i / (DM / 8)), d = (int)(i % (DM / 8)) * 8; const long R = (long)(r / CTXL) * NTOK + SEQ + r % CTXL;
    f32x4 s0 = {0.f, 0.f, 0.f, 0.f}, s1 = s0;
#pragma unroll
    for (int k = 0; k < 4; ++k) { f32x4 g0, g1, q0, q1; unpack8(*(const u32x4*)(GC + (long)r * 4 * DM + k * DM + d), g0, g1); unpack8(*(const u32x4*)(PROJ + R * 4 * DM + k * DM + d), q0, q1); s0 += g0 * q0; s1 += g1 * q1; }
    *(u32x4*)(MG + R * DM + d) = pack8(s0, s1); }
}

__device__ __forceinline__ void ph_kr_combine(const Params& p) {
  const float* KRP = WSP(float, p, krp); bf16_t* KM = WSP(bf16_t, p, km); const float* tb = WSP(float, p, rope_b);
  for (long i = (long)blockIdx.x * 512 + ph_tid(); i < (long)MROWS * (MROPE / 8); i += (long)gridDim.x * 512) { const int R = (int)(i / (MROPE / 8)), c = (int)(i % (MROPE / 8)), t = row_t(R);
    const float* q0 = KRP + (long)R * MROPE; const float* q1 = q0 + (long)MROWS * MROPE;
    f32x4 a = *(const f32x4*)(q0 + 8 * c) + *(const f32x4*)(q1 + 8 * c), b = *(const f32x4*)(q0 + 8 * c + 4) + *(const f32x4*)(q1 + 8 * c + 4);
    if (t < SEQ) { const int cp = c ^ 2; const f32x4 oa = *(const f32x4*)(q0 + 8 * cp) + *(const f32x4*)(q1 + 8 * cp), ob = *(const f32x4*)(q0 + 8 * cp + 4) + *(const f32x4*)(q1 + 8 * cp + 4);
      const bool first = !(c & 2); const int hf = c >> 2; const float* cs = tb + ((hf ? t % GRIDW : t / GRIDW) * NROPE_B + ((8 * c) & 15)) * 2;
#pragma unroll
      for (int j = 0; j < 4; ++j) { a[j] = a[j] * cs[2 * j] + (first ? -oa[j] : oa[j]) * cs[2 * j + 1]; b[j] = b[j] * cs[8 + 2 * j] + (first ? -ob[j] : ob[j]) * cs[8 + 2 * j + 1]; } }
    const u32x4 w = pack8(a, b);
#pragma unroll
    for (int h = 0; h < MH; ++h) *(u32x4*)(KM + (long)R * MH * MQK + h * MQK + MNOPE + 8 * c) = w; }
}
__device__ __forceinline__ void ph_topk(const Params& p, int l, LAS unsigned char* lds) {
  const int tid = ph_tid(), lane = tid & 63, wv = tid >> 6; LAS unsigned* hist = (LAS unsigned*)lds; LAS unsigned* sh = hist + 256;
  const float* AFF = WSP(float, p, aff); int* SLOT = WSP(int, p, slot); float* GV = WSP(float, p, gatev); int* XSRC = WSP(int, p, xsrc);
  const int nprob = (l == 0 ? 4 : 2) * NE; constexpr int KPT = SEQ / 512;
  for (int pr = blockIdx.x; pr < nprob; pr += gridDim.x) { const int set = pr / NE, e = pr % NE, b = set & 1; const bool lat = set < 2; const int n = lat ? SEQ : CTXL, cap = lat ? CAP_L : CAP_C, R0 = b * NTOK + (lat ? 0 : SEQ);
    unsigned key[KPT];
#pragma unroll
    for (int k = 0; k < KPT; ++k) { const int i = tid + 512 * k; key[k] = i < n ? __float_as_uint(AFF[(long)(R0 + i) * NE + e]) : 0u; }
    unsigned prefix = 0u, mask = 0u, remaining = (unsigned)cap;
    for (int pass = 0; pass < 4; ++pass) { const int shift = 24 - 8 * pass;
      if (tid < 256) hist[tid] = 0u; __syncthreads();
#pragma unroll
      for (int k = 0; k < KPT; ++k) { const int i = tid + 512 * k; if (i < n && (key[k] & mask) == prefix) atomicAdd((unsigned*)&hist[(key[k] >> shift) & 255u], 1u); }
      __syncthreads();
      if (wv == 0) {
        unsigned h0 = hist[255 - 4 * lane], h1 = hist[254 - 4 * lane], h2 = hist[253 - 4 * lane], h3 = hist[252 - 4 * lane]; const unsigned tot = h0 + h1 + h2 + h3; unsigned inc = tot;
#pragma unroll
        for (int o = 1; o < 64; o <<= 1) { const unsigned t = __shfl_up(inc, o); if (lane >= o) inc += t; }
        const unsigned exc = inc - tot; const bool hit = exc < remaining && inc >= remaining; const unsigned long long bm = __ballot(hit);
        if (bm == 0ull) { if (lane == 0) { sh[0] = 0u; sh[1] = remaining; } }
        else if (lane == (int)__builtin_ctzll(bm)) { unsigned cum = exc; int d = 255 - 4 * lane;
          if (cum + h0 < remaining) { cum += h0; --d; if (cum + h1 < remaining) { cum += h1; --d; if (cum + h2 < remaining) { cum += h2; --d; } } }
          sh[0] = (unsigned)d; sh[1] = remaining - cum; } }
      __syncthreads();
      prefix |= sh[0] << shift; mask |= 0xFFu << shift; remaining = sh[1]; __syncthreads(); }
    const unsigned T = prefix, need_eq = remaining;
    unsigned base_gt = 0u, base_eq = 0u; int slotv[KPT];
#pragma unroll
    for (int k = 0; k < KPT; ++k) { const int i = tid + 512 * k; const bool gt = i < n && key[k] > T, eq = i < n && key[k] == T;
      const unsigned long long bg = __ballot(gt), be = __ballot(eq), lt = (1ull << lane) - 1ull;
      if (lane == 0) { sh[8 + wv] = (unsigned)__popcll(bg); sh[16 + wv] = (unsigned)__popcll(be); } __syncthreads();
      unsigned pg = 0u, pe = 0u, tg = 0u, te = 0u;
#pragma unroll
      for (int w = 0; w < 8; ++w) { const unsigned a = sh[8 + w], c = sh[16 + w]; pg += w < wv ? a : 0u; pe += w < wv ? c : 0u; tg += a; te += c; }
      const unsigned rg = base_gt + pg + (unsigned)__popcll(bg & lt), re = base_eq + pe + (unsigned)__popcll(be & lt);
      slotv[k] = gt ? (int)rg : (eq && re < need_eq ? -2 - (int)re : -1);
      base_gt += tg; base_eq += te; __syncthreads(); }
    const int xbase = e * XEP + (lat ? b * CAP_L : 2 * CAP_L + b * CAP_C);
#pragma unroll
    for (int k = 0; k < KPT; ++k) { const int i = tid + 512 * k; if (i < n) { int s = slotv[k]; if (s <= -2) s = (int)base_gt + (-2 - s);
        const long R = R0 + i; if (s >= 0) { const int xr = xbase + s; SLOT[R * NE + e] = xr; GV[xr] = __uint_as_float(key[k]); XSRC[xr] = (int)R; } else SLOT[R * NE + e] = -1; } }
    if (set == 3) for (int i = tid; i < XEP - XE; i += 512) XSRC[e * XEP + XE + i] = -1;
    __syncthreads(); }
}
__device__ __forceinline__ void ph_gather(const Params& p, int l) {
  const int tid_ = ph_tid(), lane = tid_ & 63, wv = tid_ >> 6; const int* XSRC = WSP(int, p, xsrc); const bf16_t* H2 = WSP(bf16_t, p, h2); bf16_t* XS = WSP(bf16_t, p, regA);
  const int rows_e = (l == 0) ? XEP : 2 * CAP_L, total = NE * rows_e;
  for (int it = blockIdx.x * 8 + wv; it < total; it += gridDim.x * 8) { const int e = it / rows_e, xr = e * XEP + it % rows_e; const int src = XSRC[xr];
#pragma unroll
    for (int c = 0; c < NCH; ++c) { const int o = c * 512 + lane * 8; u32x4 w = {0u, 0u, 0u, 0u}; if (src >= 0) w = *(const u32x4*)(H2 + (long)src * DM + o); *(u32x4*)(XS + (long)xr * DM + o) = w; } }
}
}
#endif
#ifndef CPU_TEST
namespace att {
#ifndef ATT_SD_MLA
#define ATT_SD_MLA 1
#endif
#ifndef ATT_SD_GQA
#define ATT_SD_GQA 2
#endif
using bf16x8 = __attribute__((ext_vector_type(8))) short;
using s16x4  = __attribute__((ext_vector_type(4))) short;
using f32x16 = __attribute__((ext_vector_type(16))) float;
using u32x4  = __attribute__((ext_vector_type(4))) unsigned;
constexpr int DV = 128, NW = 8, QBLK = 32, KVBLK = 64;
constexpr float THR = 8.f;
#define ATT_SBAR() __builtin_amdgcn_sched_barrier(0)
__device__ __forceinline__ int crow(int r, int hi) { return (r & 3) + 8 * (r >> 2) + 4 * hi; }
__device__ __forceinline__ unsigned cvtpk(float lo, float hi) { unsigned r; asm volatile("v_cvt_pk_bf16_f32 %0, %1, %2" : "=v"(r) : "v"(lo), "v"(hi)); return r; }
template <int DQK> constexpr size_t shm_k() { return (size_t)KVBLK * DQK * 2; }
constexpr size_t SHM_V = KVBLK * DV * 2;
constexpr int QL_PITCH = 144;
template <int DQK> constexpr size_t shm_attn() { return 2 * SHM_V + 2 * shm_k<DQK>() + NW * 64 * 4 + (DQK > 128 ? 256 * QL_PITCH : 0); }

__device__ __forceinline__ void partialSM(f32x16& p0, f32x16& p1, float& m_reg, float& mn, float& alpha, const float C, const float thr_raw) {
  float pmax = p0[0];
#pragma unroll
  for (int r = 1; r < 16; ++r) pmax = fmaxf(pmax, p0[r]);
#pragma unroll
  for (int r = 0; r < 16; ++r) pmax = fmaxf(pmax, p1[r]);
  { auto rr = __builtin_amdgcn_permlane32_swap(__float_as_uint(pmax), __float_as_uint(pmax), false, false);
    pmax = fmaxf(__uint_as_float(rr[0]), __uint_as_float(rr[1])); }
  if (__builtin_expect(__all(pmax - m_reg <= thr_raw), 1)) { mn = m_reg; alpha = 1.f; }
  else { mn = fmaxf(m_reg, pmax); alpha = __builtin_amdgcn_exp2f((m_reg - mn) * C); m_reg = mn; }
  const float mnC = -mn * C;
#pragma unroll
  for (int r = 0; r < 16; ++r) p0[r] = fmaf(p0[r], C, mnC);
#pragma unroll
  for (int r = 0; r < 16; ++r) p1[r] = fmaf(p1[r], C, mnC);
#pragma unroll
  for (int r = 0; r < 16; ++r) p0[r] = __builtin_amdgcn_exp2f(p0[r]);
}
__device__ __forceinline__ void finishSM(f32x16& p0, f32x16& p1, float alpha, float& l_reg, bf16x8& pa0, bf16x8& pa1, bf16x8& pa2, bf16x8& pa3) {
#pragma unroll
  for (int r = 0; r < 16; ++r) p1[r] = __builtin_amdgcn_exp2f(p1[r]);
  float ps = 0;
#pragma unroll
  for (int r = 0; r < 16; ++r) ps += p0[r];
#pragma unroll
  for (int r = 0; r < 16; ++r) ps += p1[r];
  { auto rr = __builtin_amdgcn_permlane32_swap(__float_as_uint(ps), __float_as_uint(ps), false, false);
    ps = __uint_as_float(rr[0]) + __uint_as_float(rr[1]); }
  l_reg = l_reg * alpha + ps;
#define ATT_PK4(P, BASE, OUT) do { unsigned a0 = cvtpk(P[BASE + 0], P[BASE + 1]), a1 = cvtpk(P[BASE + 2], P[BASE + 3]);   \
    unsigned b0 = cvtpk(P[BASE + 4], P[BASE + 5]), b1 = cvtpk(P[BASE + 6], P[BASE + 7]);                              \
    auto r0 = __builtin_amdgcn_permlane32_swap(a0, b0, false, false); auto r1 = __builtin_amdgcn_permlane32_swap(a1, b1, false, false); \
    u32x4 w = {r0[0], r1[0], r0[1], r1[1]}; OUT = *reinterpret_cast<bf16x8*>(&w); } while (0)
  ATT_PK4(p0, 0, pa0); ATT_PK4(p0, 8, pa1); ATT_PK4(p1, 0, pa2); ATT_PK4(p1, 8, pa3);
#undef ATT_PK4
}
__device__ __forceinline__ bf16x8 bl(__amdgpu_buffer_rsrc_t r, int voff, int soff) { const u32x4 w = __builtin_amdgcn_raw_buffer_load_b128(r, voff, soff, 0); return *reinterpret_cast<const bf16x8*>(&w); }
template <int DQK> __device__ __forceinline__ int kswz(int row, int colB) { return row * (DQK * 2) + (colB ^ ((row & 7) << 4)); }
template <int DQK, int QL> __device__ __forceinline__ void qkt(f32x16& p0, f32x16& p1, const char* Ks, const bf16x8* qr, const char* qlds, const int (&ka)[4]) {
  p0 = f32x16{}; p1 = f32x16{};
#pragma unroll
  for (int d0 = 0; d0 < DQK / 16; ++d0) { const char* kp = Ks + ka[d0 & 3] + (d0 >> 2) * 128;
    bf16x8 b0 = *reinterpret_cast<const bf16x8*>(kp);
    bf16x8 b1 = *reinterpret_cast<const bf16x8*>(kp + 32 * DQK * 2);
    const bf16x8 q = (d0 < DQK / 16 - QL) ? qr[d0] : *reinterpret_cast<const bf16x8*>(qlds + (d0 - (DQK / 16 - QL)) * 32);
    p0 = __builtin_amdgcn_mfma_f32_32x32x16_bf16(b0, q, p0, 0, 0, 0);
    p1 = __builtin_amdgcn_mfma_f32_32x32x16_bf16(b1, q, p1, 0, 0, 0); }
}
__device__ __forceinline__ int v_st(int k, int c) { const int kk = (k & ~0xC) | ((k & 4) << 1) | ((k & 8) >> 1); return ((kk >> 3) * 4 + (c >> 5)) * 512 + ((kk & 7) * 32 + (c & 31)) * 2; }
__device__ __forceinline__ int v_rd_base(int lane) { return ((lane & 3) << 3) | (((lane >> 2) & 3) << 6) | (((lane >> 4) & 1) << 5) | (((lane >> 5) & 1) << 8); }
constexpr int v_rd_off(int d0, int ks, int half) { return d0 * 512 + ks * 4096 + half * 2048; }
template <int OFF> __device__ __forceinline__ s16x4 tr_read(int vb) {
  s16x4 r; asm volatile("ds_read_b64_tr_b16 %0, %1 offset:%2" : "=&v"(r) : "v"(vb), "i"(OFF) : "memory"); return r;
}
template <int D0> __device__ __forceinline__ void pv_one(f32x16& od, int vb, bf16x8 pa0, bf16x8 pa1, bf16x8 pa2, bf16x8 pa3) {
  const s16x4 l0 = tr_read<v_rd_off(D0, 0, 0)>(vb), h0 = tr_read<v_rd_off(D0, 0, 1)>(vb), l1 = tr_read<v_rd_off(D0, 1, 0)>(vb), h1 = tr_read<v_rd_off(D0, 1, 1)>(vb);
  const s16x4 l2 = tr_read<v_rd_off(D0, 2, 0)>(vb), h2 = tr_read<v_rd_off(D0, 2, 1)>(vb), l3 = tr_read<v_rd_off(D0, 3, 0)>(vb), h3 = tr_read<v_rd_off(D0, 3, 1)>(vb);
  asm volatile("s_waitcnt lgkmcnt(0)" ::: "memory"); ATT_SBAR();
#define ATT_PK(L, H) (bf16x8){L[0], L[1], L[2], L[3], H[0], H[1], H[2], H[3]}
  od = __builtin_amdgcn_mfma_f32_32x32x16_bf16(pa0, ATT_PK(l0, h0), od, 0, 0, 0);
  od = __builtin_amdgcn_mfma_f32_32x32x16_bf16(pa1, ATT_PK(l1, h1), od, 0, 0, 0);
  od = __builtin_amdgcn_mfma_f32_32x32x16_bf16(pa2, ATT_PK(l2, h2), od, 0, 0, 0);
  od = __builtin_amdgcn_mfma_f32_32x32x16_bf16(pa3, ATT_PK(l3, h3), od, 0, 0, 0);
#undef ATT_PK
}
__device__ __forceinline__ void pv_d0(f32x16* o, int vb, bf16x8 pa0, bf16x8 pa1, bf16x8 pa2, bf16x8 pa3) {
  pv_one<0>(o[0], vb, pa0, pa1, pa2, pa3); pv_one<1>(o[1], vb, pa0, pa1, pa2, pa3); pv_one<2>(o[2], vb, pa0, pa1, pa2, pa3); pv_one<3>(o[3], vb, pa0, pa1, pa2, pa3);
}
template <int DQK, int LDQ, int LDK, int LDV, int LDO, int SDEPTH, int QL>
__device__ __forceinline__ void attn_body(const bf16_t* __restrict__ Qb, const bf16_t* __restrict__ Kh, const bf16_t* __restrict__ Vh, bf16_t* __restrict__ Ob, int seq, char* lds, const float scale) {
  constexpr int NKC = DQK / 64;
  constexpr size_t SHM_K = shm_k<DQK>();
  const float C = scale * 1.4426950408889634f, thr_raw = THR / scale;
  const int tid = ph_tid(), wid = tid >> 6, lane = tid & 63, r32 = lane & 31, hi = lane >> 5;
  char* V_lds = lds; char* K_lds = lds + 2 * SHM_V;
  float* wsf = (float*)(lds + 2 * SHM_V + 2 * SHM_K) + wid * 64; float* li_l = wsf; float* al_l = wsf + 32;
  float m_reg = -1e30f, l_reg = 0; f32x16 o[4] = {}; bf16x8 qr[DQK / 16 - QL];
  const bf16_t* Qw = Qb + (long)(wid * QBLK + r32) * LDQ + hi * 8;
#pragma unroll
  for (int d0 = 0; d0 < DQK / 16 - QL; ++d0) qr[d0] = *reinterpret_cast<const bf16x8*>(Qw + d0 * 16);
  char* qlds = lds + 2 * SHM_V + 2 * SHM_K + NW * 64 * 4 + (wid * QBLK + r32) * QL_PITCH + hi * 16;
#pragma unroll
  for (int d0 = 0; d0 < QL; ++d0) *reinterpret_cast<bf16x8*>(qlds + d0 * 32) = *reinterpret_cast<const bf16x8*>(Qw + (DQK / 16 - QL + d0) * 16);
  const int sr = tid >> 4, sc = (tid & 15) * 8, vst0 = v_st(sr, sc), vst1 = v_st(32 + sr, sc);
  int kgo[NKC], klo[NKC];
#pragma unroll
  for (int i = 0; i < NKC; ++i) { const int c = tid + 512 * i, kr = c / (DQK / 8), kc = (c % (DQK / 8)) * 8; kgo[i] = kr * LDK + kc; klo[i] = kswz<DQK>(kr, kc * 2); }
  const int vgo = sr * LDV + sc;
  int ka[4];
#pragma unroll
  for (int q = 0; q < 4; ++q) ka[q] = r32 * (DQK * 2) + ((q * 32 + hi * 16) ^ ((r32 & 7) << 4));
  const __amdgpu_buffer_rsrc_t rK = __builtin_amdgcn_make_buffer_rsrc((void*)Kh, 0, 0x7ffffffc, 0x00020000), rV = __builtin_amdgcn_make_buffer_rsrc((void*)Vh, 0, 0x7ffffffc, 0x00020000);
  const int vb0 = (int)(uintptr_t)V_lds + v_rd_base(lane);
  struct { bf16x8 vs0, vs1, ks[NKC]; } sr_[SDEPTH];
#define ATT_SLOAD(i, k0) do { const int _vo = (k0) * (LDV * 2), _ko = (k0) * (LDK * 2); sr_[i].vs0 = bl(rV, vgo * 2, _vo); sr_[i].vs1 = bl(rV, vgo * 2 + 64 * LDV, _vo); \
    _Pragma("unroll") for (int _c = 0; _c < NKC; ++_c) sr_[i].ks[_c] = bl(rK, kgo[_c] * 2, _ko); } while (0)
#define ATT_SWRITE(b, i) do { *(bf16x8*)(V_lds + (b) * SHM_V + vst0) = sr_[i].vs0; *(bf16x8*)(V_lds + (b) * SHM_V + vst1) = sr_[i].vs1; \
    _Pragma("unroll") for (int _c = 0; _c < NKC; ++_c) *(bf16x8*)(K_lds + (b) * SHM_K + klo[_c]) = sr_[i].ks[_c]; } while (0)
#define ATT_SWAIT() asm volatile("s_waitcnt vmcnt(%0)" :: "n"(SDEPTH == 2 ? 2 + NKC : 0) : "memory")
#define ATT_RESC(a) do { if (__any((a) < 1.f)) { if (hi == 0) al_l[r32] = (a); asm volatile("s_waitcnt lgkmcnt(0)" ::: "memory"); \
    _Pragma("unroll") for (int d = 0; d < 4; ++d) _Pragma("unroll") for (int r = 0; r < 16; ++r) o[d][r] *= al_l[crow(r, hi)]; } } while (0)
  f32x16 pA0, pA1, pB0, pB1; float mnA, mnB, alA, alB; bf16x8 pa0, pa1, pa2, pa3; const int NT = seq / KVBLK;
  constexpr int SE = 0, SO = SDEPTH - 1;
  ATT_SLOAD(SE, 0); asm volatile("s_waitcnt vmcnt(0)" ::: "memory"); ATT_SWRITE(0, SE); __syncthreads();
  qkt<DQK, QL>(pA0, pA1, K_lds, qr, qlds, ka); partialSM(pA0, pA1, m_reg, mnA, alA, C, thr_raw);
  ATT_SLOAD(SO, KVBLK); if (SDEPTH == 2) { if (2 < NT) ATT_SLOAD(SE, 2 * KVBLK); }
  ATT_SWAIT(); ATT_SWRITE(1, SO); __syncthreads();
  for (int j = 1; j + 1 < NT; j += 2) {
    ATT_SBAR(); qkt<DQK, QL>(pB0, pB1, K_lds + SHM_K, qr, qlds, ka);
    finishSM(pA0, pA1, alA, l_reg, pa0, pa1, pa2, pa3); ATT_SBAR();
    ATT_SLOAD(SO, (j + SDEPTH) * KVBLK); ATT_SBAR();
    pv_d0(o, vb0, pa0, pa1, pa2, pa3); partialSM(pB0, pB1, m_reg, mnB, alB, C, thr_raw);
    __syncthreads(); ATT_SWAIT(); ATT_SWRITE(0, SE);
    ATT_RESC(alB); __syncthreads();
    ATT_SBAR(); qkt<DQK, QL>(pA0, pA1, K_lds, qr, qlds, ka);
    finishSM(pB0, pB1, alB, l_reg, pa0, pa1, pa2, pa3); ATT_SBAR();
    if (SDEPTH == 1 || j + 3 < NT) ATT_SLOAD(SE, (j + 1 + SDEPTH) * KVBLK); ATT_SBAR();
    pv_d0(o, vb0 + (int)SHM_V, pa0, pa1, pa2, pa3); partialSM(pA0, pA1, m_reg, mnA, alA, C, thr_raw);
    __syncthreads(); ATT_SWAIT(); ATT_SWRITE(1, SO);
    ATT_RESC(alA); __syncthreads();
  }
  ATT_SBAR(); qkt<DQK, QL>(pB0, pB1, K_lds + SHM_K, qr, qlds, ka);
  finishSM(pA0, pA1, alA, l_reg, pa0, pa1, pa2, pa3); ATT_SBAR();
  pv_d0(o, vb0, pa0, pa1, pa2, pa3); partialSM(pB0, pB1, m_reg, mnB, alB, C, thr_raw);
  __syncthreads(); ATT_RESC(alB);
  finishSM(pB0, pB1, alB, l_reg, pa0, pa1, pa2, pa3); ATT_SBAR();
  pv_d0(o, vb0 + (int)SHM_V, pa0, pa1, pa2, pa3);
  { const int t2 = ph_tid(), l2 = t2 & 63, w2 = t2 >> 6, r2 = l2 & 31, h2 = l2 >> 5;
    float* li2 = (float*)(lds + 2 * SHM_V + 2 * SHM_K) + w2 * 64;
    if (h2 == 0) li2[r2] = l_reg; asm volatile("s_waitcnt lgkmcnt(0)" ::: "memory");
    bf16_t* Ow = Ob + (w2 * QBLK) * LDO + r2;
#pragma unroll
    for (int r = 0; r < 16; ++r) { const int orow = crow(r, h2); const float rl = __builtin_amdgcn_rcpf(li2[orow]);
#pragma unroll
      for (int d0 = 0; d0 < 4; ++d0) Ow[orow * LDO + d0 * 32] = (bf16_t)(cvtpk(o[d0][r] * rl, 0.f) & 0xffffu); } }
  __syncthreads();
#undef ATT_SLOAD
#undef ATT_SWRITE
#undef ATT_SWAIT
#undef ATT_RESC
}

template <int DQK, int LDQ, int LDK, int LDV, int LDO>
__device__ __forceinline__ void attn_body_s1(const bf16_t* __restrict__ Qb, const bf16_t* __restrict__ Kh, const bf16_t* __restrict__ Vh, bf16_t* __restrict__ Ob, int seq, char* lds, const float scale) {
  constexpr int NKC = DQK / 64; constexpr size_t SHM_K = shm_k<DQK>();
  const float C = scale * 1.4426950408889634f, thr_raw = THR / scale;
  const int tid = ph_tid(), wid = tid >> 6, lane = tid & 63, r32 = lane & 31, hi = lane >> 5;
  char* V_lds = lds; char* K_lds = lds + 2 * SHM_V;
  float* wsf = (float*)(lds + 2 * SHM_V + 2 * SHM_K) + wid * 64; float* li_l = wsf; float* al_l = wsf + 32;
  float m_reg = -1e30f, l_reg = 0; f32x16 o[4] = {}; bf16x8 qr[DQK / 16];
  const bf16_t* Qw = Qb + (long)(wid * QBLK + r32) * LDQ + hi * 8;
#pragma unroll
  for (int d0 = 0; d0 < DQK / 16; ++d0) qr[d0] = *reinterpret_cast<const bf16x8*>(Qw + d0 * 16);
  const int sr = tid >> 4, sc = (tid & 15) * 8, vst0 = v_st(sr, sc), vst1 = v_st(32 + sr, sc);
  int kgo[NKC], klo[NKC];
#pragma unroll
  for (int i = 0; i < NKC; ++i) { const int c = tid + 512 * i, kr = c / (DQK / 8), kc = (c % (DQK / 8)) * 8; kgo[i] = kr * LDK + kc; klo[i] = kswz<DQK>(kr, kc * 2); }
  const int vgo = sr * LDV + sc;
  int ka[4];
#pragma unroll
  for (int q = 0; q < 4; ++q) ka[q] = r32 * (DQK * 2) + ((q * 32 + hi * 16) ^ ((r32 & 7) << 4));
  const __amdgpu_buffer_rsrc_t rK = __builtin_amdgcn_make_buffer_rsrc((void*)Kh, 0, 0x7ffffffc, 0x00020000), rV = __builtin_amdgcn_make_buffer_rsrc((void*)Vh, 0, 0x7ffffffc, 0x00020000);
  const int vb0 = (int)(uintptr_t)V_lds + v_rd_base(lane);
  bf16x8 vs0, vs1, ks[NKC];
#define ATT1_SLOAD(k0) do { const int _vo = (k0) * (LDV * 2), _ko = (k0) * (LDK * 2); vs0 = bl(rV, vgo * 2, _vo); vs1 = bl(rV, vgo * 2 + 64 * LDV, _vo); \
    _Pragma("unroll") for (int _c = 0; _c < NKC; ++_c) ks[_c] = bl(rK, kgo[_c] * 2, _ko); } while (0)
#define ATT1_SWRITE(b) do { *(bf16x8*)(V_lds + (b) * SHM_V + vst0) = vs0; *(bf16x8*)(V_lds + (b) * SHM_V + vst1) = vs1; \
    _Pragma("unroll") for (int _c = 0; _c < NKC; ++_c) *(bf16x8*)(K_lds + (b) * SHM_K + klo[_c]) = ks[_c]; } while (0)
  const int NT = seq / KVBLK;
  ATT1_SLOAD(0); asm volatile("s_waitcnt vmcnt(0)" ::: "memory"); ATT1_SWRITE(0);
  ATT1_SLOAD(KVBLK); asm volatile("s_waitcnt vmcnt(0)" ::: "memory"); ATT1_SWRITE(1); __syncthreads();
  for (int j = 0; j < NT; ++j) { const int b = j & 1;
    ATT_SBAR();
    f32x16 p0, p1; float mn, al; bf16x8 pa0, pa1, pa2, pa3;
    qkt<DQK, 0>(p0, p1, K_lds + b * SHM_K, qr, nullptr, ka);
    partialSM(p0, p1, m_reg, mn, al, C, thr_raw);
    if (__any(al < 1.f)) { if (hi == 0) al_l[r32] = al; asm volatile("s_waitcnt lgkmcnt(0)" ::: "memory");
#pragma unroll
      for (int d = 0; d < 4; ++d)
#pragma unroll
        for (int r = 0; r < 16; ++r) o[d][r] *= al_l[crow(r, hi)]; }
    finishSM(p0, p1, al, l_reg, pa0, pa1, pa2, pa3); ATT_SBAR();
    if (j + 2 < NT) ATT1_SLOAD((j + 2) * KVBLK);
    ATT_SBAR();
    pv_d0(o, vb0 + b * (int)SHM_V, pa0, pa1, pa2, pa3);
    __syncthreads();
    if (j + 2 < NT) { asm volatile("s_waitcnt vmcnt(0)" ::: "memory"); ATT1_SWRITE(b); } }
  { const int t2 = ph_tid(), l2 = t2 & 63, w2 = t2 >> 6, r2 = l2 & 31, h2 = l2 >> 5;
    float* li2 = (float*)(lds + 2 * SHM_V + 2 * SHM_K) + w2 * 64;
    if (h2 == 0) li2[r2] = l_reg; asm volatile("s_waitcnt lgkmcnt(0)" ::: "memory");
    bf16_t* Ow = Ob + (w2 * QBLK) * LDO + r2;
#pragma unroll
    for (int r = 0; r < 16; ++r) { const int orow = crow(r, h2); const float rl = __builtin_amdgcn_rcpf(li2[orow]);
#pragma unroll
      for (int d0 = 0; d0 < 4; ++d0) Ow[orow * LDO + d0 * 32] = (bf16_t)(cvtpk(o[d0][r] * rl, 0.f) & 0xffffu); } }
  __syncthreads();
#undef ATT1_SLOAD
#undef ATT1_SWRITE
}
template <int TYPE> __device__ __forceinline__ void attn_unit(const Params& p, int u, char* lds) {
  bf16_t* P = WSP(bf16_t, p, regA); bf16_t* OA = WSP(bf16_t, p, oall);
  int type, b, h, qb;
  if (u < 256) { const int x = u & 7, idx = u >> 3; type = idx >> 4; qb = idx & 15; b = x >> 2; h = x & 3; }
  else { const int v = u - 256; type = v >> 3; b = (v >> 2) & 1; h = v & 3; qb = SEQ / 256; }
  const long q0 = (long)b * NTOK + qb * 256, k0 = (long)b * NTOK + (qb == SEQ / 256 ? SEQ : 0); const int seq = (qb == SEQ / 256) ? CTXL : NTOK;
  if (TYPE == 0) attn_body<MQK, MH * MQK, MH * MQK, MH * MV, DM, 1, 0>(WSP(bf16_t, p, qm) + q0 * (MH * MQK) + h * MQK, WSP(bf16_t, p, km) + k0 * (MH * MQK) + h * MQK, WSP(bf16_t, p, vm) + k0 * (MH * MV) + h * MV,
                                                                 OA + q0 * DM + 3 * BW + h * MV, seq, lds, 0.07216878364870322f  );
  else attn_body<GHD, PW, PW, PW, DM, ATT_SD_GQA, 0>(P + q0 * PW + OFF_GQ + h * GHD, P + k0 * PW + OFF_GK + (h / (GH / GKV)) * GHD, P + k0 * PW + OFF_GV + (h / (GH / GKV)) * GHD,
                                      OA + q0 * DM + BW + h * GHD, seq, lds, 0.08838834764831845f  );
}
}
template <int TYPE> __global__ __launch_bounds__(512, 2) void k_attn(Params p, int l) {
  extern __shared__ __attribute__((aligned(16))) unsigned char shm[];
  const int nu = 256 + (l == 0 ? 16 : 0);
  for (int u = blockIdx.x; u < nu; u += gridDim.x) { const int type = u < 256 ? ((u >> 3) >> 4) : ((u - 256) >> 3); if (type == TYPE) att::attn_unit<TYPE>(p, u, (char*)shm); }
}
#endif
#ifndef CPU_TEST
namespace ret {
using pg8::f32x4; using pg8::u32x4; using pg8::bf16x8;
static_assert(RCH == 128 && RQK == 64 && RV == 128, "retention tiles are written for chunk 128, qk 64, v 128");
constexpr int PT_ = 272, PS = 528, PQ = 144;
constexpr int LDS_A = 2 * 128 * PT_, LDS_C = 128 * PQ + 2 * 128 * PS + 2 * 132 * 4;
template <int NB, int KS> __device__ __forceinline__ void mma16(f32x4 (&acc)[NB], const LAS char* A, int lda, const LAS char* Bt, int ldb) {
  const int lane = ph_tid() & 63, r = lane & 15, kq = lane >> 4;
#pragma unroll
  for (int s = 0; s < KS; ++s) { const bf16x8 a = *(const LAS bf16x8*)(A + r * lda + (s * 32 + kq * 8) * 2);
#pragma unroll
    for (int nb = 0; nb < NB; ++nb) { const bf16x8 bfr = *(const LAS bf16x8*)(Bt + (nb * 16 + r) * ldb + (s * 32 + kq * 8) * 2); acc[nb] = __builtin_amdgcn_mfma_f32_16x16x32_bf16(a, bfr, acc[nb], 0, 0, 0); } }
}
__device__ __forceinline__ long chunk_row0(int b, int cs) { return (long)b * NTOK + (cs < SEQ / RCH ? cs * RCH : SEQ + (cs - SEQ / RCH) * RCH); }
__device__ __forceinline__ void st16(LAS char* p, unsigned v) { *(LAS unsigned short*)p = (unsigned short)v; }
template <int NC, bool WEIGHT, int PT> __device__ __forceinline__ void stage_T(LAS char* T, LAS char* T2, const bf16_t* src, int ld, float lg1, float lg2) {
  const int tidq = ph_tid();
#pragma unroll
  for (int i = 0; i < NC / 4; ++i) { const int id = tidq + 512 * i, key = id & 127, c = id >> 7; const u32x4 w = *(const u32x4*)(src + (long)key * ld + 8 * c);
    if (!WEIGHT) {
      st16(T + (8 * c + 0) * PT + key * 2, w.x); st16(T + (8 * c + 1) * PT + key * 2, w.x >> 16); st16(T + (8 * c + 2) * PT + key * 2, w.y); st16(T + (8 * c + 3) * PT + key * 2, w.y >> 16);
      st16(T + (8 * c + 4) * PT + key * 2, w.z); st16(T + (8 * c + 5) * PT + key * 2, w.z >> 16); st16(T + (8 * c + 6) * PT + key * 2, w.w); st16(T + (8 * c + 7) * PT + key * 2, w.w >> 16);
    } else { f32x4 a, b2; pg8::unpack8(w, a, b2); const float w1 = __expf(lg1 * (float)(RCH - 1 - key)), w2 = __expf(lg2 * (float)key);
#pragma unroll
      for (int j = 0; j < 4; ++j) { st16(T + (8 * c + j) * PT + key * 2, pg8::cvt_pk_bf16(a[j] * w1, 0.f)); st16(T + (8 * c + 4 + j) * PT + key * 2, pg8::cvt_pk_bf16(b2[j] * w1, 0.f));
        st16(T2 + (8 * c + j) * PT + key * 2, pg8::cvt_pk_bf16(a[j] * w2, 0.f)); st16(T2 + (8 * c + 4 + j) * PT + key * 2, pg8::cvt_pk_bf16(b2[j] * w2, 0.f)); } } }
}
__device__ __forceinline__ void ret_a_unit(const Params& p, int l, int u, LAS char* lds) {
  const int cs = u % RNC, h = (u / RNC) % RH, b = u / (RNC * RH), tidu = ph_tid(), wv = tidu >> 6, lane = tidu & 63;
  const float lgf = -__expf(p.in[I_RDF][l * RH + h]), lgb = -__expf(p.in[I_RDB][l * RH + h]);
  const bf16_t* P = WSP(bf16_t, p, regA) + chunk_row0(b, cs) * PW; LAS char* VT = lds; LAS char* KT = lds + 128 * PT_;
  stage_T<16, false, PT_>(VT, nullptr, P + OFF_RV + h * RV, PW, 0.f, 0.f);
  stage_T<8, true, PT_>(KT, KT + 64 * PT_, P + OFF_RK + h * RQK, PW, lgf, lgb);
  __syncthreads();
  f32x4 acc[8];
#pragma unroll
  for (int nb = 0; nb < 8; ++nb) acc[nb] = (f32x4){0.f, 0.f, 0.f, 0.f};
  mma16<8, 4>(acc, VT + wv * 16 * PT_, PT_, KT, PT_);
  float* RKV = WSP(float, p, rkv);
#pragma unroll
  for (int nb = 0; nb < 8; ++nb) { const int col = nb * 16 + (lane & 15), dir = col >> 6, dk = col & 63; float* o = RKV + ((((long)(b * RH + h) * 2 + dir) * RNC + cs) * RV + wv * 16 + (lane >> 4) * 4) * RQK + dk;
#pragma unroll
    for (int r = 0; r < 4; ++r) o[r * RQK] = acc[nb][r]; }
  __syncthreads();
}
__device__ __forceinline__ void ph_ret_scan(const Params& p, int l) {
  const float* RKV = WSP(float, p, rkv); bf16_t* RS = WSP(bf16_t, p, rs); constexpr int NL = SEQ / RCH, NCX = CTXL / RCH;
  for (long i = (long)blockIdx.x * 512 + ph_tid(); i < (long)NB * RH * 2 * RV * RQK; i += (long)gridDim.x * 512) { const int e = (int)(i % (RV * RQK)), dir = (int)((i / (RV * RQK)) % 2), h = (int)((i / (2 * RV * RQK)) % RH), b = (int)(i / (2 * RV * RQK * RH));
    const float lg = -__expf(p.in[dir ? I_RDB : I_RDF][l * RH + h]), dec = __expf(lg * (float)RCH); const long base = (((long)(b * RH + h) * 2 + dir) * RNC) * (RV * RQK) + e; float S = 0.f;
    for (int s0 = 0; s0 < RNC; s0 += 17) { float kv[17]; int cs_[17];
#pragma unroll
      for (int q = 0; q < 17; ++q) { const int s = s0 + q; cs_[q] = dir == 0 ? (s < NCX ? NL + s : s - NCX) : (RNC - 1 - s); kv[q] = RKV[base + (long)cs_[q] * (RV * RQK)]; }
#pragma unroll
      for (int q = 0; q < 17; ++q) { RS[base + (long)cs_[q] * (RV * RQK)] = (bf16_t)(pg8::cvt_pk_bf16(S, 0.f) & 0xffffu); S = dec * S + kv[q]; } } }
}
__device__ __forceinline__ void ret_c_unit(const Params& p, int l, int u, LAS char* lds) {
  const int ncs = (l == NLAYER - 1) ? SEQ / RCH : RNC; const int cs = u % ncs, h = (u / ncs) % RH, b = u / (ncs * RH), tid = ph_tid(), wv = tid >> 6, lane = tid & 63;
  const float lgf = -__expf(p.in[I_RDF][l * RH + h]), lgb = -__expf(p.in[I_RDB][l * RH + h]); const long R0 = chunk_row0(b, cs);
  const bf16_t* P = WSP(bf16_t, p, regA) + R0 * PW; LAS char* Ks = lds; LAS char* Ss = lds + 128 * PQ; LAS char* B2 = Ss + 128 * PS; LAS float* gf = (LAS float*)(B2 + 128 * PS); LAS float* gb = gf + 132;
  if (tid < 129) { gf[tid] = __expf(lgf * (float)tid); gb[tid] = __expf(lgb * (float)tid); }
#pragma unroll
  for (int i = 0; i < 2; ++i) { const int id = tid + 512 * i, row = id >> 3, c = id & 7; *(LAS u32x4*)(Ks + row * PQ + c * 16) = *(const u32x4*)(P + (long)row * PW + OFF_RK + h * RQK + 8 * c);
    *(LAS u32x4*)(Ss + row * PS + 256 + c * 16) = *(const u32x4*)(P + (long)row * PW + OFF_RQ + h * RQK + 8 * c); }
  stage_T<16, false, PS>(B2, nullptr, P + OFF_RV + h * RV, PW, 0.f, 0.f);
  { const bf16_t* RS = WSP(bf16_t, p, rs);
#pragma unroll
    for (int i = 0; i < 4; ++i) { const int id = tid + 512 * i, dir = id >> 10, dv = (id >> 3) & 127, c = id & 7;
      *(LAS u32x4*)(B2 + dv * PS + 256 + dir * 128 + c * 16) = *(const u32x4*)(RS + ((((long)(b * RH + h) * 2 + dir) * RNC + cs) * RV + dv) * RQK + 8 * c); } }
  __syncthreads();
  LAS char* myS = Ss + wv * 16 * PS;
  { f32x4 acc[8];
#pragma unroll
    for (int nb = 0; nb < 8; ++nb) acc[nb] = (f32x4){0.f, 0.f, 0.f, 0.f};
    mma16<8, 2>(acc, myS + 256, PS, Ks, PQ);
#pragma unroll
    for (int nb = 0; nb < 8; ++nb) { const int a2 = nb * 16 + (lane & 15);
#pragma unroll
      for (int r = 0; r < 4; ++r) { const int ar = (lane >> 4) * 4 + r, a = wv * 16 + ar; const float f = a2 <= a ? gf[a - a2] : gb[a2 - a]; st16(myS + ar * PS + a2 * 2, pg8::cvt_pk_bf16(acc[nb][r] * f, 0.f)); } } }
#pragma unroll
  for (int i = 0; i < 2; ++i) { const int id = lane + 64 * i, ar = id >> 3, c = id & 7, a = wv * 16 + ar; LAS char* q = myS + ar * PS + 256 + c * 16; f32x4 x0, x1; pg8::unpack8(*(const LAS u32x4*)q, x0, x1);
    const float sf = gf[a + 1], sb = gb[RCH - a]; *(LAS u32x4*)(q + 128) = pg8::pack8(x0 * sb, x1 * sb); *(LAS u32x4*)q = pg8::pack8(x0 * sf, x1 * sf); }
  asm volatile("s_waitcnt lgkmcnt(0)" ::: "memory");
  f32x4 o[8];
#pragma unroll
  for (int nb = 0; nb < 8; ++nb) o[nb] = (f32x4){0.f, 0.f, 0.f, 0.f};
  mma16<8, 8>(o, myS, PS, B2, PS);
#pragma unroll
  for (int r = 0; r < 4; ++r) { float s = 0.f;
#pragma unroll
    for (int nb = 0; nb < 8; ++nb) s += o[nb][r];
    s += __shfl_xor(s, 8); s += __shfl_xor(s, 4); s += __shfl_xor(s, 2); s += __shfl_xor(s, 1); const float mean = s * (1.f / RV); float q = 0.f;
#pragma unroll
    for (int nb = 0; nb < 8; ++nb) { const float d = o[nb][r] - mean; q += d * d; }
    q += __shfl_xor(q, 8); q += __shfl_xor(q, 4); q += __shfl_xor(q, 2); q += __shfl_xor(q, 1); const float rs = 1.f / sqrtf(q * (1.f / RV) + NORM_EPS);
    const int ar = (lane >> 4) * 4 + r;
#pragma unroll
    for (int nb = 0; nb < 8; ++nb) *(LAS float*)(myS + ar * PS + (nb * 16 + (lane & 15)) * 4) = (o[nb][r] - mean) * rs; }
  asm volatile("s_waitcnt lgkmcnt(0)" ::: "memory");
  { const float* gain = p.in[I_RNORM] + l * BW + h * RV; bf16_t* OA = WSP(bf16_t, p, oall); const int ar = lane >> 2, c4 = lane & 3; const long R = R0 + wv * 16 + ar;
    u32x4 gt[4];
#pragma unroll
    for (int it = 0; it < 4; ++it) gt[it] = *(const u32x4*)(P + (long)(wv * 16 + ar) * PW + OFF_RG + h * RV + (c4 + 4 * it) * 8);
#pragma unroll
    for (int it = 0; it < 4; ++it) { const int dv = (c4 + 4 * it) * 8; const LAS float* q = (const LAS float*)(myS + ar * PS + dv * 4); f32x4 x0 = *(const LAS f32x4*)q, x1 = *(const LAS f32x4*)(q + 4), g0, g1; pg8::unpack8(gt[it], g0, g1);
      x0 = x0 * *(const f32x4*)(gain + dv) * g0 * pg8::sigmoid4(g0); x1 = x1 * *(const f32x4*)(gain + dv + 4) * g1 * pg8::sigmoid4(g1);
      *(u32x4*)(OA + R * DM + 2 * BW + h * RV + dv) = pg8::pack8(x0, x1); } }
  __syncthreads();
}
}
template <int WHICH> __global__ __launch_bounds__(512, 2) void k_ret(Params p, int l) {
  extern __shared__ __attribute__((aligned(16))) unsigned char shm[]; LAS char* lds = (LAS char*)shm;
  if (WHICH == 0) for (int u = blockIdx.x; u < NB * RH * RNC; u += gridDim.x) ret::ret_a_unit(p, l, u, lds);
  if (WHICH == 1) ret::ph_ret_scan(p, l);
  if (WHICH == 2) { const int nu = NB * RH * ((l == NLAYER - 1) ? SEQ / RCH : RNC); for (int u = blockIdx.x; u < nu; u += gridDim.x) ret::ret_c_unit(p, l, u, lds); }
}
#endif
#ifndef CPU_TEST
#define XB_TMO      128
#define XB_XCNT(j)  (256  + 64 * (j))
#define XB_XSUB(j)  (1280 + 64 * (j))
#define XB_XGEN(j)  (2304 + 64 * (j))
#define XB_TOP      3328
#define XB_TOPGEN   3392
#define XCD_BAR_WORDS 3456
#define XB_SPIN_CAP (1u << 18)

__device__ __forceinline__ unsigned xb_ld(unsigned* p)              { return __hip_atomic_load(p, __ATOMIC_RELAXED, __HIP_MEMORY_SCOPE_AGENT); }
__device__ __forceinline__ unsigned xb_add(unsigned* p, unsigned v) { return __hip_atomic_fetch_add(p, v, __ATOMIC_RELAXED, __HIP_MEMORY_SCOPE_AGENT); }
__device__ __forceinline__ unsigned xb_xcc_id() { return (unsigned)__builtin_amdgcn_s_getreg((3 << 11) | 20) & 0xFu; }
#define XB_SPIN(cond, bar) do { unsigned _sp = 0; while (cond) { __builtin_amdgcn_s_sleep(1); \
    if ((++_sp & 255u) == 0u) { if (xb_ld(&(bar)[XB_TMO])) break; if (_sp > XB_SPIN_CAP) { atomicAdd(&(bar)[XB_TMO], 1u); break; } } } } while (0)

struct XcdBarrier {
    unsigned* bar; unsigned x;
    volatile LAS unsigned* st;
};

__device__ __forceinline__ XcdBarrier xcd_barrier_post(unsigned* bar, volatile LAS unsigned* st) {
    XcdBarrier b; b.bar = bar; b.x = xb_xcc_id(); b.st = st;
    if (threadIdx.x == 0) (void)xb_add(&bar[XB_XCNT(b.x)], 1u);
    return b;
}
__device__ __forceinline__ void xcd_barrier_complete(unsigned* bar, unsigned x, unsigned& nloc, unsigned& nx) {
    const unsigned G = gridDim.x * gridDim.y * gridDim.z;
    unsigned sum, cnt, mine, sp = 0u;
    for (;;) {
        sum = 0u; cnt = 0u; mine = 0u;
#pragma unroll
        for (unsigned j = 0; j < 16; ++j) { const unsigned c = xb_ld(&bar[XB_XCNT(j)]); sum += c; cnt += (c > 0u) ? 1u : 0u; mine = (j == x) ? c : mine; }
        if (sum == G) break;
        __builtin_amdgcn_s_sleep(1);
        if ((++sp & 255u) == 0u) { if (xb_ld(&bar[XB_TMO])) break; if (sp > XB_SPIN_CAP) { atomicAdd(&bar[XB_TMO], 1u); break; } }
    }
    nloc = mine > 0u ? mine : 1u; nx = cnt > 0u ? cnt : 1u;
}

__device__ __forceinline__ void xcd_barrier(const XcdBarrier& b) {
    asm volatile("s_waitcnt vmcnt(0)" ::: "memory");
    __syncthreads();
    if (threadIdx.x == 0) {
        unsigned* bar = b.bar;
        __builtin_amdgcn_s_waitcnt(0);
        unsigned nloc = b.st[0], nx = b.st[1];
        if (nloc == 0u) { xcd_barrier_complete(bar, b.x, nloc, nx); b.st[0] = nloc; b.st[1] = nx; }
        const unsigned old = xb_add(&bar[XB_XSUB(b.x)], 1u);
        const unsigned gen = old / nloc;
        if (old + 1u == (gen + 1u) * nloc) {
            __builtin_amdgcn_fence(__ATOMIC_RELEASE, "agent");
            asm volatile("s_waitcnt vmcnt(0)" ::: "memory");
            const unsigned og = xb_add(&bar[XB_TOP], 1u);
            const unsigned tg = og / nx;
            if (og + 1u == (tg + 1u) * nx) xb_add(&bar[XB_TOPGEN], 1u);
            else XB_SPIN(xb_ld(&bar[XB_TOPGEN]) == tg, bar);
            __builtin_amdgcn_fence(__ATOMIC_ACQUIRE, "agent");
            xb_add(&bar[XB_XGEN(b.x)], 1u);
            asm volatile("s_waitcnt vmcnt(0)" ::: "memory");
        } else {
            XB_SPIN(xb_ld(&bar[XB_XGEN(b.x)]) == gen, bar);
            __builtin_amdgcn_fence(__ATOMIC_ACQUIRE, "agent");
            asm volatile("s_waitcnt vmcnt(0)" ::: "memory");
        }
    }
    __syncthreads();
}

#endif
#ifndef CPU_TEST
#include <type_traits>
constexpr int MEGA_LDS = ((ret::LDS_C > pg8::STAGE_BYTES ? ret::LDS_C : pg8::STAGE_BYTES) + 255) / 256 * 256 + 256;
typedef const __attribute__((address_space(4))) Params* KParamsPtr;
__device__ __forceinline__ Params kparams() {
#if defined(__HIP_DEVICE_COMPILE__)
  KParamsPtr k = (KParamsPtr)__builtin_amdgcn_kernarg_segment_ptr(); asm volatile("" : "+s"(k)); Params r; __builtin_memcpy(&r, k, sizeof(Params)); return r;
#else
  return Params{};
#endif
}
__device__ __forceinline__ int rotc(int off) { const int G = gridDim.x; return (int)((ph_bid() + G - (off % G)) % G); }

#ifndef MK_XCD_UP
#define MK_XCD_UP 1
#endif
#ifndef MK_XCD_DN
#define MK_XCD_DN 1
#endif
#ifndef MK_DBL
#define MK_DBL 0
#endif
#define REPS(id) ((MK_DBL) == (id) ? 2 : 1)
#ifndef MK_WAITMASK
#define MK_WAITMASK 0xffffffffffffffffull
#endif
#define CONVQ_COUNTER ((unsigned*)(p.ws + WS.bar) + XCD_BAR_WORDS)
#define CONVQ_ARRIVED(k) ((unsigned*)(p.ws + WS.bar) + XCD_BAR_WORDS + 64 * (1 + (k)))
#ifndef MK_BGCONV
#define MK_BGCONV 1
#endif
#define BG_IDLE() do { if (MK_BGCONV && convq_alive) { if (threadIdx.x == 0) __hip_atomic_fetch_add(CONVQ_ARRIVED(bar_idx), 1u, __ATOMIC_RELAXED, __HIP_MEMORY_SCOPE_AGENT); \
    __syncthreads(); convq_alive = ph::conv_work<ph::CLAIM_IDLE>(p, lds, CONVQ_COUNTER, 0, CONVQ_ARRIVED(bar_idx)); } ++bar_idx; } while (0)
#ifdef MK_WAITPROBE
#define BARX() do { const unsigned long long t0_ = wall_clock64(); xcd_barrier(bar); if ((MK_WAITMASK >> bidx_) & 1ull) wait_acc += wall_clock64() - t0_; ++bidx_; if (blockIdx.x == (MK_WAITPROBE) && threadIdx.x == 0) ((unsigned long long*)(p.ws + WS.bar + 30720))[40] = wait_acc; } while (0)
#else
#define BARX() do { BG_IDLE(); xcd_barrier(bar); if ((MK_DBL) == 99) xcd_barrier(bar); } while (0)
#endif
#ifdef MK_PROBE_A
#define STAMP(k) do { if (blockIdx.x == 0 && threadIdx.x == 0) ((unsigned long long*)(p.ws + WS.bar + 30720))[k] = wall_clock64(); } while (0)
#else
#define STAMP(k) do { } while (0)
#endif
__global__ __launch_bounds__(512, 2) void mega(Params p_unused_) {
#define p (kparams())
  extern __shared__ __attribute__((aligned(16))) unsigned char shm[];
  LAS unsigned char* lds = (LAS unsigned char*)shm; char* ldsg = (char*)shm;
  LAS unsigned* xbw = (LAS unsigned*)(lds + MEGA_LDS - 16);
  if (threadIdx.x < 4) xbw[threadIdx.x] = 0u;
  __syncthreads();
  XcdBarrier bar = xcd_barrier_post((unsigned*)(p.ws + WS.bar), (volatile LAS unsigned*)xbw);
  STAMP(0);
  bool convq_alive = true; int bar_idx = 0;
#ifdef MK_WAITPROBE
  unsigned long long wait_acc = 0ull; int bidx_ = 0;
#endif
  using namespace pg8;
  const int G = gridDim.x;
#define P WSP(bf16_t, p, regA)
#define PROJ ((bf16_t*)(p.ws + WS.regA + SZ_P))
#define H1 WSP(bf16_t, p, h1)
#define QM WSP(bf16_t, p, qm)
#define KM WSP(bf16_t, p, km)
#define VM WSP(bf16_t, p, vm)
#define Z WSP(bf16_t, p, z)
#define OA WSP(bf16_t, p, oall)
#define XS WSP(bf16_t, p, regA)
#define ACT ((bf16_t*)(p.ws + WS.regA + SZ_XS))
#define YS ((bf16_t*)(p.ws + WS.regA + SZ_XS + SZ_ACT))
  constexpr int nMfull = MROWS / 256;

#ifdef MK_NANFILL
  {
    u32x4* q = (u32x4*)(p.ws + WS.x1); const long n1 = (long)(WS.s5sw - WS.x1) / 16; const u32x4 nanv = {0x7FC07FC0u, 0x7FC07FC0u, 0x7FC07FC0u, 0x7FC07FC0u};
    for (long i = (long)blockIdx.x * 512 + threadIdx.x; i < n1; i += (long)gridDim.x * 512) q[i] = nanv;
    u32x4* q2 = (u32x4*)(p.ws + WS.rkv); const long n2 = (long)(WS.end - WS.rkv) / 16;
    for (long i = (long)blockIdx.x * 512 + threadIdx.x; i < n2; i += (long)gridDim.x * 512) q2[i] = nanv; }
#endif
_Pragma("unroll") for (int rep_ = 0; rep_ < REPS(11); ++rep_) {
  ph::ph_s5tables(p, lds);
  ph::ph_tables(p);
  ph::ph_mod(p, lds, rotc(64));
    }
_Pragma("unroll") for (int rep_ = 0; rep_ < REPS(1); ++rep_) {
  ph::conv_work<ph::CLAIM_DRAIN>(p, lds, CONVQ_COUNTER, ph::CT_DENSE_L, nullptr);
    }
  BARX();
  STAMP(1);
_Pragma("unroll") for (int rep_ = 0; rep_ < REPS(19); ++rep_) {
  ph::ph_ln_in(p, 0);
    }
  BARX();
  STAMP(2);

  auto layer = [&](auto LC) __attribute__((always_inline)) { constexpr int l = decltype(LC)::value; constexpr int last = (l == NLAYER - 1), nMlat = last ? nMfull - 2 : nMfull;
_Pragma("unroll") for (int rep_ = 0; rep_ < REPS(2); ++rep_) {
    { SchedGrid S{(const char*)H1, (const char*)(WSP(bf16_t, p, wt_in) + (long)l * PW * DM), DM, DM, nMfull, PW / 256 - 1, 0, G, ph_bid(), 0};
      gemm_phase(lds, GemmG{DM, DM, DM, 0}, S, EpiBf16{P, PW, 0}); }
    }
    BARX();
    STAMP(2 + 15 * l + 1);
    ph::ph_post_proj(p, l);
    BARX();
    STAMP(2 + 15 * l + 2);
_Pragma("unroll") for (int rep_ = 0; rep_ < REPS(12); ++rep_) {
    { constexpr int NKR = MROWS / 256;
      const int vw = ph_bid() - NKR, G2 = G - NKR;
      if (vw < 0) { SchedKR S{(const char*)H1, (const char*)(WSP(bf16_t, p, wt_in) + (long)l * PW * DM), G, ph_bid()};
        gemm_phase<false, PG8_SP2>(lds, GemmG{DM, DM, DM, 0}, S, EpiKR{KM, WSP(float, p, rope_b)}); }
      else {
        { SchedGrid S{(const char*)(P + OFF_CQ), (const char*)(WSP(bf16_t, p, wt_uq) + (long)l * MH * MQK * MQL), PW, MQL, nMfull, MH * MQK / 256, 0, G2, vw, 0};
          gemm_phase<false, PG8_SP2>(lds, GemmG{PW, MQL, MQL, 0}, S, EpiQM{QM, WSP(float, p, rope_b)}); }
        { SchedGrid S{(const char*)(P + OFF_CKV), (const char*)(WSP(bf16_t, p, wt_ukv) + (long)l * MH * (MNOPE + MV) * MKVL), PW, MKVL, nMfull, MH, 0, G2, (vw + G2 - 102) % G2, 0};
          gemm_phase<false, PG8_SP2>(lds, GemmG{PW, MKVL, MKVL, 0}, S, EpiKVm{KM, VM}); }
        { SchedS5 S{(const char*)WSP(bf16_t, p, uh), (const char*)(WSP(bf16_t, p, s5sw) + (long)l * S5G * S5K2 * S5K1), (size_t)S5K2 * S5K1 * 2, G2, (vw + G2 - (238 % G2)) % G2};
          gemm_phase<false, PG8_SP2>(lds, GemmG{S5K1 + S5K2, S5K1, S5K1, 0}, S, EpiS5E{WSP(float, p, s5e)}); }
        for (int u = (vw + G2 - ((238 + 96) % G2)) % G2; u < NB * RH * RNC; u += G2) ret::ret_a_unit(p, l, u, (LAS char*)lds); } }
    }
    BARX();
    STAMP(2 + 15 * l + 3);
_Pragma("unroll") for (int rep_ = 0; rep_ < REPS(13); ++rep_) {
    ph::ph_s5scan(p, l);
    ret::ph_ret_scan(p, l);
    }
    BARX();
    STAMP(2 + 15 * l + 4);
_Pragma("unroll") for (int rep_ = 0; rep_ < REPS(4); ++rep_) {
_Pragma("unroll") for (int rq_ = 0; rq_ < REPS(21); ++rq_) {
    { const int w = ph_bid();
      if (w < 128) att::attn_unit<0>(p, w, ldsg); else if (w < 256) att::attn_unit<1>(p, w, ldsg);
      if (!last) { if (w >= 224 && w < 232) att::attn_unit<0>(p, 256 + (w - 224), ldsg); else if (w >= 240 && w < 248) att::attn_unit<1>(p, 256 + 8 + (w - 240), ldsg); } }
    }
_Pragma("unroll") for (int rq_ = 0; rq_ < REPS(22); ++rq_) {
    { SchedS5 S{(const char*)WSP(bf16_t, p, uh), (const char*)(WSP(bf16_t, p, s5sv) + (long)l * S5G * S5K1 * (S5K1 + S5K2)), (size_t)S5K1 * (S5K1 + S5K2) * 2, 96, ph_bid() - 128};
      if (ph_bid() >= 128 && ph_bid() < 224) gemm_phase<false, PG8_SP2>(lds, GemmG{S5K1 + S5K2, S5K1 + S5K2, S5K1 + S5K2, 0}, S, EpiS5Y{P, p.in[I_S5D] + (long)l * BW, Z, last, 0}); }
    }
_Pragma("unroll") for (int rq_ = 0; rq_ < REPS(23); ++rq_) {
    { const int nu = NB * RH * (last ? SEQ / RCH : RNC), w = ph_bid();
      if (w >= 128) for (int u = w - 128; u < nu; u += 128) ret::ret_c_unit(p, l, u, (LAS char*)lds); }
    }
    }
    BARX();
    STAMP(2 + 15 * l + 5);
_Pragma("unroll") for (int rep_ = 0; rep_ < REPS(14); ++rep_) {
    { SchedGrid S{(const char*)Z, (const char*)(WSP(bf16_t, p, wt_glu) + (long)l * BW * BW), BW, BW, nMlat, BW / 256, last, G, ph_bid(), 0};
      gemm_phase<false, PG8_SP2>(lds, GemmG{BW, BW, BW, 0}, S, EpiGluO{Z, OA}); }
    }
    BARX();
    STAMP(2 + 15 * l + 6);
_Pragma("unroll") for (int rep_ = 0; rep_ < REPS(6); ++rep_) {
    if (!last) { SchedGateCtx S{(const char*)H1, (const char*)(WSP(bf16_t, p, wt_gate) + (long)l * 4 * DM * DM), G, ph_bid()};
      gemm_phase(lds, GemmG{DM, DM, DM, 0}, S, EpiGateCtx{p.in[I_BGATE] + (long)l * 4 * DM, WSP(bf16_t, p, gctx)}); }
    { SchedProjW S{(const char*)OA, (const char*)(WSP(bf16_t, p, wt_br) + (long)l * 4 * DM * BW), nMlat, last, G, ph_bid(), last ? 0 : 64, 2, last ? 4 : 5, 0};
      gemm_phase(lds, GemmG{DM, BW, BW, 0}, S, EpiBf16{PROJ, 4 * DM, 0}); }
    }
    BARX();
    STAMP(2 + 15 * l + 7);
_Pragma("unroll") for (int rep_ = 0; rep_ < REPS(7); ++rep_) {
    if (!last) ph::ph_merge_ctx(p);
    { SchedGate4 S{(const char*)H1, (const char*)(WSP(bf16_t, p, wt_gate) + (long)l * 4 * DM * DM), G, ph_bid()};
      gemm_phase(lds, GemmG{DM, DM, DM, 1}, S, EpiGate4{p.in[I_BGATE] + (long)l * 4 * DM, PROJ, WSP(bf16_t, p, merged)}); }
    }
    BARX();
    STAMP(2 + 15 * l + 8);
_Pragma("unroll") for (int rep_ = 0; rep_ < REPS(8); ++rep_) {
    { SchedGrid S{(const char*)WSP(bf16_t, p, merged), (const char*)(WSP(bf16_t, p, wt_out) + (long)l * DM * DM), DM, DM, nMlat, DM / 256, last, G, ph_bid(), 0};
      gemm_phase(lds, GemmG{DM, DM, DM, 0}, S, EpiBf16{WSP(bf16_t, p, macc), DM, 0}); }
    }
    BARX();
    STAMP(2 + 15 * l + 9);
_Pragma("unroll") for (int rep_ = 0; rep_ < REPS(15); ++rep_) {
    ph::ph_ln1(p, l, lds);
    }
    BARX();
    STAMP(2 + 15 * l + 10);
_Pragma("unroll") for (int rep_ = 0; rep_ < REPS(16); ++rep_) {
    ph::ph_topk(p, l, lds);
#ifdef MK_QPROBE
    if (l == 0 && blockIdx.x == 0 && threadIdx.x == 0) ((unsigned long long*)(p.ws + WS.bar + 30720))[41] = __hip_atomic_load(CONVQ_COUNTER, __ATOMIC_RELAXED, __HIP_MEMORY_SCOPE_AGENT);
#endif
    if (convq_alive) convq_alive = ph::conv_work<ph::CLAIM_DRAIN>(p, lds, CONVQ_COUNTER, (l + 1) * ph::CT_LAYER, nullptr);
    }
    BARX();
    STAMP(2 + 15 * l + 11);
    const int nMl = last ? (2 * CAP_L) / 256 : XEP / 256;
_Pragma("unroll") for (int rep_ = 0; rep_ < REPS(9); ++rep_) {
    { SchedMoe S{(const char*)XS, (const char*)(WSP(bf16_t, p, wt_gu) + (long)l * NE * 2 * FF * DM), DM, DM, nMl, 2 * FF / 256, (size_t)2 * FF * DM * 2, G, ph_bid(), MK_XCD_UP, 0};
      gemm_phase_gather(lds, GemmG{DM, DM, DM, 0}, S, EpiSwiGlu{ACT}, (const char*)WSP(bf16_t, p, h2), (const int*)WSP(int, p, xsrc), (unsigned)(WS.zrow - WS.h2)); }
    }
    BARX();
    STAMP(2 + 15 * l + 13);
_Pragma("unroll") for (int rep_ = 0; rep_ < REPS(10); ++rep_) {
    { SchedMoe S{(const char*)ACT, (const char*)(WSP(bf16_t, p, wt_dn) + (long)l * NE * DM * FF), FF, FF, nMl, DM / 256, (size_t)DM * FF * 2, G, ph_bid(), MK_XCD_DN, 0};
      gemm_phase(lds, GemmG{FF, FF, FF, 0}, S, EpiBf16{YS, DM, 0}); }
    }
    BARX();
    STAMP(2 + 15 * l + 14);
_Pragma("unroll") for (int rep_ = 0; rep_ < REPS(18); ++rep_) {
    ph::ph_ln2(p, l);
    if (!last && convq_alive) convq_alive = ph::conv_work<ph::CLAIM_DRAIN>(p, lds, CONVQ_COUNTER, (l + 1) * ph::CT_LAYER + ph::CT_DENSE_L, nullptr);
    }
    if (!last) BARX();
    if (!last) STAMP(2 + 15 * l + 15);
  };
  layer(std::integral_constant<int, 0>{});
  layer(std::integral_constant<int, 1>{});
#undef p
#undef P
#undef PROJ
#undef H1
#undef QM
#undef KM
#undef VM
#undef Z
#undef OA
#undef XS
#undef ACT
#undef YS
}

extern "C" void kernel_launch(void* const* d_in, const int* in_sizes, int n_in, void* d_out, int out_size, void* d_ws, size_t ws_size, hipStream_t stream) {
  if (n_in != N_IN || ws_size < WS.end || out_size != NB * SEQ * DM) { fprintf(stderr, "kernel_launch: unexpected sizes n_in %d ws %zu (need %zu) out %d\n", n_in, ws_size, WS.end, out_size); return; }
  static int grid = 0;
  if (!grid) { int dev = 0, cus = 0, per_cu = 0; (void)hipGetDevice(&dev); (void)hipDeviceGetAttribute(&cus, hipDeviceAttributeMultiprocessorCount, dev);
    (void)hipFuncSetAttribute((const void*)mega, hipFuncAttributeMaxDynamicSharedMemorySize, MEGA_LDS);
    (void)hipOccupancyMaxActiveBlocksPerMultiprocessor(&per_cu, (const void*)mega, 512, MEGA_LDS);
    if (per_cu < 1) { fprintf(stderr, "kernel_launch: occupancy query says %d blocks per CU\n", per_cu); return; }
    grid = cus > 256 ? 256 : cus; }
  Params p; memset(&p, 0, sizeof(p));
  for (int i = 0; i < N_IN; ++i) p.in[i] = (const float*)d_in[i];
  p.out = (float*)d_out; p.ws = (char*)d_ws;
  (void)hipMemsetAsync((char*)d_ws + WS.bar, 0, (XCD_BAR_WORDS + 64 * 40) * sizeof(unsigned), stream);
  hipLaunchKernelGGL(mega, dim3(grid), dim3(512), MEGA_LDS, stream, p);
}
#endif
```

```cpp
#ifdef CPU_TEST
#include <cmath>
#include <cstdio>
#include <cstdlib>
#include <cstring>
#include <cstdint>
#include <functional>
#define __global__
#define __device__
#define __host__
#define __forceinline__ inline
#define __launch_bounds__(...)
#define __restrict__
struct dim3s { int x, y, z; };
static thread_local dim3s blockIdx, threadIdx, blockDim, gridDim;
typedef void* hipStream_t;
template <class F> static void cpu_launch(int grid, int block, F f) {
#pragma omp parallel for schedule(dynamic, 1)
  for (int b = 0; b < grid; ++b) {
    gridDim.x = grid; blockDim.x = block; blockIdx.x = b;
    for (int t = 0; t < block; ++t) { threadIdx.x = t; f(); }
  }
}
#define LAUNCH(kern, grid, block, ...) cpu_launch((grid), (block), [&]() { kern(__VA_ARGS__); })
static inline void hipMemsetAsync(void* p, int v, size_t n, hipStream_t) { memset(p, v, n); }
#else
#include <hip/hip_runtime.h>
#include <cstdio>
#include <cstdint>
#include <cstring>
#define LAUNCH(kern, grid, block, ...) hipLaunchKernelGGL(kern, dim3(grid), dim3(block), 0, stream, __VA_ARGS__)
#endif

typedef unsigned short bf16_t;

#ifndef CFG_DM
#define CFG_DM 2048
#define CFG_SEQ 4096
#define CFG_GRIDW 64
#define CFG_CTX 256
#define CFG_S5P 64
#define CFG_GHD 128
#define CFG_RCHUNK 128
#define CFG_MNOPE 128
#define CFG_MROPE 64
#define CFG_NE 16
#endif
constexpr int DM = CFG_DM, NB = 2, SEQ = CFG_SEQ, GRIDW = CFG_GRIDW, CTXL = CFG_CTX, NLAYER = 2;
constexpr int BW = DM / 4, S5CH = 16, S5G = BW / S5CH, S5P = CFG_S5P;
constexpr int GHD = CFG_GHD, GH = BW / GHD, GKV = GH / 2;
constexpr int RH = 4, RV = BW / RH, RQK = RV / 2;
constexpr int MQL = BW, MKVL = BW / 2, MH = 4, MNOPE = CFG_MNOPE, MROPE = CFG_MROPE, MV = BW / MH, MQK = MNOPE + MROPE;
constexpr int NE = CFG_NE, FF = DM / 2;
constexpr int NTOK = SEQ + CTXL, MROWS = NB * NTOK;
constexpr int OFF_U = 0, OFF_GQ = BW, OFF_GK = OFF_GQ + GH * GHD, OFF_GV = OFF_GK + GKV * GHD, OFF_RQ = OFF_GV + GKV * GHD, OFF_RK = OFF_RQ + RH * RQK,
              OFF_RV = OFF_RK + RH * RQK, OFF_RG = OFF_RV + RH * RV, OFF_CQ = OFF_RG + RH * RV, OFF_CKV = OFF_CQ + MQL, OFF_KR = OFF_CKV + MKVL, IN_TOTAL = OFF_KR + MROPE;
constexpr int PW = (IN_TOTAL + 255) / 256 * 256;
constexpr int CAP_L = 2 * SEQ / NE, CAP_C = 2 * CTXL / NE;
constexpr int XE = 2 * CAP_L + 2 * CAP_C, XEP = (XE + 255) / 256 * 256;
constexpr int XROWS = NE * XEP;
constexpr int NROPE_A = GHD / 4, NROPE_B = RQK / 4;
static_assert(MROPE / 4 == NROPE_B, "rope tables");
static_assert(MNOPE == MV, "kv split");
constexpr int S5LC = 16, S5NC = NTOK / S5LC, S5NN = NB * S5NC, S5NP = (S5NN + 255) / 256 * 256, S5K1 = S5LC * S5CH, S5K2 = 2 * S5P * 2;
constexpr int RCH = CFG_RCHUNK, RNC = NTOK / RCH;
constexpr float NORM_EPS = 1e-6f;
constexpr float DN_ALPHA = 1.4142135623730951f;

enum { I_X = 0, I_C, I_CTX, I_CCTX, I_ADAW, I_ADAB, I_WIN, I_S5AREF, I_S5AIMF, I_S5DTF, I_S5AREB, I_S5AIMB, I_S5DTB, I_S5BRE, I_S5BIM, I_S5CRE, I_S5CIM, I_S5D, I_S5GLU,
       I_GQN, I_GKN, I_RDF, I_RDB, I_RNORM, I_MQN, I_MKVN, I_WUQ, I_WUKV, I_WBR, I_WGATE, I_BGATE, I_WOUT, I_LN1G, I_LN1B, I_ROUTER, I_MOEG, I_MOEU, I_MOED, I_LN2G, I_LN2B, N_IN };

constexpr size_t al256(size_t x) { return (x + 255) / 256 * 256; }
struct WsLayout {
  size_t bar, mod, rope_a, rope_b, s5tab, wt_in, wt_gate, wt_br, wt_out, wt_glu, wt_uq, wt_ukv, wt_gu, wt_dn;
  size_t x1, x2, h1, h2, regA  , qm, km, vm, z, oall, macc  , merged, aff, slot, gatev, xsrc, retst, s5st, uh, s5e, s5sw, s5sv, rkv, rs, zrow, gctx, krp, yslab, end;
};
constexpr size_t SZ_P = (size_t)MROWS * PW * 2, SZ_PROJ = (size_t)MROWS * 4 * DM * 2;
constexpr size_t SZ_XS = (size_t)XROWS * DM * 2, SZ_ACT = (size_t)XROWS * FF * 2, SZ_YS = (size_t)XROWS * DM * 2;
constexpr size_t SZ_HS = (size_t)MROWS * S5G * S5P * 2 * 4;
constexpr size_t cmax(size_t a, size_t b) { return a > b ? a : b; }
constexpr WsLayout make_ws() {
  WsLayout w{}; size_t o = 0;
  w.bar = o; o += al256(32768);
  w.mod = o; o += al256((size_t)NLAYER * 3 * 6 * DM * 4);
  w.rope_a = o; o += al256((size_t)GRIDW * NROPE_A * 2 * 4);
  w.rope_b = o; o += al256((size_t)GRIDW * NROPE_B * 2 * 4);
  w.s5tab = o; o += al256((size_t)NLAYER * 2 * S5G * S5P * (2 + 2 * S5CH) * 4);
  w.wt_in = o; o += al256((size_t)NLAYER * PW * DM * 2);
  w.wt_gate = o; o += al256((size_t)NLAYER * 4 * DM * DM * 2);
  w.wt_br = o; o += al256((size_t)NLAYER * 4 * DM * BW * 2);
  w.wt_out = o; o += al256((size_t)NLAYER * DM * DM * 2);
  w.wt_glu = o; o += al256((size_t)NLAYER * BW * BW * 2);
  w.wt_uq = o; o += al256((size_t)NLAYER * MH * MQK * MQL * 2);
  w.wt_ukv = o; o += al256((size_t)NLAYER * MH * (MNOPE + MV) * MKVL * 2);
  w.wt_gu = o; o += al256((size_t)NLAYER * NE * 2 * FF * DM * 2);
  w.wt_dn = o; o += al256((size_t)NLAYER * NE * DM * FF * 2);
  w.x1 = o; o += al256((size_t)MROWS * DM * 4);
  w.x2 = o; o += al256((size_t)MROWS * DM * 4);
  w.h1 = o; o += al256((size_t)MROWS * DM * 2);
  w.h2 = o; o += al256((size_t)MROWS * DM * 2);
  w.regA = o; o += al256(cmax(cmax(SZ_P + SZ_PROJ, SZ_XS + SZ_ACT + SZ_YS), SZ_P + SZ_HS));
  w.qm = o; o += al256((size_t)MROWS * MH * MQK * 2);
  w.km = o; o += al256((size_t)MROWS * MH * MQK * 2);
  w.vm = o; o += al256((size_t)MROWS * MH * MV * 2);
  w.z = o; o += al256((size_t)MROWS * BW * 2);
  w.oall = o; o += al256((size_t)MROWS * DM * 2);
  w.macc = o; o += al256((size_t)MROWS * DM * 4);
  w.merged = o; o += al256((size_t)MROWS * DM * 2);
  w.aff = o; o += al256((size_t)MROWS * NE * 4);
  w.slot = o; o += al256((size_t)MROWS * NE * 4);
  w.gatev = o; o += al256((size_t)XROWS * 4);
  w.xsrc = o; o += al256((size_t)XROWS * 4);
  w.retst = o; o += al256((size_t)NB * RH * 2 * RQK * RV * 4);
  w.s5st = o; o += al256((size_t)NB * 2 * S5G * S5P * 2 * 4);
  w.uh = o; o += al256((size_t)S5G * S5NP * (S5K1 + S5K2) * 2);
  w.s5e = o; o += al256((size_t)S5G * S5NP * S5K2 * 4);
  w.s5sw = o; o += al256((size_t)NLAYER * S5G * S5K2 * S5K1 * 2);
  w.s5sv = o; o += al256((size_t)NLAYER * S5G * S5K1 * (S5K1 + S5K2) * 2);
  w.rkv = o; o += al256((size_t)NB * RH * 2 * RNC * RV * RQK * 4);
  w.rs = o; o += al256((size_t)NB * RH * 2 * RNC * RV * RQK * 2);
  w.zrow = o; o += al256((size_t)DM * 2);
  w.gctx = o; o += al256((size_t)NB * CTXL * 4 * DM * 2);
  w.krp = o; o += al256((size_t)2 * MROWS * MROPE * 4);
  w.yslab = o; o += al256((size_t)4 * NB * CTXL * DM * 4);
  w.end = o; return w;
}
constexpr WsLayout WS = make_ws();

struct Params {
  const float* in[N_IN];
  float* out;
  char* ws;
};

__host__ __device__ __forceinline__ float bf2f(bf16_t b) { union { unsigned u; float f; } c; c.u = ((unsigned)b) << 16; return c.f; }
__host__ __device__ __forceinline__ bf16_t f2bf(float f) { union { unsigned u; float f; } c; c.f = f; unsigned u = c.u; u += 0x7FFFu + ((u >> 16) & 1u); return (bf16_t)(u >> 16); }
__host__ __device__ __forceinline__ float sigmoidf_(float x) { return 1.f / (1.f + expf(-x)); }
__host__ __device__ __forceinline__ float siluf_(float x) { return x / (1.f + expf(-x)); }
__host__ __device__ __forceinline__ float gelu_tanh(float x) { return 0.5f * x * (1.f + tanhf(0.7978845608028654f * (x + 0.044715f * x * x * x))); }
__host__ __device__ __forceinline__ int row_b(int R) { return R / NTOK; }
__host__ __device__ __forceinline__ int row_t(int R) { return R % NTOK; }
__host__ __device__ __forceinline__ bool row_is_ctx(int R) { return (R % NTOK) >= SEQ; }
__host__ __device__ __forceinline__ int row_mod(int R) { return row_is_ctx(R) ? 2 : row_b(R); }
#ifndef CPU_TEST
__device__ __forceinline__ int ph_bid() { int b = blockIdx.x; asm volatile("" : "+s"(b)); return b; }
__device__ __forceinline__ int ph_tid() { int t = threadIdx.x; asm volatile("" : "+v"(t)); return t; }
#endif
#define GSTRIDE(i, n) for (long i = (long)blockIdx.x * blockDim.x + threadIdx.x; i < (long)(n); i += (long)gridDim.x * blockDim.x)
#define WSP(T, p, field) ((T*)((p).ws + WS.field))

__global__ void nk_conv_t(bf16_t* dst, const float* src, int K, int N, int ldsrc, int Ndst) {
  GSTRIDE(i, (long)Ndst * K) { int n = (int)(i / K), k = (int)(i % K); dst[i] = n < N ? f2bf(src[(long)k * ldsrc + n]) : (bf16_t)0; }
}
__global__ void nk_conv_gu(bf16_t* dst, const float* wg, const float* wu) {
  GSTRIDE(i, (long)2 * FF * DM) { int j = (int)(i / DM), k = (int)(i % DM); int tile = j / 256, r = j % 256, f = tile * 128 + (r & 127);
    const float* s = (r < 128) ? wg : wu; dst[i] = f2bf(s[(long)k * FF + f]); }
}
__global__ void nk_mod(Params p) {
  float* mod = WSP(float, p, mod);
  GSTRIDE(i, (long)NLAYER * 3 * 6 * DM) { int j = (int)(i % (6 * DM)), r = (int)((i / (6 * DM)) % 3), l = (int)(i / (18 * DM));
    const float* cv = (r < 2) ? p.in[I_C] + (long)r * DM : p.in[I_CCTX]; const float* w = p.in[I_ADAW] + (long)l * DM * 6 * DM;
    float acc = 0.f; for (int k = 0; k < DM; ++k) acc += siluf_(cv[k]) * w[(long)k * 6 * DM + j];
    mod[i] = acc + p.in[I_ADAB][(long)l * 6 * DM + j]; }
}
__global__ void nk_rope_tab(Params p) {
  float* ta = WSP(float, p, rope_a); float* tb = WSP(float, p, rope_b);
  GSTRIDE(i, (long)GRIDW * (NROPE_A + NROPE_B)) { int pos = (int)(i / (NROPE_A + NROPE_B)), k = (int)(i % (NROPE_A + NROPE_B));
    if (k < NROPE_A) { float inv = powf(10000.f, -(float)k / NROPE_A), a = pos * inv; ta[(pos * NROPE_A + k) * 2] = cosf(a); ta[(pos * NROPE_A + k) * 2 + 1] = sinf(a); }
    else { int kk = k - NROPE_A; float inv = powf(10000.f, -(float)kk / NROPE_B), a = pos * inv; tb[(pos * NROPE_B + kk) * 2] = cosf(a); tb[(pos * NROPE_B + kk) * 2 + 1] = sinf(a); } }
}
constexpr int S5TW = 2 + 2 * S5CH;
__global__ void nk_s5tab(Params p) {
  float* tab = WSP(float, p, s5tab);
  GSTRIDE(i, (long)NLAYER * 2 * S5G * S5P) { int pp = (int)(i % S5P), g = (int)((i / S5P) % S5G), dir = (int)((i / (S5P * S5G)) % 2), l = (int)(i / (2 * S5P * S5G));
    const float a_re = p.in[dir ? I_S5AREB : I_S5AREF][(l * S5G + g) * S5P + pp], a_im = p.in[dir ? I_S5AIMB : I_S5AIMF][(l * S5G + g) * S5P + pp];
    const float dt = expf(p.in[dir ? I_S5DTB : I_S5DTF][l * S5G + g]);
    const float mag = expf(a_re * dt), ab_re = mag * cosf(a_im * dt), ab_im = mag * sinf(a_im * dt);
    const float den = a_re * a_re + a_im * a_im, nr = ab_re - 1.f, ni = ab_im;
    const float cr = (nr * a_re + ni * a_im) / den, ci = (ni * a_re - nr * a_im) / den;
    float* t = tab + i * S5TW; t[0] = ab_re; t[1] = ab_im;
    for (int c = 0; c < S5CH; ++c) { const float br = p.in[I_S5BRE][((l * S5G + g) * S5P + pp) * S5CH + c], bi = p.in[I_S5BIM][((l * S5G + g) * S5P + pp) * S5CH + c];
      t[2 + c] = cr * br - ci * bi; t[2 + S5CH + c] = cr * bi + ci * br; } }
}
__global__ void nk_load_x(Params p) {
  float* X2 = WSP(float, p, x2);
  GSTRIDE(i, (long)MROWS * DM) { int R = (int)(i / DM), d = (int)(i % DM), b = row_b(R), t = row_t(R);
    X2[i] = t < SEQ ? p.in[I_X][((long)b * SEQ + t) * DM + d] : p.in[I_CTX][((long)b * CTXL + (t - SEQ)) * DM + d]; }
}
__global__ void nk_ln_mod(Params p, bf16_t* H, const float* X, int l, int ch_sh, int ch_sc) {
  const float* mod = WSP(float, p, mod) + (long)l * 3 * 6 * DM;
  GSTRIDE(R, MROWS) { const float* x = X + R * DM; float s = 0.f; for (int d = 0; d < DM; ++d) s += x[d]; const float mean = s / DM;
    float v = 0.f; for (int d = 0; d < DM; ++d) { float c = x[d] - mean; v += c * c; } const float rs = 1.f / sqrtf(v / DM + NORM_EPS);
    const float* m = mod + (long)row_mod((int)R) * 6 * DM;
    for (int d = 0; d < DM; ++d) H[R * DM + d] = f2bf((x[d] - mean) * rs * (1.f + m[ch_sc * DM + d]) + m[ch_sh * DM + d]); }
}
template <class Epi> __global__ void nk_gemm(const bf16_t* A, long lda, const bf16_t* Bt, long ldb, int M, int N, int K, Epi epi) {
  GSTRIDE(i, (long)M * (N / 4)) { int m = (int)(i / (N / 4)), n = (int)(i % (N / 4)) * 4; float a0 = 0.f, a1 = 0.f, a2 = 0.f, a3 = 0.f;
    const bf16_t* ar = A + (long)m * lda; const bf16_t* b0 = Bt + (long)n * ldb;
    for (int k = 0; k < K; ++k) { const float a = bf2f(ar[k]); a0 += a * bf2f(b0[k]); a1 += a * bf2f(b0[ldb + k]); a2 += a * bf2f(b0[2 * ldb + k]); a3 += a * bf2f(b0[3 * ldb + k]); }
    epi(m, n, a0, a1, a2, a3); }
}
struct EpStoreBf16 { bf16_t* C; long ldc; __host__ __device__ void operator()(int m, int n, float a0, float a1, float a2, float a3) const {
  bf16_t* c = C + (long)m * ldc + n; c[0] = f2bf(a0); c[1] = f2bf(a1); c[2] = f2bf(a2); c[3] = f2bf(a3); } };
struct EpStoreF32 { float* C; long ldc; __host__ __device__ void operator()(int m, int n, float a0, float a1, float a2, float a3) const {
  float* c = C + (long)m * ldc + n; c[0] = a0; c[1] = a1; c[2] = a2; c[3] = a3; } };
struct EpKV { bf16_t* KM; bf16_t* VM; __host__ __device__ void operator()(int m, int n, float a0, float a1, float a2, float a3) const {
  const int h = n / (MNOPE + MV), r = n % (MNOPE + MV);
  bf16_t* c = (r < MNOPE) ? KM + (long)m * MH * MQK + h * MQK + r : VM + (long)m * MH * MV + h * MV + (r - MNOPE);
  c[0] = f2bf(a0); c[1] = f2bf(a1); c[2] = f2bf(a2); c[3] = f2bf(a3); } };
struct EpGlu { const bf16_t* Z; bf16_t* O; __host__ __device__ void operator()(int m, int n, float a0, float a1, float a2, float a3) const {
  const bf16_t* z = Z + (long)m * BW + n; bf16_t* o = O + (long)m * DM + n;
  o[0] = f2bf(bf2f(z[0]) * sigmoidf_(a0)); o[1] = f2bf(bf2f(z[1]) * sigmoidf_(a1)); o[2] = f2bf(bf2f(z[2]) * sigmoidf_(a2)); o[3] = f2bf(bf2f(z[3]) * sigmoidf_(a3)); } };
struct EpDown { const float* gate; bf16_t* Y; __host__ __device__ void operator()(int m, int n, float a0, float a1, float a2, float a3) const {
  const float g = gate[m]; bf16_t* y = Y + (long)m * DM + n; y[0] = f2bf(a0 * g); y[1] = f2bf(a1 * g); y[2] = f2bf(a2 * g); y[3] = f2bf(a3 * g); } };

__device__ __forceinline__ void rope_pair(bf16_t* x, int i1, int i2, float sc1, float sc2, bool rot, const float* cs) {
  const float c = rot ? cs[0] : 1.f, s = rot ? cs[1] : 0.f; const float a = bf2f(x[i1]) * sc1, b = bf2f(x[i2]) * sc2; x[i1] = f2bf(a * c - b * s); x[i2] = f2bf(a * s + b * c);
}
__global__ void nk_post_proj(Params p, int l) {
  bf16_t* P = WSP(bf16_t, p, regA); const float* ta = WSP(float, p, rope_a); const float* tb = WSP(float, p, rope_b);
  constexpr int NJ = GH + GKV + 2 * RH + 3;
  GSTRIDE(i, (long)MROWS * NJ) { const int R = (int)(i / NJ), j = (int)(i % NJ), t = row_t(R); const bool lat = t < SEQ; const int gr = lat ? t / GRIDW : 0, gc = lat ? t % GRIDW : 0;
    bf16_t* pr = P + (long)R * PW;
    if (j < GH + GKV) {
      bf16_t* x = pr + (j < GH ? OFF_GQ + j * GHD : OFF_GK + (j - GH) * GHD); const float* g = p.in[j < GH ? I_GQN : I_GKN] + l * GHD;
      float ss = 0.f; for (int d = 0; d < GHD; ++d) { float v = bf2f(x[d]); ss += v * v; } const float r = 1.f / sqrtf(ss / GHD + NORM_EPS);
      for (int hf = 0; hf < 2; ++hf) for (int k = 0; k < NROPE_A; ++k) { const int i1 = hf * 2 * NROPE_A + k, i2 = i1 + NROPE_A;
        rope_pair(x, i1, i2, r * g[i1], r * g[i2], lat, ta + ((hf ? gc : gr) * NROPE_A + k) * 2); }
    } else if (j < GH + GKV + 2 * RH) {
      const int jj = j - GH - GKV; const bool isk = jj >= RH; bf16_t* x = pr + (isk ? OFF_RK + (jj - RH) * RQK : OFF_RQ + jj * RQK); const float sc = isk ? 1.f / sqrtf((float)RQK) : 1.f;
      for (int hf = 0; hf < 2; ++hf) for (int k = 0; k < NROPE_B; ++k) { const int i1 = hf * 2 * NROPE_B + k, i2 = i1 + NROPE_B;
        rope_pair(x, i1, i2, sc, sc, lat, tb + ((hf ? gc : gr) * NROPE_B + k) * 2); }
    } else if (j == GH + GKV + 2 * RH) {
      bf16_t* x = pr + OFF_CQ; const float* g = p.in[I_MQN] + l * MQL; float ss = 0.f; for (int d = 0; d < MQL; ++d) { float v = bf2f(x[d]); ss += v * v; }
      const float r = 1.f / sqrtf(ss / MQL + NORM_EPS); for (int d = 0; d < MQL; ++d) x[d] = f2bf(bf2f(x[d]) * r * g[d]);
    } else if (j == GH + GKV + 2 * RH + 1) {
      bf16_t* x = pr + OFF_CKV; const float* g = p.in[I_MKVN] + l * MKVL; float ss = 0.f; for (int d = 0; d < MKVL; ++d) { float v = bf2f(x[d]); ss += v * v; }
      const float r = 1.f / sqrtf(ss / MKVL + NORM_EPS); for (int d = 0; d < MKVL; ++d) x[d] = f2bf(bf2f(x[d]) * r * g[d]);
    } else if (lat) {
      bf16_t* x = pr + OFF_KR;
      for (int hf = 0; hf < 2; ++hf) for (int k = 0; k < NROPE_B; ++k) { const int i1 = hf * 2 * NROPE_B + k, i2 = i1 + NROPE_B; rope_pair(x, i1, i2, 1.f, 1.f, true, tb + ((hf ? gc : gr) * NROPE_B + k) * 2); }
    } }
}
__global__ void nk_post_mla(Params p) {
  bf16_t* P = WSP(bf16_t, p, regA); bf16_t* QM = WSP(bf16_t, p, qm); bf16_t* KM = WSP(bf16_t, p, km); const float* tb = WSP(float, p, rope_b);
  GSTRIDE(i, (long)MROWS * MH) { const int R = (int)(i / MH), h = (int)(i % MH), t = row_t(R); const bool lat = t < SEQ;
    if (lat) { const int gr = t / GRIDW, gc = t % GRIDW; bf16_t* x = QM + (long)R * MH * MQK + h * MQK + MNOPE;
      for (int hf = 0; hf < 2; ++hf) for (int k = 0; k < NROPE_B; ++k) { const int i1 = hf * 2 * NROPE_B + k, i2 = i1 + NROPE_B; rope_pair(x, i1, i2, 1.f, 1.f, true, tb + ((hf ? gc : gr) * NROPE_B + k) * 2); } }
    for (int d = 0; d < MROPE; ++d) KM[(long)R * MH * MQK + h * MQK + MNOPE + d] = P[(long)R * PW + OFF_KR + d]; }
}
__global__ void nk_post_mla_q(Params p) {
  bf16_t* QM = WSP(bf16_t, p, qm); const float* tb = WSP(float, p, rope_b);
  GSTRIDE(i, (long)MROWS * MH) { const int R = (int)(i / MH), h = (int)(i % MH), t = row_t(R); const bool lat = t < SEQ;
    if (lat) { const int gr = t / GRIDW, gc = t % GRIDW; bf16_t* x = QM + (long)R * MH * MQK + h * MQK + MNOPE;
      for (int hf = 0; hf < 2; ++hf) for (int k = 0; k < NROPE_B; ++k) { const int i1 = hf * 2 * NROPE_B + k, i2 = i1 + NROPE_B; rope_pair(x, i1, i2, 1.f, 1.f, true, tb + ((hf ? gc : gr) * NROPE_B + k) * 2); } } }
}
__global__ void nk_s5_scan(Params p, int l) {
  const bf16_t* P = WSP(bf16_t, p, regA); float* HS = (float*)(p.ws + WS.regA + SZ_P); const float* tab = WSP(float, p, s5tab);
  GSTRIDE(i, (long)NB * S5G * S5P) { const int pp = (int)(i % S5P), g = (int)((i / S5P) % S5G), b = (int)(i / (S5P * S5G));
    for (int dir = 0; dir < 2; ++dir) { const float* t = tab + ((((long)l * 2 + dir) * S5G + g) * S5P + pp) * S5TW; const float are = t[0], aim = t[1]; float hr = 0.f, hi = 0.f;
      for (int s = 0; s < NTOK; ++s) {
        int tt; if (!dir) tt = s < CTXL ? SEQ + s : s - CTXL; else tt = s < CTXL ? SEQ + (CTXL - 1 - s) : SEQ - 1 - (s - CTXL);
        const long R = (long)b * NTOK + tt; const bf16_t* u = P + R * PW + OFF_U + g * S5CH; float br = 0.f, bi = 0.f;
        for (int c = 0; c < S5CH; ++c) { const float uv = bf2f(u[c]); br += uv * t[2 + c]; bi += uv * t[2 + S5CH + c]; }
        const float nr = are * hr - aim * hi + br, ni = are * hi + aim * hr + bi; hr = nr; hi = ni;
        float* hs = HS + ((R * S5G + g) * S5P + pp) * 2; if (!dir) { hs[0] = hr; hs[1] = hi; } else { hs[0] += hr; hs[1] += hi; } } } }
}
__global__ void nk_s5_read(Params p, int l) {
  const bf16_t* P = WSP(bf16_t, p, regA); const float* HS = (const float*)(p.ws + WS.regA + SZ_P); bf16_t* Z = WSP(bf16_t, p, z);
  GSTRIDE(i, (long)MROWS * BW) { const long R = i / BW; const int c = (int)(i % BW), g = c / S5CH, ci = c % S5CH;
    const float* hs = HS + (R * S5G + g) * S5P * 2; const float* cre = p.in[I_S5CRE] + (((long)l * S5G + g) * S5CH + ci) * S5P; const float* cim = p.in[I_S5CIM] + (((long)l * S5G + g) * S5CH + ci) * S5P;
    float y = 0.f; for (int pp = 0; pp < S5P; ++pp) y += hs[2 * pp] * cre[pp] - hs[2 * pp + 1] * cim[pp];
    y += p.in[I_S5D][l * BW + c] * bf2f(P[R * PW + OFF_U + c]); Z[i] = f2bf(gelu_tanh(y)); }
}
template <int DQK, int DV> __global__ void __launch_bounds__(256) nk_attn(const bf16_t* Q, const bf16_t* K, const bf16_t* V, bf16_t* O, int ldq, int ldk, int ldv, int ldo, int H, int group, float scale) {
  GSTRIDE(i, (long)MROWS * H) { const int R = (int)(i / H), h = (int)(i % H), b = row_b(R), kh = h / group; const bool lat = !row_is_ctx(R);
    const bf16_t* q = Q + (long)R * ldq + h * DQK; float o[DV]; _Pragma("unroll") for (int d = 0; d < DV; ++d) o[d] = 0.f; float m = -1e30f, lsum = 0.f;
    for (int kk = lat ? 0 : SEQ; kk < NTOK; ++kk) { const long KR = (long)b * NTOK + kk; const bf16_t* kp = K + KR * ldk + kh * DQK; float s = 0.f;
      for (int d = 0; d < DQK; ++d) s += bf2f(q[d]) * bf2f(kp[d]); s *= scale;
      if (s > m) { const float corr = expf(m - s); lsum *= corr; _Pragma("unroll") for (int d = 0; d < DV; ++d) o[d] *= corr; m = s; }
      const float pw = expf(s - m); lsum += pw; const bf16_t* vp = V + KR * ldv + kh * DV; _Pragma("unroll") for (int d = 0; d < DV; ++d) o[d] += pw * bf2f(vp[d]); }
    const float inv = 1.f / lsum; _Pragma("unroll") for (int d = 0; d < DV; ++d) O[(long)R * ldo + h * DV + d] = f2bf(o[d] * inv); }
}
__global__ void __launch_bounds__(256) nk_ret(Params p, int l) {
  const bf16_t* P = WSP(bf16_t, p, regA); bf16_t* O = WSP(bf16_t, p, oall);
  GSTRIDE(i, (long)MROWS * RH) { const int R = (int)(i / RH), h = (int)(i % RH), b = row_b(R), t = row_t(R); const bool lat = t < SEQ;
    const float lgf = -expf(p.in[I_RDF][l * RH + h]), lgb = -expf(p.in[I_RDB][l * RH + h]);
    const bf16_t* q = P + (long)R * PW + OFF_RQ + h * RQK; float o[RV]; _Pragma("unroll") for (int d = 0; d < RV; ++d) o[d] = 0.f;
    for (int kk = lat ? 0 : SEQ; kk < NTOK; ++kk) { float w;
      if (lat) { if (kk < SEQ) w = kk <= t ? expf(lgf * (float)(t - kk)) : expf(lgb * (float)(kk - t)); else { const int j = kk - SEQ; w = expf(lgf * (float)(t + CTXL - j)) + expf(lgb * (float)(SEQ - t + j)); } }
      else { const int j = t - SEQ, j2 = kk - SEQ; w = j2 <= j ? expf(lgf * (float)(j - j2)) : expf(lgb * (float)(j2 - j)); }
      const long KR = (long)b * NTOK + kk; const bf16_t* kp = P + KR * PW + OFF_RK + h * RQK; float s = 0.f; for (int d = 0; d < RQK; ++d) s += bf2f(q[d]) * bf2f(kp[d]); s *= w;
      const bf16_t* vp = P + KR * PW + OFF_RV + h * RV; _Pragma("unroll") for (int d = 0; d < RV; ++d) o[d] += s * bf2f(vp[d]); }
    float mean = 0.f; _Pragma("unroll") for (int d = 0; d < RV; ++d) mean += o[d]; mean /= RV; float var = 0.f; _Pragma("unroll") for (int d = 0; d < RV; ++d) { const float c = o[d] - mean; var += c * c; }
    const float rs = 1.f / sqrtf(var / RV + NORM_EPS); const bf16_t* gp = P + (long)R * PW + OFF_RG + h * RV; const float* gain = p.in[I_RNORM] + l * BW + h * RV;
    _Pragma("unroll") for (int d = 0; d < RV; ++d) O[(long)R * DM + 2 * BW + h * RV + d] = f2bf((o[d] - mean) * rs * gain[d] * siluf_(bf2f(gp[d]))); }
}
__global__ void nk_gate_merge(Params p, int l) {
  const bf16_t* H = WSP(bf16_t, p, h1); const bf16_t* Wg = WSP(bf16_t, p, wt_gate) + (long)l * 4 * DM * DM; const bf16_t* PROJ = (const bf16_t*)(p.ws + WS.regA + SZ_P); bf16_t* MG = WSP(bf16_t, p, merged);
  const float* bg = p.in[I_BGATE] + (long)l * 4 * DM;
  GSTRIDE(i, (long)MROWS * DM) { const long R = i / DM; const int d = (int)(i % DM); const bf16_t* hr = H + R * DM; float acc = 0.f;
    for (int k = 0; k < 4; ++k) { const bf16_t* w = Wg + ((long)k * DM + d) * DM; float s = 0.f; for (int c = 0; c < DM; ++c) s += bf2f(hr[c]) * bf2f(w[c]);
      acc += sigmoidf_(s + bg[k * DM + d]) * bf2f(PROJ[R * 4 * DM + k * DM + d]); }
    MG[i] = f2bf(acc); }
}
__global__ void nk_ln1(Params p, int l) {
  const float* X2 = WSP(float, p, x2); const float* Y = WSP(float, p, macc); float* X1 = WSP(float, p, x1); bf16_t* H2 = WSP(bf16_t, p, h2); float* AFF = WSP(float, p, aff);
  const float* mod = WSP(float, p, mod) + (long)l * 3 * 6 * DM; const float* lg = p.in[I_LN1G] + l * DM; const float* lb = p.in[I_LN1B] + l * DM; const float* rw = p.in[I_ROUTER] + (long)l * DM * NE;
  GSTRIDE(R, MROWS) { const float* m = mod + (long)row_mod((int)R) * 6 * DM; const float* x = X2 + R * DM; const float* y = Y + R * DM; float* x1 = X1 + R * DM;
    float s = 0.f; for (int d = 0; d < DM; ++d) { const float v = DN_ALPHA * x[d] + m[2 * DM + d] * y[d]; x1[d] = v; s += v; } float mean = s / DM;
    float var = 0.f; for (int d = 0; d < DM; ++d) { const float c = x1[d] - mean; var += c * c; } float rs = 1.f / sqrtf(var / DM + NORM_EPS);
    s = 0.f; for (int d = 0; d < DM; ++d) { const float v = (x1[d] - mean) * rs * lg[d] + lb[d]; x1[d] = v; s += v; } mean = s / DM;
    var = 0.f; for (int d = 0; d < DM; ++d) { const float c = x1[d] - mean; var += c * c; } rs = 1.f / sqrtf(var / DM + NORM_EPS);
    float lo[NE]; _Pragma("unroll") for (int e = 0; e < NE; ++e) lo[e] = 0.f;
    for (int d = 0; d < DM; ++d) { const float hv = (x1[d] - mean) * rs * (1.f + m[4 * DM + d]) + m[3 * DM + d]; H2[R * DM + d] = f2bf(hv); _Pragma("unroll") for (int e = 0; e < NE; ++e) lo[e] += hv * rw[(long)d * NE + e]; }
    float mx = lo[0]; _Pragma("unroll") for (int e = 1; e < NE; ++e) mx = fmaxf(mx, lo[e]); float se = 0.f; _Pragma("unroll") for (int e = 0; e < NE; ++e) { lo[e] = expf(lo[e] - mx); se += lo[e]; }
    _Pragma("unroll") for (int e = 0; e < NE; ++e) AFF[R * NE + e] = lo[e] / se; }
}
__global__ void nk_topk(Params p, int with_ctx) {
  const float* AFF = WSP(float, p, aff); int* SLOT = WSP(int, p, slot); float* GV = WSP(float, p, gatev); int* XSRC = WSP(int, p, xsrc);
  GSTRIDE(i, (long)MROWS * NE) { const int R = (int)(i / NE), e = (int)(i % NE), b = row_b(R), t = row_t(R); const bool lat = t < SEQ;
    if (!lat && !with_ctx) { SLOT[i] = -1; continue; }
    const int k0 = lat ? 0 : SEQ, k1 = lat ? SEQ : NTOK, cap = lat ? CAP_L : CAP_C; const float a = AFF[i]; int rank = 0;
    for (int kk = k0; kk < k1; ++kk) { const float o = AFF[((long)b * NTOK + kk) * NE + e]; rank += (o > a || (o == a && kk < t)) ? 1 : 0; }
    if (rank < cap) { const int xr = e * XEP + (lat ? b * CAP_L : 2 * CAP_L + b * CAP_C) + rank; SLOT[i] = xr; GV[xr] = a; XSRC[xr] = R; } else SLOT[i] = -1; }
}
__global__ void nk_gather(Params p) {
  const int* XSRC = WSP(int, p, xsrc); const bf16_t* H2 = WSP(bf16_t, p, h2); bf16_t* XS = WSP(bf16_t, p, regA);
  GSTRIDE(i, (long)XROWS * DM) { const long xr = i / DM; const int d = (int)(i % DM), src = XSRC[xr]; XS[i] = src >= 0 ? H2[(long)src * DM + d] : (bf16_t)0; }
}
__global__ void nk_moe_up(Params p, int l) {
  const bf16_t* XS = WSP(bf16_t, p, regA); bf16_t* ACT = (bf16_t*)(p.ws + WS.regA + SZ_XS); const bf16_t* W = WSP(bf16_t, p, wt_gu) + (long)l * NE * 2 * FF * DM; const int* XSRC = WSP(int, p, xsrc);
  GSTRIDE(i, (long)XROWS * FF) { const long xr = i / FF; const int f = (int)(i % FF), e = (int)(xr / XEP); if (XSRC[xr] < 0) { ACT[i] = 0; continue; }
    const int jg = (f / 128) * 256 + (f % 128), ju = jg + 128; const bf16_t* x = XS + xr * DM; const bf16_t* wg = W + ((long)e * 2 * FF + jg) * DM; const bf16_t* wu = W + ((long)e * 2 * FF + ju) * DM;
    float a = 0.f, u = 0.f; for (int k = 0; k < DM; ++k) { const float xv = bf2f(x[k]); a += xv * bf2f(wg[k]); u += xv * bf2f(wu[k]); }
    ACT[i] = f2bf(siluf_(a) * u); }
}
__global__ void nk_ln2(Params p, int l, int last) {
  const float* X1 = WSP(float, p, x1); float* X2 = WSP(float, p, x2); const int* SLOT = WSP(int, p, slot); const bf16_t* YS = (const bf16_t*)(p.ws + WS.regA + SZ_XS + SZ_ACT);
  const float* mod = WSP(float, p, mod) + (long)l * 3 * 6 * DM; const float* lg = p.in[I_LN2G] + l * DM; const float* lb = p.in[I_LN2B] + l * DM;
  GSTRIDE(R, MROWS) { if (last && row_is_ctx((int)R)) continue; const float* m = mod + (long)row_mod((int)R) * 6 * DM; const float* x1 = X1 + R * DM; float* x2 = X2 + R * DM;
    float s = 0.f; for (int d = 0; d < DM; ++d) { float mo = 0.f; for (int e = 0; e < NE; ++e) { const int sl = SLOT[R * NE + e]; if (sl >= 0) mo += bf2f(YS[(long)sl * DM + d]); }
      const float v = DN_ALPHA * x1[d] + m[5 * DM + d] * mo; x2[d] = v; s += v; } const float mean = s / DM;
    float var = 0.f; for (int d = 0; d < DM; ++d) { const float c = x2[d] - mean; var += c * c; } const float rs = 1.f / sqrtf(var / DM + NORM_EPS);
    for (int d = 0; d < DM; ++d) { const float v = (x2[d] - mean) * rs * lg[d] + lb[d]; x2[d] = v; if (last) p.out[((long)row_b((int)R) * SEQ + row_t((int)R)) * DM + d] = v; } }
}
#ifdef CPU_TEST
void cpu_hook(const char* name, int l, Params& p);
#define HOOK(name) cpu_hook(name, l, p)
#else
#define HOOK(name)
#endif
#define NG(n) (int)((((long)(n)) + 255) / 256 < 65536 ? (((long)(n)) + 255) / 256 : 65536)

static void naive_prologue(Params& p, hipStream_t stream) {
  for (int l = 0; l < NLAYER; ++l) {
    LAUNCH(nk_conv_t, NG((long)PW * DM), 256, WSP(bf16_t, p, wt_in) + (long)l * PW * DM, p.in[I_WIN] + (long)l * DM * IN_TOTAL, DM, IN_TOTAL, IN_TOTAL, PW);
    LAUNCH(nk_conv_t, NG((long)4 * DM * DM), 256, WSP(bf16_t, p, wt_gate) + (long)l * 4 * DM * DM, p.in[I_WGATE] + (long)l * DM * 4 * DM, DM, 4 * DM, 4 * DM, 4 * DM);
    for (int k = 0; k < 4; ++k)
      LAUNCH(nk_conv_t, NG((long)DM * BW), 256, WSP(bf16_t, p, wt_br) + ((long)l * 4 + k) * DM * BW, p.in[I_WBR] + ((long)l * 4 + k) * BW * DM, BW, DM, DM, DM);
    LAUNCH(nk_conv_t, NG((long)DM * DM), 256, WSP(bf16_t, p, wt_out) + (long)l * DM * DM, p.in[I_WOUT] + (long)l * DM * DM, DM, DM, DM, DM);
    LAUNCH(nk_conv_t, NG((long)BW * BW), 256, WSP(bf16_t, p, wt_glu) + (long)l * BW * BW, p.in[I_S5GLU] + (long)l * BW * BW, BW, BW, BW, BW);
    LAUNCH(nk_conv_t, NG((long)MH * MQK * MQL), 256, WSP(bf16_t, p, wt_uq) + (long)l * MH * MQK * MQL, p.in[I_WUQ] + (long)l * MQL * MH * MQK, MQL, MH * MQK, MH * MQK, MH * MQK);
    LAUNCH(nk_conv_t, NG((long)MH * (MNOPE + MV) * MKVL), 256, WSP(bf16_t, p, wt_ukv) + (long)l * MH * (MNOPE + MV) * MKVL, p.in[I_WUKV] + (long)l * MKVL * MH * (MNOPE + MV), MKVL, MH * (MNOPE + MV), MH * (MNOPE + MV), MH * (MNOPE + MV));
    for (int e = 0; e < NE; ++e) {
      LAUNCH(nk_conv_gu, NG((long)2 * FF * DM), 256, WSP(bf16_t, p, wt_gu) + ((long)l * NE + e) * 2 * FF * DM, p.in[I_MOEG] + ((long)l * NE + e) * DM * FF, p.in[I_MOEU] + ((long)l * NE + e) * DM * FF);
      LAUNCH(nk_conv_t, NG((long)DM * FF), 256, WSP(bf16_t, p, wt_dn) + ((long)l * NE + e) * DM * FF, p.in[I_MOED] + ((long)l * NE + e) * FF * DM, FF, DM, DM, DM);
    }
  }
  LAUNCH(nk_mod, NG((long)NLAYER * 18 * DM), 256, p);
  LAUNCH(nk_rope_tab, 4, 256, p);
  LAUNCH(nk_s5tab, NG((long)NLAYER * 2 * S5G * S5P), 256, p);
  LAUNCH(nk_load_x, NG((long)MROWS * DM), 256, p);
}

#ifdef CPU_TEST
static void naive_layer(Params& p, int l, hipStream_t stream) {
  bf16_t* P = WSP(bf16_t, p, regA); bf16_t* PROJ = (bf16_t*)(p.ws + WS.regA + SZ_P); bf16_t* H1 = WSP(bf16_t, p, h1);
  bf16_t* QM = WSP(bf16_t, p, qm); bf16_t* KM = WSP(bf16_t, p, km); bf16_t* VM = WSP(bf16_t, p, vm); bf16_t* Z = WSP(bf16_t, p, z); bf16_t* OA = WSP(bf16_t, p, oall);
  LAUNCH(nk_ln_mod, NG(MROWS), 256, p, H1, (const float*)WSP(float, p, x2), l, 0, 1);
  HOOK("h");
  LAUNCH(nk_gemm<EpStoreBf16>, NG((long)MROWS * PW / 4), 256, (const bf16_t*)H1, (long)DM, (const bf16_t*)(WSP(bf16_t, p, wt_in) + (long)l * PW * DM), (long)DM, MROWS, PW, DM, EpStoreBf16{P, PW});
  LAUNCH(nk_post_proj, NG((long)MROWS * 17), 256, p, l);
  LAUNCH(nk_gemm<EpStoreBf16>, NG((long)MROWS * MH * MQK / 4), 256, (const bf16_t*)(P + OFF_CQ), (long)PW, (const bf16_t*)(WSP(bf16_t, p, wt_uq) + (long)l * MH * MQK * MQL), (long)MQL, MROWS, MH * MQK, MQL, EpStoreBf16{QM, MH * MQK});
  LAUNCH(nk_gemm<EpKV>, NG((long)MROWS * MH * (MNOPE + MV) / 4), 256, (const bf16_t*)(P + OFF_CKV), (long)PW, (const bf16_t*)(WSP(bf16_t, p, wt_ukv) + (long)l * MH * (MNOPE + MV) * MKVL), (long)MKVL, MROWS, MH * (MNOPE + MV), MKVL, EpKV{KM, VM});
  LAUNCH(nk_post_mla, NG((long)MROWS * MH), 256, p);
  LAUNCH(nk_s5_scan, NG((long)NB * S5G * S5P), 256, p, l);
  LAUNCH(nk_s5_read, NG((long)MROWS * BW), 256, p, l);
  LAUNCH(nk_gemm<EpGlu>, NG((long)MROWS * BW / 4), 256, (const bf16_t*)Z, (long)BW, (const bf16_t*)(WSP(bf16_t, p, wt_glu) + (long)l * BW * BW), (long)BW, MROWS, BW, BW, EpGlu{Z, OA});
  HOOK("o_s5");
  LAUNCH((nk_attn<GHD, GHD>), NG((long)MROWS * GH), 256, (const bf16_t*)(P + OFF_GQ), (const bf16_t*)(P + OFF_GK), (const bf16_t*)(P + OFF_GV), OA + BW, PW, PW, PW, DM, GH, GH / GKV, 1.f / sqrtf((float)GHD));
  HOOK("o_gqa");
  LAUNCH(nk_ret, NG((long)MROWS * RH), 256, p, l);
  HOOK("o_ret");
  LAUNCH((nk_attn<MQK, MV>), NG((long)MROWS * MH), 256, (const bf16_t*)QM, (const bf16_t*)KM, (const bf16_t*)VM, OA + 3 * BW, MH * MQK, MH * MQK, MH * MV, DM, MH, 1, 1.f / sqrtf((float)MQK));
  HOOK("o_mla");
  for (int k = 0; k < 4; ++k)
    LAUNCH(nk_gemm<EpStoreBf16>, NG((long)MROWS * DM / 4), 256, (const bf16_t*)(OA + k * BW), (long)DM, (const bf16_t*)(WSP(bf16_t, p, wt_br) + ((long)l * 4 + k) * DM * BW), (long)BW, MROWS, DM, BW, EpStoreBf16{PROJ + (long)k * DM, 4 * DM});
  LAUNCH(nk_gate_merge, NG((long)MROWS * DM), 256, p, l);
  LAUNCH(nk_gemm<EpStoreF32>, NG((long)MROWS * DM / 4), 256, (const bf16_t*)WSP(bf16_t, p, merged), (long)DM, (const bf16_t*)(WSP(bf16_t, p, wt_out) + (long)l * DM * DM), (long)DM, MROWS, DM, DM, EpStoreF32{WSP(float, p, macc), DM});
  HOOK("y");
  LAUNCH(nk_ln1, NG(MROWS), 256, p, l);
  HOOK("x1");
  hipMemsetAsync(p.ws + WS.xsrc, 0xFF, (size_t)XROWS * 4, stream);
  LAUNCH(nk_topk, NG((long)MROWS * NE), 256, p, l == 0 ? 1 : 0);
  LAUNCH(nk_gather, NG((long)XROWS * DM), 256, p);
  LAUNCH(nk_moe_up, NG((long)XROWS * FF), 256, p, l);
  bf16_t* ACT = (bf16_t*)(p.ws + WS.regA + SZ_XS); bf16_t* YS = (bf16_t*)(p.ws + WS.regA + SZ_XS + SZ_ACT);
  for (int e = 0; e < NE; ++e)
    LAUNCH(nk_gemm<EpDown>, NG((long)XEP * DM / 4), 256, (const bf16_t*)(ACT + (long)e * XEP * FF), (long)FF, (const bf16_t*)(WSP(bf16_t, p, wt_dn) + ((long)l * NE + e) * DM * FF), (long)FF, XEP, DM, FF,
           EpDown{WSP(float, p, gatev) + e * XEP, YS + (long)e * XEP * DM});
  LAUNCH(nk_ln2, NG(MROWS), 256, p, l, l == NLAYER - 1 ? 1 : 0);
  HOOK("x2");
}
#endif
#ifndef CPU_TEST
#ifndef PG8_SP2
#define PG8_SP2 true
#endif
namespace pg8 {
#define PG8_LAS __attribute__((address_space(3)))
typedef short bf16x8 __attribute__((ext_vector_type(8)));
typedef float f32x4 __attribute__((ext_vector_type(4)));
typedef unsigned u32x4 __attribute__((ext_vector_type(4)));
constexpr int BM = 256, BK = 64, HALF = 128, HTB = HALF * BK * 2, STAGE_BYTES = 8 * HTB, NXCD = 8, WGM = 8;
__host__ __device__ __forceinline__ int lds_byte(int r, int c) { const int st = (r >> 4) * 2 + (c >> 5), rr = r & 15, cc = c & 31, ob = rr * 64 + cc * 2; return st * 1024 + (ob ^ (((ob >> 9) & 1) << 5)); }
__host__ __device__ __forceinline__ void stage_rc(int b, int& R, int& C) { const int st = b / 1024, sb = b % 1024, swz = sb ^ (((sb >> 9) & 1) << 5); R = (st >> 1) * 16 + swz / 64; C = (st & 1) * 32 + (swz % 64) / 2; }
__host__ __device__ __forceinline__ int perm32(int rho) { const int n = rho >> 4, i = rho & 15; return 8 * (i >> 2) + 4 * n + (i & 3); }

struct Unit { int pm, pn, aux; const char* A; const char* B; };
struct GemmG { int lda, ldb, K, bmode; };

__device__ __forceinline__ bool tile_order(long L, int nM, int nN, int& pm, int& pn) {
  const int nwg = nM * nN; if (L >= nwg) return false;
  int wgid = (int)L; { const int q = nwg / NXCD, r = nwg % NXCD, xcd = wgid % NXCD, off = wgid / NXCD; wgid = (xcd < r ? xcd * (q + 1) : r * (q + 1) + (xcd - r) * q) + off; }
  const int nig = WGM * nN, gid = wgid / nig, fm = gid * WGM, gsz = (nM - fm) < WGM ? (nM - fm) : WGM;
  pm = fm + ((wgid % nig) % gsz); pn = (wgid % nig) / gsz; return true;
}
__device__ __forceinline__ unsigned cvt_pk_bf16(float lo, float hi) { unsigned r; asm volatile("v_cvt_pk_bf16_f32 %0, %1, %2" : "=v"(r) : "v"(lo), "v"(hi)); return r; }
__device__ __forceinline__ u32x4 pack8(const f32x4 a, const f32x4 b) { u32x4 w; w.x = cvt_pk_bf16(a[0], a[1]); w.y = cvt_pk_bf16(a[2], a[3]); w.z = cvt_pk_bf16(b[0], b[1]); w.w = cvt_pk_bf16(b[2], b[3]); return w; }
__device__ __forceinline__ void unpack8(const u32x4 w, f32x4& a, f32x4& b) {
  a[0] = __uint_as_float(w.x << 16); a[1] = __uint_as_float(w.x & 0xffff0000u); a[2] = __uint_as_float(w.y << 16); a[3] = __uint_as_float(w.y & 0xffff0000u);
  b[0] = __uint_as_float(w.z << 16); b[1] = __uint_as_float(w.z & 0xffff0000u); b[2] = __uint_as_float(w.w << 16); b[3] = __uint_as_float(w.w & 0xffff0000u); }
#ifndef MK_NT
#define MK_NT 0
#endif
template <class T> __device__ __forceinline__ void st_out(T* p, const T v) { if (MK_NT) __builtin_nontemporal_store(v, p); else *p = v; }
__device__ __forceinline__ float fast_sigmoid(float x) { return __builtin_amdgcn_rcpf(1.f + __builtin_amdgcn_exp2f(-1.4426950408889634f * x)); }
__device__ __forceinline__ f32x4 sigmoid4(f32x4 v) { f32x4 o; o[0] = fast_sigmoid(v[0]); o[1] = fast_sigmoid(v[1]); o[2] = fast_sigmoid(v[2]); o[3] = fast_sigmoid(v[3]); return o; }

template <bool ALIGN = true, bool SP2 = PG8_SP2, class Epi, class Sched>
__device__ __forceinline__ void gemm_phase(PG8_LAS unsigned char* lds, const GemmG g, const Sched& S, const Epi& E) {
    const int tid = ph_tid(), wid = __builtin_amdgcn_readfirstlane(tid >> 6), lane = tid & 63, wr = wid >> 2, wc = wid & 3, fr = lane & 15, fq = lane >> 4;
    const int K = g.K, nt = K / BK;
    unsigned voffA[2], voffB[2];
#pragma unroll
    for (int i = 0; i < 2; ++i) { int R, C; stage_rc(tid * 16 + i * 8192, R, C); const int Rb = (R & ~31) + perm32(R & 31);
        const int wrow = g.bmode ? (((Rb >> 4) & 1) * DM + 16 * ((Rb >> 5) & 3) + (Rb & 15)) : Rb;
        voffA[i] = (unsigned)(R * g.lda + C) * 2u; voffB[i] = (unsigned)(wrow * g.ldb + C) * 2u; }
    const size_t kstep = (size_t)(BK * 2);
    const size_t hsA = (size_t)HALF * g.lda * 2, hsB = (size_t)(g.bmode ? 2 * DM : HALF) * g.ldb * 2;
    const unsigned ldsw = (unsigned)wid * 1024u;
    const int aoff = lds_byte(wr * 64 + fr, fq * 8), boff = lds_byte(wc * 32 + fr, fq * 8);
#define PG8_SA(b, h) (((b) * 2 + (h)) * HTB)
#define PG8_SB(b, h) ((4 + (b) * 2 + (h)) * HTB)
#define PG8_STAGE(bufoff, gbase, voff) do { _Pragma("unroll") for (int _i = 0; _i < 2; ++_i) \
        __builtin_amdgcn_global_load_lds((const unsigned*)((const char*)(gbase) + (voff)[_i]), (PG8_LAS unsigned*)(lds + (bufoff) + ldsw + _i * 8192), 16, 0, 0); } while (0)
#define PG8_LDA(dst, b, h) do { _Pragma("unroll") for (int m = 0; m < 4; ++m) _Pragma("unroll") for (int k = 0; k < 2; ++k) dst[m][k] = *(const PG8_LAS bf16x8*)(lds + PG8_SA(b, h) + aoff + m * 2048 + k * 1024); } while (0)
#define PG8_LDB(dst, b, h) do { _Pragma("unroll") for (int n = 0; n < 2; ++n) _Pragma("unroll") for (int k = 0; k < 2; ++k) dst[n][k] = *(const PG8_LAS bf16x8*)(lds + PG8_SB(b, h) + boff + n * 2048 + k * 1024); } while (0)
#define PG8_MMA(ai, bj, At, Bt) do { __builtin_amdgcn_s_setprio(1); _Pragma("unroll") for (int m = 0; m < 4; ++m) _Pragma("unroll") for (int n = 0; n < 2; ++n) _Pragma("unroll") for (int k = 0; k < 2; ++k) \
        acc[ai][bj][m][n] = __builtin_amdgcn_mfma_f32_16x16x32_bf16(Bt[n][k], At[m][k], acc[ai][bj][m][n], 0, 0, 0); __builtin_amdgcn_s_setprio(0); } while (0)
#define PG8_WAIT_V(n) asm volatile("s_waitcnt vmcnt(" #n ")" ::: "memory")
#define PG8_WAIT_L(n) asm volatile("s_waitcnt lgkmcnt(" #n ")" ::: "memory")
#define PG8_BAR __builtin_amdgcn_s_barrier()
#define PG8_SCHED __builtin_amdgcn_sched_barrier(0)
    Unit cur, nxt; int ui = 0;
    if (!S.next(0, cur)) return;
    f32x4 acc[2][2][4][2];
#pragma unroll
    for (int a = 0; a < 2; ++a)
#pragma unroll
        for (int b = 0; b < 2; ++b)
#pragma unroll
            for (int m = 0; m < 4; ++m)
#pragma unroll
                for (int n = 0; n < 2; ++n) acc[a][b][m][n] = (f32x4){0.f, 0.f, 0.f, 0.f};
    bf16x8 At[4][2], B0[2][2], B1[2][2];
    const char* cA = cur.A; const char* cB = cur.B;
    if constexpr (SP2) {
      PG8_STAGE(PG8_SB(0, 0), cB, voffB); PG8_STAGE(PG8_SB(0, 1), cB + hsB, voffB); PG8_STAGE(PG8_SA(0, 0), cA, voffA); PG8_STAGE(PG8_SA(0, 1), cA + hsA, voffA);
      if (wr == 1) PG8_BAR;
      PG8_WAIT_V(2); PG8_BAR;
      PG8_STAGE(PG8_SB(1, 0), cB + kstep, voffB); PG8_STAGE(PG8_SA(1, 0), cA + kstep, voffA); PG8_STAGE(PG8_SB(1, 1), cB + hsB + kstep, voffB);
      PG8_WAIT_V(6); PG8_BAR;
    } else {
    PG8_STAGE(PG8_SB(0, 0), cB, voffB); PG8_STAGE(PG8_SA(0, 0), cA, voffA); PG8_STAGE(PG8_SB(0, 1), cB + hsB, voffB); PG8_STAGE(PG8_SA(0, 1), cA + hsA, voffA);
    if (wr == 1) PG8_BAR;
    PG8_WAIT_V(4); PG8_BAR;
    PG8_STAGE(PG8_SB(1, 0), cB + kstep, voffB); PG8_STAGE(PG8_SA(1, 0), cA + kstep, voffA); PG8_STAGE(PG8_SB(1, 1), cB + hsB + kstep, voffB);
    PG8_WAIT_V(6); PG8_BAR;
    }
    for (;;) {
        const bool has_next = S.next(ui + 1, nxt);
        const char* nA = has_next ? nxt.A : cA; const char* nB = has_next ? nxt.B : cB;
        for (int t = 0; t < nt; t += 2) {
            const bool last = (t == nt - 2);
            const char* a1 = cA + (size_t)(t + 1) * kstep;
            const char* a2 = last ? nA : cA + (size_t)(t + 2) * kstep; const char* b2 = last ? nB : cB + (size_t)(t + 2) * kstep;
            const char* a3 = a2 + kstep; const char* b3 = b2 + kstep;
            if constexpr (SP2) {
            PG8_LDB(B0, 0, 0); PG8_LDB(B1, 0, 1); PG8_SCHED; PG8_LDA(At, 0, 0); PG8_STAGE(PG8_SA(1, 1), a1 + hsA, voffA);
            PG8_WAIT_V(8); PG8_WAIT_L(0); PG8_BAR; PG8_MMA(0, 0, At, B0); PG8_MMA(0, 1, At, B1); PG8_BAR; PG8_SCHED;
            PG8_LDA(At, 0, 1); PG8_STAGE(PG8_SB(0, 0), b2, voffB); PG8_STAGE(PG8_SB(0, 1), b2 + hsB, voffB); PG8_STAGE(PG8_SA(0, 0), a2, voffA);
            PG8_WAIT_V(8); PG8_WAIT_L(0); PG8_BAR; PG8_MMA(1, 0, At, B0); PG8_MMA(1, 1, At, B1); PG8_BAR; PG8_SCHED;
            PG8_LDB(B0, 1, 0); PG8_LDB(B1, 1, 1); PG8_SCHED; PG8_LDA(At, 1, 0); PG8_STAGE(PG8_SA(0, 1), a2 + hsA, voffA);
            PG8_WAIT_V(8); PG8_WAIT_L(0); PG8_BAR; PG8_MMA(0, 0, At, B0); PG8_MMA(0, 1, At, B1); PG8_BAR; PG8_SCHED;
            PG8_LDA(At, 1, 1); PG8_STAGE(PG8_SB(1, 0), b3, voffB); PG8_STAGE(PG8_SB(1, 1), b3 + hsB, voffB); PG8_STAGE(PG8_SA(1, 0), a3, voffA);
            PG8_WAIT_V(8); PG8_WAIT_L(0); PG8_BAR; PG8_MMA(1, 0, At, B0); PG8_MMA(1, 1, At, B1); PG8_BAR; PG8_SCHED;
            } else {
            PG8_LDB(B0, 0, 0); PG8_SCHED; PG8_LDA(At, 0, 0); PG8_STAGE(PG8_SA(1, 1), a1 + hsA, voffA);
            PG8_WAIT_L(8); PG8_BAR; PG8_WAIT_L(0); PG8_MMA(0, 0, At, B0); PG8_BAR; PG8_SCHED;
            PG8_LDB(B1, 0, 1); PG8_STAGE(PG8_SB(0, 0), b2, voffB);
            PG8_BAR; PG8_WAIT_L(0); PG8_MMA(0, 1, At, B1); PG8_BAR;
            PG8_LDA(At, 0, 1); PG8_STAGE(PG8_SA(0, 0), a2, voffA);
            PG8_BAR; PG8_WAIT_L(0); PG8_MMA(1, 0, At, B0); PG8_BAR; PG8_SCHED;
            PG8_STAGE(PG8_SB(0, 1), b2 + hsB, voffB);
            PG8_WAIT_V(6); PG8_BAR; PG8_MMA(1, 1, At, B1); PG8_BAR;
            PG8_LDB(B0, 1, 0); PG8_SCHED; PG8_LDA(At, 1, 0); PG8_STAGE(PG8_SA(0, 1), a2 + hsA, voffA);
            PG8_WAIT_L(8); PG8_BAR; PG8_WAIT_L(0); PG8_MMA(0, 0, At, B0); PG8_BAR; PG8_SCHED;
            PG8_LDB(B1, 1, 1); PG8_STAGE(PG8_SB(1, 0), b3, voffB);
            PG8_BAR; PG8_WAIT_L(0); PG8_MMA(0, 1, At, B1); PG8_BAR;
            PG8_LDA(At, 1, 1); PG8_STAGE(PG8_SA(1, 0), a3, voffA);
            PG8_BAR; PG8_WAIT_L(0); PG8_MMA(1, 0, At, B0); PG8_BAR; PG8_SCHED;
            PG8_STAGE(PG8_SB(1, 1), b3 + hsB, voffB);
            PG8_WAIT_V(6); PG8_BAR; PG8_MMA(1, 1, At, B1); PG8_BAR;
            }
        }
        if (ALIGN && wr == 0) PG8_BAR;
        { int efr = fr, efq = fq; asm volatile("" : "+v"(efr), "+v"(efq)); E(acc, cur, wr, wc, efr, efq); }
        if (!has_next) break;
#pragma unroll
        for (int a = 0; a < 2; ++a)
#pragma unroll
            for (int b = 0; b < 2; ++b)
#pragma unroll
                for (int m = 0; m < 4; ++m)
#pragma unroll
                    for (int n = 0; n < 2; ++n) acc[a][b][m][n] = (f32x4){0.f, 0.f, 0.f, 0.f};
        cur = nxt; cA = nA; cB = nB; ++ui;
        if (ALIGN && wr == 1) PG8_BAR;
    }
    PG8_WAIT_V(0);
    if (!ALIGN && wr == 0) PG8_BAR;
    PG8_BAR;
#undef PG8_SA
#undef PG8_SB
#undef PG8_STAGE
#undef PG8_LDA
#undef PG8_LDB
#undef PG8_MMA
#undef PG8_WAIT_V
#undef PG8_WAIT_L
#undef PG8_BAR
#undef PG8_SCHED
}

template <bool ALIGN = true, bool SP2 = PG8_SP2, class Epi, class Sched>
__device__ __forceinline__ void gemm_phase_gather(PG8_LAS unsigned char* lds, const GemmG g, const Sched& S, const Epi& E, const char* Abase, const int* rowidx, const unsigned zoff) {
    const int tid = ph_tid(), wid = __builtin_amdgcn_readfirstlane(tid >> 6), lane = tid & 63, wr = wid >> 2, wc = wid & 3, fr = lane & 15, fq = lane >> 4;
    const int K = g.K, nt = K / BK;
    unsigned voffB[2];
#pragma unroll
    for (int i = 0; i < 2; ++i) { int R, C; stage_rc(tid * 16 + i * 8192, R, C); const int Rb = (R & ~31) + perm32(R & 31);
        const int wrow = g.bmode ? (((Rb >> 4) & 1) * DM + 16 * ((Rb >> 5) & 3) + (Rb & 15)) : Rb;
        voffB[i] = (unsigned)(wrow * g.ldb + C) * 2u; }
    unsigned vc0[2], vc1[2], vn0[2], vn1[2];
#define PG8_GOFF(dst0, dst1, u) do { const int _t = ph_tid(); _Pragma("unroll") for (int _i = 0; _i < 2; ++_i) { int _R, _C; stage_rc(_t * 16 + _i * 8192, _R, _C); const int _r0 = rowidx[(u).pm * BM + _R], _r1 = rowidx[(u).pm * BM + HALF + _R]; \
        dst0[_i] = (_r0 >= 0 ? (unsigned)_r0 * (unsigned)(g.lda * 2) : zoff) + (unsigned)_C * 2u; dst1[_i] = (_r1 >= 0 ? (unsigned)_r1 * (unsigned)(g.lda * 2) : zoff) + (unsigned)_C * 2u; } } while (0)
    const size_t kstep = (size_t)(BK * 2);
    const size_t hsB = (size_t)(g.bmode ? 2 * DM : HALF) * g.ldb * 2;
    const unsigned ldsw = (unsigned)wid * 1024u;
    const int aoff = lds_byte(wr * 64 + fr, fq * 8), boff = lds_byte(wc * 32 + fr, fq * 8);
#define PG8_SA(b, h) (((b) * 2 + (h)) * HTB)
#define PG8_SB(b, h) ((4 + (b) * 2 + (h)) * HTB)
#define PG8_STAGE(bufoff, gbase, voff) do { _Pragma("unroll") for (int _i = 0; _i < 2; ++_i) \
        __builtin_amdgcn_global_load_lds((const unsigned*)((const char*)(gbase) + (voff)[_i]), (PG8_LAS unsigned*)(lds + (bufoff) + ldsw + _i * 8192), 16, 0, 0); } while (0)
#define PG8_LDA(dst, b, h) do { _Pragma("unroll") for (int m = 0; m < 4; ++m) _Pragma("unroll") for (int k = 0; k < 2; ++k) dst[m][k] = *(const PG8_LAS bf16x8*)(lds + PG8_SA(b, h) + aoff + m * 2048 + k * 1024); } while (0)
#define PG8_LDB(dst, b, h) do { _Pragma("unroll") for (int n = 0; n < 2; ++n) _Pragma("unroll") for (int k = 0; k < 2; ++k) dst[n][k] = *(const PG8_LAS bf16x8*)(lds + PG8_SB(b, h) + boff + n * 2048 + k * 1024); } while (0)
#define PG8_MMA(ai, bj, At, Bt) do { __builtin_amdgcn_s_setprio(1); _Pragma("unroll") for (int m = 0; m < 4; ++m) _Pragma("unroll") for (int n = 0; n < 2; ++n) _Pragma("unroll") for (int k = 0; k < 2; ++k) \
        acc[ai][bj][m][n] = __builtin_amdgcn_mfma_f32_16x16x32_bf16(Bt[n][k], At[m][k], acc[ai][bj][m][n], 0, 0, 0); __builtin_amdgcn_s_setprio(0); } while (0)
#define PG8_WAIT_V(n) asm volatile("s_waitcnt vmcnt(" #n ")" ::: "memory")
#define PG8_WAIT_L(n) asm volatile("s_waitcnt lgkmcnt(" #n ")" ::: "memory")
#define PG8_BAR __builtin_amdgcn_s_barrier()
#define PG8_SCHED __builtin_amdgcn_sched_barrier(0)
    Unit cur, nxt; int ui = 0;
    if (!S.next(0, cur)) return;
    f32x4 acc[2][2][4][2];
#pragma unroll
    for (int a = 0; a < 2; ++a)
#pragma unroll
        for (int b = 0; b < 2; ++b)
#pragma unroll
            for (int m = 0; m < 4; ++m)
#pragma unroll
                for (int n = 0; n < 2; ++n) acc[a][b][m][n] = (f32x4){0.f, 0.f, 0.f, 0.f};
    bf16x8 At[4][2], B0[2][2], B1[2][2];
    const char* cA = Abase; const char* cB = cur.B;
    PG8_GOFF(vc0, vc1, cur);
    if constexpr (SP2) {
      PG8_STAGE(PG8_SB(0, 0), cB, voffB); PG8_STAGE(PG8_SB(0, 1), cB + hsB, voffB); PG8_STAGE(PG8_SA(0, 0), cA, vc0); PG8_STAGE(PG8_SA(0, 1), cA, vc1);
      if (wr == 1) PG8_BAR;
      PG8_WAIT_V(2); PG8_BAR;
      PG8_STAGE(PG8_SB(1, 0), cB + kstep, voffB); PG8_STAGE(PG8_SA(1, 0), cA + kstep, vc0); PG8_STAGE(PG8_SB(1, 1), cB + hsB + kstep, voffB);
      PG8_WAIT_V(6); PG8_BAR;
    } else {
    PG8_STAGE(PG8_SB(0, 0), cB, voffB); PG8_STAGE(PG8_SA(0, 0), cA, vc0); PG8_STAGE(PG8_SB(0, 1), cB + hsB, voffB); PG8_STAGE(PG8_SA(0, 1), cA, vc1);
    if (wr == 1) PG8_BAR;
    PG8_WAIT_V(4); PG8_BAR;
    PG8_STAGE(PG8_SB(1, 0), cB + kstep, voffB); PG8_STAGE(PG8_SA(1, 0), cA + kstep, vc0); PG8_STAGE(PG8_SB(1, 1), cB + hsB + kstep, voffB);
    PG8_WAIT_V(6); PG8_BAR;
    }
    for (;;) {
        const bool has_next = S.next(ui + 1, nxt);
        const char* nB = has_next ? nxt.B : cB;
        if (has_next) { PG8_GOFF(vn0, vn1, nxt); } else {
#pragma unroll
          for (int _i = 0; _i < 2; ++_i) { vn0[_i] = vc0[_i]; vn1[_i] = vc1[_i]; } }
        for (int t = 0; t < nt; t += 2) {
            const bool last = (t == nt - 2);
            const char* a1 = cA + (size_t)(t + 1) * kstep;
            const char* a2 = last ? cA : cA + (size_t)(t + 2) * kstep; const char* b2 = last ? nB : cB + (size_t)(t + 2) * kstep;
            const char* a3 = a2 + kstep; const char* b3 = b2 + kstep;
            if constexpr (SP2) {
            PG8_LDB(B0, 0, 0); PG8_LDB(B1, 0, 1); PG8_SCHED; PG8_LDA(At, 0, 0); PG8_STAGE(PG8_SA(1, 1), a1, vc1);
            PG8_WAIT_V(8); PG8_WAIT_L(0); PG8_BAR; PG8_MMA(0, 0, At, B0); PG8_MMA(0, 1, At, B1); PG8_BAR; PG8_SCHED;
            PG8_LDA(At, 0, 1); PG8_STAGE(PG8_SB(0, 0), b2, voffB); PG8_STAGE(PG8_SB(0, 1), b2 + hsB, voffB); if (last) PG8_STAGE(PG8_SA(0, 0), a2, vn0); else PG8_STAGE(PG8_SA(0, 0), a2, vc0);
            PG8_WAIT_V(8); PG8_WAIT_L(0); PG8_BAR; PG8_MMA(1, 0, At, B0); PG8_MMA(1, 1, At, B1); PG8_BAR; PG8_SCHED;
            PG8_LDB(B0, 1, 0); PG8_LDB(B1, 1, 1); PG8_SCHED; PG8_LDA(At, 1, 0); if (last) PG8_STAGE(PG8_SA(0, 1), a2, vn1); else PG8_STAGE(PG8_SA(0, 1), a2, vc1);
            PG8_WAIT_V(8); PG8_WAIT_L(0); PG8_BAR; PG8_MMA(0, 0, At, B0); PG8_MMA(0, 1, At, B1); PG8_BAR; PG8_SCHED;
            PG8_LDA(At, 1, 1); PG8_STAGE(PG8_SB(1, 0), b3, voffB); PG8_STAGE(PG8_SB(1, 1), b3 + hsB, voffB); if (last) PG8_STAGE(PG8_SA(1, 0), a3, vn0); else PG8_STAGE(PG8_SA(1, 0), a3, vc0);
            PG8_WAIT_V(8); PG8_WAIT_L(0); PG8_BAR; PG8_MMA(1, 0, At, B0); PG8_MMA(1, 1, At, B1); PG8_BAR; PG8_SCHED;
            } else {
            PG8_LDB(B0, 0, 0); PG8_SCHED; PG8_LDA(At, 0, 0); PG8_STAGE(PG8_SA(1, 1), a1, vc1);
            PG8_WAIT_L(8); PG8_BAR; PG8_WAIT_L(0); PG8_MMA(0, 0, At, B0); PG8_BAR; PG8_SCHED;
            PG8_LDB(B1, 0, 1); PG8_STAGE(PG8_SB(0, 0), b2, voffB);
            PG8_BAR; PG8_WAIT_L(0); PG8_MMA(0, 1, At, B1); PG8_BAR;
            PG8_LDA(At, 0, 1); if (last) PG8_STAGE(PG8_SA(0, 0), a2, vn0); else PG8_STAGE(PG8_SA(0, 0), a2, vc0);
            PG8_BAR; PG8_WAIT_L(0); PG8_MMA(1, 0, At, B0); PG8_BAR; PG8_SCHED;
            PG8_STAGE(PG8_SB(0, 1), b2 + hsB, voffB);
            PG8_WAIT_V(6); PG8_BAR; PG8_MMA(1, 1, At, B1); PG8_BAR;
            PG8_LDB(B0, 1, 0); PG8_SCHED; PG8_LDA(At, 1, 0); if (last) PG8_STAGE(PG8_SA(0, 1), a2, vn1); else PG8_STAGE(PG8_SA(0, 1), a2, vc1);
            PG8_WAIT_L(8); PG8_BAR; PG8_WAIT_L(0); PG8_MMA(0, 0, At, B0); PG8_BAR; PG8_SCHED;
            PG8_LDB(B1, 1, 1); PG8_STAGE(PG8_SB(1, 0), b3, voffB);
            PG8_BAR; PG8_WAIT_L(0); PG8_MMA(0, 1, At, B1); PG8_BAR;
            PG8_LDA(At, 1, 1); if (last) PG8_STAGE(PG8_SA(1, 0), a3, vn0); else PG8_STAGE(PG8_SA(1, 0), a3, vc0);
            PG8_BAR; PG8_WAIT_L(0); PG8_MMA(1, 0, At, B0); PG8_BAR; PG8_SCHED;
            PG8_STAGE(PG8_SB(1, 1), b3 + hsB, voffB);
            PG8_WAIT_V(6); PG8_BAR; PG8_MMA(1, 1, At, B1); PG8_BAR;
            }
        }
        if (ALIGN && wr == 0) PG8_BAR;
        { int efr = fr, efq = fq; asm volatile("" : "+v"(efr), "+v"(efq)); E(acc, cur, wr, wc, efr, efq); }
        if (!has_next) break;
#pragma unroll
        for (int a = 0; a < 2; ++a)
#pragma unroll
            for (int b = 0; b < 2; ++b)
#pragma unroll
                for (int m = 0; m < 4; ++m)
#pragma unroll
                    for (int n = 0; n < 2; ++n) acc[a][b][m][n] = (f32x4){0.f, 0.f, 0.f, 0.f};
        cur = nxt; cB = nB; ++ui;
#pragma unroll
        for (int _i = 0; _i < 2; ++_i) { vc0[_i] = vn0[_i]; vc1[_i] = vn1[_i]; }
        if (ALIGN && wr == 1) PG8_BAR;
    }
    PG8_WAIT_V(0);
    if (!ALIGN && wr == 0) PG8_BAR;
    PG8_BAR;
#undef PG8_GOFF
#undef PG8_SA
#undef PG8_SB
#undef PG8_STAGE
#undef PG8_LDA
#undef PG8_LDB
#undef PG8_MMA
#undef PG8_WAIT_V
#undef PG8_WAIT_L
#undef PG8_BAR
#undef PG8_SCHED
}

struct SchedGrid {
  const char* A; const char* B; int lda, ldb, nM, nN, skip_ctx, G, c, pad;
  __device__ __forceinline__ bool next(int i, Unit& u) const {
    int pm, pn; if (!tile_order((long)i * G + c, nM, nN, pm, pn)) return false;
    if (skip_ctx && pm >= NTOK / 256 - 1) pm += 1;
    u.pm = pm; u.pn = pn; u.aux = 0; u.A = A + (size_t)pm * BM * lda * 2; u.B = B + (size_t)pn * BM * ldb * 2; return true; }
};
struct SchedProj {
  const char* OA; const char* B; int nM, skip_ctx, G, c;
  __device__ __forceinline__ bool next(int i, Unit& u) const {
    int pm, pn; if (!tile_order((long)i * G + c, nM, 4 * DM / 256, pm, pn)) return false;
    if (skip_ctx && pm >= NTOK / 256 - 1) pm += 1;
    const int k = pn / (DM / 256);
    u.pm = pm; u.pn = pn; u.aux = k; u.A = OA + ((size_t)pm * BM * DM + (size_t)k * BW) * 2; u.B = B + (size_t)pn * BM * BW * 2; return true; }
};
struct SchedGate {
  const char* H; const char* B; int nM, skip_ctx, G, c;
  __device__ __forceinline__ bool next(int i, Unit& u) const {
    const int j = i >> 2, k = i & 3; int pm, pd; if (!tile_order((long)j * G + c, nM, DM / 256, pm, pd)) return false;
    if (skip_ctx && pm >= NTOK / 256 - 1) pm += 1;
    u.pm = pm; u.pn = pd; u.aux = k; u.A = H + (size_t)pm * BM * DM * 2; u.B = B + ((size_t)k * DM + (size_t)pd * BM) * DM * 2; return true; }
};
struct SchedMoe {
  const char* A; const char* B; int lda, ldb, nMl, nN; size_t wstride; int G, c, xcd, pad;
  __device__ __forceinline__ bool next(int i, Unit& u) const {
    int e, rem; const int per_e = nMl * nN;
    if (xcd) { const int x = c & 7, idx = c >> 3, wpx = G >> 3, j = i * wpx + idx; if (j >= (NE / 8) * per_e) return false; e = x + 8 * (j / per_e); rem = j % per_e; }
    else { const long L = (long)i * G + c; if (L >= (long)NE * per_e) return false; e = (int)(L / per_e); rem = (int)(L % per_e); }
    const int pn = rem / nMl, pml = rem % nMl;
    u.pm = e * (XEP / 256) + pml; u.pn = pn; u.aux = e; u.A = A + (size_t)u.pm * BM * lda * 2; u.B = B + (size_t)e * wstride + (size_t)pn * BM * ldb * 2; return true; }
};

#define EPI_LOOP(...) _Pragma("unroll") for (int ai = 0; ai < 2; ++ai) _Pragma("unroll") for (int m = 0; m < 4; ++m) { const int trow = ai * HALF + wr * 64 + m * 16 + fr; \
    _Pragma("unroll") for (int bj = 0; bj < 2; ++bj) { const int tcol = bj * HALF + wc * 32 + 8 * fq; const f32x4 v0 = acc[ai][bj][m][0], v1 = acc[ai][bj][m][1]; __VA_ARGS__ } }
typedef f32x4 AccT[2][2][4][2];
struct EpiBf16 { bf16_t* O; int ldc, pad;
  __device__ __forceinline__ void operator()(const AccT& acc, const Unit& u, int wr, int wc, int fr, int fq) const {
    bf16_t* base = O + (size_t)u.pm * BM * ldc + (size_t)u.pn * BM;
    EPI_LOOP(st_out((u32x4*)(base + (size_t)trow * ldc + tcol), pack8(v0, v1));) } };
struct EpiF32 { float* O; int ldc, pad;
  __device__ __forceinline__ void operator()(const AccT& acc, const Unit& u, int wr, int wc, int fr, int fq) const {
    float* base = O + (size_t)u.pm * BM * ldc + (size_t)u.pn * BM;
    EPI_LOOP(float* q = base + (size_t)trow * ldc + tcol; st_out((f32x4*)q, v0); st_out((f32x4*)(q + 4), v1);) } };
struct EpiKVm { bf16_t* KM; bf16_t* VM;
  __device__ __forceinline__ void operator()(const AccT& acc, const Unit& u, int wr, int wc, int fr, int fq) const {
    bf16_t* kb = KM + (size_t)u.pm * BM * (MH * MQK) + u.pn * MQK; bf16_t* vb = VM + (size_t)u.pm * BM * (MH * MV) + u.pn * MV;
    EPI_LOOP(bf16_t* q = (bj == 0) ? kb + trow * (MH * MQK) + tcol : vb + trow * (MH * MV) + (tcol - HALF); *(u32x4*)q = pack8(v0, v1);) } };
struct EpiGluO { const bf16_t* Z; bf16_t* O;
  __device__ __forceinline__ void operator()(const AccT& acc, const Unit& u, int wr, int wc, int fr, int fq) const {
    EPI_LOOP(const size_t row = (size_t)u.pm * BM + trow; const int col = u.pn * BM + tcol; f32x4 z0, z1; unpack8(*(const u32x4*)(Z + row * BW + col), z0, z1);
             *(u32x4*)(O + row * DM + col) = pack8(z0 * sigmoid4(v0), z1 * sigmoid4(v1));) } };
struct EpiGateMerge { const float* bg; const bf16_t* PROJ; float* MACC; bf16_t* MG;
  __device__ __forceinline__ void operator()(const AccT& acc, const Unit& u, int wr, int wc, int fr, int fq) const {
    const int k = u.aux; const bf16_t* pb = PROJ + (size_t)u.pm * BM * (4 * DM) + k * DM + u.pn * BM; float* mb = MACC + (size_t)u.pm * BM * DM + u.pn * BM; bf16_t* gb = MG + (size_t)u.pm * BM * DM + u.pn * BM;
    const float* bp0 = bg + k * DM + u.pn * BM;
#pragma unroll
    for (int ai = 0; ai < 2; ++ai)
#pragma unroll
      for (int bj = 0; bj < 2; ++bj) { const int tcol = bj * HALF + wc * 32 + 8 * fq; u32x4 pj[4]; f32x4 m0[4], m1[4];
#pragma unroll
        for (int m = 0; m < 4; ++m) { const int trow = ai * HALF + wr * 64 + m * 16 + fr; pj[m] = *(const u32x4*)(pb + trow * (4 * DM) + tcol);
          if (k > 0) { m0[m] = *(const f32x4*)(mb + trow * DM + tcol); m1[m] = *(const f32x4*)(mb + trow * DM + tcol + 4); } }
        const f32x4 b0 = *(const f32x4*)(bp0 + tcol), b1 = *(const f32x4*)(bp0 + tcol + 4);
#pragma unroll
        for (int m = 0; m < 4; ++m) { const int trow = ai * HALF + wr * 64 + m * 16 + fr; f32x4 p0, p1; unpack8(pj[m], p0, p1);
          f32x4 r0 = sigmoid4(acc[ai][bj][m][0] + b0) * p0, r1 = sigmoid4(acc[ai][bj][m][1] + b1) * p1;
          if (k > 0) { r0 += m0[m]; r1 += m1[m]; }
          if (k < 3) { *(f32x4*)(mb + trow * DM + tcol) = r0; *(f32x4*)(mb + trow * DM + tcol + 4) = r1; } else *(u32x4*)(gb + trow * DM + tcol) = pack8(r0, r1); } } } };
struct EpiSwiGlu { bf16_t* ACT;
  __device__ __forceinline__ void operator()(const AccT& acc, const Unit& u, int wr, int wc, int fr, int fq) const {
#pragma unroll
    for (int ai = 0; ai < 2; ++ai)
#pragma unroll
      for (int m = 0; m < 4; ++m) { const size_t row = (size_t)u.pm * BM + ai * HALF + wr * 64 + m * 16 + fr; const int col = u.pn * HALF + wc * 32 + 8 * fq;
        const f32x4 g0 = acc[ai][0][m][0], g1 = acc[ai][0][m][1], u0 = acc[ai][1][m][0], u1 = acc[ai][1][m][1];
        st_out((u32x4*)(ACT + row * FF + col), pack8(g0 * sigmoid4(g0) * u0, g1 * sigmoid4(g1) * u1)); } } };
struct EpiDownG { const float* GV; bf16_t* YS;
  __device__ __forceinline__ void operator()(const AccT& acc, const Unit& u, int wr, int wc, int fr, int fq) const {
    EPI_LOOP(const size_t row = (size_t)u.pm * BM + trow; const float gv = GV[row]; *(u32x4*)(YS + row * DM + u.pn * BM + tcol) = pack8(v0 * gv, v1 * gv);) } };

struct SchedS5 { const char* UH; const char* W; size_t wstride; int G, c;
  __device__ __forceinline__ bool next(int i, Unit& u) const {
    const long L = (long)i * G + c; if (L >= (long)S5G * (S5NP / 256)) return false; const int g = (int)(L / (S5NP / 256)), pm = (int)(L % (S5NP / 256));
    u.pm = pm; u.pn = 0; u.aux = g; u.A = UH + ((size_t)g * S5NP + (size_t)pm * BM) * (S5K1 + S5K2) * 2; u.B = W + (size_t)g * wstride; return true; }
};
struct EpiS5E { float* E;
  __device__ __forceinline__ void operator()(const AccT& acc, const Unit& u, int wr, int wc, int fr, int fq) const {
    float* base = E + ((size_t)u.aux * S5NP + (size_t)u.pm * BM) * S5K2;
    EPI_LOOP(float* q = base + (size_t)trow * S5K2 + tcol; *(f32x4*)q = v0; *(f32x4*)(q + 4) = v1;) } };
__device__ __forceinline__ float fast_gelu_tanh(float x) { const float t = 0.7978845608028654f * (x + 0.044715f * x * x * x); const float e = __builtin_amdgcn_exp2f(2.885390081777927f * t);
  return 0.5f * x * (2.f - 2.f * __builtin_amdgcn_rcpf(e + 1.f)); }
struct EpiS5Y { const bf16_t* P; const float* D; bf16_t* Z; int last, pad;
  __device__ __forceinline__ void operator()(const AccT& acc, const Unit& u, int wr, int wc, int fr, int fq) const {
    const int g = u.aux;
#pragma unroll
    for (int ai = 0; ai < 2; ++ai) { u32x4 uu[4][2]; bool ok[4]; long Rr[4];
#pragma unroll
      for (int m = 0; m < 4; ++m) { const int n = u.pm * BM + ai * HALF + wr * 64 + m * 16 + fr; const int b = n / S5NC, j = n % S5NC; ok[m] = n < S5NN && !(last && j >= SEQ / S5LC);
#pragma unroll
        for (int bj = 0; bj < 2; ++bj) { const int tcol = bj * HALF + wc * 32 + 8 * fq, a = tcol >> 4, i0 = tcol & 15; const long R = (long)b * NTOK + j * S5LC + a; if (bj == 0) Rr[m] = R - a;
          uu[m][bj] = ok[m] ? *(const u32x4*)(P + R * PW + OFF_U + g * S5CH + i0) : (u32x4){0u, 0u, 0u, 0u}; } }
#pragma unroll
      for (int bj = 0; bj < 2; ++bj) { const int tcol = bj * HALF + wc * 32 + 8 * fq, a = tcol >> 4, i0 = tcol & 15; const float* dp = D + g * S5CH + i0; const f32x4 d0 = *(const f32x4*)dp, d1 = *(const f32x4*)(dp + 4);
#pragma unroll
        for (int m = 0; m < 4; ++m) if (ok[m]) { f32x4 u0, u1; unpack8(uu[m][bj], u0, u1); f32x4 y0 = acc[ai][bj][m][0] + d0 * u0, y1 = acc[ai][bj][m][1] + d1 * u1;
#pragma unroll
          for (int q = 0; q < 4; ++q) { y0[q] = fast_gelu_tanh(y0[q]); y1[q] = fast_gelu_tanh(y1[q]); }
          *(u32x4*)(Z + (Rr[m] + a) * BW + g * S5CH + i0) = pack8(y0, y1); } } } } };
struct SchedGateCtx { const char* H; const char* B; int G, c;
  __device__ __forceinline__ bool next(int i, Unit& u) const {
    const int L = i * G + c; if (L >= 2 * (4 * DM / BM)) return false; const int ct = L / (4 * DM / BM), pn = L % (4 * DM / BM), pm = ct * (NTOK / BM) + SEQ / BM;
    u.pm = pm; u.pn = pn; u.aux = ct; u.A = H + (size_t)pm * BM * DM * 2; u.B = B + (size_t)pn * BM * DM * 2; return true; }
};
struct EpiGateCtx { const float* bg; bf16_t* GC;
  __device__ __forceinline__ void operator()(const AccT& acc, const Unit& u, int wr, int wc, int fr, int fq) const {
    bf16_t* base = GC + (size_t)u.aux * BM * (4 * DM) + u.pn * BM; const float* bp = bg + u.pn * BM;
    EPI_LOOP(*(u32x4*)(base + trow * (4 * DM) + tcol) = pack8(sigmoid4(v0 + *(const f32x4*)(bp + tcol)), sigmoid4(v1 + *(const f32x4*)(bp + tcol + 4)));) } };
struct SchedProjW { const char* OA; const char* B; int nM, skip_ctx, G, c, nA, ua, ub, pad;
  __device__ __forceinline__ bool next(int i, Unit& u) const {
    long L; if (c < nA) { if (i >= ua) return false; L = (long)c * ua + i; } else { if (i >= ub) return false; L = (long)nA * ua + (long)(c - nA) * ub + i; }
    int pm, pn; if (!tile_order(L, nM, 4 * DM / 256, pm, pn)) return false;
    if (skip_ctx && pm >= NTOK / 256 - 1) pm += 1;
    const int k = pn / (DM / 256);
    u.pm = pm; u.pn = pn; u.aux = k; u.A = OA + ((size_t)pm * BM * DM + (size_t)k * BW) * 2; u.B = B + (size_t)pn * BM * BW * 2; return true; }
};

struct SchedGate4 { const char* H; const char* B; int G, c;
  __device__ __forceinline__ bool next(int i, Unit& u) const {
    int pm, pd; if (!tile_order((long)i * G + c, MROWS / BM - 2, DM / 64, pm, pd)) return false;
    if (pm >= NTOK / BM - 1) pm += 1;
    u.pm = pm; u.pn = pd; u.aux = 0; u.A = H + (size_t)pm * BM * DM * 2; u.B = B + (size_t)pd * 64 * DM * 2; return true; }
};
struct EpiGate4 { const float* bg; const bf16_t* PROJ; bf16_t* MG;
  __device__ __forceinline__ void operator()(const AccT& acc, const Unit& u, int wr, int wc, int fr, int fq) const {
    const int kb = fq >> 1, d0 = u.pn * 64 + 16 * wc + 8 * (fq & 1); const bf16_t* pb = PROJ + (size_t)u.pm * BM * (4 * DM) + kb * DM + d0; bf16_t* gb = MG + (size_t)u.pm * BM * DM + d0;
    const float* bp = bg + kb * DM + d0; const f32x4 b00 = *(const f32x4*)bp, b01 = *(const f32x4*)(bp + 4), b10 = *(const f32x4*)(bp + 2 * DM), b11 = *(const f32x4*)(bp + 2 * DM + 4);
    u32x4 p0[2][4], p1[2][4];
#pragma unroll
    for (int ai = 0; ai < 2; ++ai)
#pragma unroll
      for (int m = 0; m < 4; ++m) { const int trow = ai * HALF + wr * 64 + m * 16 + fr; p0[ai][m] = *(const u32x4*)(pb + trow * (4 * DM)); p1[ai][m] = *(const u32x4*)(pb + trow * (4 * DM) + 2 * DM); }
#pragma unroll
    for (int ai = 0; ai < 2; ++ai)
#pragma unroll
      for (int m = 0; m < 4; ++m) { const int trow = ai * HALF + wr * 64 + m * 16 + fr; f32x4 q0, q1, q2, q3; unpack8(p0[ai][m], q0, q1); unpack8(p1[ai][m], q2, q3);
        f32x4 r0 = sigmoid4(acc[ai][0][m][0] + b00) * q0 + sigmoid4(acc[ai][1][m][0] + b10) * q2, r1 = sigmoid4(acc[ai][0][m][1] + b01) * q1 + sigmoid4(acc[ai][1][m][1] + b11) * q3;
#pragma unroll
        for (int j = 0; j < 4; ++j) { r0[j] += __shfl_xor(r0[j], 32); r1[j] += __shfl_xor(r1[j], 32); }
        if (kb == 0) st_out((u32x4*)(gb + trow * DM), pack8(r0, r1)); } } };

struct SchedKR { const char* H; const char* B; int G, c;
  __device__ __forceinline__ bool next(int i, Unit& u) const {
    const int L = i * G + c; if (L >= MROWS / BM) return false;
    u.pm = L; u.pn = PW / BM - 1; u.aux = 0; u.A = H + (size_t)L * BM * DM * 2; u.B = B + (size_t)(PW / BM - 1) * BM * DM * 2; return true; }
};
struct EpiKR { bf16_t* KM; const float* tb;
  __device__ __forceinline__ void operator()(const AccT& acc, const Unit& u, int wr, int wc, int fr, int fq) const {
    static_assert(IN_TOTAL - OFF_KR == 64 && OFF_KR == (PW / BM - 1) * BM, "rope key = first 64 columns of the last column tile");
    if (wc >= 2) return;
    const bool lat_tile = (u.pm % (NTOK / BM)) < SEQ / BM; const int t0 = (u.pm % (NTOK / BM)) * BM; bf16_t* base = KM + (size_t)u.pm * BM * (MH * MQK) + MNOPE + wc * 32 + 8 * fq;
#pragma unroll
    for (int ai = 0; ai < 2; ++ai)
#pragma unroll
      for (int m = 0; m < 4; ++m) { const int trow = ai * HALF + wr * 64 + m * 16 + fr; f32x4 a = acc[ai][0][m][0], b2 = acc[ai][0][m][1];
        if (lat_tile) { const int t = t0 + trow; const float* cs = tb + ((wc ? t % GRIDW : t / GRIDW) * NROPE_B + ((8 * fq) & 15)) * 2;
#pragma unroll
          for (int j = 0; j < 4; ++j) { const float oa = __shfl_xor(a[j], 32), ob = __shfl_xor(b2[j], 32); const float ca = cs[2 * j], sa = cs[2 * j + 1], cb = cs[8 + 2 * j], sb = cs[8 + 2 * j + 1];
            a[j] = a[j] * ca + (fq < 2 ? -oa : oa) * sa; b2[j] = b2[j] * cb + (fq < 2 ? -ob : ob) * sb; } }
        const u32x4 w = pack8(a, b2);
#pragma unroll
        for (int h = 0; h < MH; ++h) *(u32x4*)(base + trow * (MH * MQK) + h * MQK) = w; } } };

struct SchedKR2 { const char* H; const char* B; int G, c;
  __device__ __forceinline__ bool next(int i, Unit& u) const {
    const int L = i * G + c; if (L >= 2 * (MROWS / BM)) return false; const int pm = L >> 1, kh = L & 1;
    u.pm = pm; u.pn = PW / BM - 1; u.aux = kh; u.A = H + ((size_t)pm * BM * DM + (size_t)kh * (DM / 2)) * 2; u.B = B + ((size_t)(PW / BM - 1) * BM * DM + (size_t)kh * (DM / 2)) * 2; return true; }
};
struct EpiKRpart { float* KRP;
  __device__ __forceinline__ void operator()(const AccT& acc, const Unit& u, int wr, int wc, int fr, int fq) const {
    if (wc >= 2) return;
    float* base = KRP + ((size_t)u.aux * MROWS + (size_t)u.pm * BM) * MROPE + wc * 32 + 8 * fq;
#pragma unroll
    for (int ai = 0; ai < 2; ++ai)
#pragma unroll
      for (int m = 0; m < 4; ++m) { const int trow = ai * HALF + wr * 64 + m * 16 + fr; float* q = base + trow * MROPE; *(f32x4*)q = acc[ai][0][m][0]; *(f32x4*)(q + 4) = acc[ai][0][m][1]; } } };

struct SchedOutCtx { const char* MG; const char* B; int G, c;
  __device__ __forceinline__ bool next(int i, Unit& u) const {
    const int L = i * G + c; if (L >= 2 * (DM / BM) * 4) return false; const int kq = L & 3, pn = (L >> 2) % (DM / BM), ct = L / (4 * (DM / BM)), pm = ct * (NTOK / BM) + SEQ / BM;
    u.pm = ct; u.pn = pn; u.aux = kq; u.A = MG + ((size_t)pm * BM * DM + (size_t)kq * (DM / 4)) * 2; u.B = B + ((size_t)pn * BM * DM + (size_t)kq * (DM / 4)) * 2; return true; }
};
struct EpiSlab { float* Y;
  __device__ __forceinline__ void operator()(const AccT& acc, const Unit& u, int wr, int wc, int fr, int fq) const {
    float* base = Y + ((size_t)u.aux * NB * CTXL + (size_t)u.pm * BM) * DM + u.pn * BM;
    EPI_LOOP(float* q = base + (size_t)trow * DM + tcol; *(f32x4*)q = v0; *(f32x4*)(q + 4) = v1;) } };
struct EpiQM { bf16_t* QM; const float* tb;
  __device__ __forceinline__ void operator()(const AccT& acc, const Unit& u, int wr, int wc, int fr, int fq) const {
    const bool lat_tile = (u.pm % (NTOK / BM)) < SEQ / BM; bf16_t* base = QM + (size_t)u.pm * BM * (MH * MQK) + u.pn * BM; const int t0 = (u.pm % (NTOK / BM)) * BM;
    EPI_LOOP(const int cr = (u.pn * BM + tcol) % MQK; f32x4 a = v0, b2 = v1;
      if (cr >= MNOPE && lat_tile) { const int t = t0 + trow, hf = (cr - MNOPE) >> 5, off = (cr - MNOPE) & 31; const float* cs = tb + (((hf ? t % GRIDW : t / GRIDW)) * NROPE_B + (off & 15)) * 2;
        _Pragma("unroll") for (int j = 0; j < 4; ++j) { const float oa = __shfl_xor(a[j], 32), ob = __shfl_xor(b2[j], 32); const float ca = cs[2 * j], sa = cs[2 * j + 1], cb = cs[8 + 2 * j], sb = cs[8 + 2 * j + 1];
          a[j] = a[j] * ca + (fq < 2 ? -oa : oa) * sa; b2[j] = b2[j] * cb + (fq < 2 ? -ob : ob) * sb; } }
      *(u32x4*)(base + trow * (MH * MQK) + tcol) = pack8(a, b2);) } };
}

template <class Epi, class Sched> __global__ __launch_bounds__(512, 2) void k_gemm_phase(pg8::GemmG g, Sched S, Epi E) {
  extern __shared__ __attribute__((aligned(16))) unsigned char shm[];
  S.G = gridDim.x; S.c = blockIdx.x;
  pg8::gemm_phase<Epi, Sched>((PG8_LAS unsigned char*)shm, g, S, E);
}
#endif
#ifndef CPU_TEST
namespace ph {
using pg8::f32x4; using pg8::u32x4; using pg8::pack8; using pg8::unpack8;
#define LAS __attribute__((address_space(3)))
__device__ __forceinline__ float wave_sum(float v) { v += __shfl_xor(v, 32); v += __shfl_xor(v, 16); v += __shfl_xor(v, 8); v += __shfl_xor(v, 4); v += __shfl_xor(v, 2); v += __shfl_xor(v, 1); return v; }
__device__ __forceinline__ float wave_max(float v) { v = fmaxf(v, __shfl_xor(v, 32)); v = fmaxf(v, __shfl_xor(v, 16)); v = fmaxf(v, __shfl_xor(v, 8)); v = fmaxf(v, __shfl_xor(v, 4)); v = fmaxf(v, __shfl_xor(v, 2)); v = fmaxf(v, __shfl_xor(v, 1)); return v; }
__device__ __forceinline__ float sum8(const f32x4& a, const f32x4& b) { return ((a[0] + a[1]) + (a[2] + a[3])) + ((b[0] + b[1]) + (b[2] + b[3])); }
__device__ __forceinline__ const float* resid_row(const Params& p, int l, int R) {
  const int b = row_b(R), t = row_t(R); return t < SEQ ? p.in[I_X] + ((long)b * SEQ + t) * DM : p.in[I_CTX] + ((long)b * CTXL + (t - SEQ)) * DM;
}

constexpr int NCH = DM / 512;
static_assert(DM % 512 == 0, "row chunking");
struct RowV { f32x4 a[NCH], b[NCH]; };
__device__ __forceinline__ void row_load(RowV& v, const float* x, int lane) {
#pragma unroll
  for (int c = 0; c < NCH; ++c) { const float* q = x + c * 512 + lane * 8; v.a[c] = *(const f32x4*)q; v.b[c] = *(const f32x4*)(q + 4); } }
__device__ __forceinline__ void row_store(const RowV& v, float* x, int lane) {
#pragma unroll
  for (int c = 0; c < NCH; ++c) { float* q = x + c * 512 + lane * 8; *(f32x4*)q = v.a[c]; *(f32x4*)(q + 4) = v.b[c]; } }
__device__ __forceinline__ void row_load_nt(RowV& v, const float* x, int lane) {
#pragma unroll
  for (int c = 0; c < NCH; ++c) { const float* q = x + c * 512 + lane * 8; v.a[c] = __builtin_nontemporal_load((const f32x4*)q); v.b[c] = __builtin_nontemporal_load((const f32x4*)(q + 4)); } }
__device__ __forceinline__ void row_load_bf_nt(RowV& v, const bf16_t* x, int lane) {
#pragma unroll
  for (int c = 0; c < NCH; ++c) unpack8(__builtin_nontemporal_load((const u32x4*)(x + c * 512 + lane * 8)), v.a[c], v.b[c]); }
__device__ __forceinline__ void row_store_bf_nt(const RowV& v, bf16_t* x, int lane) {
#pragma unroll
  for (int c = 0; c < NCH; ++c) __builtin_nontemporal_store(pack8(v.a[c], v.b[c]), (u32x4*)(x + c * 512 + lane * 8)); }
__device__ __forceinline__ void row_load_bf(RowV& v, const bf16_t* x, int lane) {
#pragma unroll
  for (int c = 0; c < NCH; ++c) unpack8(*(const u32x4*)(x + c * 512 + lane * 8), v.a[c], v.b[c]); }
__device__ __forceinline__ void row_store_bf(const RowV& v, bf16_t* x, int lane) {
#pragma unroll
  for (int c = 0; c < NCH; ++c) *(u32x4*)(x + c * 512 + lane * 8) = pack8(v.a[c], v.b[c]); }
__device__ __forceinline__ void resid_load(RowV& v, const Params& p, int l, int R, int lane) {
  if (l == 0) row_load_nt(v, resid_row(p, l, R), lane); else row_load_bf_nt(v, WSP(bf16_t, p, x2) + (long)R * DM, lane);
}
__device__ __forceinline__ void row_stats(const RowV& v, float& mean, float& rstd) {
  float s = 0.f;
#pragma unroll
  for (int c = 0; c < NCH; ++c) s += sum8(v.a[c], v.b[c]);
  mean = wave_sum(s) * (1.f / DM); float q = 0.f;
#pragma unroll
  for (int c = 0; c < NCH; ++c) { const f32x4 da = v.a[c] - mean, db = v.b[c] - mean; q += sum8(da * da, db * db); }
  rstd = 1.f / sqrtf(wave_sum(q) * (1.f / DM) + NORM_EPS);
}
__device__ __forceinline__ void row_modulate_store(const RowV& v, float mean, float rstd, const float* sh, const float* sc, bf16_t* H, int lane) {
#pragma unroll
  for (int c = 0; c < NCH; ++c) { const int o = c * 512 + lane * 8; const f32x4 s0 = *(const f32x4*)(sc + o), s1 = *(const f32x4*)(sc + o + 4), h0 = *(const f32x4*)(sh + o), h1 = *(const f32x4*)(sh + o + 4);
    *(u32x4*)(H + o) = pack8((v.a[c] - mean) * rstd * (1.f + s0) + h0, (v.b[c] - mean) * rstd * (1.f + s1) + h1); } }

__device__ __forceinline__ void ph_ln_in(const Params& p, int l) {
  const int tid_ = ph_tid(), lane = tid_ & 63, wv = tid_ >> 6; const float* mod = WSP(float, p, mod) + (long)l * 18 * DM; bf16_t* H1 = WSP(bf16_t, p, h1);
  for (int R = blockIdx.x * 8 + wv; R < MROWS; R += gridDim.x * 8) { RowV v; resid_load(v, p, l, R, lane); float mean, rstd; row_stats(v, mean, rstd);
    const float* m = mod + (long)row_mod(R) * 6 * DM; row_modulate_store(v, mean, rstd, m, m + DM, H1 + (long)R * DM, lane); }
}
__device__ __forceinline__ void ph_ln1(const Params& p, int l, LAS unsigned char* lds) {
  const int tid_ = ph_tid(), lane = tid_ & 63, wv = tid_ >> 6; const float* mod = WSP(float, p, mod) + (long)l * 18 * DM; const int last = (l == NLAYER - 1);
  LAS float* rwt = (LAS float*)lds;
  { const float* rw = p.in[I_ROUTER] + (long)l * DM * NE; for (int i = tid_; i < DM * NE; i += 512) { const int e = i / DM, d = i % DM; rwt[i] = rw[d * NE + e]; } }
  __syncthreads();
  const bf16_t* Y = WSP(bf16_t, p, macc); bf16_t* X1 = WSP(bf16_t, p, x1); bf16_t* H2 = WSP(bf16_t, p, h2); float* AFF = WSP(float, p, aff);
  const float* lg = p.in[I_LN1G] + l * DM; const float* lb = p.in[I_LN1B] + l * DM;
  for (int R = blockIdx.x * 8 + wv; R < MROWS; R += gridDim.x * 8) { if (last && row_is_ctx(R)) continue;
    const float* m = mod + (long)row_mod(R) * 6 * DM; RowV v, y; resid_load(v, p, l, R, lane);
#pragma unroll
    for (int c = 0; c < NCH; ++c) unpack8(__builtin_nontemporal_load((const u32x4*)(Y + (long)R * DM + c * 512 + lane * 8)), y.a[c], y.b[c]);
#pragma unroll
    for (int c = 0; c < NCH; ++c) { const int o = c * 512 + lane * 8; v.a[c] = DN_ALPHA * v.a[c] + *(const f32x4*)(m + 2 * DM + o) * y.a[c]; v.b[c] = DN_ALPHA * v.b[c] + *(const f32x4*)(m + 2 * DM + o + 4) * y.b[c]; }
    float mean, rstd; row_stats(v, mean, rstd);
#pragma unroll
    for (int c = 0; c < NCH; ++c) { const int o = c * 512 + lane * 8; v.a[c] = (v.a[c] - mean) * rstd * *(const f32x4*)(lg + o) + *(const f32x4*)(lb + o); v.b[c] = (v.b[c] - mean) * rstd * *(const f32x4*)(lg + o + 4) + *(const f32x4*)(lb + o + 4); }
    row_store_bf_nt(v, X1 + (long)R * DM, lane);
    row_stats(v, mean, rstd);
#pragma unroll
    for (int c = 0; c < NCH; ++c) { const int o = c * 512 + lane * 8; v.a[c] = (v.a[c] - mean) * rstd * (1.f + *(const f32x4*)(m + 4 * DM + o)) + *(const f32x4*)(m + 3 * DM + o);
      v.b[c] = (v.b[c] - mean) * rstd * (1.f + *(const f32x4*)(m + 4 * DM + o + 4)) + *(const f32x4*)(m + 3 * DM + o + 4); *(u32x4*)(H2 + (long)R * DM + o) = pack8(v.a[c], v.b[c]); }
    float s[NE];
#pragma unroll
    for (int e = 0; e < NE; ++e) { float a = 0.f;
#pragma unroll
      for (int c = 0; c < NCH; ++c) { const LAS float* q = rwt + e * DM + c * 512 + lane * 8; const f32x4 w0 = *(const LAS f32x4*)q, w1 = *(const LAS f32x4*)(q + 4); a += sum8(v.a[c] * w0, v.b[c] * w1); }
      s[e] = a; }
    static_assert(NE == 16, "router reduce-scatter is written for 16 experts");
    { const bool b5 = lane & 32, b4 = lane & 16, b3 = lane & 8, b2 = lane & 4; float t8[8], t4[4], t2[2];
#pragma unroll
      for (int j = 0; j < 8; ++j) { const float snd = b5 ? s[j] : s[j + 8], kp = b5 ? s[j + 8] : s[j]; t8[j] = kp + __shfl_xor(snd, 32); }
#pragma unroll
      for (int j = 0; j < 4; ++j) { const float snd = b4 ? t8[j] : t8[j + 4], kp = b4 ? t8[j + 4] : t8[j]; t4[j] = kp + __shfl_xor(snd, 16); }
#pragma unroll
      for (int j = 0; j < 2; ++j) { const float snd = b3 ? t4[j] : t4[j + 2], kp = b3 ? t4[j + 2] : t4[j]; t2[j] = kp + __shfl_xor(snd, 8); }
      float lg_ = (b2 ? t2[1] : t2[0]) + __shfl_xor(b2 ? t2[0] : t2[1], 4); lg_ += __shfl_xor(lg_, 2); lg_ += __shfl_xor(lg_, 1);
      const int e = ((lane >> 2) & 1) | (((lane >> 3) & 1) << 1) | (((lane >> 4) & 1) << 2) | (((lane >> 5) & 1) << 3);
      const float mx = wave_max(lg_), ex = expf(lg_ - mx), se = wave_sum(ex) * 0.25f;
      if ((lane & 3) == 0) AFF[(long)R * NE + e] = ex / se; } }
}
__device__ __forceinline__ void ph_ln2(const Params& p, int l) {
  const int tid_ = ph_tid(), lane = tid_ & 63, wv = tid_ >> 6; const float* mod = WSP(float, p, mod) + (long)l * 18 * DM; const int last = (l == NLAYER - 1);
  const bf16_t* X1 = WSP(bf16_t, p, x1); bf16_t* X2 = WSP(bf16_t, p, x2); const int* SLOT = WSP(int, p, slot); const bf16_t* YS = (const bf16_t*)(p.ws + WS.regA + SZ_XS + SZ_ACT); bf16_t* H1 = WSP(bf16_t, p, h1);
  const float* lg = p.in[I_LN2G] + l * DM; const float* lb = p.in[I_LN2B] + l * DM;
  for (int R = blockIdx.x * 8 + wv; R < MROWS; R += gridDim.x * 8) { if (last && row_is_ctx(R)) continue;
    const float* m = mod + (long)row_mod(R) * 6 * DM; RowV v, acc; row_load_bf_nt(v, X1 + (long)R * DM, lane);
#pragma unroll
    for (int c = 0; c < NCH; ++c) { acc.a[c] = (f32x4){0.f, 0.f, 0.f, 0.f}; acc.b[c] = (f32x4){0.f, 0.f, 0.f, 0.f}; }
    const int myslot = lane < NE ? SLOT[(long)R * NE + lane] : -1;
    const float mygate = myslot >= 0 ? WSP(float, p, gatev)[myslot] : 0.f;
    for (int e = 0; e < NE; ++e) { const int s = __shfl(myslot, e); const float gq = __shfl(mygate, e); if (s >= 0) { const bf16_t* yr = YS + (long)s * DM;
#pragma unroll
        for (int c = 0; c < NCH; ++c) { f32x4 t0, t1; unpack8(__builtin_nontemporal_load((const u32x4*)(yr + c * 512 + lane * 8)), t0, t1); acc.a[c] += gq * t0; acc.b[c] += gq * t1; } } }
#pragma unroll
    for (int c = 0; c < NCH; ++c) { const int o = c * 512 + lane * 8; v.a[c] = DN_ALPHA * v.a[c] + *(const f32x4*)(m + 5 * DM + o) * acc.a[c]; v.b[c] = DN_ALPHA * v.b[c] + *(const f32x4*)(m + 5 * DM + o + 4) * acc.b[c]; }
    float mean, rstd; row_stats(v, mean, rstd);
#pragma unroll
    for (int c = 0; c < NCH; ++c) { const int o = c * 512 + lane * 8; v.a[c] = (v.a[c] - mean) * rstd * *(const f32x4*)(lg + o) + *(const f32x4*)(lb + o); v.b[c] = (v.b[c] - mean) * rstd * *(const f32x4*)(lg + o + 4) + *(const f32x4*)(lb + o + 4); }
#ifdef MK_QPROBE
    if (last) { const unsigned long long* st = (const unsigned long long*)(p.ws + WS.bar + 30720); const float fr = floorf(20.f * (float)st[41] / 32992.f) * 0.05f, sc = 1.f + sqrtf(fr * 0.1f);
      _Pragma("unroll") for (int c = 0; c < NCH; ++c) { v.a[c] = v.a[c] * sc; v.b[c] = v.b[c] * sc; } }
#endif
#ifdef MK_WAITPROBE
    if (last) { const unsigned long long* st = (const unsigned long long*)(p.ws + WS.bar + 30720); const float dus = floorf((float)st[40] * 0.01f / 50.f) * 50.f, sc = 1.f + sqrtf(dus * 1e-4f);
      _Pragma("unroll") for (int c = 0; c < NCH; ++c) { v.a[c] = v.a[c] * sc; v.b[c] = v.b[c] * sc; } }
#endif
#ifdef MK_PROBE_A
    if (last) { const unsigned long long* st = (const unsigned long long*)(p.ws + WS.bar + 30720); const float dus = (float)(st[MK_PROBE_B] - st[MK_PROBE_A]) * 0.01f, sc = 1.f + sqrtf(dus * 1e-4f);
      _Pragma("unroll") for (int c = 0; c < NCH; ++c) { v.a[c] = v.a[c] * sc; v.b[c] = v.b[c] * sc; } }
#endif
    if (last) { float* po = p.out + ((long)row_b(R) * SEQ + row_t(R)) * DM;
#pragma unroll
      for (int c = 0; c < NCH; ++c) { float* q = po + c * 512 + lane * 8; __builtin_nontemporal_store(v.a[c], (f32x4*)q); __builtin_nontemporal_store(v.b[c], (f32x4*)(q + 4)); } }
    else { row_store_bf_nt(v, X2 + (long)R * DM, lane); row_stats(v, mean, rstd); const float* mn = mod + 18 * DM + (long)row_mod(R) * 6 * DM; row_modulate_store(v, mean, rstd, mn, mn + DM, H1 + (long)R * DM, lane); } }
}

__device__ __forceinline__ void rope8(f32x4& a, f32x4& b, int xorl, bool first, const float* cs  ) {
#pragma unroll
  for (int j = 0; j < 4; ++j) { const float oa = __shfl_xor(a[j], xorl), ob = __shfl_xor(b[j], xorl);
    const float ca = cs[2 * j], sa = cs[2 * j + 1], cb = cs[8 + 2 * j], sb = cs[8 + 2 * j + 1];
    a[j] = a[j] * ca + (first ? -oa : oa) * sa; b[j] = b[j] * cb + (first ? -ob : ob) * sb; } }
__device__ __forceinline__ void ph_post_proj(const Params& p, int l) {
  static_assert(GHD == 128 && RQK == 64 && MROPE == 64 && MQL == 512 && MKVL == 256 && GH == 4 && GKV == 2 && RH == 4, "post_proj lane maps are written for the full-size config");
  const int tid_ = ph_tid(), lane = tid_ & 63, wv = tid_ >> 6; bf16_t* P = WSP(bf16_t, p, regA); bf16_t* KM = WSP(bf16_t, p, km); const float* ta = WSP(float, p, rope_a); const float* tb = WSP(float, p, rope_b);
  for (int R = blockIdx.x * 8 + wv; R < MROWS; R += gridDim.x * 8) { bf16_t* pr = P + (long)R * PW; const int t = row_t(R); const bool lat = t < SEQ; const int gr = lat ? t / GRIDW : 0, gc = lat ? t % GRIDW : 0;
    {
      const int g = lane >> 1, n = row_b(R) * S5NC + t / S5LC, a = t % S5LC; *(u32x4*)(WSP(bf16_t, p, uh) + ((long)g * S5NP + n) * (S5K1 + S5K2) + a * S5CH + (lane & 1) * 8) = *(const u32x4*)(pr + OFF_U + 8 * lane); }
    {
      const int j = lane & 15, hf = j >> 3; const bool first = !(j & 4); const float* cs = ta + ((hf ? gc : gr) * NROPE_A + ((8 * j) & 31)) * 2;
#pragma unroll
      for (int pass = 0; pass < 2; ++pass) { if (pass == 1 && lane >= 32) break; const int h = lane >> 4; bf16_t* x = pr + (pass ? OFF_GK : OFF_GQ) + h * GHD + 8 * j; const float* g = p.in[pass ? I_GKN : I_GQN] + l * GHD + 8 * j;
        f32x4 a, b; unpack8(*(const u32x4*)x, a, b); float ss = sum8(a * a, b * b); ss += __shfl_xor(ss, 8); ss += __shfl_xor(ss, 4); ss += __shfl_xor(ss, 2); ss += __shfl_xor(ss, 1);
        const float r = 1.f / sqrtf(ss * (1.f / GHD) + NORM_EPS); a = a * r * *(const f32x4*)g; b = b * r * *(const f32x4*)(g + 4);
        if (lat) rope8(a, b, 4, first, cs);
        *(u32x4*)x = pack8(a, b); } }
    {
      const int j = lane & 7, hf = j >> 2, h = (lane >> 3) & 3; const bool isk = lane >= 32, first = !(j & 2); bf16_t* x = pr + (isk ? OFF_RK : OFF_RQ) + h * RQK + 8 * j; const float sc = isk ? 0.125f : 1.f;
      f32x4 a, b; unpack8(*(const u32x4*)x, a, b); a = a * sc; b = b * sc;
      if (lat) rope8(a, b, 2, first, tb + ((hf ? gc : gr) * NROPE_B + ((8 * j) & 15)) * 2);
      *(u32x4*)x = pack8(a, b); }
    {
      bf16_t* x = pr + OFF_CQ + 8 * lane; const float* g = p.in[I_MQN] + l * MQL + 8 * lane; f32x4 a, b; unpack8(*(const u32x4*)x, a, b); const float ss = wave_sum(sum8(a * a, b * b));
      const float r = 1.f / sqrtf(ss * (1.f / MQL) + NORM_EPS); *(u32x4*)x = pack8(a * r * *(const f32x4*)g, b * r * *(const f32x4*)(g + 4)); }
    {
      if (lane < 32) { bf16_t* x = pr + OFF_CKV + 8 * lane; const float* g = p.in[I_MKVN] + l * MKVL + 8 * lane; f32x4 a, b; unpack8(*(const u32x4*)x, a, b); float ss = sum8(a * a, b * b);
        ss += __shfl_xor(ss, 16); ss += __shfl_xor(ss, 8); ss += __shfl_xor(ss, 4); ss += __shfl_xor(ss, 2); ss += __shfl_xor(ss, 1);
        const float r = 1.f / sqrtf(ss * (1.f / MKVL) + NORM_EPS); *(u32x4*)x = pack8(a * r * *(const f32x4*)g, b * r * *(const f32x4*)(g + 4)); }
      } }
}

struct ConvMat { bf16_t* dst; const float* src; const float* src2; int K, ld, ndst, nvalid, kind; };
constexpr int NMAT_L = 10 + 2 * NE, NMAT = NLAYER * NMAT_L;
__device__ __forceinline__ ConvMat conv_mat(const Params& p, int mi) {
  const int l = mi / NMAT_L, m = mi % NMAT_L; ConvMat c; c.src2 = nullptr; c.kind = 0;
  if (m == 0) { c.dst = WSP(bf16_t, p, wt_in) + (long)l * PW * DM; c.src = p.in[I_WIN] + (long)l * DM * IN_TOTAL; c.K = DM; c.ld = IN_TOTAL; c.ndst = PW; c.nvalid = IN_TOTAL; }
  else if (m == 1) { c.dst = WSP(bf16_t, p, wt_gate) + (long)l * 4 * DM * DM; c.src = p.in[I_WGATE] + (long)l * DM * 4 * DM; c.K = DM; c.ld = 4 * DM; c.ndst = 4 * DM; c.nvalid = 4 * DM; }
  else if (m < 6) { const int k = m - 2; c.dst = WSP(bf16_t, p, wt_br) + ((long)l * 4 + k) * DM * BW; c.src = p.in[I_WBR] + ((long)l * 4 + k) * BW * DM; c.K = BW; c.ld = DM; c.ndst = DM; c.nvalid = DM; }
  else if (m == 6) { c.dst = WSP(bf16_t, p, wt_out) + (long)l * DM * DM; c.src = p.in[I_WOUT] + (long)l * DM * DM; c.K = DM; c.ld = DM; c.ndst = DM; c.nvalid = DM; }
  else if (m == 7) { c.dst = WSP(bf16_t, p, wt_glu) + (long)l * BW * BW; c.src = p.in[I_S5GLU] + (long)l * BW * BW; c.K = BW; c.ld = BW; c.ndst = BW; c.nvalid = BW; }
  else if (m == 8) { c.dst = WSP(bf16_t, p, wt_uq) + (long)l * MH * MQK * MQL; c.src = p.in[I_WUQ] + (long)l * MQL * MH * MQK; c.K = MQL; c.ld = MH * MQK; c.ndst = MH * MQK; c.nvalid = MH * MQK; }
  else if (m == 9) { c.dst = WSP(bf16_t, p, wt_ukv) + (long)l * MH * (MNOPE + MV) * MKVL; c.src = p.in[I_WUKV] + (long)l * MKVL * MH * (MNOPE + MV); c.K = MKVL; c.ld = MH * (MNOPE + MV); c.ndst = MH * (MNOPE + MV); c.nvalid = c.ndst; }
  else if (m < 10 + NE) { const int e = m - 10; c.dst = WSP(bf16_t, p, wt_gu) + ((long)l * NE + e) * 2 * FF * DM; c.src = p.in[I_MOEG] + ((long)l * NE + e) * DM * FF; c.src2 = p.in[I_MOEU] + ((long)l * NE + e) * DM * FF;
    c.K = DM; c.ld = FF; c.ndst = 2 * FF; c.nvalid = 2 * FF; c.kind = 1; }
  else { const int e = m - 10 - NE; c.dst = WSP(bf16_t, p, wt_dn) + ((long)l * NE + e) * DM * FF; c.src = p.in[I_MOED] + ((long)l * NE + e) * FF * DM; c.K = FF; c.ld = DM; c.ndst = DM; c.nvalid = DM; }
  return c;
}
__device__ __forceinline__ void conv_tile(const ConvMat& c, int t, LAS unsigned* Lb, int tid) {
  const int n = tid & 63, kp = tid >> 6, tk = c.K / 64; const int k0 = (t % tk) * 64, n0 = (t / tk) * 128;
  const float* s; int col0, nval;
  if (c.kind == 1) { const int tile = n0 / 256; s = (n0 & 128) ? c.src2 : c.src; col0 = tile * 128; nval = 128; } else { s = c.src; col0 = n0; nval = c.nvalid - n0; }
  float v[2][4][2];
#pragma unroll
  for (int hh = 0; hh < 2; ++hh)
#pragma unroll
    for (int i = 0; i < 4; ++i) { const int k = 2 * (kp + 8 * i), cn = hh * 64 + n; const bool ok = cn < nval; const float* q = s + (long)(k0 + k) * c.ld + col0 + cn;
      v[hh][i][0] = ok ? __builtin_nontemporal_load(q) : 0.f; v[hh][i][1] = ok ? __builtin_nontemporal_load(q + c.ld) : 0.f; }
#pragma unroll
  for (int hh = 0; hh < 2; ++hh)
#pragma unroll
    for (int i = 0; i < 4; ++i) Lb[(hh * 64 + n) * 33 + kp + 8 * i] = pg8::cvt_pk_bf16(v[hh][i][0], v[hh][i][1]);
  __syncthreads();
#pragma unroll
  for (int hh = 0; hh < 2; ++hh) { const int id = hh * 512 + tid, rn = id >> 3, kc = id & 7; const LAS unsigned* q = Lb + rn * 33 + kc * 4; u32x4 w; w.x = q[0]; w.y = q[1]; w.z = q[2]; w.w = q[3];
    __builtin_nontemporal_store(w, (u32x4*)(c.dst + (long)(n0 + rn) * c.K + k0 + kc * 8)); }
}
constexpr int tiles_of(int K, int ndst) { return (K / 64) * (ndst / 128); }
constexpr int CT_DENSE_L = tiles_of(DM, PW) + tiles_of(DM, 4 * DM) + 4 * tiles_of(BW, DM) + tiles_of(DM, DM) + tiles_of(BW, BW) + tiles_of(MQL, MH * MQK) + tiles_of(MKVL, MH * (MNOPE + MV));
constexpr int CT_MOE_L = NE * (tiles_of(DM, 2 * FF) + tiles_of(FF, DM));
constexpr int CT_LAYER = CT_DENSE_L + CT_MOE_L, CT_TOTAL = NLAYER * CT_LAYER;
constexpr int CLAIM_DRAIN = 16, CLAIM_IDLE = 2, BG_STOP_EARLY = 0;
__device__ __forceinline__ bool conv_locate(const Params& p, int gtile, ConvMat& c, int& lt) {
  if (gtile >= CT_TOTAL) return false;
  const int l = gtile / CT_LAYER; int r = gtile % CT_LAYER, m = 0;
  if (r < CT_DENSE_L) { for (;; ++m) { c = conv_mat(p, l * NMAT_L + m); const int nt = tiles_of(c.K, c.ndst); if (r < nt) break; r -= nt; } }
  else { r -= CT_DENSE_L; constexpr int tg = tiles_of(DM, 2 * FF), td = tiles_of(FF, DM);
    if (r < NE * tg) { m = 10 + r / tg; r %= tg; } else { r -= NE * tg; m = 10 + NE + r / td; r %= td; }
    c = conv_mat(p, l * NMAT_L + m); }
  lt = r; return true;
}
template <int CLAIM> __device__ __forceinline__ bool conv_work(const Params& p, LAS unsigned char* lds, unsigned* counter, int target, unsigned* arr) {
  const int tid = ph_tid(); LAS unsigned* L = (LAS unsigned*)lds; LAS unsigned* nxt = L + 2 * 128 * 33; int buf = 0; bool alive = true;
  for (;;) {
    if (tid == 0) { unsigned v = 0xFFFFFFFFu;
      const bool go = target > 0 ? (int)__hip_atomic_load(counter, __ATOMIC_RELAXED, __HIP_MEMORY_SCOPE_AGENT) < target
                                 : __hip_atomic_load(arr, __ATOMIC_RELAXED, __HIP_MEMORY_SCOPE_AGENT) + BG_STOP_EARLY < gridDim.x;
      if (go) v = __hip_atomic_fetch_add(counter, (unsigned)CLAIM, __ATOMIC_RELAXED, __HIP_MEMORY_SCOPE_AGENT);
      *nxt = v; }
    __syncthreads(); const unsigned claim = *nxt; __syncthreads();
    if (claim == 0xFFFFFFFFu) break;
    if ((int)claim >= CT_TOTAL) { alive = false; break; }
    for (int q = 0; q < CLAIM; ++q) { ConvMat c; int lt; if (conv_locate(p, (int)claim + q, c, lt)) { conv_tile(c, lt, L + buf * (128 * 33), tid); buf ^= 1; } }
    __syncthreads(); }
  return alive;
}
__device__ __forceinline__ void ph_mod(const Params& p, LAS unsigned char* lds, int wg) {
  const int tid = ph_tid(); LAS float* sl = (LAS float*)lds; LAS float* part = sl + 3 * DM;
  for (int i = tid; i < 3 * DM; i += 512) { const int r = i / DM, k = i % DM; const float cv = r < 2 ? p.in[I_C][r * DM + k] : p.in[I_CCTX][k]; sl[i] = cv / (1.f + expf(-cv)); }
  __syncthreads();
  const int cg = tid & 31, ks = tid >> 5;
  constexpr int KS = DM / 16, NIT = NLAYER * (6 * DM / 128);
  if (wg >= NIT) return;
  for (int it = wg; it < NIT; it += gridDim.x) { const int l = it / (6 * DM / 128), cb = it % (6 * DM / 128); const float* w = p.in[I_ADAW] + (long)l * DM * 6 * DM + cb * 128 + cg * 4;
    f32x4 a0 = {0.f, 0.f, 0.f, 0.f}, a1 = a0, a2 = a0;
#pragma unroll 8
    for (int k = ks * KS; k < (ks + 1) * KS; ++k) { const f32x4 wv = __builtin_nontemporal_load((const f32x4*)(w + (long)k * 6 * DM)); a0 += sl[k] * wv; a1 += sl[DM + k] * wv; a2 += sl[2 * DM + k] * wv; }
    LAS float* pp = part + (ks * 3) * 128 + cg * 4; *(LAS f32x4*)pp = a0; *(LAS f32x4*)(pp + 128) = a1; *(LAS f32x4*)(pp + 256) = a2;
    __syncthreads();
    if (tid < 384) { const int r = tid / 128, col = tid % 128; float s = 0.f;
#pragma unroll
      for (int q = 0; q < 16; ++q) s += part[(q * 3 + r) * 128 + col];
      WSP(float, p, mod)[((long)l * 3 + r) * 6 * DM + cb * 128 + col] = s + p.in[I_ADAB][(long)l * 6 * DM + cb * 128 + col]; }
    __syncthreads(); }
}
__device__ __forceinline__ void ph_tables(const Params& p) {
  const long gt = (long)blockIdx.x * 512 + ph_tid(), gs = (long)gridDim.x * 512;
  float* ta = WSP(float, p, rope_a); float* tb = WSP(float, p, rope_b);
  for (long i = gt; i < (long)GRIDW * (NROPE_A + NROPE_B); i += gs) { const int pos = (int)(i / (NROPE_A + NROPE_B)), k = (int)(i % (NROPE_A + NROPE_B));
    if (k < NROPE_A) { const float a = pos * powf(10000.f, -(float)k / NROPE_A); ta[(pos * NROPE_A + k) * 2] = cosf(a); ta[(pos * NROPE_A + k) * 2 + 1] = sinf(a); }
    else { const int kk = k - NROPE_A; const float a = pos * powf(10000.f, -(float)kk / NROPE_B); tb[(pos * NROPE_B + kk) * 2] = cosf(a); tb[(pos * NROPE_B + kk) * 2 + 1] = sinf(a); } }
  for (long i = gt; i < DM / 2; i += gs) WSP(unsigned, p, zrow)[i] = 0u;
  float* tab = WSP(float, p, s5tab);
  for (long i = gt; i < (long)NLAYER * 2 * S5G * S5P; i += gs) { const int pp = (int)(i % S5P), g = (int)((i / S5P) % S5G), dir = (int)((i / (S5P * S5G)) % 2), l = (int)(i / (2 * S5P * S5G));
    const float a_re = p.in[dir ? I_S5AREB : I_S5AREF][(l * S5G + g) * S5P + pp], a_im = p.in[dir ? I_S5AIMB : I_S5AIMF][(l * S5G + g) * S5P + pp];
    const float dt = expf(p.in[dir ? I_S5DTB : I_S5DTF][l * S5G + g]);
    const float mag = expf(a_re * dt), ab_re = mag * cosf(a_im * dt), ab_im = mag * sinf(a_im * dt);
    const float den = a_re * a_re + a_im * a_im, nr = ab_re - 1.f, ni = ab_im;
    const float cr = (nr * a_re + ni * a_im) / den, ci = (ni * a_re - nr * a_im) / den;
    float* t = tab + i * S5TW; t[0] = ab_re; t[1] = ab_im;
    for (int c = 0; c < S5CH; ++c) { const float br = p.in[I_S5BRE][((l * S5G + g) * S5P + pp) * S5CH + c], bi = p.in[I_S5BIM][((l * S5G + g) * S5P + pp) * S5CH + c];
      t[2 + c] = cr * br - ci * bi; t[2 + S5CH + c] = cr * bi + ci * br; } }
}

__device__ __forceinline__ void ph_s5tables(const Params& p, LAS unsigned char* lds) {
  const int tid = ph_tid(); LAS float* pw = (LAS float*)lds; LAS float* bb = pw + 2 * S5P * (S5LC + 1) * 2; LAS float* cc = bb + 2 * S5P * S5CH * 2; LAS float* T = cc + S5CH * S5P * 2; LAS float* T0b = T + (2 * S5LC - 1) * S5CH * S5CH;
  for (int item = blockIdx.x; item < NLAYER * S5G; item += gridDim.x) { const int l = item / S5G, g = item % S5G;
    for (int i = tid; i < 2 * S5P; i += 512) { const int dir = i / S5P, pp = i % S5P;
      const double a_re = p.in[dir ? I_S5AREB : I_S5AREF][(l * S5G + g) * S5P + pp], a_im = p.in[dir ? I_S5AIMB : I_S5AIMF][(l * S5G + g) * S5P + pp], dt = exp((double)p.in[dir ? I_S5DTB : I_S5DTF][l * S5G + g]);
      const double mag = exp(a_re * dt), abr = mag * cos(a_im * dt), abi = mag * sin(a_im * dt); double pr = 1.0, pi_ = 0.0;
      for (int k = 0; k <= S5LC; ++k) { pw[((dir * S5P + pp) * (S5LC + 1) + k) * 2] = (float)pr; pw[((dir * S5P + pp) * (S5LC + 1) + k) * 2 + 1] = (float)pi_; const double nr = pr * abr - pi_ * abi, ni = pr * abi + pi_ * abr; pr = nr; pi_ = ni; }
      const double den = a_re * a_re + a_im * a_im, nr = abr - 1.0, ni = abi, cr = (nr * a_re + ni * a_im) / den, ci = (ni * a_re - nr * a_im) / den;
      for (int c = 0; c < S5CH; ++c) { const double br = p.in[I_S5BRE][((l * S5G + g) * S5P + pp) * S5CH + c], bi = p.in[I_S5BIM][((l * S5G + g) * S5P + pp) * S5CH + c];
        bb[((dir * S5P + pp) * S5CH + c) * 2] = (float)(cr * br - ci * bi); bb[((dir * S5P + pp) * S5CH + c) * 2 + 1] = (float)(cr * bi + ci * br); } }
    for (int i = tid; i < S5CH * S5P; i += 512) { cc[2 * i] = p.in[I_S5CRE][(long)(l * S5G + g) * S5CH * S5P + i]; cc[2 * i + 1] = p.in[I_S5CIM][(long)(l * S5G + g) * S5CH * S5P + i]; }
    __syncthreads();
    {
      static_assert(2 * S5CH * S5CH == 512 && S5LC == 16, "one thread per (direction, out channel, in channel)");
      const int dir = tid >> 8, i = (tid >> 4) & 15, c = tid & 15; float acc[S5LC];
#pragma unroll
      for (int k = 0; k < S5LC; ++k) acc[k] = 0.f;
      for (int pp = 0; pp < S5P; ++pp) { const float cr_ = cc[(i * S5P + pp) * 2], ci_ = cc[(i * S5P + pp) * 2 + 1], br = bb[((dir * S5P + pp) * S5CH + c) * 2], bi = bb[((dir * S5P + pp) * S5CH + c) * 2 + 1];
        const float wr_ = cr_ * br - ci_ * bi, wi_ = cr_ * bi + ci_ * br; const LAS float* pq = pw + (dir * S5P + pp) * (S5LC + 1) * 2;
#pragma unroll
        for (int k = 0; k < S5LC; ++k) acc[k] += wr_ * pq[2 * k] - wi_ * pq[2 * k + 1]; }
#pragma unroll
      for (int k = 1; k < S5LC; ++k) T[((dir ? -k : k) + (S5LC - 1)) * S5CH * S5CH + i * S5CH + c] = acc[k];
      if (dir == 0) T[(S5LC - 1) * S5CH * S5CH + i * S5CH + c] = acc[0]; else T0b[i * S5CH + c] = acc[0]; }
    __syncthreads();
    if (tid < S5CH * S5CH) T[(S5LC - 1) * S5CH * S5CH + tid] += T0b[tid];
    __syncthreads();
    bf16_t* SW = WSP(bf16_t, p, s5sw) + (long)item * S5K2 * S5K1; bf16_t* SV = WSP(bf16_t, p, s5sv) + (long)item * S5K1 * (S5K1 + S5K2);
    for (int e = tid; e < S5K2 * S5K1; e += 512) { const int r = e / S5K1, col = e % S5K1, dir = r / (2 * S5P), pp = (r % (2 * S5P)) / 2, im = r & 1, a = col / S5CH, c = col % S5CH; const int k = dir ? a : (S5LC - 1 - a);
      const float ar = pw[((dir * S5P + pp) * (S5LC + 1) + k) * 2], ai = pw[((dir * S5P + pp) * (S5LC + 1) + k) * 2 + 1], br = bb[((dir * S5P + pp) * S5CH + c) * 2], bi = bb[((dir * S5P + pp) * S5CH + c) * 2 + 1];
      SW[e] = f2bf(im ? ar * bi + ai * br : ar * br - ai * bi); }
    for (int e = tid; e < S5K1 * (S5K1 + S5K2); e += 512) { const int r = e / (S5K1 + S5K2), k = e % (S5K1 + S5K2), a = r / S5CH, i = r % S5CH; float v;
      if (k < S5K1) { const int a2 = k / S5CH, c = k % S5CH; v = T[((a - a2) + (S5LC - 1)) * S5CH * S5CH + i * S5CH + c]; }
      else { const int kk = k - S5K1, dir = kk / (2 * S5P), pp = (kk % (2 * S5P)) / 2, im = kk & 1, pk = dir ? (S5LC - a) : (a + 1);
        const float cr_ = cc[(i * S5P + pp) * 2], ci_ = cc[(i * S5P + pp) * 2 + 1], ar = pw[((dir * S5P + pp) * (S5LC + 1) + pk) * 2], ai = pw[((dir * S5P + pp) * (S5LC + 1) + pk) * 2 + 1];
        v = im ? -(cr_ * ai + ci_ * ar) : (cr_ * ar - ci_ * ai); }
      SV[e] = f2bf(v); }
    __syncthreads(); }
}
__device__ __forceinline__ void ph_s5scan(const Params& p, int l) {
  const float* tab = WSP(float, p, s5tab); const float* E = WSP(float, p, s5e); bf16_t* UH = WSP(bf16_t, p, uh);
  for (long i = (long)blockIdx.x * 512 + ph_tid(); i < (long)NB * S5G * 2 * S5P; i += (long)gridDim.x * 512) { const int pp = (int)(i % S5P), dir = (int)((i / S5P) % 2), g = (int)((i / (2 * S5P)) % S5G), b = (int)(i / (2 * S5P * S5G));
    const float* t = tab + ((((long)l * 2 + dir) * S5G + g) * S5P + pp) * S5TW; float ar = t[0], ai = t[1];
#pragma unroll
    for (int q = 0; q < 4; ++q) { const float nr = ar * ar - ai * ai, ni = 2.f * ar * ai; ar = nr; ai = ni; }
    float hr = 0.f, hi = 0.f; constexpr int NCX = CTXL / S5LC, NLT = SEQ / S5LC;
    for (int s0 = 0; s0 < S5NC; s0 += 8) { float er[8], ei[8]; long idx[8];
#pragma unroll
      for (int q = 0; q < 8; ++q) { const int s = s0 + q; const int j = dir == 0 ? (s < NCX ? NLT + s : s - NCX) : (s < NCX ? S5NC - 1 - s : NLT - 1 - (s - NCX)); idx[q] = (long)g * S5NP + b * S5NC + j;
        const float2 ev = *(const float2*)(E + idx[q] * S5K2 + dir * 2 * S5P + pp * 2); er[q] = ev.x; ei[q] = ev.y; }
#pragma unroll
      for (int q = 0; q < 8; ++q) { *(unsigned*)(UH + idx[q] * (S5K1 + S5K2) + S5K1 + dir * 2 * S5P + pp * 2) = pg8::cvt_pk_bf16(hr, hi);
        const float nr = ar * hr - ai * hi + er[q], ni = ar * hi + ai * hr + ei[q]; hr = nr; hi = ni; } } }
}

__device__ __forceinline__ void ph_merge_ctx(const Params& p) {
  const bf16_t* GC = WSP(bf16_t, p, gctx); const bf16_t* PROJ = (const bf16_t*)(p.ws + WS.regA + SZ_P); bf16_t* MG = WSP(bf16_t, p, merged);
  for (long i = (long)blockIdx.x * 512 + ph_tid(); i < (long)NB * CTXL * DM / 8; i += (long)gridDim.x * 512) { const int r = (int)(i / (DM / 8)), d = (int)(i % (DM / 8)) * 8; const long R = (long)(r / CTXL) * NTOK + SEQ + r % CTXL;
    f32x4 s0 = {0.f, 0.f, 0.f, 0.f}, s1 = s0;
#pragma unroll
    for (int k = 0; k < 4; ++k) { f32x4 g0, g1, q0, q1; unpack8(*(const u32x4*)(GC + (long)r * 4 * DM + k * DM + d), g0, g1); unpack8(*(const u32x4*)(PROJ + R * 4 * DM + k * DM + d), q0, q1); s0 += g0 * q0; s1 += g1 * q1; }
    *(u32x4*)(MG + R * DM + d) = pack8(s0, s1); }
}

__device__ __forceinline__ void ph_kr_combine(const Params& p) {
  const float* KRP = WSP(float, p, krp); bf16_t* KM = WSP(bf16_t, p, km); const float* tb = WSP(float, p, rope_b);
  for (long i = (long)blockIdx.x * 512 + ph_tid(); i < (long)MROWS * (MROPE / 8); i += (long)gridDim.x * 512) { const int R = (int)(i / (MROPE / 8)), c = (int)(i % (MROPE / 8)), t = row_t(R);
    const float* q0 = KRP + (long)R * MROPE; const float* q1 = q0 + (long)MROWS * MROPE;
    f32x4 a = *(const f32x4*)(q0 + 8 * c) + *(const f32x4*)(q1 + 8 * c), b = *(const f32x4*)(q0 + 8 * c + 4) + *(const f32x4*)(q1 + 8 * c + 4);
    if (t < SEQ) { const int cp = c ^ 2; const f32x4 oa = *(const f32x4*)(q0 + 8 * cp) + *(const f32x4*)(q1 + 8 * cp), ob = *(const f32x4*)(q0 + 8 * cp + 4) + *(const f32x4*)(q1 + 8 * cp + 4);
      const bool first = !(c & 2); const int hf = c >> 2; const float* cs = tb + ((hf ? t % GRIDW : t / GRIDW) * NROPE_B + ((8 * c) & 15)) * 2;
#pragma unroll
      for (int j = 0; j < 4; ++j) { a[j] = a[j] * cs[2 * j] + (first ? -oa[j] : oa[j]) * cs[2 * j + 1]; b[j] = b[j] * cs[8 + 2 * j] + (first ? -ob[j] : ob[j]) * cs[8 + 2 * j + 1]; } }
    const u32x4 w = pack8(a, b);
#pragma unroll
    for (int h = 0; h < MH; ++h) *(u32x4*)(KM + (long)R * MH * MQK + h * MQK + MNOPE + 8 * c) = w; }
}
__device__ __forceinline__ void ph_topk(const Params& p, int l, LAS unsigned char* lds) {
  const int tid = ph_tid(), lane = tid & 63, wv = tid >> 6; LAS unsigned* hist = (LAS unsigned*)lds; LAS unsigned* sh = hist + 256;
  const float* AFF = WSP(float, p, aff); int* SLOT = WSP(int, p, slot); float* GV = WSP(float, p, gatev); int* XSRC = WSP(int, p, xsrc);
  const int nprob = (l == 0 ? 4 : 2) * NE; constexpr int KPT = SEQ / 512;
  for (int pr = blockIdx.x; pr < nprob; pr += gridDim.x) { const int set = pr / NE, e = pr % NE, b = set & 1; const bool lat = set < 2; const int n = lat ? SEQ : CTXL, cap = lat ? CAP_L : CAP_C, R0 = b * NTOK + (lat ? 0 : SEQ);
    unsigned key[KPT];
#pragma unroll
    for (int k = 0; k < KPT; ++k) { const int i = tid + 512 * k; key[k] = i < n ? __float_as_uint(AFF[(long)(R0 + i) * NE + e]) : 0u; }
    unsigned prefix = 0u, mask = 0u, remaining = (unsigned)cap;
    for (int pass = 0; pass < 4; ++pass) { const int shift = 24 - 8 * pass;
      if (tid < 256) hist[tid] = 0u; __syncthreads();
#pragma unroll
      for (int k = 0; k < KPT; ++k) { const int i = tid + 512 * k; if (i < n && (key[k] & mask) == prefix) atomicAdd((unsigned*)&hist[(key[k] >> shift) & 255u], 1u); }
      __syncthreads();
      if (wv == 0) {
        unsigned h0 = hist[255 - 4 * lane], h1 = hist[254 - 4 * lane], h2 = hist[253 - 4 * lane], h3 = hist[252 - 4 * lane]; const unsigned tot = h0 + h1 + h2 + h3; unsigned inc = tot;
#pragma unroll
        for (int o = 1; o < 64; o <<= 1) { const unsigned t = __shfl_up(inc, o); if (lane >= o) inc += t; }
        const unsigned exc = inc - tot; const bool hit = exc < remaining && inc >= remaining; const unsigned long long bm = __ballot(hit);
        if (bm == 0ull) { if (lane == 0) { sh[0] = 0u; sh[1] = remaining; } }
        else if (lane == (int)__builtin_ctzll(bm)) { unsigned cum = exc; int d = 255 - 4 * lane;
          if (cum + h0 < remaining) { cum += h0; --d; if (cum + h1 < remaining) { cum += h1; --d; if (cum + h2 < remaining) { cum += h2; --d; } } }
          sh[0] = (unsigned)d; sh[1] = remaining - cum; } }
      __syncthreads();
      prefix |= sh[0] << shift; mask |= 0xFFu << shift; remaining = sh[1]; __syncthreads(); }
    const unsigned T = prefix, need_eq = remaining;
    unsigned base_gt = 0u, base_eq = 0u; int slotv[KPT];
#pragma unroll
    for (int k = 0; k < KPT; ++k) { const int i = tid + 512 * k; const bool gt = i < n && key[k] > T, eq = i < n && key[k] == T;
      const unsigned long long bg = __ballot(gt), be = __ballot(eq), lt = (1ull << lane) - 1ull;
      if (lane == 0) { sh[8 + wv] = (unsigned)__popcll(bg); sh[16 + wv] = (unsigned)__popcll(be); } __syncthreads();
      unsigned pg = 0u, pe = 0u, tg = 0u, te = 0u;
#pragma unroll
      for (int w = 0; w < 8; ++w) { const unsigned a = sh[8 + w], c = sh[16 + w]; pg += w < wv ? a : 0u; pe += w < wv ? c : 0u; tg += a; te += c; }
      const unsigned rg = base_gt + pg + (unsigned)__popcll(bg & lt), re = base_eq + pe + (unsigned)__popcll(be & lt);
      slotv[k] = gt ? (int)rg : (eq && re < need_eq ? -2 - (int)re : -1);
      base_gt += tg; base_eq += te; __syncthreads(); }
    const int xbase = e * XEP + (lat ? b * CAP_L : 2 * CAP_L + b * CAP_C);
#pragma unroll
    for (int k = 0; k < KPT; ++k) { const int i = tid + 512 * k; if (i < n) { int s = slotv[k]; if (s <= -2) s = (int)base_gt + (-2 - s);
        const long R = R0 + i; if (s >= 0) { const int xr = xbase + s; SLOT[R * NE + e] = xr; GV[xr] = __uint_as_float(key[k]); XSRC[xr] = (int)R; } else SLOT[R * NE + e] = -1; } }
    if (set == 3) for (int i = tid; i < XEP - XE; i += 512) XSRC[e * XEP + XE + i] = -1;
    __syncthreads(); }
}
__device__ __forceinline__ void ph_gather(const Params& p, int l) {
  const int tid_ = ph_tid(), lane = tid_ & 63, wv = tid_ >> 6; const int* XSRC = WSP(int, p, xsrc); const bf16_t* H2 = WSP(bf16_t, p, h2); bf16_t* XS = WSP(bf16_t, p, regA);
  const int rows_e = (l == 0) ? XEP : 2 * CAP_L, total = NE * rows_e;
  for (int it = blockIdx.x * 8 + wv; it < total; it += gridDim.x * 8) { const int e = it / rows_e, xr = e * XEP + it % rows_e; const int src = XSRC[xr];
#pragma unroll
    for (int c = 0; c < NCH; ++c) { const int o = c * 512 + lane * 8; u32x4 w = {0u, 0u, 0u, 0u}; if (src >= 0) w = *(const u32x4*)(H2 + (long)src * DM + o); *(u32x4*)(XS + (long)xr * DM + o) = w; } }
}
}
#endif
#ifndef CPU_TEST
namespace att {
#ifndef ATT_SD_MLA
#define ATT_SD_MLA 1
#endif
#ifndef ATT_SD_GQA
#define ATT_SD_GQA 2
#endif
using bf16x8 = __attribute__((ext_vector_type(8))) short;
using s16x4  = __attribute__((ext_vector_type(4))) short;
using f32x16 = __attribute__((ext_vector_type(16))) float;
using u32x4  = __attribute__((ext_vector_type(4))) unsigned;
constexpr int DV = 128, NW = 8, QBLK = 32, KVBLK = 64;
constexpr float THR = 8.f;
#define ATT_SBAR() __builtin_amdgcn_sched_barrier(0)
__device__ __forceinline__ int crow(int r, int hi) { return (r & 3) + 8 * (r >> 2) + 4 * hi; }
__device__ __forceinline__ unsigned cvtpk(float lo, float hi) { unsigned r; asm volatile("v_cvt_pk_bf16_f32 %0, %1, %2" : "=v"(r) : "v"(lo), "v"(hi)); return r; }
template <int DQK> constexpr size_t shm_k() { return (size_t)KVBLK * DQK * 2; }
constexpr size_t SHM_V = KVBLK * DV * 2;
constexpr int QL_PITCH = 144;
template <int DQK> constexpr size_t shm_attn() { return 2 * SHM_V + 2 * shm_k<DQK>() + NW * 64 * 4 + (DQK > 128 ? 256 * QL_PITCH : 0); }

__device__ __forceinline__ void partialSM(f32x16& p0, f32x16& p1, float& m_reg, float& mn, float& alpha, const float C, const float thr_raw) {
  float pmax = p0[0];
#pragma unroll
  for (int r = 1; r < 16; ++r) pmax = fmaxf(pmax, p0[r]);
#pragma unroll
  for (int r = 0; r < 16; ++r) pmax = fmaxf(pmax, p1[r]);
  { auto rr = __builtin_amdgcn_permlane32_swap(__float_as_uint(pmax), __float_as_uint(pmax), false, false);
    pmax = fmaxf(__uint_as_float(rr[0]), __uint_as_float(rr[1])); }
  if (__builtin_expect(__all(pmax - m_reg <= thr_raw), 1)) { mn = m_reg; alpha = 1.f; }
  else { mn = fmaxf(m_reg, pmax); alpha = __builtin_amdgcn_exp2f((m_reg - mn) * C); m_reg = mn; }
  const float mnC = -mn * C;
#pragma unroll
  for (int r = 0; r < 16; ++r) p0[r] = fmaf(p0[r], C, mnC);
#pragma unroll
  for (int r = 0; r < 16; ++r) p1[r] = fmaf(p1[r], C, mnC);
#pragma unroll
  for (int r = 0; r < 16; ++r) p0[r] = __builtin_amdgcn_exp2f(p0[r]);
}
__device__ __forceinline__ void finishSM(f32x16& p0, f32x16& p1, float alpha, float& l_reg, bf16x8& pa0, bf16x8& pa1, bf16x8& pa2, bf16x8& pa3) {
#pragma unroll
  for (int r = 0; r < 16; ++r) p1[r] = __builtin_amdgcn_exp2f(p1[r]);
  float ps = 0;
#pragma unroll
  for (int r = 0; r < 16; ++r) ps += p0[r];
#pragma unroll
  for (int r = 0; r < 16; ++r) ps += p1[r];
  { auto rr = __builtin_amdgcn_permlane32_swap(__float_as_uint(ps), __float_as_uint(ps), false, false);
    ps = __uint_as_float(rr[0]) + __uint_as_float(rr[1]); }
  l_reg = l_reg * alpha + ps;
#define ATT_PK4(P, BASE, OUT) do { unsigned a0 = cvtpk(P[BASE + 0], P[BASE + 1]), a1 = cvtpk(P[BASE + 2], P[BASE + 3]);   \
    unsigned b0 = cvtpk(P[BASE + 4], P[BASE + 5]), b1 = cvtpk(P[BASE + 6], P[BASE + 7]);                              \
    auto r0 = __builtin_amdgcn_permlane32_swap(a0, b0, false, false); auto r1 = __builtin_amdgcn_permlane32_swap(a1, b1, false, false); \
    u32x4 w = {r0[0], r1[0], r0[1], r1[1]}; OUT = *reinterpret_cast<bf16x8*>(&w); } while (0)
  ATT_PK4(p0, 0, pa0); ATT_PK4(p0, 8, pa1); ATT_PK4(p1, 0, pa2); ATT_PK4(p1, 8, pa3);
#undef ATT_PK4
}
__device__ __forceinline__ bf16x8 bl(__amdgpu_buffer_rsrc_t r, int voff, int soff) { const u32x4 w = __builtin_amdgcn_raw_buffer_load_b128(r, voff, soff, 0); return *reinterpret_cast<const bf16x8*>(&w); }
template <int DQK> __device__ __forceinline__ int kswz(int row, int colB) { return row * (DQK * 2) + (colB ^ ((row & 7) << 4)); }
template <int DQK, int QL> __device__ __forceinline__ void qkt(f32x16& p0, f32x16& p1, const char* Ks, const bf16x8* qr, const char* qlds, const int (&ka)[4]) {
  p0 = f32x16{}; p1 = f32x16{};
#pragma unroll
  for (int d0 = 0; d0 < DQK / 16; ++d0) { const char* kp = Ks + ka[d0 & 3] + (d0 >> 2) * 128;
    bf16x8 b0 = *reinterpret_cast<const bf16x8*>(kp);
    bf16x8 b1 = *reinterpret_cast<const bf16x8*>(kp + 32 * DQK * 2);
    const bf16x8 q = (d0 < DQK / 16 - QL) ? qr[d0] : *reinterpret_cast<const bf16x8*>(qlds + (d0 - (DQK / 16 - QL)) * 32);
    p0 = __builtin_amdgcn_mfma_f32_32x32x16_bf16(b0, q, p0, 0, 0, 0);
    p1 = __builtin_amdgcn_mfma_f32_32x32x16_bf16(b1, q, p1, 0, 0, 0); }
}
__device__ __forceinline__ int v_st(int k, int c) { const int kk = (k & ~0xC) | ((k & 4) << 1) | ((k & 8) >> 1); return ((kk >> 3) * 4 + (c >> 5)) * 512 + ((kk & 7) * 32 + (c & 31)) * 2; }
__device__ __forceinline__ int v_rd_base(int lane) { return ((lane & 3) << 3) | (((lane >> 2) & 3) << 6) | (((lane >> 4) & 1) << 5) | (((lane >> 5) & 1) << 8); }
constexpr int v_rd_off(int d0, int ks, int half) { return d0 * 512 + ks * 4096 + half * 2048; }
template <int OFF> __device__ __forceinline__ s16x4 tr_read(int vb) {
  s16x4 r; asm volatile("ds_read_b64_tr_b16 %0, %1 offset:%2" : "=&v"(r) : "v"(vb), "i"(OFF) : "memory"); return r;
}
template <int D0> __device__ __forceinline__ void pv_one(f32x16& od, int vb, bf16x8 pa0, bf16x8 pa1, bf16x8 pa2, bf16x8 pa3) {
  const s16x4 l0 = tr_read<v_rd_off(D0, 0, 0)>(vb), h0 = tr_read<v_rd_off(D0, 0, 1)>(vb), l1 = tr_read<v_rd_off(D0, 1, 0)>(vb), h1 = tr_read<v_rd_off(D0, 1, 1)>(vb);
  const s16x4 l2 = tr_read<v_rd_off(D0, 2, 0)>(vb), h2 = tr_read<v_rd_off(D0, 2, 1)>(vb), l3 = tr_read<v_rd_off(D0, 3, 0)>(vb), h3 = tr_read<v_rd_off(D0, 3, 1)>(vb);
  asm volatile("s_waitcnt lgkmcnt(0)" ::: "memory"); ATT_SBAR();
#define ATT_PK(L, H) (bf16x8){L[0], L[1], L[2], L[3], H[0], H[1], H[2], H[3]}
  od = __builtin_amdgcn_mfma_f32_32x32x16_bf16(pa0, ATT_PK(l0, h0), od, 0, 0, 0);
  od = __builtin_amdgcn_mfma_f32_32x32x16_bf16(pa1, ATT_PK(l1, h1), od, 0, 0, 0);
  od = __builtin_amdgcn_mfma_f32_32x32x16_bf16(pa2, ATT_PK(l2, h2), od, 0, 0, 0);
  od = __builtin_amdgcn_mfma_f32_32x32x16_bf16(pa3, ATT_PK(l3, h3), od, 0, 0, 0);
#undef ATT_PK
}
__device__ __forceinline__ void pv_d0(f32x16* o, int vb, bf16x8 pa0, bf16x8 pa1, bf16x8 pa2, bf16x8 pa3) {
  pv_one<0>(o[0], vb, pa0, pa1, pa2, pa3); pv_one<1>(o[1], vb, pa0, pa1, pa2, pa3); pv_one<2>(o[2], vb, pa0, pa1, pa2, pa3); pv_one<3>(o[3], vb, pa0, pa1, pa2, pa3);
}
template <int DQK, int LDQ, int LDK, int LDV, int LDO, int SDEPTH, int QL>
__device__ __forceinline__ void attn_body(const bf16_t* __restrict__ Qb, const bf16_t* __restrict__ Kh, const bf16_t* __restrict__ Vh, bf16_t* __restrict__ Ob, int seq, char* lds, const float scale) {
  constexpr int NKC = DQK / 64;
  constexpr size_t SHM_K = shm_k<DQK>();
  const float C = scale * 1.4426950408889634f, thr_raw = THR / scale;
  const int tid = ph_tid(), wid = tid >> 6, lane = tid & 63, r32 = lane & 31, hi = lane >> 5;
  char* V_lds = lds; char* K_lds = lds + 2 * SHM_V;
  float* wsf = (float*)(lds + 2 * SHM_V + 2 * SHM_K) + wid * 64; float* li_l = wsf; float* al_l = wsf + 32;
  float m_reg = -1e30f, l_reg = 0; f32x16 o[4] = {}; bf16x8 qr[DQK / 16 - QL];
  const bf16_t* Qw = Qb + (long)(wid * QBLK + r32) * LDQ + hi * 8;
#pragma unroll
  for (int d0 = 0; d0 < DQK / 16 - QL; ++d0) qr[d0] = *reinterpret_cast<const bf16x8*>(Qw + d0 * 16);
  char* qlds = lds + 2 * SHM_V + 2 * SHM_K + NW * 64 * 4 + (wid * QBLK + r32) * QL_PITCH + hi * 16;
#pragma unroll
  for (int d0 = 0; d0 < QL; ++d0) *reinterpret_cast<bf16x8*>(qlds + d0 * 32) = *reinterpret_cast<const bf16x8*>(Qw + (DQK / 16 - QL + d0) * 16);
  const int sr = tid >> 4, sc = (tid & 15) * 8, vst0 = v_st(sr, sc), vst1 = v_st(32 + sr, sc);
  int kgo[NKC], klo[NKC];
#pragma unroll
  for (int i = 0; i < NKC; ++i) { const int c = tid + 512 * i, kr = c / (DQK / 8), kc = (c % (DQK / 8)) * 8; kgo[i] = kr * LDK + kc; klo[i] = kswz<DQK>(kr, kc * 2); }
  const int vgo = sr * LDV + sc;
  int ka[4];
#pragma unroll
  for (int q = 0; q < 4; ++q) ka[q] = r32 * (DQK * 2) + ((q * 32 + hi * 16) ^ ((r32 & 7) << 4));
  const __amdgpu_buffer_rsrc_t rK = __builtin_amdgcn_make_buffer_rsrc((void*)Kh, 0, 0x7ffffffc, 0x00020000), rV = __builtin_amdgcn_make_buffer_rsrc((void*)Vh, 0, 0x7ffffffc, 0x00020000);
  const int vb0 = (int)(uintptr_t)V_lds + v_rd_base(lane);
  struct { bf16x8 vs0, vs1, ks[NKC]; } sr_[SDEPTH];
#define ATT_SLOAD(i, k0) do { const int _vo = (k0) * (LDV * 2), _ko = (k0) * (LDK * 2); sr_[i].vs0 = bl(rV, vgo * 2, _vo); sr_[i].vs1 = bl(rV, vgo * 2 + 64 * LDV, _vo); \
    _Pragma("unroll") for (int _c = 0; _c < NKC; ++_c) sr_[i].ks[_c] = bl(rK, kgo[_c] * 2, _ko); } while (0)
#define ATT_SWRITE(b, i) do { *(bf16x8*)(V_lds + (b) * SHM_V + vst0) = sr_[i].vs0; *(bf16x8*)(V_lds + (b) * SHM_V + vst1) = sr_[i].vs1; \
    _Pragma("unroll") for (int _c = 0; _c < NKC; ++_c) *(bf16x8*)(K_lds + (b) * SHM_K + klo[_c]) = sr_[i].ks[_c]; } while (0)
#define ATT_SWAIT() asm volatile("s_waitcnt vmcnt(%0)" :: "n"(SDEPTH == 2 ? 2 + NKC : 0) : "memory")
#define ATT_RESC(a) do { if (__any((a) < 1.f)) { if (hi == 0) al_l[r32] = (a); asm volatile("s_waitcnt lgkmcnt(0)" ::: "memory"); \
    _Pragma("unroll") for (int d = 0; d < 4; ++d) _Pragma("unroll") for (int r = 0; r < 16; ++r) o[d][r] *= al_l[crow(r, hi)]; } } while (0)
  f32x16 pA0, pA1, pB0, pB1; float mnA, mnB, alA, alB; bf16x8 pa0, pa1, pa2, pa3; const int NT = seq / KVBLK;
  constexpr int SE = 0, SO = SDEPTH - 1;
  ATT_SLOAD(SE, 0); asm volatile("s_waitcnt vmcnt(0)" ::: "memory"); ATT_SWRITE(0, SE); __syncthreads();
  qkt<DQK, QL>(pA0, pA1, K_lds, qr, qlds, ka); partialSM(pA0, pA1, m_reg, mnA, alA, C, thr_raw);
  ATT_SLOAD(SO, KVBLK); if (SDEPTH == 2) { if (2 < NT) ATT_SLOAD(SE, 2 * KVBLK); }
  ATT_SWAIT(); ATT_SWRITE(1, SO); __syncthreads();
  for (int j = 1; j + 1 < NT; j += 2) {
    ATT_SBAR(); qkt<DQK, QL>(pB0, pB1, K_lds + SHM_K, qr, qlds, ka);
    finishSM(pA0, pA1, alA, l_reg, pa0, pa1, pa2, pa3); ATT_SBAR();
    ATT_SLOAD(SO, (j + SDEPTH) * KVBLK); ATT_SBAR();
    pv_d0(o, vb0, pa0, pa1, pa2, pa3); partialSM(pB0, pB1, m_reg, mnB, alB, C, thr_raw);
    __syncthreads(); ATT_SWAIT(); ATT_SWRITE(0, SE);
    ATT_RESC(alB); __syncthreads();
    ATT_SBAR(); qkt<DQK, QL>(pA0, pA1, K_lds, qr, qlds, ka);
    finishSM(pB0, pB1, alB, l_reg, pa0, pa1, pa2, pa3); ATT_SBAR();
    if (SDEPTH == 1 || j + 3 < NT) ATT_SLOAD(SE, (j + 1 + SDEPTH) * KVBLK); ATT_SBAR();
    pv_d0(o, vb0 + (int)SHM_V, pa0, pa1, pa2, pa3); partialSM(pA0, pA1, m_reg, mnA, alA, C, thr_raw);
    __syncthreads(); ATT_SWAIT(); ATT_SWRITE(1, SO);
    ATT_RESC(alA); __syncthreads();
  }
  ATT_SBAR(); qkt<DQK, QL>(pB0, pB1, K_lds + SHM_K, qr, qlds, ka);
  finishSM(pA0, pA1, alA, l_reg, pa0, pa1, pa2, pa3); ATT_SBAR();
  pv_d0(o, vb0, pa0, pa1, pa2, pa3); partialSM(pB0, pB1, m_reg, mnB, alB, C, thr_raw);
  __syncthreads(); ATT_RESC(alB);
  finishSM(pB0, pB1, alB, l_reg, pa0, pa1, pa2, pa3); ATT_SBAR();
  pv_d0(o, vb0 + (int)SHM_V, pa0, pa1, pa2, pa3);
  { const int t2 = ph_tid(), l2 = t2 & 63, w2 = t2 >> 6, r2 = l2 & 31, h2 = l2 >> 5;
    float* li2 = (float*)(lds + 2 * SHM_V + 2 * SHM_K) + w2 * 64;
    if (h2 == 0) li2[r2] = l_reg; asm volatile("s_waitcnt lgkmcnt(0)" ::: "memory");
    bf16_t* Ow = Ob + (w2 * QBLK) * LDO + r2;
#pragma unroll
    for (int r = 0; r < 16; ++r) { const int orow = crow(r, h2); const float rl = __builtin_amdgcn_rcpf(li2[orow]);
#pragma unroll
      for (int d0 = 0; d0 < 4; ++d0) Ow[orow * LDO + d0 * 32] = (bf16_t)(cvtpk(o[d0][r] * rl, 0.f) & 0xffffu); } }
  __syncthreads();
#undef ATT_SLOAD
#undef ATT_SWRITE
#undef ATT_SWAIT
#undef ATT_RESC
}

template <int DQK, int LDQ, int LDK, int LDV, int LDO>
__device__ __forceinline__ void attn_body_s1(const bf16_t* __restrict__ Qb, const bf16_t* __restrict__ Kh, const bf16_t* __restrict__ Vh, bf16_t* __restrict__ Ob, int seq, char* lds, const float scale) {
  constexpr int NKC = DQK / 64; constexpr size_t SHM_K = shm_k<DQK>();
  const float C = scale * 1.4426950408889634f, thr_raw = THR / scale;
  const int tid = ph_tid(), wid = tid >> 6, lane = tid & 63, r32 = lane & 31, hi = lane >> 5;
  char* V_lds = lds; char* K_lds = lds + 2 * SHM_V;
  float* wsf = (float*)(lds + 2 * SHM_V + 2 * SHM_K) + wid * 64; float* li_l = wsf; float* al_l = wsf + 32;
  float m_reg = -1e30f, l_reg = 0; f32x16 o[4] = {}; bf16x8 qr[DQK / 16];
  const bf16_t* Qw = Qb + (long)(wid * QBLK + r32) * LDQ + hi * 8;
#pragma unroll
  for (int d0 = 0; d0 < DQK / 16; ++d0) qr[d0] = *reinterpret_cast<const bf16x8*>(Qw + d0 * 16);
  const int sr = tid >> 4, sc = (tid & 15) * 8, vst0 = v_st(sr, sc), vst1 = v_st(32 + sr, sc);
  int kgo[NKC], klo[NKC];
#pragma unroll
  for (int i = 0; i < NKC; ++i) { const int c = tid + 512 * i, kr = c / (DQK / 8), kc = (c % (DQK / 8)) * 8; kgo[i] = kr * LDK + kc; klo[i] = kswz<DQK>(kr, kc * 2); }
  const int vgo = sr * LDV + sc;
  int ka[4];
#pragma unroll
  for (int q = 0; q < 4; ++q) ka[q] = r32 * (DQK * 2) + ((q * 32 + hi * 16) ^ ((r32 & 7) << 4));
  const __amdgpu_buffer_rsrc_t rK = __builtin_amdgcn_make_buffer_rsrc((void*)Kh, 0, 0x7ffffffc, 0x00020000), rV = __builtin_amdgcn_make_buffer_rsrc((void*)Vh, 0, 0x7ffffffc, 0x00020000);
  const int vb0 = (int)(uintptr_t)V_lds + v_rd_base(lane);
  bf16x8 vs0, vs1, ks[NKC];
#define ATT1_SLOAD(k0) do { const int _vo = (k0) * (LDV * 2), _ko = (k0) * (LDK * 2); vs0 = bl(rV, vgo * 2, _vo); vs1 = bl(rV, vgo * 2 + 64 * LDV, _vo); \
    _Pragma("unroll") for (int _c = 0; _c < NKC; ++_c) ks[_c] = bl(rK, kgo[_c] * 2, _ko); } while (0)
#define ATT1_SWRITE(b) do { *(bf16x8*)(V_lds + (b) * SHM_V + vst0) = vs0; *(bf16x8*)(V_lds + (b) * SHM_V + vst1) = vs1; \
    _Pragma("unroll") for (int _c = 0; _c < NKC; ++_c) *(bf16x8*)(K_lds + (b) * SHM_K + klo[_c]) = ks[_c]; } while (0)
  const int NT = seq / KVBLK;
  ATT1_SLOAD(0); asm volatile("s_waitcnt vmcnt(0)" ::: "memory"); ATT1_SWRITE(0);
  ATT1_SLOAD(KVBLK); asm volatile("s_waitcnt vmcnt(0)" ::: "memory"); ATT1_SWRITE(1); __syncthreads();
  for (int j = 0; j < NT; ++j) { const int b = j & 1;
    ATT_SBAR();
    f32x16 p0, p1; float mn, al; bf16x8 pa0, pa1, pa2, pa3;
    qkt<DQK, 0>(p0, p1, K_lds + b * SHM_K, qr, nullptr, ka);
    partialSM(p0, p1, m_reg, mn, al, C, thr_raw);
    if (__any(al < 1.f)) { if (hi == 0) al_l[r32] = al; asm volatile("s_waitcnt lgkmcnt(0)" ::: "memory");
#pragma unroll
      for (int d = 0; d < 4; ++d)
#pragma unroll
        for (int r = 0; r < 16; ++r) o[d][r] *= al_l[crow(r, hi)]; }
    finishSM(p0, p1, al, l_reg, pa0, pa1, pa2, pa3); ATT_SBAR();
    if (j + 2 < NT) ATT1_SLOAD((j + 2) * KVBLK);
    ATT_SBAR();
    pv_d0(o, vb0 + b * (int)SHM_V, pa0, pa1, pa2, pa3);
    __syncthreads();
    if (j + 2 < NT) { asm volatile("s_waitcnt vmcnt(0)" ::: "memory"); ATT1_SWRITE(b); } }
  { const int t2 = ph_tid(), l2 = t2 & 63, w2 = t2 >> 6, r2 = l2 & 31, h2 = l2 >> 5;
    float* li2 = (float*)(lds + 2 * SHM_V + 2 * SHM_K) + w2 * 64;
    if (h2 == 0) li2[r2] = l_reg; asm volatile("s_waitcnt lgkmcnt(0)" ::: "memory");
    bf16_t* Ow = Ob + (w2 * QBLK) * LDO + r2;
#pragma unroll
    for (int r = 0; r < 16; ++r) { const int orow = crow(r, h2); const float rl = __builtin_amdgcn_rcpf(li2[orow]);
#pragma unroll
      for (int d0 = 0; d0 < 4; ++d0) Ow[orow * LDO + d0 * 32] = (bf16_t)(cvtpk(o[d0][r] * rl, 0.f) & 0xffffu); } }
  __syncthreads();
#undef ATT1_SLOAD
#undef ATT1_SWRITE
}
template <int TYPE> __device__ __forceinline__ void attn_unit(const Params& p, int u, char* lds) {
  bf16_t* P = WSP(bf16_t, p, regA); bf16_t* OA = WSP(bf16_t, p, oall);
  int type, b, h, qb;
  if (u < 256) { const int x = u & 7, idx = u >> 3; type = idx >> 4; b = x >> 2;
    if (TYPE == 0) { qb = idx & 15; h = x & 3; }
    else { const int i = idx & 15, kvh = (x >> 1) & 1; h = 2 * kvh + (i & 1); qb = (x & 1) * 8 + (i >> 1); } }
  else { const int v = u - 256; type = v >> 3; b = (v >> 2) & 1; h = v & 3; qb = SEQ / 256; }
  const long q0 = (long)b * NTOK + qb * 256, k0 = (long)b * NTOK + (qb == SEQ / 256 ? SEQ : 0); const int seq = (qb == SEQ / 256) ? CTXL : NTOK;
  if (TYPE == 0) attn_body<MQK, MH * MQK, MH * MQK, MH * MV, DM, 1, 0>(WSP(bf16_t, p, qm) + q0 * (MH * MQK) + h * MQK, WSP(bf16_t, p, km) + k0 * (MH * MQK) + h * MQK, WSP(bf16_t, p, vm) + k0 * (MH * MV) + h * MV,
                                                                 OA + q0 * DM + 3 * BW + h * MV, seq, lds, 0.07216878364870322f  );
  else attn_body<GHD, PW, PW, PW, DM, ATT_SD_GQA, 0>(P + q0 * PW + OFF_GQ + h * GHD, P + k0 * PW + OFF_GK + (h / (GH / GKV)) * GHD, P + k0 * PW + OFF_GV + (h / (GH / GKV)) * GHD,
                                      OA + q0 * DM + BW + h * GHD, seq, lds, 0.08838834764831845f  );
}
}
template <int TYPE> __global__ __launch_bounds__(512, 2) void k_attn(Params p, int l) {
  extern __shared__ __attribute__((aligned(16))) unsigned char shm[];
  const int nu = 256 + (l == 0 ? 16 : 0);
  for (int u = blockIdx.x; u < nu; u += gridDim.x) { const int type = u < 256 ? ((u >> 3) >> 4) : ((u - 256) >> 3); if (type == TYPE) att::attn_unit<TYPE>(p, u, (char*)shm); }
}
#endif
#ifndef CPU_TEST
namespace ret {
using pg8::f32x4; using pg8::u32x4; using pg8::bf16x8;
static_assert(RCH == 128 && RQK == 64 && RV == 128, "retention tiles are written for chunk 128, qk 64, v 128");
constexpr int PT_ = 272, PS = 528, PQ = 144;
constexpr int LDS_A = 2 * 128 * PT_, LDS_C = 128 * PQ + 2 * 128 * PS + 2 * 132 * 4;
template <int NB, int KS> __device__ __forceinline__ void mma16(f32x4 (&acc)[NB], const LAS char* A, int lda, const LAS char* Bt, int ldb) {
  const int lane = ph_tid() & 63, r = lane & 15, kq = lane >> 4;
#pragma unroll
  for (int s = 0; s < KS; ++s) { const bf16x8 a = *(const LAS bf16x8*)(A + r * lda + (s * 32 + kq * 8) * 2);
#pragma unroll
    for (int nb = 0; nb < NB; ++nb) { const bf16x8 bfr = *(const LAS bf16x8*)(Bt + (nb * 16 + r) * ldb + (s * 32 + kq * 8) * 2); acc[nb] = __builtin_amdgcn_mfma_f32_16x16x32_bf16(a, bfr, acc[nb], 0, 0, 0); } }
}
__device__ __forceinline__ long chunk_row0(int b, int cs) { return (long)b * NTOK + (cs < SEQ / RCH ? cs * RCH : SEQ + (cs - SEQ / RCH) * RCH); }
__device__ __forceinline__ void st16(LAS char* p, unsigned v) { *(LAS unsigned short*)p = (unsigned short)v; }
template <int NC, bool WEIGHT, int PT> __device__ __forceinline__ void stage_T(LAS char* T, LAS char* T2, const bf16_t* src, int ld, float lg1, float lg2) {
  const int tidq = ph_tid();
#pragma unroll
  for (int i = 0; i < NC / 4; ++i) { const int id = tidq + 512 * i, key = id & 127, c = id >> 7; const u32x4 w = *(const u32x4*)(src + (long)key * ld + 8 * c);
    if (!WEIGHT) {
      st16(T + (8 * c + 0) * PT + key * 2, w.x); st16(T + (8 * c + 1) * PT + key * 2, w.x >> 16); st16(T + (8 * c + 2) * PT + key * 2, w.y); st16(T + (8 * c + 3) * PT + key * 2, w.y >> 16);
      st16(T + (8 * c + 4) * PT + key * 2, w.z); st16(T + (8 * c + 5) * PT + key * 2, w.z >> 16); st16(T + (8 * c + 6) * PT + key * 2, w.w); st16(T + (8 * c + 7) * PT + key * 2, w.w >> 16);
    } else { f32x4 a, b2; pg8::unpack8(w, a, b2); const float w1 = __expf(lg1 * (float)(RCH - 1 - key)), w2 = __expf(lg2 * (float)key);
#pragma unroll
      for (int j = 0; j < 4; ++j) { st16(T + (8 * c + j) * PT + key * 2, pg8::cvt_pk_bf16(a[j] * w1, 0.f)); st16(T + (8 * c + 4 + j) * PT + key * 2, pg8::cvt_pk_bf16(b2[j] * w1, 0.f));
        st16(T2 + (8 * c + j) * PT + key * 2, pg8::cvt_pk_bf16(a[j] * w2, 0.f)); st16(T2 + (8 * c + 4 + j) * PT + key * 2, pg8::cvt_pk_bf16(b2[j] * w2, 0.f)); } } }
}
__device__ __forceinline__ void ret_a_unit(const Params& p, int l, int u, LAS char* lds) {
  const int cs = u % RNC, h = (u / RNC) % RH, b = u / (RNC * RH), tidu = ph_tid(), wv = tidu >> 6, lane = tidu & 63;
  const float lgf = -__expf(p.in[I_RDF][l * RH + h]), lgb = -__expf(p.in[I_RDB][l * RH + h]);
  const bf16_t* P = WSP(bf16_t, p, regA) + chunk_row0(b, cs) * PW; LAS char* VT = lds; LAS char* KT = lds + 128 * PT_;
  stage_T<16, false, PT_>(VT, nullptr, P + OFF_RV + h * RV, PW, 0.f, 0.f);
  stage_T<8, true, PT_>(KT, KT + 64 * PT_, P + OFF_RK + h * RQK, PW, lgf, lgb);
  __syncthreads();
  f32x4 acc[8];
#pragma unroll
  for (int nb = 0; nb < 8; ++nb) acc[nb] = (f32x4){0.f, 0.f, 0.f, 0.f};
  mma16<8, 4>(acc, VT + wv * 16 * PT_, PT_, KT, PT_);
  float* RKV = WSP(float, p, rkv);
#pragma unroll
  for (int nb = 0; nb < 8; ++nb) { const int col = nb * 16 + (lane & 15), dir = col >> 6, dk = col & 63; float* o = RKV + ((((long)(b * RH + h) * 2 + dir) * RNC + cs) * RV + wv * 16 + (lane >> 4) * 4) * RQK + dk;
#pragma unroll
    for (int r = 0; r < 4; ++r) o[r * RQK] = acc[nb][r]; }
  __syncthreads();
}
__device__ __forceinline__ void ph_ret_scan(const Params& p, int l) {
  const float* RKV = WSP(float, p, rkv); bf16_t* RS = WSP(bf16_t, p, rs); constexpr int NL = SEQ / RCH, NCX = CTXL / RCH;
  for (long i = (long)blockIdx.x * 512 + ph_tid(); i < (long)NB * RH * 2 * RV * RQK; i += (long)gridDim.x * 512) { const int e = (int)(i % (RV * RQK)), dir = (int)((i / (RV * RQK)) % 2), h = (int)((i / (2 * RV * RQK)) % RH), b = (int)(i / (2 * RV * RQK * RH));
    const float lg = -__expf(p.in[dir ? I_RDB : I_RDF][l * RH + h]), dec = __expf(lg * (float)RCH); const long base = (((long)(b * RH + h) * 2 + dir) * RNC) * (RV * RQK) + e; float S = 0.f;
    for (int s0 = 0; s0 < RNC; s0 += 17) { float kv[17]; int cs_[17];
#pragma unroll
      for (int q = 0; q < 17; ++q) { const int s = s0 + q; cs_[q] = dir == 0 ? (s < NCX ? NL + s : s - NCX) : (RNC - 1 - s); kv[q] = RKV[base + (long)cs_[q] * (RV * RQK)]; }
#pragma unroll
      for (int q = 0; q < 17; ++q) { RS[base + (long)cs_[q] * (RV * RQK)] = (bf16_t)(pg8::cvt_pk_bf16(S, 0.f) & 0xffffu); S = dec * S + kv[q]; } } }
}
__device__ __forceinline__ void ret_c_unit(const Params& p, int l, int u, LAS char* lds) {
  const int ncs = (l == NLAYER - 1) ? SEQ / RCH : RNC; const int cs = u % ncs, h = (u / ncs) % RH, b = u / (ncs * RH), tid = ph_tid(), wv = tid >> 6, lane = tid & 63;
  const float lgf = -__expf(p.in[I_RDF][l * RH + h]), lgb = -__expf(p.in[I_RDB][l * RH + h]); const long R0 = chunk_row0(b, cs);
  const bf16_t* P = WSP(bf16_t, p, regA) + R0 * PW; LAS char* Ks = lds; LAS char* Ss = lds + 128 * PQ; LAS char* B2 = Ss + 128 * PS; LAS float* gf = (LAS float*)(B2 + 128 * PS); LAS float* gb = gf + 132;
  if (tid < 129) { gf[tid] = __expf(lgf * (float)tid); gb[tid] = __expf(lgb * (float)tid); }
#pragma unroll
  for (int i = 0; i < 2; ++i) { const int id = tid + 512 * i, row = id >> 3, c = id & 7; *(LAS u32x4*)(Ks + row * PQ + c * 16) = *(const u32x4*)(P + (long)row * PW + OFF_RK + h * RQK + 8 * c);
    *(LAS u32x4*)(Ss + row * PS + 256 + c * 16) = *(const u32x4*)(P + (long)row * PW + OFF_RQ + h * RQK + 8 * c); }
  stage_T<16, false, PS>(B2, nullptr, P + OFF_RV + h * RV, PW, 0.f, 0.f);
  { const bf16_t* RS = WSP(bf16_t, p, rs);
#pragma unroll
    for (int i = 0; i < 4; ++i) { const int id = tid + 512 * i, dir = id >> 10, dv = (id >> 3) & 127, c = id & 7;
      *(LAS u32x4*)(B2 + dv * PS + 256 + dir * 128 + c * 16) = *(const u32x4*)(RS + ((((long)(b * RH + h) * 2 + dir) * RNC + cs) * RV + dv) * RQK + 8 * c); } }
  __syncthreads();
  LAS char* myS = Ss + wv * 16 * PS;
  { f32x4 acc[8];
#pragma unroll
    for (int nb = 0; nb < 8; ++nb) acc[nb] = (f32x4){0.f, 0.f, 0.f, 0.f};
    mma16<8, 2>(acc, myS + 256, PS, Ks, PQ);
#pragma unroll
    for (int nb = 0; nb < 8; ++nb) { const int a2 = nb * 16 + (lane & 15);
#pragma unroll
      for (int r = 0; r < 4; ++r) { const int ar = (lane >> 4) * 4 + r, a = wv * 16 + ar; const float f = a2 <= a ? gf[a - a2] : gb[a2 - a]; st16(myS + ar * PS + a2 * 2, pg8::cvt_pk_bf16(acc[nb][r] * f, 0.f)); } } }
#pragma unroll
  for (int i = 0; i < 2; ++i) { const int id = lane + 64 * i, ar = id >> 3, c = id & 7, a = wv * 16 + ar; LAS char* q = myS + ar * PS + 256 + c * 16; f32x4 x0, x1; pg8::unpack8(*(const LAS u32x4*)q, x0, x1);
    const float sf = gf[a + 1], sb = gb[RCH - a]; *(LAS u32x4*)(q + 128) = pg8::pack8(x0 * sb, x1 * sb); *(LAS u32x4*)q = pg8::pack8(x0 * sf, x1 * sf); }
  asm volatile("s_waitcnt lgkmcnt(0)" ::: "memory");
  f32x4 o[8];
#pragma unroll
  for (int nb = 0; nb < 8; ++nb) o[nb] = (f32x4){0.f, 0.f, 0.f, 0.f};
  mma16<8, 8>(o, myS, PS, B2, PS);
#pragma unroll
  for (int r = 0; r < 4; ++r) { float s = 0.f;
#pragma unroll
    for (int nb = 0; nb < 8; ++nb) s += o[nb][r];
    s += __shfl_xor(s, 8); s += __shfl_xor(s, 4); s += __shfl_xor(s, 2); s += __shfl_xor(s, 1); const float mean = s * (1.f / RV); float q = 0.f;
#pragma unroll
    for (int nb = 0; nb < 8; ++nb) { const float d = o[nb][r] - mean; q += d * d; }
    q += __shfl_xor(q, 8); q += __shfl_xor(q, 4); q += __shfl_xor(q, 2); q += __shfl_xor(q, 1); const float rs = 1.f / sqrtf(q * (1.f / RV) + NORM_EPS);
    const int ar = (lane >> 4) * 4 + r;
#pragma unroll
    for (int nb = 0; nb < 8; ++nb) *(LAS float*)(myS + ar * PS + (nb * 16 + (lane & 15)) * 4) = (o[nb][r] - mean) * rs; }
  asm volatile("s_waitcnt lgkmcnt(0)" ::: "memory");
  { const float* gain = p.in[I_RNORM] + l * BW + h * RV; bf16_t* OA = WSP(bf16_t, p, oall); const int ar = lane >> 2, c4 = lane & 3; const long R = R0 + wv * 16 + ar;
    u32x4 gt[4];
#pragma unroll
    for (int it = 0; it < 4; ++it) gt[it] = *(const u32x4*)(P + (long)(wv * 16 + ar) * PW + OFF_RG + h * RV + (c4 + 4 * it) * 8);
#pragma unroll
    for (int it = 0; it < 4; ++it) { const int dv = (c4 + 4 * it) * 8; const LAS float* q = (const LAS float*)(myS + ar * PS + dv * 4); f32x4 x0 = *(const LAS f32x4*)q, x1 = *(const LAS f32x4*)(q + 4), g0, g1; pg8::unpack8(gt[it], g0, g1);
      x0 = x0 * *(const f32x4*)(gain + dv) * g0 * pg8::sigmoid4(g0); x1 = x1 * *(const f32x4*)(gain + dv + 4) * g1 * pg8::sigmoid4(g1);
      *(u32x4*)(OA + R * DM + 2 * BW + h * RV + dv) = pg8::pack8(x0, x1); } }
  __syncthreads();
}
}
template <int WHICH> __global__ __launch_bounds__(512, 2) void k_ret(Params p, int l) {
  extern __shared__ __attribute__((aligned(16))) unsigned char shm[]; LAS char* lds = (LAS char*)shm;
  if (WHICH == 0) for (int u = blockIdx.x; u < NB * RH * RNC; u += gridDim.x) ret::ret_a_unit(p, l, u, lds);
  if (WHICH == 1) ret::ph_ret_scan(p, l);
  if (WHICH == 2) { const int nu = NB * RH * ((l == NLAYER - 1) ? SEQ / RCH : RNC); for (int u = blockIdx.x; u < nu; u += gridDim.x) ret::ret_c_unit(p, l, u, lds); }
}
#endif
#ifndef CPU_TEST
#define XB_TMO      128
#define XB_XCNT(j)  (256  + 64 * (j))
#define XB_XSUB(j)  (1280 + 64 * (j))
#define XB_XGEN(j)  (2304 + 64 * (j))
#define XB_TOP      3328
#define XB_TOPGEN   3392
#define XCD_BAR_WORDS 3456
#define XB_SPIN_CAP (1u << 18)

__device__ __forceinline__ unsigned xb_ld(unsigned* p)              { return __hip_atomic_load(p, __ATOMIC_RELAXED, __HIP_MEMORY_SCOPE_AGENT); }
__device__ __forceinline__ unsigned xb_add(unsigned* p, unsigned v) { return __hip_atomic_fetch_add(p, v, __ATOMIC_RELAXED, __HIP_MEMORY_SCOPE_AGENT); }
__device__ __forceinline__ unsigned xb_xcc_id() { return (unsigned)__builtin_amdgcn_s_getreg((3 << 11) | 20) & 0xFu; }
#define XB_SPIN(cond, bar) do { unsigned _sp = 0; while (cond) { __builtin_amdgcn_s_sleep(1); \
    if ((++_sp & 255u) == 0u) { if (xb_ld(&(bar)[XB_TMO])) break; if (_sp > XB_SPIN_CAP) { atomicAdd(&(bar)[XB_TMO], 1u); break; } } } } while (0)

struct XcdBarrier {
    unsigned* bar; unsigned x;
    volatile LAS unsigned* st;
};

__device__ __forceinline__ XcdBarrier xcd_barrier_post(unsigned* bar, volatile LAS unsigned* st) {
    XcdBarrier b; b.bar = bar; b.x = xb_xcc_id(); b.st = st;
    if (threadIdx.x == 0) (void)xb_add(&bar[XB_XCNT(b.x)], 1u);
    return b;
}
__device__ __forceinline__ void xcd_barrier_complete(unsigned* bar, unsigned x, unsigned& nloc, unsigned& nx) {
    const unsigned G = gridDim.x * gridDim.y * gridDim.z;
    unsigned sum, cnt, mine, sp = 0u;
    for (;;) {
        sum = 0u; cnt = 0u; mine = 0u;
#pragma unroll
        for (unsigned j = 0; j < 16; ++j) { const unsigned c = xb_ld(&bar[XB_XCNT(j)]); sum += c; cnt += (c > 0u) ? 1u : 0u; mine = (j == x) ? c : mine; }
        if (sum == G) break;
        __builtin_amdgcn_s_sleep(1);
        if ((++sp & 255u) == 0u) { if (xb_ld(&bar[XB_TMO])) break; if (sp > XB_SPIN_CAP) { atomicAdd(&bar[XB_TMO], 1u); break; } }
    }
    nloc = mine > 0u ? mine : 1u; nx = cnt > 0u ? cnt : 1u;
}

__device__ __forceinline__ void xcd_barrier(const XcdBarrier& b) {
    asm volatile("s_waitcnt vmcnt(0)" ::: "memory");
    __syncthreads();
    if (threadIdx.x == 0) {
        unsigned* bar = b.bar;
        __builtin_amdgcn_s_waitcnt(0);
        unsigned nloc = b.st[0], nx = b.st[1];
        if (nloc == 0u) { xcd_barrier_complete(bar, b.x, nloc, nx); b.st[0] = nloc; b.st[1] = nx; }
        const unsigned old = xb_add(&bar[XB_XSUB(b.x)], 1u);
        const unsigned gen = old / nloc;
        if (old + 1u == (gen + 1u) * nloc) {
            __builtin_amdgcn_fence(__ATOMIC_RELEASE, "agent");
            asm volatile("s_waitcnt vmcnt(0)" ::: "memory");
            const unsigned og = xb_add(&bar[XB_TOP], 1u);
            const unsigned tg = og / nx;
            if (og + 1u == (tg + 1u) * nx) xb_add(&bar[XB_TOPGEN], 1u);
            else XB_SPIN(xb_ld(&bar[XB_TOPGEN]) == tg, bar);
            __builtin_amdgcn_fence(__ATOMIC_ACQUIRE, "agent");
            xb_add(&bar[XB_XGEN(b.x)], 1u);
            asm volatile("s_waitcnt vmcnt(0)" ::: "memory");
        } else {
            XB_SPIN(xb_ld(&bar[XB_XGEN(b.x)]) == gen, bar);
            __builtin_amdgcn_fence(__ATOMIC_ACQUIRE, "agent");
            asm volatile("s_waitcnt vmcnt(0)" ::: "memory");
        }
    }
    __syncthreads();
}

#endif
#ifndef CPU_TEST
#include <type_traits>
constexpr int MEGA_LDS = ((ret::LDS_C > pg8::STAGE_BYTES ? ret::LDS_C : pg8::STAGE_BYTES) + 255) / 256 * 256 + 256;
typedef const __attribute__((address_space(4))) Params* KParamsPtr;
__device__ __forceinline__ Params kparams() {
#if defined(__HIP_DEVICE_COMPILE__)
  KParamsPtr k = (KParamsPtr)__builtin_amdgcn_kernarg_segment_ptr(); asm volatile("" : "+s"(k)); Params r; __builtin_memcpy(&r, k, sizeof(Params)); return r;
#else
  return Params{};
#endif
}
__device__ __forceinline__ int rotc(int off) { const int G = gridDim.x; return (int)((ph_bid() + G - (off % G)) % G); }

#ifndef MK_XCD_UP
#define MK_XCD_UP 1
#endif
#ifndef MK_XCD_DN
#define MK_XCD_DN 1
#endif
#ifndef MK_DBL
#define MK_DBL 0
#endif
#define REPS(id) ((MK_DBL) == (id) ? 2 : 1)
#ifndef MK_WAITMASK
#define MK_WAITMASK 0xffffffffffffffffull
#endif
#define CONVQ_COUNTER ((unsigned*)(p.ws + WS.bar) + XCD_BAR_WORDS)
#define CONVQ_ARRIVED(k) ((unsigned*)(p.ws + WS.bar) + XCD_BAR_WORDS + 64 * (1 + (k)))
#ifndef MK_BGCONV
#define MK_BGCONV 1
#endif
#define BG_IDLE() do { if (MK_BGCONV && convq_alive) { if (threadIdx.x == 0) __hip_atomic_fetch_add(CONVQ_ARRIVED(bar_idx), 1u, __ATOMIC_RELAXED, __HIP_MEMORY_SCOPE_AGENT); \
    __syncthreads(); convq_alive = ph::conv_work<ph::CLAIM_IDLE>(p, lds, CONVQ_COUNTER, 0, CONVQ_ARRIVED(bar_idx)); } ++bar_idx; } while (0)
#ifdef MK_WAITPROBE
#define BARX() do { const unsigned long long t0_ = wall_clock64(); xcd_barrier(bar); if ((MK_WAITMASK >> bidx_) & 1ull) wait_acc += wall_clock64() - t0_; ++bidx_; if (blockIdx.x == (MK_WAITPROBE) && threadIdx.x == 0) ((unsigned long long*)(p.ws + WS.bar + 30720))[40] = wait_acc; } while (0)
#else
#define BARX() do { BG_IDLE(); xcd_barrier(bar); if ((MK_DBL) == 99) xcd_barrier(bar); } while (0)
#endif
#ifdef MK_PROBE_A
#define STAMP(k) do { if (blockIdx.x == 0 && threadIdx.x == 0) ((unsigned long long*)(p.ws + WS.bar + 30720))[k] = wall_clock64(); } while (0)
#else
#define STAMP(k) do { } while (0)
#endif
__global__ __launch_bounds__(512, 2) void mega(Params p_unused_) {
#define p (kparams())
  extern __shared__ __attribute__((aligned(16))) unsigned char shm[];
  LAS unsigned char* lds = (LAS unsigned char*)shm; char* ldsg = (char*)shm;
  LAS unsigned* xbw = (LAS unsigned*)(lds + MEGA_LDS - 16);
  if (threadIdx.x < 4) xbw[threadIdx.x] = 0u;
  __syncthreads();
  XcdBarrier bar = xcd_barrier_post((unsigned*)(p.ws + WS.bar), (volatile LAS unsigned*)xbw);
  STAMP(0);
  bool convq_alive = true; int bar_idx = 0;
#ifdef MK_WAITPROBE
  unsigned long long wait_acc = 0ull; int bidx_ = 0;
#endif
  using namespace pg8;
  const int G = gridDim.x;
#define P WSP(bf16_t, p, regA)
#define PROJ ((bf16_t*)(p.ws + WS.regA + SZ_P))
#define H1 WSP(bf16_t, p, h1)
#define QM WSP(bf16_t, p, qm)
#define KM WSP(bf16_t, p, km)
#define VM WSP(bf16_t, p, vm)
#define Z WSP(bf16_t, p, z)
#define OA WSP(bf16_t, p, oall)
#define XS WSP(bf16_t, p, regA)
#define ACT ((bf16_t*)(p.ws + WS.regA + SZ_XS))
#define YS ((bf16_t*)(p.ws + WS.regA + SZ_XS + SZ_ACT))
  constexpr int nMfull = MROWS / 256;

#ifdef MK_NANFILL
  {
    u32x4* q = (u32x4*)(p.ws + WS.x1); const long n1 = (long)(WS.s5sw - WS.x1) / 16; const u32x4 nanv = {0x7FC07FC0u, 0x7FC07FC0u, 0x7FC07FC0u, 0x7FC07FC0u};
    for (long i = (long)blockIdx.x * 512 + threadIdx.x; i < n1; i += (long)gridDim.x * 512) q[i] = nanv;
    u32x4* q2 = (u32x4*)(p.ws + WS.rkv); const long n2 = (long)(WS.end - WS.rkv) / 16;
    for (long i = (long)blockIdx.x * 512 + threadIdx.x; i < n2; i += (long)gridDim.x * 512) q2[i] = nanv; }
#endif
_Pragma("unroll") for (int rep_ = 0; rep_ < REPS(11); ++rep_) {
  ph::ph_s5tables(p, lds);
  ph::ph_tables(p);
  ph::ph_mod(p, lds, rotc(64));
    }
_Pragma("unroll") for (int rep_ = 0; rep_ < REPS(1); ++rep_) {
  ph::conv_work<ph::CLAIM_DRAIN>(p, lds, CONVQ_COUNTER, ph::CT_DENSE_L, nullptr);
    }
  BARX();
  STAMP(1);
_Pragma("unroll") for (int rep_ = 0; rep_ < REPS(19); ++rep_) {
  ph::ph_ln_in(p, 0);
    }
  BARX();
  STAMP(2);

  auto layer = [&](auto LC) __attribute__((always_inline)) { constexpr int l = decltype(LC)::value; constexpr int last = (l == NLAYER - 1), nMlat = last ? nMfull - 2 : nMfull;
_Pragma("unroll") for (int rep_ = 0; rep_ < REPS(2); ++rep_) {
    { SchedGrid S{(const char*)H1, (const char*)(WSP(bf16_t, p, wt_in) + (long)l * PW * DM), DM, DM, nMfull, PW / 256 - 1, 0, G, ph_bid(), 0};
      gemm_phase(lds, GemmG{DM, DM, DM, 0}, S, EpiBf16{P, PW, 0}); }
    }
    BARX();
    STAMP(2 + 15 * l + 1);
    ph::ph_post_proj(p, l);
    BARX();
    STAMP(2 + 15 * l + 2);
_Pragma("unroll") for (int rep_ = 0; rep_ < REPS(12); ++rep_) {
    { constexpr int NKR = MROWS / 256;
      const int vw = ph_bid() - NKR, G2 = G - NKR;
      if (vw < 0) { SchedKR S{(const char*)H1, (const char*)(WSP(bf16_t, p, wt_in) + (long)l * PW * DM), G, ph_bid()};
        gemm_phase<false, PG8_SP2>(lds, GemmG{DM, DM, DM, 0}, S, EpiKR{KM, WSP(float, p, rope_b)}); }
      else {
        { SchedGrid S{(const char*)(P + OFF_CQ), (const char*)(WSP(bf16_t, p, wt_uq) + (long)l * MH * MQK * MQL), PW, MQL, nMfull, MH * MQK / 256, 0, G2, vw, 0};
          gemm_phase<false, PG8_SP2>(lds, GemmG{PW, MQL, MQL, 0}, S, EpiQM{QM, WSP(float, p, rope_b)}); }
        { SchedGrid S{(const char*)(P + OFF_CKV), (const char*)(WSP(bf16_t, p, wt_ukv) + (long)l * MH * (MNOPE + MV) * MKVL), PW, MKVL, nMfull, MH, 0, G2, (vw + G2 - 102) % G2, 0};
          gemm_phase<false, PG8_SP2>(lds, GemmG{PW, MKVL, MKVL, 0}, S, EpiKVm{KM, VM}); }
        { SchedS5 S{(const char*)WSP(bf16_t, p, uh), (const char*)(WSP(bf16_t, p, s5sw) + (long)l * S5G * S5K2 * S5K1), (size_t)S5K2 * S5K1 * 2, G2, (vw + G2 - (238 % G2)) % G2};
          gemm_phase<false, PG8_SP2>(lds, GemmG{S5K1 + S5K2, S5K1, S5K1, 0}, S, EpiS5E{WSP(float, p, s5e)}); }
        for (int u = (vw + G2 - ((238 + 96) % G2)) % G2; u < NB * RH * RNC; u += G2) ret::ret_a_unit(p, l, u, (LAS char*)lds); } }
    }
    BARX();
    STAMP(2 + 15 * l + 3);
_Pragma("unroll") for (int rep_ = 0; rep_ < REPS(13); ++rep_) {
    ph::ph_s5scan(p, l);
    ret::ph_ret_scan(p, l);
    }
    BARX();
    STAMP(2 + 15 * l + 4);
_Pragma("unroll") for (int rep_ = 0; rep_ < REPS(4); ++rep_) {
_Pragma("unroll") for (int rq_ = 0; rq_ < REPS(21); ++rq_) {
    { const int w = ph_bid();
      if (w < 128) att::attn_unit<0>(p, w, ldsg); else if (w < 256) att::attn_unit<1>(p, w, ldsg);
      if (!last) { if (w >= 224 && w < 232) att::attn_unit<0>(p, 256 + (w - 224), ldsg); else if (w >= 240 && w < 248) att::attn_unit<1>(p, 256 + 8 + (w - 240), ldsg); } }
    }
_Pragma("unroll") for (int rq_ = 0; rq_ < REPS(22); ++rq_) {
    { SchedS5 S{(const char*)WSP(bf16_t, p, uh), (const char*)(WSP(bf16_t, p, s5sv) + (long)l * S5G * S5K1 * (S5K1 + S5K2)), (size_t)S5K1 * (S5K1 + S5K2) * 2, 96, ph_bid() - 128};
      if (ph_bid() >= 128 && ph_bid() < 224) gemm_phase<false, PG8_SP2>(lds, GemmG{S5K1 + S5K2, S5K1 + S5K2, S5K1 + S5K2, 0}, S, EpiS5Y{P, p.in[I_S5D] + (long)l * BW, Z, last, 0}); }
    }
_Pragma("unroll") for (int rq_ = 0; rq_ < REPS(23); ++rq_) {
    { const int nu = NB * RH * (last ? SEQ / RCH : RNC), w = ph_bid();
      if (w >= 128) for (int u = w - 128; u < nu; u += 128) ret::ret_c_unit(p, l, u, (LAS char*)lds); }
    }
    }
    BARX();
    STAMP(2 + 15 * l + 5);
_Pragma("unroll") for (int rep_ = 0; rep_ < REPS(14); ++rep_) {
    { SchedGrid S{(const char*)Z, (const char*)(WSP(bf16_t, p, wt_glu) + (long)l * BW * BW), BW, BW, nMlat, BW / 256, last, G, ph_bid(), 0};
      gemm_phase<false, PG8_SP2>(lds, GemmG{BW, BW, BW, 0}, S, EpiGluO{Z, OA}); }
    }
    BARX();
    STAMP(2 + 15 * l + 6);
_Pragma("unroll") for (int rep_ = 0; rep_ < REPS(6); ++rep_) {
    if (!last) { SchedGateCtx S{(const char*)H1, (const char*)(WSP(bf16_t, p, wt_gate) + (long)l * 4 * DM * DM), G, ph_bid()};
      gemm_phase(lds, GemmG{DM, DM, DM, 0}, S, EpiGateCtx{p.in[I_BGATE] + (long)l * 4 * DM, WSP(bf16_t, p, gctx)}); }
    { SchedProjW S{(const char*)OA, (const char*)(WSP(bf16_t, p, wt_br) + (long)l * 4 * DM * BW), nMlat, last, G, ph_bid(), last ? 0 : 64, 2, last ? 4 : 5, 0};
      gemm_phase(lds, GemmG{DM, BW, BW, 0}, S, EpiBf16{PROJ, 4 * DM, 0}); }
    }
    BARX();
    STAMP(2 + 15 * l + 7);
_Pragma("unroll") for (int rep_ = 0; rep_ < REPS(7); ++rep_) {
    if (!last) ph::ph_merge_ctx(p);
    { SchedGate4 S{(const char*)H1, (const char*)(WSP(bf16_t, p, wt_gate) + (long)l * 4 * DM * DM), G, ph_bid()};
      gemm_phase(lds, GemmG{DM, DM, DM, 1}, S, EpiGate4{p.in[I_BGATE] + (long)l * 4 * DM, PROJ, WSP(bf16_t, p, merged)}); }
    }
    BARX();
    STAMP(2 + 15 * l + 8);
_Pragma("unroll") for (int rep_ = 0; rep_ < REPS(8); ++rep_) {
    { SchedGrid S{(const char*)WSP(bf16_t, p, merged), (const char*)(WSP(bf16_t, p, wt_out) + (long)l * DM * DM), DM, DM, nMlat, DM / 256, last, G, ph_bid(), 0};
      gemm_phase(lds, GemmG{DM, DM, DM, 0}, S, EpiBf16{WSP(bf16_t, p, macc), DM, 0}); }
    }
    BARX();
    STAMP(2 + 15 * l + 9);
_Pragma("unroll") for (int rep_ = 0; rep_ < REPS(15); ++rep_) {
    ph::ph_ln1(p, l, lds);
    }
    BARX();
    STAMP(2 + 15 * l + 10);
_Pragma("unroll") for (int rep_ = 0; rep_ < REPS(16); ++rep_) {
    ph::ph_topk(p, l, lds);
#ifdef MK_QPROBE
    if (l == 0 && blockIdx.x == 0 && threadIdx.x == 0) ((unsigned long long*)(p.ws + WS.bar + 30720))[41] = __hip_atomic_load(CONVQ_COUNTER, __ATOMIC_RELAXED, __HIP_MEMORY_SCOPE_AGENT);
#endif
    if (convq_alive) convq_alive = ph::conv_work<ph::CLAIM_DRAIN>(p, lds, CONVQ_COUNTER, (l + 1) * ph::CT_LAYER, nullptr);
    }
    BARX();
    STAMP(2 + 15 * l + 11);
    const int nMl = last ? (2 * CAP_L) / 256 : XEP / 256;
_Pragma("unroll") for (int rep_ = 0; rep_ < REPS(9); ++rep_) {
    { SchedMoe S{(const char*)XS, (const char*)(WSP(bf16_t, p, wt_gu) + (long)l * NE * 2 * FF * DM), DM, DM, nMl, 2 * FF / 256, (size_t)2 * FF * DM * 2, G, ph_bid(), MK_XCD_UP, 0};
      gemm_phase_gather(lds, GemmG{DM, DM, DM, 0}, S, EpiSwiGlu{ACT}, (const char*)WSP(bf16_t, p, h2), (const int*)WSP(int, p, xsrc), (unsigned)(WS.zrow - WS.h2)); }
    }
    BARX();
    STAMP(2 + 15 * l + 13);
_Pragma("unroll") for (int rep_ = 0; rep_ < REPS(10); ++rep_) {
    { SchedMoe S{(const char*)ACT, (const char*)(WSP(bf16_t, p, wt_dn) + (long)l * NE * DM * FF), FF, FF, nMl, DM / 256, (size_t)DM * FF * 2, G, ph_bid(), MK_XCD_DN, 0};
      gemm_phase(lds, GemmG{FF, FF, FF, 0}, S, EpiBf16{YS, DM, 0}); }
    }
    BARX();
    STAMP(2 + 15 * l + 14);
_Pragma("unroll") for (int rep_ = 0; rep_ < REPS(18); ++rep_) {
    ph::ph_ln2(p, l);
    if (!last && convq_alive) convq_alive = ph::conv_work<ph::CLAIM_DRAIN>(p, lds, CONVQ_COUNTER, (l + 1) * ph::CT_LAYER + ph::CT_DENSE_L, nullptr);
    }
    if (!last) BARX();
    if (!last) STAMP(2 + 15 * l + 15);
  };
  layer(std::integral_constant<int, 0>{});
  layer(std::integral_constant<int, 1>{});
#undef p
#undef P
#undef PROJ
#undef H1
#undef QM
#undef KM
#undef VM
#undef Z
#undef OA
#undef XS
#undef ACT
#undef YS
}

extern "C" void kernel_launch(void* const* d_in, const int* in_sizes, int n_in, void* d_out, int out_size, void* d_ws, size_t ws_size, hipStream_t stream) {
  if (n_in != N_IN || ws_size < WS.end || out_size != NB * SEQ * DM) { fprintf(stderr, "kernel_launch: unexpected sizes n_in %d ws %zu (need %zu) out %d\n", n_in, ws_size, WS.end, out_size); return; }
  static int grid = 0;
  if (!grid) { int dev = 0, cus = 0, per_cu = 0; (void)hipGetDevice(&dev); (void)hipDeviceGetAttribute(&cus, hipDeviceAttributeMultiprocessorCount, dev);
    (void)hipFuncSetAttribute((const void*)mega, hipFuncAttributeMaxDynamicSharedMemorySize, MEGA_LDS);
    (void)hipOccupancyMaxActiveBlocksPerMultiprocessor(&per_cu, (const void*)mega, 512, MEGA_LDS);
    if (per_cu < 1) { fprintf(stderr, "kernel_launch: occupancy query says %d blocks per CU\n", per_cu); return; }
    grid = cus > 256 ? 256 : cus; }
  Params p; memset(&p, 0, sizeof(p));
  for (int i = 0; i < N_IN; ++i) p.in[i] = (const float*)d_in[i];
  p.out = (float*)d_out; p.ws = (char*)d_ws;
  (void)hipMemsetAsync((char*)d_ws + WS.bar, 0, (XCD_BAR_WORDS + 64 * 40) * sizeof(unsigned), stream);
  hipLaunchKernelGGL(mega, dim3(grid), dim3(512), MEGA_LDS, stream, p);
}
#endif
```

```cpp
#ifdef CPU_TEST
#include <cmath>
#include <cstdio>
#include <cstdlib>
#include <cstring>
#include <cstdint>
#include <functional>
#define __global__
#define __device__
#define __host__
#define __forceinline__ inline
#define __launch_bounds__(...)
#define __restrict__
struct dim3s { int x, y, z; };
static thread_local dim3s blockIdx, threadIdx, blockDim, gridDim;
typedef void* hipStream_t;
template <class F> static void cpu_launch(int grid, int block, F f) {
#pragma omp parallel for schedule(dynamic, 1)
  for (int b = 0; b < grid; ++b) {
    gridDim.x = grid; blockDim.x = block; blockIdx.x = b;
    for (int t = 0; t < block; ++t) { threadIdx.x = t; f(); }
  }
}
#define LAUNCH(kern, grid, block, ...) cpu_launch((grid), (block), [&]() { kern(__VA_ARGS__); })
static inline void hipMemsetAsync(void* p, int v, size_t n, hipStream_t) { memset(p, v, n); }
#else
#include <hip/hip_runtime.h>
#include <cstdio>
#include <cstdint>
#include <cstring>
#define LAUNCH(kern, grid, block, ...) hipLaunchKernelGGL(kern, dim3(grid), dim3(block), 0, stream, __VA_ARGS__)
#endif

typedef unsigned short bf16_t;

#ifndef CFG_DM
#define CFG_DM 2048
#define CFG_SEQ 4096
#define CFG_GRIDW 64
#define CFG_CTX 256
#define CFG_S5P 64
#define CFG_GHD 128
#define CFG_RCHUNK 128
#define CFG_MNOPE 128
#define CFG_MROPE 64
#define CFG_NE 16
#endif
constexpr int DM = CFG_DM, NB = 2, SEQ = CFG_SEQ, GRIDW = CFG_GRIDW, CTXL = CFG_CTX, NLAYER = 2;
constexpr int BW = DM / 4, S5CH = 16, S5G = BW / S5CH, S5P = CFG_S5P;
constexpr int GHD = CFG_GHD, GH = BW / GHD, GKV = GH / 2;
constexpr int RH = 4, RV = BW / RH, RQK = RV / 2;
constexpr int MQL = BW, MKVL = BW / 2, MH = 4, MNOPE = CFG_MNOPE, MROPE = CFG_MROPE, MV = BW / MH, MQK = MNOPE + MROPE;
constexpr int NE = CFG_NE, FF = DM / 2;
constexpr int NTOK = SEQ + CTXL, MROWS = NB * NTOK;
constexpr int OFF_U = 0, OFF_GQ = BW, OFF_GK = OFF_GQ + GH * GHD, OFF_GV = OFF_GK + GKV * GHD, OFF_RQ = OFF_GV + GKV * GHD, OFF_RK = OFF_RQ + RH * RQK,
              OFF_RV = OFF_RK + RH * RQK, OFF_RG = OFF_RV + RH * RV, OFF_CQ = OFF_RG + RH * RV, OFF_CKV = OFF_CQ + MQL, OFF_KR = OFF_CKV + MKVL, IN_TOTAL = OFF_KR + MROPE;
constexpr int PW = (IN_TOTAL + 255) / 256 * 256;
constexpr int CAP_L = 2 * SEQ / NE, CAP_C = 2 * CTXL / NE;
constexpr int XE = 2 * CAP_L + 2 * CAP_C, XEP = (XE + 255) / 256 * 256;
constexpr int XROWS = NE * XEP;
constexpr int NROPE_A = GHD / 4, NROPE_B = RQK / 4;
static_assert(MROPE / 4 == NROPE_B, "rope tables");
static_assert(MNOPE == MV, "kv split");
constexpr int S5LC = 16, S5NC = NTOK / S5LC, S5NN = NB * S5NC, S5NP = (S5NN + 255) / 256 * 256, S5K1 = S5LC * S5CH, S5K2 = 2 * S5P * 2;
constexpr int RCH = CFG_RCHUNK, RNC = NTOK / RCH;
constexpr float NORM_EPS = 1e-6f;
constexpr float DN_ALPHA = 1.4142135623730951f;

enum { I_X = 0, I_C, I_CTX, I_CCTX, I_ADAW, I_ADAB, I_WIN, I_S5AREF, I_S5AIMF, I_S5DTF, I_S5AREB, I_S5AIMB, I_S5DTB, I_S5BRE, I_S5BIM, I_S5CRE, I_S5CIM, I_S5D, I_S5GLU,
       I_GQN, I_GKN, I_RDF, I_RDB, I_RNORM, I_MQN, I_MKVN, I_WUQ, I_WUKV, I_WBR, I_WGATE, I_BGATE, I_WOUT, I_LN1G, I_LN1B, I_ROUTER, I_MOEG, I_MOEU, I_MOED, I_LN2G, I_LN2B, N_IN };

constexpr size_t al256(size_t x) { return (x + 255) / 256 * 256; }
struct WsLayout {
  size_t bar, mod, rope_a, rope_b, s5tab, wt_in, wt_gate, wt_br, wt_out, wt_glu, wt_uq, wt_ukv, wt_gu, wt_dn;
  size_t x1, x2, h1, h2, regA  , qm, km, vm, z, oall, macc  , merged, aff, slot, gatev, xsrc, retst, s5st, uh, s5e, s5sw, s5sv, rkv, rs, zrow, gctx, krp, yslab, end;
};
constexpr size_t SZ_P = (size_t)MROWS * PW * 2, SZ_PROJ = (size_t)MROWS * 4 * DM * 2;
constexpr size_t SZ_XS = (size_t)XROWS * DM * 2, SZ_ACT = (size_t)XROWS * FF * 2, SZ_YS = (size_t)XROWS * DM * 2;
constexpr size_t SZ_HS = (size_t)MROWS * S5G * S5P * 2 * 4;
constexpr size_t cmax(size_t a, size_t b) { return a > b ? a : b; }
constexpr WsLayout make_ws() {
  WsLayout w{}; size_t o = 0;
  w.bar = o; o += al256(32768);
  w.mod = o; o += al256((size_t)NLAYER * 3 * 6 * DM * 4);
  w.rope_a = o; o += al256((size_t)GRIDW * NROPE_A * 2 * 4);
  w.rope_b = o; o += al256((size_t)GRIDW * NROPE_B * 2 * 4);
  w.s5tab = o; o += al256((size_t)NLAYER * 2 * S5G * S5P * (2 + 2 * S5CH) * 4);
  w.wt_in = o; o += al256((size_t)NLAYER * PW * DM * 2);
  w.wt_gate = o; o += al256((size_t)NLAYER * 4 * DM * DM * 2);
  w.wt_br = o; o += al256((size_t)NLAYER * 4 * DM * BW * 2);
  w.wt_out = o; o += al256((size_t)NLAYER * DM * DM * 2);
  w.wt_glu = o; o += al256((size_t)NLAYER * BW * BW * 2);
  w.wt_uq = o; o += al256((size_t)NLAYER * MH * MQK * MQL * 2);
  w.wt_ukv = o; o += al256((size_t)NLAYER * MH * (MNOPE + MV) * MKVL * 2);
  w.wt_gu = o; o += al256((size_t)NLAYER * NE * 2 * FF * DM * 2);
  w.wt_dn = o; o += al256((size_t)NLAYER * NE * DM * FF * 2);
  w.x1 = o; o += al256((size_t)MROWS * DM * 4);
  w.x2 = o; o += al256((size_t)MROWS * DM * 4);
  w.h1 = o; o += al256((size_t)MROWS * DM * 2);
  w.h2 = o; o += al256((size_t)MROWS * DM * 2);
  w.regA = o; o += al256(cmax(cmax(SZ_P + SZ_PROJ, SZ_XS + SZ_ACT + SZ_YS), SZ_P + SZ_HS));
  w.qm = o; o += al256((size_t)MROWS * MH * MQK * 2);
  w.km = o; o += al256((size_t)MROWS * MH * MQK * 2);
  w.vm = o; o += al256((size_t)MROWS * MH * MV * 2);
  w.z = o; o += al256((size_t)MROWS * BW * 2);
  w.oall = o; o += al256((size_t)MROWS * DM * 2);
  w.macc = o; o += al256((size_t)MROWS * DM * 4);
  w.merged = o; o += al256((size_t)MROWS * DM * 2);
  w.aff = o; o += al256((size_t)MROWS * NE * 4);
  w.slot = o; o += al256((size_t)MROWS * NE * 4);
  w.gatev = o; o += al256((size_t)XROWS * 4);
  w.xsrc = o; o += al256((size_t)XROWS * 4);
  w.retst = o; o += al256((size_t)NB * RH * 2 * RQK * RV * 4);
  w.s5st = o; o += al256((size_t)NB * 2 * S5G * S5P * 2 * 4);
  w.uh = o; o += al256((size_t)S5G * S5NP * (S5K1 + S5K2) * 2);
  w.s5e = o; o += al256((size_t)S5G * S5NP * S5K2 * 4);
  w.s5sw = o; o += al256((size_t)NLAYER * S5G * S5K2 * S5K1 * 2);
  w.s5sv = o; o += al256((size_t)NLAYER * S5G * S5K1 * (S5K1 + S5K2) * 2);
  w.rkv = o; o += al256((size_t)NB * RH * 2 * RNC * RV * RQK * 4);
  w.rs = o; o += al256((size_t)NB * RH * 2 * RNC * RV * RQK * 2);
  w.zrow = o; o += al256((size_t)DM * 2);
  w.gctx = o; o += al256((size_t)NB * CTXL * 4 * DM * 2);
  w.krp = o; o += al256((size_t)2 * MROWS * MROPE * 4);
  w.yslab = o; o += al256((size_t)4 * NB * CTXL * DM * 4);
  w.end = o; return w;
}
constexpr WsLayout WS = make_ws();

struct Params {
  const float* in[N_IN];
  float* out;
  char* ws;
};

__host__ __device__ __forceinline__ float bf2f(bf16_t b) { union { unsigned u; float f; } c; c.u = ((unsigned)b) << 16; return c.f; }
__host__ __device__ __forceinline__ bf16_t f2bf(float f) { union { unsigned u; float f; } c; c.f = f; unsigned u = c.u; u += 0x7FFFu + ((u >> 16) & 1u); return (bf16_t)(u >> 16); }
__host__ __device__ __forceinline__ float sigmoidf_(float x) { return 1.f / (1.f + expf(-x)); }
__host__ __device__ __forceinline__ float siluf_(float x) { return x / (1.f + expf(-x)); }
__host__ __device__ __forceinline__ float gelu_tanh(float x) { return 0.5f * x * (1.f + tanhf(0.7978845608028654f * (x + 0.044715f * x * x * x))); }
__host__ __device__ __forceinline__ int row_b(int R) { return R / NTOK; }
__host__ __device__ __forceinline__ int row_t(int R) { return R % NTOK; }
__host__ __device__ __forceinline__ bool row_is_ctx(int R) { return (R % NTOK) >= SEQ; }
__host__ __device__ __forceinline__ int row_mod(int R) { return row_is_ctx(R) ? 2 : row_b(R); }
#ifndef CPU_TEST
__device__ __forceinline__ int ph_bid() { int b = blockIdx.x; asm volatile("" : "+s"(b)); return b; }
__device__ __forceinline__ int ph_tid() { int t = threadIdx.x; asm volatile("" : "+v"(t)); return t; }
#endif
#define GSTRIDE(i, n) for (long i = (long)blockIdx.x * blockDim.x + threadIdx.x; i < (long)(n); i += (long)gridDim.x * blockDim.x)
#define WSP(T, p, field) ((T*)((p).ws + WS.field))

__global__ void nk_conv_t(bf16_t* dst, const float* src, int K, int N, int ldsrc, int Ndst) {
  GSTRIDE(i, (long)Ndst * K) { int n = (int)(i / K), k = (int)(i % K); dst[i] = n < N ? f2bf(src[(long)k * ldsrc + n]) : (bf16_t)0; }
}
__global__ void nk_conv_gu(bf16_t* dst, const float* wg, const float* wu) {
  GSTRIDE(i, (long)2 * FF * DM) { int j = (int)(i / DM), k = (int)(i % DM); int tile = j / 256, r = j % 256, f = tile * 128 + (r & 127);
    const float* s = (r < 128) ? wg : wu; dst[i] = f2bf(s[(long)k * FF + f]); }
}
__global__ void nk_mod(Params p) {
  float* mod = WSP(float, p, mod);
  GSTRIDE(i, (long)NLAYER * 3 * 6 * DM) { int j = (int)(i % (6 * DM)), r = (int)((i / (6 * DM)) % 3), l = (int)(i / (18 * DM));
    const float* cv = (r < 2) ? p.in[I_C] + (long)r * DM : p.in[I_CCTX]; const float* w = p.in[I_ADAW] + (long)l * DM * 6 * DM;
    float acc = 0.f; for (int k = 0; k < DM; ++k) acc += siluf_(cv[k]) * w[(long)k * 6 * DM + j];
    mod[i] = acc + p.in[I_ADAB][(long)l * 6 * DM + j]; }
}
__global__ void nk_rope_tab(Params p) {
  float* ta = WSP(float, p, rope_a); float* tb = WSP(float, p, rope_b);
  GSTRIDE(i, (long)GRIDW * (NROPE_A + NROPE_B)) { int pos = (int)(i / (NROPE_A + NROPE_B)), k = (int)(i % (NROPE_A + NROPE_B));
    if (k < NROPE_A) { float inv = powf(10000.f, -(float)k / NROPE_A), a = pos * inv; ta[(pos * NROPE_A + k) * 2] = cosf(a); ta[(pos * NROPE_A + k) * 2 + 1] = sinf(a); }
    else { int kk = k - NROPE_A; float inv = powf(10000.f, -(float)kk / NROPE_B), a = pos * inv; tb[(pos * NROPE_B + kk) * 2] = cosf(a); tb[(pos * NROPE_B + kk) * 2 + 1] = sinf(a); } }
}
constexpr int S5TW = 2 + 2 * S5CH;
__global__ void nk_s5tab(Params p) {
  float* tab = WSP(float, p, s5tab);
  GSTRIDE(i, (long)NLAYER * 2 * S5G * S5P) { int pp = (int)(i % S5P), g = (int)((i / S5P) % S5G), dir = (int)((i / (S5P * S5G)) % 2), l = (int)(i / (2 * S5P * S5G));
    const float a_re = p.in[dir ? I_S5AREB : I_S5AREF][(l * S5G + g) * S5P + pp], a_im = p.in[dir ? I_S5AIMB : I_S5AIMF][(l * S5G + g) * S5P + pp];
    const float dt = expf(p.in[dir ? I_S5DTB : I_S5DTF][l * S5G + g]);
    const float mag = expf(a_re * dt), ab_re = mag * cosf(a_im * dt), ab_im = mag * sinf(a_im * dt);
    const float den = a_re * a_re + a_im * a_im, nr = ab_re - 1.f, ni = ab_im;
    const float cr = (nr * a_re + ni * a_im) / den, ci = (ni * a_re - nr * a_im) / den;
    float* t = tab + i * S5TW; t[0] = ab_re; t[1] = ab_im;
    for (int c = 0; c < S5CH; ++c) { const float br = p.in[I_S5BRE][((l * S5G + g) * S5P + pp) * S5CH + c], bi = p.in[I_S5BIM][((l * S5G + g) * S5P + pp) * S5CH + c];
      t[2 + c] = cr * br - ci * bi; t[2 + S5CH + c] = cr * bi + ci * br; } }
}
__global__ void nk_load_x(Params p) {
  float* X2 = WSP(float, p, x2);
  GSTRIDE(i, (long)MROWS * DM) { int R = (int)(i / DM), d = (int)(i % DM), b = row_b(R), t = row_t(R);
    X2[i] = t < SEQ ? p.in[I_X][((long)b * SEQ + t) * DM + d] : p.in[I_CTX][((long)b * CTXL + (t - SEQ)) * DM + d]; }
}
__global__ void nk_ln_mod(Params p, bf16_t* H, const float* X, int l, int ch_sh, int ch_sc) {
  const float* mod = WSP(float, p, mod) + (long)l * 3 * 6 * DM;
  GSTRIDE(R, MROWS) { const float* x = X + R * DM; float s = 0.f; for (int d = 0; d < DM; ++d) s += x[d]; const float mean = s / DM;
    float v = 0.f; for (int d = 0; d < DM; ++d) { float c = x[d] - mean; v += c * c; } const float rs = 1.f / sqrtf(v / DM + NORM_EPS);
    const float* m = mod + (long)row_mod((int)R) * 6 * DM;
    for (int d = 0; d < DM; ++d) H[R * DM + d] = f2bf((x[d] - mean) * rs * (1.f + m[ch_sc * DM + d]) + m[ch_sh * DM + d]); }
}
template <class Epi> __global__ void nk_gemm(const bf16_t* A, long lda, const bf16_t* Bt, long ldb, int M, int N, int K, Epi epi) {
  GSTRIDE(i, (long)M * (N / 4)) { int m = (int)(i / (N / 4)), n = (int)(i % (N / 4)) * 4; float a0 = 0.f, a1 = 0.f, a2 = 0.f, a3 = 0.f;
    const bf16_t* ar = A + (long)m * lda; const bf16_t* b0 = Bt + (long)n * ldb;
    for (int k = 0; k < K; ++k) { const float a = bf2f(ar[k]); a0 += a * bf2f(b0[k]); a1 += a * bf2f(b0[ldb + k]); a2 += a * bf2f(b0[2 * ldb + k]); a3 += a * bf2f(b0[3 * ldb + k]); }
    epi(m, n, a0, a1, a2, a3); }
}
struct EpStoreBf16 { bf16_t* C; long ldc; __host__ __device__ void operator()(int m, int n, float a0, float a1, float a2, float a3) const {
  bf16_t* c = C + (long)m * ldc + n; c[0] = f2bf(a0); c[1] = f2bf(a1); c[2] = f2bf(a2); c[3] = f2bf(a3); } };
struct EpStoreF32 { float* C; long ldc; __host__ __device__ void operator()(int m, int n, float a0, float a1, float a2, float a3) const {
  float* c = C + (long)m * ldc + n; c[0] = a0; c[1] = a1; c[2] = a2; c[3] = a3; } };
struct EpKV { bf16_t* KM; bf16_t* VM; __host__ __device__ void operator()(int m, int n, float a0, float a1, float a2, float a3) const {
  const int h = n / (MNOPE + MV), r = n % (MNOPE + MV);
  bf16_t* c = (r < MNOPE) ? KM + (long)m * MH * MQK + h * MQK + r : VM + (long)m * MH * MV + h * MV + (r - MNOPE);
  c[0] = f2bf(a0); c[1] = f2bf(a1); c[2] = f2bf(a2); c[3] = f2bf(a3); } };
struct EpGlu { const bf16_t* Z; bf16_t* O; __host__ __device__ void operator()(int m, int n, float a0, float a1, float a2, float a3) const {
  const bf16_t* z = Z + (long)m * BW + n; bf16_t* o = O + (long)m * DM + n;
  o[0] = f2bf(bf2f(z[0]) * sigmoidf_(a0)); o[1] = f2bf(bf2f(z[1]) * sigmoidf_(a1)); o[2] = f2bf(bf2f(z[2]) * sigmoidf_(a2)); o[3] = f2bf(bf2f(z[3]) * sigmoidf_(a3)); } };
struct EpDown { const float* gate; bf16_t* Y; __host__ __device__ void operator()(int m, int n, float a0, float a1, float a2, float a3) const {
  const float g = gate[m]; bf16_t* y = Y + (long)m * DM + n; y[0] = f2bf(a0 * g); y[1] = f2bf(a1 * g); y[2] = f2bf(a2 * g); y[3] = f2bf(a3 * g); } };

__device__ __forceinline__ void rope_pair(bf16_t* x, int i1, int i2, float sc1, float sc2, bool rot, const float* cs) {
  const float c = rot ? cs[0] : 1.f, s = rot ? cs[1] : 0.f; const float a = bf2f(x[i1]) * sc1, b = bf2f(x[i2]) * sc2; x[i1] = f2bf(a * c - b * s); x[i2] = f2bf(a * s + b * c);
}
__global__ void nk_post_proj(Params p, int l) {
  bf16_t* P = WSP(bf16_t, p, regA); const float* ta = WSP(float, p, rope_a); const float* tb = WSP(float, p, rope_b);
  constexpr int NJ = GH + GKV + 2 * RH + 3;
  GSTRIDE(i, (long)MROWS * NJ) { const int R = (int)(i / NJ), j = (int)(i % NJ), t = row_t(R); const bool lat = t < SEQ; const int gr = lat ? t / GRIDW : 0, gc = lat ? t % GRIDW : 0;
    bf16_t* pr = P + (long)R * PW;
    if (j < GH + GKV) {
      bf16_t* x = pr + (j < GH ? OFF_GQ + j * GHD : OFF_GK + (j - GH) * GHD); const float* g = p.in[j < GH ? I_GQN : I_GKN] + l * GHD;
      float ss = 0.f; for (int d = 0; d < GHD; ++d) { float v = bf2f(x[d]); ss += v * v; } const float r = 1.f / sqrtf(ss / GHD + NORM_EPS);
      for (int hf = 0; hf < 2; ++hf) for (int k = 0; k < NROPE_A; ++k) { const int i1 = hf * 2 * NROPE_A + k, i2 = i1 + NROPE_A;
        rope_pair(x, i1, i2, r * g[i1], r * g[i2], lat, ta + ((hf ? gc : gr) * NROPE_A + k) * 2); }
    } else if (j < GH + GKV + 2 * RH) {
      const int jj = j - GH - GKV; const bool isk = jj >= RH; bf16_t* x = pr + (isk ? OFF_RK + (jj - RH) * RQK : OFF_RQ + jj * RQK); const float sc = isk ? 1.f / sqrtf((float)RQK) : 1.f;
      for (int hf = 0; hf < 2; ++hf) for (int k = 0; k < NROPE_B; ++k) { const int i1 = hf * 2 * NROPE_B + k, i2 = i1 + NROPE_B;
        rope_pair(x, i1, i2, sc, sc, lat, tb + ((hf ? gc : gr) * NROPE_B + k) * 2); }
    } else if (j == GH + GKV + 2 * RH) {
      bf16_t* x = pr + OFF_CQ; const float* g = p.in[I_MQN] + l * MQL; float ss = 0.f; for (int d = 0; d < MQL; ++d) { float v = bf2f(x[d]); ss += v * v; }
      const float r = 1.f / sqrtf(ss / MQL + NORM_EPS); for (int d = 0; d < MQL; ++d) x[d] = f2bf(bf2f(x[d]) * r * g[d]);
    } else if (j == GH + GKV + 2 * RH + 1) {
      bf16_t* x = pr + OFF_CKV; const float* g = p.in[I_MKVN] + l * MKVL; float ss = 0.f; for (int d = 0; d < MKVL; ++d) { float v = bf2f(x[d]); ss += v * v; }
      const float r = 1.f / sqrtf(ss / MKVL + NORM_EPS); for (int d = 0; d < MKVL; ++d) x[d] = f2bf(bf2f(x[d]) * r * g[d]);
    } else if (lat) {
      bf16_t* x = pr + OFF_KR;
      for (int hf = 0; hf < 2; ++hf) for (int k = 0; k < NROPE_B; ++k) { const int i1 = hf * 2 * NROPE_B + k, i2 = i1 + NROPE_B; rope_pair(x, i1, i2, 1.f, 1.f, true, tb + ((hf ? gc : gr) * NROPE_B + k) * 2); }
    } }
}
__global__ void nk_post_mla(Params p) {
  bf16_t* P = WSP(bf16_t, p, regA); bf16_t* QM = WSP(bf16_t, p, qm); bf16_t* KM = WSP(bf16_t, p, km); const float* tb = WSP(float, p, rope_b);
  GSTRIDE(i, (long)MROWS * MH) { const int R = (int)(i / MH), h = (int)(i % MH), t = row_t(R); const bool lat = t < SEQ;
    if (lat) { const int gr = t / GRIDW, gc = t % GRIDW; bf16_t* x = QM + (long)R * MH * MQK + h * MQK + MNOPE;
      for (int hf = 0; hf < 2; ++hf) for (int k = 0; k < NROPE_B; ++k) { const int i1 = hf * 2 * NROPE_B + k, i2 = i1 + NROPE_B; rope_pair(x, i1, i2, 1.f, 1.f, true, tb + ((hf ? gc : gr) * NROPE_B + k) * 2); } }
    for (int d = 0; d < MROPE; ++d) KM[(long)R * MH * MQK + h * MQK + MNOPE + d] = P[(long)R * PW + OFF_KR + d]; }
}
__global__ void nk_post_mla_q(Params p) {
  bf16_t* QM = WSP(bf16_t, p, qm); const float* tb = WSP(float, p, rope_b);
  GSTRIDE(i, (long)MROWS * MH) { const int R = (int)(i / MH), h = (int)(i % MH), t = row_t(R); const bool lat = t < SEQ;
    if (lat) { const int gr = t / GRIDW, gc = t % GRIDW; bf16_t* x = QM + (long)R * MH * MQK + h * MQK + MNOPE;
      for (int hf = 0; hf < 2; ++hf) for (int k = 0; k < NROPE_B; ++k) { const int i1 = hf * 2 * NROPE_B + k, i2 = i1 + NROPE_B; rope_pair(x, i1, i2, 1.f, 1.f, true, tb + ((hf ? gc : gr) * NROPE_B + k) * 2); } } }
}
__global__ void nk_s5_scan(Params p, int l) {
  const bf16_t* P = WSP(bf16_t, p, regA); float* HS = (float*)(p.ws + WS.regA + SZ_P); const float* tab = WSP(float, p, s5tab);
  GSTRIDE(i, (long)NB * S5G * S5P) { const int pp = (int)(i % S5P), g = (int)((i / S5P) % S5G), b = (int)(i / (S5P * S5G));
    for (int dir = 0; dir < 2; ++dir) { const float* t = tab + ((((long)l * 2 + dir) * S5G + g) * S5P + pp) * S5TW; const float are = t[0], aim = t[1]; float hr = 0.f, hi = 0.f;
      for (int s = 0; s < NTOK; ++s) {
        int tt; if (!dir) tt = s < CTXL ? SEQ + s : s - CTXL; else tt = s < CTXL ? SEQ + (CTXL - 1 - s) : SEQ - 1 - (s - CTXL);
        const long R = (long)b * NTOK + tt; const bf16_t* u = P + R * PW + OFF_U + g * S5CH; float br = 0.f, bi = 0.f;
        for (int c = 0; c < S5CH; ++c) { const float uv = bf2f(u[c]); br += uv * t[2 + c]; bi += uv * t[2 + S5CH + c]; }
        const float nr = are * hr - aim * hi + br, ni = are * hi + aim * hr + bi; hr = nr; hi = ni;
        float* hs = HS + ((R * S5G + g) * S5P + pp) * 2; if (!dir) { hs[0] = hr; hs[1] = hi; } else { hs[0] += hr; hs[1] += hi; } } } }
}
__global__ void nk_s5_read(Params p, int l) {
  const bf16_t* P = WSP(bf16_t, p, regA); const float* HS = (const float*)(p.ws + WS.regA + SZ_P); bf16_t* Z = WSP(bf16_t, p, z);
  GSTRIDE(i, (long)MROWS * BW) { const long R = i / BW; const int c = (int)(i % BW), g = c / S5CH, ci = c % S5CH;
    const float* hs = HS + (R * S5G + g) * S5P * 2; const float* cre = p.in[I_S5CRE] + (((long)l * S5G + g) * S5CH + ci) * S5P; const float* cim = p.in[I_S5CIM] + (((long)l * S5G + g) * S5CH + ci) * S5P;
    float y = 0.f; for (int pp = 0; pp < S5P; ++pp) y += hs[2 * pp] * cre[pp] - hs[2 * pp + 1] * cim[pp];
    y += p.in[I_S5D][l * BW + c] * bf2f(P[R * PW + OFF_U + c]); Z[i] = f2bf(gelu_tanh(y)); }
}
template <int DQK, int DV> __global__ void __launch_bounds__(256) nk_attn(const bf16_t* Q, const bf16_t* K, const bf16_t* V, bf16_t* O, int ldq, int ldk, int ldv, int ldo, int H, int group, float scale) {
  GSTRIDE(i, (long)MROWS * H) { const int R = (int)(i / H), h = (int)(i % H), b = row_b(R), kh = h / group; const bool lat = !row_is_ctx(R);
    const bf16_t* q = Q + (long)R * ldq + h * DQK; float o[DV]; _Pragma("unroll") for (int d = 0; d < DV; ++d) o[d] = 0.f; float m = -1e30f, lsum = 0.f;
    for (int kk = lat ? 0 : SEQ; kk < NTOK; ++kk) { const long KR = (long)b * NTOK + kk; const bf16_t* kp = K + KR * ldk + kh * DQK; float s = 0.f;
      for (int d = 0; d < DQK; ++d) s += bf2f(q[d]) * bf2f(kp[d]); s *= scale;
      if (s > m) { const float corr = expf(m - s); lsum *= corr; _Pragma("unroll") for (int d = 0; d < DV; ++d) o[d] *= corr; m = s; }
      const float pw = expf(s - m); lsum += pw; const bf16_t* vp = V + KR * ldv + kh * DV; _Pragma("unroll") for (int d = 0; d < DV; ++d) o[d] += pw * bf2f(vp[d]); }
    const float inv = 1.f / lsum; _Pragma("unroll") for (int d = 0; d < DV; ++d) O[(long)R * ldo + h * DV + d] = f2bf(o[d] * inv); }
}
__global__ void __launch_bounds__(256) nk_ret(Params p, int l) {
  const bf16_t* P = WSP(bf16_t, p, regA); bf16_t* O = WSP(bf16_t, p, oall);
  GSTRIDE(i, (long)MROWS * RH) { const int R = (int)(i / RH), h = (int)(i % RH), b = row_b(R), t = row_t(R); const bool lat = t < SEQ;
    const float lgf = -expf(p.in[I_RDF][l * RH + h]), lgb = -expf(p.in[I_RDB][l * RH + h]);
    const bf16_t* q = P + (long)R * PW + OFF_RQ + h * RQK; float o[RV]; _Pragma("unroll") for (int d = 0; d < RV; ++d) o[d] = 0.f;
    for (int kk = lat ? 0 : SEQ; kk < NTOK; ++kk) { float w;
      if (lat) { if (kk < SEQ) w = kk <= t ? expf(lgf * (float)(t - kk)) : expf(lgb * (float)(kk - t)); else { const int j = kk - SEQ; w = expf(lgf * (float)(t + CTXL - j)) + expf(lgb * (float)(SEQ - t + j)); } }
      else { const int j = t - SEQ, j2 = kk - SEQ; w = j2 <= j ? expf(lgf * (float)(j - j2)) : expf(lgb * (float)(j2 - j)); }
      const long KR = (long)b * NTOK + kk; const bf16_t* kp = P + KR * PW + OFF_RK + h * RQK; float s = 0.f; for (int d = 0; d < RQK; ++d) s += bf2f(q[d]) * bf2f(kp[d]); s *= w;
      const bf16_t* vp = P + KR * PW + OFF_RV + h * RV; _Pragma("unroll") for (int d = 0; d < RV; ++d) o[d] += s * bf2f(vp[d]); }
    float mean = 0.f; _Pragma("unroll") for (int d = 0; d < RV; ++d) mean += o[d]; mean /= RV; float var = 0.f; _Pragma("unroll") for (int d = 0; d < RV; ++d) { const float c = o[d] - mean; var += c * c; }
    const float rs = 1.f / sqrtf(var / RV + NORM_EPS); const bf16_t* gp = P + (long)R * PW + OFF_RG + h * RV; const float* gain = p.in[I_RNORM] + l * BW + h * RV;
    _Pragma("unroll") for (int d = 0; d < RV; ++d) O[(long)R * DM + 2 * BW + h * RV + d] = f2bf((o[d] - mean) * rs * gain[d] * siluf_(bf2f(gp[d]))); }
}
__global__ void nk_gate_merge(Params p, int l) {
  const bf16_t* H = WSP(bf16_t, p, h1); const bf16_t* Wg = WSP(bf16_t, p, wt_gate) + (long)l * 4 * DM * DM; const bf16_t* PROJ = (const bf16_t*)(p.ws + WS.regA + SZ_P); bf16_t* MG = WSP(bf16_t, p, merged);
  const float* bg = p.in[I_BGATE] + (long)l * 4 * DM;
  GSTRIDE(i, (long)MROWS * DM) { const long R = i / DM; const int d = (int)(i % DM); const bf16_t* hr = H + R * DM; float acc = 0.f;
    for (int k = 0; k < 4; ++k) { const bf16_t* w = Wg + ((long)k * DM + d) * DM; float s = 0.f; for (int c = 0; c < DM; ++c) s += bf2f(hr[c]) * bf2f(w[c]);
      acc += sigmoidf_(s + bg[k * DM + d]) * bf2f(PROJ[R * 4 * DM + k * DM + d]); }
    MG[i] = f2bf(acc); }
}
__global__ void nk_ln1(Params p, int l) {
  const float* X2 = WSP(float, p, x2); const float* Y = WSP(float, p, macc); float* X1 = WSP(float, p, x1); bf16_t* H2 = WSP(bf16_t, p, h2); float* AFF = WSP(float, p, aff);
  const float* mod = WSP(float, p, mod) + (long)l * 3 * 6 * DM; const float* lg = p.in[I_LN1G] + l * DM; const float* lb = p.in[I_LN1B] + l * DM; const float* rw = p.in[I_ROUTER] + (long)l * DM * NE;
  GSTRIDE(R, MROWS) { const float* m = mod + (long)row_mod((int)R) * 6 * DM; const float* x = X2 + R * DM; const float* y = Y + R * DM; float* x1 = X1 + R * DM;
    float s = 0.f; for (int d = 0; d < DM; ++d) { const float v = DN_ALPHA * x[d] + m[2 * DM + d] * y[d]; x1[d] = v; s += v; } float mean = s / DM;
    float var = 0.f; for (int d = 0; d < DM; ++d) { const float c = x1[d] - mean; var += c * c; } float rs = 1.f / sqrtf(var / DM + NORM_EPS);
    s = 0.f; for (int d = 0; d < DM; ++d) { const float v = (x1[d] - mean) * rs * lg[d] + lb[d]; x1[d] = v; s += v; } mean = s / DM;
    var = 0.f; for (int d = 0; d < DM; ++d) { const float c = x1[d] - mean; var += c * c; } rs = 1.f / sqrtf(var / DM + NORM_EPS);
    float lo[NE]; _Pragma("unroll") for (int e = 0; e < NE; ++e) lo[e] = 0.f;
    for (int d = 0; d < DM; ++d) { const float hv = (x1[d] - mean) * rs * (1.f + m[4 * DM + d]) + m[3 * DM + d]; H2[R * DM + d] = f2bf(hv); _Pragma("unroll") for (int e = 0; e < NE; ++e) lo[e] += hv * rw[(long)d * NE + e]; }
    float mx = lo[0]; _Pragma("unroll") for (int e = 1; e < NE; ++e) mx = fmaxf(mx, lo[e]); float se = 0.f; _Pragma("unroll") for (int e = 0; e < NE; ++e) { lo[e] = expf(lo[e] - mx); se += lo[e]; }
    _Pragma("unroll") for (int e = 0; e < NE; ++e) AFF[R * NE + e] = lo[e] / se; }
}
__global__ void nk_topk(Params p, int with_ctx) {
  const float* AFF = WSP(float, p, aff); int* SLOT = WSP(int, p, slot); float* GV = WSP(float, p, gatev); int* XSRC = WSP(int, p, xsrc);
  GSTRIDE(i, (long)MROWS * NE) { const int R = (int)(i / NE), e = (int)(i % NE), b = row_b(R), t = row_t(R); const bool lat = t < SEQ;
    if (!lat && !with_ctx) { SLOT[i] = -1; continue; }
    const int k0 = lat ? 0 : SEQ, k1 = lat ? SEQ : NTOK, cap = lat ? CAP_L : CAP_C; const float a = AFF[i]; int rank = 0;
    for (int kk = k0; kk < k1; ++kk) { const float o = AFF[((long)b * NTOK + kk) * NE + e]; rank += (o > a || (o == a && kk < t)) ? 1 : 0; }
    if (rank < cap) { const int xr = e * XEP + (lat ? b * CAP_L : 2 * CAP_L + b * CAP_C) + rank; SLOT[i] = xr; GV[xr] = a; XSRC[xr] = R; } else SLOT[i] = -1; }
}
__global__ void nk_gather(Params p) {
  const int* XSRC = WSP(int, p, xsrc); const bf16_t* H2 = WSP(bf16_t, p, h2); bf16_t* XS = WSP(bf16_t, p, regA);
  GSTRIDE(i, (long)XROWS * DM) { const long xr = i / DM; const int d = (int)(i % DM), src = XSRC[xr]; XS[i] = src >= 0 ? H2[(long)src * DM + d] : (bf16_t)0; }
}
__global__ void nk_moe_up(Params p, int l) {
  const bf16_t* XS = WSP(bf16_t, p, regA); bf16_t* ACT = (bf16_t*)(p.ws + WS.regA + SZ_XS); const bf16_t* W = WSP(bf16_t, p, wt_gu) + (long)l * NE * 2 * FF * DM; const int* XSRC = WSP(int, p, xsrc);
  GSTRIDE(i, (long)XROWS * FF) { const long xr = i / FF; const int f = (int)(i % FF), e = (int)(xr / XEP); if (XSRC[xr] < 0) { ACT[i] = 0; continue; }
    const int jg = (f / 128) * 256 + (f % 128), ju = jg + 128; const bf16_t* x = XS + xr * DM; const bf16_t* wg = W + ((long)e * 2 * FF + jg) * DM; const bf16_t* wu = W + ((long)e * 2 * FF + ju) * DM;
    float a = 0.f, u = 0.f; for (int k = 0; k < DM; ++k) { const float xv = bf2f(x[k]); a += xv * bf2f(wg[k]); u += xv * bf2f(wu[k]); }
    ACT[i] = f2bf(siluf_(a) * u); }
}
__global__ void nk_ln2(Params p, int l, int last) {
  const float* X1 = WSP(float, p, x1); float* X2 = WSP(float, p, x2); const int* SLOT = WSP(int, p, slot); const bf16_t* YS = (const bf16_t*)(p.ws + WS.regA + SZ_XS + SZ_ACT);
  const float* mod = WSP(float, p, mod) + (long)l * 3 * 6 * DM; const float* lg = p.in[I_LN2G] + l * DM; const float* lb = p.in[I_LN2B] + l * DM;
  GSTRIDE(R, MROWS) { if (last && row_is_ctx((int)R)) continue; const float* m = mod + (long)row_mod((int)R) * 6 * DM; const float* x1 = X1 + R * DM; float* x2 = X2 + R * DM;
    float s = 0.f; for (int d = 0; d < DM; ++d) { float mo = 0.f; for (int e = 0; e < NE; ++e) { const int sl = SLOT[R * NE + e]; if (sl >= 0) mo += bf2f(YS[(long)sl * DM + d]); }
      const float v = DN_ALPHA * x1[d] + m[5 * DM + d] * mo; x2[d] = v; s += v; } const float mean = s / DM;
    float var = 0.f; for (int d = 0; d < DM; ++d) { const float c = x2[d] - mean; var += c * c; } const float rs = 1.f / sqrtf(var / DM + NORM_EPS);
    for (int d = 0; d < DM; ++d) { const float v = (x2[d] - mean) * rs * lg[d] + lb[d]; x2[d] = v; if (last) p.out[((long)row_b((int)R) * SEQ + row_t((int)R)) * DM + d] = v; } }
}
#ifdef CPU_TEST
void cpu_hook(const char* name, int l, Params& p);
#define HOOK(name) cpu_hook(name, l, p)
#else
#define HOOK(name)
#endif
#define NG(n) (int)((((long)(n)) + 255) / 256 < 65536 ? (((long)(n)) + 255) / 256 : 65536)

static void naive_prologue(Params& p, hipStream_t stream) {
  for (int l = 0; l < NLAYER; ++l) {
    LAUNCH(nk_conv_t, NG((long)PW * DM), 256, WSP(bf16_t, p, wt_in) + (long)l * PW * DM, p.in[I_WIN] + (long)l * DM * IN_TOTAL, DM, IN_TOTAL, IN_TOTAL, PW);
    LAUNCH(nk_conv_t, NG((long)4 * DM * DM), 256, WSP(bf16_t, p, wt_gate) + (long)l * 4 * DM * DM, p.in[I_WGATE] + (long)l * DM * 4 * DM, DM, 4 * DM, 4 * DM, 4 * DM);
    for (int k = 0; k < 4; ++k)
      LAUNCH(nk_conv_t, NG((long)DM * BW), 256, WSP(bf16_t, p, wt_br) + ((long)l * 4 + k) * DM * BW, p.in[I_WBR] + ((long)l * 4 + k) * BW * DM, BW, DM, DM, DM);
    LAUNCH(nk_conv_t, NG((long)DM * DM), 256, WSP(bf16_t, p, wt_out) + (long)l * DM * DM, p.in[I_WOUT] + (long)l * DM * DM, DM, DM, DM, DM);
    LAUNCH(nk_conv_t, NG((long)BW * BW), 256, WSP(bf16_t, p, wt_glu) + (long)l * BW * BW, p.in[I_S5GLU] + (long)l * BW * BW, BW, BW, BW, BW);
    LAUNCH(nk_conv_t, NG((long)MH * MQK * MQL), 256, WSP(bf16_t, p, wt_uq) + (long)l * MH * MQK * MQL, p.in[I_WUQ] + (long)l * MQL * MH * MQK, MQL, MH * MQK, MH * MQK, MH * MQK);
    LAUNCH(nk_conv_t, NG((long)MH * (MNOPE + MV) * MKVL), 256, WSP(bf16_t, p, wt_ukv) + (long)l * MH * (MNOPE + MV) * MKVL, p.in[I_WUKV] + (long)l * MKVL * MH * (MNOPE + MV), MKVL, MH * (MNOPE + MV), MH * (MNOPE + MV), MH * (MNOPE + MV));
    for (int e = 0; e < NE; ++e) {
      LAUNCH(nk_conv_gu, NG((long)2 * FF * DM), 256, WSP(bf16_t, p, wt_gu) + ((long)l * NE + e) * 2 * FF * DM, p.in[I_MOEG] + ((long)l * NE + e) * DM * FF, p.in[I_MOEU] + ((long)l * NE + e) * DM * FF);
      LAUNCH(nk_conv_t, NG((long)DM * FF), 256, WSP(bf16_t, p, wt_dn) + ((long)l * NE + e) * DM * FF, p.in[I_MOED] + ((long)l * NE + e) * FF * DM, FF, DM, DM, DM);
    }
  }
  LAUNCH(nk_mod, NG((long)NLAYER * 18 * DM), 256, p);
  LAUNCH(nk_rope_tab, 4, 256, p);
  LAUNCH(nk_s5tab, NG((long)NLAYER * 2 * S5G * S5P), 256, p);
  LAUNCH(nk_load_x, NG((long)MROWS * DM), 256, p);
}

#ifdef CPU_TEST
static void naive_layer(Params& p, int l, hipStream_t stream) {
  bf16_t* P = WSP(bf16_t, p, regA); bf16_t* PROJ = (bf16_t*)(p.ws + WS.regA + SZ_P); bf16_t* H1 = WSP(bf16_t, p, h1);
  bf16_t* QM = WSP(bf16_t, p, qm); bf16_t* KM = WSP(bf16_t, p, km); bf16_t* VM = WSP(bf16_t, p, vm); bf16_t* Z = WSP(bf16_t, p, z); bf16_t* OA = WSP(bf16_t, p, oall);
  LAUNCH(nk_ln_mod, NG(MROWS), 256, p, H1, (const float*)WSP(float, p, x2), l, 0, 1);
  HOOK("h");
  LAUNCH(nk_gemm<EpStoreBf16>, NG((long)MROWS * PW / 4), 256, (const bf16_t*)H1, (long)DM, (const bf16_t*)(WSP(bf16_t, p, wt_in) + (long)l * PW * DM), (long)DM, MROWS, PW, DM, EpStoreBf16{P, PW});
  LAUNCH(nk_post_proj, NG((long)MROWS * 17), 256, p, l);
  LAUNCH(nk_gemm<EpStoreBf16>, NG((long)MROWS * MH * MQK / 4), 256, (const bf16_t*)(P + OFF_CQ), (long)PW, (const bf16_t*)(WSP(bf16_t, p, wt_uq) + (long)l * MH * MQK * MQL), (long)MQL, MROWS, MH * MQK, MQL, EpStoreBf16{QM, MH * MQK});
  LAUNCH(nk_gemm<EpKV>, NG((long)MROWS * MH * (MNOPE + MV) / 4), 256, (const bf16_t*)(P + OFF_CKV), (long)PW, (const bf16_t*)(WSP(bf16_t, p, wt_ukv) + (long)l * MH * (MNOPE + MV) * MKVL), (long)MKVL, MROWS, MH * (MNOPE + MV), MKVL, EpKV{KM, VM});
  LAUNCH(nk_post_mla, NG((long)MROWS * MH), 256, p);
  LAUNCH(nk_s5_scan, NG((long)NB * S5G * S5P), 256, p, l);
  LAUNCH(nk_s5_read, NG((long)MROWS * BW), 256, p, l);
  LAUNCH(nk_gemm<EpGlu>, NG((long)MROWS * BW / 4), 256, (const bf16_t*)Z, (long)BW, (const bf16_t*)(WSP(bf16_t, p, wt_glu) + (long)l * BW * BW), (long)BW, MROWS, BW, BW, EpGlu{Z, OA});
  HOOK("o_s5");
  LAUNCH((nk_attn<GHD, GHD>), NG((long)MROWS * GH), 256, (const bf16_t*)(P + OFF_GQ), (const bf16_t*)(P + OFF_GK), (const bf16_t*)(P + OFF_GV), OA + BW, PW, PW, PW, DM, GH, GH / GKV, 1.f / sqrtf((float)GHD));
  HOOK("o_gqa");
  LAUNCH(nk_ret, NG((long)MROWS * RH), 256, p, l);
  HOOK("o_ret");
  LAUNCH((nk_attn<MQK, MV>), NG((long)MROWS * MH), 256, (const bf16_t*)QM, (const bf16_t*)KM, (const bf16_t*)VM, OA + 3 * BW, MH * MQK, MH * MQK, MH * MV, DM, MH, 1, 1.f / sqrtf((float)MQK));
  HOOK("o_mla");
  for (int k = 0; k < 4; ++k)
    LAUNCH(nk_gemm<EpStoreBf16>, NG((long)MROWS * DM / 4), 256, (const bf16_t*)(OA + k * BW), (long)DM, (const bf16_t*)(WSP(bf16_t, p, wt_br) + ((long)l * 4 + k) * DM * BW), (long)BW, MROWS, DM, BW, EpStoreBf16{PROJ + (long)k * DM, 4 * DM});
  LAUNCH(nk_gate_merge, NG((long)MROWS * DM), 256, p, l);
  LAUNCH(nk_gemm<EpStoreF32>, NG((long)MROWS * DM / 4), 256, (const bf16_t*)WSP(bf16_t, p, merged), (long)DM, (const bf16_t*)(WSP(bf16_t, p, wt_out) + (long)l * DM * DM), (long)DM, MROWS, DM, DM, EpStoreF32{WSP(float, p, macc), DM});
  HOOK("y");
  LAUNCH(nk_ln1, NG(MROWS), 256, p, l);
  HOOK("x1");
  hipMemsetAsync(p.ws + WS.xsrc, 0xFF, (size_t)XROWS * 4, stream);
  LAUNCH(nk_topk, NG((long)MROWS * NE), 256, p, l == 0 ? 1 : 0);
  LAUNCH(nk_gather, NG((long)XROWS * DM), 256, p);
  LAUNCH(nk_moe_up, NG((long)XROWS * FF), 256, p, l);
  bf16_t* ACT = (bf16_t*)(p.ws + WS.regA + SZ_XS); bf16_t* YS = (bf16_t*)(p.ws + WS.regA + SZ_XS + SZ_ACT);
  for (int e = 0; e < NE; ++e)
    LAUNCH(nk_gemm<EpDown>, NG((long)XEP * DM / 4), 256, (const bf16_t*)(ACT + (long)e * XEP * FF), (long)FF, (const bf16_t*)(WSP(bf16_t, p, wt_dn) + ((long)l * NE + e) * DM * FF), (long)FF, XEP, DM, FF,
           EpDown{WSP(float, p, gatev) + e * XEP, YS + (long)e * XEP * DM});
  LAUNCH(nk_ln2, NG(MROWS), 256, p, l, l == NLAYER - 1 ? 1 : 0);
  HOOK("x2");
}
#endif
#ifndef CPU_TEST
#ifndef PG8_SP2
#define PG8_SP2 true
#endif
namespace pg8 {
#define PG8_LAS __attribute__((address_space(3)))
typedef short bf16x8 __attribute__((ext_vector_type(8)));
typedef float f32x4 __attribute__((ext_vector_type(4)));
typedef unsigned u32x4 __attribute__((ext_vector_type(4)));
constexpr int BM = 256, BK = 64, HALF = 128, HTB = HALF * BK * 2, STAGE_BYTES = 8 * HTB, NXCD = 8, WGM = 8;
__host__ __device__ __forceinline__ int lds_byte(int r, int c) { const int st = (r >> 4) * 2 + (c >> 5), rr = r & 15, cc = c & 31, ob = rr * 64 + cc * 2; return st * 1024 + (ob ^ (((ob >> 9) & 1) << 5)); }
__host__ __device__ __forceinline__ void stage_rc(int b, int& R, int& C) { const int st = b / 1024, sb = b % 1024, swz = sb ^ (((sb >> 9) & 1) << 5); R = (st >> 1) * 16 + swz / 64; C = (st & 1) * 32 + (swz % 64) / 2; }
__host__ __device__ __forceinline__ int perm32(int rho) { const int n = rho >> 4, i = rho & 15; return 8 * (i >> 2) + 4 * n + (i & 3); }

struct Unit { int pm, pn, aux; const char* A; const char* B; };
struct GemmG { int lda, ldb, K, bmode; };

__device__ __forceinline__ bool tile_order(long L, int nM, int nN, int& pm, int& pn) {
  const int nwg = nM * nN; if (L >= nwg) return false;
  int wgid = (int)L; { const int q = nwg / NXCD, r = nwg % NXCD, xcd = wgid % NXCD, off = wgid / NXCD; wgid = (xcd < r ? xcd * (q + 1) : r * (q + 1) + (xcd - r) * q) + off; }
  const int nig = WGM * nN, gid = wgid / nig, fm = gid * WGM, gsz = (nM - fm) < WGM ? (nM - fm) : WGM;
  pm = fm + ((wgid % nig) % gsz); pn = (wgid % nig) / gsz; return true;
}
__device__ __forceinline__ unsigned cvt_pk_bf16(float lo, float hi) { unsigned r; asm volatile("v_cvt_pk_bf16_f32 %0, %1, %2" : "=v"(r) : "v"(lo), "v"(hi)); return r; }
__device__ __forceinline__ u32x4 pack8(const f32x4 a, const f32x4 b) { u32x4 w; w.x = cvt_pk_bf16(a[0], a[1]); w.y = cvt_pk_bf16(a[2], a[3]); w.z = cvt_pk_bf16(b[0], b[1]); w.w = cvt_pk_bf16(b[2], b[3]); return w; }
__device__ __forceinline__ void unpack8(const u32x4 w, f32x4& a, f32x4& b) {
  a[0] = __uint_as_float(w.x << 16); a[1] = __uint_as_float(w.x & 0xffff0000u); a[2] = __uint_as_float(w.y << 16); a[3] = __uint_as_float(w.y & 0xffff0000u);
  b[0] = __uint_as_float(w.z << 16); b[1] = __uint_as_float(w.z & 0xffff0000u); b[2] = __uint_as_float(w.w << 16); b[3] = __uint_as_float(w.w & 0xffff0000u); }
#ifndef MK_NT
#define MK_NT 0
#endif
template <class T> __device__ __forceinline__ void st_out(T* p, const T v) { if (MK_NT) __builtin_nontemporal_store(v, p); else *p = v; }
__device__ __forceinline__ float fast_sigmoid(float x) { return __builtin_amdgcn_rcpf(1.f + __builtin_amdgcn_exp2f(-1.4426950408889634f * x)); }
__device__ __forceinline__ f32x4 sigmoid4(f32x4 v) { f32x4 o; o[0] = fast_sigmoid(v[0]); o[1] = fast_sigmoid(v[1]); o[2] = fast_sigmoid(v[2]); o[3] = fast_sigmoid(v[3]); return o; }

template <bool ALIGN = true, bool SP2 = PG8_SP2, class Epi, class Sched>
__device__ __forceinline__ void gemm_phase(PG8_LAS unsigned char* lds, const GemmG g, const Sched& S, const Epi& E) {
    const int tid = ph_tid(), wid = __builtin_amdgcn_readfirstlane(tid >> 6), lane = tid & 63, wr = wid >> 2, wc = wid & 3, fr = lane & 15, fq = lane >> 4;
    const int K = g.K, nt = K / BK;
    unsigned voffA[2], voffB[2];
#pragma unroll
    for (int i = 0; i < 2; ++i) { int R, C; stage_rc(tid * 16 + i * 8192, R, C); const int Rb = (R & ~31) + perm32(R & 31);
        const int wrow = g.bmode ? (((Rb >> 4) & 1) * DM + 16 * ((Rb >> 5) & 3) + (Rb & 15)) : Rb;
        voffA[i] = (unsigned)(R * g.lda + C) * 2u; voffB[i] = (unsigned)(wrow * g.ldb + C) * 2u; }
    const size_t kstep = (size_t)(BK * 2);
    const size_t hsA = (size_t)HALF * g.lda * 2, hsB = (size_t)(g.bmode ? 2 * DM : HALF) * g.ldb * 2;
    const unsigned ldsw = (unsigned)wid * 1024u;
    const int aoff = lds_byte(wr * 64 + fr, fq * 8), boff = lds_byte(wc * 32 + fr, fq * 8);
#define PG8_SA(b, h) (((b) * 2 + (h)) * HTB)
#define PG8_SB(b, h) ((4 + (b) * 2 + (h)) * HTB)
#define PG8_STAGE(bufoff, gbase, voff) do { _Pragma("unroll") for (int _i = 0; _i < 2; ++_i) \
        __builtin_amdgcn_global_load_lds((const unsigned*)((const char*)(gbase) + (voff)[_i]), (PG8_LAS unsigned*)(lds + (bufoff) + ldsw + _i * 8192), 16, 0, 0); } while (0)
#define PG8_LDA(dst, b, h) do { _Pragma("unroll") for (int m = 0; m < 4; ++m) _Pragma("unroll") for (int k = 0; k < 2; ++k) dst[m][k] = *(const PG8_LAS bf16x8*)(lds + PG8_SA(b, h) + aoff + m * 2048 + k * 1024); } while (0)
#define PG8_LDB(dst, b, h) do { _Pragma("unroll") for (int n = 0; n < 2; ++n) _Pragma("unroll") for (int k = 0; k < 2; ++k) dst[n][k] = *(const PG8_LAS bf16x8*)(lds + PG8_SB(b, h) + boff + n * 2048 + k * 1024); } while (0)
#define PG8_MMA(ai, bj, At, Bt) do { __builtin_amdgcn_s_setprio(1); _Pragma("unroll") for (int m = 0; m < 4; ++m) _Pragma("unroll") for (int n = 0; n < 2; ++n) _Pragma("unroll") for (int k = 0; k < 2; ++k) \
        acc[ai][bj][m][n] = __builtin_amdgcn_mfma_f32_16x16x32_bf16(Bt[n][k], At[m][k], acc[ai][bj][m][n], 0, 0, 0); __builtin_amdgcn_s_setprio(0); } while (0)
#define PG8_WAIT_V(n) asm volatile("s_waitcnt vmcnt(" #n ")" ::: "memory")
#define PG8_WAIT_L(n) asm volatile("s_waitcnt lgkmcnt(" #n ")" ::: "memory")
#define PG8_BAR __builtin_amdgcn_s_barrier()
#define PG8_SCHED __builtin_amdgcn_sched_barrier(0)
    Unit cur, nxt; int ui = 0;
    if (!S.next(0, cur)) return;
    f32x4 acc[2][2][4][2];
#pragma unroll
    for (int a = 0; a < 2; ++a)
#pragma unroll
        for (int b = 0; b < 2; ++b)
#pragma unroll
            for (int m = 0; m < 4; ++m)
#pragma unroll
                for (int n = 0; n < 2; ++n) acc[a][b][m][n] = (f32x4){0.f, 0.f, 0.f, 0.f};
    bf16x8 At[4][2], B0[2][2], B1[2][2];
    const char* cA = cur.A; const char* cB = cur.B;
    if constexpr (SP2) {
      PG8_STAGE(PG8_SB(0, 0), cB, voffB); PG8_STAGE(PG8_SB(0, 1), cB + hsB, voffB); PG8_STAGE(PG8_SA(0, 0), cA, voffA); PG8_STAGE(PG8_SA(0, 1), cA + hsA, voffA);
      if (wr == 1) PG8_BAR;
      PG8_WAIT_V(2); PG8_BAR;
      PG8_STAGE(PG8_SB(1, 0), cB + kstep, voffB); PG8_STAGE(PG8_SA(1, 0), cA + kstep, voffA); PG8_STAGE(PG8_SB(1, 1), cB + hsB + kstep, voffB);
      PG8_WAIT_V(6); PG8_BAR;
    } else {
    PG8_STAGE(PG8_SB(0, 0), cB, voffB); PG8_STAGE(PG8_SA(0, 0), cA, voffA); PG8_STAGE(PG8_SB(0, 1), cB + hsB, voffB); PG8_STAGE(PG8_SA(0, 1), cA + hsA, voffA);
    if (wr == 1) PG8_BAR;
    PG8_WAIT_V(4); PG8_BAR;
    PG8_STAGE(PG8_SB(1, 0), cB + kstep, voffB); PG8_STAGE(PG8_SA(1, 0), cA + kstep, voffA); PG8_STAGE(PG8_SB(1, 1), cB + hsB + kstep, voffB);
    PG8_WAIT_V(6); PG8_BAR;
    }
    for (;;) {
        const bool has_next = S.next(ui + 1, nxt);
        const char* nA = has_next ? nxt.A : cA; const char* nB = has_next ? nxt.B : cB;
        for (int t = 0; t < nt; t += 2) {
            const bool last = (t == nt - 2);
            const char* a1 = cA + (size_t)(t + 1) * kstep;
            const char* a2 = last ? nA : cA + (size_t)(t + 2) * kstep; const char* b2 = last ? nB : cB + (size_t)(t + 2) * kstep;
            const char* a3 = a2 + kstep; const char* b3 = b2 + kstep;
            if constexpr (SP2) {
            PG8_LDB(B0, 0, 0); PG8_LDB(B1, 0, 1); PG8_SCHED; PG8_LDA(At, 0, 0); PG8_STAGE(PG8_SA(1, 1), a1 + hsA, voffA);
            PG8_WAIT_V(8); PG8_WAIT_L(0); PG8_BAR; PG8_MMA(0, 0, At, B0); PG8_MMA(0, 1, At, B1); PG8_BAR; PG8_SCHED;
            PG8_LDA(At, 0, 1); PG8_STAGE(PG8_SB(0, 0), b2, voffB); PG8_STAGE(PG8_SB(0, 1), b2 + hsB, voffB); PG8_STAGE(PG8_SA(0, 0), a2, voffA);
            PG8_WAIT_V(8); PG8_WAIT_L(0); PG8_BAR; PG8_MMA(1, 0, At, B0); PG8_MMA(1, 1, At, B1); PG8_BAR; PG8_SCHED;
            PG8_LDB(B0, 1, 0); PG8_LDB(B1, 1, 1); PG8_SCHED; PG8_LDA(At, 1, 0); PG8_STAGE(PG8_SA(0, 1), a2 + hsA, voffA);
            PG8_WAIT_V(8); PG8_WAIT_L(0); PG8_BAR; PG8_MMA(0, 0, At, B0); PG8_MMA(0, 1, At, B1); PG8_BAR; PG8_SCHED;
            PG8_LDA(At, 1, 1); PG8_STAGE(PG8_SB(1, 0), b3, voffB); PG8_STAGE(PG8_SB(1, 1), b3 + hsB, voffB); PG8_STAGE(PG8_SA(1, 0), a3, voffA);
            PG8_WAIT_V(8); PG8_WAIT_L(0); PG8_BAR; PG8_MMA(1, 0, At, B0); PG8_MMA(1, 1, At, B1); PG8_BAR; PG8_SCHED;
            } else {
            PG8_LDB(B0, 0, 0); PG8_SCHED; PG8_LDA(At, 0, 0); PG8_STAGE(PG8_SA(1, 1), a1 + hsA, voffA);
            PG8_WAIT_L(8); PG8_BAR; PG8_WAIT_L(0); PG8_MMA(0, 0, At, B0); PG8_BAR; PG8_SCHED;
            PG8_LDB(B1, 0, 1); PG8_STAGE(PG8_SB(0, 0), b2, voffB);
            PG8_BAR; PG8_WAIT_L(0); PG8_MMA(0, 1, At, B1); PG8_BAR;
            PG8_LDA(At, 0, 1); PG8_STAGE(PG8_SA(0, 0), a2, voffA);
            PG8_BAR; PG8_WAIT_L(0); PG8_MMA(1, 0, At, B0); PG8_BAR; PG8_SCHED;
            PG8_STAGE(PG8_SB(0, 1), b2 + hsB, voffB);
            PG8_WAIT_V(6); PG8_BAR; PG8_MMA(1, 1, At, B1); PG8_BAR;
            PG8_LDB(B0, 1, 0); PG8_SCHED; PG8_LDA(At, 1, 0); PG8_STAGE(PG8_SA(0, 1), a2 + hsA, voffA);
            PG8_WAIT_L(8); PG8_BAR; PG8_WAIT_L(0); PG8_MMA(0, 0, At, B0); PG8_BAR; PG8_SCHED;
            PG8_LDB(B1, 1, 1); PG8_STAGE(PG8_SB(1, 0), b3, voffB);
            PG8_BAR; PG8_WAIT_L(0); PG8_MMA(0, 1, At, B1); PG8_BAR;
            PG8_LDA(At, 1, 1); PG8_STAGE(PG8_SA(1, 0), a3, voffA);
            PG8_BAR; PG8_WAIT_L(0); PG8_MMA(1, 0, At, B0); PG8_BAR; PG8_SCHED;
            PG8_STAGE(PG8_SB(1, 1), b3 + hsB, voffB);
            PG8_WAIT_V(6); PG8_BAR; PG8_MMA(1, 1, At, B1); PG8_BAR;
            }
        }
        if (ALIGN && wr == 0) PG8_BAR;
        { int efr = fr, efq = fq; asm volatile("" : "+v"(efr), "+v"(efq)); E(acc, cur, wr, wc, efr, efq); }
        if (!has_next) break;
#pragma unroll
        for (int a = 0; a < 2; ++a)
#pragma unroll
            for (int b = 0; b < 2; ++b)
#pragma unroll
                for (int m = 0; m < 4; ++m)
#pragma unroll
                    for (int n = 0; n < 2; ++n) acc[a][b][m][n] = (f32x4){0.f, 0.f, 0.f, 0.f};
        cur = nxt; cA = nA; cB = nB; ++ui;
        if (ALIGN && wr == 1) PG8_BAR;
    }
    PG8_WAIT_V(0);
    if (!ALIGN && wr == 0) PG8_BAR;
    PG8_BAR;
#undef PG8_SA
#undef PG8_SB
#undef PG8_STAGE
#undef PG8_LDA
#undef PG8_LDB
#undef PG8_MMA
#undef PG8_WAIT_V
#undef PG8_WAIT_L
#undef PG8_BAR
#undef PG8_SCHED
}

template <bool ALIGN = true, bool SP2 = PG8_SP2, class Epi, class Sched>
__device__ __forceinline__ void gemm_phase_gather(PG8_LAS unsigned char* lds, const GemmG g, const Sched& S, const Epi& E, const char* Abase, const int* rowidx, const unsigned zoff) {
    const int tid = ph_tid(), wid = __builtin_amdgcn_readfirstlane(tid >> 6), lane = tid & 63, wr = wid >> 2, wc = wid & 3, fr = lane & 15, fq = lane >> 4;
    const int K = g.K, nt = K / BK;
    unsigned voffB[2];
#pragma unroll
    for (int i = 0; i < 2; ++i) { int R, C; stage_rc(tid * 16 + i * 8192, R, C); const int Rb = (R & ~31) + perm32(R & 31);
        const int wrow = g.bmode ? (((Rb >> 4) & 1) * DM + 16 * ((Rb >> 5) & 3) + (Rb & 15)) : Rb;
        voffB[i] = (unsigned)(wrow * g.ldb + C) * 2u; }
    unsigned vc0[2], vc1[2], vn0[2], vn1[2];
#define PG8_GOFF(dst0, dst1, u) do { const int _t = ph_tid(); _Pragma("unroll") for (int _i = 0; _i < 2; ++_i) { int _R, _C; stage_rc(_t * 16 + _i * 8192, _R, _C); const int _r0 = rowidx[(u).pm * BM + _R], _r1 = rowidx[(u).pm * BM + HALF + _R]; \
        dst0[_i] = (_r0 >= 0 ? (unsigned)_r0 * (unsigned)(g.lda * 2) : zoff) + (unsigned)_C * 2u; dst1[_i] = (_r1 >= 0 ? (unsigned)_r1 * (unsigned)(g.lda * 2) : zoff) + (unsigned)_C * 2u; } } while (0)
    const size_t kstep = (size_t)(BK * 2);
    const size_t hsB = (size_t)(g.bmode ? 2 * DM : HALF) * g.ldb * 2;
    const unsigned ldsw = (unsigned)wid * 1024u;
    const int aoff = lds_byte(wr * 64 + fr, fq * 8), boff = lds_byte(wc * 32 + fr, fq * 8);
#define PG8_SA(b, h) (((b) * 2 + (h)) * HTB)
#define PG8_SB(b, h) ((4 + (b) * 2 + (h)) * HTB)
#define PG8_STAGE(bufoff, gbase, voff) do { _Pragma("unroll") for (int _i = 0; _i < 2; ++_i) \
        __builtin_amdgcn_global_load_lds((const unsigned*)((const char*)(gbase) + (voff)[_i]), (PG8_LAS unsigned*)(lds + (bufoff) + ldsw + _i * 8192), 16, 0, 0); } while (0)
#define PG8_LDA(dst, b, h) do { _Pragma("unroll") for (int m = 0; m < 4; ++m) _Pragma("unroll") for (int k = 0; k < 2; ++k) dst[m][k] = *(const PG8_LAS bf16x8*)(lds + PG8_SA(b, h) + aoff + m * 2048 + k * 1024); } while (0)
#define PG8_LDB(dst, b, h) do { _Pragma("unroll") for (int n = 0; n < 2; ++n) _Pragma("unroll") for (int k = 0; k < 2; ++k) dst[n][k] = *(const PG8_LAS bf16x8*)(lds + PG8_SB(b, h) + boff + n * 2048 + k * 1024); } while (0)
#define PG8_MMA(ai, bj, At, Bt) do { __builtin_amdgcn_s_setprio(1); _Pragma("unroll") for (int m = 0; m < 4; ++m) _Pragma("unroll") for (int n = 0; n < 2; ++n) _Pragma("unroll") for (int k = 0; k < 2; ++k) \
        acc[ai][bj][m][n] = __builtin_amdgcn_mfma_f32_16x16x32_bf16(Bt[n][k], At[m][k], acc[ai][bj][m][n], 0, 0, 0); __builtin_amdgcn_s_setprio(0); } while (0)
#define PG8_WAIT_V(n) asm volatile("s_waitcnt vmcnt(" #n ")" ::: "memory")
#define PG8_WAIT_L(n) asm volatile("s_waitcnt lgkmcnt(" #n ")" ::: "memory")
#define PG8_BAR __builtin_amdgcn_s_barrier()
#define PG8_SCHED __builtin_amdgcn_sched_barrier(0)
    Unit cur, nxt; int ui = 0;
    if (!S.next(0, cur)) return;
    f32x4 acc[2][2][4][2];
#pragma unroll
    for (int a = 0; a < 2; ++a)
#pragma unroll
        for (int b = 0; b < 2; ++b)
#pragma unroll
            for (int m = 0; m < 4; ++m)
#pragma unroll
                for (int n = 0; n < 2; ++n) acc[a][b][m][n] = (f32x4){0.f, 0.f, 0.f, 0.f};
    bf16x8 At[4][2], B0[2][2], B1[2][2];
    const char* cA = Abase; const char* cB = cur.B;
    PG8_GOFF(vc0, vc1, cur);
    if constexpr (SP2) {
      PG8_STAGE(PG8_SB(0, 0), cB, voffB); PG8_STAGE(PG8_SB(0, 1), cB + hsB, voffB); PG8_STAGE(PG8_SA(0, 0), cA, vc0); PG8_STAGE(PG8_SA(0, 1), cA, vc1);
      if (wr == 1) PG8_BAR;
      PG8_WAIT_V(2); PG8_BAR;
      PG8_STAGE(PG8_SB(1, 0), cB + kstep, voffB); PG8_STAGE(PG8_SA(1, 0), cA + kstep, vc0); PG8_STAGE(PG8_SB(1, 1), cB + hsB + kstep, voffB);
      PG8_WAIT_V(6); PG8_BAR;
    } else {
    PG8_STAGE(PG8_SB(0, 0), cB, voffB); PG8_STAGE(PG8_SA(0, 0), cA, vc0); PG8_STAGE(PG8_SB(0, 1), cB + hsB, voffB); PG8_STAGE(PG8_SA(0, 1), cA, vc1);
    if (wr == 1) PG8_BAR;
    PG8_WAIT_V(4); PG8_BAR;
    PG8_STAGE(PG8_SB(1, 0), cB + kstep, voffB); PG8_STAGE(PG8_SA(1, 0), cA + kstep, vc0); PG8_STAGE(PG8_SB(1, 1), cB + hsB + kstep, voffB);
    PG8_WAIT_V(6); PG8_BAR;
    }
    for (;;) {
        const bool has_next = S.next(ui + 1, nxt);
        const char* nB = has_next ? nxt.B : cB;
        if (has_next) { PG8_GOFF(vn0, vn1, nxt); } else {
#pragma unroll
          for (int _i = 0; _i < 2; ++_i) { vn0[_i] = vc0[_i]; vn1[_i] = vc1[_i]; } }
        for (int t = 0; t < nt; t += 2) {
            const bool last = (t == nt - 2);
            const char* a1 = cA + (size_t)(t + 1) * kstep;
            const char* a2 = last ? cA : cA + (size_t)(t + 2) * kstep; const char* b2 = last ? nB : cB + (size_t)(t + 2) * kstep;
            const char* a3 = a2 + kstep; const char* b3 = b2 + kstep;
            if constexpr (SP2) {
            PG8_LDB(B0, 0, 0); PG8_LDB(B1, 0, 1); PG8_SCHED; PG8_LDA(At, 0, 0); PG8_STAGE(PG8_SA(1, 1), a1, vc1);
            PG8_WAIT_V(8); PG8_WAIT_L(0); PG8_BAR; PG8_MMA(0, 0, At, B0); PG8_MMA(0, 1, At, B1); PG8_BAR; PG8_SCHED;
            PG8_LDA(At, 0, 1); PG8_STAGE(PG8_SB(0, 0), b2, voffB); PG8_STAGE(PG8_SB(0, 1), b2 + hsB, voffB); if (last) PG8_STAGE(PG8_SA(0, 0), a2, vn0); else PG8_STAGE(PG8_SA(0, 0), a2, vc0);
            PG8_WAIT_V(8); PG8_WAIT_L(0); PG8_BAR; PG8_MMA(1, 0, At, B0); PG8_MMA(1, 1, At, B1); PG8_BAR; PG8_SCHED;
            PG8_LDB(B0, 1, 0); PG8_LDB(B1, 1, 1); PG8_SCHED; PG8_LDA(At, 1, 0); if (last) PG8_STAGE(PG8_SA(0, 1), a2, vn1); else PG8_STAGE(PG8_SA(0, 1), a2, vc1);
            PG8_WAIT_V(8); PG8_WAIT_L(0); PG8_BAR; PG8_MMA(0, 0, At, B0); PG8_MMA(0, 1, At, B1); PG8_BAR; PG8_SCHED;
            PG8_LDA(At, 1, 1); PG8_STAGE(PG8_SB(1, 0), b3, voffB); PG8_STAGE(PG8_SB(1, 1), b3 + hsB, voffB); if (last) PG8_STAGE(PG8_SA(1, 0), a3, vn0); else PG8_STAGE(PG8_SA(1, 0), a3, vc0);
            PG8_WAIT_V(8); PG8_WAIT_L(0); PG8_BAR; PG8_MMA(1, 0, At, B0); PG8_MMA(1, 1, At, B1); PG8_BAR; PG8_SCHED;
            } else {
            PG8_LDB(B0, 0, 0); PG8_SCHED; PG8_LDA(At, 0, 0); PG8_STAGE(PG8_SA(1, 1), a1, vc1);
            PG8_WAIT_L(8); PG8_BAR; PG8_WAIT_L(0); PG8_MMA(0, 0, At, B0); PG8_BAR; PG8_SCHED;
            PG8_LDB(B1, 0, 1); PG8_STAGE(PG8_SB(0, 0), b2, voffB);
            PG8_BAR; PG8_WAIT_L(0); PG8_MMA(0, 1, At, B1); PG8_BAR;
            PG8_LDA(At, 0, 1); if (last) PG8_STAGE(PG8_SA(0, 0), a2, vn0); else PG8_STAGE(PG8_SA(0, 0), a2, vc0);
            PG8_BAR; PG8_WAIT_L(0); PG8_MMA(1, 0, At, B0); PG8_BAR; PG8_SCHED;
            PG8_STAGE(PG8_SB(0, 1), b2 + hsB, voffB);
            PG8_WAIT_V(6); PG8_BAR; PG8_MMA(1, 1, At, B1); PG8_BAR;
            PG8_LDB(B0, 1, 0); PG8_SCHED; PG8_LDA(At, 1, 0); if (last) PG8_STAGE(PG8_SA(0, 1), a2, vn1); else PG8_STAGE(PG8_SA(0, 1), a2, vc1);
            PG8_WAIT_L(8); PG8_BAR; PG8_WAIT_L(0); PG8_MMA(0, 0, At, B0); PG8_BAR; PG8_SCHED;
            PG8_LDB(B1, 1, 1); PG8_STAGE(PG8_SB(1, 0), b3, voffB);
            PG8_BAR; PG8_WAIT_L(0); PG8_MMA(0, 1, At, B1); PG8_BAR;
            PG8_LDA(At, 1, 1); if (last) PG8_STAGE(PG8_SA(1, 0), a3, vn0); else PG8_STAGE(PG8_SA(1, 0), a3, vc0);
            PG8_BAR; PG8_WAIT_L(0); PG8_MMA(1, 0, At, B0); PG8_BAR; PG8_SCHED;
            PG8_STAGE(PG8_SB(1, 1), b3 + hsB, voffB);
            PG8_WAIT_V(6); PG8_BAR; PG8_MMA(1, 1, At, B1); PG8_BAR;
            }
        }
        if (ALIGN && wr == 0) PG8_BAR;
        { int efr = fr, efq = fq; asm volatile("" : "+v"(efr), "+v"(efq)); E(acc, cur, wr, wc, efr, efq); }
        if (!has_next) break;
#pragma unroll
        for (int a = 0; a < 2; ++a)
#pragma unroll
            for (int b = 0; b < 2; ++b)
#pragma unroll
                for (int m = 0; m < 4; ++m)
#pragma unroll
                    for (int n = 0; n < 2; ++n) acc[a][b][m][n] = (f32x4){0.f, 0.f, 0.f, 0.f};
        cur = nxt; cB = nB; ++ui;
#pragma unroll
        for (int _i = 0; _i < 2; ++_i) { vc0[_i] = vn0[_i]; vc1[_i] = vn1[_i]; }
        if (ALIGN && wr == 1) PG8_BAR;
    }
    PG8_WAIT_V(0);
    if (!ALIGN && wr == 0) PG8_BAR;
    PG8_BAR;
#undef PG8_GOFF
#undef PG8_SA
#undef PG8_SB
#undef PG8_STAGE
#undef PG8_LDA
#undef PG8_LDB
#undef PG8_MMA
#undef PG8_WAIT_V
#undef PG8_WAIT_L
#undef PG8_BAR
#undef PG8_SCHED
}

struct SchedGrid {
  const char* A; const char* B; int lda, ldb, nM, nN, skip_ctx, G, c, pad;
  __device__ __forceinline__ bool next(int i, Unit& u) const {
    int pm, pn; if (!tile_order((long)i * G + c, nM, nN, pm, pn)) return false;
    if (skip_ctx && pm >= NTOK / 256 - 1) pm += 1;
    u.pm = pm; u.pn = pn; u.aux = 0; u.A = A + (size_t)pm * BM * lda * 2; u.B = B + (size_t)pn * BM * ldb * 2; return true; }
};
struct SchedProj {
  const char* OA; const char* B; int nM, skip_ctx, G, c;
  __device__ __forceinline__ bool next(int i, Unit& u) const {
    int pm, pn; if (!tile_order((long)i * G + c, nM, 4 * DM / 256, pm, pn)) return false;
    if (skip_ctx && pm >= NTOK / 256 - 1) pm += 1;
    const int k = pn / (DM / 256);
    u.pm = pm; u.pn = pn; u.aux = k; u.A = OA + ((size_t)pm * BM * DM + (size_t)k * BW) * 2; u.B = B + (size_t)pn * BM * BW * 2; return true; }
};
struct SchedGate {
  const char* H; const char* B; int nM, skip_ctx, G, c;
  __device__ __forceinline__ bool next(int i, Unit& u) const {
    const int j = i >> 2, k = i & 3; int pm, pd; if (!tile_order((long)j * G + c, nM, DM / 256, pm, pd)) return false;
    if (skip_ctx && pm >= NTOK / 256 - 1) pm += 1;
    u.pm = pm; u.pn = pd; u.aux = k; u.A = H + (size_t)pm * BM * DM * 2; u.B = B + ((size_t)k * DM + (size_t)pd * BM) * DM * 2; return true; }
};
struct SchedMoe {
  const char* A; const char* B; int lda, ldb, nMl, nN; size_t wstride; int G, c, xcd, pad;
  __device__ __forceinline__ bool next(int i, Unit& u) const {
    int e, rem; const int per_e = nMl * nN;
    if (xcd) { const int x = c & 7, idx = c >> 3, wpx = G >> 3, j = i * wpx + idx; if (j >= (NE / 8) * per_e) return false; e = x + 8 * (j / per_e); rem = j % per_e; }
    else { const long L = (long)i * G + c; if (L >= (long)NE * per_e) return false; e = (int)(L / per_e); rem = (int)(L % per_e); }
    const int pn = rem / nMl, pml = rem % nMl;
    u.pm = e * (XEP / 256) + pml; u.pn = pn; u.aux = e; u.A = A + (size_t)u.pm * BM * lda * 2; u.B = B + (size_t)e * wstride + (size_t)pn * BM * ldb * 2; return true; }
};

#define EPI_LOOP(...) _Pragma("unroll") for (int ai = 0; ai < 2; ++ai) _Pragma("unroll") for (int m = 0; m < 4; ++m) { const int trow = ai * HALF + wr * 64 + m * 16 + fr; \
    _Pragma("unroll") for (int bj = 0; bj < 2; ++bj) { const int tcol = bj * HALF + wc * 32 + 8 * fq; const f32x4 v0 = acc[ai][bj][m][0], v1 = acc[ai][bj][m][1]; __VA_ARGS__ } }
typedef f32x4 AccT[2][2][4][2];
struct EpiBf16 { bf16_t* O; int ldc, pad;
  __device__ __forceinline__ void operator()(const AccT& acc, const Unit& u, int wr, int wc, int fr, int fq) const {
    bf16_t* base = O + (size_t)u.pm * BM * ldc + (size_t)u.pn * BM;
    EPI_LOOP(st_out((u32x4*)(base + (size_t)trow * ldc + tcol), pack8(v0, v1));) } };
struct EpiF32 { float* O; int ldc, pad;
  __device__ __forceinline__ void operator()(const AccT& acc, const Unit& u, int wr, int wc, int fr, int fq) const {
    float* base = O + (size_t)u.pm * BM * ldc + (size_t)u.pn * BM;
    EPI_LOOP(float* q = base + (size_t)trow * ldc + tcol; st_out((f32x4*)q, v0); st_out((f32x4*)(q + 4), v1);) } };
struct EpiKVm { bf16_t* KM; bf16_t* VM;
  __device__ __forceinline__ void operator()(const AccT& acc, const Unit& u, int wr, int wc, int fr, int fq) const {
    bf16_t* kb = KM + (size_t)u.pm * BM * (MH * MQK) + u.pn * MQK; bf16_t* vb = VM + (size_t)u.pm * BM * (MH * MV) + u.pn * MV;
    EPI_LOOP(bf16_t* q = (bj == 0) ? kb + trow * (MH * MQK) + tcol : vb + trow * (MH * MV) + (tcol - HALF); *(u32x4*)q = pack8(v0, v1);) } };
struct EpiGluO { const bf16_t* Z; bf16_t* O;
  __device__ __forceinline__ void operator()(const AccT& acc, const Unit& u, int wr, int wc, int fr, int fq) const {
    EPI_LOOP(const size_t row = (size_t)u.pm * BM + trow; const int col = u.pn * BM + tcol; f32x4 z0, z1; unpack8(*(const u32x4*)(Z + row * BW + col), z0, z1);
             *(u32x4*)(O + row * DM + col) = pack8(z0 * sigmoid4(v0), z1 * sigmoid4(v1));) } };
struct EpiGateMerge { const float* bg; const bf16_t* PROJ; float* MACC; bf16_t* MG;
  __device__ __forceinline__ void operator()(const AccT& acc, const Unit& u, int wr, int wc, int fr, int fq) const {
    const int k = u.aux; const bf16_t* pb = PROJ + (size_t)u.pm * BM * (4 * DM) + k * DM + u.pn * BM; float* mb = MACC + (size_t)u.pm * BM * DM + u.pn * BM; bf16_t* gb = MG + (size_t)u.pm * BM * DM + u.pn * BM;
    const float* bp0 = bg + k * DM + u.pn * BM;
#pragma unroll
    for (int ai = 0; ai < 2; ++ai)
#pragma unroll
      for (int bj = 0; bj < 2; ++bj) { const int tcol = bj * HALF + wc * 32 + 8 * fq; u32x4 pj[4]; f32x4 m0[4], m1[4];
#pragma unroll
        for (int m = 0; m < 4; ++m) { const int trow = ai * HALF + wr * 64 + m * 16 + fr; pj[m] = *(const u32x4*)(pb + trow * (4 * DM) + tcol);
          if (k > 0) { m0[m] = *(const f32x4*)(mb + trow * DM + tcol); m1[m] = *(const f32x4*)(mb + trow * DM + tcol + 4); } }
        const f32x4 b0 = *(const f32x4*)(bp0 + tcol), b1 = *(const f32x4*)(bp0 + tcol + 4);
#pragma unroll
        for (int m = 0; m < 4; ++m) { const int trow = ai * HALF + wr * 64 + m * 16 + fr; f32x4 p0, p1; unpack8(pj[m], p0, p1);
          f32x4 r0 = sigmoid4(acc[ai][bj][m][0] + b0) * p0, r1 = sigmoid4(acc[ai][bj][m][1] + b1) * p1;
          if (k > 0) { r0 += m0[m]; r1 += m1[m]; }
          if (k < 3) { *(f32x4*)(mb + trow * DM + tcol) = r0; *(f32x4*)(mb + trow * DM + tcol + 4) = r1; } else *(u32x4*)(gb + trow * DM + tcol) = pack8(r0, r1); } } } };
struct EpiSwiGlu { bf16_t* ACT;
  __device__ __forceinline__ void operator()(const AccT& acc, const Unit& u, int wr, int wc, int fr, int fq) const {
#pragma unroll
    for (int ai = 0; ai < 2; ++ai)
#pragma unroll
      for (int m = 0; m < 4; ++m) { const size_t row = (size_t)u.pm * BM + ai * HALF + wr * 64 + m * 16 + fr; const int col = u.pn * HALF + wc * 32 + 8 * fq;
        const f32x4 g0 = acc[ai][0][m][0], g1 = acc[ai][0][m][1], u0 = acc[ai][1][m][0], u1 = acc[ai][1][m][1];
        st_out((u32x4*)(ACT + row * FF + col), pack8(g0 * sigmoid4(g0) * u0, g1 * sigmoid4(g1) * u1)); } } };
struct EpiDownG { const float* GV; bf16_t* YS;
  __device__ __forceinline__ void operator()(const AccT& acc, const Unit& u, int wr, int wc, int fr, int fq) const {
    EPI_LOOP(const size_t row = (size_t)u.pm * BM + trow; const float gv = GV[row]; *(u32x4*)(YS + row * DM + u.pn * BM + tcol) = pack8(v0 * gv, v1 * gv);) } };

struct SchedS5 { const char* UH; const char* W; size_t wstride; int G, c;
  __device__ __forceinline__ bool next(int i, Unit& u) const {
    const long L = (long)i * G + c; if (L >= (long)S5G * (S5NP / 256)) return false; const int g = (int)(L / (S5NP / 256)), pm = (int)(L % (S5NP / 256));
    u.pm = pm; u.pn = 0; u.aux = g; u.A = UH + ((size_t)g * S5NP + (size_t)pm * BM) * (S5K1 + S5K2) * 2; u.B = W + (size_t)g * wstride; return true; }
};
struct EpiS5E { float* E;
  __device__ __forceinline__ void operator()(const AccT& acc, const Unit& u, int wr, int wc, int fr, int fq) const {
    float* base = E + ((size_t)u.aux * S5NP + (size_t)u.pm * BM) * S5K2;
    EPI_LOOP(float* q = base + (size_t)trow * S5K2 + tcol; *(f32x4*)q = v0; *(f32x4*)(q + 4) = v1;) } };
__device__ __forceinline__ float fast_gelu_tanh(float x) { const float t = 0.7978845608028654f * (x + 0.044715f * x * x * x); const float e = __builtin_amdgcn_exp2f(2.885390081777927f * t);
  return 0.5f * x * (2.f - 2.f * __builtin_amdgcn_rcpf(e + 1.f)); }
struct EpiS5Y { const bf16_t* P; const float* D; bf16_t* Z; int last, pad;
  __device__ __forceinline__ void operator()(const AccT& acc, const Unit& u, int wr, int wc, int fr, int fq) const {
    const int g = u.aux;
#pragma unroll
    for (int ai = 0; ai < 2; ++ai) { u32x4 uu[4][2]; bool ok[4]; long Rr[4];
#pragma unroll
      for (int m = 0; m < 4; ++m) { const int n = u.pm * BM + ai * HALF + wr * 64 + m * 16 + fr; const int b = n / S5NC, j = n % S5NC; ok[m] = n < S5NN && !(last && j >= SEQ / S5LC);
#pragma unroll
        for (int bj = 0; bj < 2; ++bj) { const int tcol = bj * HALF + wc * 32 + 8 * fq, a = tcol >> 4, i0 = tcol & 15; const long R = (long)b * NTOK + j * S5LC + a; if (bj == 0) Rr[m] = R - a;
          uu[m][bj] = ok[m] ? *(const u32x4*)(P + R * PW + OFF_U + g * S5CH + i0) : (u32x4){0u, 0u, 0u, 0u}; } }
#pragma unroll
      for (int bj = 0; bj < 2; ++bj) { const int tcol = bj * HALF + wc * 32 + 8 * fq, a = tcol >> 4, i0 = tcol & 15; const float* dp = D + g * S5CH + i0; const f32x4 d0 = *(const f32x4*)dp, d1 = *(const f32x4*)(dp + 4);
#pragma unroll
        for (int m = 0; m < 4; ++m) if (ok[m]) { f32x4 u0, u1; unpack8(uu[m][bj], u0, u1); f32x4 y0 = acc[ai][bj][m][0] + d0 * u0, y1 = acc[ai][bj][m][1] + d1 * u1;
#pragma unroll
          for (int q = 0; q < 4; ++q) { y0[q] = fast_gelu_tanh(y0[q]); y1[q] = fast_gelu_tanh(y1[q]); }
          *(u32x4*)(Z + (Rr[m] + a) * BW + g * S5CH + i0) = pack8(y0, y1); } } } } };
struct SchedGateCtx { const char* H; const char* B; int G, c;
  __device__ __forceinline__ bool next(int i, Unit& u) const {
    const int L = i * G + c; if (L >= 2 * (4 * DM / BM)) return false; const int ct = L / (4 * DM / BM), pn = L % (4 * DM / BM), pm = ct * (NTOK / BM) + SEQ / BM;
    u.pm = pm; u.pn = pn; u.aux = ct; u.A = H + (size_t)pm * BM * DM * 2; u.B = B + (size_t)pn * BM * DM * 2; return true; }
};
struct EpiGateCtx { const float* bg; bf16_t* GC;
  __device__ __forceinline__ void operator()(const AccT& acc, const Unit& u, int wr, int wc, int fr, int fq) const {
    bf16_t* base = GC + (size_t)u.aux * BM * (4 * DM) + u.pn * BM; const float* bp = bg + u.pn * BM;
    EPI_LOOP(*(u32x4*)(base + trow * (4 * DM) + tcol) = pack8(sigmoid4(v0 + *(const f32x4*)(bp + tcol)), sigmoid4(v1 + *(const f32x4*)(bp + tcol + 4)));) } };
struct SchedProjW { const char* OA; const char* B; int nM, skip_ctx, G, c, nA, ua, ub, pad;
  __device__ __forceinline__ bool next(int i, Unit& u) const {
    long L; if (c < nA) { if (i >= ua) return false; L = (long)c * ua + i; } else { if (i >= ub) return false; L = (long)nA * ua + (long)(c - nA) * ub + i; }
    int pm, pn; if (!tile_order(L, nM, 4 * DM / 256, pm, pn)) return false;
    if (skip_ctx && pm >= NTOK / 256 - 1) pm += 1;
    const int k = pn / (DM / 256);
    u.pm = pm; u.pn = pn; u.aux = k; u.A = OA + ((size_t)pm * BM * DM + (size_t)k * BW) * 2; u.B = B + (size_t)pn * BM * BW * 2; return true; }
};

struct SchedGate4 { const char* H; const char* B; int G, c;
  __device__ __forceinline__ bool next(int i, Unit& u) const {
    int pm, pd; if (!tile_order((long)i * G + c, MROWS / BM - 2, DM / 64, pm, pd)) return false;
    if (pm >= NTOK / BM - 1) pm += 1;
    u.pm = pm; u.pn = pd; u.aux = 0; u.A = H + (size_t)pm * BM * DM * 2; u.B = B + (size_t)pd * 64 * DM * 2; return true; }
};
struct EpiGate4 { const float* bg; const bf16_t* PROJ; bf16_t* MG;
  __device__ __forceinline__ void operator()(const AccT& acc, const Unit& u, int wr, int wc, int fr, int fq) const {
    const int kb = fq >> 1, d0 = u.pn * 64 + 16 * wc + 8 * (fq & 1); const bf16_t* pb = PROJ + (size_t)u.pm * BM * (4 * DM) + kb * DM + d0; bf16_t* gb = MG + (size_t)u.pm * BM * DM + d0;
    const float* bp = bg + kb * DM + d0; const f32x4 b00 = *(const f32x4*)bp, b01 = *(const f32x4*)(bp + 4), b10 = *(const f32x4*)(bp + 2 * DM), b11 = *(const f32x4*)(bp + 2 * DM + 4);
    u32x4 p0[2][4], p1[2][4];
#pragma unroll
    for (int ai = 0; ai < 2; ++ai)
#pragma unroll
      for (int m = 0; m < 4; ++m) { const int trow = ai * HALF + wr * 64 + m * 16 + fr; p0[ai][m] = *(const u32x4*)(pb + trow * (4 * DM)); p1[ai][m] = *(const u32x4*)(pb + trow * (4 * DM) + 2 * DM); }
#pragma unroll
    for (int ai = 0; ai < 2; ++ai)
#pragma unroll
      for (int m = 0; m < 4; ++m) { const int trow = ai * HALF + wr * 64 + m * 16 + fr; f32x4 q0, q1, q2, q3; unpack8(p0[ai][m], q0, q1); unpack8(p1[ai][m], q2, q3);
        f32x4 r0 = sigmoid4(acc[ai][0][m][0] + b00) * q0 + sigmoid4(acc[ai][1][m][0] + b10) * q2, r1 = sigmoid4(acc[ai][0][m][1] + b01) * q1 + sigmoid4(acc[ai][1][m][1] + b11) * q3;
#pragma unroll
        for (int j = 0; j < 4; ++j) { r0[j] += __shfl_xor(r0[j], 32); r1[j] += __shfl_xor(r1[j], 32); }
        if (kb == 0) st_out((u32x4*)(gb + trow * DM), pack8(r0, r1)); } } };

struct SchedKR { const char* H; const char* B; int G, c;
  __device__ __forceinline__ bool next(int i, Unit& u) const {
    const int L = i * G + c; if (L >= MROWS / BM) return false;
    u.pm = L; u.pn = PW / BM - 1; u.aux = 0; u.A = H + (size_t)L * BM * DM * 2; u.B = B + (size_t)(PW / BM - 1) * BM * DM * 2; return true; }
};
struct EpiKR { bf16_t* KM; const float* tb;
  __device__ __forceinline__ void operator()(const AccT& acc, const Unit& u, int wr, int wc, int fr, int fq) const {
    static_assert(IN_TOTAL - OFF_KR == 64 && OFF_KR == (PW / BM - 1) * BM, "rope key = first 64 columns of the last column tile");
    if (wc >= 2) return;
    const bool lat_tile = (u.pm % (NTOK / BM)) < SEQ / BM; const int t0 = (u.pm % (NTOK / BM)) * BM; bf16_t* base = KM + (size_t)u.pm * BM * (MH * MQK) + MNOPE + wc * 32 + 8 * fq;
#pragma unroll
    for (int ai = 0; ai < 2; ++ai)
#pragma unroll
      for (int m = 0; m < 4; ++m) { const int trow = ai * HALF + wr * 64 + m * 16 + fr; f32x4 a = acc[ai][0][m][0], b2 = acc[ai][0][m][1];
        if (lat_tile) { const int t = t0 + trow; const float* cs = tb + ((wc ? t % GRIDW : t / GRIDW) * NROPE_B + ((8 * fq) & 15)) * 2;
#pragma unroll
          for (int j = 0; j < 4; ++j) { const float oa = __shfl_xor(a[j], 32), ob = __shfl_xor(b2[j], 32); const float ca = cs[2 * j], sa = cs[2 * j + 1], cb = cs[8 + 2 * j], sb = cs[8 + 2 * j + 1];
            a[j] = a[j] * ca + (fq < 2 ? -oa : oa) * sa; b2[j] = b2[j] * cb + (fq < 2 ? -ob : ob) * sb; } }
        const u32x4 w = pack8(a, b2);
#pragma unroll
        for (int h = 0; h < MH; ++h) *(u32x4*)(base + trow * (MH * MQK) + h * MQK) = w; } } };

struct SchedKR2 { const char* H; const char* B; int G, c;
  __device__ __forceinline__ bool next(int i, Unit& u) const {
    const int L = i * G + c; if (L >= 2 * (MROWS / BM)) return false; const int pm = L >> 1, kh = L & 1;
    u.pm = pm; u.pn = PW / BM - 1; u.aux = kh; u.A = H + ((size_t)pm * BM * DM + (size_t)kh * (DM / 2)) * 2; u.B = B + ((size_t)(PW / BM - 1) * BM * DM + (size_t)kh * (DM / 2)) * 2; return true; }
};
struct EpiKRpart { float* KRP;
  __device__ __forceinline__ void operator()(const AccT& acc, const Unit& u, int wr, int wc, int fr, int fq) const {
    if (wc >= 2) return;
    float* base = KRP + ((size_t)u.aux * MROWS + (size_t)u.pm * BM) * MROPE + wc * 32 + 8 * fq;
#pragma unroll
    for (int ai = 0; ai < 2; ++ai)
#pragma unroll
      for (int m = 0; m < 4; ++m) { const int trow = ai * HALF + wr * 64 + m * 16 + fr; float* q = base + trow * MROPE; *(f32x4*)q = acc[ai][0][m][0]; *(f32x4*)(q + 4) = acc[ai][0][m][1]; } } };

struct SchedOutCtx { const char* MG; const char* B; int G, c;
  __device__ __forceinline__ bool next(int i, Unit& u) const {
    const int L = i * G + c; if (L >= 2 * (DM / BM) * 4) return false; const int kq = L & 3, pn = (L >> 2) % (DM / BM), ct = L / (4 * (DM / BM)), pm = ct * (NTOK / BM) + SEQ / BM;
    u.pm = ct; u.pn = pn; u.aux = kq; u.A = MG + ((size_t)pm * BM * DM + (size_t)kq * (DM / 4)) * 2; u.B = B + ((size_t)pn * BM * DM + (size_t)kq * (DM / 4)) * 2; return true; }
};
struct EpiSlab { float* Y;
  __device__ __forceinline__ void operator()(const AccT& acc, const Unit& u, int wr, int wc, int fr, int fq) const {
    float* base = Y + ((size_t)u.aux * NB * CTXL + (size_t)u.pm * BM) * DM + u.pn * BM;
    EPI_LOOP(float* q = base + (size_t)trow * DM + tcol; *(f32x4*)q = v0; *(f32x4*)(q + 4) = v1;) } };
struct EpiQM { bf16_t* QM; const float* tb;
  __device__ __forceinline__ void operator()(const AccT& acc, const Unit& u, int wr, int wc, int fr, int fq) const {
    const bool lat_tile = (u.pm % (NTOK / BM)) < SEQ / BM; bf16_t* base = QM + (size_t)u.pm * BM * (MH * MQK) + u.pn * BM; const int t0 = (u.pm % (NTOK / BM)) * BM;
    EPI_LOOP(const int cr = (u.pn * BM + tcol) % MQK; f32x4 a = v0, b2 = v1;
      if (cr >= MNOPE && lat_tile) { const int t = t0 + trow, hf = (cr - MNOPE) >> 5, off = (cr - MNOPE) & 31; const float* cs = tb + (((hf ? t % GRIDW : t / GRIDW)) * NROPE_B + (off & 15)) * 2;
        _Pragma("unroll") for (int j = 0; j < 4; ++j) { const float oa = __shfl_xor(a[j], 32), ob = __shfl_xor(b2[j], 32); const float ca = cs[2 * j], sa = cs[2 * j + 1], cb = cs[8 + 2 * j], sb = cs[8 + 2 * j + 1];
          a[j] = a[j] * ca + (fq < 2 ? -oa : oa) * sa; b2[j] = b2[j] * cb + (fq < 2 ? -ob : ob) * sb; } }
      *(u32x4*)(base + trow * (MH * MQK) + tcol) = pack8(a, b2);) } };
}

template <class Epi, class Sched> __global__ __launch_bounds__(512, 2) void k_gemm_phase(pg8::GemmG g, Sched S, Epi E) {
  extern __shared__ __attribute__((aligned(16))) unsigned char shm[];
  S.G = gridDim.x; S.c = blockIdx.x;
  pg8::gemm_phase<Epi, Sched>((PG8_LAS unsigned char*)shm, g, S, E);
}
#endif
#ifndef CPU_TEST
namespace ph {
using pg8::f32x4; using pg8::u32x4; using pg8::pack8; using pg8::unpack8;
#define LAS __attribute__((address_space(3)))
__device__ __forceinline__ float wave_sum(float v) { v += __shfl_xor(v, 32); v += __shfl_xor(v, 16); v += __shfl_xor(v, 8); v += __shfl_xor(v, 4); v += __shfl_xor(v, 2); v += __shfl_xor(v, 1); return v; }
__device__ __forceinline__ float wave_max(float v) { v = fmaxf(v, __shfl_xor(v, 32)); v = fmaxf(v, __shfl_xor(v, 16)); v = fmaxf(v, __shfl_xor(v, 8)); v = fmaxf(v, __shfl_xor(v, 4)); v = fmaxf(v, __shfl_xor(v, 2)); v = fmaxf(v, __shfl_xor(v, 1)); return v; }
__device__ __forceinline__ float sum8(const f32x4& a, const f32x4& b) { return ((a[0] + a[1]) + (a[2] + a[3])) + ((b[0] + b[1]) + (b[2] + b[3])); }
__device__ __forceinline__ const float* resid_row(const Params& p, int l, int R) {
  const int b = row_b(R), t = row_t(R); return t < SEQ ? p.in[I_X] + ((long)b * SEQ + t) * DM : p.in[I_CTX] + ((long)b * CTXL + (t - SEQ)) * DM;
}

constexpr int NCH = DM / 512;
static_assert(DM % 512 == 0, "row chunking");
struct RowV { f32x4 a[NCH], b[NCH]; };
__device__ __forceinline__ void row_load(RowV& v, const float* x, int lane) {
#pragma unroll
  for (int c = 0; c < NCH; ++c) { const float* q = x + c * 512 + lane * 8; v.a[c] = *(const f32x4*)q; v.b[c] = *(const f32x4*)(q + 4); } }
__device__ __forceinline__ void row_store(const RowV& v, float* x, int lane) {
#pragma unroll
  for (int c = 0; c < NCH; ++c) { float* q = x + c * 512 + lane * 8; *(f32x4*)q = v.a[c]; *(f32x4*)(q + 4) = v.b[c]; } }
__device__ __forceinline__ void row_load_nt(RowV& v, const float* x, int lane) {
#pragma unroll
  for (int c = 0; c < NCH; ++c) { const float* q = x + c * 512 + lane * 8; v.a[c] = __builtin_nontemporal_load((const f32x4*)q); v.b[c] = __builtin_nontemporal_load((const f32x4*)(q + 4)); } }
__device__ __forceinline__ void row_load_bf_nt(RowV& v, const bf16_t* x, int lane) {
#pragma unroll
  for (int c = 0; c < NCH; ++c) unpack8(__builtin_nontemporal_load((const u32x4*)(x + c * 512 + lane * 8)), v.a[c], v.b[c]); }
__device__ __forceinline__ void row_store_bf_nt(const RowV& v, bf16_t* x, int lane) {
#pragma unroll
  for (int c = 0; c < NCH; ++c) __builtin_nontemporal_store(pack8(v.a[c], v.b[c]), (u32x4*)(x + c * 512 + lane * 8)); }
__device__ __forceinline__ void row_load_bf(RowV& v, const bf16_t* x, int lane) {
#pragma unroll
  for (int c = 0; c < NCH; ++c) unpack8(*(const u32x4*)(x + c * 512 + lane * 8), v.a[c], v.b[c]); }
__device__ __forceinline__ void row_store_bf(const RowV& v, bf16_t* x, int lane) {
#pragma unroll
  for (int c = 0; c < NCH; ++c) *(u32x4*)(x + c * 512 + lane * 8) = pack8(v.a[c], v.b[c]); }
__device__ __forceinline__ void resid_load(RowV& v, const Params& p, int l, int R, int lane) {
  if (l == 0) row_load_nt(v, resid_row(p, l, R), lane); else row_load_bf_nt(v, WSP(bf16_t, p, x2) + (long)R * DM, lane);
}
__device__ __forceinline__ void row_stats(const RowV& v, float& mean, float& rstd) {
  float s = 0.f;
#pragma unroll
  for (int c = 0; c < NCH; ++c) s += sum8(v.a[c], v.b[c]);
  mean = wave_sum(s) * (1.f / DM); float q = 0.f;
#pragma unroll
  for (int c = 0; c < NCH; ++c) { const f32x4 da = v.a[c] - mean, db = v.b[c] - mean; q += sum8(da * da, db * db); }
  rstd = 1.f / sqrtf(wave_sum(q) * (1.f / DM) + NORM_EPS);
}
__device__ __forceinline__ void row_modulate_store(const RowV& v, float mean, float rstd, const float* sh, const float* sc, bf16_t* H, int lane) {
#pragma unroll
  for (int c = 0; c < NCH; ++c) { const int o = c * 512 + lane * 8; const f32x4 s0 = *(const f32x4*)(sc + o), s1 = *(const f32x4*)(sc + o + 4), h0 = *(const f32x4*)(sh + o), h1 = *(const f32x4*)(sh + o + 4);
    *(u32x4*)(H + o) = pack8((v.a[c] - mean) * rstd * (1.f + s0) + h0, (v.b[c] - mean) * rstd * (1.f + s1) + h1); } }

__device__ __forceinline__ void ph_ln_in(const Params& p, int l) {
  const int tid_ = ph_tid(), lane = tid_ & 63, wv = tid_ >> 6; const float* mod = WSP(float, p, mod) + (long)l * 18 * DM; bf16_t* H1 = WSP(bf16_t, p, h1);
  for (int R = blockIdx.x * 8 + wv; R < MROWS; R += gridDim.x * 8) { RowV v; resid_load(v, p, l, R, lane); float mean, rstd; row_stats(v, mean, rstd);
    const float* m = mod + (long)row_mod(R) * 6 * DM; row_modulate_store(v, mean, rstd, m, m + DM, H1 + (long)R * DM, lane); }
}
__device__ __forceinline__ void ph_ln1(const Params& p, int l, LAS unsigned char* lds) {
  const int tid_ = ph_tid(), lane = tid_ & 63, wv = tid_ >> 6; const float* mod = WSP(float, p, mod) + (long)l * 18 * DM; const int last = (l == NLAYER - 1);
  LAS float* rwt = (LAS float*)lds;
  { const float* rw = p.in[I_ROUTER] + (long)l * DM * NE; for (int i = tid_; i < DM * NE; i += 512) { const int e = i / DM, d = i % DM; rwt[i] = rw[d * NE + e]; } }
  __syncthreads();
  const bf16_t* Y = WSP(bf16_t, p, macc); bf16_t* X1 = WSP(bf16_t, p, x1); bf16_t* H2 = WSP(bf16_t, p, h2); float* AFF = WSP(float, p, aff);
  const float* lg = p.in[I_LN1G] + l * DM; const float* lb = p.in[I_LN1B] + l * DM;
  for (int R = blockIdx.x * 8 + wv; R < MROWS; R += gridDim.x * 8) { if (last && row_is_ctx(R)) continue;
    const float* m = mod + (long)row_mod(R) * 6 * DM; RowV v, y; resid_load(v, p, l, R, lane);
#pragma unroll
    for (int c = 0; c < NCH; ++c) unpack8(__builtin_nontemporal_load((const u32x4*)(Y + (long)R * DM + c * 512 + lane * 8)), y.a[c], y.b[c]);
#pragma unroll
    for (int c = 0; c < NCH; ++c) { const int o = c * 512 + lane * 8; v.a[c] = DN_ALPHA * v.a[c] + *(const f32x4*)(m + 2 * DM + o) * y.a[c]; v.b[c] = DN_ALPHA * v.b[c] + *(const f32x4*)(m + 2 * DM + o + 4) * y.b[c]; }
    float mean, rstd; row_stats(v, mean, rstd);
#pragma unroll
    for (int c = 0; c < NCH; ++c) { const int o = c * 512 + lane * 8; v.a[c] = (v.a[c] - mean) * rstd * *(const f32x4*)(lg + o) + *(const f32x4*)(lb + o); v.b[c] = (v.b[c] - mean) * rstd * *(const f32x4*)(lg + o + 4) + *(const f32x4*)(lb + o + 4); }
    row_store_bf_nt(v, X1 + (long)R * DM, lane);
    row_stats(v, mean, rstd);
#pragma unroll
    for (int c = 0; c < NCH; ++c) { const int o = c * 512 + lane * 8; v.a[c] = (v.a[c] - mean) * rstd * (1.f + *(const f32x4*)(m + 4 * DM + o)) + *(const f32x4*)(m + 3 * DM + o);
      v.b[c] = (v.b[c] - mean) * rstd * (1.f + *(const f32x4*)(m + 4 * DM + o + 4)) + *(const f32x4*)(m + 3 * DM + o + 4); *(u32x4*)(H2 + (long)R * DM + o) = pack8(v.a[c], v.b[c]); }
    float s[NE];
#pragma unroll
    for (int e = 0; e < NE; ++e) { float a = 0.f;
#pragma unroll
      for (int c = 0; c < NCH; ++c) { const LAS float* q = rwt + e * DM + c * 512 + lane * 8; const f32x4 w0 = *(const LAS f32x4*)q, w1 = *(const LAS f32x4*)(q + 4); a += sum8(v.a[c] * w0, v.b[c] * w1); }
      s[e] = a; }
    static_assert(NE == 16, "router reduce-scatter is written for 16 experts");
    { const bool b5 = lane & 32, b4 = lane & 16, b3 = lane & 8, b2 = lane & 4; float t8[8], t4[4], t2[2];
#pragma unroll
      for (int j = 0; j < 8; ++j) { const float snd = b5 ? s[j] : s[j + 8], kp = b5 ? s[j + 8] : s[j]; t8[j] = kp + __shfl_xor(snd, 32); }
#pragma unroll
      for (int j = 0; j < 4; ++j) { const float snd = b4 ? t8[j] : t8[j + 4], kp = b4 ? t8[j + 4] : t8[j]; t4[j] = kp + __shfl_xor(snd, 16); }
#pragma unroll
      for (int j = 0; j < 2; ++j) { const float snd = b3 ? t4[j] : t4[j + 2], kp = b3 ? t4[j + 2] : t4[j]; t2[j] = kp + __shfl_xor(snd, 8); }
      float lg_ = (b2 ? t2[1] : t2[0]) + __shfl_xor(b2 ? t2[0] : t2[1], 4); lg_ += __shfl_xor(lg_, 2); lg_ += __shfl_xor(lg_, 1);
      const int e = ((lane >> 2) & 1) | (((lane >> 3) & 1) << 1) | (((lane >> 4) & 1) << 2) | (((lane >> 5) & 1) << 3);
      const float mx = wave_max(lg_), ex = expf(lg_ - mx), se = wave_sum(ex) * 0.25f;
      if ((lane & 3) == 0) AFF[(long)R * NE + e] = ex / se; } }
}
__device__ __forceinline__ void ph_ln2(const Params& p, int l) {
  const int tid_ = ph_tid(), lane = tid_ & 63, wv = tid_ >> 6; const float* mod = WSP(float, p, mod) + (long)l * 18 * DM; const int last = (l == NLAYER - 1);
  const bf16_t* X1 = WSP(bf16_t, p, x1); bf16_t* X2 = WSP(bf16_t, p, x2); const int* SLOT = WSP(int, p, slot); const bf16_t* YS = (const bf16_t*)(p.ws + WS.regA + SZ_XS + SZ_ACT); bf16_t* H1 = WSP(bf16_t, p, h1);
  const float* lg = p.in[I_LN2G] + l * DM; const float* lb = p.in[I_LN2B] + l * DM;
  for (int R = blockIdx.x * 8 + wv; R < MROWS; R += gridDim.x * 8) { if (last && row_is_ctx(R)) continue;
    const float* m = mod + (long)row_mod(R) * 6 * DM; RowV v, acc; row_load_bf_nt(v, X1 + (long)R * DM, lane);
#pragma unroll
    for (int c = 0; c < NCH; ++c) { acc.a[c] = (f32x4){0.f, 0.f, 0.f, 0.f}; acc.b[c] = (f32x4){0.f, 0.f, 0.f, 0.f}; }
    const int myslot = lane < NE ? SLOT[(long)R * NE + lane] : -1;
    const float mygate = myslot >= 0 ? WSP(float, p, gatev)[myslot] : 0.f;
    for (int e = 0; e < NE; ++e) { const int s = __shfl(myslot, e); const float gq = __shfl(mygate, e); if (s >= 0) { const bf16_t* yr = YS + (long)s * DM;
#pragma unroll
        for (int c = 0; c < NCH; ++c) { f32x4 t0, t1; unpack8(__builtin_nontemporal_load((const u32x4*)(yr + c * 512 + lane * 8)), t0, t1); acc.a[c] += gq * t0; acc.b[c] += gq * t1; } } }
#pragma unroll
    for (int c = 0; c < NCH; ++c) { const int o = c * 512 + lane * 8; v.a[c] = DN_ALPHA * v.a[c] + *(const f32x4*)(m + 5 * DM + o) * acc.a[c]; v.b[c] = DN_ALPHA * v.b[c] + *(const f32x4*)(m + 5 * DM + o + 4) * acc.b[c]; }
    float mean, rstd; row_stats(v, mean, rstd);
#pragma unroll
    for (int c = 0; c < NCH; ++c) { const int o = c * 512 + lane * 8; v.a[c] = (v.a[c] - mean) * rstd * *(const f32x4*)(lg + o) + *(const f32x4*)(lb + o); v.b[c] = (v.b[c] - mean) * rstd * *(const f32x4*)(lg + o + 4) + *(const f32x4*)(lb + o + 4); }
#ifdef MK_QPROBE
    if (last) { const unsigned long long* st = (const unsigned long long*)(p.ws + WS.bar + 30720); const float fr = floorf(20.f * (float)st[41] / 32992.f) * 0.05f, sc = 1.f + sqrtf(fr * 0.1f);
      _Pragma("unroll") for (int c = 0; c < NCH; ++c) { v.a[c] = v.a[c] * sc; v.b[c] = v.b[c] * sc; } }
#endif
#ifdef MK_WAITPROBE
    if (last) { const unsigned long long* st = (const unsigned long long*)(p.ws + WS.bar + 30720); const float dus = floorf((float)st[40] * 0.01f / 50.f) * 50.f, sc = 1.f + sqrtf(dus * 1e-4f);
      _Pragma("unroll") for (int c = 0; c < NCH; ++c) { v.a[c] = v.a[c] * sc; v.b[c] = v.b[c] * sc; } }
#endif
#ifdef MK_PROBE_A
    if (last) { const unsigned long long* st = (const unsigned long long*)(p.ws + WS.bar + 30720); const float dus = floorf((float)(st[MK_PROBE_B] - st[MK_PROBE_A]) * 0.01f / MK_PROBE_Q) * MK_PROBE_Q, sc = 1.f + sqrtf(dus * 1e-5f);
      _Pragma("unroll") for (int c = 0; c < NCH; ++c) { v.a[c] = v.a[c] * sc; v.b[c] = v.b[c] * sc; } }
#endif
    if (last) { float* po = p.out + ((long)row_b(R) * SEQ + row_t(R)) * DM;
#pragma unroll
      for (int c = 0; c < NCH; ++c) { float* q = po + c * 512 + lane * 8; __builtin_nontemporal_store(v.a[c], (f32x4*)q); __builtin_nontemporal_store(v.b[c], (f32x4*)(q + 4)); } }
    else { row_store_bf_nt(v, X2 + (long)R * DM, lane); row_stats(v, mean, rstd); const float* mn = mod + 18 * DM + (long)row_mod(R) * 6 * DM; row_modulate_store(v, mean, rstd, mn, mn + DM, H1 + (long)R * DM, lane); } }
}

__device__ __forceinline__ void rope8(f32x4& a, f32x4& b, int xorl, bool first, const float* cs  ) {
#pragma unroll
  for (int j = 0; j < 4; ++j) { const float oa = __shfl_xor(a[j], xorl), ob = __shfl_xor(b[j], xorl);
    const float ca = cs[2 * j], sa = cs[2 * j + 1], cb = cs[8 + 2 * j], sb = cs[8 + 2 * j + 1];
    a[j] = a[j] * ca + (first ? -oa : oa) * sa; b[j] = b[j] * cb + (first ? -ob : ob) * sb; } }
__device__ __forceinline__ void ph_post_proj(const Params& p, int l) {
  static_assert(GHD == 128 && RQK == 64 && MROPE == 64 && MQL == 512 && MKVL == 256 && GH == 4 && GKV == 2 && RH == 4, "post_proj lane maps are written for the full-size config");
  const int tid_ = ph_tid(), lane = tid_ & 63, wv = tid_ >> 6; bf16_t* P = WSP(bf16_t, p, regA); bf16_t* KM = WSP(bf16_t, p, km); const float* ta = WSP(float, p, rope_a); const float* tb = WSP(float, p, rope_b);
  for (int R = blockIdx.x * 8 + wv; R < MROWS; R += gridDim.x * 8) { bf16_t* pr = P + (long)R * PW; const int t = row_t(R); const bool lat = t < SEQ; const int gr = lat ? t / GRIDW : 0, gc = lat ? t % GRIDW : 0;
    {
      const int g = lane >> 1, n = row_b(R) * S5NC + t / S5LC, a = t % S5LC; *(u32x4*)(WSP(bf16_t, p, uh) + ((long)g * S5NP + n) * (S5K1 + S5K2) + a * S5CH + (lane & 1) * 8) = *(const u32x4*)(pr + OFF_U + 8 * lane); }
    {
      const int j = lane & 15, hf = j >> 3; const bool first = !(j & 4); const float* cs = ta + ((hf ? gc : gr) * NROPE_A + ((8 * j) & 31)) * 2;
#pragma unroll
      for (int pass = 0; pass < 2; ++pass) { if (pass == 1 && lane >= 32) break; const int h = lane >> 4; bf16_t* x = pr + (pass ? OFF_GK : OFF_GQ) + h * GHD + 8 * j; const float* g = p.in[pass ? I_GKN : I_GQN] + l * GHD + 8 * j;
        f32x4 a, b; unpack8(*(const u32x4*)x, a, b); float ss = sum8(a * a, b * b); ss += __shfl_xor(ss, 8); ss += __shfl_xor(ss, 4); ss += __shfl_xor(ss, 2); ss += __shfl_xor(ss, 1);
        const float r = 1.f / sqrtf(ss * (1.f / GHD) + NORM_EPS); a = a * r * *(const f32x4*)g; b = b * r * *(const f32x4*)(g + 4);
        if (lat) rope8(a, b, 4, first, cs);
        *(u32x4*)x = pack8(a, b); } }
    {
      const int j = lane & 7, hf = j >> 2, h = (lane >> 3) & 3; const bool isk = lane >= 32, first = !(j & 2); bf16_t* x = pr + (isk ? OFF_RK : OFF_RQ) + h * RQK + 8 * j; const float sc = isk ? 0.125f : 1.f;
      f32x4 a, b; unpack8(*(const u32x4*)x, a, b); a = a * sc; b = b * sc;
      if (lat) rope8(a, b, 2, first, tb + ((hf ? gc : gr) * NROPE_B + ((8 * j) & 15)) * 2);
      *(u32x4*)x = pack8(a, b); }
    {
      bf16_t* x = pr + OFF_CQ + 8 * lane; const float* g = p.in[I_MQN] + l * MQL + 8 * lane; f32x4 a, b; unpack8(*(const u32x4*)x, a, b); const float ss = wave_sum(sum8(a * a, b * b));
      const float r = 1.f / sqrtf(ss * (1.f / MQL) + NORM_EPS); *(u32x4*)x = pack8(a * r * *(const f32x4*)g, b * r * *(const f32x4*)(g + 4)); }
    {
      if (lane < 32) { bf16_t* x = pr + OFF_CKV + 8 * lane; const float* g = p.in[I_MKVN] + l * MKVL + 8 * lane; f32x4 a, b; unpack8(*(const u32x4*)x, a, b); float ss = sum8(a * a, b * b);
        ss += __shfl_xor(ss, 16); ss += __shfl_xor(ss, 8); ss += __shfl_xor(ss, 4); ss += __shfl_xor(ss, 2); ss += __shfl_xor(ss, 1);
        const float r = 1.f / sqrtf(ss * (1.f / MKVL) + NORM_EPS); *(u32x4*)x = pack8(a * r * *(const f32x4*)g, b * r * *(const f32x4*)(g + 4)); }
      } }
}

struct ConvMat { bf16_t* dst; const float* src; const float* src2; int K, ld, ndst, nvalid, kind; };
constexpr int NMAT_L = 10 + 2 * NE, NMAT = NLAYER * NMAT_L;
__device__ __forceinline__ ConvMat conv_mat(const Params& p, int mi) {
  const int l = mi / NMAT_L, m = mi % NMAT_L; ConvMat c; c.src2 = nullptr; c.kind = 0;
  if (m == 0) { c.dst = WSP(bf16_t, p, wt_in) + (long)l * PW * DM; c.src = p.in[I_WIN] + (long)l * DM * IN_TOTAL; c.K = DM; c.ld = IN_TOTAL; c.ndst = PW; c.nvalid = IN_TOTAL; }
  else if (m == 1) { c.dst = WSP(bf16_t, p, wt_uq) + (long)l * MH * MQK * MQL; c.src = p.in[I_WUQ] + (long)l * MQL * MH * MQK; c.K = MQL; c.ld = MH * MQK; c.ndst = MH * MQK; c.nvalid = MH * MQK; }
  else if (m == 2) { c.dst = WSP(bf16_t, p, wt_ukv) + (long)l * MH * (MNOPE + MV) * MKVL; c.src = p.in[I_WUKV] + (long)l * MKVL * MH * (MNOPE + MV); c.K = MKVL; c.ld = MH * (MNOPE + MV); c.ndst = MH * (MNOPE + MV); c.nvalid = c.ndst; }
  else if (m == 3) { c.dst = WSP(bf16_t, p, wt_glu) + (long)l * BW * BW; c.src = p.in[I_S5GLU] + (long)l * BW * BW; c.K = BW; c.ld = BW; c.ndst = BW; c.nvalid = BW; }
  else if (m < 8) { const int k = m - 4; c.dst = WSP(bf16_t, p, wt_br) + ((long)l * 4 + k) * DM * BW; c.src = p.in[I_WBR] + ((long)l * 4 + k) * BW * DM; c.K = BW; c.ld = DM; c.ndst = DM; c.nvalid = DM; }
  else if (m == 8) { c.dst = WSP(bf16_t, p, wt_gate) + (long)l * 4 * DM * DM; c.src = p.in[I_WGATE] + (long)l * DM * 4 * DM; c.K = DM; c.ld = 4 * DM; c.ndst = 4 * DM; c.nvalid = 4 * DM; }
  else if (m == 9) { c.dst = WSP(bf16_t, p, wt_out) + (long)l * DM * DM; c.src = p.in[I_WOUT] + (long)l * DM * DM; c.K = DM; c.ld = DM; c.ndst = DM; c.nvalid = DM; }
  else if (m < 10 + NE) { const int e = m - 10; c.dst = WSP(bf16_t, p, wt_gu) + ((long)l * NE + e) * 2 * FF * DM; c.src = p.in[I_MOEG] + ((long)l * NE + e) * DM * FF; c.src2 = p.in[I_MOEU] + ((long)l * NE + e) * DM * FF;
    c.K = DM; c.ld = FF; c.ndst = 2 * FF; c.nvalid = 2 * FF; c.kind = 1; }
  else { const int e = m - 10 - NE; c.dst = WSP(bf16_t, p, wt_dn) + ((long)l * NE + e) * DM * FF; c.src = p.in[I_MOED] + ((long)l * NE + e) * FF * DM; c.K = FF; c.ld = DM; c.ndst = DM; c.nvalid = DM; }
  return c;
}
__device__ __forceinline__ void conv_tile(const ConvMat& c, int t, LAS unsigned* Lb, int tid) {
  const int n = tid & 63, kp = tid >> 6, tk = c.K / 64; const int k0 = (t % tk) * 64, n0 = (t / tk) * 128;
  const float* s; int col0, nval;
  if (c.kind == 1) { const int tile = n0 / 256; s = (n0 & 128) ? c.src2 : c.src; col0 = tile * 128; nval = 128; } else { s = c.src; col0 = n0; nval = c.nvalid - n0; }
  float v[2][4][2];
#pragma unroll
  for (int hh = 0; hh < 2; ++hh)
#pragma unroll
    for (int i = 0; i < 4; ++i) { const int k = 2 * (kp + 8 * i), cn = hh * 64 + n; const bool ok = cn < nval; const float* q = s + (long)(k0 + k) * c.ld + col0 + cn;
      v[hh][i][0] = ok ? __builtin_nontemporal_load(q) : 0.f; v[hh][i][1] = ok ? __builtin_nontemporal_load(q + c.ld) : 0.f; }
#pragma unroll
  for (int hh = 0; hh < 2; ++hh)
#pragma unroll
    for (int i = 0; i < 4; ++i) Lb[(hh * 64 + n) * 33 + kp + 8 * i] = pg8::cvt_pk_bf16(v[hh][i][0], v[hh][i][1]);
  __syncthreads();
#pragma unroll
  for (int hh = 0; hh < 2; ++hh) { const int id = hh * 512 + tid, rn = id >> 3, kc = id & 7; const LAS unsigned* q = Lb + rn * 33 + kc * 4; u32x4 w; w.x = q[0]; w.y = q[1]; w.z = q[2]; w.w = q[3];
    __builtin_nontemporal_store(w, (u32x4*)(c.dst + (long)(n0 + rn) * c.K + k0 + kc * 8)); }
}
constexpr int tiles_of(int K, int ndst) { return (K / 64) * (ndst / 128); }
constexpr int CT_DENSE_L = tiles_of(DM, PW) + tiles_of(DM, 4 * DM) + 4 * tiles_of(BW, DM) + tiles_of(DM, DM) + tiles_of(BW, BW) + tiles_of(MQL, MH * MQK) + tiles_of(MKVL, MH * (MNOPE + MV));
constexpr int CT_IN = tiles_of(DM, PW), CT_PREP = CT_IN + tiles_of(MQL, MH * MQK) + tiles_of(MKVL, MH * (MNOPE + MV)), CT_GLU = CT_PREP + tiles_of(BW, BW), CT_BR = CT_GLU + 4 * tiles_of(BW, DM),
              CT_GATE = CT_BR + tiles_of(DM, 4 * DM), CT_OUT = CT_GATE + tiles_of(DM, DM);
static_assert(CT_OUT == CT_DENSE_L, "dense tile order");
constexpr int CT_MOE_L = NE * (tiles_of(DM, 2 * FF) + tiles_of(FF, DM));
constexpr int CT_LAYER = CT_DENSE_L + CT_MOE_L, CT_TOTAL = NLAYER * CT_LAYER;
constexpr int CLAIM_DRAIN = 16, CLAIM_IDLE = 2, BG_STOP_EARLY = 0;
__device__ __forceinline__ bool conv_locate(const Params& p, int gtile, ConvMat& c, int& lt) {
  if (gtile >= CT_TOTAL) return false;
  const int l = gtile / CT_LAYER; int r = gtile % CT_LAYER, m = 0;
  if (r < CT_DENSE_L) { for (;; ++m) { c = conv_mat(p, l * NMAT_L + m); const int nt = tiles_of(c.K, c.ndst); if (r < nt) break; r -= nt; } }
  else { r -= CT_DENSE_L; constexpr int tg = tiles_of(DM, 2 * FF), td = tiles_of(FF, DM);
    if (r < NE * tg) { m = 10 + r / tg; r %= tg; } else { r -= NE * tg; m = 10 + NE + r / td; r %= td; }
    c = conv_mat(p, l * NMAT_L + m); }
  lt = r; return true;
}
template <int CLAIM> __device__ __forceinline__ bool conv_work(const Params& p, LAS unsigned char* lds, unsigned* counter, int target, unsigned* arr) {
  const int tid = ph_tid(); LAS unsigned* L = (LAS unsigned*)lds; LAS unsigned* nxt = L + 2 * 128 * 33; int buf = 0; bool alive = true;
  for (;;) {
    if (tid == 0) { unsigned v = 0xFFFFFFFFu;
      const bool go = target > 0 ? (int)__hip_atomic_load(counter, __ATOMIC_RELAXED, __HIP_MEMORY_SCOPE_AGENT) < target
                                 : __hip_atomic_load(arr, __ATOMIC_RELAXED, __HIP_MEMORY_SCOPE_AGENT) + BG_STOP_EARLY < gridDim.x;
      if (go) v = __hip_atomic_fetch_add(counter, (unsigned)CLAIM, __ATOMIC_RELAXED, __HIP_MEMORY_SCOPE_AGENT);
      *nxt = v; }
    __syncthreads(); const unsigned claim = *nxt; __syncthreads();
    if (claim == 0xFFFFFFFFu) break;
    if ((int)claim >= CT_TOTAL) { alive = false; break; }
    for (int q = 0; q < CLAIM; ++q) { ConvMat c; int lt; if (conv_locate(p, (int)claim + q, c, lt)) { conv_tile(c, lt, L + buf * (128 * 33), tid); buf ^= 1; } }
    __syncthreads(); }
  return alive;
}
__device__ __forceinline__ void ph_mod(const Params& p, LAS unsigned char* lds, int wg) {
  const int tid = ph_tid(); LAS float* sl = (LAS float*)lds; LAS float* part = sl + 3 * DM;
  for (int i = tid; i < 3 * DM; i += 512) { const int r = i / DM, k = i % DM; const float cv = r < 2 ? p.in[I_C][r * DM + k] : p.in[I_CCTX][k]; sl[i] = cv / (1.f + expf(-cv)); }
  __syncthreads();
  const int cg = tid & 31, ks = tid >> 5;
  constexpr int KS = DM / 16, NIT = NLAYER * (6 * DM / 128);
  if (wg >= NIT) return;
  for (int it = wg; it < NIT; it += gridDim.x) { const int l = it / (6 * DM / 128), cb = it % (6 * DM / 128); const float* w = p.in[I_ADAW] + (long)l * DM * 6 * DM + cb * 128 + cg * 4;
    f32x4 a0 = {0.f, 0.f, 0.f, 0.f}, a1 = a0, a2 = a0;
#pragma unroll 8
    for (int k = ks * KS; k < (ks + 1) * KS; ++k) { const f32x4 wv = __builtin_nontemporal_load((const f32x4*)(w + (long)k * 6 * DM)); a0 += sl[k] * wv; a1 += sl[DM + k] * wv; a2 += sl[2 * DM + k] * wv; }
    LAS float* pp = part + (ks * 3) * 128 + cg * 4; *(LAS f32x4*)pp = a0; *(LAS f32x4*)(pp + 128) = a1; *(LAS f32x4*)(pp + 256) = a2;
    __syncthreads();
    if (tid < 384) { const int r = tid / 128, col = tid % 128; float s = 0.f;
#pragma unroll
      for (int q = 0; q < 16; ++q) s += part[(q * 3 + r) * 128 + col];
      WSP(float, p, mod)[((long)l * 3 + r) * 6 * DM + cb * 128 + col] = s + p.in[I_ADAB][(long)l * 6 * DM + cb * 128 + col]; }
    __syncthreads(); }
}
__device__ __forceinline__ void ph_tables(const Params& p) {
  const long gt = (long)blockIdx.x * 512 + ph_tid(), gs = (long)gridDim.x * 512;
  float* ta = WSP(float, p, rope_a); float* tb = WSP(float, p, rope_b);
  for (long i = gt; i < (long)GRIDW * (NROPE_A + NROPE_B); i += gs) { const int pos = (int)(i / (NROPE_A + NROPE_B)), k = (int)(i % (NROPE_A + NROPE_B));
    if (k < NROPE_A) { const float a = pos * powf(10000.f, -(float)k / NROPE_A); ta[(pos * NROPE_A + k) * 2] = cosf(a); ta[(pos * NROPE_A + k) * 2 + 1] = sinf(a); }
    else { const int kk = k - NROPE_A; const float a = pos * powf(10000.f, -(float)kk / NROPE_B); tb[(pos * NROPE_B + kk) * 2] = cosf(a); tb[(pos * NROPE_B + kk) * 2 + 1] = sinf(a); } }
  for (long i = gt; i < DM / 2; i += gs) WSP(unsigned, p, zrow)[i] = 0u;
  float* tab = WSP(float, p, s5tab);
  for (long i = gt; i < (long)NLAYER * 2 * S5G * S5P; i += gs) { const int pp = (int)(i % S5P), g = (int)((i / S5P) % S5G), dir = (int)((i / (S5P * S5G)) % 2), l = (int)(i / (2 * S5P * S5G));
    const float a_re = p.in[dir ? I_S5AREB : I_S5AREF][(l * S5G + g) * S5P + pp], a_im = p.in[dir ? I_S5AIMB : I_S5AIMF][(l * S5G + g) * S5P + pp];
    const float dt = expf(p.in[dir ? I_S5DTB : I_S5DTF][l * S5G + g]);
    const float mag = expf(a_re * dt), ab_re = mag * cosf(a_im * dt), ab_im = mag * sinf(a_im * dt);
    const float den = a_re * a_re + a_im * a_im, nr = ab_re - 1.f, ni = ab_im;
    const float cr = (nr * a_re + ni * a_im) / den, ci = (ni * a_re - nr * a_im) / den;
    float* t = tab + i * S5TW; t[0] = ab_re; t[1] = ab_im;
    for (int c = 0; c < S5CH; ++c) { const float br = p.in[I_S5BRE][((l * S5G + g) * S5P + pp) * S5CH + c], bi = p.in[I_S5BIM][((l * S5G + g) * S5P + pp) * S5CH + c];
      t[2 + c] = cr * br - ci * bi; t[2 + S5CH + c] = cr * bi + ci * br; } }
}

__device__ __forceinline__ void ph_s5tables(const Params& p, LAS unsigned char* lds) {
  const int tid = ph_tid(); LAS float* pw = (LAS float*)lds; LAS float* bb = pw + 2 * S5P * (S5LC + 1) * 2; LAS float* cc = bb + 2 * S5P * S5CH * 2; LAS float* T = cc + S5CH * S5P * 2; LAS float* T0b = T + (2 * S5LC - 1) * S5CH * S5CH;
  for (int item = blockIdx.x; item < NLAYER * S5G; item += gridDim.x) { const int l = item / S5G, g = item % S5G;
    for (int i = tid; i < 2 * S5P; i += 512) { const int dir = i / S5P, pp = i % S5P;
      const double a_re = p.in[dir ? I_S5AREB : I_S5AREF][(l * S5G + g) * S5P + pp], a_im = p.in[dir ? I_S5AIMB : I_S5AIMF][(l * S5G + g) * S5P + pp], dt = exp((double)p.in[dir ? I_S5DTB : I_S5DTF][l * S5G + g]);
      const double mag = exp(a_re * dt), abr = mag * cos(a_im * dt), abi = mag * sin(a_im * dt); double pr = 1.0, pi_ = 0.0;
      for (int k = 0; k <= S5LC; ++k) { pw[((dir * S5P + pp) * (S5LC + 1) + k) * 2] = (float)pr; pw[((dir * S5P + pp) * (S5LC + 1) + k) * 2 + 1] = (float)pi_; const double nr = pr * abr - pi_ * abi, ni = pr * abi + pi_ * abr; pr = nr; pi_ = ni; }
      const double den = a_re * a_re + a_im * a_im, nr = abr - 1.0, ni = abi, cr = (nr * a_re + ni * a_im) / den, ci = (ni * a_re - nr * a_im) / den;
      for (int c = 0; c < S5CH; ++c) { const double br = p.in[I_S5BRE][((l * S5G + g) * S5P + pp) * S5CH + c], bi = p.in[I_S5BIM][((l * S5G + g) * S5P + pp) * S5CH + c];
        bb[((dir * S5P + pp) * S5CH + c) * 2] = (float)(cr * br - ci * bi); bb[((dir * S5P + pp) * S5CH + c) * 2 + 1] = (float)(cr * bi + ci * br); } }
    for (int i = tid; i < S5CH * S5P; i += 512) { cc[2 * i] = p.in[I_S5CRE][(long)(l * S5G + g) * S5CH * S5P + i]; cc[2 * i + 1] = p.in[I_S5CIM][(long)(l * S5G + g) * S5CH * S5P + i]; }
    __syncthreads();
    {
      static_assert(2 * S5CH * S5CH == 512 && S5LC == 16, "one thread per (direction, out channel, in channel)");
      const int dir = tid >> 8, i = (tid >> 4) & 15, c = tid & 15; float acc[S5LC];
#pragma unroll
      for (int k = 0; k < S5LC; ++k) acc[k] = 0.f;
      for (int pp = 0; pp < S5P; ++pp) { const float cr_ = cc[(i * S5P + pp) * 2], ci_ = cc[(i * S5P + pp) * 2 + 1], br = bb[((dir * S5P + pp) * S5CH + c) * 2], bi = bb[((dir * S5P + pp) * S5CH + c) * 2 + 1];
        const float wr_ = cr_ * br - ci_ * bi, wi_ = cr_ * bi + ci_ * br; const LAS float* pq = pw + (dir * S5P + pp) * (S5LC + 1) * 2;
#pragma unroll
        for (int k = 0; k < S5LC; ++k) acc[k] += wr_ * pq[2 * k] - wi_ * pq[2 * k + 1]; }
#pragma unroll
      for (int k = 1; k < S5LC; ++k) T[((dir ? -k : k) + (S5LC - 1)) * S5CH * S5CH + i * S5CH + c] = acc[k];
      if (dir == 0) T[(S5LC - 1) * S5CH * S5CH + i * S5CH + c] = acc[0]; else T0b[i * S5CH + c] = acc[0]; }
    __syncthreads();
    if (tid < S5CH * S5CH) T[(S5LC - 1) * S5CH * S5CH + tid] += T0b[tid];
    __syncthreads();
    bf16_t* SW = WSP(bf16_t, p, s5sw) + (long)item * S5K2 * S5K1; bf16_t* SV = WSP(bf16_t, p, s5sv) + (long)item * S5K1 * (S5K1 + S5K2);
    for (int e = tid; e < S5K2 * S5K1; e += 512) { const int r = e / S5K1, col = e % S5K1, dir = r / (2 * S5P), pp = (r % (2 * S5P)) / 2, im = r & 1, a = col / S5CH, c = col % S5CH; const int k = dir ? a : (S5LC - 1 - a);
      const float ar = pw[((dir * S5P + pp) * (S5LC + 1) + k) * 2], ai = pw[((dir * S5P + pp) * (S5LC + 1) + k) * 2 + 1], br = bb[((dir * S5P + pp) * S5CH + c) * 2], bi = bb[((dir * S5P + pp) * S5CH + c) * 2 + 1];
      SW[e] = f2bf(im ? ar * bi + ai * br : ar * br - ai * bi); }
    for (int e = tid; e < S5K1 * (S5K1 + S5K2); e += 512) { const int r = e / (S5K1 + S5K2), k = e % (S5K1 + S5K2), a = r / S5CH, i = r % S5CH; float v;
      if (k < S5K1) { const int a2 = k / S5CH, c = k % S5CH; v = T[((a - a2) + (S5LC - 1)) * S5CH * S5CH + i * S5CH + c]; }
      else { const int kk = k - S5K1, dir = kk / (2 * S5P), pp = (kk % (2 * S5P)) / 2, im = kk & 1, pk = dir ? (S5LC - a) : (a + 1);
        const float cr_ = cc[(i * S5P + pp) * 2], ci_ = cc[(i * S5P + pp) * 2 + 1], ar = pw[((dir * S5P + pp) * (S5LC + 1) + pk) * 2], ai = pw[((dir * S5P + pp) * (S5LC + 1) + pk) * 2 + 1];
        v = im ? -(cr_ * ai + ci_ * ar) : (cr_ * ar - ci_ * ai); }
      SV[e] = f2bf(v); }
    __syncthreads(); }
}
__device__ __forceinline__ void ph_s5scan(const Params& p, int l) {
  const float* tab = WSP(float, p, s5tab); const float* E = WSP(float, p, s5e); bf16_t* UH = WSP(bf16_t, p, uh);
  for (long i = (long)blockIdx.x * 512 + ph_tid(); i < (long)NB * S5G * 2 * S5P; i += (long)gridDim.x * 512) { const int pp = (int)(i % S5P), dir = (int)((i / S5P) % 2), g = (int)((i / (2 * S5P)) % S5G), b = (int)(i / (2 * S5P * S5G));
    const float* t = tab + ((((long)l * 2 + dir) * S5G + g) * S5P + pp) * S5TW; float ar = t[0], ai = t[1];
#pragma unroll
    for (int q = 0; q < 4; ++q) { const float nr = ar * ar - ai * ai, ni = 2.f * ar * ai; ar = nr; ai = ni; }
    float hr = 0.f, hi = 0.f; constexpr int NCX = CTXL / S5LC, NLT = SEQ / S5LC;
    for (int s0 = 0; s0 < S5NC; s0 += 8) { float er[8], ei[8]; long idx[8];
#pragma unroll
      for (int q = 0; q < 8; ++q) { const int s = s0 + q; const int j = dir == 0 ? (s < NCX ? NLT + s : s - NCX) : (s < NCX ? S5NC - 1 - s : NLT - 1 - (s - NCX)); idx[q] = (long)g * S5NP + b * S5NC + j;
        const float2 ev = *(const float2*)(E + idx[q] * S5K2 + dir * 2 * S5P + pp * 2); er[q] = ev.x; ei[q] = ev.y; }
#pragma unroll
      for (int q = 0; q < 8; ++q) { *(unsigned*)(UH + idx[q] * (S5K1 + S5K2) + S5K1 + dir * 2 * S5P + pp * 2) = pg8::cvt_pk_bf16(hr, hi);
        const float nr = ar * hr - ai * hi + er[q], ni = ar * hi + ai * hr + ei[q]; hr = nr; hi = ni; } } }
}

__device__ __forceinline__ void ph_merge_ctx(const Params& p) {
  const bf16_t* GC = WSP(bf16_t, p, gctx); const bf16_t* PROJ = (const bf16_t*)(p.ws + WS.regA + SZ_P); bf16_t* MG = WSP(bf16_t, p, merged);
  for (long i = (long)blockIdx.x * 512 + ph_tid(); i < (long)NB * CTXL * DM / 8; i += (long)gridDim.x * 512) { const int r = (int)(i / (DM / 8)), d = (int)(i % (DM / 8)) * 8; const long R = (long)(r / CTXL) * NTOK + SEQ + r % CTXL;
    f32x4 s0 = {0.f, 0.f, 0.f, 0.f}, s1 = s0;
#pragma unroll
    for (int k = 0; k < 4; ++k) { f32x4 g0, g1, q0, q1; unpack8(*(const u32x4*)(GC + (long)r * 4 * DM + k * DM + d), g0, g1); unpack8(*(const u32x4*)(PROJ + R * 4 * DM + k * DM + d), q0, q1); s0 += g0 * q0; s1 += g1 * q1; }
    *(u32x4*)(MG + R * DM + d) = pack8(s0, s1); }
}

__device__ __forceinline__ void ph_kr_combine(const Params& p) {
  const float* KRP = WSP(float, p, krp); bf16_t* KM = WSP(bf16_t, p, km); const float* tb = WSP(float, p, rope_b);
  for (long i = (long)blockIdx.x * 512 + ph_tid(); i < (long)MROWS * (MROPE / 8); i += (long)gridDim.x * 512) { const int R = (int)(i / (MROPE / 8)), c = (int)(i % (MROPE / 8)), t = row_t(R);
    const float* q0 = KRP + (long)R * MROPE; const float* q1 = q0 + (long)MROWS * MROPE;
    f32x4 a = *(const f32x4*)(q0 + 8 * c) + *(const f32x4*)(q1 + 8 * c), b = *(const f32x4*)(q0 + 8 * c + 4) + *(const f32x4*)(q1 + 8 * c + 4);
    if (t < SEQ) { const int cp = c ^ 2; const f32x4 oa = *(const f32x4*)(q0 + 8 * cp) + *(const f32x4*)(q1 + 8 * cp), ob = *(const f32x4*)(q0 + 8 * cp + 4) + *(const f32x4*)(q1 + 8 * cp + 4);
      const bool first = !(c & 2); const int hf = c >> 2; const float* cs = tb + ((hf ? t % GRIDW : t / GRIDW) * NROPE_B + ((8 * c) & 15)) * 2;
#pragma unroll
      for (int j = 0; j < 4; ++j) { a[j] = a[j] * cs[2 * j] + (first ? -oa[j] : oa[j]) * cs[2 * j + 1]; b[j] = b[j] * cs[8 + 2 * j] + (first ? -ob[j] : ob[j]) * cs[8 + 2 * j + 1]; } }
    const u32x4 w = pack8(a, b);
#pragma unroll
    for (int h = 0; h < MH; ++h) *(u32x4*)(KM + (long)R * MH * MQK + h * MQK + MNOPE + 8 * c) = w; }
}
__device__ __forceinline__ void ph_topk(const Params& p, int l, LAS unsigned char* lds) {
  const int tid = ph_tid(), lane = tid & 63, wv = tid >> 6; LAS unsigned* hist = (LAS unsigned*)lds; LAS unsigned* sh = hist + 256;
  const float* AFF = WSP(float, p, aff); int* SLOT = WSP(int, p, slot); float* GV = WSP(float, p, gatev); int* XSRC = WSP(int, p, xsrc);
  const int nprob = (l == 0 ? 4 : 2) * NE; constexpr int KPT = SEQ / 512;
  for (int pr = blockIdx.x; pr < nprob; pr += gridDim.x) { const int set = pr / NE, e = pr % NE, b = set & 1; const bool lat = set < 2; const int n = lat ? SEQ : CTXL, cap = lat ? CAP_L : CAP_C, R0 = b * NTOK + (lat ? 0 : SEQ);
    unsigned key[KPT];
#pragma unroll
    for (int k = 0; k < KPT; ++k) { const int i = tid + 512 * k; key[k] = i < n ? __float_as_uint(AFF[(long)(R0 + i) * NE + e]) : 0u; }
    unsigned prefix = 0u, mask = 0u, remaining = (unsigned)cap;
    for (int pass = 0; pass < 4; ++pass) { const int shift = 24 - 8 * pass;
      if (tid < 256) hist[tid] = 0u; __syncthreads();
#pragma unroll
      for (int k = 0; k < KPT; ++k) { const int i = tid + 512 * k; if (i < n && (key[k] & mask) == prefix) atomicAdd((unsigned*)&hist[(key[k] >> shift) & 255u], 1u); }
      __syncthreads();
      if (wv == 0) {
        unsigned h0 = hist[255 - 4 * lane], h1 = hist[254 - 4 * lane], h2 = hist[253 - 4 * lane], h3 = hist[252 - 4 * lane]; const unsigned tot = h0 + h1 + h2 + h3; unsigned inc = tot;
#pragma unroll
        for (int o = 1; o < 64; o <<= 1) { const unsigned t = __shfl_up(inc, o); if (lane >= o) inc += t; }
        const unsigned exc = inc - tot; const bool hit = exc < remaining && inc >= remaining; const unsigned long long bm = __ballot(hit);
        if (bm == 0ull) { if (lane == 0) { sh[0] = 0u; sh[1] = remaining; } }
        else if (lane == (int)__builtin_ctzll(bm)) { unsigned cum = exc; int d = 255 - 4 * lane;
          if (cum + h0 < remaining) { cum += h0; --d; if (cum + h1 < remaining) { cum += h1; --d; if (cum + h2 < remaining) { cum += h2; --d; } } }
          sh[0] = (unsigned)d; sh[1] = remaining - cum; } }
      __syncthreads();
      prefix |= sh[0] << shift; mask |= 0xFFu << shift; remaining = sh[1]; __syncthreads(); }
    const unsigned T = prefix, need_eq = remaining;
    unsigned base_gt = 0u, base_eq = 0u; int slotv[KPT];
#pragma unroll
    for (int k = 0; k < KPT; ++k) { const int i = tid + 512 * k; const bool gt = i < n && key[k] > T, eq = i < n && key[k] == T;
      const unsigned long long bg = __ballot(gt), be = __ballot(eq), lt = (1ull << lane) - 1ull;
      if (lane == 0) { sh[8 + wv] = (unsigned)__popcll(bg); sh[16 + wv] = (unsigned)__popcll(be); } __syncthreads();
      unsigned pg = 0u, pe = 0u, tg = 0u, te = 0u;
#pragma unroll
      for (int w = 0; w < 8; ++w) { const unsigned a = sh[8 + w], c = sh[16 + w]; pg += w < wv ? a : 0u; pe += w < wv ? c : 0u; tg += a; te += c; }
      const unsigned rg = base_gt + pg + (unsigned)__popcll(bg & lt), re = base_eq + pe + (unsigned)__popcll(be & lt);
      slotv[k] = gt ? (int)rg : (eq && re < need_eq ? -2 - (int)re : -1);
      base_gt += tg; base_eq += te; __syncthreads(); }
    const int xbase = e * XEP + (lat ? b * CAP_L : 2 * CAP_L + b * CAP_C);
#pragma unroll
    for (int k = 0; k < KPT; ++k) { const int i = tid + 512 * k; if (i < n) { int s = slotv[k]; if (s <= -2) s = (int)base_gt + (-2 - s);
        const long R = R0 + i; if (s >= 0) { const int xr = xbase + s; SLOT[R * NE + e] = xr; GV[xr] = __uint_as_float(key[k]); XSRC[xr] = (int)R; } else SLOT[R * NE + e] = -1; } }
    if (set == 3) for (int i = tid; i < XEP - XE; i += 512) XSRC[e * XEP + XE + i] = -1;
    __syncthreads(); }
}
__device__ __forceinline__ void ph_gather(const Params& p, int l) {
  const int tid_ = ph_tid(), lane = tid_ & 63, wv = tid_ >> 6; const int* XSRC = WSP(int, p, xsrc); const bf16_t* H2 = WSP(bf16_t, p, h2); bf16_t* XS = WSP(bf16_t, p, regA);
  const int rows_e = (l == 0) ? XEP : 2 * CAP_L, total = NE * rows_e;
  for (int it = blockIdx.x * 8 + wv; it < total; it += gridDim.x * 8) { const int e = it / rows_e, xr = e * XEP + it % rows_e; const int src = XSRC[xr];
#pragma unroll
    for (int c = 0; c < NCH; ++c) { const int o = c * 512 + lane * 8; u32x4 w = {0u, 0u, 0u, 0u}; if (src >= 0) w = *(const u32x4*)(H2 + (long)src * DM + o); *(u32x4*)(XS + (long)xr * DM + o) = w; } }
}
}
#endif
#ifndef CPU_TEST
namespace att {
#ifndef ATT_SD_MLA
#define ATT_SD_MLA 1
#endif
#ifndef ATT_SD_GQA
#define ATT_SD_GQA 2
#endif
using bf16x8 = __attribute__((ext_vector_type(8))) short;
using s16x4  = __attribute__((ext_vector_type(4))) short;
using f32x16 = __attribute__((ext_vector_type(16))) float;
using u32x4  = __attribute__((ext_vector_type(4))) unsigned;
constexpr int DV = 128, NW = 8, QBLK = 32, KVBLK = 64;
constexpr float THR = 8.f;
#define ATT_SBAR() __builtin_amdgcn_sched_barrier(0)
__device__ __forceinline__ int crow(int r, int hi) { return (r & 3) + 8 * (r >> 2) + 4 * hi; }
__device__ __forceinline__ unsigned cvtpk(float lo, float hi) { unsigned r; asm volatile("v_cvt_pk_bf16_f32 %0, %1, %2" : "=v"(r) : "v"(lo), "v"(hi)); return r; }
template <int DQK> constexpr size_t shm_k() { return (size_t)KVBLK * DQK * 2; }
constexpr size_t SHM_V = KVBLK * DV * 2;
constexpr int QL_PITCH = 144;
template <int DQK> constexpr size_t shm_attn() { return 2 * SHM_V + 2 * shm_k<DQK>() + NW * 64 * 4 + (DQK > 128 ? 256 * QL_PITCH : 0); }

__device__ __forceinline__ void partialSM(f32x16& p0, f32x16& p1, float& m_reg, float& mn, float& alpha, const float C, const float thr_raw) {
  float pmax = p0[0];
#pragma unroll
  for (int r = 1; r < 16; ++r) pmax = fmaxf(pmax, p0[r]);
#pragma unroll
  for (int r = 0; r < 16; ++r) pmax = fmaxf(pmax, p1[r]);
  { auto rr = __builtin_amdgcn_permlane32_swap(__float_as_uint(pmax), __float_as_uint(pmax), false, false);
    pmax = fmaxf(__uint_as_float(rr[0]), __uint_as_float(rr[1])); }
  if (__builtin_expect(__all(pmax - m_reg <= thr_raw), 1)) { mn = m_reg; alpha = 1.f; }
  else { mn = fmaxf(m_reg, pmax); alpha = __builtin_amdgcn_exp2f((m_reg - mn) * C); m_reg = mn; }
  const float mnC = -mn * C;
#pragma unroll
  for (int r = 0; r < 16; ++r) p0[r] = fmaf(p0[r], C, mnC);
#pragma unroll
  for (int r = 0; r < 16; ++r) p1[r] = fmaf(p1[r], C, mnC);
#pragma unroll
  for (int r = 0; r < 16; ++r) p0[r] = __builtin_amdgcn_exp2f(p0[r]);
}
__device__ __forceinline__ void finishSM(f32x16& p0, f32x16& p1, float alpha, float& l_reg, bf16x8& pa0, bf16x8& pa1, bf16x8& pa2, bf16x8& pa3) {
#pragma unroll
  for (int r = 0; r < 16; ++r) p1[r] = __builtin_amdgcn_exp2f(p1[r]);
  float ps = 0;
#pragma unroll
  for (int r = 0; r < 16; ++r) ps += p0[r];
#pragma unroll
  for (int r = 0; r < 16; ++r) ps += p1[r];
  { auto rr = __builtin_amdgcn_permlane32_swap(__float_as_uint(ps), __float_as_uint(ps), false, false);
    ps = __uint_as_float(rr[0]) + __uint_as_float(rr[1]); }
  l_reg = l_reg * alpha + ps;
#define ATT_PK4(P, BASE, OUT) do { unsigned a0 = cvtpk(P[BASE + 0], P[BASE + 1]), a1 = cvtpk(P[BASE + 2], P[BASE + 3]);   \
    unsigned b0 = cvtpk(P[BASE + 4], P[BASE + 5]), b1 = cvtpk(P[BASE + 6], P[BASE + 7]);                              \
    auto r0 = __builtin_amdgcn_permlane32_swap(a0, b0, false, false); auto r1 = __builtin_amdgcn_permlane32_swap(a1, b1, false, false); \
    u32x4 w = {r0[0], r1[0], r0[1], r1[1]}; OUT = *reinterpret_cast<bf16x8*>(&w); } while (0)
  ATT_PK4(p0, 0, pa0); ATT_PK4(p0, 8, pa1); ATT_PK4(p1, 0, pa2); ATT_PK4(p1, 8, pa3);
#undef ATT_PK4
}
__device__ __forceinline__ bf16x8 bl(__amdgpu_buffer_rsrc_t r, int voff, int soff) { const u32x4 w = __builtin_amdgcn_raw_buffer_load_b128(r, voff, soff, 0); return *reinterpret_cast<const bf16x8*>(&w); }
template <int DQK> __device__ __forceinline__ int kswz(int row, int colB) { return row * (DQK * 2) + (colB ^ ((row & 7) << 4)); }
template <int DQK, int QL> __device__ __forceinline__ void qkt(f32x16& p0, f32x16& p1, const char* Ks, const bf16x8* qr, const char* qlds, const int (&ka)[4]) {
  p0 = f32x16{}; p1 = f32x16{};
#pragma unroll
  for (int d0 = 0; d0 < DQK / 16; ++d0) { const char* kp = Ks + ka[d0 & 3] + (d0 >> 2) * 128;
    bf16x8 b0 = *reinterpret_cast<const bf16x8*>(kp);
    bf16x8 b1 = *reinterpret_cast<const bf16x8*>(kp + 32 * DQK * 2);
    const bf16x8 q = (d0 < DQK / 16 - QL) ? qr[d0] : *reinterpret_cast<const bf16x8*>(qlds + (d0 - (DQK / 16 - QL)) * 32);
    p0 = __builtin_amdgcn_mfma_f32_32x32x16_bf16(b0, q, p0, 0, 0, 0);
    p1 = __builtin_amdgcn_mfma_f32_32x32x16_bf16(b1, q, p1, 0, 0, 0); }
}
__device__ __forceinline__ int v_st(int k, int c) { const int kk = (k & ~0xC) | ((k & 4) << 1) | ((k & 8) >> 1); return ((kk >> 3) * 4 + (c >> 5)) * 512 + ((kk & 7) * 32 + (c & 31)) * 2; }
__device__ __forceinline__ int v_rd_base(int lane) { return ((lane & 3) << 3) | (((lane >> 2) & 3) << 6) | (((lane >> 4) & 1) << 5) | (((lane >> 5) & 1) << 8); }
constexpr int v_rd_off(int d0, int ks, int half) { return d0 * 512 + ks * 4096 + half * 2048; }
template <int OFF> __device__ __forceinline__ s16x4 tr_read(int vb) {
  s16x4 r; asm volatile("ds_read_b64_tr_b16 %0, %1 offset:%2" : "=&v"(r) : "v"(vb), "i"(OFF) : "memory"); return r;
}
template <int D0> __device__ __forceinline__ void pv_one(f32x16& od, int vb, bf16x8 pa0, bf16x8 pa1, bf16x8 pa2, bf16x8 pa3) {
  const s16x4 l0 = tr_read<v_rd_off(D0, 0, 0)>(vb), h0 = tr_read<v_rd_off(D0, 0, 1)>(vb), l1 = tr_read<v_rd_off(D0, 1, 0)>(vb), h1 = tr_read<v_rd_off(D0, 1, 1)>(vb);
  const s16x4 l2 = tr_read<v_rd_off(D0, 2, 0)>(vb), h2 = tr_read<v_rd_off(D0, 2, 1)>(vb), l3 = tr_read<v_rd_off(D0, 3, 0)>(vb), h3 = tr_read<v_rd_off(D0, 3, 1)>(vb);
  asm volatile("s_waitcnt lgkmcnt(0)" ::: "memory"); ATT_SBAR();
#define ATT_PK(L, H) (bf16x8){L[0], L[1], L[2], L[3], H[0], H[1], H[2], H[3]}
  od = __builtin_amdgcn_mfma_f32_32x32x16_bf16(pa0, ATT_PK(l0, h0), od, 0, 0, 0);
  od = __builtin_amdgcn_mfma_f32_32x32x16_bf16(pa1, ATT_PK(l1, h1), od, 0, 0, 0);
  od = __builtin_amdgcn_mfma_f32_32x32x16_bf16(pa2, ATT_PK(l2, h2), od, 0, 0, 0);
  od = __builtin_amdgcn_mfma_f32_32x32x16_bf16(pa3, ATT_PK(l3, h3), od, 0, 0, 0);
#undef ATT_PK
}
__device__ __forceinline__ void pv_d0(f32x16* o, int vb, bf16x8 pa0, bf16x8 pa1, bf16x8 pa2, bf16x8 pa3) {
  pv_one<0>(o[0], vb, pa0, pa1, pa2, pa3); pv_one<1>(o[1], vb, pa0, pa1, pa2, pa3); pv_one<2>(o[2], vb, pa0, pa1, pa2, pa3); pv_one<3>(o[3], vb, pa0, pa1, pa2, pa3);
}
template <int DQK, int LDQ, int LDK, int LDV, int LDO, int SDEPTH, int QL>
__device__ __forceinline__ void attn_body(const bf16_t* __restrict__ Qb, const bf16_t* __restrict__ Kh, const bf16_t* __restrict__ Vh, bf16_t* __restrict__ Ob, int seq, char* lds, const float scale) {
  constexpr int NKC = DQK / 64;
  constexpr size_t SHM_K = shm_k<DQK>();
  const float C = scale * 1.4426950408889634f, thr_raw = THR / scale;
  const int tid = ph_tid(), wid = tid >> 6, lane = tid & 63, r32 = lane & 31, hi = lane >> 5;
  char* V_lds = lds; char* K_lds = lds + 2 * SHM_V;
  float* wsf = (float*)(lds + 2 * SHM_V + 2 * SHM_K) + wid * 64; float* li_l = wsf; float* al_l = wsf + 32;
  float m_reg = -1e30f, l_reg = 0; f32x16 o[4] = {}; bf16x8 qr[DQK / 16 - QL];
  const bf16_t* Qw = Qb + (long)(wid * QBLK + r32) * LDQ + hi * 8;
#pragma unroll
  for (int d0 = 0; d0 < DQK / 16 - QL; ++d0) qr[d0] = *reinterpret_cast<const bf16x8*>(Qw + d0 * 16);
  char* qlds = lds + 2 * SHM_V + 2 * SHM_K + NW * 64 * 4 + (wid * QBLK + r32) * QL_PITCH + hi * 16;
#pragma unroll
  for (int d0 = 0; d0 < QL; ++d0) *reinterpret_cast<bf16x8*>(qlds + d0 * 32) = *reinterpret_cast<const bf16x8*>(Qw + (DQK / 16 - QL + d0) * 16);
  const int sr = tid >> 4, sc = (tid & 15) * 8, vst0 = v_st(sr, sc), vst1 = v_st(32 + sr, sc);
  int kgo[NKC], klo[NKC];
#pragma unroll
  for (int i = 0; i < NKC; ++i) { const int c = tid + 512 * i, kr = c / (DQK / 8), kc = (c % (DQK / 8)) * 8; kgo[i] = kr * LDK + kc; klo[i] = kswz<DQK>(kr, kc * 2); }
  const int vgo = sr * LDV + sc;
  int ka[4];
#pragma unroll
  for (int q = 0; q < 4; ++q) ka[q] = r32 * (DQK * 2) + ((q * 32 + hi * 16) ^ ((r32 & 7) << 4));
  const __amdgpu_buffer_rsrc_t rK = __builtin_amdgcn_make_buffer_rsrc((void*)Kh, 0, 0x7ffffffc, 0x00020000), rV = __builtin_amdgcn_make_buffer_rsrc((void*)Vh, 0, 0x7ffffffc, 0x00020000);
  const int vb0 = (int)(uintptr_t)V_lds + v_rd_base(lane);
  struct { bf16x8 vs0, vs1, ks[NKC]; } sr_[SDEPTH];
#define ATT_SLOAD(i, k0) do { const int _vo = (k0) * (LDV * 2), _ko = (k0) * (LDK * 2); sr_[i].vs0 = bl(rV, vgo * 2, _vo); sr_[i].vs1 = bl(rV, vgo * 2 + 64 * LDV, _vo); \
    _Pragma("unroll") for (int _c = 0; _c < NKC; ++_c) sr_[i].ks[_c] = bl(rK, kgo[_c] * 2, _ko); } while (0)
#define ATT_SWRITE(b, i) do { *(bf16x8*)(V_lds + (b) * SHM_V + vst0) = sr_[i].vs0; *(bf16x8*)(V_lds + (b) * SHM_V + vst1) = sr_[i].vs1; \
    _Pragma("unroll") for (int _c = 0; _c < NKC; ++_c) *(bf16x8*)(K_lds + (b) * SHM_K + klo[_c]) = sr_[i].ks[_c]; } while (0)
#define ATT_SWAIT() asm volatile("s_waitcnt vmcnt(%0)" :: "n"(SDEPTH == 2 ? 2 + NKC : 0) : "memory")
#define ATT_RESC(a) do { if (__any((a) < 1.f)) { if (hi == 0) al_l[r32] = (a); asm volatile("s_waitcnt lgkmcnt(0)" ::: "memory"); \
    _Pragma("unroll") for (int d = 0; d < 4; ++d) _Pragma("unroll") for (int r = 0; r < 16; ++r) o[d][r] *= al_l[crow(r, hi)]; } } while (0)
  f32x16 pA0, pA1, pB0, pB1; float mnA, mnB, alA, alB; bf16x8 pa0, pa1, pa2, pa3; const int NT = seq / KVBLK;
  constexpr int SE = 0, SO = SDEPTH - 1;
  ATT_SLOAD(SE, 0); asm volatile("s_waitcnt vmcnt(0)" ::: "memory"); ATT_SWRITE(0, SE); __syncthreads();
  qkt<DQK, QL>(pA0, pA1, K_lds, qr, qlds, ka); partialSM(pA0, pA1, m_reg, mnA, alA, C, thr_raw);
  ATT_SLOAD(SO, KVBLK); if (SDEPTH == 2) { if (2 < NT) ATT_SLOAD(SE, 2 * KVBLK); }
  ATT_SWAIT(); ATT_SWRITE(1, SO); __syncthreads();
  for (int j = 1; j + 1 < NT; j += 2) {
    ATT_SBAR(); qkt<DQK, QL>(pB0, pB1, K_lds + SHM_K, qr, qlds, ka);
    finishSM(pA0, pA1, alA, l_reg, pa0, pa1, pa2, pa3); ATT_SBAR();
    ATT_SLOAD(SO, (j + SDEPTH) * KVBLK); ATT_SBAR();
    pv_d0(o, vb0, pa0, pa1, pa2, pa3); partialSM(pB0, pB1, m_reg, mnB, alB, C, thr_raw);
    __syncthreads(); ATT_SWAIT(); ATT_SWRITE(0, SE);
    ATT_RESC(alB); __syncthreads();
    ATT_SBAR(); qkt<DQK, QL>(pA0, pA1, K_lds, qr, qlds, ka);
    finishSM(pB0, pB1, alB, l_reg, pa0, pa1, pa2, pa3); ATT_SBAR();
    if (SDEPTH == 1 || j + 3 < NT) ATT_SLOAD(SE, (j + 1 + SDEPTH) * KVBLK); ATT_SBAR();
    pv_d0(o, vb0 + (int)SHM_V, pa0, pa1, pa2, pa3); partialSM(pA0, pA1, m_reg, mnA, alA, C, thr_raw);
    __syncthreads(); ATT_SWAIT(); ATT_SWRITE(1, SO);
    ATT_RESC(alA); __syncthreads();
  }
  ATT_SBAR(); qkt<DQK, QL>(pB0, pB1, K_lds + SHM_K, qr, qlds, ka);
  finishSM(pA0, pA1, alA, l_reg, pa0, pa1, pa2, pa3); ATT_SBAR();
  pv_d0(o, vb0, pa0, pa1, pa2, pa3); partialSM(pB0, pB1, m_reg, mnB, alB, C, thr_raw);
  __syncthreads(); ATT_RESC(alB);
  finishSM(pB0, pB1, alB, l_reg, pa0, pa1, pa2, pa3); ATT_SBAR();
  pv_d0(o, vb0 + (int)SHM_V, pa0, pa1, pa2, pa3);
  { const int t2 = ph_tid(), l2 = t2 & 63, w2 = t2 >> 6, r2 = l2 & 31, h2 = l2 >> 5;
    float* li2 = (float*)(lds + 2 * SHM_V + 2 * SHM_K) + w2 * 64;
    if (h2 == 0) li2[r2] = l_reg; asm volatile("s_waitcnt lgkmcnt(0)" ::: "memory");
    bf16_t* Ow = Ob + (w2 * QBLK) * LDO + r2;
#pragma unroll
    for (int r = 0; r < 16; ++r) { const int orow = crow(r, h2); const float rl = __builtin_amdgcn_rcpf(li2[orow]);
#pragma unroll
      for (int d0 = 0; d0 < 4; ++d0) Ow[orow * LDO + d0 * 32] = (bf16_t)(cvtpk(o[d0][r] * rl, 0.f) & 0xffffu); } }
  __syncthreads();
#undef ATT_SLOAD
#undef ATT_SWRITE
#undef ATT_SWAIT
#undef ATT_RESC
}

template <int DQK, int LDQ, int LDK, int LDV, int LDO>
__device__ __forceinline__ void attn_body_s1(const bf16_t* __restrict__ Qb, const bf16_t* __restrict__ Kh, const bf16_t* __restrict__ Vh, bf16_t* __restrict__ Ob, int seq, char* lds, const float scale) {
  constexpr int NKC = DQK / 64; constexpr size_t SHM_K = shm_k<DQK>();
  const float C = scale * 1.4426950408889634f, thr_raw = THR / scale;
  const int tid = ph_tid(), wid = tid >> 6, lane = tid & 63, r32 = lane & 31, hi = lane >> 5;
  char* V_lds = lds; char* K_lds = lds + 2 * SHM_V;
  float* wsf = (float*)(lds + 2 * SHM_V + 2 * SHM_K) + wid * 64; float* li_l = wsf; float* al_l = wsf + 32;
  float m_reg = -1e30f, l_reg = 0; f32x16 o[4] = {}; bf16x8 qr[DQK / 16];
  const bf16_t* Qw = Qb + (long)(wid * QBLK + r32) * LDQ + hi * 8;
#pragma unroll
  for (int d0 = 0; d0 < DQK / 16; ++d0) qr[d0] = *reinterpret_cast<const bf16x8*>(Qw + d0 * 16);
  const int sr = tid >> 4, sc = (tid & 15) * 8, vst0 = v_st(sr, sc), vst1 = v_st(32 + sr, sc);
  int kgo[NKC], klo[NKC];
#pragma unroll
  for (int i = 0; i < NKC; ++i) { const int c = tid + 512 * i, kr = c / (DQK / 8), kc = (c % (DQK / 8)) * 8; kgo[i] = kr * LDK + kc; klo[i] = kswz<DQK>(kr, kc * 2); }
  const int vgo = sr * LDV + sc;
  int ka[4];
#pragma unroll
  for (int q = 0; q < 4; ++q) ka[q] = r32 * (DQK * 2) + ((q * 32 + hi * 16) ^ ((r32 & 7) << 4));
  const __amdgpu_buffer_rsrc_t rK = __builtin_amdgcn_make_buffer_rsrc((void*)Kh, 0, 0x7ffffffc, 0x00020000), rV = __builtin_amdgcn_make_buffer_rsrc((void*)Vh, 0, 0x7ffffffc, 0x00020000);
  const int vb0 = (int)(uintptr_t)V_lds + v_rd_base(lane);
  bf16x8 vs0, vs1, ks[NKC];
#define ATT1_SLOAD(k0) do { const int _vo = (k0) * (LDV * 2), _ko = (k0) * (LDK * 2); vs0 = bl(rV, vgo * 2, _vo); vs1 = bl(rV, vgo * 2 + 64 * LDV, _vo); \
    _Pragma("unroll") for (int _c = 0; _c < NKC; ++_c) ks[_c] = bl(rK, kgo[_c] * 2, _ko); } while (0)
#define ATT1_SWRITE(b) do { *(bf16x8*)(V_lds + (b) * SHM_V + vst0) = vs0; *(bf16x8*)(V_lds + (b) * SHM_V + vst1) = vs1; \
    _Pragma("unroll") for (int _c = 0; _c < NKC; ++_c) *(bf16x8*)(K_lds + (b) * SHM_K + klo[_c]) = ks[_c]; } while (0)
  const int NT = seq / KVBLK;
  ATT1_SLOAD(0); asm volatile("s_waitcnt vmcnt(0)" ::: "memory"); ATT1_SWRITE(0);
  ATT1_SLOAD(KVBLK); asm volatile("s_waitcnt vmcnt(0)" ::: "memory"); ATT1_SWRITE(1); __syncthreads();
  for (int j = 0; j < NT; ++j) { const int b = j & 1;
    ATT_SBAR();
    f32x16 p0, p1; float mn, al; bf16x8 pa0, pa1, pa2, pa3;
    qkt<DQK, 0>(p0, p1, K_lds + b * SHM_K, qr, nullptr, ka);
    partialSM(p0, p1, m_reg, mn, al, C, thr_raw);
    if (__any(al < 1.f)) { if (hi == 0) al_l[r32] = al; asm volatile("s_waitcnt lgkmcnt(0)" ::: "memory");
#pragma unroll
      for (int d = 0; d < 4; ++d)
#pragma unroll
        for (int r = 0; r < 16; ++r) o[d][r] *= al_l[crow(r, hi)]; }
    finishSM(p0, p1, al, l_reg, pa0, pa1, pa2, pa3); ATT_SBAR();
    if (j + 2 < NT) ATT1_SLOAD((j + 2) * KVBLK);
    ATT_SBAR();
    pv_d0(o, vb0 + b * (int)SHM_V, pa0, pa1, pa2, pa3);
    __syncthreads();
    if (j + 2 < NT) { asm volatile("s_waitcnt vmcnt(0)" ::: "memory"); ATT1_SWRITE(b); } }
  { const int t2 = ph_tid(), l2 = t2 & 63, w2 = t2 >> 6, r2 = l2 & 31, h2 = l2 >> 5;
    float* li2 = (float*)(lds + 2 * SHM_V + 2 * SHM_K) + w2 * 64;
    if (h2 == 0) li2[r2] = l_reg; asm volatile("s_waitcnt lgkmcnt(0)" ::: "memory");
    bf16_t* Ow = Ob + (w2 * QBLK) * LDO + r2;
#pragma unroll
    for (int r = 0; r < 16; ++r) { const int orow = crow(r, h2); const float rl = __builtin_amdgcn_rcpf(li2[orow]);
#pragma unroll
      for (int d0 = 0; d0 < 4; ++d0) Ow[orow * LDO + d0 * 32] = (bf16_t)(cvtpk(o[d0][r] * rl, 0.f) & 0xffffu); } }
  __syncthreads();
#undef ATT1_SLOAD
#undef ATT1_SWRITE
}
template <int TYPE> __device__ __forceinline__ void attn_unit(const Params& p, int u, char* lds) {
  bf16_t* P = WSP(bf16_t, p, regA); bf16_t* OA = WSP(bf16_t, p, oall);
  int type, b, h, qb;
  if (u < 256) { const int x = u & 7, idx = u >> 3; type = idx >> 4; b = x >> 2;
    if (TYPE == 0) { qb = idx & 15; h = x & 3; }
    else { const int i = idx & 15, kvh = (x >> 1) & 1; h = 2 * kvh + (i & 1); qb = (x & 1) * 8 + (i >> 1); } }
  else { const int v = u - 256; type = v >> 3; b = (v >> 2) & 1; h = v & 3; qb = SEQ / 256; }
  const long q0 = (long)b * NTOK + qb * 256, k0 = (long)b * NTOK + (qb == SEQ / 256 ? SEQ : 0); const int seq = (qb == SEQ / 256) ? CTXL : NTOK;
  if (TYPE == 0) attn_body<MQK, MH * MQK, MH * MQK, MH * MV, DM, 1, 0>(WSP(bf16_t, p, qm) + q0 * (MH * MQK) + h * MQK, WSP(bf16_t, p, km) + k0 * (MH * MQK) + h * MQK, WSP(bf16_t, p, vm) + k0 * (MH * MV) + h * MV,
                                                                 OA + q0 * DM + 3 * BW + h * MV, seq, lds, 0.07216878364870322f  );
  else attn_body<GHD, PW, PW, PW, DM, ATT_SD_GQA, 0>(P + q0 * PW + OFF_GQ + h * GHD, P + k0 * PW + OFF_GK + (h / (GH / GKV)) * GHD, P + k0 * PW + OFF_GV + (h / (GH / GKV)) * GHD,
                                      OA + q0 * DM + BW + h * GHD, seq, lds, 0.08838834764831845f  );
}
}
template <int TYPE> __global__ __launch_bounds__(512, 2) void k_attn(Params p, int l) {
  extern __shared__ __attribute__((aligned(16))) unsigned char shm[];
  const int nu = 256 + (l == 0 ? 16 : 0);
  for (int u = blockIdx.x; u < nu; u += gridDim.x) { const int type = u < 256 ? ((u >> 3) >> 4) : ((u - 256) >> 3); if (type == TYPE) att::attn_unit<TYPE>(p, u, (char*)shm); }
}
#endif
#ifndef CPU_TEST
namespace ret {
using pg8::f32x4; using pg8::u32x4; using pg8::bf16x8;
static_assert(RCH == 128 && RQK == 64 && RV == 128, "retention tiles are written for chunk 128, qk 64, v 128");
constexpr int PT_ = 272, PS = 528, PQ = 144;
constexpr int LDS_A = 2 * 128 * PT_, LDS_C = 128 * PQ + 2 * 128 * PS + 2 * 132 * 4;
template <int NB, int KS> __device__ __forceinline__ void mma16(f32x4 (&acc)[NB], const LAS char* A, int lda, const LAS char* Bt, int ldb) {
  const int lane = ph_tid() & 63, r = lane & 15, kq = lane >> 4;
#pragma unroll
  for (int s = 0; s < KS; ++s) { const bf16x8 a = *(const LAS bf16x8*)(A + r * lda + (s * 32 + kq * 8) * 2);
#pragma unroll
    for (int nb = 0; nb < NB; ++nb) { const bf16x8 bfr = *(const LAS bf16x8*)(Bt + (nb * 16 + r) * ldb + (s * 32 + kq * 8) * 2); acc[nb] = __builtin_amdgcn_mfma_f32_16x16x32_bf16(a, bfr, acc[nb], 0, 0, 0); } }
}
__device__ __forceinline__ long chunk_row0(int b, int cs) { return (long)b * NTOK + (cs < SEQ / RCH ? cs * RCH : SEQ + (cs - SEQ / RCH) * RCH); }
__device__ __forceinline__ void st16(LAS char* p, unsigned v) { *(LAS unsigned short*)p = (unsigned short)v; }
template <int NC, bool WEIGHT, int PT> __device__ __forceinline__ void stage_T(LAS char* T, LAS char* T2, const bf16_t* src, int ld, float lg1, float lg2) {
  const int tidq = ph_tid();
#pragma unroll
  for (int i = 0; i < NC / 4; ++i) { const int id = tidq + 512 * i, key = id & 127, c = id >> 7; const u32x4 w = *(const u32x4*)(src + (long)key * ld + 8 * c);
    if (!WEIGHT) {
      st16(T + (8 * c + 0) * PT + key * 2, w.x); st16(T + (8 * c + 1) * PT + key * 2, w.x >> 16); st16(T + (8 * c + 2) * PT + key * 2, w.y); st16(T + (8 * c + 3) * PT + key * 2, w.y >> 16);
      st16(T + (8 * c + 4) * PT + key * 2, w.z); st16(T + (8 * c + 5) * PT + key * 2, w.z >> 16); st16(T + (8 * c + 6) * PT + key * 2, w.w); st16(T + (8 * c + 7) * PT + key * 2, w.w >> 16);
    } else { f32x4 a, b2; pg8::unpack8(w, a, b2); const float w1 = __expf(lg1 * (float)(RCH - 1 - key)), w2 = __expf(lg2 * (float)key);
#pragma unroll
      for (int j = 0; j < 4; ++j) { st16(T + (8 * c + j) * PT + key * 2, pg8::cvt_pk_bf16(a[j] * w1, 0.f)); st16(T + (8 * c + 4 + j) * PT + key * 2, pg8::cvt_pk_bf16(b2[j] * w1, 0.f));
        st16(T2 + (8 * c + j) * PT + key * 2, pg8::cvt_pk_bf16(a[j] * w2, 0.f)); st16(T2 + (8 * c + 4 + j) * PT + key * 2, pg8::cvt_pk_bf16(b2[j] * w2, 0.f)); } } }
}
__device__ __forceinline__ void ret_a_unit(const Params& p, int l, int u, LAS char* lds) {
  const int cs = u % RNC, h = (u / RNC) % RH, b = u / (RNC * RH), tidu = ph_tid(), wv = tidu >> 6, lane = tidu & 63;
  const float lgf = -__expf(p.in[I_RDF][l * RH + h]), lgb = -__expf(p.in[I_RDB][l * RH + h]);
  const bf16_t* P = WSP(bf16_t, p, regA) + chunk_row0(b, cs) * PW; LAS char* VT = lds; LAS char* KT = lds + 128 * PT_;
  stage_T<16, false, PT_>(VT, nullptr, P + OFF_RV + h * RV, PW, 0.f, 0.f);
  stage_T<8, true, PT_>(KT, KT + 64 * PT_, P + OFF_RK + h * RQK, PW, lgf, lgb);
  __syncthreads();
  f32x4 acc[8];
#pragma unroll
  for (int nb = 0; nb < 8; ++nb) acc[nb] = (f32x4){0.f, 0.f, 0.f, 0.f};
  mma16<8, 4>(acc, VT + wv * 16 * PT_, PT_, KT, PT_);
  float* RKV = WSP(float, p, rkv);
#pragma unroll
  for (int nb = 0; nb < 8; ++nb) { const int col = nb * 16 + (lane & 15), dir = col >> 6, dk = col & 63; float* o = RKV + ((((long)(b * RH + h) * 2 + dir) * RNC + cs) * RV + wv * 16 + (lane >> 4) * 4) * RQK + dk;
#pragma unroll
    for (int r = 0; r < 4; ++r) o[r * RQK] = acc[nb][r]; }
  __syncthreads();
}
__device__ __forceinline__ void ph_ret_scan(const Params& p, int l) {
  const float* RKV = WSP(float, p, rkv); bf16_t* RS = WSP(bf16_t, p, rs); constexpr int NL = SEQ / RCH, NCX = CTXL / RCH;
  for (long i = (long)blockIdx.x * 512 + ph_tid(); i < (long)NB * RH * 2 * RV * RQK; i += (long)gridDim.x * 512) { const int e = (int)(i % (RV * RQK)), dir = (int)((i / (RV * RQK)) % 2), h = (int)((i / (2 * RV * RQK)) % RH), b = (int)(i / (2 * RV * RQK * RH));
    const float lg = -__expf(p.in[dir ? I_RDB : I_RDF][l * RH + h]), dec = __expf(lg * (float)RCH); const long base = (((long)(b * RH + h) * 2 + dir) * RNC) * (RV * RQK) + e; float S = 0.f;
    for (int s0 = 0; s0 < RNC; s0 += 17) { float kv[17]; int cs_[17];
#pragma unroll
      for (int q = 0; q < 17; ++q) { const int s = s0 + q; cs_[q] = dir == 0 ? (s < NCX ? NL + s : s - NCX) : (RNC - 1 - s); kv[q] = RKV[base + (long)cs_[q] * (RV * RQK)]; }
#pragma unroll
      for (int q = 0; q < 17; ++q) { RS[base + (long)cs_[q] * (RV * RQK)] = (bf16_t)(pg8::cvt_pk_bf16(S, 0.f) & 0xffffu); S = dec * S + kv[q]; } } }
}
__device__ __forceinline__ void ret_c_unit(const Params& p, int l, int u, LAS char* lds) {
  const int ncs = (l == NLAYER - 1) ? SEQ / RCH : RNC; const int cs = u % ncs, h = (u / ncs) % RH, b = u / (ncs * RH), tid = ph_tid(), wv = tid >> 6, lane = tid & 63;
  const float lgf = -__expf(p.in[I_RDF][l * RH + h]), lgb = -__expf(p.in[I_RDB][l * RH + h]); const long R0 = chunk_row0(b, cs);
  const bf16_t* P = WSP(bf16_t, p, regA) + R0 * PW; LAS char* Ks = lds; LAS char* Ss = lds + 128 * PQ; LAS char* B2 = Ss + 128 * PS; LAS float* gf = (LAS float*)(B2 + 128 * PS); LAS float* gb = gf + 132;
  if (tid < 129) { gf[tid] = __expf(lgf * (float)tid); gb[tid] = __expf(lgb * (float)tid); }
#pragma unroll
  for (int i = 0; i < 2; ++i) { const int id = tid + 512 * i, row = id >> 3, c = id & 7; *(LAS u32x4*)(Ks + row * PQ + c * 16) = *(const u32x4*)(P + (long)row * PW + OFF_RK + h * RQK + 8 * c);
    *(LAS u32x4*)(Ss + row * PS + 256 + c * 16) = *(const u32x4*)(P + (long)row * PW + OFF_RQ + h * RQK + 8 * c); }
  stage_T<16, false, PS>(B2, nullptr, P + OFF_RV + h * RV, PW, 0.f, 0.f);
  { const bf16_t* RS = WSP(bf16_t, p, rs);
#pragma unroll
    for (int i = 0; i < 4; ++i) { const int id = tid + 512 * i, dir = id >> 10, dv = (id >> 3) & 127, c = id & 7;
      *(LAS u32x4*)(B2 + dv * PS + 256 + dir * 128 + c * 16) = *(const u32x4*)(RS + ((((long)(b * RH + h) * 2 + dir) * RNC + cs) * RV + dv) * RQK + 8 * c); } }
  __syncthreads();
  LAS char* myS = Ss + wv * 16 * PS;
  { f32x4 acc[8];
#pragma unroll
    for (int nb = 0; nb < 8; ++nb) acc[nb] = (f32x4){0.f, 0.f, 0.f, 0.f};
    mma16<8, 2>(acc, myS + 256, PS, Ks, PQ);
#pragma unroll
    for (int nb = 0; nb < 8; ++nb) { const int a2 = nb * 16 + (lane & 15);
#pragma unroll
      for (int r = 0; r < 4; ++r) { const int ar = (lane >> 4) * 4 + r, a = wv * 16 + ar; const float f = a2 <= a ? gf[a - a2] : gb[a2 - a]; st16(myS + ar * PS + a2 * 2, pg8::cvt_pk_bf16(acc[nb][r] * f, 0.f)); } } }
#pragma unroll
  for (int i = 0; i < 2; ++i) { const int id = lane + 64 * i, ar = id >> 3, c = id & 7, a = wv * 16 + ar; LAS char* q = myS + ar * PS + 256 + c * 16; f32x4 x0, x1; pg8::unpack8(*(const LAS u32x4*)q, x0, x1);
    const float sf = gf[a + 1], sb = gb[RCH - a]; *(LAS u32x4*)(q + 128) = pg8::pack8(x0 * sb, x1 * sb); *(LAS u32x4*)q = pg8::pack8(x0 * sf, x1 * sf); }
  asm volatile("s_waitcnt lgkmcnt(0)" ::: "memory");
  f32x4 o[8];
#pragma unroll
  for (int nb = 0; nb < 8; ++nb) o[nb] = (f32x4){0.f, 0.f, 0.f, 0.f};
  mma16<8, 8>(o, myS, PS, B2, PS);
#pragma unroll
  for (int r = 0; r < 4; ++r) { float s = 0.f;
#pragma unroll
    for (int nb = 0; nb < 8; ++nb) s += o[nb][r];
    s += __shfl_xor(s, 8); s += __shfl_xor(s, 4); s += __shfl_xor(s, 2); s += __shfl_xor(s, 1); const float mean = s * (1.f / RV); float q = 0.f;
#pragma unroll
    for (int nb = 0; nb < 8; ++nb) { const float d = o[nb][r] - mean; q += d * d; }
    q += __shfl_xor(q, 8); q += __shfl_xor(q, 4); q += __shfl_xor(q, 2); q += __shfl_xor(q, 1); const float rs = 1.f / sqrtf(q * (1.f / RV) + NORM_EPS);
    const int ar = (lane >> 4) * 4 + r;
#pragma unroll
    for (int nb = 0; nb < 8; ++nb) *(LAS float*)(myS + ar * PS + (nb * 16 + (lane & 15)) * 4) = (o[nb][r] - mean) * rs; }
  asm volatile("s_waitcnt lgkmcnt(0)" ::: "memory");
  { const float* gain = p.in[I_RNORM] + l * BW + h * RV; bf16_t* OA = WSP(bf16_t, p, oall); const int ar = lane >> 2, c4 = lane & 3; const long R = R0 + wv * 16 + ar;
    u32x4 gt[4];
#pragma unroll
    for (int it = 0; it < 4; ++it) gt[it] = *(const u32x4*)(P + (long)(wv * 16 + ar) * PW + OFF_RG + h * RV + (c4 + 4 * it) * 8);
#pragma unroll
    for (int it = 0; it < 4; ++it) { const int dv = (c4 + 4 * it) * 8; const LAS float* q = (const LAS float*)(myS + ar * PS + dv * 4); f32x4 x0 = *(const LAS f32x4*)q, x1 = *(const LAS f32x4*)(q + 4), g0, g1; pg8::unpack8(gt[it], g0, g1);
      x0 = x0 * *(const f32x4*)(gain + dv) * g0 * pg8::sigmoid4(g0); x1 = x1 * *(const f32x4*)(gain + dv + 4) * g1 * pg8::sigmoid4(g1);
      *(u32x4*)(OA + R * DM + 2 * BW + h * RV + dv) = pg8::pack8(x0, x1); } }
  __syncthreads();
}
}
template <int WHICH> __global__ __launch_bounds__(512, 2) void k_ret(Params p, int l) {
  extern __shared__ __attribute__((aligned(16))) unsigned char shm[]; LAS char* lds = (LAS char*)shm;
  if (WHICH == 0) for (int u = blockIdx.x; u < NB * RH * RNC; u += gridDim.x) ret::ret_a_unit(p, l, u, lds);
  if (WHICH == 1) ret::ph_ret_scan(p, l);
  if (WHICH == 2) { const int nu = NB * RH * ((l == NLAYER - 1) ? SEQ / RCH : RNC); for (int u = blockIdx.x; u < nu; u += gridDim.x) ret::ret_c_unit(p, l, u, lds); }
}
#endif
#ifndef CPU_TEST
#define XB_TMO      128
#define XB_XCNT(j)  (256  + 64 * (j))
#define XB_XSUB(j)  (1280 + 64 * (j))
#define XB_XGEN(j)  (2304 + 64 * (j))
#define XB_TOP      3328
#define XB_TOPGEN   3392
#define XCD_BAR_WORDS 3456
#define XB_SPIN_CAP (1u << 18)

__device__ __forceinline__ unsigned xb_ld(unsigned* p)              { return __hip_atomic_load(p, __ATOMIC_RELAXED, __HIP_MEMORY_SCOPE_AGENT); }
__device__ __forceinline__ unsigned xb_add(unsigned* p, unsigned v) { return __hip_atomic_fetch_add(p, v, __ATOMIC_RELAXED, __HIP_MEMORY_SCOPE_AGENT); }
__device__ __forceinline__ unsigned xb_xcc_id() { return (unsigned)__builtin_amdgcn_s_getreg((3 << 11) | 20) & 0xFu; }
#define XB_SPIN(cond, bar) do { unsigned _sp = 0; while (cond) { __builtin_amdgcn_s_sleep(1); \
    if ((++_sp & 255u) == 0u) { if (xb_ld(&(bar)[XB_TMO])) break; if (_sp > XB_SPIN_CAP) { atomicAdd(&(bar)[XB_TMO], 1u); break; } } } } while (0)

struct XcdBarrier {
    unsigned* bar; unsigned x;
    volatile LAS unsigned* st;
};

__device__ __forceinline__ XcdBarrier xcd_barrier_post(unsigned* bar, volatile LAS unsigned* st) {
    XcdBarrier b; b.bar = bar; b.x = xb_xcc_id(); b.st = st;
    if (threadIdx.x == 0) (void)xb_add(&bar[XB_XCNT(b.x)], 1u);
    return b;
}
__device__ __forceinline__ void xcd_barrier_complete(unsigned* bar, unsigned x, unsigned& nloc, unsigned& nx) {
    const unsigned G = gridDim.x * gridDim.y * gridDim.z;
    unsigned sum, cnt, mine, sp = 0u;
    for (;;) {
        sum = 0u; cnt = 0u; mine = 0u;
#pragma unroll
        for (unsigned j = 0; j < 16; ++j) { const unsigned c = xb_ld(&bar[XB_XCNT(j)]); sum += c; cnt += (c > 0u) ? 1u : 0u; mine = (j == x) ? c : mine; }
        if (sum == G) break;
        __builtin_amdgcn_s_sleep(1);
        if ((++sp & 255u) == 0u) { if (xb_ld(&bar[XB_TMO])) break; if (sp > XB_SPIN_CAP) { atomicAdd(&bar[XB_TMO], 1u); break; } }
    }
    nloc = mine > 0u ? mine : 1u; nx = cnt > 0u ? cnt : 1u;
}

__device__ __forceinline__ void xcd_barrier(const XcdBarrier& b) {
    asm volatile("s_waitcnt vmcnt(0)" ::: "memory");
    __syncthreads();
    if (threadIdx.x == 0) {
        unsigned* bar = b.bar;
        __builtin_amdgcn_s_waitcnt(0);
        unsigned nloc = b.st[0], nx = b.st[1];
        if (nloc == 0u) { xcd_barrier_complete(bar, b.x, nloc, nx); b.st[0] = nloc; b.st[1] = nx; }
        const unsigned old = xb_add(&bar[XB_XSUB(b.x)], 1u);
        const unsigned gen = old / nloc;
        if (old + 1u == (gen + 1u) * nloc) {
            __builtin_amdgcn_fence(__ATOMIC_RELEASE, "agent");
            asm volatile("s_waitcnt vmcnt(0)" ::: "memory");
            const unsigned og = xb_add(&bar[XB_TOP], 1u);
            const unsigned tg = og / nx;
            if (og + 1u == (tg + 1u) * nx) xb_add(&bar[XB_TOPGEN], 1u);
            else XB_SPIN(xb_ld(&bar[XB_TOPGEN]) == tg, bar);
            __builtin_amdgcn_fence(__ATOMIC_ACQUIRE, "agent");
            xb_add(&bar[XB_XGEN(b.x)], 1u);
            asm volatile("s_waitcnt vmcnt(0)" ::: "memory");
        } else {
            XB_SPIN(xb_ld(&bar[XB_XGEN(b.x)]) == gen, bar);
            __builtin_amdgcn_fence(__ATOMIC_ACQUIRE, "agent");
            asm volatile("s_waitcnt vmcnt(0)" ::: "memory");
        }
    }
    __syncthreads();
}

#endif
#ifndef CPU_TEST
#include <type_traits>
constexpr int MEGA_LDS = ((ret::LDS_C > pg8::STAGE_BYTES ? ret::LDS_C : pg8::STAGE_BYTES) + 255) / 256 * 256 + 256;
typedef const __attribute__((address_space(4))) Params* KParamsPtr;
__device__ __forceinline__ Params kparams() {
#if defined(__HIP_DEVICE_COMPILE__)
  KParamsPtr k = (KParamsPtr)__builtin_amdgcn_kernarg_segment_ptr(); asm volatile("" : "+s"(k)); Params r; __builtin_memcpy(&r, k, sizeof(Params)); return r;
#else
  return Params{};
#endif
}
__device__ __forceinline__ int rotc(int off) { const int G = gridDim.x; return (int)((ph_bid() + G - (off % G)) % G); }

#ifndef MK_XCD_UP
#define MK_XCD_UP 1
#endif
#ifndef MK_XCD_DN
#define MK_XCD_DN 1
#endif
#ifndef MK_DBL
#define MK_DBL 0
#endif
#define REPS(id) ((MK_DBL) == (id) ? 2 : 1)
#ifndef MK_WAITMASK
#define MK_WAITMASK 0xffffffffffffffffull
#endif
#define CONVQ_COUNTER ((unsigned*)(p.ws + WS.bar) + XCD_BAR_WORDS)
#define CONVQ_ARRIVED(k) ((unsigned*)(p.ws + WS.bar) + XCD_BAR_WORDS + 64 * (1 + (k)))
#ifndef MK_BGCONV
#define MK_BGCONV 1
#endif
#ifndef MK_BGMASK
#define MK_BGMASK 0x47c55f1ull
#endif
#define BG_IDLE() do { if (MK_BGCONV && convq_alive && ((MK_BGMASK >> bar_idx) & 1ull)) { if (threadIdx.x == 0) __hip_atomic_fetch_add(CONVQ_ARRIVED(bar_idx), 1u, __ATOMIC_RELAXED, __HIP_MEMORY_SCOPE_AGENT); \
    __syncthreads(); convq_alive = ph::conv_work<ph::CLAIM_IDLE>(p, lds, CONVQ_COUNTER, 0, CONVQ_ARRIVED(bar_idx)); } ++bar_idx; } while (0)
#define CONV_DRAIN(t) do { if (MK_BGCONV && convq_alive) convq_alive = ph::conv_work<ph::CLAIM_DRAIN>(p, lds, CONVQ_COUNTER, (t), nullptr); } while (0)
#ifdef MK_WAITPROBE
#define BARX() do { const unsigned long long t0_ = wall_clock64(); xcd_barrier(bar); if ((MK_WAITMASK >> bidx_) & 1ull) wait_acc += wall_clock64() - t0_; ++bidx_; if (blockIdx.x == (MK_WAITPROBE) && threadIdx.x == 0) ((unsigned long long*)(p.ws + WS.bar + 30720))[40] = wait_acc; } while (0)
#else
#define BARX() do { BG_IDLE(); xcd_barrier(bar); if ((MK_DBL) == 99) xcd_barrier(bar); } while (0)
#endif
#ifdef MK_PROBE_A
#define STAMP(k) do { if (blockIdx.x == 0 && threadIdx.x == 0) ((unsigned long long*)(p.ws + WS.bar + 30720))[k] = wall_clock64(); } while (0)
#else
#define STAMP(k) do { } while (0)
#endif
__global__ __launch_bounds__(512, 2) void mega(Params p_unused_) {
#define p (kparams())
  extern __shared__ __attribute__((aligned(16))) unsigned char shm[];
  LAS unsigned char* lds = (LAS unsigned char*)shm; char* ldsg = (char*)shm;
  LAS unsigned* xbw = (LAS unsigned*)(lds + MEGA_LDS - 16);
  if (threadIdx.x < 4) xbw[threadIdx.x] = 0u;
  __syncthreads();
  XcdBarrier bar = xcd_barrier_post((unsigned*)(p.ws + WS.bar), (volatile LAS unsigned*)xbw);
  STAMP(0);
  bool convq_alive = true; int bar_idx = 0;
#ifdef MK_WAITPROBE
  unsigned long long wait_acc = 0ull; int bidx_ = 0;
#endif
  using namespace pg8;
  const int G = gridDim.x;
#define P WSP(bf16_t, p, regA)
#define PROJ ((bf16_t*)(p.ws + WS.regA + SZ_P))
#define H1 WSP(bf16_t, p, h1)
#define QM WSP(bf16_t, p, qm)
#define KM WSP(bf16_t, p, km)
#define VM WSP(bf16_t, p, vm)
#define Z WSP(bf16_t, p, z)
#define OA WSP(bf16_t, p, oall)
#define XS WSP(bf16_t, p, regA)
#define ACT ((bf16_t*)(p.ws + WS.regA + SZ_XS))
#define YS ((bf16_t*)(p.ws + WS.regA + SZ_XS + SZ_ACT))
  constexpr int nMfull = MROWS / 256;

#ifdef MK_NANFILL
  {
    u32x4* q = (u32x4*)(p.ws + WS.x1); const long n1 = (long)(WS.s5sw - WS.x1) / 16; const u32x4 nanv = {0x7FC07FC0u, 0x7FC07FC0u, 0x7FC07FC0u, 0x7FC07FC0u};
    for (long i = (long)blockIdx.x * 512 + threadIdx.x; i < n1; i += (long)gridDim.x * 512) q[i] = nanv;
    u32x4* q2 = (u32x4*)(p.ws + WS.rkv); const long n2 = (long)(WS.end - WS.rkv) / 16;
    for (long i = (long)blockIdx.x * 512 + threadIdx.x; i < n2; i += (long)gridDim.x * 512) q2[i] = nanv; }
#endif
_Pragma("unroll") for (int rep_ = 0; rep_ < REPS(11); ++rep_) {
  ph::ph_s5tables(p, lds);
  ph::ph_tables(p);
  ph::ph_mod(p, lds, rotc(64));
    }
_Pragma("unroll") for (int rep_ = 0; rep_ < REPS(1); ++rep_) {
  ph::conv_work<ph::CLAIM_DRAIN>(p, lds, CONVQ_COUNTER, ph::CT_DENSE_L, nullptr);
    }
  BARX();
  STAMP(1);
_Pragma("unroll") for (int rep_ = 0; rep_ < REPS(19); ++rep_) {
  ph::ph_ln_in(p, 0);
    }
  BARX();
  STAMP(2);

  auto layer = [&](auto LC) __attribute__((always_inline)) { constexpr int l = decltype(LC)::value; constexpr int last = (l == NLAYER - 1), nMlat = last ? nMfull - 2 : nMfull;
_Pragma("unroll") for (int rep_ = 0; rep_ < REPS(2); ++rep_) {
    { SchedGrid S{(const char*)H1, (const char*)(WSP(bf16_t, p, wt_in) + (long)l * PW * DM), DM, DM, nMfull, PW / 256 - 1, 0, G, ph_bid(), 0};
      gemm_phase(lds, GemmG{DM, DM, DM, 0}, S, EpiBf16{P, PW, 0}); }
    }
    BARX();
    STAMP(2 + 15 * l + 1);
    ph::ph_post_proj(p, l);
    CONV_DRAIN(l * ph::CT_LAYER + ph::CT_PREP);
    BARX();
    STAMP(2 + 15 * l + 2);
_Pragma("unroll") for (int rep_ = 0; rep_ < REPS(12); ++rep_) {
    { constexpr int NKR = MROWS / 256;
      const int vw = ph_bid() - NKR, G2 = G - NKR;
      if (vw < 0) { SchedKR S{(const char*)H1, (const char*)(WSP(bf16_t, p, wt_in) + (long)l * PW * DM), G, ph_bid()};
        gemm_phase<false, PG8_SP2>(lds, GemmG{DM, DM, DM, 0}, S, EpiKR{KM, WSP(float, p, rope_b)}); }
      else {
        { SchedGrid S{(const char*)(P + OFF_CQ), (const char*)(WSP(bf16_t, p, wt_uq) + (long)l * MH * MQK * MQL), PW, MQL, nMfull, MH * MQK / 256, 0, G2, vw, 0};
          gemm_phase<false, PG8_SP2>(lds, GemmG{PW, MQL, MQL, 0}, S, EpiQM{QM, WSP(float, p, rope_b)}); }
        { SchedGrid S{(const char*)(P + OFF_CKV), (const char*)(WSP(bf16_t, p, wt_ukv) + (long)l * MH * (MNOPE + MV) * MKVL), PW, MKVL, nMfull, MH, 0, G2, (vw + G2 - 102) % G2, 0};
          gemm_phase<false, PG8_SP2>(lds, GemmG{PW, MKVL, MKVL, 0}, S, EpiKVm{KM, VM}); }
        { SchedS5 S{(const char*)WSP(bf16_t, p, uh), (const char*)(WSP(bf16_t, p, s5sw) + (long)l * S5G * S5K2 * S5K1), (size_t)S5K2 * S5K1 * 2, G2, (vw + G2 - (238 % G2)) % G2};
          gemm_phase<false, PG8_SP2>(lds, GemmG{S5K1 + S5K2, S5K1, S5K1, 0}, S, EpiS5E{WSP(float, p, s5e)}); }
        for (int u = (vw + G2 - ((238 + 96) % G2)) % G2; u < NB * RH * RNC; u += G2) ret::ret_a_unit(p, l, u, (LAS char*)lds); } }
    }
    BARX();
    STAMP(2 + 15 * l + 3);
_Pragma("unroll") for (int rep_ = 0; rep_ < REPS(13); ++rep_) {
    ph::ph_s5scan(p, l);
    ret::ph_ret_scan(p, l);
    }
    BARX();
    STAMP(2 + 15 * l + 4);
_Pragma("unroll") for (int rep_ = 0; rep_ < REPS(4); ++rep_) {
_Pragma("unroll") for (int rq_ = 0; rq_ < REPS(21); ++rq_) {
    { const int w = ph_bid();
      if (w < 128) att::attn_unit<0>(p, w, ldsg); else if (w < 256) att::attn_unit<1>(p, w, ldsg);
      if (!last) { if (w >= 224 && w < 232) att::attn_unit<0>(p, 256 + (w - 224), ldsg); else if (w >= 240 && w < 248) att::attn_unit<1>(p, 256 + 8 + (w - 240), ldsg); } }
    }
_Pragma("unroll") for (int rq_ = 0; rq_ < REPS(22); ++rq_) {
    { SchedS5 S{(const char*)WSP(bf16_t, p, uh), (const char*)(WSP(bf16_t, p, s5sv) + (long)l * S5G * S5K1 * (S5K1 + S5K2)), (size_t)S5K1 * (S5K1 + S5K2) * 2, 96, ph_bid() - 128};
      if (ph_bid() >= 128 && ph_bid() < 224) gemm_phase<false, PG8_SP2>(lds, GemmG{S5K1 + S5K2, S5K1 + S5K2, S5K1 + S5K2, 0}, S, EpiS5Y{P, p.in[I_S5D] + (long)l * BW, Z, last, 0}); }
    }
_Pragma("unroll") for (int rq_ = 0; rq_ < REPS(23); ++rq_) {
    { const int nu = NB * RH * (last ? SEQ / RCH : RNC), w = ph_bid();
      if (w >= 128) for (int u = w - 128; u < nu; u += 128) ret::ret_c_unit(p, l, u, (LAS char*)lds); }
    }
    }
    CONV_DRAIN(l * ph::CT_LAYER + ph::CT_GLU);
    BARX();
    STAMP(2 + 15 * l + 5);
_Pragma("unroll") for (int rep_ = 0; rep_ < REPS(14); ++rep_) {
    { SchedGrid S{(const char*)Z, (const char*)(WSP(bf16_t, p, wt_glu) + (long)l * BW * BW), BW, BW, nMlat, BW / 256, last, G, ph_bid(), 0};
      gemm_phase<false, PG8_SP2>(lds, GemmG{BW, BW, BW, 0}, S, EpiGluO{Z, OA}); }
    }
    CONV_DRAIN(l * ph::CT_LAYER + ph::CT_GATE);
    BARX();
    STAMP(2 + 15 * l + 6);
_Pragma("unroll") for (int rep_ = 0; rep_ < REPS(6); ++rep_) {
    if (!last) { SchedGateCtx S{(const char*)H1, (const char*)(WSP(bf16_t, p, wt_gate) + (long)l * 4 * DM * DM), G, ph_bid()};
      gemm_phase(lds, GemmG{DM, DM, DM, 0}, S, EpiGateCtx{p.in[I_BGATE] + (long)l * 4 * DM, WSP(bf16_t, p, gctx)}); }
    { SchedProjW S{(const char*)OA, (const char*)(WSP(bf16_t, p, wt_br) + (long)l * 4 * DM * BW), nMlat, last, G, ph_bid(), last ? 0 : 64, 2, last ? 4 : 5, 0};
      gemm_phase(lds, GemmG{DM, BW, BW, 0}, S, EpiBf16{PROJ, 4 * DM, 0}); }
    }
    BARX();
    STAMP(2 + 15 * l + 7);
_Pragma("unroll") for (int rep_ = 0; rep_ < REPS(7); ++rep_) {
    if (!last) ph::ph_merge_ctx(p);
    { SchedGate4 S{(const char*)H1, (const char*)(WSP(bf16_t, p, wt_gate) + (long)l * 4 * DM * DM), G, ph_bid()};
      gemm_phase(lds, GemmG{DM, DM, DM, 1}, S, EpiGate4{p.in[I_BGATE] + (long)l * 4 * DM, PROJ, WSP(bf16_t, p, merged)}); }
    }
    CONV_DRAIN(l * ph::CT_LAYER + ph::CT_OUT);
    BARX();
    STAMP(2 + 15 * l + 8);
_Pragma("unroll") for (int rep_ = 0; rep_ < REPS(8); ++rep_) {
    { SchedGrid S{(const char*)WSP(bf16_t, p, merged), (const char*)(WSP(bf16_t, p, wt_out) + (long)l * DM * DM), DM, DM, nMlat, DM / 256, last, G, ph_bid(), 0};
      gemm_phase(lds, GemmG{DM, DM, DM, 0}, S, EpiBf16{WSP(bf16_t, p, macc), DM, 0}); }
    }
    BARX();
    STAMP(2 + 15 * l + 9);
_Pragma("unroll") for (int rep_ = 0; rep_ < REPS(15); ++rep_) {
    ph::ph_ln1(p, l, lds);
    }
    BARX();
    STAMP(2 + 15 * l + 10);
_Pragma("unroll") for (int rep_ = 0; rep_ < REPS(16); ++rep_) {
    ph::ph_topk(p, l, lds);
#ifdef MK_QPROBE
    if (l == 0 && blockIdx.x == 0 && threadIdx.x == 0) ((unsigned long long*)(p.ws + WS.bar + 30720))[41] = __hip_atomic_load(CONVQ_COUNTER, __ATOMIC_RELAXED, __HIP_MEMORY_SCOPE_AGENT);
#endif
    if (convq_alive) convq_alive = ph::conv_work<ph::CLAIM_DRAIN>(p, lds, CONVQ_COUNTER, (l + 1) * ph::CT_LAYER, nullptr);
    }
    BARX();
    STAMP(2 + 15 * l + 11);
    const int nMl = last ? (2 * CAP_L) / 256 : XEP / 256;
_Pragma("unroll") for (int rep_ = 0; rep_ < REPS(9); ++rep_) {
    { SchedMoe S{(const char*)XS, (const char*)(WSP(bf16_t, p, wt_gu) + (long)l * NE * 2 * FF * DM), DM, DM, nMl, 2 * FF / 256, (size_t)2 * FF * DM * 2, G, ph_bid(), MK_XCD_UP, 0};
      gemm_phase_gather(lds, GemmG{DM, DM, DM, 0}, S, EpiSwiGlu{ACT}, (const char*)WSP(bf16_t, p, h2), (const int*)WSP(int, p, xsrc), (unsigned)(WS.zrow - WS.h2)); }
    }
    BARX();
    STAMP(2 + 15 * l + 13);
_Pragma("unroll") for (int rep_ = 0; rep_ < REPS(10); ++rep_) {
    { SchedMoe S{(const char*)ACT, (const char*)(WSP(bf16_t, p, wt_dn) + (long)l * NE * DM * FF), FF, FF, nMl, DM / 256, (size_t)DM * FF * 2, G, ph_bid(), MK_XCD_DN, 0};
      gemm_phase(lds, GemmG{FF, FF, FF, 0}, S, EpiBf16{YS, DM, 0}); }
    }
    BARX();
    STAMP(2 + 15 * l + 14);
_Pragma("unroll") for (int rep_ = 0; rep_ < REPS(18); ++rep_) {
    ph::ph_ln2(p, l);
    if (!last && convq_alive) convq_alive = ph::conv_work<ph::CLAIM_DRAIN>(p, lds, CONVQ_COUNTER, (l + 1) * ph::CT_LAYER + ph::CT_DENSE_L, nullptr);
    }
    if (!last) BARX();
    if (!last) STAMP(2 + 15 * l + 15);
  };
  layer(std::integral_constant<int, 0>{});
  layer(std::integral_constant<int, 1>{});
#undef p
#undef P
#undef PROJ
#undef H1
#undef QM
#undef KM
#undef VM
#undef Z
#undef OA
#undef XS
#undef ACT
#undef YS
}

extern "C" void kernel_launch(void* const* d_in, const int* in_sizes, int n_in, void* d_out, int out_size, void* d_ws, size_t ws_size, hipStream_t stream) {
  if (n_in != N_IN || ws_size < WS.end || out_size != NB * SEQ * DM) { fprintf(stderr, "kernel_launch: unexpected sizes n_in %d ws %zu (need %zu) out %d\n", n_in, ws_size, WS.end, out_size); return; }
  static int grid = 0;
  if (!grid) { int dev = 0, cus = 0, per_cu = 0; (void)hipGetDevice(&dev); (void)hipDeviceGetAttribute(&cus, hipDeviceAttributeMultiprocessorCount, dev);
    (void)hipFuncSetAttribute((const void*)mega, hipFuncAttributeMaxDynamicSharedMemorySize, MEGA_LDS);
    (void)hipOccupancyMaxActiveBlocksPerMultiprocessor(&per_cu, (const void*)mega, 512, MEGA_LDS);
    if (per_cu < 1) { fprintf(stderr, "kernel_launch: occupancy query says %d blocks per CU\n", per_cu); return; }
    grid = cus > 256 ? 256 : cus; }
  Params p; memset(&p, 0, sizeof(p));
  for (int i = 0; i < N_IN; ++i) p.in[i] = (const float*)d_in[i];
  p.out = (float*)d_out; p.ws = (char*)d_ws;
  (void)hipMemsetAsync((char*)d_ws + WS.bar, 0, (XCD_BAR_WORDS + 64 * 40) * sizeof(unsigned), stream);
  hipLaunchKernelGGL(mega, dim3(grid), dim3(512), MEGA_LDS, stream, p);
}
#endif
```
